# Optimizing an MI355X kernel written in HIP

```python
import math
import jax
import jax.numpy as jnp
from jax import lax
import numpy as np

D_MODEL = 2048
BATCH = 2
SEQ = 16384
DEPTH = 4
DEC_BATCH = 4
DEC_SEQ = 2048
PAST_LEN = 128

N_MIXERS = 2
N_HYENA = (DEPTH + 1) // 2
N_ATTN = DEPTH // 2
HYENA_ORDER = 2
N_DIRS = 2
SHORT_WIDTH = 3
FILTER_BANDS = 16
FILTER_EMB = 1 + 2 * FILTER_BANDS
FILTER_HIDDEN = 64
DECAY_TARGET = 1e-2
FAST_DECAY_PCT = 0.3
SLOW_DECAY_PCT = 1.5
ATTN_PATTERNS = ((128, 1), (512, 4), (2048, 16))
N_GROUPS = len(ATTN_PATTERNS)
HEADS_PER_GROUP = 8
HEAD_DIM = 128
GROUP_WIDTH = HEADS_PER_GROUP * HEAD_DIM
ROT_DIM = HEAD_DIM // 4
ROPE_THETA = 500000.0
D_FF = -(-8 * D_MODEL // (3 * 256)) * 256
EPS = 1e-6

kernel_name = 'hybrid_hyena_dilated_attn_encoder'

F32 = jnp.float32


def rms_norm(x, g):
    x32 = x.astype(F32)
    y = x32 * lax.rsqrt(jnp.mean(x32 * x32, axis=-1, keepdims=True) + EPS)
    return (y * g.astype(F32)).astype(x.dtype)


def modulate(h, shift, scale):
    return h * (1 + scale[:, None, :]) + shift[:, None, :]


def short_conv(z, w, b):
    zp = jnp.pad(z, ((0, 0), (1, 1), (0, 0)))
    return zp[:, :-2] * w[0] + zp[:, 1:-1] * w[1] + zp[:, 2:] * w[2] + b


def hyena_filters(L, w1, b1, freq, w2, b2, w3, decay):
    pos = jnp.arange(L, dtype=F32)
    t = pos / max(L - 1, 1)
    bands = jnp.linspace(1e-4, FILTER_BANDS - 1, FILTER_BANDS, dtype=F32)
    ang = 2.0 * math.pi * pos[:, None] * bands[None, :] / L
    z = jnp.concatenate([t[:, None], jnp.cos(ang), -jnp.sin(ang)], axis=-1)
    a = jnp.sin(freq[0].astype(F32) * (z @ w1.astype(F32) + b1.astype(F32)))
    a = jnp.sin(freq[1].astype(F32) * (a @ w2.astype(F32) + b2.astype(F32)))
    h = (a @ w3.astype(F32)).reshape(L, HYENA_ORDER, N_DIRS, D_MODEL)
    window = jnp.exp(-t[:, None, None, None] * jnp.abs(decay.astype(F32))[None])
    return h * window


def long_conv(u, filt_fwd, filt_bwd, skip):
    L = u.shape[1]
    filt = jnp.concatenate(
        [filt_fwd, jnp.zeros((1, filt_fwd.shape[1]), F32), filt_bwd[:0:-1]], axis=0)
    filt = filt * lax.rsqrt(jnp.sum(filt * filt, axis=0, keepdims=True) + EPS)
    u32 = u.astype(F32)
    spec = jnp.fft.rfft(u32, n=2 * L, axis=1) * jnp.fft.rfft(filt, axis=0)[None]
    y = jnp.fft.irfft(spec, n=2 * L, axis=1)[:, :L]
    return (y + u32 * skip.astype(F32)).astype(u.dtype)


def hyena_mixer(h, w_in, b_in, conv_w, conv_b, fw1, fb1, ffreq, fw2, fb2, fw3, decay, skip,
                w_out, b_out):
    L = h.shape[1]
    z = short_conv(h @ w_in + b_in, conv_w, conv_b)
    x1, x2, v = jnp.split(z, 3, axis=-1)
    filt = hyena_filters(L, fw1, fb1, ffreq, fw2, fb2, fw3, decay)
    out = v
    for o, gate in enumerate((x1, x2)):
        out = gate * long_conv(out, filt[:, o, 0], filt[:, o, 1], skip[o])
    return out @ w_out + b_out


def rope_partial(x, pos):
    half = ROT_DIM // 2
    inv = ROPE_THETA ** (-jnp.arange(0, ROT_DIM, 2, dtype=F32) / ROT_DIM)
    ang = pos[:, None] * inv[None, :]
    cos = jnp.cos(ang)[None, :, None, :]
    sin = jnp.sin(ang)[None, :, None, :]
    a, b, rest = x[..., :half], x[..., half:ROT_DIM], x[..., ROT_DIM:]
    return jnp.concatenate([a * cos - b * sin, b * cos + a * sin, rest], axis=-1)


def dilated_group(q, k, v, window, dilation):
    B, L, H, dh = q.shape
    r = dilation
    radius = window // (2 * r)
    blk = radius
    n = L // r
    nb = -(-n // blk)
    n_pad = nb * blk

    def sub(a, lo, hi):
        a = a.reshape(B, n, r, H, dh)
        return jnp.pad(a, ((0, 0), (lo, hi), (0, 0), (0, 0), (0, 0)))

    qb = sub(q, 0, n_pad - n).reshape(B, nb, blk, r, H, dh)

    def windows(a):
        ab = sub(a, blk, blk + n_pad - n).reshape(B, nb + 2, blk, r, H, dh)
        return jnp.concatenate([ab[:, :-2], ab[:, 1:-1], ab[:, 2:]], axis=2)

    kw, vw = windows(k), windows(v)
    s = jnp.einsum('bnqrhd,bnkrhd->bnrhqk', qb, kw) * (HEAD_DIM ** -0.5)
    qi = (jnp.arange(nb)[:, None] * blk + jnp.arange(blk)[None, :])[:, :, None]
    ki = (jnp.arange(nb)[:, None] * blk - blk + jnp.arange(3 * blk)[None, :])[:, None, :]
    valid = ((jnp.abs(ki - qi) <= radius) & (ki >= 0) & (ki < n)) | (ki == qi)
    s = jnp.where(valid[None, :, None, None], s, -jnp.inf)
    m = jnp.max(s, axis=-1, keepdims=True)
    p = jnp.exp(s - m)
    den = jnp.sum(p, axis=-1)
    o = jnp.einsum('bnrhqk,bnkrhd->bnqrhd', p, vw) / jnp.moveaxis(den, -1, 2)[..., None]
    lse = jnp.moveaxis(m[..., 0] + jnp.log(den), -1, 2)
    o = o.reshape(B, n_pad, r, H, dh)[:, :n].reshape(B, L, H, dh)
    lse = lse.reshape(B, n_pad, r, H)[:, :n].reshape(B, L, H)
    return o, lse


def dilated_attention(h, w_in, w_out):
    B, L, _ = h.shape
    qkv = (h @ w_in).astype(F32).reshape(B, L, N_GROUPS, 3, HEADS_PER_GROUP, HEAD_DIM)
    pos = jnp.arange(L, dtype=F32)
    outs, lses = [], []
    for g, (window, dilation) in enumerate(ATTN_PATTERNS):
        q = rope_partial(qkv[:, :, g, 0], pos)
        k = rope_partial(qkv[:, :, g, 1], pos)
        o, lse = dilated_group(q, k, qkv[:, :, g, 2], window, dilation)
        outs.append(o)
        lses.append(lse)
    alpha = jax.nn.softmax(jnp.stack(lses, axis=-1), axis=-1)
    o = jnp.einsum('gblhd,blhg->blhd', jnp.stack(outs, axis=0), alpha)
    return o.reshape(B, L, GROUP_WIDTH).astype(h.dtype) @ w_out


def swiglu(h, w_gate, w_up, w_down):
    return (jax.nn.silu(h @ w_gate) * (h @ w_up)) @ w_down


def encoder(x, c, p):
    cs = jax.nn.silu(c)
    for i in range(DEPTH):
        mod = cs @ p['ada_w'][i] + p['ada_b'][i]
        sh_m, sc_m, g_m, sh_f, sc_f, g_f = jnp.split(mod, 6, axis=-1)
        h = modulate(rms_norm(x, p['norm_mix'][i]), sh_m, sc_m)
        j = i // N_MIXERS
        if i % N_MIXERS == 0:
            y = hyena_mixer(h, p['hy_w_in'][j], p['hy_b_in'][j], p['hy_conv_w'][j], p['hy_conv_b'][j],
                            p['hy_fw1'][j], p['hy_fb1'][j], p['hy_ffreq'][j], p['hy_fw2'][j],
                            p['hy_fb2'][j], p['hy_fw3'][j], p['hy_decay'][j], p['hy_skip'][j],
                            p['hy_w_out'][j], p['hy_b_out'][j])
        else:
            y = dilated_attention(h, p['at_w_in'][j], p['at_w_out'][j])
        x = x + g_m[:, None, :] * y
        h = modulate(rms_norm(x, p['norm_ffn'][i]), sh_f, sc_f)
        x = x + g_f[:, None, :] * swiglu(h, p['ffn_w_gate'][i], p['ffn_w_up'][i], p['ffn_w_down'][i])
    sh, sc = jnp.split(cs @ p['final_ada_w'] + p['final_ada_b'], 2, axis=-1)
    return modulate(rms_norm(x, p['final_norm']), sh, sc)


def setup_inputs(seed: int = 0) -> dict:
    key = jax.random.key(seed)
    ks = iter(jax.random.split(key, 40))

    def nrm(shape, scale):
        return scale * jax.random.normal(next(ks), shape, F32)

    D = D_MODEL
    decay_base = jnp.linspace(-math.log(DECAY_TARGET) / SLOW_DECAY_PCT,
                              -math.log(DECAY_TARGET) / FAST_DECAY_PCT, D, dtype=F32)
    return {
        'x_prompt': nrm((BATCH, SEQ, D), 1.0),
        'x_sample': nrm((DEC_BATCH, DEC_SEQ, D), 1.0),
        'c_prompt': nrm((BATCH, D), 1.0),
        'c_sample': nrm((DEC_BATCH, D), 1.0),
        'ada_w': nrm((DEPTH, D, 6 * D), 0.5 * D ** -0.5),
        'ada_b': nrm((DEPTH, 6 * D), 0.02),
        'norm_mix': 1.0 + nrm((DEPTH, D), 0.05),
        'norm_ffn': 1.0 + nrm((DEPTH, D), 0.05),
        'hy_w_in': nrm((N_HYENA, D, 3 * D), D ** -0.5),
        'hy_b_in': nrm((N_HYENA, 3 * D), 0.02),
        'hy_conv_w': nrm((N_HYENA, SHORT_WIDTH, 3 * D), SHORT_WIDTH ** -0.5),
        'hy_conv_b': nrm((N_HYENA, 3 * D), 0.02),
        'hy_fw1': nrm((N_HYENA, FILTER_EMB, FILTER_HIDDEN), FILTER_EMB ** -0.5),
        'hy_fb1': nrm((N_HYENA, FILTER_HIDDEN), 0.1),
        'hy_ffreq': 1.0 + nrm((N_HYENA, 2, FILTER_HIDDEN), 0.05),
        'hy_fw2': nrm((N_HYENA, FILTER_HIDDEN, FILTER_HIDDEN), FILTER_HIDDEN ** -0.5),
        'hy_fb2': nrm((N_HYENA, FILTER_HIDDEN), 0.1),
        'hy_fw3': nrm((N_HYENA, FILTER_HIDDEN, HYENA_ORDER * N_DIRS * D), FILTER_HIDDEN ** -0.5),
        'hy_decay': decay_base + nrm((N_HYENA, HYENA_ORDER, N_DIRS, D), 0.1),
        'hy_skip': nrm((N_HYENA, HYENA_ORDER, D), 1.0),
        'hy_w_out': nrm((N_HYENA, D, D), D ** -0.5),
        'hy_b_out': nrm((N_HYENA, D), 0.02),
        'at_w_in': nrm((N_ATTN, D, N_GROUPS * 3 * GROUP_WIDTH), D ** -0.5),
        'at_w_out': nrm((N_ATTN, GROUP_WIDTH, D), GROUP_WIDTH ** -0.5),
        'ffn_w_gate': nrm((DEPTH, D, D_FF), D ** -0.5),
        'ffn_w_up': nrm((DEPTH, D, D_FF), D ** -0.5),
        'ffn_w_down': nrm((DEPTH, D_FF, D), D_FF ** -0.5),
        'final_norm': 1.0 + nrm((D,), 0.05),
        'final_ada_w': nrm((D, 2 * D), 0.5 * D ** -0.5),
        'final_ada_b': nrm((2 * D,), 0.02),
    }


def reference(x_prompt, x_sample, c_prompt, c_sample, ada_w, ada_b, norm_mix, norm_ffn,
              hy_w_in, hy_b_in, hy_conv_w, hy_conv_b, hy_fw1, hy_fb1, hy_ffreq, hy_fw2, hy_fb2,
              hy_fw3, hy_decay, hy_skip, hy_w_out, hy_b_out, at_w_in, at_w_out,
              ffn_w_gate, ffn_w_up, ffn_w_down, final_norm, final_ada_w, final_ada_b):
    params = dict(ada_w=ada_w, ada_b=ada_b, norm_mix=norm_mix, norm_ffn=norm_ffn,
                  hy_w_in=hy_w_in, hy_b_in=hy_b_in, hy_conv_w=hy_conv_w, hy_conv_b=hy_conv_b,
                  hy_fw1=hy_fw1, hy_fb1=hy_fb1, hy_ffreq=hy_ffreq, hy_fw2=hy_fw2, hy_fb2=hy_fb2,
                  hy_fw3=hy_fw3, hy_decay=hy_decay, hy_skip=hy_skip, hy_w_out=hy_w_out,
                  hy_b_out=hy_b_out, at_w_in=at_w_in, at_w_out=at_w_out,
                  ffn_w_gate=ffn_w_gate, ffn_w_up=ffn_w_up, ffn_w_down=ffn_w_down,
                  final_norm=final_norm, final_ada_w=final_ada_w, final_ada_b=final_ada_b)
    y_prompt = encoder(x_prompt, c_prompt, params)
    y_sample = encoder(x_sample, c_sample, params)
    return (y_prompt, y_sample)
```

```cpp
#include <hip/hip_runtime.h>
#include <cstdio>
#include <cstdint>
#ifndef MK_PER_PHASE
#define MK_PER_PHASE 1
#endif
namespace pg8 {
#define PG8_LAS __attribute__((address_space(3)))
__device__ __forceinline__ int otid() { int t = threadIdx.x; asm volatile("" : "+v"(t)); return t; }
__device__ __forceinline__ int obid() { int b = blockIdx.x; asm volatile("" : "+s"(b)); return b; }
__device__ __forceinline__ int ogrid() { int g = gridDim.x; asm volatile("" : "+s"(g)); return g; }
typedef unsigned short bf16_t;
typedef short bf16x8 __attribute__((ext_vector_type(8)));
typedef float f32x4 __attribute__((ext_vector_type(4)));
typedef unsigned u32x4 __attribute__((ext_vector_type(4)));
constexpr int BM = 256, BK = 64, HALF = 128, HTB = HALF * BK * 2  , STAGE_BYTES = 8 * HTB, NXCD = 8, WGM = 8;

__host__ __device__ __forceinline__ int lds_byte(int r, int c) { const int st = (r >> 4) * 2 + (c >> 5), rr = r & 15, cc = c & 31, ob = rr * 64 + cc * 2; return st * 1024 + (ob ^ (((ob >> 9) & 1) << 5)); }
__host__ __device__ __forceinline__ void stage_rc(int b, int& R, int& C) { const int st = b / 1024, sb = b % 1024, swz = sb ^ (((sb >> 9) & 1) << 5); R = (st >> 1) * 16 + swz / 64; C = (st & 1) * 32 + (swz % 64) / 2; }
__host__ __device__ __forceinline__ int perm32(int rho) { const int n = rho >> 4, i = rho & 15; return 8 * (i >> 2) + 4 * n + (i & 3); }

struct Unit { int pm, pn; };
struct Gemm { const bf16_t* A; const bf16_t* Bt; int M, N, K; };

struct StaticOrder {
    int nM, nN, nwg, G, c;
    __host__ __device__ void init(int M, int N, int G_, int c_) { nM = M / BM; nN = N / BM; nwg = nM * nN; G = G_; c = c_; }
    __host__ __device__ bool next(int i, Unit& u) const {
        const long L = (long)i * G + c; if (L >= nwg) return false;
        int wgid = (int)L; { const int q = nwg / NXCD, r = nwg % NXCD, xcd = wgid % NXCD, off = wgid / NXCD; wgid = (xcd < r ? xcd * (q + 1) : r * (q + 1) + (xcd - r) * q) + off; }
        const int nig = WGM * nN, gid = wgid / nig, fm = gid * WGM, gsz = (nM - fm) < WGM ? (nM - fm) : WGM;
        u.pm = fm + ((wgid % nig) % gsz); u.pn = (wgid % nig) / gsz; return true;
    }
    __device__ __forceinline__ void a_ready(const Unit&) const {}
    __device__ __forceinline__ void done(const Unit&) const {}
};
__device__ __forceinline__ unsigned cvt_pk_bf16(float lo, float hi) { unsigned r; asm volatile("v_cvt_pk_bf16_f32 %0, %1, %2" : "=v"(r) : "v"(lo), "v"(hi)); return r; }
template <class Epi, class Sched, bool STAMP = false>
__device__ __forceinline__ void gemm_phase(PG8_LAS unsigned char* lds, const Gemm g, const Sched& S, const Epi& E, unsigned long long* stamps) {
    const int tid = otid(), wid = __builtin_amdgcn_readfirstlane(tid >> 6), lane = tid & 63, wr = wid >> 2, wc = wid & 3, fr = lane & 15, fq = lane >> 4;
    const int K = g.K, nt = K / BK;
    int ts_lo = 0, ts_hi = 0, nts = 0; const unsigned long long rt_entry = STAMP ? (unsigned long long)wall_clock64() : 0ull;
#define PG8_STAMP() do { if (STAMP && wid == 0 && nts < 64) { const unsigned long long _c = (unsigned long long)clock64(); \
        ts_lo = (lane == nts) ? (int)(unsigned)_c : ts_lo; ts_hi = (lane == nts) ? (int)(unsigned)(_c >> 32) : ts_hi; ++nts; } } while (0)
    PG8_STAMP();
    unsigned voffA[2], voffB[2];
#pragma unroll
    for (int i = 0; i < 2; ++i) { int R, C; stage_rc(tid * 16 + i * 8192, R, C); const int Rb = Epi::PERM ? ((R & ~31) + perm32(R & 31)) : R;
        voffA[i] = (unsigned)(R * K + C) * 2u; voffB[i] = (unsigned)(Rb * K + C) * 2u; }
    const size_t kstep = (size_t)(BK * 2);
    const size_t hstep = (size_t)HALF * K * 2;
    const size_t tstep = 2 * hstep;
    const unsigned ldsw = (unsigned)wid * 1024u;
    const int aoff = lds_byte(wr * 64 + fr, fq * 8), boff = lds_byte(wc * 32 + fr, fq * 8);
#define PG8_SA(b, h) (((b) * 2 + (h)) * HTB)
#define PG8_SB(b, h) ((4 + (b) * 2 + (h)) * HTB)
#define PG8_STAGE(bufoff, gbase, voff) do { _Pragma("unroll") for (int _i = 0; _i < 2; ++_i) \
        __builtin_amdgcn_global_load_lds((const unsigned*)((const char*)(gbase) + (voff)[_i]), (PG8_LAS unsigned*)(lds + (bufoff) + ldsw + _i * 8192), 16, 0, 0); } while (0)
#define PG8_LDA(dst, b, h) do { _Pragma("unroll") for (int m = 0; m < 4; ++m) _Pragma("unroll") for (int k = 0; k < 2; ++k) dst[m][k] = *(const PG8_LAS bf16x8*)(lds + PG8_SA(b, h) + aoff + m * 2048 + k * 1024); } while (0)
#define PG8_LDB(dst, b, h) do { _Pragma("unroll") for (int n = 0; n < 2; ++n) _Pragma("unroll") for (int k = 0; k < 2; ++k) dst[n][k] = *(const PG8_LAS bf16x8*)(lds + PG8_SB(b, h) + boff + n * 2048 + k * 1024); } while (0)
#define PG8_MMA(ai, bj, At, Bt) do { __builtin_amdgcn_s_setprio(1); _Pragma("unroll") for (int m = 0; m < 4; ++m) _Pragma("unroll") for (int n = 0; n < 2; ++n) _Pragma("unroll") for (int k = 0; k < 2; ++k) \
        acc[ai][bj][m][n] = __builtin_amdgcn_mfma_f32_16x16x32_bf16(Bt[n][k], At[m][k], acc[ai][bj][m][n], 0, 0, 0); __builtin_amdgcn_s_setprio(0); } while (0)
#define PG8_WAIT_V(n) asm volatile("s_waitcnt vmcnt(" #n ")" ::: "memory")
#define PG8_WAIT_L(n) asm volatile("s_waitcnt lgkmcnt(" #n ")" ::: "memory")
#define PG8_BAR __builtin_amdgcn_s_barrier()
#define PG8_SCHED __builtin_amdgcn_sched_barrier(0)
    Unit cur, nxt; int ui = 0;
    if (!S.next(0, cur)) return;
    f32x4 acc[2][2][4][2];
#pragma unroll
    for (int a = 0; a < 2; ++a)
#pragma unroll
        for (int b = 0; b < 2; ++b)
#pragma unroll
            for (int m = 0; m < 4; ++m)
#pragma unroll
                for (int n = 0; n < 2; ++n) acc[a][b][m][n] = (f32x4){0.f, 0.f, 0.f, 0.f};
    bf16x8 At[4][2], B0[2][2], B1[2][2];
    const char* cA = (const char*)g.A + (size_t)cur.pm * tstep; const char* cB = (const char*)g.Bt + (size_t)cur.pn * tstep;
    S.a_ready(cur);
    PG8_STAGE(PG8_SB(0, 0), cB, voffB); PG8_STAGE(PG8_SA(0, 0), cA, voffA); PG8_STAGE(PG8_SB(0, 1), cB + hstep, voffB); PG8_STAGE(PG8_SA(0, 1), cA + hstep, voffA);
    if (wr == 1) PG8_BAR;
    PG8_WAIT_V(4); PG8_BAR;
    PG8_STAGE(PG8_SB(1, 0), cB + kstep, voffB); PG8_STAGE(PG8_SA(1, 0), cA + kstep, voffA); PG8_STAGE(PG8_SB(1, 1), cB + hstep + kstep, voffB);
    PG8_WAIT_V(6); PG8_BAR;
    PG8_STAMP();
    for (;;) {
        const bool has_next = S.next(ui + 1, nxt);
        const char* nA = has_next ? (const char*)g.A + (size_t)nxt.pm * tstep : cA; const char* nB = has_next ? (const char*)g.Bt + (size_t)nxt.pn * tstep : cB;
        for (int t = 0; t < nt; t += 2) {
            const bool last = (t == nt - 2);
            const char* a1 = cA + (size_t)(t + 1) * kstep;
            const char* a2 = last ? nA : cA + (size_t)(t + 2) * kstep; const char* b2 = last ? nB : cB + (size_t)(t + 2) * kstep;
            const char* a3 = a2 + kstep; const char* b3 = b2 + kstep;
            if (last && has_next) S.a_ready(nxt);
            PG8_LDB(B0, 0, 0); PG8_SCHED; PG8_LDA(At, 0, 0); PG8_STAGE(PG8_SA(1, 1), a1 + hstep, voffA);
            PG8_WAIT_L(8); PG8_BAR; PG8_WAIT_L(0); PG8_MMA(0, 0, At, B0); PG8_BAR; PG8_SCHED;
            PG8_LDB(B1, 0, 1); PG8_STAGE(PG8_SB(0, 0), b2, voffB);
            PG8_BAR; PG8_WAIT_L(0); PG8_MMA(0, 1, At, B1); PG8_BAR;
            PG8_LDA(At, 0, 1); PG8_STAGE(PG8_SA(0, 0), a2, voffA);
            PG8_BAR; PG8_WAIT_L(0); PG8_MMA(1, 0, At, B0); PG8_BAR; PG8_SCHED;
            PG8_STAGE(PG8_SB(0, 1), b2 + hstep, voffB);
            PG8_WAIT_V(6); PG8_BAR; PG8_MMA(1, 1, At, B1); PG8_BAR;
            PG8_LDB(B0, 1, 0); PG8_SCHED; PG8_LDA(At, 1, 0); PG8_STAGE(PG8_SA(0, 1), a2 + hstep, voffA);
            PG8_WAIT_L(8); PG8_BAR; PG8_WAIT_L(0); PG8_MMA(0, 0, At, B0); PG8_BAR; PG8_SCHED;
            PG8_LDB(B1, 1, 1); PG8_STAGE(PG8_SB(1, 0), b3, voffB);
            PG8_BAR; PG8_WAIT_L(0); PG8_MMA(0, 1, At, B1); PG8_BAR;
            PG8_LDA(At, 1, 1); PG8_STAGE(PG8_SA(1, 0), a3, voffA);
            PG8_BAR; PG8_WAIT_L(0); PG8_MMA(1, 0, At, B0); PG8_BAR; PG8_SCHED;
            PG8_STAGE(PG8_SB(1, 1), b3 + hstep, voffB);
            PG8_WAIT_V(6); PG8_BAR; PG8_MMA(1, 1, At, B1); PG8_BAR;
        }
        PG8_STAMP();
        if constexpr (!Epi::AFTER_DRAIN) { E(acc, cur, wr, wc, fr, fq); S.done(cur); }
        PG8_STAMP();
        if (!has_next) break;
#pragma unroll
        for (int a = 0; a < 2; ++a)
#pragma unroll
            for (int b = 0; b < 2; ++b)
#pragma unroll
                for (int m = 0; m < 4; ++m)
#pragma unroll
                    for (int n = 0; n < 2; ++n) acc[a][b][m][n] = (f32x4){0.f, 0.f, 0.f, 0.f};
        cur = nxt; cA = nA; cB = nB; ++ui;
    }
    PG8_WAIT_V(0);
    if (wr == 0) PG8_BAR;
    PG8_BAR;
    if constexpr (Epi::AFTER_DRAIN) { E.fused(acc, cur, wr, wc, fr, fq, lds, wid, lane); S.done(cur); }
    PG8_STAMP();
    if (STAMP && wid == 0) { stamps[lane] = lane < nts ? (((unsigned long long)(unsigned)ts_hi << 32) | (unsigned)ts_lo) : 0ull;
        if (lane == 62) stamps[62] = rt_entry; if (lane == 63) stamps[63] = (unsigned long long)wall_clock64(); }
#undef PG8_STAMP
#undef PG8_SA
#undef PG8_SB
#undef PG8_STAGE
#undef PG8_LDA
#undef PG8_LDB
#undef PG8_MMA
#undef PG8_WAIT_V
#undef PG8_WAIT_L
#undef PG8_BAR
#undef PG8_SCHED
}
}
#define XB_TMO      128
#define XB_XCNT(j)  (256  + 64 * (j))
#define XB_XSUB(j)  (1280 + 64 * (j))
#define XB_XGEN(j)  (2304 + 64 * (j))
#define XB_TOP      3328
#define XB_TOPGEN   3392
#define XCD_BAR_WORDS 3456
#define XB_SPIN_CAP (1u << 18)
#define LAS __attribute__((address_space(3)))

__device__ __forceinline__ unsigned xb_ld(unsigned* p)              { return __hip_atomic_load(p, __ATOMIC_RELAXED, __HIP_MEMORY_SCOPE_AGENT); }
__device__ __forceinline__ unsigned xb_add(unsigned* p, unsigned v) { return __hip_atomic_fetch_add(p, v, __ATOMIC_RELAXED, __HIP_MEMORY_SCOPE_AGENT); }
__device__ __forceinline__ unsigned xb_xcc_id() { return (unsigned)__builtin_amdgcn_s_getreg((3 << 11) | 20) & 0xFu; }
#define XB_SPIN(cond, bar) do { unsigned _sp = 0; while (cond) { __builtin_amdgcn_s_sleep(1); \
    if ((++_sp & 255u) == 0u) { if (xb_ld(&(bar)[XB_TMO])) break; if (_sp > XB_SPIN_CAP) { atomicAdd(&(bar)[XB_TMO], 1u); break; } } } } while (0)

struct XcdBarrier {
    unsigned* bar; unsigned x;
    volatile LAS unsigned* st;
};

__device__ __forceinline__ XcdBarrier xcd_barrier_post(unsigned* bar, volatile LAS unsigned* st) {
    XcdBarrier b; b.bar = bar; b.x = xb_xcc_id(); b.st = st;
    if (threadIdx.x == 0) (void)xb_add(&bar[XB_XCNT(b.x)], 1u);
    return b;
}
__device__ __forceinline__ void xcd_barrier_complete(unsigned* bar, unsigned x, unsigned& nloc, unsigned& nx) {
    const unsigned G = gridDim.x * gridDim.y * gridDim.z;
    unsigned sum, cnt, mine, sp = 0u;
    for (;;) {
        sum = 0u; cnt = 0u; mine = 0u;
#pragma unroll
        for (unsigned j = 0; j < 16; ++j) { const unsigned c = xb_ld(&bar[XB_XCNT(j)]); sum += c; cnt += (c > 0u) ? 1u : 0u; mine = (j == x) ? c : mine; }
        if (sum == G) break;
        __builtin_amdgcn_s_sleep(1);
        if ((++sp & 255u) == 0u) { if (xb_ld(&bar[XB_TMO])) break; if (sp > XB_SPIN_CAP) { atomicAdd(&bar[XB_TMO], 1u); break; } }
    }
    nloc = mine > 0u ? mine : 1u; nx = cnt > 0u ? cnt : 1u;
}

__device__ __forceinline__ void xcd_barrier(const XcdBarrier& b) {
    asm volatile("s_waitcnt vmcnt(0)" ::: "memory");
    __syncthreads();
    if (threadIdx.x == 0) {
        unsigned* bar = b.bar;
        __builtin_amdgcn_s_waitcnt(0);
        unsigned nloc = b.st[0], nx = b.st[1];
        if (nloc == 0u) { xcd_barrier_complete(bar, b.x, nloc, nx); b.st[0] = nloc; b.st[1] = nx; }
        const unsigned old = xb_add(&bar[XB_XSUB(b.x)], 1u);
        const unsigned gen = old / nloc;
        if (old + 1u == (gen + 1u) * nloc) {
            __builtin_amdgcn_fence(__ATOMIC_RELEASE, "agent");
            asm volatile("s_waitcnt vmcnt(0)" ::: "memory");
            const unsigned og = xb_add(&bar[XB_TOP], 1u);
            const unsigned tg = og / nx;
            if (og + 1u == (tg + 1u) * nx) xb_add(&bar[XB_TOPGEN], 1u);
            else XB_SPIN(xb_ld(&bar[XB_TOPGEN]) == tg, bar);
            __builtin_amdgcn_fence(__ATOMIC_ACQUIRE, "agent");
            xb_add(&bar[XB_XGEN(b.x)], 1u);
            asm volatile("s_waitcnt vmcnt(0)" ::: "memory");
        } else {
            XB_SPIN(xb_ld(&bar[XB_XGEN(b.x)]) == gen, bar);
            __builtin_amdgcn_fence(__ATOMIC_ACQUIRE, "agent");
            asm volatile("s_waitcnt vmcnt(0)" ::: "memory");
        }
    }
    __syncthreads();
}


namespace mk {
using pg8::bf16_t; using pg8::bf16x8; using pg8::f32x4; using pg8::u32x4; using pg8::Unit; using pg8::cvt_pk_bf16;
typedef unsigned u32x2 __attribute__((ext_vector_type(2)));
typedef float cpx __attribute__((ext_vector_type(2)));
__host__ __device__ __forceinline__ cpx mkc(float a, float b) { cpx r; r.x = a; r.y = b; return r; }

constexpr int D = 2048, T_P = 32768, T_S = 8192, T = 40960, L_P = 16384, L_S = 2048, DFF = 5632;
constexpr int NTHR = 512;
constexpr int MODW = 53248;
constexpr int NPOS = 18432;
constexpr int QKVW = 9216;
constexpr float EPS = 1e-6f;
constexpr float QSCALE = 0.12751743082459868f;
constexpr int LDS_BYTES = 147456;
constexpr int LDS_MISC = 147456 - 256;

constexpr size_t al256(size_t x) { return (x + 255) & ~(size_t)255; }
constexpr size_t WS_CTL  = 0;
constexpr size_t CTL_BYTES = 65536;
constexpr size_t WS_PART = WS_CTL + CTL_BYTES;
constexpr size_t WS_MOD  = WS_PART + al256((size_t)8 * 6 * MODW * 4);
constexpr size_t WS_ROPE = WS_MOD + al256((size_t)6 * MODW * 4);
constexpr size_t WS_A2X  = WS_ROPE + (size_t)16384 * 16 * 8;
constexpr size_t WS_W3X  = WS_A2X + (size_t)2 * NPOS * 256 * 2;
constexpr size_t WS_WL   = WS_W3X + (size_t)2 * 8192 * 256 * 2;
constexpr size_t WL_FFN1 = 0;
constexpr size_t WL_FFN2 = WL_FFN1 + (size_t)11264 * 2048 * 2;
constexpr size_t WL_MIXIN = WL_FFN2 + (size_t)2048 * 5632 * 2;
constexpr size_t WL_MIXOUT = WL_MIXIN + (size_t)9216 * 2048 * 2;
constexpr size_t WL_BYTES = WL_MIXOUT + (size_t)2048 * 2048 * 2;
constexpr size_t WS_H    = WS_WL + WL_BYTES;
constexpr size_t H_BYTES = (size_t)T * 2048 * 2;
constexpr size_t WS_BIG  = WS_H + H_BYTES;
constexpr size_t BIG_ZINT = 0;
constexpr size_t BIG_TAPS = BIG_ZINT + (size_t)6144 * T * 2;
constexpr size_t BIG_HY_END = BIG_TAPS + (size_t)8192 * NPOS * 4;
constexpr size_t BIG_QKV = 0;
constexpr size_t BIG_OG  = BIG_QKV + (size_t)T * QKVW * 2;
constexpr size_t BIG_LSE = BIG_OG + (size_t)3 * T * 1024 * 2;
constexpr size_t BIG_AT_END = BIG_LSE + (size_t)3 * T * 8 * 4;
constexpr size_t BIG_MID = 0;
constexpr size_t BIG_BYTES = BIG_HY_END > BIG_AT_END ? BIG_HY_END : BIG_AT_END;
constexpr size_t WS_END  = WS_BIG + BIG_BYTES;
constexpr size_t FFT_SCR_PER_WG = 5 * 131072;
constexpr size_t WS_TOTAL = WS_END + (size_t)256 * 131072;
static_assert(256 * FFT_SCR_PER_WG <= H_BYTES, "fft scratch must fit in H");

struct Params {
    const float *x_prompt, *x_sample, *c_prompt, *c_sample, *ada_w, *ada_b, *norm_mix, *norm_ffn;
    const float *hy_w_in, *hy_b_in, *hy_conv_w, *hy_conv_b, *hy_fw1, *hy_fb1, *hy_ffreq, *hy_fw2, *hy_fb2, *hy_fw3, *hy_decay, *hy_skip, *hy_w_out, *hy_b_out;
    const float *at_w_in, *at_w_out, *ffn_w_gate, *ffn_w_up, *ffn_w_down, *final_norm, *final_ada_w, *final_ada_b;
    float* out; unsigned char* ws; int ph_lo, ph_hi;
};

#define LDSQ __attribute__((address_space(3)))

__device__ __forceinline__ float bf2f(bf16_t b) { return __uint_as_float(((unsigned)b) << 16); }
__device__ __forceinline__ bf16_t f2bf(float f) { unsigned u = __float_as_uint(f); u += 0x7FFFu + ((u >> 16) & 1u); return (bf16_t)(u >> 16); }
__device__ __forceinline__ int seq_of_row(int row) { return row < T_P ? (row >> 14) : 2 + ((row - T_P) >> 11); }
__device__ __forceinline__ int pos_of_row(int row) { return row < T_P ? (row & 16383) : (row & 2047); }
__device__ __forceinline__ float wave_sum(float v) {
#pragma unroll
    for (int o = 32; o >= 1; o >>= 1) v += __shfl_xor(v, o);
    return v;
}

struct EpiZinT {
    static constexpr bool PERM = true, AFTER_DRAIN = false;
    bf16_t* O; int ldc; const float* bias;
    __device__ __forceinline__ void operator()(const f32x4 (&acc)[2][2][4][2], const Unit& u, int wr, int wc, int fr, int fq) const {
        const int row0 = u.pm * 256 + wr * 64 + fr, col0 = u.pn * 256 + wc * 32 + 8 * fq;
#pragma unroll
        for (int ai = 0; ai < 2; ++ai)
#pragma unroll
            for (int m = 0; m < 4; ++m) { const int r = row0 + ai * 128 + m * 16; const float b = bias[r]; bf16_t* rowp = O + (size_t)r * ldc + col0;
#pragma unroll
                for (int bj = 0; bj < 2; ++bj) { const f32x4 v0 = acc[ai][bj][m][0] + b, v1 = acc[ai][bj][m][1] + b;
                    u32x4 w; w.x = cvt_pk_bf16(v0[0], v0[1]); w.y = cvt_pk_bf16(v0[2], v0[3]); w.z = cvt_pk_bf16(v1[0], v1[1]); w.w = cvt_pk_bf16(v1[2], v1[3]);
                    *(u32x4*)(rowp + bj * 128) = w; } }
    }
};
struct EpiRes {
    static constexpr bool PERM = false, AFTER_DRAIN = false;
    float* X; const float* bias; const float* gate;
    __device__ __forceinline__ void operator()(const f32x4 (&acc)[2][2][4][2], const Unit& u, int wr, int wc, int fr, int fq) const {
        const int row0 = u.pm * 256 + wr * 64 + fr, col0 = u.pn * 256 + wc * 32 + 4 * fq;
        const float* gp = gate + (size_t)seq_of_row(u.pm * 256) * MODW + col0;
        f32x4 gv[2][2], bv[2][2];
#pragma unroll
        for (int bj = 0; bj < 2; ++bj)
#pragma unroll
            for (int n = 0; n < 2; ++n) { gv[bj][n] = *(const f32x4*)(gp + bj * 128 + n * 16); bv[bj][n] = bias ? *(const f32x4*)(bias + col0 + bj * 128 + n * 16) : (f32x4){0.f, 0.f, 0.f, 0.f}; }
#pragma unroll
        for (int ai = 0; ai < 2; ++ai)
#pragma unroll
            for (int m = 0; m < 4; ++m) { float* rowp = X + (size_t)(row0 + ai * 128 + m * 16) * 2048 + col0;
#pragma unroll
                for (int bj = 0; bj < 2; ++bj)
#pragma unroll
                    for (int n = 0; n < 2; ++n) { float* pp = rowp + bj * 128 + n * 16; f32x4 x = *(const f32x4*)pp; x += gv[bj][n] * (acc[ai][bj][m][n] + bv[bj][n]); *(f32x4*)pp = x; } }
    }
};
struct EpiQKV {
    static constexpr bool PERM = true, AFTER_DRAIN = false;
    bf16_t* O; const cpx* rope;
    __device__ __forceinline__ void operator()(const f32x4 (&acc)[2][2][4][2], const Unit& u, int wr, int wc, int fr, int fq) const {
        const int row0 = u.pm * 256 + wr * 64 + fr, colt = u.pn * 256, col0 = colt + wc * 32 + 8 * fq;
        const int sidx = (colt % 3072) >> 10;
        const bool dorope = (sidx < 2) && (wc == 0);
        const float qs = (sidx == 0) ? QSCALE : 1.0f;
#pragma unroll
        for (int ai = 0; ai < 2; ++ai)
#pragma unroll
            for (int m = 0; m < 4; ++m) { const int r = row0 + ai * 128 + m * 16; bf16_t* rowp = O + (size_t)r * QKVW + col0;
                f32x4 c0, c1, s0, s1;
                if (dorope) { const cpx* rp = rope + (size_t)pos_of_row(r) * 16 + 8 * (fq & 1);
                    const f32x4 t0 = *(const f32x4*)(rp), t1 = *(const f32x4*)(rp + 2), t2 = *(const f32x4*)(rp + 4), t3 = *(const f32x4*)(rp + 6);
                    c0 = (f32x4){t0[0], t0[2], t1[0], t1[2]}; s0 = (f32x4){t0[1], t0[3], t1[1], t1[3]};
                    c1 = (f32x4){t2[0], t2[2], t3[0], t3[2]}; s1 = (f32x4){t2[1], t2[3], t3[1], t3[3]}; }
#pragma unroll
                for (int bj = 0; bj < 2; ++bj) { f32x4 v0 = acc[ai][bj][m][0], v1 = acc[ai][bj][m][1];
                    if (dorope) { f32x4 p0, p1;
#pragma unroll
                        for (int e = 0; e < 4; ++e) { p0[e] = __shfl_xor(v0[e], 32); p1[e] = __shfl_xor(v1[e], 32); }
                        if (fq < 2) { v0 = v0 * c0 - p0 * s0; v1 = v1 * c1 - p1 * s1; }
                        else        { v0 = v0 * c0 + p0 * s0; v1 = v1 * c1 + p1 * s1; } }
                    v0 *= qs; v1 *= qs;
                    u32x4 w; w.x = cvt_pk_bf16(v0[0], v0[1]); w.y = cvt_pk_bf16(v0[2], v0[3]); w.z = cvt_pk_bf16(v1[0], v1[1]); w.w = cvt_pk_bf16(v1[2], v1[3]);
                    *(u32x4*)(rowp + bj * 128) = w; } }
    }
};
struct EpiFFN1 {
    static constexpr bool PERM = true, AFTER_DRAIN = false;
    bf16_t* O;
    __device__ __forceinline__ void operator()(const f32x4 (&acc)[2][2][4][2], const Unit& u, int wr, int wc, int fr, int fq) const {
        const int row0 = u.pm * 256 + wr * 64 + fr, col0 = u.pn * 128 + wc * 32 + 8 * fq;
#pragma unroll
        for (int ai = 0; ai < 2; ++ai)
#pragma unroll
            for (int m = 0; m < 4; ++m) { bf16_t* rowp = O + (size_t)(row0 + ai * 128 + m * 16) * DFF + col0; float o[8];
#pragma unroll
                for (int n = 0; n < 2; ++n)
#pragma unroll
                    for (int e = 0; e < 4; ++e) { const float g = acc[ai][0][m][n][e], up = acc[ai][1][m][n][e]; o[n * 4 + e] = g * __builtin_amdgcn_rcpf(1.0f + __expf(-g)) * up; }
                u32x4 w; w.x = cvt_pk_bf16(o[0], o[1]); w.y = cvt_pk_bf16(o[2], o[3]); w.z = cvt_pk_bf16(o[4], o[5]); w.w = cvt_pk_bf16(o[6], o[7]);
                *(u32x4*)rowp = w; }
    }
};
struct EpiTaps {
    static constexpr bool PERM = false, AFTER_DRAIN = false;
    float* O;
    __device__ __forceinline__ void operator()(const f32x4 (&acc)[2][2][4][2], const Unit& u, int wr, int wc, int fr, int fq) const {
        const int row0 = u.pm * 256 + wr * 64 + fr, col0 = u.pn * 256 + wc * 32 + 4 * fq;
#pragma unroll
        for (int ai = 0; ai < 2; ++ai)
#pragma unroll
            for (int m = 0; m < 4; ++m) { float* rowp = O + (size_t)(row0 + ai * 128 + m * 16) * NPOS + col0;
#pragma unroll
                for (int bj = 0; bj < 2; ++bj)
#pragma unroll
                    for (int n = 0; n < 2; ++n) *(f32x4*)(rowp + bj * 128 + n * 16) = acc[ai][bj][m][n]; }
    }
};

__device__ __forceinline__ void ada_partials(const Params& p, LDSQ unsigned char* lds) {
    LDSQ float* cs = (LDSQ float*)lds;
    for (int i = pg8::otid(); i < 6 * 2048; i += NTHR) { const int b = i >> 11, k = i & 2047; const float c = b < 2 ? p.c_prompt[b * 2048 + k] : p.c_sample[(b - 2) * 2048 + k]; cs[i] = c / (1.0f + expf(-c)); }
    __syncthreads();
    float* part = (float*)(p.ws + WS_PART);
    for (int item = pg8::obid() * NTHR + pg8::otid(); item < 8 * 13312; item += pg8::ogrid() * NTHR) {
        const int chunk = item / 13312, c4 = item % 13312;
        const float* W; int ldw;
        if (c4 < 12288) { const int layer = c4 / 3072, col = (c4 % 3072) * 4; W = p.ada_w + (size_t)layer * 2048 * 12288 + col; ldw = 12288; }
        else { W = p.final_ada_w + (c4 - 12288) * 4; ldw = 4096; }
        f32x4 a0 = {0.f, 0.f, 0.f, 0.f}, a1 = a0, a2 = a0, a3 = a0, a4 = a0, a5 = a0;
        const int k0 = chunk * 256;
#pragma unroll 8
        for (int k = k0; k < k0 + 256; ++k) { const f32x4 w = *(const f32x4*)(W + (size_t)k * ldw);
            a0 += cs[k] * w; a1 += cs[2048 + k] * w; a2 += cs[4096 + k] * w; a3 += cs[6144 + k] * w; a4 += cs[8192 + k] * w; a5 += cs[10240 + k] * w; }
        float* o = part + (size_t)chunk * 6 * MODW + (size_t)c4 * 4;
        *(f32x4*)(o) = a0; *(f32x4*)(o + MODW) = a1; *(f32x4*)(o + 2 * MODW) = a2; *(f32x4*)(o + 3 * MODW) = a3; *(f32x4*)(o + 4 * MODW) = a4; *(f32x4*)(o + 5 * MODW) = a5;
    }
    __syncthreads();
}
__device__ __forceinline__ void ada_reduce(const Params& p) {
    const float* part = (const float*)(p.ws + WS_PART); float* mod = (float*)(p.ws + WS_MOD);
    for (int i = pg8::obid() * NTHR + pg8::otid(); i < 6 * MODW; i += pg8::ogrid() * NTHR) {
        const int c = i % MODW; float s = c < 49152 ? p.ada_b[c] : p.final_ada_b[c - 49152];
#pragma unroll
        for (int ch = 0; ch < 8; ++ch) s += part[(size_t)ch * 6 * MODW + i];
        mod[i] = s;
    }
}
__device__ __forceinline__ void rope_table(const Params& p) {
    cpx* rope = (cpx*)(p.ws + WS_ROPE);
    for (int i = pg8::obid() * NTHR + pg8::otid(); i < 16384 * 16; i += pg8::ogrid() * NTHR) {
        const int pos = i >> 4, f = i & 15; const float inv = powf(500000.0f, -(float)f / 16.0f); const float ang = (float)pos * inv;
        float s, c; sincosf(ang, &s, &c); rope[i] = mkc(c, s);
    }
}
__device__ __forceinline__ void filter_mlp(const Params& p) {
    const int lane = pg8::otid() & 63, gw = pg8::obid() * 8 + (pg8::otid() >> 6);
    bf16_t* a2x = (bf16_t*)(p.ws + WS_A2X);
    for (int q = gw; q < 2 * NPOS; q += pg8::ogrid() * 8) {
        const int j = q / NPOS, r = q % NPOS; const int L = r < 16384 ? 16384 : 2048, pos = r < 16384 ? r : r - 16384;
        const float fpos = (float)pos;
        float z = 0.f;
        if (lane == 0) z = fpos / (float)(L - 1);
        else if (lane <= 32) { const int bi = (lane - 1) & 15; const float band = 1e-4f + (float)bi * ((15.0f - 1e-4f) / 15.0f);
            const float ang = ((6.283185307179586f * fpos) * band) / (float)L; z = lane <= 16 ? cosf(ang) : -sinf(ang); }
        const float* w1 = p.hy_fw1 + j * 33 * 64; const float* w2 = p.hy_fw2 + j * 64 * 64;
        float acc = p.hy_fb1[j * 64 + lane];
#pragma unroll
        for (int m = 0; m < 33; ++m) acc += __shfl(z, m) * w1[m * 64 + lane];
        const float a1 = sinf(p.hy_ffreq[j * 128 + lane] * acc);
        acc = p.hy_fb2[j * 64 + lane];
#pragma unroll
        for (int m = 0; m < 64; ++m) acc += __shfl(a1, m) * w2[m * 64 + lane];
        const float a2 = sinf(p.hy_ffreq[j * 128 + 64 + lane] * acc);
        const bf16_t hi = f2bf(a2), lo = f2bf(a2 - bf2f(hi));
        bf16_t* o = a2x + ((size_t)j * NPOS + r) * 256;
        o[lane] = hi; o[64 + lane] = hi; o[128 + lane] = lo; o[192 + lane] = 0;
    }
    bf16_t* w3x = (bf16_t*)(p.ws + WS_W3X);
    for (int i = pg8::obid() * NTHR + pg8::otid(); i < 2 * 8192 * 64; i += pg8::ogrid() * NTHR) {
        const int k = i & 63, col = (i >> 6) & 8191, j = i >> 19;
        const float v = p.hy_fw3[(size_t)j * 64 * 8192 + (size_t)k * 8192 + col];
        const bf16_t hi = f2bf(v), lo = f2bf(v - bf2f(hi));
        bf16_t* o = w3x + ((size_t)j * 8192 + col) * 256;
        o[k] = hi; o[64 + k] = lo; o[128 + k] = hi; o[192 + k] = 0;
    }
}
__device__ __forceinline__ void convert_T(LDSQ unsigned char* lds, const float* src, int K, int N, bf16_t* dst, int ffs) {
    LDSQ float* tile = (LDSQ float*)lds;
    const int tid = pg8::otid(), ntn = N >> 6, ntiles = (K >> 6) * ntn;
    for (int ti = pg8::obid(); ti < ntiles; ti += pg8::ogrid()) {
        const int tk = ti / ntn, tn = ti % ntn;
        { const int r = tid >> 4, c4 = tid & 15;
#pragma unroll
          for (int it = 0; it < 2; ++it) { const f32x4 v = *(const f32x4*)(src + (size_t)(tk * 64 + r + 32 * it) * N + tn * 64 + 4 * c4);
              LDSQ float* tp = tile + (r + 32 * it) * 65 + 4 * c4; tp[0] = v[0]; tp[1] = v[1]; tp[2] = v[2]; tp[3] = v[3]; } }
        __syncthreads();
        { const int n = tid >> 3, kq = tid & 7; float f[8];
#pragma unroll
          for (int e = 0; e < 8; ++e) f[e] = tile[(kq * 8 + e) * 65 + n];
          const int nn = tn * 64 + n; const int row = ffs < 0 ? nn : (256 * (nn >> 7) + 128 * ffs + (nn & 127));
          u32x4 w; w.x = cvt_pk_bf16(f[0], f[1]); w.y = cvt_pk_bf16(f[2], f[3]); w.z = cvt_pk_bf16(f[4], f[5]); w.w = cvt_pk_bf16(f[6], f[7]);
          *(u32x4*)(dst + (size_t)row * K + tk * 64 + kq * 8) = w; }
        __syncthreads();
    }
}
__device__ __forceinline__ void norm_mod(const float* xp, const float* xs, float* xcopy, const float* g, const float* modl, int sh_off, int sc_off, bf16_t* H) {
    const int lane = pg8::otid() & 63, gw = pg8::obid() * 8 + (pg8::otid() >> 6);
    for (int row = gw; row < T; row += pg8::ogrid() * 8) {
        const f32x4* src = (const f32x4*)(row < T_P ? xp + (size_t)row * 2048 : xs + (size_t)(row - T_P) * 2048);
        f32x4 v[8]; float ss = 0.f;
#pragma unroll
        for (int i = 0; i < 8; ++i) { v[i] = src[lane + 64 * i]; ss += v[i][0] * v[i][0] + v[i][1] * v[i][1] + v[i][2] * v[i][2] + v[i][3] * v[i][3]; }
        ss = wave_sum(ss);
        const float rstd = 1.0f / sqrtf(ss * (1.0f / 2048.0f) + EPS);
        const float* mod = modl + (size_t)seq_of_row(row) * MODW;
#pragma unroll
        for (int i = 0; i < 8; ++i) { const int col = (lane + 64 * i) * 4;
            const f32x4 gg = *(const f32x4*)(g + col), sc = *(const f32x4*)(mod + sc_off + col), sh = *(const f32x4*)(mod + sh_off + col);
            const f32x4 h = (v[i] * rstd * gg) * (1.0f + sc) + sh;
            u32x2 w; w.x = cvt_pk_bf16(h[0], h[1]); w.y = cvt_pk_bf16(h[2], h[3]);
            *(u32x2*)(H + (size_t)row * 2048 + col) = w;
            if (xcopy) *(f32x4*)(xcopy + (size_t)row * 2048 + col) = v[i]; }
    }
}
__device__ __forceinline__ void final_norm_phase(const Params& p) {
    const int lane = pg8::otid() & 63, gw = pg8::obid() * 8 + (pg8::otid() >> 6);
    const float* modf = (const float*)(p.ws + WS_MOD) + 49152;
    for (int row = gw; row < T; row += pg8::ogrid() * 8) {
        f32x4* src = (f32x4*)(p.out + (size_t)row * 2048);
        f32x4 v[8]; float ss = 0.f;
#pragma unroll
        for (int i = 0; i < 8; ++i) { v[i] = src[lane + 64 * i]; ss += v[i][0] * v[i][0] + v[i][1] * v[i][1] + v[i][2] * v[i][2] + v[i][3] * v[i][3]; }
        ss = wave_sum(ss);
        const float rstd = 1.0f / sqrtf(ss * (1.0f / 2048.0f) + EPS);
        const float* mod = modf + (size_t)seq_of_row(row) * MODW;
#pragma unroll
        for (int i = 0; i < 8; ++i) { const int col = (lane + 64 * i) * 4;
            const f32x4 gg = *(const f32x4*)(p.final_norm + col), sh = *(const f32x4*)(mod + col), sc = *(const f32x4*)(mod + 2048 + col);
            src[lane + 64 * i] = (v[i] * rstd * gg) * (1.0f + sc) + sh; }
    }
}
__device__ __forceinline__ void transpose_phase(const Params& p, LDSQ unsigned char* lds) {
    LDSQ bf16_t* tile = (LDSQ bf16_t*)lds;
    const bf16_t* zin = (const bf16_t*)(p.ws + WS_BIG + BIG_ZINT); bf16_t* H = (bf16_t*)(p.ws + WS_H);
    const int tid = pg8::otid();
    for (int ti = pg8::obid(); ti < 32 * 640; ti += pg8::ogrid()) {
        const int tc = ti / 640, tt = ti % 640;
        { const int cr = tid >> 3, tq = tid & 7; const u32x4 v = *(const u32x4*)(zin + (size_t)(tc * 64 + cr) * T + tt * 64 + tq * 8);
          *(LDSQ u32x4*)(tile + cr * 72 + tq * 8) = v; }
        __syncthreads();
        { const int tok = tid >> 3, cq = tid & 7; unsigned w[4];
#pragma unroll
          for (int e = 0; e < 4; ++e) { const unsigned lo = tile[(cq * 8 + 2 * e) * 72 + tok], hi = tile[(cq * 8 + 2 * e + 1) * 72 + tok]; w[e] = lo | (hi << 16); }
          *(u32x4*)(H + (size_t)(tt * 64 + tok) * 2048 + tc * 64 + cq * 8) = (u32x4){w[0], w[1], w[2], w[3]}; }
        __syncthreads();
    }
}

__host__ __device__ constexpr float cos64q(int k) {
    constexpr float t[17] = {1.0f, 0.99518472667219693f, 0.98078528040323043f, 0.95694033573220882f, 0.92387953251128674f, 0.88192126434835505f, 0.83146961230254524f,
        0.77301045336273699f, 0.70710678118654757f, 0.63439328416364549f, 0.55557023301960229f, 0.47139673682599781f, 0.38268343236508984f, 0.29028467725446233f,
        0.19509032201612833f, 0.09801714032956077f, 0.0f};
    return t[k];
}
__host__ __device__ constexpr float cos64(int k) { k &= 63; return k <= 16 ? cos64q(k) : k <= 32 ? -cos64q(32 - k) : k <= 48 ? -cos64q(k - 32) : cos64q(64 - k); }
__host__ __device__ constexpr float sin64(int k) { return cos64((k + 48) & 63); }
template <int R> __host__ __device__ constexpr int brev(int k) { int r = 0; for (int b = 1; b < R; b <<= 1) { r = (r << 1) | (k & 1); k >>= 1; } return r; }

__device__ __forceinline__ cpx cmul(cpx a, cpx b) { return mkc(a.x * b.x - a.y * b.y, a.x * b.y + a.y * b.x); }
__device__ __forceinline__ cpx cmulc(cpx a, cpx b) { return mkc(a.x * b.x + a.y * b.y, a.y * b.x - a.x * b.y); }

template <int R, bool INV> __device__ __forceinline__ void dft_r2(cpx (&v)[R]) {
#pragma unroll
    for (int h = R / 2; h >= 1; h >>= 1) {
#pragma unroll
        for (int b = 0; b < R; b += 2 * h) {
#pragma unroll
            for (int i = 0; i < h; ++i) {
                const cpx u = v[b + i], w = v[b + i + h];
                v[b + i] = mkc(u.x + w.x, u.y + w.y);
                const float dx = u.x - w.x, dy = u.y - w.y;
                const int e = i * (32 / h);
                const float c = cos64(e), s = INV ? sin64(e) : -sin64(e);
                v[b + i + h] = mkc(dx * c - dy * s, dx * s + dy * c);
            }
        }
    }
}


template <int R, bool CONJ, bool BREV> __device__ __forceinline__ void apply_pows(cpx (&v)[R], cpx w) {
    cpx pw = w;
#pragma unroll
    for (int k = 1; k < R; ++k) { const int idx = BREV ? brev<R>(k) : k; v[idx] = CONJ ? cmulc(v[idx], pw) : cmul(v[idx], pw); if (k + 1 < R) pw = cmul(pw, w); }
}
__device__ __forceinline__ int phys(int i) { return i + (i >> 5); }
constexpr int TW_OFF = 135168 + 64;
template <int R, int S, bool INV> __device__ __forceinline__ void fft_pass(LDSQ cpx* A, int t) {
    constexpr int G = 32 / R;
    asm volatile("" : "+v"(t));
    const LDSQ cpx* TW = (const LDSQ cpx*)((LDSQ unsigned char*)A + TW_OFF);
#pragma unroll 1
    for (int gi = 0; gi < G; ++gi) {
        const int gam = gi * 512 + t, hi = gam / S, lo = gam % S, base = hi * (R * S) + lo;
        cpx v[R];
#pragma unroll
        for (int j = 0; j < R; ++j) v[j] = A[phys(base + j * S)];
        const cpx tw = TW[lo * (16384 / (R * S))]; const float cs = tw.x, sn = tw.y;
        if (!INV) {
            dft_r2<R, false>(v);
            apply_pows<R, false, true>(v, mkc(cs, sn));
#pragma unroll
            for (int k = 0; k < R; ++k) A[phys(base + k * S)] = v[brev<R>(k)];
        } else {
            apply_pows<R, true, false>(v, mkc(cs, sn));
            dft_r2<R, true>(v);
#pragma unroll
            for (int j = 0; j < R; ++j) A[phys(base + j * S)] = v[brev<R>(j)];
        }
    }
}
template <int R, int MODE> __device__ __forceinline__ void fft_mid(LDSQ cpx* A, int t, cpx* spec, float scale) {
    constexpr int G = 32 / R;
    asm volatile("" : "+v"(t));
#pragma unroll 1
    for (int gi = 0; gi < G; ++gi) {
        const int gam = gi * 512 + t, base = gam * R;
        cpx v[R];
#pragma unroll
        for (int j = 0; j < R; ++j) v[j] = A[phys(base + j)];
        dft_r2<R, false>(v);
        if (MODE == 0) {
#pragma unroll
            for (int k = 0; k < R; ++k) { const cpx x = v[brev<R>(k)]; spec[(size_t)base + k] = mkc(x.x * scale, x.y * scale); }
        } else {
            cpx x[R];
#pragma unroll
            for (int k = 0; k < R; ++k) x[k] = cmul(v[brev<R>(k)], spec[(size_t)base + k]);
            dft_r2<R, true>(x);
#pragma unroll
            for (int j = 0; j < R; ++j) A[phys(base + j)] = x[brev<R>(j)];
        }
    }
}
template <int LOG2L, bool INV> __device__ __forceinline__ void fft_outer(LDSQ cpx* A, int t) {
    if (LOG2L == 14) {
        if (!INV) { fft_pass<16, 1024, false>(A, t); __syncthreads(); fft_pass<16, 64, false>(A, t); __syncthreads(); fft_pass<16, 4, false>(A, t); __syncthreads(); }
        else      { fft_pass<16, 4, true>(A, t); __syncthreads(); fft_pass<16, 64, true>(A, t); __syncthreads(); fft_pass<16, 1024, true>(A, t); __syncthreads(); }
    } else {
        if (!INV) { fft_pass<16, 128, false>(A, t); __syncthreads(); fft_pass<16, 8, false>(A, t); __syncthreads(); }
        else      { fft_pass<16, 8, true>(A, t); __syncthreads(); fft_pass<16, 128, true>(A, t); __syncthreads(); }
    }
}
template <int LOG2L> __device__ __forceinline__ void fft_to_spec(LDSQ cpx* A, int t, cpx* spec, float scale) {
    fft_outer<LOG2L, false>(A, t);
    fft_mid<LOG2L == 14 ? 4 : 8, 0>(A, t, spec, scale);
    __syncthreads();
}
template <int LOG2L> __device__ __forceinline__ void fft_conv(LDSQ cpx* A, int t, cpx* spec) {
    fft_outer<LOG2L, false>(A, t);
    fft_mid<LOG2L == 14 ? 4 : 8, 1>(A, t, spec, 1.0f);
    __syncthreads();
    fft_outer<LOG2L, true>(A, t);
}

template <int LOG2L> __device__ __forceinline__ void hyena_item(const Params& p, LDSQ unsigned char* lds, int layer_j, int c0) {
    constexpr int L = 1 << LOG2L, NS = L / 32, NPAIR = (LOG2L == 14) ? 1 : 2;
    constexpr int TOK0 = (LOG2L == 14) ? 0 : T_P, PB = (LOG2L == 14) ? 0 : 16384;
    LDSQ cpx* A = (LDSQ cpx*)lds;
    LDSQ float* red = (LDSQ float*)(lds + 135168);
    const int t = pg8::otid(), seq = (LOG2L == 14) ? 0 : (t >> 6), n0 = (LOG2L == 14) ? t : (t & 63), ch = c0 + seq, a0 = seq * L + n0;
    bf16_t* zin = (bf16_t*)(p.ws + WS_BIG + BIG_ZINT);
    const float* taps = (const float*)(p.ws + WS_BIG + BIG_TAPS);
    cpx* scr = (cpx*)(p.ws + WS_H + (size_t)pg8::obid() * FFT_SCR_PER_WG);
    cpx* yes = (cpx*)(p.ws + WS_END + (size_t)pg8::obid() * 131072);
    float sb, cb; sincospif(-(float)n0 / (float)L, &sb, &cb);
    const cpx wbase = mkc(cb, sb);
    const cpx wstep = mkc(0.99518472667219693f, -0.09801714032956060f);
#pragma unroll 1
    for (int o = 0; o < 2; ++o) {
        const float* tf = taps + (size_t)((o * 2 + 0) * 2048 + ch) * NPOS + PB;
        const float* tb = taps + (size_t)((o * 2 + 1) * 2048 + ch) * NPOS + PB;
        const float df = fabsf(p.hy_decay[(size_t)layer_j * 8192 + (o * 2 + 0) * 2048 + ch]) * (1.0f / (float)(L - 1));
        const float db = fabsf(p.hy_decay[(size_t)layer_j * 8192 + (o * 2 + 1) * 2048 + ch]) * (1.0f / (float)(L - 1));
        const float wf0 = expf(-df * (float)n0), wfs = expf(-df * (float)NS), wb0 = expf(-db * (float)(L - n0)), wbs = expf(db * (float)NS);
        float ss = 0.f;
        { float wf = wf0, wb = wb0;
#pragma unroll 4
          for (int i = 0; i < 32; ++i) { const int n = i * NS + n0; const float fa = tf[n] * wf, fb = n == 0 ? 0.f : tb[L - n] * wb; ss += fa * fa + fb * fb; wf *= wfs; wb *= wbs; } }
        ss = wave_sum(ss);
        if (LOG2L == 14) {
            if ((t & 63) == 0) red[t >> 6] = ss;
            __syncthreads();
            ss = red[0] + red[1] + red[2] + red[3] + red[4] + red[5] + red[6] + red[7];
            __syncthreads();
        }
        const float nrm = 1.0f / sqrtf(ss + EPS);
        const float skp = p.hy_skip[(size_t)layer_j * 2 * 2048 + o * 2048 + ch];
#pragma unroll 1
        for (int part = 0; part < 2; ++part) {
            cpx wn = wbase; float wf = wf0 * nrm, wb = wb0 * nrm;
#pragma unroll 4
            for (int i = 0; i < 32; ++i) { const int n = i * NS + n0; float fa = tf[n] * wf; const float fb = n == 0 ? 0.f : tb[L - n] * wb; if (n == 0) fa += skp;
                cpx val; if (part == 0) val = mkc(fa + fb, 0.0f); else { const float d = fa - fb; val = mkc(d * wn.x, d * wn.y); }
                A[phys(a0 + i * NS)] = val; wn = cmul(wn, wstep); wf *= wfs; wb *= wbs; }
            __syncthreads();
            fft_to_spec<LOG2L>(A, t, scr + (size_t)(o * 2 + part) * 16384, 0.5f / (float)L);
        }
    }
    const float* cw = p.hy_conv_w + (size_t)layer_j * 3 * 6144; const float* cbias = p.hy_conv_b + (size_t)layer_j * 6144;
    cpx* u1s = scr + (size_t)4 * 16384;
#pragma unroll 1
    for (int pr = 0; pr < NPAIR; ++pr) {
        const size_t tb0 = (size_t)TOK0 + (size_t)(2 * pr) * L, tb1 = tb0 + L;
#pragma unroll 1
        for (int o = 0; o < 2; ++o) {
#pragma unroll 1
            for (int path = 0; path < 2; ++path) {
                cpx wn = wbase;
                if (o == 0) {
                    const int rc = 2 * 2048 + ch; const float w0 = cw[rc], w1 = cw[6144 + rc], w2 = cw[2 * 6144 + rc], bb = cbias[rc];
                    const bf16_t* z0 = zin + (size_t)rc * T + tb0; const bf16_t* z1 = zin + (size_t)rc * T + tb1;
#pragma unroll 4
                    for (int i = 0; i < 32; ++i) { const int n = i * NS + n0;
                        const float x0 = n > 0 ? bf2f(z0[n - 1]) : 0.f, x1 = bf2f(z0[n]), x2 = n < L - 1 ? bf2f(z0[n + 1]) : 0.f;
                        const float y0 = n > 0 ? bf2f(z1[n - 1]) : 0.f, y1 = bf2f(z1[n]), y2 = n < L - 1 ? bf2f(z1[n + 1]) : 0.f;
                        cpx val = mkc(w0 * x0 + w1 * x1 + w2 * x2 + bb, w0 * y0 + w1 * y1 + w2 * y2 + bb);
                        if (path == 1) val = cmul(val, wn);
                        A[phys(a0 + i * NS)] = val; wn = cmul(wn, wstep); }
                } else {
#pragma unroll 4
                    for (int i = 0; i < 32; ++i) { cpx val = u1s[a0 + i * NS]; if (path == 1) val = cmul(val, wn); A[phys(a0 + i * NS)] = val; wn = cmul(wn, wstep); }
                }
                __syncthreads();
                fft_conv<LOG2L>(A, t, scr + (size_t)(o * 2 + path) * 16384);
                if (path == 0) {
#pragma unroll 4
                    for (int i = 0; i < 32; ++i) yes[a0 + i * NS] = A[phys(a0 + i * NS)];
                    __syncthreads();
                }
            }
            const int rg = o * 2048 + ch; const float w0 = cw[rg], w1 = cw[6144 + rg], w2 = cw[2 * 6144 + rg], bb = cbias[rg];
            const bf16_t* g0 = zin + (size_t)rg * T + tb0; const bf16_t* g1 = zin + (size_t)rg * T + tb1;
            bf16_t* o0 = zin + (size_t)ch * T + tb0; bf16_t* o1 = zin + (size_t)ch * T + tb1;
            cpx wn = wbase;
#pragma unroll 4
            for (int i = 0; i < 32; ++i) { const int n = i * NS + n0;
                const cpx yo = cmulc(A[phys(a0 + i * NS)], wn), ye = yes[a0 + i * NS];
                const float ya = ye.x + yo.x, yb = ye.y + yo.y;
                const float x0 = n > 0 ? bf2f(g0[n - 1]) : 0.f, x1 = bf2f(g0[n]), x2 = n < L - 1 ? bf2f(g0[n + 1]) : 0.f;
                const float y0 = n > 0 ? bf2f(g1[n - 1]) : 0.f, y1 = bf2f(g1[n]), y2 = n < L - 1 ? bf2f(g1[n + 1]) : 0.f;
                const float ga = w0 * x0 + w1 * x1 + w2 * x2 + bb, gb = w0 * y0 + w1 * y1 + w2 * y2 + bb;
                const cpx res = mkc(ga * ya, gb * yb);
                if (o == 0) u1s[a0 + i * NS] = res; else A[phys(a0 + i * NS)] = res;
                wn = cmul(wn, wstep); }
            __syncthreads();
            if (o == 1) {
#pragma unroll 4
                for (int i = 0; i < 32; ++i) { const int n = i * NS + n0; const cpx res = A[phys(a0 + i * NS)]; o0[n] = f2bf(res.x); o1[n] = f2bf(res.y); }
                __syncthreads();
            }
        }
    }
}
__device__ __forceinline__ void hyena_conv_phase(const Params& p, LDSQ unsigned char* lds, int layer_j) {
    { LDSQ cpx* TW = (LDSQ cpx*)(lds + TW_OFF);
      for (int e = pg8::otid(); e < 1024; e += NTHR) { float sn, cs; sincospif(-2.0f * (float)e / 16384.0f, &sn, &cs); TW[e] = mkc(cs, sn); }
      __syncthreads(); }
    for (int it = pg8::obid(); it < 2048; it += pg8::ogrid()) hyena_item<14>(p, lds, layer_j, it);
    for (int it = pg8::obid(); it < 256; it += pg8::ogrid()) hyena_item<11>(p, lds, layer_j, it * 8);
}

__device__ __forceinline__ void attn_phase(const Params& p, LDSQ unsigned char* lds) {
    constexpr int KROW = 272, VROW = 264;
    LDSQ unsigned char* Kl = lds; LDSQ bf16_t* VT = (LDSQ bf16_t*)(lds + 256 * KROW);
    const bf16_t* qkv = (const bf16_t*)(p.ws + WS_BIG + BIG_QKV);
    bf16_t* og = (bf16_t*)(p.ws + WS_BIG + BIG_OG); float* lse = (float*)(p.ws + WS_BIG + BIG_LSE);
    const int tid = pg8::otid(), lane = tid & 63, wid = __builtin_amdgcn_readfirstlane(tid >> 6), l15 = lane & 15, g4 = lane >> 4;
    for (int it = pg8::obid(); it < 7680; it += pg8::ogrid()) {
        int g, b, hh, rho, pp, L, tokbase;
        if (it < 6144) { g = it >> 11; const int rem = it & 2047; const int npp = 128 >> (2 * g); pp = rem % npp; rho = (rem / npp) & ((1 << (2 * g)) - 1); hh = (rem >> 7) & 7; b = rem >> 10; L = L_P; tokbase = 0; }
        else { const int i2 = it - 6144; g = i2 >> 9; const int rem = i2 & 511; const int npp = 16 >> (2 * g); pp = rem % npp; rho = (rem / npp) & ((1 << (2 * g)) - 1); hh = (rem >> 4) & 7; b = rem >> 7; L = L_S; tokbase = T_P; }
        const int rsh = 2 * g, n = L >> rsh;
        const size_t tok0 = (size_t)tokbase + (size_t)b * L + rho;
        const int i0 = 128 * pp - 64;
        const int qcol = g * 3072 + hh * 128, kcol = qcol + 1024, vcol = qcol + 2048;
#pragma unroll
        for (int s8 = 0; s8 < 8; ++s8) { const int ci = tid + 512 * s8, slot = ci >> 4, chn = ci & 15, i = i0 + slot;
            u32x4 v = {0u, 0u, 0u, 0u};
            if (i >= 0 && i < n) v = *(const u32x4*)(qkv + (tok0 + ((size_t)i << rsh)) * QKVW + kcol + chn * 8);
            *(LDSQ u32x4*)(Kl + slot * KROW + chn * 16) = v; }
#pragma unroll
        for (int s8 = 0; s8 < 8; ++s8) { const int ci = tid + 512 * s8, slot = ci & 255, chn = ci >> 8, i = i0 + slot;
            u32x4 v = {0u, 0u, 0u, 0u};
            if (i >= 0 && i < n) v = *(const u32x4*)(qkv + (tok0 + ((size_t)i << rsh)) * QKVW + vcol + chn * 8);
            LDSQ bf16_t* vp = VT + (chn * 8) * VROW + slot;
            vp[0] = (bf16_t)(v.x & 0xffffu); vp[VROW] = (bf16_t)(v.x >> 16); vp[2 * VROW] = (bf16_t)(v.y & 0xffffu); vp[3 * VROW] = (bf16_t)(v.y >> 16);
            vp[4 * VROW] = (bf16_t)(v.z & 0xffffu); vp[5 * VROW] = (bf16_t)(v.z >> 16); vp[6 * VROW] = (bf16_t)(v.w & 0xffffu); vp[7 * VROW] = (bf16_t)(v.w >> 16); }
        __syncthreads();
        const int blk = wid >> 2, qq = 16 * (wid & 3) + l15;
        const int qi = 128 * pp + 64 * blk + qq;
        const size_t tq = tok0 + ((size_t)qi << rsh);
        bf16x8 bq[4];
#pragma unroll
        for (int ks = 0; ks < 4; ++ks) bq[ks] = *(const bf16x8*)(qkv + tq * QKVW + qcol + 32 * ks + 8 * g4);
        f32x4 sc[12];
#pragma unroll
        for (int kt = 0; kt < 12; ++kt) { f32x4 a = {0.f, 0.f, 0.f, 0.f};
#pragma unroll
            for (int ks = 0; ks < 4; ++ks) { const bf16x8 ka = *(const LDSQ bf16x8*)(Kl + (64 * blk + 16 * kt + l15) * KROW + (32 * ks + 8 * g4) * 2);
                a = __builtin_amdgcn_mfma_f32_16x16x32_bf16(ka, bq[ks], a, 0, 0, 0); }
            sc[kt] = a; }
        const int ibase = 128 * pp + 64 * blk - 64;
        float mx = -3.0e38f;
#pragma unroll
        for (int kt = 0; kt < 12; ++kt)
#pragma unroll
            for (int r = 0; r < 4; ++r) { const int kk = 16 * kt + 4 * g4 + r, ki = ibase + kk; const bool ok = (kk >= qq) && (kk <= qq + 128) && (ki >= 0) && (ki < n);
                sc[kt][r] = ok ? sc[kt][r] : -3.0e38f; mx = fmaxf(mx, sc[kt][r]); }
        mx = fmaxf(mx, __shfl_xor(mx, 16)); mx = fmaxf(mx, __shfl_xor(mx, 32));
        float ls = 0.f;
#pragma unroll
        for (int kt = 0; kt < 12; ++kt)
#pragma unroll
            for (int r = 0; r < 4; ++r) { const float e = sc[kt][r] > -1.0e38f ? exp2f(sc[kt][r] - mx) : 0.f; sc[kt][r] = e; ls += e; }
        ls += __shfl_xor(ls, 16); ls += __shfl_xor(ls, 32);
        f32x4 oa[8];
#pragma unroll
        for (int dt = 0; dt < 8; ++dt) oa[dt] = (f32x4){0.f, 0.f, 0.f, 0.f};
#pragma unroll
        for (int k2 = 0; k2 < 6; ++k2) {
            union { u32x4 u; bf16x8 h; } pb;
            pb.u.x = cvt_pk_bf16(sc[2 * k2][0], sc[2 * k2][1]); pb.u.y = cvt_pk_bf16(sc[2 * k2][2], sc[2 * k2][3]);
            pb.u.z = cvt_pk_bf16(sc[2 * k2 + 1][0], sc[2 * k2 + 1][1]); pb.u.w = cvt_pk_bf16(sc[2 * k2 + 1][2], sc[2 * k2 + 1][3]);
#pragma unroll
            for (int dt = 0; dt < 8; ++dt) {
                const LDSQ bf16_t* vr = VT + (16 * dt + l15) * VROW + 64 * blk + 32 * k2 + 4 * g4;
                union { u32x4 u; bf16x8 h; } va; const u32x2 lo = *(const LDSQ u32x2*)vr, hi = *(const LDSQ u32x2*)(vr + 16);
                va.u.x = lo.x; va.u.y = lo.y; va.u.z = hi.x; va.u.w = hi.y;
                oa[dt] = __builtin_amdgcn_mfma_f32_16x16x32_bf16(va.h, pb.h, oa[dt], 0, 0, 0); }
        }
        const float inv = 1.0f / ls;
        const size_t gt = (size_t)g * T + tq;
#pragma unroll
        for (int dt = 0; dt < 8; ++dt) { u32x2 w; w.x = cvt_pk_bf16(oa[dt][0] * inv, oa[dt][1] * inv); w.y = cvt_pk_bf16(oa[dt][2] * inv, oa[dt][3] * inv);
            *(u32x2*)(og + gt * 1024 + hh * 128 + 16 * dt + 4 * g4) = w; }
        if (g4 == 0) lse[gt * 8 + hh] = mx + log2f(ls);
        __syncthreads();
    }
}
__device__ __forceinline__ void attn_merge_phase(const Params& p) {
    const bf16_t* og = (const bf16_t*)(p.ws + WS_BIG + BIG_OG); const float* lse = (const float*)(p.ws + WS_BIG + BIG_LSE); bf16_t* H = (bf16_t*)(p.ws + WS_H);
    for (int i = pg8::obid() * NTHR + pg8::otid(); i < T * 128; i += pg8::ogrid() * NTHR) {
        const int tok = i >> 7, c8 = i & 127, hh = c8 >> 4;
        const float l0 = lse[(size_t)tok * 8 + hh], l1 = lse[((size_t)T + tok) * 8 + hh], l2 = lse[((size_t)2 * T + tok) * 8 + hh];
        const float m = fmaxf(l0, fmaxf(l1, l2)); float a0 = exp2f(l0 - m), a1 = exp2f(l1 - m), a2 = exp2f(l2 - m); const float is = 1.0f / (a0 + a1 + a2); a0 *= is; a1 *= is; a2 *= is;
        const u32x4 v0 = *(const u32x4*)(og + (size_t)tok * 1024 + c8 * 8), v1 = *(const u32x4*)(og + ((size_t)T + tok) * 1024 + c8 * 8), v2 = *(const u32x4*)(og + ((size_t)2 * T + tok) * 1024 + c8 * 8);
        u32x4 w;
#pragma unroll
        for (int e = 0; e < 4; ++e) { const float lo = a0 * __uint_as_float(v0[e] << 16) + a1 * __uint_as_float(v1[e] << 16) + a2 * __uint_as_float(v2[e] << 16);
            const float hi = a0 * __uint_as_float(v0[e] & 0xffff0000u) + a1 * __uint_as_float(v1[e] & 0xffff0000u) + a2 * __uint_as_float(v2[e] & 0xffff0000u);
            w[e] = cvt_pk_bf16(lo, hi); }
        *(u32x4*)(H + (size_t)tok * 1024 + c8 * 8) = w;
    }
}

constexpr int NPHASE = 35;
typedef const __attribute__((address_space(4))) unsigned char* KARG;
template <class Tp> __device__ __forceinline__ Tp karg(int byte_off) { return *(volatile const __attribute__((address_space(4))) Tp*)((KARG)__builtin_amdgcn_kernarg_segment_ptr() + byte_off); }
#define PA(q, member) q.member = karg<decltype(Params::member)>((int)__builtin_offsetof(Params, member))
__global__ void __launch_bounds__(512, 2) mega(Params parg) {
    extern __shared__ __attribute__((aligned(16))) unsigned char shm[];
    LDSQ unsigned char* lds = (LDSQ unsigned char*)shm;
    const int tid = pg8::otid();
    volatile LDSQ unsigned* misc = (volatile LDSQ unsigned*)(lds + LDS_MISC);
    if (tid < 8) misc[tid] = 0u;
    __syncthreads();
    const int ph_lo = parg.ph_lo, ph_hi = parg.ph_hi;
    XcdBarrier bar; bar.bar = nullptr; bar.x = 0; bar.st = misc;
    if (ph_hi - ph_lo > 1) { Params q{}; PA(q, ws); bar = xcd_barrier_post((unsigned*)(q.ws + WS_CTL), misc); }
#define IN(k) (ph_lo <= (k) && (k) < ph_hi)
#define SEAM(k) do { if (IN(k) && IN((k) + 1)) { Params qb{}; PA(qb, ws); bar.bar = (unsigned*)(qb.ws + WS_CTL); xcd_barrier(bar); } } while (0)

    if (IN(0)) { Params q{}; PA(q, ws); PA(q, c_prompt); PA(q, c_sample); PA(q, ada_w); PA(q, final_ada_w); ada_partials(q, lds); rope_table(q);
                 PA(q, hy_fw1); PA(q, hy_fb1); PA(q, hy_ffreq); PA(q, hy_fw2); PA(q, hy_fb2); PA(q, hy_fw3); filter_mlp(q); }
    SEAM(0);
    if (IN(1)) { Params q{}; PA(q, ws); PA(q, ada_b); PA(q, final_ada_b); ada_reduce(q); }
    SEAM(1);
#pragma unroll 1
    for (int layer = 0; layer < 4; ++layer) {
        const int pb = 2 + 8 * layer, j = layer >> 1; const bool hy = (layer & 1) == 0;
        if (IN(pb + 0)) {
            Params q{}; PA(q, ws); unsigned char* wl = q.ws + WS_WL;
            PA(q, ffn_w_gate); convert_T(lds, q.ffn_w_gate + (size_t)layer * 2048 * DFF, 2048, DFF, (bf16_t*)(wl + WL_FFN1), 0);
            PA(q, ffn_w_up);   convert_T(lds, q.ffn_w_up + (size_t)layer * 2048 * DFF, 2048, DFF, (bf16_t*)(wl + WL_FFN1), 1);
            PA(q, ffn_w_down); convert_T(lds, q.ffn_w_down + (size_t)layer * DFF * 2048, DFF, 2048, (bf16_t*)(wl + WL_FFN2), -1);
            if (hy) { PA(q, hy_w_in);  convert_T(lds, q.hy_w_in + (size_t)j * 2048 * 6144, 2048, 6144, (bf16_t*)(wl + WL_MIXIN), -1);
                      PA(q, hy_w_out); convert_T(lds, q.hy_w_out + (size_t)j * 2048 * 2048, 2048, 2048, (bf16_t*)(wl + WL_MIXOUT), -1); }
            else    { PA(q, at_w_in);  convert_T(lds, q.at_w_in + (size_t)j * 2048 * QKVW, 2048, QKVW, (bf16_t*)(wl + WL_MIXIN), -1);
                      PA(q, at_w_out); convert_T(lds, q.at_w_out + (size_t)j * 1024 * 2048, 1024, 2048, (bf16_t*)(wl + WL_MIXOUT), -1); }
            PA(q, out); PA(q, norm_mix);
            const float* modl = (const float*)(q.ws + WS_MOD) + layer * 12288;
            if (layer == 0) { PA(q, x_prompt); PA(q, x_sample); norm_mod(q.x_prompt, q.x_sample, q.out, q.norm_mix + layer * 2048, modl, 0, 2048, (bf16_t*)(q.ws + WS_H)); }
            else            norm_mod(q.out, q.out + (size_t)T_P * 2048, nullptr, q.norm_mix + layer * 2048, modl, 0, 2048, (bf16_t*)(q.ws + WS_H));
            if (hy) { __syncthreads();
                pg8::Gemm g{(const bf16_t*)(q.ws + WS_W3X) + (size_t)j * 8192 * 256, (const bf16_t*)(q.ws + WS_A2X) + (size_t)j * NPOS * 256, 8192, NPOS, 256};
                pg8::StaticOrder S; S.init(8192, NPOS, pg8::ogrid(), pg8::obid());
                EpiTaps E{(float*)(q.ws + WS_BIG + BIG_TAPS)};
                pg8::gemm_phase<EpiTaps, pg8::StaticOrder, false>(lds, g, S, E, nullptr); }
        }
        SEAM(pb + 0);
        if (IN(pb + 1)) {
            Params q{}; PA(q, ws);
            if (hy) { PA(q, hy_b_in); pg8::Gemm g{(const bf16_t*)(q.ws + WS_WL + WL_MIXIN), (const bf16_t*)(q.ws + WS_H), 6144, T, 2048}; pg8::StaticOrder S; S.init(6144, T, pg8::ogrid(), pg8::obid());
                EpiZinT E{(bf16_t*)(q.ws + WS_BIG + BIG_ZINT), T, q.hy_b_in + (size_t)j * 6144};
                pg8::gemm_phase<EpiZinT, pg8::StaticOrder, false>(lds, g, S, E, nullptr); }
            else { pg8::Gemm g{(const bf16_t*)(q.ws + WS_H), (const bf16_t*)(q.ws + WS_WL + WL_MIXIN), T, QKVW, 2048}; pg8::StaticOrder S; S.init(T, QKVW, pg8::ogrid(), pg8::obid());
                EpiQKV E{(bf16_t*)(q.ws + WS_BIG + BIG_QKV), (const cpx*)(q.ws + WS_ROPE)};
                pg8::gemm_phase<EpiQKV, pg8::StaticOrder, false>(lds, g, S, E, nullptr); }
        }
        SEAM(pb + 1);
        if (IN(pb + 2)) { Params q{}; PA(q, ws); if (hy) { PA(q, hy_skip); PA(q, hy_conv_w); PA(q, hy_conv_b); PA(q, hy_decay); hyena_conv_phase(q, lds, j); } else attn_phase(q, lds); }
        SEAM(pb + 2);
        if (IN(pb + 3)) { Params q{}; PA(q, ws); if (hy) transpose_phase(q, lds); else attn_merge_phase(q); }
        SEAM(pb + 3);
        if (IN(pb + 4)) {
            Params q{}; PA(q, ws); PA(q, out); PA(q, hy_b_out);
            pg8::Gemm g{(const bf16_t*)(q.ws + WS_H), (const bf16_t*)(q.ws + WS_WL + WL_MIXOUT), T, 2048, hy ? 2048 : 1024}; pg8::StaticOrder S; S.init(T, 2048, pg8::ogrid(), pg8::obid());
            EpiRes E{q.out, hy ? q.hy_b_out + (size_t)j * 2048 : nullptr, (const float*)(q.ws + WS_MOD) + layer * 12288 + 4096};
            pg8::gemm_phase<EpiRes, pg8::StaticOrder, false>(lds, g, S, E, nullptr);
        }
        SEAM(pb + 4);
        if (IN(pb + 5)) { Params q{}; PA(q, ws); PA(q, out); PA(q, norm_ffn);
            norm_mod(q.out, q.out + (size_t)T_P * 2048, nullptr, q.norm_ffn + layer * 2048, (const float*)(q.ws + WS_MOD) + layer * 12288, 6144, 8192, (bf16_t*)(q.ws + WS_H)); }
        SEAM(pb + 5);
        if (IN(pb + 6)) {
            Params q{}; PA(q, ws);
            pg8::Gemm g{(const bf16_t*)(q.ws + WS_H), (const bf16_t*)(q.ws + WS_WL + WL_FFN1), T, 2 * DFF, 2048}; pg8::StaticOrder S; S.init(T, 2 * DFF, pg8::ogrid(), pg8::obid());
            EpiFFN1 E{(bf16_t*)(q.ws + WS_BIG + BIG_MID)};
            pg8::gemm_phase<EpiFFN1, pg8::StaticOrder, false>(lds, g, S, E, nullptr);
        }
        SEAM(pb + 6);
        if (IN(pb + 7)) {
            Params q{}; PA(q, ws); PA(q, out);
            pg8::Gemm g{(const bf16_t*)(q.ws + WS_BIG + BIG_MID), (const bf16_t*)(q.ws + WS_WL + WL_FFN2), T, 2048, DFF}; pg8::StaticOrder S; S.init(T, 2048, pg8::ogrid(), pg8::obid());
            EpiRes E{q.out, nullptr, (const float*)(q.ws + WS_MOD) + layer * 12288 + 10240};
            pg8::gemm_phase<EpiRes, pg8::StaticOrder, false>(lds, g, S, E, nullptr);
        }
        SEAM(pb + 7);
    }
    if (IN(34)) { Params q{}; PA(q, ws); PA(q, out); PA(q, final_norm); final_norm_phase(q); }
#undef IN
#undef SEAM
}
}

extern "C" void kernel_launch(void* const* d_in, const int* in_sizes, int n_in, void* d_out, int out_size, void* d_ws, size_t ws_size, hipStream_t stream) {
    static int grid = 0;
    if (grid == 0) {
        if (n_in != 30 || out_size != mk::T * mk::D || ws_size < mk::WS_TOTAL) { fprintf(stderr, "kernel_launch: unexpected shapes (n_in %d out %d ws %zu need %zu); nothing launched\n", n_in, out_size, ws_size, (size_t)mk::WS_TOTAL); grid = -1; return; }
        int dev = 0, cus = 0;
        if (hipGetDevice(&dev) != hipSuccess || hipDeviceGetAttribute(&cus, hipDeviceAttributeMultiprocessorCount, dev) != hipSuccess) { grid = -1; return; }
        if (hipFuncSetAttribute((const void*)mk::mega, hipFuncAttributeMaxDynamicSharedMemorySize, mk::LDS_BYTES) != hipSuccess) { fprintf(stderr, "kernel_launch: hipFuncSetAttribute failed\n"); grid = -1; return; }
        int per_cu = 0; (void)hipOccupancyMaxActiveBlocksPerMultiprocessor(&per_cu, (const void*)mk::mega, 512, mk::LDS_BYTES); (void)hipGetLastError();
        if (per_cu < 1) fprintf(stderr, "kernel_launch: occupancy query reports %d blocks per CU\n", per_cu);
        grid = cus > 256 ? 256 : cus;
    }
    if (grid < 0) return;
    mk::Params p{};
    const float** f = (const float**)&p;
    for (int i = 0; i < 30; ++i) f[i] = (const float*)d_in[i];
    p.out = (float*)d_out; p.ws = (unsigned char*)d_ws;
#if MK_PER_PHASE
    for (int k = 0; k < mk::NPHASE; ++k) { p.ph_lo = k; p.ph_hi = k + 1; hipLaunchKernelGGL(mk::mega, dim3(grid), dim3(512), mk::LDS_BYTES, stream, p); }
#else
    (void)hipMemsetAsync((char*)d_ws + mk::WS_CTL, 0, mk::CTL_BYTES, stream);
    p.ph_lo = 0; p.ph_hi = mk::NPHASE;
    hipLaunchKernelGGL(mk::mega, dim3(grid), dim3(512), mk::LDS_BYTES, stream, p);
#endif
}
```

```cpp
#include <hip/hip_runtime.h>
#include <cstdio>
#include <cstdint>
#include <utility>
#ifndef MK_PER_PHASE
#define MK_PER_PHASE 0
#endif
#ifndef MK_PROBE
#define MK_PROBE 0
#endif
namespace pg8 {
#define PG8_LAS __attribute__((address_space(3)))
__device__ __forceinline__ int otid() { int t = threadIdx.x; asm volatile("" : "+v"(t) :: "memory"); return t; }
__device__ __forceinline__ int obid() { int b = blockIdx.x; asm volatile("" : "+s"(b)); return b; }
__device__ __forceinline__ int ogrid() { int g = gridDim.x; asm volatile("" : "+s"(g)); return g; }
typedef unsigned short bf16_t;
typedef short bf16x8 __attribute__((ext_vector_type(8)));
typedef float f32x4 __attribute__((ext_vector_type(4)));
typedef unsigned u32x4 __attribute__((ext_vector_type(4)));
constexpr int BM = 256, BK = 64, HALF = 128, HTB = HALF * BK * 2  , STAGE_BYTES = 8 * HTB, NXCD = 8, WGM = 4;

__host__ __device__ __forceinline__ int lds_byte(int r, int c) { const int st = (r >> 4) * 2 + (c >> 5), rr = r & 15, cc = c & 31, ob = rr * 64 + cc * 2; return st * 1024 + (ob ^ (((ob >> 9) & 1) << 5)); }
__host__ __device__ __forceinline__ void stage_rc(int b, int& R, int& C) { const int st = b / 1024, sb = b % 1024, swz = sb ^ (((sb >> 9) & 1) << 5); R = (st >> 1) * 16 + swz / 64; C = (st & 1) * 32 + (swz % 64) / 2; }
__host__ __device__ __forceinline__ int perm32(int rho) { const int n = rho >> 4, i = rho & 15; return 8 * (i >> 2) + 4 * n + (i & 3); }

struct Unit { int pm, pn; };
struct Gemm { const bf16_t* A; const bf16_t* Bt; int M, N, K; };

struct StaticOrder {
    int nM, nN, nwg, G, c, wgm;
    __host__ __device__ void init(int M, int N, int G_, int c_, int wgm_ = WGM) { nM = M / BM; nN = N / BM; nwg = nM * nN; G = G_; c = c_; wgm = wgm_; }
    __host__ __device__ bool next(int i, Unit& u) const {
        const long L = (long)i * G + c; if (L >= nwg) return false;
        int wgid = (int)L; { const int q = nwg / NXCD, r = nwg % NXCD, xcd = wgid % NXCD, off = wgid / NXCD; wgid = (xcd < r ? xcd * (q + 1) : r * (q + 1) + (xcd - r) * q) + off; }
        const int nig = wgm * nN, gid = wgid / nig, fm = gid * wgm, gsz = (nM - fm) < wgm ? (nM - fm) : wgm;
        u.pm = fm + ((wgid % nig) % gsz); u.pn = (wgid % nig) / gsz; return true;
    }
    __device__ __forceinline__ void a_ready(const Unit&) const {}
    __device__ __forceinline__ void done(const Unit&) const {}
};
__device__ __forceinline__ unsigned cvt_pk_bf16(float lo, float hi) { unsigned r; asm volatile("v_cvt_pk_bf16_f32 %0, %1, %2" : "=v"(r) : "v"(lo), "v"(hi)); return r; }
template <class Epi, class Sched, bool STAMP = false>
__device__ __forceinline__ void gemm_phase(PG8_LAS unsigned char* lds, const Gemm g, const Sched& S, const Epi& E, unsigned long long* stamps) {
    const int tid = otid(), wid = __builtin_amdgcn_readfirstlane(tid >> 6), lane = tid & 63, wr = wid >> 2, wc = wid & 3, fr = lane & 15, fq = lane >> 4;
    const int K = g.K, nt = K / BK;
    int ts_lo = 0, ts_hi = 0, nts = 0; const unsigned long long rt_entry = STAMP ? (unsigned long long)wall_clock64() : 0ull;
#define PG8_STAMP() do { if (STAMP && wid == 0 && nts < 64) { const unsigned long long _c = (unsigned long long)clock64(); \
        ts_lo = (lane == nts) ? (int)(unsigned)_c : ts_lo; ts_hi = (lane == nts) ? (int)(unsigned)(_c >> 32) : ts_hi; ++nts; } } while (0)
    PG8_STAMP();
    unsigned voffA[2], voffB[2];
#pragma unroll
    for (int i = 0; i < 2; ++i) { int R, C; stage_rc(tid * 16 + i * 8192, R, C); const int Rb = Epi::PERM ? ((R & ~31) + perm32(R & 31)) : R;
        voffA[i] = (unsigned)(R * K + C) * 2u; voffB[i] = (unsigned)(Rb * K + C) * 2u; }
    const size_t kstep = (size_t)(BK * 2);
    const size_t hstep = (size_t)HALF * K * 2;
    const size_t tstep = 2 * hstep;
    const unsigned ldsw = (unsigned)wid * 1024u;
    const int aoff = lds_byte(wr * 64 + fr, fq * 8), boff = lds_byte(wc * 32 + fr, fq * 8);
#define PG8_SA(b, h) (((b) * 2 + (h)) * HTB)
#define PG8_SB(b, h) ((4 + (b) * 2 + (h)) * HTB)
#define PG8_STAGE(bufoff, gbase, voff) do { _Pragma("unroll") for (int _i = 0; _i < 2; ++_i) \
        __builtin_amdgcn_global_load_lds((const unsigned*)((const char*)(gbase) + (voff)[_i]), (PG8_LAS unsigned*)(lds + (bufoff) + ldsw + _i * 8192), 16, 0, 0); } while (0)
#define PG8_LDA(dst, b, h) do { _Pragma("unroll") for (int m = 0; m < 4; ++m) _Pragma("unroll") for (int k = 0; k < 2; ++k) dst[m][k] = *(const PG8_LAS bf16x8*)(lds + PG8_SA(b, h) + aoff + m * 2048 + k * 1024); } while (0)
#define PG8_LDB(dst, b, h) do { _Pragma("unroll") for (int n = 0; n < 2; ++n) _Pragma("unroll") for (int k = 0; k < 2; ++k) dst[n][k] = *(const PG8_LAS bf16x8*)(lds + PG8_SB(b, h) + boff + n * 2048 + k * 1024); } while (0)
#define PG8_MMA(ai, bj, At, Bt) do { __builtin_amdgcn_s_setprio(1); _Pragma("unroll") for (int m = 0; m < 4; ++m) _Pragma("unroll") for (int n = 0; n < 2; ++n) _Pragma("unroll") for (int k = 0; k < 2; ++k) \
        acc[ai][bj][m][n] = __builtin_amdgcn_mfma_f32_16x16x32_bf16(Bt[n][k], At[m][k], acc[ai][bj][m][n], 0, 0, 0); __builtin_amdgcn_s_setprio(0); } while (0)
#define PG8_WAIT_V(n) asm volatile("s_waitcnt vmcnt(" #n ")" ::: "memory")
#define PG8_WAIT_L(n) asm volatile("s_waitcnt lgkmcnt(" #n ")" ::: "memory")
#define PG8_BAR __builtin_amdgcn_s_barrier()
#define PG8_SCHED __builtin_amdgcn_sched_barrier(0)
    Unit cur, nxt; int ui = 0;
    if (!S.next(0, cur)) return;
    f32x4 acc[2][2][4][2];
#pragma unroll
    for (int a = 0; a < 2; ++a)
#pragma unroll
        for (int b = 0; b < 2; ++b)
#pragma unroll
            for (int m = 0; m < 4; ++m)
#pragma unroll
                for (int n = 0; n < 2; ++n) acc[a][b][m][n] = (f32x4){0.f, 0.f, 0.f, 0.f};
    bf16x8 At[4][2], B0[2][2], B1[2][2];
    const char* cA = (const char*)g.A + (size_t)cur.pm * tstep; const char* cB = (const char*)g.Bt + (size_t)cur.pn * tstep;
    S.a_ready(cur);
    PG8_STAGE(PG8_SB(0, 0), cB, voffB); PG8_STAGE(PG8_SA(0, 0), cA, voffA); PG8_STAGE(PG8_SB(0, 1), cB + hstep, voffB); PG8_STAGE(PG8_SA(0, 1), cA + hstep, voffA);
    if (wr == 1) PG8_BAR;
    PG8_WAIT_V(4); PG8_BAR;
    PG8_STAGE(PG8_SB(1, 0), cB + kstep, voffB); PG8_STAGE(PG8_SA(1, 0), cA + kstep, voffA); PG8_STAGE(PG8_SB(1, 1), cB + hstep + kstep, voffB);
    PG8_WAIT_V(6); PG8_BAR;
    PG8_STAMP();
    for (;;) {
        const bool has_next = S.next(ui + 1, nxt);
        const char* nA = has_next ? (const char*)g.A + (size_t)nxt.pm * tstep : cA; const char* nB = has_next ? (const char*)g.Bt + (size_t)nxt.pn * tstep : cB;
        for (int t = 0; t < nt; t += 2) {
            const bool last = (t == nt - 2);
            const char* a1 = cA + (size_t)(t + 1) * kstep;
            const char* a2 = last ? nA : cA + (size_t)(t + 2) * kstep; const char* b2 = last ? nB : cB + (size_t)(t + 2) * kstep;
            const char* a3 = a2 + kstep; const char* b3 = b2 + kstep;
            if (last && has_next) S.a_ready(nxt);
            PG8_LDB(B0, 0, 0); PG8_SCHED; PG8_LDA(At, 0, 0); PG8_STAGE(PG8_SA(1, 1), a1 + hstep, voffA);
            PG8_WAIT_L(8); PG8_BAR; PG8_WAIT_L(0); PG8_MMA(0, 0, At, B0); PG8_BAR; PG8_SCHED;
            PG8_LDB(B1, 0, 1); PG8_STAGE(PG8_SB(0, 0), b2, voffB);
            PG8_BAR; PG8_WAIT_L(0); PG8_MMA(0, 1, At, B1); PG8_BAR;
            PG8_LDA(At, 0, 1); PG8_STAGE(PG8_SA(0, 0), a2, voffA);
            PG8_BAR; PG8_WAIT_L(0); PG8_MMA(1, 0, At, B0); PG8_BAR; PG8_SCHED;
            PG8_STAGE(PG8_SB(0, 1), b2 + hstep, voffB);
            PG8_WAIT_V(6); PG8_BAR; PG8_MMA(1, 1, At, B1); PG8_BAR;
            PG8_LDB(B0, 1, 0); PG8_SCHED; PG8_LDA(At, 1, 0); PG8_STAGE(PG8_SA(0, 1), a2 + hstep, voffA);
            PG8_WAIT_L(8); PG8_BAR; PG8_WAIT_L(0); PG8_MMA(0, 0, At, B0); PG8_BAR; PG8_SCHED;
            PG8_LDB(B1, 1, 1); PG8_STAGE(PG8_SB(1, 0), b3, voffB);
            PG8_BAR; PG8_WAIT_L(0); PG8_MMA(0, 1, At, B1); PG8_BAR;
            PG8_LDA(At, 1, 1); PG8_STAGE(PG8_SA(1, 0), a3, voffA);
            PG8_BAR; PG8_WAIT_L(0); PG8_MMA(1, 0, At, B0); PG8_BAR; PG8_SCHED;
            PG8_STAGE(PG8_SB(1, 1), b3 + hstep, voffB);
            PG8_WAIT_V(6); PG8_BAR; PG8_MMA(1, 1, At, B1); PG8_BAR;
        }
        PG8_STAMP();
        if constexpr (!Epi::AFTER_DRAIN) { E(acc, cur, wr, wc, fr, fq); S.done(cur); }
        PG8_STAMP();
        if (!has_next) break;
#pragma unroll
        for (int a = 0; a < 2; ++a)
#pragma unroll
            for (int b = 0; b < 2; ++b)
#pragma unroll
                for (int m = 0; m < 4; ++m)
#pragma unroll
                    for (int n = 0; n < 2; ++n) acc[a][b][m][n] = (f32x4){0.f, 0.f, 0.f, 0.f};
        cur = nxt; cA = nA; cB = nB; ++ui;
    }
    PG8_WAIT_V(0);
    if (wr == 0) PG8_BAR;
    PG8_BAR;
    if constexpr (Epi::AFTER_DRAIN) { E.fused(acc, cur, wr, wc, fr, fq, lds, wid, lane); S.done(cur); }
    PG8_STAMP();
    if (STAMP && wid == 0) { stamps[lane] = lane < nts ? (((unsigned long long)(unsigned)ts_hi << 32) | (unsigned)ts_lo) : 0ull;
        if (lane == 62) stamps[62] = rt_entry; if (lane == 63) stamps[63] = (unsigned long long)wall_clock64(); }
#undef PG8_STAMP
#undef PG8_SA
#undef PG8_SB
#undef PG8_STAGE
#undef PG8_LDA
#undef PG8_LDB
#undef PG8_MMA
#undef PG8_WAIT_V
#undef PG8_WAIT_L
#undef PG8_BAR
#undef PG8_SCHED
}
}
#define XB_TMO      128
#define XB_XCNT(j)  (256  + 64 * (j))
#define XB_XSUB(j)  (1280 + 64 * (j))
#define XB_XGEN(j)  (2304 + 64 * (j))
#define XB_TOP      3328
#define XB_TOPGEN   3392
#define XCD_BAR_WORDS 3456
#define XB_SPIN_CAP (1u << 18)
#define LAS __attribute__((address_space(3)))

__device__ __forceinline__ unsigned xb_ld(unsigned* p)              { return __hip_atomic_load(p, __ATOMIC_RELAXED, __HIP_MEMORY_SCOPE_AGENT); }
__device__ __forceinline__ unsigned xb_add(unsigned* p, unsigned v) { return __hip_atomic_fetch_add(p, v, __ATOMIC_RELAXED, __HIP_MEMORY_SCOPE_AGENT); }
__device__ __forceinline__ unsigned xb_xcc_id() { return (unsigned)__builtin_amdgcn_s_getreg((3 << 11) | 20) & 0xFu; }
#define XB_SPIN(cond, bar) do { unsigned _sp = 0; while (cond) { __builtin_amdgcn_s_sleep(1); \
    if ((++_sp & 255u) == 0u) { if (xb_ld(&(bar)[XB_TMO])) break; if (_sp > XB_SPIN_CAP) { atomicAdd(&(bar)[XB_TMO], 1u); break; } } } } while (0)

struct XcdBarrier {
    unsigned* bar; unsigned x;
    volatile LAS unsigned* st;
};

__device__ __forceinline__ XcdBarrier xcd_barrier_post(unsigned* bar, volatile LAS unsigned* st) {
    XcdBarrier b; b.bar = bar; b.x = xb_xcc_id(); b.st = st;
    if (threadIdx.x == 0) (void)xb_add(&bar[XB_XCNT(b.x)], 1u);
    return b;
}
__device__ __forceinline__ void xcd_barrier_complete(unsigned* bar, unsigned x, unsigned& nloc, unsigned& nx) {
    const unsigned G = gridDim.x * gridDim.y * gridDim.z;
    unsigned sum, cnt, mine, sp = 0u;
    for (;;) {
        sum = 0u; cnt = 0u; mine = 0u;
#pragma unroll
        for (unsigned j = 0; j < 16; ++j) { const unsigned c = xb_ld(&bar[XB_XCNT(j)]); sum += c; cnt += (c > 0u) ? 1u : 0u; mine = (j == x) ? c : mine; }
        if (sum == G) break;
        __builtin_amdgcn_s_sleep(1);
        if ((++sp & 255u) == 0u) { if (xb_ld(&bar[XB_TMO])) break; if (sp > XB_SPIN_CAP) { atomicAdd(&bar[XB_TMO], 1u); break; } }
    }
    nloc = mine > 0u ? mine : 1u; nx = cnt > 0u ? cnt : 1u;
}

__device__ __forceinline__ void xcd_barrier(const XcdBarrier& b) {
    asm volatile("s_waitcnt vmcnt(0)" ::: "memory");
    __syncthreads();
    if (threadIdx.x == 0) {
        unsigned* bar = b.bar;
        __builtin_amdgcn_s_waitcnt(0);
        unsigned nloc = b.st[0], nx = b.st[1];
        if (nloc == 0u) { xcd_barrier_complete(bar, b.x, nloc, nx); b.st[0] = nloc; b.st[1] = nx; }
        const unsigned old = xb_add(&bar[XB_XSUB(b.x)], 1u);
        const unsigned gen = old / nloc;
        if (old + 1u == (gen + 1u) * nloc) {
            __builtin_amdgcn_fence(__ATOMIC_RELEASE, "agent");
            asm volatile("s_waitcnt vmcnt(0)" ::: "memory");
            const unsigned og = xb_add(&bar[XB_TOP], 1u);
            const unsigned tg = og / nx;
            if (og + 1u == (tg + 1u) * nx) xb_add(&bar[XB_TOPGEN], 1u);
            else XB_SPIN(xb_ld(&bar[XB_TOPGEN]) == tg, bar);
            __builtin_amdgcn_fence(__ATOMIC_ACQUIRE, "agent");
            xb_add(&bar[XB_XGEN(b.x)], 1u);
            asm volatile("s_waitcnt vmcnt(0)" ::: "memory");
        } else {
            XB_SPIN(xb_ld(&bar[XB_XGEN(b.x)]) == gen, bar);
            __builtin_amdgcn_fence(__ATOMIC_ACQUIRE, "agent");
            asm volatile("s_waitcnt vmcnt(0)" ::: "memory");
        }
    }
    __syncthreads();
}


namespace mk {
using pg8::bf16_t; using pg8::bf16x8; using pg8::f32x4; using pg8::u32x4; using pg8::Unit; using pg8::cvt_pk_bf16;
typedef unsigned u32x2 __attribute__((ext_vector_type(2)));
typedef float cpx __attribute__((ext_vector_type(2)));
__host__ __device__ __forceinline__ cpx mkc(float a, float b) { cpx r; r.x = a; r.y = b; return r; }

constexpr int D = 2048, T_P = 32768, T_S = 8192, T = 40960, L_P = 16384, L_S = 2048, DFF = 5632;
constexpr int NTHR = 512;
constexpr int MODW = 53248;
constexpr int NPOS = 18432;
constexpr int QKVW = 9216;
constexpr float EPS = 1e-6f;
constexpr float QSCALE = 0.12751743082459868f;
constexpr int LDS_BYTES = 147456;
constexpr int LDS_MISC = 147456 - 256;

constexpr size_t al256(size_t x) { return (x + 255) & ~(size_t)255; }
constexpr size_t WS_CTL  = 0;
constexpr size_t CTL_BYTES = 65536;
constexpr size_t WS_PART = WS_CTL + CTL_BYTES;
constexpr size_t WS_MOD  = WS_PART + al256((size_t)8 * 6 * MODW * 4);
constexpr size_t WS_ROPE = WS_MOD + al256((size_t)6 * MODW * 4);
constexpr size_t WS_A2X  = WS_ROPE + (size_t)16384 * 16 * 8;
constexpr size_t WS_W3X  = WS_A2X + (size_t)2 * NPOS * 256 * 2;
constexpr size_t WS_WL   = WS_W3X + (size_t)2 * 8192 * 256 * 2;
constexpr size_t WL_FFN1 = 0;
constexpr size_t WL_FFN2 = WL_FFN1 + (size_t)11264 * 2048 * 2;
constexpr size_t WL_MIXIN = WL_FFN2 + (size_t)2048 * 5632 * 2;
constexpr size_t WL_MIXOUT = WL_MIXIN + (size_t)9216 * 2048 * 2;
constexpr size_t WL_BYTES = WL_MIXOUT + (size_t)2048 * 2048 * 2;
constexpr size_t WS_H    = WS_WL + WL_BYTES;
constexpr size_t H_BYTES = (size_t)T * 2048 * 2;
constexpr size_t WS_BIG  = WS_H + H_BYTES;
constexpr size_t BIG_ZINT = 0;
constexpr size_t BIG_TAPS = BIG_ZINT + (size_t)6144 * T * 2;
constexpr size_t BIG_HY_END = BIG_TAPS + (size_t)8192 * NPOS * 2;
constexpr size_t BIG_QKV = 0;
constexpr size_t BIG_OG  = BIG_QKV + (size_t)T * QKVW * 2;
constexpr size_t BIG_LSE = BIG_OG + (size_t)3 * T * 1024 * 2;
constexpr size_t BIG_AT_END = BIG_LSE + (size_t)3 * T * 8 * 4;
constexpr size_t BIG_MID = 0;
constexpr size_t BIG_BYTES = BIG_HY_END > BIG_AT_END ? BIG_HY_END : BIG_AT_END;
constexpr size_t WS_END  = WS_BIG + BIG_BYTES;
constexpr size_t FFT_SCR_PER_WG = 5 * 131072;
constexpr size_t FFT_EXT_PER_WG = 2 * 65536;
constexpr size_t WS_XB = WS_END + (size_t)256 * FFT_EXT_PER_WG;
constexpr size_t WS_TOTAL = WS_XB + (size_t)T * 2048 * 2;
static_assert(256 * FFT_SCR_PER_WG <= H_BYTES, "fft scratch must fit in H");

struct Params {
    const float *x_prompt, *x_sample, *c_prompt, *c_sample, *ada_w, *ada_b, *norm_mix, *norm_ffn;
    const float *hy_w_in, *hy_b_in, *hy_conv_w, *hy_conv_b, *hy_fw1, *hy_fb1, *hy_ffreq, *hy_fw2, *hy_fb2, *hy_fw3, *hy_decay, *hy_skip, *hy_w_out, *hy_b_out;
    const float *at_w_in, *at_w_out, *ffn_w_gate, *ffn_w_up, *ffn_w_down, *final_norm, *final_ada_w, *final_ada_b;
    float* out; unsigned char* ws; int ph_lo, ph_hi, probe, pad0;
};

#define LDSQ __attribute__((address_space(3)))

__device__ __forceinline__ float bf2f(bf16_t b) { return __uint_as_float(((unsigned)b) << 16); }
__device__ __forceinline__ bf16_t f2bf(float f) { unsigned u = __float_as_uint(f); u += 0x7FFFu + ((u >> 16) & 1u); return (bf16_t)(u >> 16); }
__device__ __forceinline__ int seq_of_row(int row) { return row < T_P ? (row >> 14) : 2 + ((row - T_P) >> 11); }
__device__ __forceinline__ int pos_of_row(int row) { return row < T_P ? (row & 16383) : (row & 2047); }
__device__ __forceinline__ float wave_sum(float v) {
#pragma unroll
    for (int o = 32; o >= 1; o >>= 1) v += __shfl_xor(v, o);
    return v;
}

struct EpiZinT {
    static constexpr bool PERM = true, AFTER_DRAIN = false;
    bf16_t* O; int ldc; const float* bias;
    __device__ __forceinline__ void operator()(const f32x4 (&acc)[2][2][4][2], const Unit& u, int wr, int wc, int fr, int fq) const {
        const int row0 = u.pm * 256 + wr * 64 + fr, col0 = u.pn * 256 + wc * 32 + 8 * fq;
        float bs[8];
#pragma unroll
        for (int r = 0; r < 8; ++r) bs[r] = bias[row0 + (r >> 2) * 128 + (r & 3) * 16];
#pragma unroll
        for (int ai = 0; ai < 2; ++ai)
#pragma unroll
            for (int m = 0; m < 4; ++m) { const int r = row0 + ai * 128 + m * 16; const float b = bs[ai * 4 + m]; bf16_t* rowp = O + (size_t)r * ldc + col0;
#pragma unroll
                for (int bj = 0; bj < 2; ++bj) { const f32x4 v0 = acc[ai][bj][m][0] + b, v1 = acc[ai][bj][m][1] + b;
                    u32x4 w; w.x = cvt_pk_bf16(v0[0], v0[1]); w.y = cvt_pk_bf16(v0[2], v0[3]); w.z = cvt_pk_bf16(v1[0], v1[1]); w.w = cvt_pk_bf16(v1[2], v1[3]);
                    *(u32x4*)(rowp + bj * 128) = w; } }
    }
};
struct EpiRes {
    static constexpr bool PERM = false, AFTER_DRAIN = false;
    bf16_t* X; const float* bias; const float* gate; int dry;
    __device__ __forceinline__ void operator()(const f32x4 (&acc)[2][2][4][2], const Unit& u, int wr, int wc, int fr, int fq) const {
        const int row0 = u.pm * 256 + wr * 64 + fr, col0 = u.pn * 256 + wc * 32 + 4 * fq;
        const float* gp = gate + (size_t)seq_of_row(u.pm * 256) * MODW + col0;
        bf16_t* xb = X + (size_t)row0 * 2048 + col0;
        u32x2 xv[2][8]; f32x4 gv[2], bv[2];
#pragma unroll
        for (int r = 0; r < 8; ++r) xv[0][r] = *(const u32x2*)(xb + (size_t)((r >> 2) * 128 + (r & 3) * 16) * 2048);
        gv[0] = *(const f32x4*)(gp); bv[0] = bias ? *(const f32x4*)(bias + col0) : (f32x4){0.f, 0.f, 0.f, 0.f};
#pragma unroll
        for (int cg = 0; cg < 4; ++cg) {
            const int bj = cg >> 1, n = cg & 1, coff = bj * 128 + n * 16;
            if (cg < 3) { const int c2 = ((cg + 1) >> 1) * 128 + ((cg + 1) & 1) * 16;
#pragma unroll
                for (int r = 0; r < 8; ++r) xv[(cg + 1) & 1][r] = *(const u32x2*)(xb + (size_t)((r >> 2) * 128 + (r & 3) * 16) * 2048 + c2);
                gv[(cg + 1) & 1] = *(const f32x4*)(gp + c2); bv[(cg + 1) & 1] = bias ? *(const f32x4*)(bias + col0 + c2) : (f32x4){0.f, 0.f, 0.f, 0.f}; }
#pragma unroll
            for (int r = 0; r < 8; ++r) { const u32x2 xo = xv[cg & 1][r];
                const f32x4 xf = {__uint_as_float(xo.x << 16), __uint_as_float(xo.x & 0xffff0000u), __uint_as_float(xo.y << 16), __uint_as_float(xo.y & 0xffff0000u)};
                const f32x4 x = xf + gv[cg & 1] * (acc[r >> 2][bj][r & 3][n] + bv[cg & 1]);
                u32x2 w; w.x = cvt_pk_bf16(x[0], x[1]); w.y = cvt_pk_bf16(x[2], x[3]);
                if (!dry) *(u32x2*)(xb + (size_t)((r >> 2) * 128 + (r & 3) * 16) * 2048 + coff) = w; }
        }
    }
};
struct EpiQKV {
    static constexpr bool PERM = true, AFTER_DRAIN = false;
    bf16_t* O; const cpx* rope;
    __device__ __forceinline__ void operator()(const f32x4 (&acc)[2][2][4][2], const Unit& u, int wr, int wc, int fr, int fq) const {
        const int row0 = u.pm * 256 + wr * 64 + fr, colt = u.pn * 256, col0 = colt + wc * 32 + 8 * fq;
        const int sidx = (colt % 3072) >> 10;
        const bool dorope = (sidx < 2) && (wc == 0);
        const float qs = (sidx == 0) ? QSCALE : 1.0f;
        f32x4 tt[2][4];
        if (dorope) { const cpx* rp = rope + (size_t)pos_of_row(row0) * 16 + 8 * (fq & 1);
            tt[0][0] = *(const f32x4*)(rp); tt[0][1] = *(const f32x4*)(rp + 2); tt[0][2] = *(const f32x4*)(rp + 4); tt[0][3] = *(const f32x4*)(rp + 6); }
#pragma unroll
        for (int g = 0; g < 8; ++g) { const int ai = g >> 2, m = g & 3; const int r = row0 + ai * 128 + m * 16; bf16_t* rowp = O + (size_t)r * QKVW + col0;
            f32x4 c0, c1, s0, s1;
            if (dorope) {
                if (g < 7) { const int r2 = row0 + ((g + 1) >> 2) * 128 + ((g + 1) & 3) * 16; const cpx* rp = rope + (size_t)pos_of_row(r2) * 16 + 8 * (fq & 1);
                    tt[(g + 1) & 1][0] = *(const f32x4*)(rp); tt[(g + 1) & 1][1] = *(const f32x4*)(rp + 2); tt[(g + 1) & 1][2] = *(const f32x4*)(rp + 4); tt[(g + 1) & 1][3] = *(const f32x4*)(rp + 6); }
                const f32x4 t0 = tt[g & 1][0], t1 = tt[g & 1][1], t2 = tt[g & 1][2], t3 = tt[g & 1][3];
                c0 = (f32x4){t0[0], t0[2], t1[0], t1[2]}; s0 = (f32x4){t0[1], t0[3], t1[1], t1[3]};
                c1 = (f32x4){t2[0], t2[2], t3[0], t3[2]}; s1 = (f32x4){t2[1], t2[3], t3[1], t3[3]}; }
#pragma unroll
            for (int bj = 0; bj < 2; ++bj) { f32x4 v0 = acc[ai][bj][m][0], v1 = acc[ai][bj][m][1];
                if (dorope) { f32x4 p0, p1;
#pragma unroll
                    for (int e = 0; e < 4; ++e) { p0[e] = __shfl_xor(v0[e], 32); p1[e] = __shfl_xor(v1[e], 32); }
                    if (fq < 2) { v0 = v0 * c0 - p0 * s0; v1 = v1 * c1 - p1 * s1; }
                    else        { v0 = v0 * c0 + p0 * s0; v1 = v1 * c1 + p1 * s1; } }
                v0 *= qs; v1 *= qs;
                u32x4 w; w.x = cvt_pk_bf16(v0[0], v0[1]); w.y = cvt_pk_bf16(v0[2], v0[3]); w.z = cvt_pk_bf16(v1[0], v1[1]); w.w = cvt_pk_bf16(v1[2], v1[3]);
                *(u32x4*)(rowp + bj * 128) = w; } }
    }
};
struct EpiFFN1 {
    static constexpr bool PERM = true, AFTER_DRAIN = false;
    bf16_t* O;
    __device__ __forceinline__ void operator()(const f32x4 (&acc)[2][2][4][2], const Unit& u, int wr, int wc, int fr, int fq) const {
        const int row0 = u.pm * 256 + wr * 64 + fr, col0 = u.pn * 128 + wc * 32 + 8 * fq;
#pragma unroll
        for (int ai = 0; ai < 2; ++ai)
#pragma unroll
            for (int m = 0; m < 4; ++m) { bf16_t* rowp = O + (size_t)(row0 + ai * 128 + m * 16) * DFF + col0; float o[8];
#pragma unroll
                for (int n = 0; n < 2; ++n)
#pragma unroll
                    for (int e = 0; e < 4; ++e) { const float g = acc[ai][0][m][n][e], up = acc[ai][1][m][n][e]; o[n * 4 + e] = g * __builtin_amdgcn_rcpf(1.0f + __expf(-g)) * up; }
                u32x4 w; w.x = cvt_pk_bf16(o[0], o[1]); w.y = cvt_pk_bf16(o[2], o[3]); w.z = cvt_pk_bf16(o[4], o[5]); w.w = cvt_pk_bf16(o[6], o[7]);
                *(u32x4*)rowp = w; }
    }
};
struct EpiTaps {
    static constexpr bool PERM = true, AFTER_DRAIN = false;
    _Float16* O;
    __device__ __forceinline__ void operator()(const f32x4 (&acc)[2][2][4][2], const Unit& u, int wr, int wc, int fr, int fq) const {
        typedef _Float16 h8 __attribute__((ext_vector_type(8)));
        const int row0 = u.pm * 256 + wr * 64 + fr, col0 = u.pn * 256 + wc * 32 + 8 * fq;
#pragma unroll
        for (int ai = 0; ai < 2; ++ai)
#pragma unroll
            for (int m = 0; m < 4; ++m) { _Float16* rowp = O + (size_t)(row0 + ai * 128 + m * 16) * NPOS + col0;
#pragma unroll
                for (int bj = 0; bj < 2; ++bj) { const f32x4 v0 = acc[ai][bj][m][0], v1 = acc[ai][bj][m][1]; h8 w;
                    w[0] = (_Float16)v0[0]; w[1] = (_Float16)v0[1]; w[2] = (_Float16)v0[2]; w[3] = (_Float16)v0[3]; w[4] = (_Float16)v1[0]; w[5] = (_Float16)v1[1]; w[6] = (_Float16)v1[2]; w[7] = (_Float16)v1[3];
                    *(h8*)(rowp + bj * 128) = w; } }
    }
};

__device__ __forceinline__ void ada_partials(const Params& p, LDSQ unsigned char* lds) {
    LDSQ float* cs = (LDSQ float*)lds;
    for (int i = pg8::otid(); i < 6 * 2048; i += NTHR) { const int b = i >> 11, k = i & 2047; const float c = b < 2 ? p.c_prompt[b * 2048 + k] : p.c_sample[(b - 2) * 2048 + k]; cs[i] = c / (1.0f + expf(-c)); }
    __syncthreads();
    float* part = (float*)(p.ws + WS_PART);
    for (int item = pg8::obid() * NTHR + pg8::otid(); item < 8 * 13312; item += pg8::ogrid() * NTHR) {
        const int chunk = item / 13312, c4 = item % 13312;
        const float* W; int ldw;
        if (c4 < 12288) { const int layer = c4 / 3072, col = (c4 % 3072) * 4; W = p.ada_w + (size_t)layer * 2048 * 12288 + col; ldw = 12288; }
        else { W = p.final_ada_w + (c4 - 12288) * 4; ldw = 4096; }
        f32x4 a0 = {0.f, 0.f, 0.f, 0.f}, a1 = a0, a2 = a0, a3 = a0, a4 = a0, a5 = a0;
        const int k0 = chunk * 256;
#pragma unroll 8
        for (int k = k0; k < k0 + 256; ++k) { const f32x4 w = *(const f32x4*)(W + (size_t)k * ldw);
            a0 += cs[k] * w; a1 += cs[2048 + k] * w; a2 += cs[4096 + k] * w; a3 += cs[6144 + k] * w; a4 += cs[8192 + k] * w; a5 += cs[10240 + k] * w; }
        float* o = part + (size_t)chunk * 6 * MODW + (size_t)c4 * 4;
        *(f32x4*)(o) = a0; *(f32x4*)(o + MODW) = a1; *(f32x4*)(o + 2 * MODW) = a2; *(f32x4*)(o + 3 * MODW) = a3; *(f32x4*)(o + 4 * MODW) = a4; *(f32x4*)(o + 5 * MODW) = a5;
    }
    __syncthreads();
}
__device__ __forceinline__ void ada_reduce(const Params& p) {
    const float* part = (const float*)(p.ws + WS_PART); float* mod = (float*)(p.ws + WS_MOD);
    for (int i = pg8::obid() * NTHR + pg8::otid(); i < 6 * MODW; i += pg8::ogrid() * NTHR) {
        const int c = i % MODW; float s = c < 49152 ? p.ada_b[c] : p.final_ada_b[c - 49152];
#pragma unroll
        for (int ch = 0; ch < 8; ++ch) s += part[(size_t)ch * 6 * MODW + i];
        mod[i] = s;
    }
}
__device__ __forceinline__ void rope_table(const Params& p) {
    cpx* rope = (cpx*)(p.ws + WS_ROPE);
    for (int i = pg8::obid() * NTHR + pg8::otid(); i < 16384 * 16; i += pg8::ogrid() * NTHR) {
        const int pos = i >> 4, f = i & 15; const float inv = powf(500000.0f, -(float)f / 16.0f); const float ang = (float)pos * inv;
        float s, c; sincosf(ang, &s, &c); rope[i] = mkc(c, s);
    }
}
__device__ __forceinline__ void filter_mlp(const Params& p) {
    const int lane = pg8::otid() & 63, gw = pg8::obid() * 8 + (pg8::otid() >> 6);
    bf16_t* a2x = (bf16_t*)(p.ws + WS_A2X);
    for (int q = gw; q < 2 * NPOS; q += pg8::ogrid() * 8) {
        const int j = q / NPOS, r = q % NPOS; const int L = r < 16384 ? 16384 : 2048, pos = r < 16384 ? r : r - 16384;
        const float fpos = (float)pos;
        float z = 0.f;
        if (lane == 0) z = fpos / (float)(L - 1);
        else if (lane <= 32) { const int bi = (lane - 1) & 15; const float band = 1e-4f + (float)bi * ((15.0f - 1e-4f) / 15.0f);
            const float ang = ((6.283185307179586f * fpos) * band) / (float)L; z = lane <= 16 ? cosf(ang) : -sinf(ang); }
        const float* w1 = p.hy_fw1 + j * 33 * 64; const float* w2 = p.hy_fw2 + j * 64 * 64;
        float acc = p.hy_fb1[j * 64 + lane];
#pragma unroll
        for (int m = 0; m < 33; ++m) acc += __shfl(z, m) * w1[m * 64 + lane];
        const float a1 = sinf(p.hy_ffreq[j * 128 + lane] * acc);
        acc = p.hy_fb2[j * 64 + lane];
#pragma unroll
        for (int m = 0; m < 64; ++m) acc += __shfl(a1, m) * w2[m * 64 + lane];
        const float a2 = sinf(p.hy_ffreq[j * 128 + 64 + lane] * acc);
        const bf16_t hi = f2bf(a2), lo = f2bf(a2 - bf2f(hi));
        bf16_t* o = a2x + ((size_t)j * NPOS + r) * 256;
        o[lane] = hi; o[64 + lane] = hi; o[128 + lane] = lo; o[192 + lane] = 0;
    }
    bf16_t* w3x = (bf16_t*)(p.ws + WS_W3X);
    for (int i = pg8::obid() * NTHR + pg8::otid(); i < 2 * 8192 * 64; i += pg8::ogrid() * NTHR) {
        const int k = i & 63, col = (i >> 6) & 8191, j = i >> 19;
        const float v = p.hy_fw3[(size_t)j * 64 * 8192 + (size_t)k * 8192 + col];
        const bf16_t hi = f2bf(v), lo = f2bf(v - bf2f(hi));
        bf16_t* o = w3x + ((size_t)j * 8192 + col) * 256;
        o[k] = hi; o[64 + k] = lo; o[128 + k] = hi; o[192 + k] = 0;
    }
}
__device__ __forceinline__ void convert_T(LDSQ unsigned char* lds, const float* src, int K, int N, bf16_t* dst, int ffs) {
    LDSQ float* tile = (LDSQ float*)lds;
    const int tid = pg8::otid(), ntn = N >> 8, ntiles = (K >> 6) * ntn, stride = pg8::ogrid();
    const int r = tid >> 6, c4 = tid & 63;
    f32x4 v[8];
    int ti = pg8::obid();
    if (ti < ntiles) { const int tk = ti / ntn, tn = ti % ntn;
#pragma unroll
        for (int it = 0; it < 8; ++it) v[it] = *(const f32x4*)(src + (size_t)(tk * 64 + r + 8 * it) * N + tn * 256 + 4 * c4); }
    for (; ti < ntiles; ti += stride) {
        const int tk = ti / ntn, tn = ti % ntn;
#pragma unroll
        for (int it = 0; it < 8; ++it) { LDSQ float* tp = tile + (r + 8 * it) * 257 + 4 * c4; tp[0] = v[it][0]; tp[1] = v[it][1]; tp[2] = v[it][2]; tp[3] = v[it][3]; }
        __syncthreads();
        if (ti + stride < ntiles) { const int t2 = ti + stride, tk2 = t2 / ntn, tn2 = t2 % ntn;
#pragma unroll
            for (int it = 0; it < 8; ++it) v[it] = *(const f32x4*)(src + (size_t)(tk2 * 64 + r + 8 * it) * N + tn2 * 256 + 4 * c4); }
        { const int n = tid >> 1, kh = tid & 1; const int nn = tn * 256 + n; const int row = ffs < 0 ? nn : (256 * (nn >> 7) + 128 * ffs + (nn & 127));
          bf16_t* dp = dst + (size_t)row * K + tk * 64 + kh * 32;
#pragma unroll
          for (int q = 0; q < 4; ++q) { float f[8];
#pragma unroll
              for (int e = 0; e < 8; ++e) f[e] = tile[(kh * 32 + q * 8 + e) * 257 + n];
              u32x4 w; w.x = cvt_pk_bf16(f[0], f[1]); w.y = cvt_pk_bf16(f[2], f[3]); w.z = cvt_pk_bf16(f[4], f[5]); w.w = cvt_pk_bf16(f[6], f[7]);
              *(u32x4*)(dp + q * 8) = w; } }
        __syncthreads();
    }
}
template <bool FINAL, bool SRC_F32> __device__ __forceinline__ void norm_rows(const float* xp, const float* xs, bf16_t* xb, const float* g, const float* modl, int sh_off, int sc_off, bf16_t* H, float* outf) {
    const int lane = pg8::otid() & 63, gw = pg8::obid() * 8 + (pg8::otid() >> 6), nw = pg8::ogrid() * 8;
    const int rpw = (T + nw - 1) / nw, r0 = gw * rpw, r1 = (r0 + rpw < T) ? r0 + rpw : T;
    if (r0 >= r1) return;
    f32x4 gs[8], sh[8]; int curseq = -1;
    f32x4 v[8], nx[8]; u32x2 nb[8];
    if (SRC_F32) { const f32x4* src = (const f32x4*)(r0 < T_P ? xp + (size_t)r0 * 2048 : xs + (size_t)(r0 - T_P) * 2048);
#pragma unroll
        for (int i = 0; i < 8; ++i) nx[i] = src[lane + 64 * i]; }
    else { const u32x2* src = (const u32x2*)(xb + (size_t)r0 * 2048);
#pragma unroll
        for (int i = 0; i < 8; ++i) nb[i] = src[lane + 64 * i]; }
    for (int row = r0; row < r1; ++row) {
#pragma unroll
        for (int i = 0; i < 8; ++i) { if (SRC_F32) v[i] = nx[i]; else v[i] = (f32x4){__uint_as_float(nb[i].x << 16), __uint_as_float(nb[i].x & 0xffff0000u), __uint_as_float(nb[i].y << 16), __uint_as_float(nb[i].y & 0xffff0000u)}; }
        if (row + 1 < r1) { const int rn = row + 1;
            if (SRC_F32) { const f32x4* src = (const f32x4*)(rn < T_P ? xp + (size_t)rn * 2048 : xs + (size_t)(rn - T_P) * 2048);
#pragma unroll
                for (int i = 0; i < 8; ++i) nx[i] = src[lane + 64 * i]; }
            else { const u32x2* src = (const u32x2*)(xb + (size_t)rn * 2048);
#pragma unroll
                for (int i = 0; i < 8; ++i) nb[i] = src[lane + 64 * i]; } }
        const int seq = seq_of_row(row);
        if (seq != curseq) { curseq = seq; const float* mod = modl + (size_t)seq * MODW;
#pragma unroll
            for (int i = 0; i < 8; ++i) { const int col = (lane + 64 * i) * 4; gs[i] = *(const f32x4*)(g + col) * (1.0f + *(const f32x4*)(mod + sc_off + col)); sh[i] = *(const f32x4*)(mod + sh_off + col); } }
        float ss = 0.f;
#pragma unroll
        for (int i = 0; i < 8; ++i) ss += v[i][0] * v[i][0] + v[i][1] * v[i][1] + v[i][2] * v[i][2] + v[i][3] * v[i][3];
        ss = wave_sum(ss);
        const float rstd = 1.0f / sqrtf(ss * (1.0f / 2048.0f) + EPS);
#pragma unroll
        for (int i = 0; i < 8; ++i) { const int col = (lane + 64 * i) * 4;
            const f32x4 h = (v[i] * rstd) * gs[i] + sh[i];
            if (FINAL) *(f32x4*)(outf + (size_t)row * 2048 + col) = h;
            else { u32x2 w; w.x = cvt_pk_bf16(h[0], h[1]); w.y = cvt_pk_bf16(h[2], h[3]); *(u32x2*)(H + (size_t)row * 2048 + col) = w;
                if (SRC_F32) { u32x2 c; c.x = cvt_pk_bf16(v[i][0], v[i][1]); c.y = cvt_pk_bf16(v[i][2], v[i][3]); *(u32x2*)(xb + (size_t)row * 2048 + col) = c; } } }
    }
}
__device__ __forceinline__ void final_norm_phase(const Params& p) {
    norm_rows<true, false>(nullptr, nullptr, (bf16_t*)(p.ws + WS_XB), p.final_norm, (const float*)(p.ws + WS_MOD) + 49152, 0, 2048, nullptr, p.out);
}
__device__ __forceinline__ void transpose_phase(const Params& p, LDSQ unsigned char* lds) {
    LDSQ bf16_t* tile = (LDSQ bf16_t*)lds;
    const bf16_t* zin = (const bf16_t*)(p.ws + WS_BIG + BIG_ZINT); bf16_t* H = (bf16_t*)(p.ws + WS_H);
    const int tid = pg8::otid(), stride = pg8::ogrid();
    const int cr = tid >> 5, tq = tid & 31;
    u32x4 v[4];
    int ti = pg8::obid();
    if (ti < 32 * 160) { const int tc = ti / 160, tt = ti % 160;
#pragma unroll
        for (int it = 0; it < 4; ++it) v[it] = *(const u32x4*)(zin + (size_t)(tc * 64 + cr + 16 * it) * T + tt * 256 + tq * 8); }
    for (; ti < 32 * 160; ti += stride) {
        const int tc = ti / 160, tt = ti % 160;
#pragma unroll
        for (int it = 0; it < 4; ++it) *(LDSQ u32x4*)(tile + (cr + 16 * it) * 264 + tq * 8) = v[it];
        __syncthreads();
        if (ti + stride < 32 * 160) { const int t2 = ti + stride, tc2 = t2 / 160, tt2 = t2 % 160;
#pragma unroll
            for (int it = 0; it < 4; ++it) v[it] = *(const u32x4*)(zin + (size_t)(tc2 * 64 + cr + 16 * it) * T + tt2 * 256 + tq * 8); }
        { const int cq = tid & 7, tk = tid >> 3;
#pragma unroll
          for (int it = 0; it < 4; ++it) { const int tok = tk + 64 * it; unsigned w[4];
#pragma unroll
              for (int e = 0; e < 4; ++e) { const unsigned lo = tile[(cq * 8 + 2 * e) * 264 + tok], hi = tile[(cq * 8 + 2 * e + 1) * 264 + tok]; w[e] = lo | (hi << 16); }
              *(u32x4*)(H + (size_t)(tt * 256 + tok) * 2048 + tc * 64 + cq * 8) = (u32x4){w[0], w[1], w[2], w[3]}; } }
        __syncthreads();
    }
}

__host__ __device__ constexpr float cos64q(int k) {
    constexpr float t[17] = {1.0f, 0.99518472667219693f, 0.98078528040323043f, 0.95694033573220882f, 0.92387953251128674f, 0.88192126434835505f, 0.83146961230254524f,
        0.77301045336273699f, 0.70710678118654757f, 0.63439328416364549f, 0.55557023301960229f, 0.47139673682599781f, 0.38268343236508984f, 0.29028467725446233f,
        0.19509032201612833f, 0.09801714032956077f, 0.0f};
    return t[k];
}
__host__ __device__ constexpr float cos64(int k) { k &= 63; return k <= 16 ? cos64q(k) : k <= 32 ? -cos64q(32 - k) : k <= 48 ? -cos64q(k - 32) : cos64q(64 - k); }
__host__ __device__ constexpr float sin64(int k) { return cos64((k + 48) & 63); }
template <int R> __host__ __device__ constexpr int brev(int k) { int r = 0; for (int b = 1; b < R; b <<= 1) { r = (r << 1) | (k & 1); k >>= 1; } return r; }

typedef _Float16 hcpx __attribute__((ext_vector_type(2)));
typedef _Float16 hcpx2 __attribute__((ext_vector_type(4)));
__device__ __forceinline__ hcpx h_of(cpx a) { hcpx r; r.x = (_Float16)a.x; r.y = (_Float16)a.y; return r; }
__device__ __forceinline__ cpx c_of(hcpx a) { return mkc((float)a.x, (float)a.y); }
__device__ __forceinline__ hcpx2 h2_of(cpx a, cpx b) { hcpx2 r; r.x = (_Float16)a.x; r.y = (_Float16)a.y; r.z = (_Float16)b.x; r.w = (_Float16)b.y; return r; }
#define VA __device__ __forceinline__ float
VA f_mul(float a, float b) { float r; asm("v_mul_f32_e32 %0, %1, %2" : "=v"(r) : "v"(a), "v"(b)); return r; }
VA f_fma(float a, float b, float c) { float r; asm("v_fma_f32 %0, %1, %2, %3" : "=v"(r) : "v"(a), "v"(b), "v"(c)); return r; }
VA f_fms(float a, float b, float c) { float r; asm("v_fma_f32 %0, %1, %2, -%3" : "=v"(r) : "v"(a), "v"(b), "v"(c)); return r; }
#undef VA
__device__ __forceinline__ cpx cmul(cpx a, cpx b) { float rx, ry;
    asm("v_mul_f32_e32 %0, %3, %5\n\tv_mul_f32_e32 %1, %3, %4\n\tv_fma_f32 %0, %2, %4, -%0\n\tv_fma_f32 %1, %2, %5, %1" : "=&v"(rx), "=&v"(ry) : "v"(a.x), "v"(a.y), "v"(b.x), "v"(b.y)); return mkc(rx, ry); }
__device__ __forceinline__ cpx cmulc(cpx a, cpx b) { float rx, ry;
    asm("v_mul_f32_e32 %0, %3, %5\n\tv_mul_f32_e32 %1, %2, %5\n\tv_fma_f32 %0, %2, %4, %0\n\tv_fma_f32 %1, %3, %4, -%1" : "=&v"(rx), "=&v"(ry) : "v"(a.x), "v"(a.y), "v"(b.x), "v"(b.y)); return mkc(rx, ry); }

template <int R, bool INV, int H, int P> __device__ __forceinline__ void bfly(cpx (&v)[R]) {
    constexpr int b = (P / H) * 2 * H, i = P % H, e = i * (32 / H);
    float ux = v[b + i].x, uy = v[b + i].y, wx = v[b + i + H].x, wy = v[b + i + H].y;
    if constexpr (e == 0) { float dx, dy;
        asm("v_sub_f32_e32 %2, %0, %4\n\tv_sub_f32_e32 %3, %1, %5\n\tv_add_f32_e32 %0, %0, %4\n\tv_add_f32_e32 %1, %1, %5" : "+v"(ux), "+v"(uy), "=&v"(dx), "=&v"(dy) : "v"(wx), "v"(wy));
        wx = dx; wy = dy; }
    else if constexpr (e == 16) { float ox, oy;
        if constexpr (!INV) asm("v_sub_f32_e32 %2, %1, %5\n\tv_sub_f32_e32 %3, %4, %0\n\tv_add_f32_e32 %0, %0, %4\n\tv_add_f32_e32 %1, %1, %5" : "+v"(ux), "+v"(uy), "=&v"(ox), "=&v"(oy) : "v"(wx), "v"(wy));
        else                asm("v_sub_f32_e32 %2, %5, %1\n\tv_sub_f32_e32 %3, %0, %4\n\tv_add_f32_e32 %0, %0, %4\n\tv_add_f32_e32 %1, %1, %5" : "+v"(ux), "+v"(uy), "=&v"(ox), "=&v"(oy) : "v"(wx), "v"(wy));
        wx = ox; wy = oy; }
    else { constexpr float c = cos64(e), s = INV ? sin64(e) : -sin64(e);
        constexpr unsigned cb = __builtin_bit_cast(unsigned, c), sb = __builtin_bit_cast(unsigned, s), nsb = __builtin_bit_cast(unsigned, -s);
        float dx, dy;
        asm("v_sub_f32_e32 %4, %0, %2\n\tv_sub_f32_e32 %5, %1, %3\n\tv_add_f32_e32 %0, %0, %2\n\tv_add_f32_e32 %1, %1, %3\n\t"
            "v_mul_f32_e32 %2, %8, %5\n\tv_mul_f32_e32 %3, %6, %5\n\tv_fmamk_f32 %2, %4, %6, %2\n\tv_fmamk_f32 %3, %4, %7, %3"
            : "+v"(ux), "+v"(uy), "+v"(wx), "+v"(wy), "=&v"(dx), "=&v"(dy) : "i"(cb), "i"(sb), "i"(nsb)); }
    v[b + i] = mkc(ux, uy); v[b + i + H] = mkc(wx, wy);
}
template <int R, bool INV, int H, int... Ps> __device__ __forceinline__ void dft_stage(cpx (&v)[R], std::integer_sequence<int, Ps...>) { (bfly<R, INV, H, Ps>(v), ...); }
template <int R, bool INV, int H> __device__ __forceinline__ void dft_stages(cpx (&v)[R]) {
    dft_stage<R, INV, H>(v, std::make_integer_sequence<int, R / 2>{});
    if constexpr (H > 1) dft_stages<R, INV, H / 2>(v);
}
template <int R, bool INV> __device__ __forceinline__ void dft_r2(cpx (&v)[R]) { dft_stages<R, INV, R / 2>(v); }
template <int R, bool CONJ, bool BREV> __device__ __forceinline__ void apply_pows(cpx (&v)[R], cpx w) {
    constexpr int H = R > 16 ? 16 : R;
    cpx pw[H];
    pw[1] = w;
#pragma unroll
    for (int k = 2; k < H; ++k) pw[k] = (k & 1) ? cmul(pw[k - 1], w) : cmul(pw[k / 2], pw[k / 2]);
#pragma unroll
    for (int k = 1; k < H; ++k) { const int idx = BREV ? brev<R>(k) : k; v[idx] = CONJ ? cmulc(v[idx], pw[k]) : cmul(v[idx], pw[k]); }
    if (R > 16) {
        const cpx w16 = cmul(pw[8], pw[8]);
#pragma unroll
        for (int k = 0; k < R - 16; ++k) { const cpx q = k == 0 ? w16 : cmul(pw[k], w16); const int idx = BREV ? brev<R>(16 + k) : 16 + k; v[idx] = CONJ ? cmulc(v[idx], q) : cmul(v[idx], q); }
    }
}
__device__ __forceinline__ int phys(int i) { return i + (i >> 5); }
constexpr int TW_OFF = 135168 + 64;
template <int S> __host__ __device__ constexpr int poff(int j) { return S >= 32 ? j * (S + S / 32) : j * S + ((j * S) >> 5); }
typedef hcpx PreRegs[32];
template <int R, int S> __device__ __forceinline__ void fft_prefetch(int t, const hcpx* gio, PreRegs& pre) {
    constexpr int G = 32 / R;
#pragma unroll
    for (int gi = 0; gi < G; ++gi) { const int gam = gi * 512 + t, hi = gam / S, lo = gam % S, base = hi * (R * S) + lo;
#pragma unroll
        for (int j = 0; j < R; ++j) pre[gi * R + j] = __builtin_nontemporal_load(gio + base + j * S); }
}
template <int R, int S, bool INV, int IO> __device__ __forceinline__ void fft_pass(LDSQ cpx* A, int t, hcpx* gio, const PreRegs& pre) {
    constexpr int G = 32 / R;
    asm volatile("" : "+v"(t) :: "memory");
    const LDSQ cpx* TW = (const LDSQ cpx*)((LDSQ unsigned char*)A + TW_OFF);
    cpx v[G][R]; cpx tw[G];
#pragma unroll
    for (int gi = 0; gi < G; ++gi) {
        const int gam = gi * 512 + t, hi = gam / S, lo = gam % S, base = hi * (R * S) + lo; const LDSQ cpx* Ab = A + phys(base);
#pragma unroll
        for (int j = 0; j < R; ++j) v[gi][j] = (IO == 3) ? c_of(pre[gi * R + j]) : (IO == 1) ? c_of(__builtin_nontemporal_load(gio + base + j * S)) : Ab[poff<S>(j)];
        tw[gi] = TW[lo * (16384 / (R * S))];
    }
#pragma unroll
    for (int gi = 0; gi < G; ++gi) {
        const int gam = gi * 512 + t, hi = gam / S, lo = gam % S, base = hi * (R * S) + lo; LDSQ cpx* Ab = A + phys(base);
        if (!INV) {
            dft_r2<R, false>(v[gi]);
            apply_pows<R, false, true>(v[gi], tw[gi]);
#pragma unroll
            for (int k = 0; k < R; ++k) { if (IO == 2) gio[base + k * S] = h_of(v[gi][brev<R>(k)]); else Ab[poff<S>(k)] = v[gi][brev<R>(k)]; }
        } else {
            apply_pows<R, true, false>(v[gi], tw[gi]);
            dft_r2<R, true>(v[gi]);
#pragma unroll
            for (int j = 0; j < R; ++j) { if (IO == 2) gio[base + j * S] = h_of(v[gi][brev<R>(j)]); else Ab[poff<S>(j)] = v[gi][brev<R>(j)]; }
        }
    }
}
template <int R, int MODE> __device__ __forceinline__ void fft_mid(LDSQ cpx* A, int t, hcpx* spec, float scale) {
    constexpr int G = 32 / R;
    asm volatile("" : "+v"(t) :: "memory");
    hcpx2 sp[G][R / 2];
    if (MODE == 1) {
#pragma unroll
        for (int gi = 0; gi < G; ++gi)
#pragma unroll
            for (int k2 = 0; k2 < R / 2; ++k2) sp[gi][k2] = *(const hcpx2*)(spec + (size_t)(gi * 512 + t) * R + 2 * k2);
    }
#pragma unroll
    for (int gi = 0; gi < G; ++gi) {
        const int gam = gi * 512 + t, base = gam * R;
        cpx v[R];
        LDSQ cpx* Ab = A + phys(base);
#pragma unroll
        for (int j = 0; j < R; ++j) v[j] = Ab[j];
        dft_r2<R, false>(v);
        if (MODE == 0) {
#pragma unroll
            for (int k2 = 0; k2 < R / 2; ++k2) { const cpx x = v[brev<R>(2 * k2)], y = v[brev<R>(2 * k2 + 1)];
                *(hcpx2*)(spec + (size_t)base + 2 * k2) = h2_of(mkc(x.x * scale, x.y * scale), mkc(y.x * scale, y.y * scale)); }
        } else {
            cpx x[R];
#pragma unroll
            for (int k2 = 0; k2 < R / 2; ++k2) { const hcpx2 s = sp[gi][k2]; x[2 * k2] = cmul(v[brev<R>(2 * k2)], mkc((float)s.x * scale, (float)s.y * scale)); x[2 * k2 + 1] = cmul(v[brev<R>(2 * k2 + 1)], mkc((float)s.z * scale, (float)s.w * scale)); }
            dft_r2<R, true>(x);
#pragma unroll
            for (int j = 0; j < R; ++j) Ab[j] = x[brev<R>(j)];
        }
    }
}
#define GL_DRAIN() asm volatile("s_waitcnt vmcnt(0)" ::: "memory")
struct NoHook { __device__ __forceinline__ void operator()() const {} };
template <int LOG2L, bool INV, int GIO, class Hook = NoHook> __device__ __forceinline__ void fft_outer(LDSQ cpx* A, int t, hcpx* gio, const hcpx* pfsrc, PreRegs& pre, Hook hook = Hook()) {
    constexpr int R1 = LOG2L == 14 ? 32 : 16, S1 = LOG2L == 14 ? 512 : 128, S2 = LOG2L == 14 ? 16 : 8;
    if (!INV) { fft_pass<R1, S1, false, GIO == 3 ? 3 : 0>(A, t, nullptr, pre); __syncthreads(); fft_pass<R1, S2, false, 0>(A, t, nullptr, pre); __syncthreads(); }
    else      { fft_pass<R1, S2, true, 0>(A, t, nullptr, pre); __syncthreads();
                if (GIO == 2) fft_prefetch<R1, S1>(t, pfsrc, pre);
                hook();
                fft_pass<R1, S1, true, GIO == 2 ? 2 : 0>(A, t, gio, pre); if (GIO != 2) GL_DRAIN(); __syncthreads(); }
}
template <int LOG2L, int SRC, int DST, class Hook = NoHook> __device__ __forceinline__ void fft_conv(LDSQ cpx* A, int t, hcpx* spec, hcpx* gdst, const hcpx* pfsrc, PreRegs& pre, Hook hook = Hook()) {
    fft_outer<LOG2L, false, SRC>(A, t, nullptr, nullptr, pre);
    fft_mid<LOG2L == 14 ? 16 : 8, 1>(A, t, spec, 1.0f / (float)(1 << LOG2L));
    if (SRC == 3) GL_DRAIN();
    __syncthreads();
    fft_outer<LOG2L, true, DST>(A, t, gdst, pfsrc, pre, hook);
}

__device__ __forceinline__ void sconv4r(u32x2 q, unsigned zmr, unsigned zpr, float w0, float w1, float w2, float bb, float (&o)[4]) {
    const float zm = __uint_as_float(zmr << 16), zp = __uint_as_float(zpr << 16);
    const float z0 = __uint_as_float(q.x << 16), z1 = __uint_as_float(q.x & 0xffff0000u), z2 = __uint_as_float(q.y << 16), z3 = __uint_as_float(q.y & 0xffff0000u);
    o[0] = w0 * zm + w1 * z0 + w2 * z1 + bb; o[1] = w0 * z0 + w1 * z1 + w2 * z2 + bb; o[2] = w0 * z1 + w1 * z2 + w2 * z3 + bb; o[3] = w0 * z2 + w1 * z3 + w2 * zp + bb;
}
typedef _Float16 h4 __attribute__((ext_vector_type(4)));
__device__ __forceinline__ void tapquad(h4 a, h4 bq, unsigned b0bits, float wf, float wb, float rf1, float rf2, float rf3, float rb1, float rb2, float rb3, float (&fa)[4], float (&fb)[4]) {
    const float b0 = (float)__builtin_bit_cast(_Float16, (unsigned short)b0bits);
    fa[0] = (float)a.x * wf; fa[1] = (float)a.y * (wf * rf1); fa[2] = (float)a.z * (wf * rf2); fa[3] = (float)a.w * (wf * rf3);
    fb[0] = b0 * wb; fb[1] = (float)bq.w * (wb * rb1); fb[2] = (float)bq.z * (wb * rb2); fb[3] = (float)bq.y * (wb * rb3);
}
template <int LOG2L> struct SweepIdx {
    static constexpr int L = 1 << LOG2L, QS = L / 32;
    int t, seq, n00, a00; cpx wq0, w1, w2, w3;
    __device__ __forceinline__ SweepIdx(int t_, bool need_w) { t = t_; asm volatile("" : "+v"(t) :: "memory"); seq = (LOG2L == 14) ? 0 : (t >> 6); const int q0 = (LOG2L == 14) ? t : (t & 63); n00 = 4 * q0; a00 = seq * L + n00;
        if (need_w) { float sb, cb; sincospif(-(float)n00 / (float)L, &sb, &cb); wq0 = mkc(cb, sb);
            sincospif(-1.0f / (float)L, &sb, &cb); w1 = mkc(cb, sb); w2 = cmul(w1, w1); w3 = cmul(w2, w1); } }
};
#define WQS mkc(0.92387953251128674f, -0.38268343236508978f)
struct TapWin { float wf0, wfs, rf1, rf2, rf3, wb0, wbs, rb1, rb2, rb3; };
template <int LOG2L> __device__ __forceinline__ TapWin tap_windows(float df, float db, int n00) {
    constexpr int L = 1 << LOG2L, QS = L / 32; TapWin w;
    w.wf0 = expf(-df * (float)n00); w.wfs = expf(-df * (float)(4 * QS)); w.rf1 = expf(-df); w.rf2 = w.rf1 * w.rf1; w.rf3 = w.rf2 * w.rf1;
    w.wb0 = expf(-db * (float)(L - n00)); w.wbs = expf(db * (float)(4 * QS)); w.rb1 = expf(db); w.rb2 = w.rb1 * w.rb1; w.rb3 = w.rb2 * w.rb1; return w;
}
template <int LOG2L> __device__ __forceinline__ void sweep_taps2(LDSQ cpx* A, int t_, const _Float16* tf0, const _Float16* tb0, const _Float16* tf1, const _Float16* tb1, float df0, float db0, float df1, float db1, hcpx* hos, float& ss0, float& ss1) {
    constexpr int L = 1 << LOG2L, QS = L / 32; const SweepIdx<LOG2L> X(t_, true);
    const TapWin W0 = tap_windows<LOG2L>(df0, db0, X.n00), W1 = tap_windows<LOG2L>(df1, db1, X.n00);
    float s0 = 0.f, s1 = 0.f, wf0 = W0.wf0, wb0 = W0.wb0, wf1 = W1.wf0, wb1 = W1.wb0;
    cpx wn = X.wq0;
    h4 ra0[8], rb0[8], ra1[8], rb1[8]; unsigned rc0[8], rc1[8];
#pragma unroll
    for (int i = 0; i < 8; ++i) { const int n = 4 * (i * QS) + X.n00, nb = n > 0 ? L - n : L - 1;
        ra0[i] = *(const h4*)(tf0 + n); rb0[i] = *(const h4*)(tb0 + L - n - 4); rc0[i] = ((const unsigned short*)tb0)[nb];
        ra1[i] = *(const h4*)(tf1 + n); rb1[i] = *(const h4*)(tb1 + L - n - 4); rc1[i] = ((const unsigned short*)tb1)[nb]; }
#pragma unroll
    for (int i = 0; i < 8; ++i) { const int n = 4 * (i * QS) + X.n00; float fa0[4], fb0[4], fa1[4], fb1[4]; const unsigned hm = n > 0 ? 0xffffu : 0u;
        tapquad(ra0[i], rb0[i], rc0[i] & hm, wf0, wb0, W0.rf1, W0.rf2, W0.rf3, W0.rb1, W0.rb2, W0.rb3, fa0, fb0);
        tapquad(ra1[i], rb1[i], rc1[i] & hm, wf1, wb1, W1.rf1, W1.rf2, W1.rf3, W1.rb1, W1.rb2, W1.rb3, fa1, fb1);
        LDSQ cpx* ap = A + phys(X.a00 + 4 * i * QS); hcpx* hp = hos + X.a00 + 4 * i * QS;
#pragma unroll
        for (int e = 0; e < 4; ++e) { s0 += fa0[e] * fa0[e] + fb0[e] * fb0[e]; s1 += fa1[e] * fa1[e] + fb1[e] * fb1[e]; ap[e] = mkc(fa0[e] + fb0[e], fa1[e] + fb1[e]); }
        const cpx wa = cmul(wn, X.w1), wb2 = cmul(wn, X.w2), wc = cmul(wn, X.w3);
        const cpx y0 = cmul(mkc(fa0[0] - fb0[0], fa1[0] - fb1[0]), wn), y1 = cmul(mkc(fa0[1] - fb0[1], fa1[1] - fb1[1]), wa);
        const cpx y2 = cmul(mkc(fa0[2] - fb0[2], fa1[2] - fb1[2]), wb2), y3 = cmul(mkc(fa0[3] - fb0[3], fa1[3] - fb1[3]), wc);
        *(hcpx2*)hp = h2_of(y0, y1); *(hcpx2*)(hp + 2) = h2_of(y2, y3);
        wn = cmul(wn, WQS); wf0 *= W0.wfs; wb0 *= W0.wbs; wf1 *= W1.wfs; wb1 *= W1.wbs; }
    ss0 = s0; ss1 = s1;
}
template <int LOG2L, int PART> __device__ __forceinline__ void fft_mid_sep(LDSQ cpx* A, int t, hcpx* spec0, hcpx* spec1, const LDSQ float* red, const float* skp0, const float* skp1) {
    constexpr int R = LOG2L == 14 ? 16 : 8, G = 32 / R, NB = LOG2L == 14 ? 32 : 16, NG = NB * NB;
    asm volatile("" : "+v"(t) :: "memory");
#pragma unroll
    for (int gi = 0; gi < G; ++gi) {
        cpx v[R]; LDSQ cpx* Ab = A + phys((gi * 512 + t) * R);
#pragma unroll
        for (int j = 0; j < R; ++j) v[j] = Ab[j];
        dft_r2<R, false>(v);
#pragma unroll
        for (int k = 0; k < R; ++k) Ab[k] = v[brev<R>(k)];
    }
    __syncthreads();
#pragma unroll
    for (int gi = 0; gi < G; ++gi) {
        const int gam = gi * 512 + t, seq = gam / NG, g = gam % NG, k1 = g / NB, k2 = g % NB;
        const int gp = PART == 1 ? NG - 1 - g : (k1 ? (NB - k1) * NB + (NB - 1 - k2) : (k2 ? NB - k2 : 0));
        const bool wrap = PART == 0 && g == 0;
        const LDSQ cpx* Ab = A + phys(gam * R); const LDSQ cpx* Ap = A + phys((seq * NG + gp) * R);
        cpx z[R], q[R];
#pragma unroll
        for (int k = 0; k < R; ++k) { z[k] = Ab[k]; q[k] = Ap[k]; }
        float ss0, ss1;
        if (LOG2L == 14) { ss0 = red[0] + red[1] + red[2] + red[3] + red[4] + red[5] + red[6] + red[7]; ss1 = red[8] + red[9] + red[10] + red[11] + red[12] + red[13] + red[14] + red[15]; }
        else { ss0 = red[seq]; ss1 = red[8 + seq]; }
        const float n0 = 0.25f / sqrtf(ss0 + EPS), n1 = 0.25f / sqrtf(ss1 + EPS), h0 = 0.5f * skp0[seq], h1 = 0.5f * skp1[seq];
        hcpx* s0p = spec0 + (size_t)gam * R; hcpx* s1p = spec1 + (size_t)gam * R;
#pragma unroll
        for (int k2_ = 0; k2_ < R / 2; ++k2_) { cpx o0[2], o1[2];
#pragma unroll
            for (int e = 0; e < 2; ++e) { const int k = 2 * k2_ + e; cpx zp = q[R - 1 - k]; const cpx zw = q[(R - k) & (R - 1)];
                if (PART == 0) { zp.x = wrap ? zw.x : zp.x; zp.y = wrap ? zw.y : zp.y; }
                o0[e] = mkc((z[k].x + zp.x) * n0 + h0, (z[k].y - zp.y) * n0); o1[e] = mkc((z[k].y + zp.y) * n1 + h1, (zp.x - z[k].x) * n1); }
            *(hcpx2*)(s0p + 2 * k2_) = h2_of(o0[0], o0[1]); *(hcpx2*)(s1p + 2 * k2_) = h2_of(o1[0], o1[1]); }
    }
}
template <int LOG2L> __device__ __forceinline__ void sweep_load_v(LDSQ cpx* A, int t_, const bf16_t* zrow, size_t tb0, const float* cw, const float* cbias, int rc0, hcpx* xw) {
    constexpr int L = 1 << LOG2L, QS = L / 32; const SweepIdx<LOG2L> X(t_, true);
    const int rc = rc0 + X.seq; const float cw0 = cw[rc], cw1 = cw[6144 + rc], cw2 = cw[2 * 6144 + rc], bb = cbias[rc];
    const bf16_t* z0 = zrow + (size_t)rc * T + tb0; const bf16_t* z1 = z0 + L;
    cpx wn = X.wq0;
    u32x2 rq[8][2]; unsigned rm[8][2], rp[8][2];
#pragma unroll
    for (int i = 0; i < 8; ++i) { const int n = 4 * (i * QS) + X.n00, nm = n > 0 ? n - 1 : 0, np = n + 4 < L ? n + 4 : L - 1;
        rq[i][0] = *(const u32x2*)(z0 + n); rq[i][1] = *(const u32x2*)(z1 + n); rm[i][0] = z0[nm]; rm[i][1] = z1[nm]; rp[i][0] = z0[np]; rp[i][1] = z1[np]; }
#pragma unroll
    for (int i = 0; i < 8; ++i) { const int n = 4 * (i * QS) + X.n00; float xa[4], xb[4]; const unsigned hm = n > 0 ? 0xffffu : 0u, hp = n + 4 < L ? 0xffffu : 0u;
        sconv4r(rq[i][0], rm[i][0] & hm, rp[i][0] & hp, cw0, cw1, cw2, bb, xa); sconv4r(rq[i][1], rm[i][1] & hm, rp[i][1] & hp, cw0, cw1, cw2, bb, xb);
        LDSQ cpx* ap = A + phys(X.a00 + 4 * i * QS); hcpx* xp = xw + X.a00 + 4 * i * QS;
        ap[0] = mkc(xa[0], xb[0]); ap[1] = mkc(xa[1], xb[1]); ap[2] = mkc(xa[2], xb[2]); ap[3] = mkc(xa[3], xb[3]);
        const cpx y0 = cmul(mkc(xa[0], xb[0]), wn), y1 = cmul(mkc(xa[1], xb[1]), cmul(wn, X.w1)), y2 = cmul(mkc(xa[2], xb[2]), cmul(wn, X.w2)), y3 = cmul(mkc(xa[3], xb[3]), cmul(wn, X.w3));
        *(hcpx2*)xp = h2_of(y0, y1); *(hcpx2*)(xp + 2) = h2_of(y2, y3);
        wn = cmul(wn, WQS); }
}
constexpr int CPA = 2;
template <int N> struct CombPreN { u32x2 q[N][2]; unsigned zm[N][2], zp[N][2]; hcpx2 h01[N], h23[N]; };
typedef CombPreN<CPA> CombPre;
template <int LOG2L, int I0, int N> __device__ __forceinline__ void combine_prefetch(int t_, const hcpx* yes, const bf16_t* zrow, size_t tb0, int rg0, CombPreN<N>& P) {
    constexpr int L = 1 << LOG2L, QS = L / 32; const SweepIdx<LOG2L> X(t_, false);
    const int rg = rg0 + X.seq; const bf16_t* g0 = zrow + (size_t)rg * T + tb0; const bf16_t* g1 = g0 + L;
#pragma unroll
    for (int i = 0; i < N; ++i) { const int n = 4 * ((I0 + i) * QS) + X.n00; const hcpx* yp = yes + X.a00 + 4 * (I0 + i) * QS;
        P.q[i][0] = *(const u32x2*)(g0 + n); P.q[i][1] = *(const u32x2*)(g1 + n);
        const int nm = n > 0 ? n - 1 : 0, np = n + 4 < L ? n + 4 : L - 1;
        P.zm[i][0] = g0[nm]; P.zm[i][1] = g1[nm]; P.zp[i][0] = g0[np]; P.zp[i][1] = g1[np];
        P.h01[i] = __builtin_nontemporal_load((const hcpx2*)yp); P.h23[i] = __builtin_nontemporal_load((const hcpx2*)(yp + 2)); }
}
template <int LOG2L, int FINAL> __device__ __forceinline__ void sweep_combine(LDSQ cpx* A, int t_, const CombPre& P0, const hcpx* yes, hcpx* xw, bf16_t* zrow, size_t tb0, const float* cw, const float* cbias, int rg0, int ro0, int dry) {
    constexpr int L = 1 << LOG2L, QS = L / 32; const SweepIdx<LOG2L> X(t_, true);
    CombPreN<8 - CPA> P1; combine_prefetch<LOG2L, CPA>(X.t, yes, zrow, tb0, rg0, P1);
    const int rg = rg0 + X.seq; const float cw0 = cw[rg], cw1 = cw[6144 + rg], cw2 = cw[2 * 6144 + rg], bb = cbias[rg];
    bf16_t* o0 = zrow + (size_t)(ro0 + X.seq) * T + tb0; bf16_t* o1 = o0 + L;
    cpx wn = X.wq0;
#pragma unroll
    for (int i = 0; i < 8; ++i) { const int n = 4 * (i * QS) + X.n00; float ga[4], gb[4];
        const bool ah = i < CPA; const int ia = ah ? i : 0, ib = ah ? 0 : i - CPA;
        const unsigned hm = n > 0 ? 0xffffu : 0u, hp = n + 4 < L ? 0xffffu : 0u;
        sconv4r(ah ? P0.q[ia][0] : P1.q[ib][0], (ah ? P0.zm[ia][0] : P1.zm[ib][0]) & hm, (ah ? P0.zp[ia][0] : P1.zp[ib][0]) & hp, cw0, cw1, cw2, bb, ga);
        sconv4r(ah ? P0.q[ia][1] : P1.q[ib][1], (ah ? P0.zm[ia][1] : P1.zm[ib][1]) & hm, (ah ? P0.zp[ia][1] : P1.zp[ib][1]) & hp, cw0, cw1, cw2, bb, gb);
        const LDSQ cpx* ap = A + phys(X.a00 + 4 * i * QS);
        const hcpx2 h01 = ah ? P0.h01[ia] : P1.h01[ib], h23 = ah ? P0.h23[ia] : P1.h23[ib];
        const f32x4 e01 = {(float)h01.x, (float)h01.y, (float)h01.z, (float)h01.w}, e23 = {(float)h23.x, (float)h23.y, (float)h23.z, (float)h23.w};
        const cpx wa = cmul(wn, X.w1), wb2 = cmul(wn, X.w2), wc = cmul(wn, X.w3);
        const cpx r0 = cmulc(ap[0], wn), r1 = cmulc(ap[1], wa), r2 = cmulc(ap[2], wb2), r3 = cmulc(ap[3], wc);
        const cpx s0 = mkc(ga[0] * (e01[0] + r0.x), gb[0] * (e01[1] + r0.y)), s1 = mkc(ga[1] * (e01[2] + r1.x), gb[1] * (e01[3] + r1.y));
        const cpx s2 = mkc(ga[2] * (e23[0] + r2.x), gb[2] * (e23[1] + r2.y)), s3 = mkc(ga[3] * (e23[2] + r3.x), gb[3] * (e23[3] + r3.y));
        if (FINAL == 0) { LDSQ cpx* aw = A + phys(X.a00 + 4 * i * QS); hcpx* xp = xw + X.a00 + 4 * i * QS;
            aw[0] = s0; aw[1] = s1; aw[2] = s2; aw[3] = s3;
            const cpx y0 = cmul(s0, wn), y1 = cmul(s1, wa), y2 = cmul(s2, wb2), y3 = cmul(s3, wc);
            *(hcpx2*)xp = h2_of(y0, y1); *(hcpx2*)(xp + 2) = h2_of(y2, y3); }
        else if (!dry) { u32x2 wa2, wb3; wa2.x = cvt_pk_bf16(s0.x, s1.x); wa2.y = cvt_pk_bf16(s2.x, s3.x); wb3.x = cvt_pk_bf16(s0.y, s1.y); wb3.y = cvt_pk_bf16(s2.y, s3.y);
            *(u32x2*)(o0 + n) = wa2; *(u32x2*)(o1 + n) = wb3; }
        wn = cmul(wn, WQS); }
}
template <int LOG2L> __device__ __forceinline__ void hyena_item(const Params& p, LDSQ unsigned char* lds, int layer_j, int c0, int dry) {
    constexpr int L = 1 << LOG2L, NPAIR = (LOG2L == 14) ? 1 : 2;
    constexpr int TOK0 = (LOG2L == 14) ? 0 : T_P, PB = (LOG2L == 14) ? 0 : 16384;
    LDSQ cpx* A = (LDSQ cpx*)lds;
    LDSQ float* red = (LDSQ float*)(lds + 135168);
    const int t = pg8::otid(), ch = c0 + ((LOG2L == 14) ? 0 : (t >> 6));
    bf16_t* zin = (bf16_t*)(p.ws + WS_BIG + BIG_ZINT);
    const _Float16* taps = (const _Float16*)(p.ws + WS_BIG + BIG_TAPS);
    hcpx* scr = (hcpx*)(p.ws + WS_H + (size_t)pg8::obid() * FFT_SCR_PER_WG);
    hcpx* u1s = scr + (size_t)4 * 16384;
    hcpx* yes = (hcpx*)(p.ws + WS_END + (size_t)pg8::obid() * FFT_EXT_PER_WG);
    PreRegs pre;
    hcpx* xw = yes + 16384;
    {
        const _Float16* tf0 = taps + (size_t)(0 * 2048 + ch) * NPOS + PB; const _Float16* tb0 = taps + (size_t)(1 * 2048 + ch) * NPOS + PB;
        const _Float16* tf1 = taps + (size_t)(2 * 2048 + ch) * NPOS + PB; const _Float16* tb1 = taps + (size_t)(3 * 2048 + ch) * NPOS + PB;
        const float* dec = p.hy_decay + (size_t)layer_j * 8192 + ch;
        const float df0 = fabsf(dec[0]) * (1.0f / (float)(L - 1)), db0 = fabsf(dec[2048]) * (1.0f / (float)(L - 1));
        const float df1 = fabsf(dec[4096]) * (1.0f / (float)(L - 1)), db1 = fabsf(dec[6144]) * (1.0f / (float)(L - 1));
        float ss0, ss1;
        sweep_taps2<LOG2L>(A, t, tf0, tb0, tf1, tb1, df0, db0, df1, db1, xw, ss0, ss1);
        ss0 = wave_sum(ss0); ss1 = wave_sum(ss1);
        if ((t & 63) == 0) { red[t >> 6] = ss0; red[8 + (t >> 6)] = ss1; }
        GL_DRAIN(); __syncthreads();
        const float* skp0 = p.hy_skip + (size_t)layer_j * 2 * 2048 + c0; const float* skp1 = skp0 + 2048;
        fft_outer<LOG2L, false, 0>(A, t, nullptr, nullptr, pre);
        fft_prefetch<LOG2L == 14 ? 32 : 16, LOG2L == 14 ? 512 : 128>(t, xw, pre);
        fft_mid_sep<LOG2L, 0>(A, t, scr + (size_t)0 * 16384, scr + (size_t)2 * 16384, red, skp0, skp1); __syncthreads();
        fft_outer<LOG2L, false, 3>(A, t, nullptr, nullptr, pre);
        fft_mid_sep<LOG2L, 1>(A, t, scr + (size_t)1 * 16384, scr + (size_t)3 * 16384, red, skp0, skp1); __syncthreads();
    }
    const float* cw = p.hy_conv_w + (size_t)layer_j * 3 * 6144; const float* cbias = p.hy_conv_b + (size_t)layer_j * 6144;
#pragma unroll 1
    for (int pr = 0; pr < NPAIR; ++pr) {
        const size_t tb0 = (size_t)TOK0 + (size_t)(2 * pr) * L;
        sweep_load_v<LOG2L>(A, t, zin, tb0, cw, cbias, 2 * 2048 + c0, xw); GL_DRAIN(); __syncthreads();
        fft_conv<LOG2L, 0, 2>(A, t, scr + (size_t)0 * 16384, yes, xw, pre);
        CombPre cp;
        fft_conv<LOG2L, 3, 0>(A, t, scr + (size_t)1 * 16384, nullptr, nullptr, pre, [&]() { combine_prefetch<LOG2L, 0>(t, yes, zin, tb0, c0, cp); });
        sweep_combine<LOG2L, 0>(A, t, cp, yes, xw, zin, tb0, cw, cbias, c0, c0, dry); GL_DRAIN(); __syncthreads();
        fft_conv<LOG2L, 0, 2>(A, t, scr + (size_t)2 * 16384, yes, xw, pre);
        fft_conv<LOG2L, 3, 0>(A, t, scr + (size_t)3 * 16384, nullptr, nullptr, pre, [&]() { combine_prefetch<LOG2L, 0>(t, yes, zin, tb0, 2048 + c0, cp); });
        sweep_combine<LOG2L, 1>(A, t, cp, yes, xw, zin, tb0, cw, cbias, 2048 + c0, c0, dry); __syncthreads();
    }
}
__device__ __forceinline__ void hyena_conv_phase(const Params& p, LDSQ unsigned char* lds, int layer_j, int dry) {
    { LDSQ cpx* TW = (LDSQ cpx*)(lds + TW_OFF);
      for (int e = pg8::otid(); e < 1024; e += NTHR) { float sn, cs; sincospif(-2.0f * (float)e / 16384.0f, &sn, &cs); TW[e] = mkc(cs, sn); }
      __syncthreads(); }
    for (int it = pg8::obid(); it < 2048; it += pg8::ogrid()) hyena_item<14>(p, lds, layer_j, it, dry);
    for (int it = pg8::obid(); it < 256; it += pg8::ogrid()) hyena_item<11>(p, lds, layer_j, it * 8, dry);
}

__device__ __forceinline__ void attn_phase(const Params& p, LDSQ unsigned char* lds, int dry = 0) {
    constexpr int KROW = 272, VROW = 264;
    LDSQ unsigned char* Kl = lds; LDSQ bf16_t* VT = (LDSQ bf16_t*)(lds + 256 * KROW);
    const bf16_t* qkv = (const bf16_t*)(p.ws + WS_BIG + BIG_QKV);
    bf16_t* og = (bf16_t*)(p.ws + WS_BIG + BIG_OG); float* lse = (float*)(p.ws + WS_BIG + BIG_LSE);
    const int tid = pg8::otid(), lane = tid & 63, wid = __builtin_amdgcn_readfirstlane(tid >> 6), l15 = lane & 15, g4 = lane >> 4;
    for (int it = pg8::obid(); it < 7680; it += pg8::ogrid()) {
        int g, b, hh, rho, pp, L, tokbase;
        if (it < 6144) { g = it >> 11; const int rem = it & 2047; const int npp = 128 >> (2 * g); pp = rem % npp; rho = (rem / npp) & ((1 << (2 * g)) - 1); hh = (rem >> 7) & 7; b = rem >> 10; L = L_P; tokbase = 0; }
        else { const int i2 = it - 6144; g = i2 >> 9; const int rem = i2 & 511; const int npp = 16 >> (2 * g); pp = rem % npp; rho = (rem / npp) & ((1 << (2 * g)) - 1); hh = (rem >> 4) & 7; b = rem >> 7; L = L_S; tokbase = T_P; }
        const int rsh = 2 * g, n = L >> rsh;
        const size_t tok0 = (size_t)tokbase + (size_t)b * L + rho;
        const int i0 = 128 * pp - 64;
        const int qcol = g * 3072 + hh * 128, kcol = qcol + 1024, vcol = qcol + 2048;
        const int blk = wid >> 2, qq = 16 * (wid & 3) + l15;
        const int qi = 128 * pp + 64 * blk + qq;
        const size_t tq = tok0 + ((size_t)qi << rsh);
        u32x4 kr[8], vr[8];
#pragma unroll
        for (int s8 = 0; s8 < 8; ++s8) { const int ci = tid + 512 * s8, slot = ci >> 4, chn = ci & 15, i = i0 + slot, ic = i < 0 ? 0 : (i < n ? i : n - 1);
            kr[s8] = *(const u32x4*)(qkv + (tok0 + ((size_t)ic << rsh)) * QKVW + kcol + chn * 8); }
#pragma unroll
        for (int s8 = 0; s8 < 8; ++s8) { const int ci = tid + 512 * s8, slot = ci & 255, chn = ci >> 8, i = i0 + slot, ic = i < 0 ? 0 : (i < n ? i : n - 1);
            vr[s8] = *(const u32x4*)(qkv + (tok0 + ((size_t)ic << rsh)) * QKVW + vcol + chn * 8); }
        bf16x8 bq[4];
#pragma unroll
        for (int ks = 0; ks < 4; ++ks) bq[ks] = *(const bf16x8*)(qkv + tq * QKVW + qcol + 32 * ks + 8 * g4);
#pragma unroll
        for (int s8 = 0; s8 < 8; ++s8) { const int ci = tid + 512 * s8, slot = ci >> 4, chn = ci & 15, i = i0 + slot; const unsigned ok = (i >= 0 && i < n) ? 0xffffffffu : 0u;
            u32x4 v = kr[s8]; v.x &= ok; v.y &= ok; v.z &= ok; v.w &= ok;
            *(LDSQ u32x4*)(Kl + slot * KROW + chn * 16) = v; }
#pragma unroll
        for (int s8 = 0; s8 < 8; ++s8) { const int ci = tid + 512 * s8, slot = ci & 255, chn = ci >> 8, i = i0 + slot; const unsigned ok = (i >= 0 && i < n) ? 0xffffffffu : 0u;
            u32x4 v = vr[s8]; v.x &= ok; v.y &= ok; v.z &= ok; v.w &= ok;
            LDSQ bf16_t* vp = VT + (chn * 8) * VROW + slot;
            vp[0] = (bf16_t)(v.x & 0xffffu); vp[VROW] = (bf16_t)(v.x >> 16); vp[2 * VROW] = (bf16_t)(v.y & 0xffffu); vp[3 * VROW] = (bf16_t)(v.y >> 16);
            vp[4 * VROW] = (bf16_t)(v.z & 0xffffu); vp[5 * VROW] = (bf16_t)(v.z >> 16); vp[6 * VROW] = (bf16_t)(v.w & 0xffffu); vp[7 * VROW] = (bf16_t)(v.w >> 16); }
        __syncthreads();
        f32x4 sc[12];
#pragma unroll
        for (int kt = 0; kt < 12; ++kt) { f32x4 a = {0.f, 0.f, 0.f, 0.f};
#pragma unroll
            for (int ks = 0; ks < 4; ++ks) { const bf16x8 ka = *(const LDSQ bf16x8*)(Kl + (64 * blk + 16 * kt + l15) * KROW + (32 * ks + 8 * g4) * 2);
                a = __builtin_amdgcn_mfma_f32_16x16x32_bf16(ka, bq[ks], a, 0, 0, 0); }
            sc[kt] = a; }
        const int ibase = 128 * pp + 64 * blk - 64;
        const int klo = qq > -ibase ? qq : -ibase, khi = (qq + 128 < n - 1 - ibase) ? qq + 128 : n - 1 - ibase;
        const unsigned kspan = (unsigned)(khi - klo); const int kk0 = 4 * g4 - klo;
        float mx = -3.0e38f;
#pragma unroll
        for (int kt = 0; kt < 12; ++kt)
#pragma unroll
            for (int r = 0; r < 4; ++r) { const bool ok = (unsigned)(kk0 + 16 * kt + r) <= kspan;
                sc[kt][r] = ok ? sc[kt][r] : -3.0e38f; mx = fmaxf(mx, sc[kt][r]); }
        mx = fmaxf(mx, __shfl_xor(mx, 16)); mx = fmaxf(mx, __shfl_xor(mx, 32));
        float ls = 0.f;
#pragma unroll
        for (int kt = 0; kt < 12; ++kt)
#pragma unroll
            for (int r = 0; r < 4; ++r) { const float e = __builtin_amdgcn_exp2f(sc[kt][r] - mx); sc[kt][r] = e; ls += e; }
        ls += __shfl_xor(ls, 16); ls += __shfl_xor(ls, 32);
        f32x4 oa[8];
#pragma unroll
        for (int dt = 0; dt < 8; ++dt) oa[dt] = (f32x4){0.f, 0.f, 0.f, 0.f};
#pragma unroll
        for (int k2 = 0; k2 < 6; ++k2) {
            union { u32x4 u; bf16x8 h; } pb;
            pb.u.x = cvt_pk_bf16(sc[2 * k2][0], sc[2 * k2][1]); pb.u.y = cvt_pk_bf16(sc[2 * k2][2], sc[2 * k2][3]);
            pb.u.z = cvt_pk_bf16(sc[2 * k2 + 1][0], sc[2 * k2 + 1][1]); pb.u.w = cvt_pk_bf16(sc[2 * k2 + 1][2], sc[2 * k2 + 1][3]);
#pragma unroll
            for (int dt = 0; dt < 8; ++dt) {
                const LDSQ bf16_t* vr = VT + (16 * dt + l15) * VROW + 64 * blk + 32 * k2 + 4 * g4;
                union { u32x4 u; bf16x8 h; } va; const u32x2 lo = *(const LDSQ u32x2*)vr, hi = *(const LDSQ u32x2*)(vr + 16);
                va.u.x = lo.x; va.u.y = lo.y; va.u.z = hi.x; va.u.w = hi.y;
                oa[dt] = __builtin_amdgcn_mfma_f32_16x16x32_bf16(va.h, pb.h, oa[dt], 0, 0, 0); }
        }
        const float inv = 1.0f / ls;
        const size_t gt = (size_t)g * T + tq;
#pragma unroll
        for (int dt = 0; dt < 8; ++dt) { u32x2 w; w.x = cvt_pk_bf16(oa[dt][0] * inv, oa[dt][1] * inv); w.y = cvt_pk_bf16(oa[dt][2] * inv, oa[dt][3] * inv);
            if (!dry) *(u32x2*)(og + gt * 1024 + hh * 128 + 16 * dt + 4 * g4) = w; }
        if (g4 == 0 && !dry) lse[gt * 8 + hh] = mx + log2f(ls);
        __syncthreads();
    }
}
__device__ __forceinline__ void attn_merge_phase(const Params& p) {
    const bf16_t* og = (const bf16_t*)(p.ws + WS_BIG + BIG_OG); const float* lse = (const float*)(p.ws + WS_BIG + BIG_LSE); bf16_t* H = (bf16_t*)(p.ws + WS_H);
    const int stride = pg8::ogrid() * NTHR;
    for (int i0 = pg8::obid() * NTHR + pg8::otid(); i0 < T * 128; i0 += 4 * stride) {
        u32x4 v0[4], v1[4], v2[4]; float l0[4], l1[4], l2[4];
#pragma unroll
        for (int u = 0; u < 4; ++u) { const int i = i0 + u * stride; if (i < T * 128) { const int tok = i >> 7, c8 = i & 127, hh = c8 >> 4;
            l0[u] = lse[(size_t)tok * 8 + hh]; l1[u] = lse[((size_t)T + tok) * 8 + hh]; l2[u] = lse[((size_t)2 * T + tok) * 8 + hh];
            v0[u] = *(const u32x4*)(og + (size_t)tok * 1024 + c8 * 8); v1[u] = *(const u32x4*)(og + ((size_t)T + tok) * 1024 + c8 * 8); v2[u] = *(const u32x4*)(og + ((size_t)2 * T + tok) * 1024 + c8 * 8); } }
#pragma unroll
        for (int u = 0; u < 4; ++u) { const int i = i0 + u * stride; if (i < T * 128) { const int tok = i >> 7, c8 = i & 127;
            const float m = fmaxf(l0[u], fmaxf(l1[u], l2[u])); float a0 = exp2f(l0[u] - m), a1 = exp2f(l1[u] - m), a2 = exp2f(l2[u] - m); const float is = 1.0f / (a0 + a1 + a2); a0 *= is; a1 *= is; a2 *= is;
            u32x4 w;
#pragma unroll
            for (int e = 0; e < 4; ++e) { const float lo = a0 * __uint_as_float(v0[u][e] << 16) + a1 * __uint_as_float(v1[u][e] << 16) + a2 * __uint_as_float(v2[u][e] << 16);
                const float hi = a0 * __uint_as_float(v0[u][e] & 0xffff0000u) + a1 * __uint_as_float(v1[u][e] & 0xffff0000u) + a2 * __uint_as_float(v2[u][e] & 0xffff0000u);
                w[e] = cvt_pk_bf16(lo, hi); }
            *(u32x4*)(H + (size_t)tok * 1024 + c8 * 8) = w; } }
    }
}

constexpr int NPHASE = 35;
typedef const __attribute__((address_space(4))) unsigned char* KARG;
template <class Tp> __device__ __forceinline__ Tp karg(int byte_off) { return *(volatile const __attribute__((address_space(4))) Tp*)((KARG)__builtin_amdgcn_kernarg_segment_ptr() + byte_off); }
#define PA(q, member) q.member = karg<decltype(Params::member)>((int)__builtin_offsetof(Params, member))
__global__ void __launch_bounds__(512, 2) mega(Params parg) {
    extern __shared__ __attribute__((aligned(16))) unsigned char shm[];
    LDSQ unsigned char* lds = (LDSQ unsigned char*)shm;
    const int tid = pg8::otid();
    volatile LDSQ unsigned* misc = (volatile LDSQ unsigned*)(lds + LDS_MISC);
    if (tid < 8) misc[tid] = 0u;
    __syncthreads();
    const int ph_lo = parg.ph_lo, ph_hi = parg.ph_hi, probe = parg.probe;
#define REPS(bit, lay) (1 + (1 + ((probe >> 15) & 1)) * (((probe >> (bit)) & 1) & ((((probe >> 10) & 3) == 0) | ((probe >> (10 + ((lay) & 1))) & 1))))
    XcdBarrier bar; bar.bar = nullptr; bar.x = 0; bar.st = misc;
    if (ph_hi - ph_lo > 1) { Params q{}; PA(q, ws); bar = xcd_barrier_post((unsigned*)(q.ws + WS_CTL), misc); }
#define IN(k) (ph_lo <= (k) && (k) < ph_hi)
#define REPBAR() do { if (((probe >> 16) & 1) && rep + 1 < nrep) { Params qb{}; PA(qb, ws); bar.bar = (unsigned*)(qb.ws + WS_CTL); xcd_barrier(bar); } } while (0)
#define SEAM(k) do { if (IN(k) && IN((k) + 1)) { Params qb{}; PA(qb, ws); bar.bar = (unsigned*)(qb.ws + WS_CTL); xcd_barrier(bar); if ((probe >> 12) & 1) { xcd_barrier(bar); xcd_barrier(bar); } } } while (0)

    for (int rep = 0, nrep = REPS(0, 0); rep < nrep; ++rep)
    if (IN(0)) { Params q{}; PA(q, ws); PA(q, c_prompt); PA(q, c_sample); PA(q, ada_w); PA(q, final_ada_w); ada_partials(q, lds); rope_table(q);
                 PA(q, hy_fw1); PA(q, hy_fb1); PA(q, hy_ffreq); PA(q, hy_fw2); PA(q, hy_fb2); PA(q, hy_fw3); filter_mlp(q); }
    SEAM(0);
    for (int rep = 0, nrep = REPS(0, 0); rep < nrep; ++rep)
    if (IN(1)) { Params q{}; PA(q, ws); PA(q, ada_b); PA(q, final_ada_b); ada_reduce(q); }
    SEAM(1);
#pragma unroll 1
    for (int layer = 0; layer < 4; ++layer) {
        const int pb = 2 + 8 * layer, j = layer >> 1; const bool hy = (layer & 1) == 0;
        for (int rep = 0, nrep = REPS(1, layer); rep < nrep; ++rep)
        if (IN(pb + 0)) {
            Params q{}; PA(q, ws); unsigned char* wl = q.ws + WS_WL;
            PA(q, ffn_w_gate); convert_T(lds, q.ffn_w_gate + (size_t)layer * 2048 * DFF, 2048, DFF, (bf16_t*)(wl + WL_FFN1), 0);
            PA(q, ffn_w_up);   convert_T(lds, q.ffn_w_up + (size_t)layer * 2048 * DFF, 2048, DFF, (bf16_t*)(wl + WL_FFN1), 1);
            PA(q, ffn_w_down); convert_T(lds, q.ffn_w_down + (size_t)layer * DFF * 2048, DFF, 2048, (bf16_t*)(wl + WL_FFN2), -1);
            if (hy) { PA(q, hy_w_in);  convert_T(lds, q.hy_w_in + (size_t)j * 2048 * 6144, 2048, 6144, (bf16_t*)(wl + WL_MIXIN), -1);
                      PA(q, hy_w_out); convert_T(lds, q.hy_w_out + (size_t)j * 2048 * 2048, 2048, 2048, (bf16_t*)(wl + WL_MIXOUT), -1); }
            else    { PA(q, at_w_in);  convert_T(lds, q.at_w_in + (size_t)j * 2048 * QKVW, 2048, QKVW, (bf16_t*)(wl + WL_MIXIN), -1);
                      PA(q, at_w_out); convert_T(lds, q.at_w_out + (size_t)j * 1024 * 2048, 1024, 2048, (bf16_t*)(wl + WL_MIXOUT), -1); }
            PA(q, norm_mix);
            const float* modl = (const float*)(q.ws + WS_MOD) + layer * 12288;
            if (layer == 0) { PA(q, x_prompt); PA(q, x_sample); norm_rows<false, true>(q.x_prompt, q.x_sample, (bf16_t*)(q.ws + WS_XB), q.norm_mix + layer * 2048, modl, 0, 2048, (bf16_t*)(q.ws + WS_H), nullptr); }
            else            norm_rows<false, false>(nullptr, nullptr, (bf16_t*)(q.ws + WS_XB), q.norm_mix + layer * 2048, modl, 0, 2048, (bf16_t*)(q.ws + WS_H), nullptr);
            if (hy) { __syncthreads();
                pg8::Gemm g{(const bf16_t*)(q.ws + WS_W3X) + (size_t)j * 8192 * 256, (const bf16_t*)(q.ws + WS_A2X) + (size_t)j * NPOS * 256, 8192, NPOS, 256};
                pg8::StaticOrder S; S.init(8192, NPOS, pg8::ogrid(), pg8::obid());
                EpiTaps E{(_Float16*)(q.ws + WS_BIG + BIG_TAPS)};
                pg8::gemm_phase<EpiTaps, pg8::StaticOrder, false>(lds, g, S, E, nullptr); }
        }
        SEAM(pb + 0);
        for (int rep = 0, nrep = REPS(2, layer); rep < nrep; ++rep)
        if (IN(pb + 1)) {
            Params q{}; PA(q, ws);
            if (hy) { PA(q, hy_b_in); pg8::Gemm g{(const bf16_t*)(q.ws + WS_WL + WL_MIXIN), (const bf16_t*)(q.ws + WS_H), 6144, T, 2048}; pg8::StaticOrder S; S.init(6144, T, pg8::ogrid(), pg8::obid());
                EpiZinT E{(bf16_t*)(q.ws + WS_BIG + BIG_ZINT), T, q.hy_b_in + (size_t)j * 6144};
                pg8::gemm_phase<EpiZinT, pg8::StaticOrder, false>(lds, g, S, E, nullptr); }
            else { pg8::Gemm g{(const bf16_t*)(q.ws + WS_H), (const bf16_t*)(q.ws + WS_WL + WL_MIXIN), T, QKVW, 2048}; pg8::StaticOrder S; S.init(T, QKVW, pg8::ogrid(), pg8::obid());
                EpiQKV E{(bf16_t*)(q.ws + WS_BIG + BIG_QKV), (const cpx*)(q.ws + WS_ROPE)};
                pg8::gemm_phase<EpiQKV, pg8::StaticOrder, false>(lds, g, S, E, nullptr); }
            REPBAR();
        }
        SEAM(pb + 1);
        for (int rep = 0, nrep = REPS(3, layer); rep < nrep; ++rep)
        if (IN(pb + 2)) { Params q{}; PA(q, ws); if (hy) { PA(q, hy_skip); PA(q, hy_conv_w); PA(q, hy_conv_b); PA(q, hy_decay); hyena_conv_phase(q, lds, j, rep + 1 < nrep); } else attn_phase(q, lds, (rep + 1 < nrep) ? (1 | ((probe >> 12) & 2)) : 0); }
        SEAM(pb + 2);
        for (int rep = 0, nrep = REPS(4, layer); rep < nrep; ++rep)
        if (IN(pb + 3)) { Params q{}; PA(q, ws); if (hy) transpose_phase(q, lds); else attn_merge_phase(q); }
        SEAM(pb + 3);
        for (int rep = 0, nrep = REPS(5, layer); rep < nrep; ++rep)
        if (IN(pb + 4)) {
            Params q{}; PA(q, ws); PA(q, hy_b_out);
            pg8::Gemm g{(const bf16_t*)(q.ws + WS_H), (const bf16_t*)(q.ws + WS_WL + WL_MIXOUT), T, 2048, hy ? 2048 : 1024}; pg8::StaticOrder S; S.init(T, 2048, pg8::ogrid(), pg8::obid());
            EpiRes E{(bf16_t*)(q.ws + WS_XB), hy ? q.hy_b_out + (size_t)j * 2048 : nullptr, (const float*)(q.ws + WS_MOD) + layer * 12288 + 4096, rep + 1 < nrep};
            pg8::gemm_phase<EpiRes, pg8::StaticOrder, false>(lds, g, S, E, nullptr);
            REPBAR();
        }
        SEAM(pb + 4);
        for (int rep = 0, nrep = REPS(6, layer); rep < nrep; ++rep)
        if (IN(pb + 5)) { Params q{}; PA(q, ws); PA(q, norm_ffn);
            norm_rows<false, false>(nullptr, nullptr, (bf16_t*)(q.ws + WS_XB), q.norm_ffn + layer * 2048, (const float*)(q.ws + WS_MOD) + layer * 12288, 6144, 8192, (bf16_t*)(q.ws + WS_H), nullptr); }
        SEAM(pb + 5);
        for (int rep = 0, nrep = REPS(7, layer); rep < nrep; ++rep)
        if (IN(pb + 6)) {
            Params q{}; PA(q, ws);
            pg8::Gemm g{(const bf16_t*)(q.ws + WS_H), (const bf16_t*)(q.ws + WS_WL + WL_FFN1), T, 2 * DFF, 2048}; pg8::StaticOrder S; S.init(T, 2 * DFF, pg8::ogrid(), pg8::obid());
            EpiFFN1 E{(bf16_t*)(q.ws + WS_BIG + BIG_MID)};
            pg8::gemm_phase<EpiFFN1, pg8::StaticOrder, false>(lds, g, S, E, nullptr);
            REPBAR();
        }
        SEAM(pb + 6);
        for (int rep = 0, nrep = REPS(8, layer); rep < nrep; ++rep)
        if (IN(pb + 7)) {
            Params q{}; PA(q, ws);
            pg8::Gemm g{(const bf16_t*)(q.ws + WS_BIG + BIG_MID), (const bf16_t*)(q.ws + WS_WL + WL_FFN2), T, 2048, DFF}; pg8::StaticOrder S; S.init(T, 2048, pg8::ogrid(), pg8::obid());
            EpiRes E{(bf16_t*)(q.ws + WS_XB), nullptr, (const float*)(q.ws + WS_MOD) + layer * 12288 + 10240, rep + 1 < nrep};
            pg8::gemm_phase<EpiRes, pg8::StaticOrder, false>(lds, g, S, E, nullptr);
            REPBAR();
        }
        SEAM(pb + 7);
    }
    if (IN(34)) { Params q{}; PA(q, ws); PA(q, out); PA(q, final_norm); final_norm_phase(q); }
#undef REPS
#undef IN
#undef SEAM
}
}

extern "C" void kernel_launch(void* const* d_in, const int* in_sizes, int n_in, void* d_out, int out_size, void* d_ws, size_t ws_size, hipStream_t stream) {
    static int grid = 0;
    if (grid == 0) {
        if (n_in != 30 || out_size != mk::T * mk::D || ws_size < mk::WS_TOTAL) { fprintf(stderr, "kernel_launch: unexpected shapes (n_in %d out %d ws %zu need %zu); nothing launched\n", n_in, out_size, ws_size, (size_t)mk::WS_TOTAL); grid = -1; return; }
        int dev = 0, cus = 0;
        if (hipGetDevice(&dev) != hipSuccess || hipDeviceGetAttribute(&cus, hipDeviceAttributeMultiprocessorCount, dev) != hipSuccess) { grid = -1; return; }
        if (hipFuncSetAttribute((const void*)mk::mega, hipFuncAttributeMaxDynamicSharedMemorySize, mk::LDS_BYTES) != hipSuccess) { fprintf(stderr, "kernel_launch: hipFuncSetAttribute failed\n"); grid = -1; return; }
        int per_cu = 0; (void)hipOccupancyMaxActiveBlocksPerMultiprocessor(&per_cu, (const void*)mk::mega, 512, mk::LDS_BYTES); (void)hipGetLastError();
        if (per_cu < 1) fprintf(stderr, "kernel_launch: occupancy query reports %d blocks per CU\n", per_cu);
        grid = cus > 256 ? 256 : cus;
    }
    if (grid < 0) return;
    mk::Params p{};
    const float** f = (const float**)&p;
    for (int i = 0; i < 30; ++i) f[i] = (const float*)d_in[i];
    p.out = (float*)d_out; p.ws = (unsigned char*)d_ws; p.probe = MK_PROBE;
#if MK_PER_PHASE
    for (int k = 0; k < mk::NPHASE; ++k) { p.ph_lo = k; p.ph_hi = k + 1; hipLaunchKernelGGL(mk::mega, dim3(grid), dim3(512), mk::LDS_BYTES, stream, p); }
#else
    (void)hipMemsetAsync((char*)d_ws + mk::WS_CTL, 0, mk::CTL_BYTES, stream);
    p.ph_lo = 0; p.ph_hi = mk::NPHASE;
    hipLaunchKernelGGL(mk::mega, dim3(grid), dim3(512), mk::LDS_BYTES, stream, p);
#endif
}
```

```cpp
#include <hip/hip_runtime.h>
#include <cstdio>
#include <cstdint>
#include <utility>
#ifndef MK_PER_PHASE
#define MK_PER_PHASE 0
#endif
#ifndef MK_PROBE
#define MK_PROBE 0
#endif
namespace pg8 {
#define PG8_LAS __attribute__((address_space(3)))
__device__ __forceinline__ int otid() { int t = threadIdx.x; asm volatile("" : "+v"(t) :: "memory"); return t; }
__device__ __forceinline__ int obid() { int b = blockIdx.x; asm volatile("" : "+s"(b)); return b; }
__device__ __forceinline__ int ogrid() { int g = gridDim.x; asm volatile("" : "+s"(g)); return g; }
typedef unsigned short bf16_t;
typedef short bf16x8 __attribute__((ext_vector_type(8)));
typedef float f32x4 __attribute__((ext_vector_type(4)));
typedef unsigned u32x4 __attribute__((ext_vector_type(4)));
constexpr int BM = 256, BK = 64, HALF = 128, HTB = HALF * BK * 2  , STAGE_BYTES = 8 * HTB, NXCD = 8, WGM = 4;

__host__ __device__ __forceinline__ int lds_byte(int r, int c) { const int st = (r >> 4) * 2 + (c >> 5), rr = r & 15, cc = c & 31, ob = rr * 64 + cc * 2; return st * 1024 + (ob ^ (((ob >> 9) & 1) << 5)); }
__host__ __device__ __forceinline__ void stage_rc(int b, int& R, int& C) { const int st = b / 1024, sb = b % 1024, swz = sb ^ (((sb >> 9) & 1) << 5); R = (st >> 1) * 16 + swz / 64; C = (st & 1) * 32 + (swz % 64) / 2; }
__host__ __device__ __forceinline__ int perm32(int rho) { const int n = rho >> 4, i = rho & 15; return 8 * (i >> 2) + 4 * n + (i & 3); }

struct Unit { int pm, pn; };
struct Gemm { const bf16_t* A; const bf16_t* Bt; int M, N, K; };

struct StaticOrder {
    int nM, nN, nwg, G, c, wgm;
    __host__ __device__ void init(int M, int N, int G_, int c_, int wgm_ = WGM) { nM = M / BM; nN = N / BM; nwg = nM * nN; G = G_; c = c_; wgm = wgm_; }
    __host__ __device__ bool next(int i, Unit& u) const {
        const long L = (long)i * G + c; if (L >= nwg) return false;
        int wgid = (int)L; { const int q = nwg / NXCD, r = nwg % NXCD, xcd = wgid % NXCD, off = wgid / NXCD; wgid = (xcd < r ? xcd * (q + 1) : r * (q + 1) + (xcd - r) * q) + off; }
        const int nig = wgm * nN, gid = wgid / nig, fm = gid * wgm, gsz = (nM - fm) < wgm ? (nM - fm) : wgm;
        u.pm = fm + ((wgid % nig) % gsz); u.pn = (wgid % nig) / gsz; return true;
    }
    __device__ __forceinline__ void a_ready(const Unit&) const {}
    __device__ __forceinline__ void done(const Unit&) const {}
};
__device__ __forceinline__ unsigned cvt_pk_bf16(float lo, float hi) { unsigned r; asm volatile("v_cvt_pk_bf16_f32 %0, %1, %2" : "=v"(r) : "v"(lo), "v"(hi)); return r; }
template <class Epi, class Sched, bool STAMP = false>
__device__ __forceinline__ void gemm_phase(PG8_LAS unsigned char* lds, const Gemm g, const Sched& S, const Epi& E, unsigned long long* stamps) {
    const int tid = otid(), wid = __builtin_amdgcn_readfirstlane(tid >> 6), lane = tid & 63, wr = wid >> 2, wc = wid & 3, fr = lane & 15, fq = lane >> 4;
    const int K = g.K, nt = K / BK;
    int ts_lo = 0, ts_hi = 0, nts = 0; const unsigned long long rt_entry = STAMP ? (unsigned long long)wall_clock64() : 0ull;
#define PG8_STAMP() do { if (STAMP && wid == 0 && nts < 64) { const unsigned long long _c = (unsigned long long)clock64(); \
        ts_lo = (lane == nts) ? (int)(unsigned)_c : ts_lo; ts_hi = (lane == nts) ? (int)(unsigned)(_c >> 32) : ts_hi; ++nts; } } while (0)
    PG8_STAMP();
    unsigned voffA[2], voffB[2];
#pragma unroll
    for (int i = 0; i < 2; ++i) { int R, C; stage_rc(tid * 16 + i * 8192, R, C); const int Rb = Epi::PERM ? ((R & ~31) + perm32(R & 31)) : R;
        voffA[i] = (unsigned)(R * K + C) * 2u; voffB[i] = (unsigned)(Rb * K + C) * 2u; }
    const size_t kstep = (size_t)(BK * 2);
    const size_t hstep = (size_t)HALF * K * 2;
    const size_t tstep = 2 * hstep;
    const unsigned ldsw = (unsigned)wid * 1024u;
    const int aoff = lds_byte(wr * 64 + fr, fq * 8), boff = lds_byte(wc * 32 + fr, fq * 8);
#define PG8_SA(b, h) (((b) * 2 + (h)) * HTB)
#define PG8_SB(b, h) ((4 + (b) * 2 + (h)) * HTB)
#define PG8_STAGE(bufoff, gbase, voff) do { _Pragma("unroll") for (int _i = 0; _i < 2; ++_i) \
        __builtin_amdgcn_global_load_lds((const unsigned*)((const char*)(gbase) + (voff)[_i]), (PG8_LAS unsigned*)(lds + (bufoff) + ldsw + _i * 8192), 16, 0, 0); } while (0)
#define PG8_LDA(dst, b, h) do { _Pragma("unroll") for (int m = 0; m < 4; ++m) _Pragma("unroll") for (int k = 0; k < 2; ++k) dst[m][k] = *(const PG8_LAS bf16x8*)(lds + PG8_SA(b, h) + aoff + m * 2048 + k * 1024); } while (0)
#define PG8_LDB(dst, b, h) do { _Pragma("unroll") for (int n = 0; n < 2; ++n) _Pragma("unroll") for (int k = 0; k < 2; ++k) dst[n][k] = *(const PG8_LAS bf16x8*)(lds + PG8_SB(b, h) + boff + n * 2048 + k * 1024); } while (0)
#define PG8_MMA(ai, bj, At, Bt) do { __builtin_amdgcn_s_setprio(1); _Pragma("unroll") for (int m = 0; m < 4; ++m) _Pragma("unroll") for (int n = 0; n < 2; ++n) _Pragma("unroll") for (int k = 0; k < 2; ++k) \
        acc[ai][bj][m][n] = __builtin_amdgcn_mfma_f32_16x16x32_bf16(Bt[n][k], At[m][k], acc[ai][bj][m][n], 0, 0, 0); __builtin_amdgcn_s_setprio(0); } while (0)
#define PG8_WAIT_V(n) asm volatile("s_waitcnt vmcnt(" #n ")" ::: "memory")
#define PG8_WAIT_L(n) asm volatile("s_waitcnt lgkmcnt(" #n ")" ::: "memory")
#define PG8_BAR __builtin_amdgcn_s_barrier()
#define PG8_SCHED __builtin_amdgcn_sched_barrier(0)
    Unit cur, nxt; int ui = 0;
    if (!S.next(0, cur)) return;
    f32x4 acc[2][2][4][2];
#pragma unroll
    for (int a = 0; a < 2; ++a)
#pragma unroll
        for (int b = 0; b < 2; ++b)
#pragma unroll
            for (int m = 0; m < 4; ++m)
#pragma unroll
                for (int n = 0; n < 2; ++n) acc[a][b][m][n] = (f32x4){0.f, 0.f, 0.f, 0.f};
    bf16x8 At[4][2], B0[2][2], B1[2][2];
    const char* cA = (const char*)g.A + (size_t)cur.pm * tstep; const char* cB = (const char*)g.Bt + (size_t)cur.pn * tstep;
    S.a_ready(cur);
    PG8_STAGE(PG8_SB(0, 0), cB, voffB); PG8_STAGE(PG8_SA(0, 0), cA, voffA); PG8_STAGE(PG8_SB(0, 1), cB + hstep, voffB); PG8_STAGE(PG8_SA(0, 1), cA + hstep, voffA);
    if (wr == 1) PG8_BAR;
    PG8_WAIT_V(4); PG8_BAR;
    PG8_STAGE(PG8_SB(1, 0), cB + kstep, voffB); PG8_STAGE(PG8_SA(1, 0), cA + kstep, voffA); PG8_STAGE(PG8_SB(1, 1), cB + hstep + kstep, voffB);
    PG8_WAIT_V(6); PG8_BAR;
    PG8_STAMP();
    for (;;) {
        const bool has_next = S.next(ui + 1, nxt);
        const char* nA = has_next ? (const char*)g.A + (size_t)nxt.pm * tstep : cA; const char* nB = has_next ? (const char*)g.Bt + (size_t)nxt.pn * tstep : cB;
        for (int t = 0; t < nt; t += 2) {
            const bool last = (t == nt - 2);
            const char* a1 = cA + (size_t)(t + 1) * kstep;
            const char* a2 = last ? nA : cA + (size_t)(t + 2) * kstep; const char* b2 = last ? nB : cB + (size_t)(t + 2) * kstep;
            const char* a3 = a2 + kstep; const char* b3 = b2 + kstep;
            if (last && has_next) S.a_ready(nxt);
            PG8_LDB(B0, 0, 0); PG8_SCHED; PG8_LDA(At, 0, 0); PG8_STAGE(PG8_SA(1, 1), a1 + hstep, voffA);
            PG8_WAIT_L(8); PG8_BAR; PG8_WAIT_L(0); PG8_MMA(0, 0, At, B0); PG8_BAR; PG8_SCHED;
            PG8_LDB(B1, 0, 1); PG8_STAGE(PG8_SB(0, 0), b2, voffB);
            PG8_BAR; PG8_WAIT_L(0); PG8_MMA(0, 1, At, B1); PG8_BAR;
            PG8_LDA(At, 0, 1); PG8_STAGE(PG8_SA(0, 0), a2, voffA);
            PG8_BAR; PG8_WAIT_L(0); PG8_MMA(1, 0, At, B0); PG8_BAR; PG8_SCHED;
            PG8_STAGE(PG8_SB(0, 1), b2 + hstep, voffB);
            PG8_WAIT_V(6); PG8_BAR; PG8_MMA(1, 1, At, B1); PG8_BAR;
            PG8_LDB(B0, 1, 0); PG8_SCHED; PG8_LDA(At, 1, 0); PG8_STAGE(PG8_SA(0, 1), a2 + hstep, voffA);
            PG8_WAIT_L(8); PG8_BAR; PG8_WAIT_L(0); PG8_MMA(0, 0, At, B0); PG8_BAR; PG8_SCHED;
            PG8_LDB(B1, 1, 1); PG8_STAGE(PG8_SB(1, 0), b3, voffB);
            PG8_BAR; PG8_WAIT_L(0); PG8_MMA(0, 1, At, B1); PG8_BAR;
            PG8_LDA(At, 1, 1); PG8_STAGE(PG8_SA(1, 0), a3, voffA);
            PG8_BAR; PG8_WAIT_L(0); PG8_MMA(1, 0, At, B0); PG8_BAR; PG8_SCHED;
            PG8_STAGE(PG8_SB(1, 1), b3 + hstep, voffB);
            PG8_WAIT_V(6); PG8_BAR; PG8_MMA(1, 1, At, B1); PG8_BAR;
        }
        PG8_STAMP();
        if constexpr (!Epi::AFTER_DRAIN) { E(acc, cur, wr, wc, fr, fq); S.done(cur); }
        PG8_STAMP();
        if (!has_next) break;
#pragma unroll
        for (int a = 0; a < 2; ++a)
#pragma unroll
            for (int b = 0; b < 2; ++b)
#pragma unroll
                for (int m = 0; m < 4; ++m)
#pragma unroll
                    for (int n = 0; n < 2; ++n) acc[a][b][m][n] = (f32x4){0.f, 0.f, 0.f, 0.f};
        cur = nxt; cA = nA; cB = nB; ++ui;
    }
    PG8_WAIT_V(0);
    if (wr == 0) PG8_BAR;
    PG8_BAR;
    if constexpr (Epi::AFTER_DRAIN) { E.fused(acc, cur, wr, wc, fr, fq, lds, wid, lane); S.done(cur); }
    PG8_STAMP();
    if (STAMP && wid == 0) { stamps[lane] = lane < nts ? (((unsigned long long)(unsigned)ts_hi << 32) | (unsigned)ts_lo) : 0ull;
        if (lane == 62) stamps[62] = rt_entry; if (lane == 63) stamps[63] = (unsigned long long)wall_clock64(); }
#undef PG8_STAMP
#undef PG8_SA
#undef PG8_SB
#undef PG8_STAGE
#undef PG8_LDA
#undef PG8_LDB
#undef PG8_MMA
#undef PG8_WAIT_V
#undef PG8_WAIT_L
#undef PG8_BAR
#undef PG8_SCHED
}
}
#define XB_TMO      128
#define XB_XCNT(j)  (256  + 64 * (j))
#define XB_XSUB(j)  (1280 + 64 * (j))
#define XB_XGEN(j)  (2304 + 64 * (j))
#define XB_TOP      3328
#define XB_TOPGEN   3392
#define XCD_BAR_WORDS 3456
#define XB_SPIN_CAP (1u << 18)
#define LAS __attribute__((address_space(3)))

__device__ __forceinline__ unsigned xb_ld(unsigned* p)              { return __hip_atomic_load(p, __ATOMIC_RELAXED, __HIP_MEMORY_SCOPE_AGENT); }
__device__ __forceinline__ unsigned xb_add(unsigned* p, unsigned v) { return __hip_atomic_fetch_add(p, v, __ATOMIC_RELAXED, __HIP_MEMORY_SCOPE_AGENT); }
__device__ __forceinline__ unsigned xb_xcc_id() { return (unsigned)__builtin_amdgcn_s_getreg((3 << 11) | 20) & 0xFu; }
#define XB_SPIN(cond, bar) do { unsigned _sp = 0; while (cond) { __builtin_amdgcn_s_sleep(1); \
    if ((++_sp & 255u) == 0u) { if (xb_ld(&(bar)[XB_TMO])) break; if (_sp > XB_SPIN_CAP) { atomicAdd(&(bar)[XB_TMO], 1u); break; } } } } while (0)

struct XcdBarrier {
    unsigned* bar; unsigned x;
    volatile LAS unsigned* st;
};

__device__ __forceinline__ XcdBarrier xcd_barrier_post(unsigned* bar, volatile LAS unsigned* st) {
    XcdBarrier b; b.bar = bar; b.x = xb_xcc_id(); b.st = st;
    if (threadIdx.x == 0) (void)xb_add(&bar[XB_XCNT(b.x)], 1u);
    return b;
}
__device__ __forceinline__ void xcd_barrier_complete(unsigned* bar, unsigned x, unsigned& nloc, unsigned& nx) {
    const unsigned G = gridDim.x * gridDim.y * gridDim.z;
    unsigned sum, cnt, mine, sp = 0u;
    for (;;) {
        sum = 0u; cnt = 0u; mine = 0u;
#pragma unroll
        for (unsigned j = 0; j < 16; ++j) { const unsigned c = xb_ld(&bar[XB_XCNT(j)]); sum += c; cnt += (c > 0u) ? 1u : 0u; mine = (j == x) ? c : mine; }
        if (sum == G) break;
        __builtin_amdgcn_s_sleep(1);
        if ((++sp & 255u) == 0u) { if (xb_ld(&bar[XB_TMO])) break; if (sp > XB_SPIN_CAP) { atomicAdd(&bar[XB_TMO], 1u); break; } }
    }
    nloc = mine > 0u ? mine : 1u; nx = cnt > 0u ? cnt : 1u;
}

__device__ __forceinline__ void xcd_barrier(const XcdBarrier& b) {
    asm volatile("s_waitcnt vmcnt(0)" ::: "memory");
    __syncthreads();
    if (threadIdx.x == 0) {
        unsigned* bar = b.bar;
        __builtin_amdgcn_s_waitcnt(0);
        unsigned nloc = b.st[0], nx = b.st[1];
        if (nloc == 0u) { xcd_barrier_complete(bar, b.x, nloc, nx); b.st[0] = nloc; b.st[1] = nx; }
        const unsigned old = xb_add(&bar[XB_XSUB(b.x)], 1u);
        const unsigned gen = old / nloc;
        if (old + 1u == (gen + 1u) * nloc) {
            __builtin_amdgcn_fence(__ATOMIC_RELEASE, "agent");
            asm volatile("s_waitcnt vmcnt(0)" ::: "memory");
            const unsigned og = xb_add(&bar[XB_TOP], 1u);
            const unsigned tg = og / nx;
            if (og + 1u == (tg + 1u) * nx) xb_add(&bar[XB_TOPGEN], 1u);
            else XB_SPIN(xb_ld(&bar[XB_TOPGEN]) == tg, bar);
            __builtin_amdgcn_fence(__ATOMIC_ACQUIRE, "agent");
            xb_add(&bar[XB_XGEN(b.x)], 1u);
            asm volatile("s_waitcnt vmcnt(0)" ::: "memory");
        } else {
            XB_SPIN(xb_ld(&bar[XB_XGEN(b.x)]) == gen, bar);
            __builtin_amdgcn_fence(__ATOMIC_ACQUIRE, "agent");
            asm volatile("s_waitcnt vmcnt(0)" ::: "memory");
        }
    }
    __syncthreads();
}


namespace mk {
using pg8::bf16_t; using pg8::bf16x8; using pg8::f32x4; using pg8::u32x4; using pg8::Unit; using pg8::cvt_pk_bf16;
typedef unsigned u32x2 __attribute__((ext_vector_type(2)));
typedef float cpx __attribute__((ext_vector_type(2)));
__host__ __device__ __forceinline__ cpx mkc(float a, float b) { cpx r; r.x = a; r.y = b; return r; }

constexpr int D = 2048, T_P = 32768, T_S = 8192, T = 40960, L_P = 16384, L_S = 2048, DFF = 5632;
constexpr int NTHR = 512;
constexpr int MODW = 53248;
constexpr int NPOS = 18432;
constexpr int QKVW = 9216;
constexpr float EPS = 1e-6f;
constexpr float QSCALE = 0.12751743082459868f;
constexpr int LDS_BYTES = 147456;
constexpr int LDS_MISC = 147456 - 256;

constexpr size_t al256(size_t x) { return (x + 255) & ~(size_t)255; }
constexpr size_t WS_CTL  = 0;
constexpr size_t CTL_BYTES = 65536;
constexpr size_t WS_PART = WS_CTL + CTL_BYTES;
constexpr size_t WS_MOD  = WS_PART + al256((size_t)8 * 6 * MODW * 4);
constexpr size_t WS_ROPE = WS_MOD + al256((size_t)6 * MODW * 4);
constexpr size_t WS_A2X  = WS_ROPE + (size_t)16384 * 16 * 8;
constexpr size_t WS_W3X  = WS_A2X + (size_t)2 * NPOS * 256 * 2;
constexpr size_t WS_WL   = WS_W3X + (size_t)2 * 8192 * 256 * 2;
constexpr size_t WL_FFN1 = 0;
constexpr size_t WL_FFN2 = WL_FFN1 + (size_t)11264 * 2048 * 2;
constexpr size_t WL_MIXIN = WL_FFN2 + (size_t)2048 * 5632 * 2;
constexpr size_t WL_MIXOUT = WL_MIXIN + (size_t)9216 * 2048 * 2;
constexpr size_t WL_BYTES = WL_MIXOUT + (size_t)2048 * 2048 * 2;
constexpr size_t WS_H    = WS_WL + WL_BYTES;
constexpr size_t H_BYTES = (size_t)T * 2048 * 2;
constexpr size_t WS_BIG  = WS_H + H_BYTES;
constexpr size_t BIG_ZINT = 0;
constexpr size_t BIG_TAPS = BIG_ZINT + (size_t)6144 * T * 2;
constexpr size_t BIG_HY_END = BIG_TAPS + (size_t)8192 * NPOS * 2;
constexpr size_t BIG_QKV = 0;
constexpr size_t BIG_OG  = BIG_QKV + (size_t)T * QKVW * 2;
constexpr size_t BIG_LSE = BIG_OG + (size_t)3 * T * 1024 * 2;
constexpr size_t BIG_AT_END = BIG_LSE + (size_t)3 * T * 8 * 4;
constexpr size_t BIG_MID = 0;
constexpr size_t BIG_BYTES = BIG_HY_END > BIG_AT_END ? BIG_HY_END : BIG_AT_END;
constexpr size_t WS_END  = WS_BIG + BIG_BYTES;
constexpr size_t FFT_SCR_PER_WG = 5 * 131072;
constexpr size_t FFT_EXT_PER_WG = 2 * 65536;
constexpr size_t WS_XB = WS_END + (size_t)256 * FFT_EXT_PER_WG;
constexpr size_t WS_TOTAL = WS_XB + (size_t)T * 2048 * 2;
static_assert(256 * FFT_SCR_PER_WG <= H_BYTES, "fft scratch must fit in H");

struct Params {
    const float *x_prompt, *x_sample, *c_prompt, *c_sample, *ada_w, *ada_b, *norm_mix, *norm_ffn;
    const float *hy_w_in, *hy_b_in, *hy_conv_w, *hy_conv_b, *hy_fw1, *hy_fb1, *hy_ffreq, *hy_fw2, *hy_fb2, *hy_fw3, *hy_decay, *hy_skip, *hy_w_out, *hy_b_out;
    const float *at_w_in, *at_w_out, *ffn_w_gate, *ffn_w_up, *ffn_w_down, *final_norm, *final_ada_w, *final_ada_b;
    float* out; unsigned char* ws; int ph_lo, ph_hi, probe, pad0;
};

#define LDSQ __attribute__((address_space(3)))

__device__ __forceinline__ float bf2f(bf16_t b) { return __uint_as_float(((unsigned)b) << 16); }
__device__ __forceinline__ bf16_t f2bf(float f) { unsigned u = __float_as_uint(f); u += 0x7FFFu + ((u >> 16) & 1u); return (bf16_t)(u >> 16); }
__device__ __forceinline__ int seq_of_row(int row) { return row < T_P ? (row >> 14) : 2 + ((row - T_P) >> 11); }
__device__ __forceinline__ int pos_of_row(int row) { return row < T_P ? (row & 16383) : (row & 2047); }
__device__ __forceinline__ float wave_sum(float v) {
#pragma unroll
    for (int o = 32; o >= 1; o >>= 1) v += __shfl_xor(v, o);
    return v;
}

struct EpiZinT {
    static constexpr bool PERM = true, AFTER_DRAIN = false;
    bf16_t* O; int ldc; const float* bias;
    __device__ __forceinline__ void operator()(const f32x4 (&acc)[2][2][4][2], const Unit& u, int wr, int wc, int fr, int fq) const {
        const int row0 = u.pm * 256 + wr * 64 + fr, col0 = u.pn * 256 + wc * 32 + 8 * fq;
        float bs[8];
#pragma unroll
        for (int r = 0; r < 8; ++r) bs[r] = bias[row0 + (r >> 2) * 128 + (r & 3) * 16];
#pragma unroll
        for (int ai = 0; ai < 2; ++ai)
#pragma unroll
            for (int m = 0; m < 4; ++m) { const int r = row0 + ai * 128 + m * 16; const float b = bs[ai * 4 + m]; bf16_t* rowp = O + (size_t)r * ldc + col0;
#pragma unroll
                for (int bj = 0; bj < 2; ++bj) { const f32x4 v0 = acc[ai][bj][m][0] + b, v1 = acc[ai][bj][m][1] + b;
                    u32x4 w; w.x = cvt_pk_bf16(v0[0], v0[1]); w.y = cvt_pk_bf16(v0[2], v0[3]); w.z = cvt_pk_bf16(v1[0], v1[1]); w.w = cvt_pk_bf16(v1[2], v1[3]);
                    *(u32x4*)(rowp + bj * 128) = w; } }
    }
};
struct EpiRes {
    static constexpr bool PERM = false, AFTER_DRAIN = false;
    bf16_t* X; const float* bias; const float* gate; int dry;
    __device__ __forceinline__ void operator()(const f32x4 (&acc)[2][2][4][2], const Unit& u, int wr, int wc, int fr, int fq) const {
        const int row0 = u.pm * 256 + wr * 64 + fr, col0 = u.pn * 256 + wc * 32 + 4 * fq;
        const float* gp = gate + (size_t)seq_of_row(u.pm * 256) * MODW + col0;
        bf16_t* xb = X + (size_t)row0 * 2048 + col0;
        u32x2 xv[2][8]; f32x4 gv[2], bv[2];
#pragma unroll
        for (int r = 0; r < 8; ++r) xv[0][r] = *(const u32x2*)(xb + (size_t)((r >> 2) * 128 + (r & 3) * 16) * 2048);
        gv[0] = *(const f32x4*)(gp); bv[0] = bias ? *(const f32x4*)(bias + col0) : (f32x4){0.f, 0.f, 0.f, 0.f};
#pragma unroll
        for (int cg = 0; cg < 4; ++cg) {
            const int bj = cg >> 1, n = cg & 1, coff = bj * 128 + n * 16;
            if (cg < 3) { const int c2 = ((cg + 1) >> 1) * 128 + ((cg + 1) & 1) * 16;
#pragma unroll
                for (int r = 0; r < 8; ++r) xv[(cg + 1) & 1][r] = *(const u32x2*)(xb + (size_t)((r >> 2) * 128 + (r & 3) * 16) * 2048 + c2);
                gv[(cg + 1) & 1] = *(const f32x4*)(gp + c2); bv[(cg + 1) & 1] = bias ? *(const f32x4*)(bias + col0 + c2) : (f32x4){0.f, 0.f, 0.f, 0.f}; }
#pragma unroll
            for (int r = 0; r < 8; ++r) { const u32x2 xo = xv[cg & 1][r];
                const f32x4 xf = {__uint_as_float(xo.x << 16), __uint_as_float(xo.x & 0xffff0000u), __uint_as_float(xo.y << 16), __uint_as_float(xo.y & 0xffff0000u)};
                const f32x4 x = xf + gv[cg & 1] * (acc[r >> 2][bj][r & 3][n] + bv[cg & 1]);
                u32x2 w; w.x = cvt_pk_bf16(x[0], x[1]); w.y = cvt_pk_bf16(x[2], x[3]);
                if (!dry) *(u32x2*)(xb + (size_t)((r >> 2) * 128 + (r & 3) * 16) * 2048 + coff) = w; }
        }
    }
};
struct EpiQKV {
    static constexpr bool PERM = true, AFTER_DRAIN = false;
    bf16_t* O; const cpx* rope;
    __device__ __forceinline__ void operator()(const f32x4 (&acc)[2][2][4][2], const Unit& u, int wr, int wc, int fr, int fq) const {
        const int row0 = u.pm * 256 + wr * 64 + fr, colt = u.pn * 256, col0 = colt + wc * 32 + 8 * fq;
        const int sidx = (colt % 3072) >> 10;
        const bool dorope = (sidx < 2) && (wc == 0);
        const float qs = (sidx == 0) ? QSCALE : 1.0f;
        f32x4 tt[2][4];
        if (dorope) { const cpx* rp = rope + (size_t)pos_of_row(row0) * 16 + 8 * (fq & 1);
            tt[0][0] = *(const f32x4*)(rp); tt[0][1] = *(const f32x4*)(rp + 2); tt[0][2] = *(const f32x4*)(rp + 4); tt[0][3] = *(const f32x4*)(rp + 6); }
#pragma unroll
        for (int g = 0; g < 8; ++g) { const int ai = g >> 2, m = g & 3; const int r = row0 + ai * 128 + m * 16; bf16_t* rowp = O + (size_t)r * QKVW + col0;
            f32x4 c0, c1, s0, s1;
            if (dorope) {
                if (g < 7) { const int r2 = row0 + ((g + 1) >> 2) * 128 + ((g + 1) & 3) * 16; const cpx* rp = rope + (size_t)pos_of_row(r2) * 16 + 8 * (fq & 1);
                    tt[(g + 1) & 1][0] = *(const f32x4*)(rp); tt[(g + 1) & 1][1] = *(const f32x4*)(rp + 2); tt[(g + 1) & 1][2] = *(const f32x4*)(rp + 4); tt[(g + 1) & 1][3] = *(const f32x4*)(rp + 6); }
                const f32x4 t0 = tt[g & 1][0], t1 = tt[g & 1][1], t2 = tt[g & 1][2], t3 = tt[g & 1][3];
                c0 = (f32x4){t0[0], t0[2], t1[0], t1[2]}; s0 = (f32x4){t0[1], t0[3], t1[1], t1[3]};
                c1 = (f32x4){t2[0], t2[2], t3[0], t3[2]}; s1 = (f32x4){t2[1], t2[3], t3[1], t3[3]}; }
#pragma unroll
            for (int bj = 0; bj < 2; ++bj) { f32x4 v0 = acc[ai][bj][m][0], v1 = acc[ai][bj][m][1];
                if (dorope) { f32x4 p0, p1;
#pragma unroll
                    for (int e = 0; e < 4; ++e) { p0[e] = __shfl_xor(v0[e], 32); p1[e] = __shfl_xor(v1[e], 32); }
                    if (fq < 2) { v0 = v0 * c0 - p0 * s0; v1 = v1 * c1 - p1 * s1; }
                    else        { v0 = v0 * c0 + p0 * s0; v1 = v1 * c1 + p1 * s1; } }
                v0 *= qs; v1 *= qs;
                u32x4 w; w.x = cvt_pk_bf16(v0[0], v0[1]); w.y = cvt_pk_bf16(v0[2], v0[3]); w.z = cvt_pk_bf16(v1[0], v1[1]); w.w = cvt_pk_bf16(v1[2], v1[3]);
                *(u32x4*)(rowp + bj * 128) = w; } }
    }
};
struct EpiFFN1 {
    static constexpr bool PERM = true, AFTER_DRAIN = false;
    bf16_t* O;
    __device__ __forceinline__ void operator()(const f32x4 (&acc)[2][2][4][2], const Unit& u, int wr, int wc, int fr, int fq) const {
        const int row0 = u.pm * 256 + wr * 64 + fr, col0 = u.pn * 128 + wc * 32 + 8 * fq;
#pragma unroll
        for (int ai = 0; ai < 2; ++ai)
#pragma unroll
            for (int m = 0; m < 4; ++m) { bf16_t* rowp = O + (size_t)(row0 + ai * 128 + m * 16) * DFF + col0; float o[8];
#pragma unroll
                for (int n = 0; n < 2; ++n)
#pragma unroll
                    for (int e = 0; e < 4; ++e) { const float g = acc[ai][0][m][n][e], up = acc[ai][1][m][n][e]; o[n * 4 + e] = g * __builtin_amdgcn_rcpf(1.0f + __expf(-g)) * up; }
                u32x4 w; w.x = cvt_pk_bf16(o[0], o[1]); w.y = cvt_pk_bf16(o[2], o[3]); w.z = cvt_pk_bf16(o[4], o[5]); w.w = cvt_pk_bf16(o[6], o[7]);
                *(u32x4*)rowp = w; }
    }
};
struct EpiTaps {
    static constexpr bool PERM = true, AFTER_DRAIN = false;
    _Float16* O;
    __device__ __forceinline__ void operator()(const f32x4 (&acc)[2][2][4][2], const Unit& u, int wr, int wc, int fr, int fq) const {
        typedef _Float16 h8 __attribute__((ext_vector_type(8)));
        const int row0 = u.pm * 256 + wr * 64 + fr, col0 = u.pn * 256 + wc * 32 + 8 * fq;
#pragma unroll
        for (int ai = 0; ai < 2; ++ai)
#pragma unroll
            for (int m = 0; m < 4; ++m) { _Float16* rowp = O + (size_t)(row0 + ai * 128 + m * 16) * NPOS + col0;
#pragma unroll
                for (int bj = 0; bj < 2; ++bj) { const f32x4 v0 = acc[ai][bj][m][0], v1 = acc[ai][bj][m][1]; h8 w;
                    w[0] = (_Float16)v0[0]; w[1] = (_Float16)v0[1]; w[2] = (_Float16)v0[2]; w[3] = (_Float16)v0[3]; w[4] = (_Float16)v1[0]; w[5] = (_Float16)v1[1]; w[6] = (_Float16)v1[2]; w[7] = (_Float16)v1[3];
                    *(h8*)(rowp + bj * 128) = w; } }
    }
};

__device__ __forceinline__ void ada_partials(const Params& p, LDSQ unsigned char* lds) {
    LDSQ float* cs = (LDSQ float*)lds;
    for (int i = pg8::otid(); i < 6 * 2048; i += NTHR) { const int b = i >> 11, k = i & 2047; const float c = b < 2 ? p.c_prompt[b * 2048 + k] : p.c_sample[(b - 2) * 2048 + k]; cs[i] = c / (1.0f + expf(-c)); }
    __syncthreads();
    float* part = (float*)(p.ws + WS_PART);
    for (int item = pg8::obid() * NTHR + pg8::otid(); item < 8 * 13312; item += pg8::ogrid() * NTHR) {
        const int chunk = item / 13312, c4 = item % 13312;
        const float* W; int ldw;
        if (c4 < 12288) { const int layer = c4 / 3072, col = (c4 % 3072) * 4; W = p.ada_w + (size_t)layer * 2048 * 12288 + col; ldw = 12288; }
        else { W = p.final_ada_w + (c4 - 12288) * 4; ldw = 4096; }
        f32x4 a0 = {0.f, 0.f, 0.f, 0.f}, a1 = a0, a2 = a0, a3 = a0, a4 = a0, a5 = a0;
        const int k0 = chunk * 256;
#pragma unroll 8
        for (int k = k0; k < k0 + 256; ++k) { const f32x4 w = *(const f32x4*)(W + (size_t)k * ldw);
            a0 += cs[k] * w; a1 += cs[2048 + k] * w; a2 += cs[4096 + k] * w; a3 += cs[6144 + k] * w; a4 += cs[8192 + k] * w; a5 += cs[10240 + k] * w; }
        float* o = part + (size_t)chunk * 6 * MODW + (size_t)c4 * 4;
        *(f32x4*)(o) = a0; *(f32x4*)(o + MODW) = a1; *(f32x4*)(o + 2 * MODW) = a2; *(f32x4*)(o + 3 * MODW) = a3; *(f32x4*)(o + 4 * MODW) = a4; *(f32x4*)(o + 5 * MODW) = a5;
    }
    __syncthreads();
}
__device__ __forceinline__ void ada_reduce(const Params& p) {
    const float* part = (const float*)(p.ws + WS_PART); float* mod = (float*)(p.ws + WS_MOD);
    for (int i = pg8::obid() * NTHR + pg8::otid(); i < 6 * MODW; i += pg8::ogrid() * NTHR) {
        const int c = i % MODW; float s = c < 49152 ? p.ada_b[c] : p.final_ada_b[c - 49152];
#pragma unroll
        for (int ch = 0; ch < 8; ++ch) s += part[(size_t)ch * 6 * MODW + i];
        mod[i] = s;
    }
}
__device__ __forceinline__ void rope_table(const Params& p) {
    cpx* rope = (cpx*)(p.ws + WS_ROPE);
    for (int i = pg8::obid() * NTHR + pg8::otid(); i < 16384 * 16; i += pg8::ogrid() * NTHR) {
        const int pos = i >> 4, f = i & 15; const float inv = powf(500000.0f, -(float)f / 16.0f); const float ang = (float)pos * inv;
        float s, c; sincosf(ang, &s, &c); rope[i] = mkc(c, s);
    }
}
__device__ __forceinline__ void filter_mlp(const Params& p) {
    const int lane = pg8::otid() & 63, gw = pg8::obid() * 8 + (pg8::otid() >> 6);
    bf16_t* a2x = (bf16_t*)(p.ws + WS_A2X);
    for (int q = gw; q < 2 * NPOS; q += pg8::ogrid() * 8) {
        const int j = q / NPOS, r = q % NPOS; const int L = r < 16384 ? 16384 : 2048, pos = r < 16384 ? r : r - 16384;
        const float fpos = (float)pos;
        float z = 0.f;
        if (lane == 0) z = fpos / (float)(L - 1);
        else if (lane <= 32) { const int bi = (lane - 1) & 15; const float band = 1e-4f + (float)bi * ((15.0f - 1e-4f) / 15.0f);
            const float ang = ((6.283185307179586f * fpos) * band) / (float)L; z = lane <= 16 ? cosf(ang) : -sinf(ang); }
        const float* w1 = p.hy_fw1 + j * 33 * 64; const float* w2 = p.hy_fw2 + j * 64 * 64;
        float acc = p.hy_fb1[j * 64 + lane];
#pragma unroll
        for (int m = 0; m < 33; ++m) acc += __shfl(z, m) * w1[m * 64 + lane];
        const float a1 = sinf(p.hy_ffreq[j * 128 + lane] * acc);
        acc = p.hy_fb2[j * 64 + lane];
#pragma unroll
        for (int m = 0; m < 64; ++m) acc += __shfl(a1, m) * w2[m * 64 + lane];
        const float a2 = sinf(p.hy_ffreq[j * 128 + 64 + lane] * acc);
        const bf16_t hi = f2bf(a2), lo = f2bf(a2 - bf2f(hi));
        bf16_t* o = a2x + ((size_t)j * NPOS + r) * 256;
        o[lane] = hi; o[64 + lane] = hi; o[128 + lane] = lo; o[192 + lane] = 0;
    }
    bf16_t* w3x = (bf16_t*)(p.ws + WS_W3X);
    for (int i = pg8::obid() * NTHR + pg8::otid(); i < 2 * 8192 * 64; i += pg8::ogrid() * NTHR) {
        const int k = i & 63, col = (i >> 6) & 8191, j = i >> 19;
        const float v = p.hy_fw3[(size_t)j * 64 * 8192 + (size_t)k * 8192 + col];
        const bf16_t hi = f2bf(v), lo = f2bf(v - bf2f(hi));
        bf16_t* o = w3x + ((size_t)j * 8192 + col) * 256;
        o[k] = hi; o[64 + k] = lo; o[128 + k] = hi; o[192 + k] = 0;
    }
}
__device__ __forceinline__ void convert_T(LDSQ unsigned char* lds, const float* src, int K, int N, bf16_t* dst, int ffs) {
    LDSQ float* tile = (LDSQ float*)lds;
    const int tid = pg8::otid(), ntn = N >> 8, ntiles = (K >> 6) * ntn, stride = pg8::ogrid();
    const int r = tid >> 6, c4 = tid & 63;
    f32x4 v[8];
    int ti = pg8::obid();
    if (ti < ntiles) { const int tk = ti / ntn, tn = ti % ntn;
#pragma unroll
        for (int it = 0; it < 8; ++it) v[it] = *(const f32x4*)(src + (size_t)(tk * 64 + r + 8 * it) * N + tn * 256 + 4 * c4); }
    for (; ti < ntiles; ti += stride) {
        const int tk = ti / ntn, tn = ti % ntn;
#pragma unroll
        for (int it = 0; it < 8; ++it) { LDSQ float* tp = tile + (r + 8 * it) * 257 + 4 * c4; tp[0] = v[it][0]; tp[1] = v[it][1]; tp[2] = v[it][2]; tp[3] = v[it][3]; }
        __syncthreads();
        if (ti + stride < ntiles) { const int t2 = ti + stride, tk2 = t2 / ntn, tn2 = t2 % ntn;
#pragma unroll
            for (int it = 0; it < 8; ++it) v[it] = *(const f32x4*)(src + (size_t)(tk2 * 64 + r + 8 * it) * N + tn2 * 256 + 4 * c4); }
        { const int n = tid >> 1, kh = tid & 1; const int nn = tn * 256 + n; const int row = ffs < 0 ? nn : (256 * (nn >> 7) + 128 * ffs + (nn & 127));
          bf16_t* dp = dst + (size_t)row * K + tk * 64 + kh * 32;
#pragma unroll
          for (int q = 0; q < 4; ++q) { float f[8];
#pragma unroll
              for (int e = 0; e < 8; ++e) f[e] = tile[(kh * 32 + q * 8 + e) * 257 + n];
              u32x4 w; w.x = cvt_pk_bf16(f[0], f[1]); w.y = cvt_pk_bf16(f[2], f[3]); w.z = cvt_pk_bf16(f[4], f[5]); w.w = cvt_pk_bf16(f[6], f[7]);
              *(u32x4*)(dp + q * 8) = w; } }
        __syncthreads();
    }
}
template <bool FINAL, bool SRC_F32> __device__ __forceinline__ void norm_rows(const float* xp, const float* xs, bf16_t* xb, const float* g, const float* modl, int sh_off, int sc_off, bf16_t* H, float* outf) {
    const int lane = pg8::otid() & 63, gw = pg8::obid() * 8 + (pg8::otid() >> 6), nw = pg8::ogrid() * 8;
    const int rpw = (T + nw - 1) / nw, r0 = gw * rpw, r1 = (r0 + rpw < T) ? r0 + rpw : T;
    if (r0 >= r1) return;
    f32x4 gs[8], sh[8]; int curseq = -1;
    struct RowBuf { f32x4 f[SRC_F32 ? 8 : 1]; u32x2 b[SRC_F32 ? 1 : 8]; };
    auto request = [&](RowBuf& B, int row) {
        if (SRC_F32) { const f32x4* src = (const f32x4*)(row < T_P ? xp + (size_t)row * 2048 : xs + (size_t)(row - T_P) * 2048);
#pragma unroll
            for (int i = 0; i < 8; ++i) B.f[i] = src[lane + 64 * i]; }
        else { const u32x2* src = (const u32x2*)(xb + (size_t)row * 2048);
#pragma unroll
            for (int i = 0; i < 8; ++i) B.b[i] = src[lane + 64 * i]; } };
    auto process = [&](RowBuf& B, int row, int next) {
        f32x4 v[8];
#pragma unroll
        for (int i = 0; i < 8; ++i) { if (SRC_F32) v[i] = B.f[i]; else v[i] = (f32x4){__uint_as_float(B.b[i].x << 16), __uint_as_float(B.b[i].x & 0xffff0000u), __uint_as_float(B.b[i].y << 16), __uint_as_float(B.b[i].y & 0xffff0000u)}; }
        if (next < r1) request(B, next);
        const int seq = seq_of_row(row);
        if (seq != curseq) { curseq = seq; const float* mod = modl + (size_t)seq * MODW;
#pragma unroll
            for (int i = 0; i < 8; ++i) { const int col = (lane + 64 * i) * 4; gs[i] = *(const f32x4*)(g + col); sh[i] = *(const f32x4*)(mod + sc_off + col); }
#pragma unroll
            for (int i = 0; i < 8; ++i) { const int col = (lane + 64 * i) * 4; const f32x4 sft = *(const f32x4*)(mod + sh_off + col); gs[i] = gs[i] * (1.0f + sh[i]); sh[i] = sft; } }
        float ss = 0.f;
#pragma unroll
        for (int i = 0; i < 8; ++i) ss += v[i][0] * v[i][0] + v[i][1] * v[i][1] + v[i][2] * v[i][2] + v[i][3] * v[i][3];
        ss = wave_sum(ss);
        const float rstd = 1.0f / sqrtf(ss * (1.0f / 2048.0f) + EPS);
#pragma unroll
        for (int i = 0; i < 8; ++i) { const int col = (lane + 64 * i) * 4;
            const f32x4 h = (v[i] * rstd) * gs[i] + sh[i];
            if (FINAL) *(f32x4*)(outf + (size_t)row * 2048 + col) = h;
            else { u32x2 w; w.x = cvt_pk_bf16(h[0], h[1]); w.y = cvt_pk_bf16(h[2], h[3]); *(u32x2*)(H + (size_t)row * 2048 + col) = w;
                if (SRC_F32) { u32x2 c; c.x = cvt_pk_bf16(v[i][0], v[i][1]); c.y = cvt_pk_bf16(v[i][2], v[i][3]); *(u32x2*)(xb + (size_t)row * 2048 + col) = c; } } } };
    if (SRC_F32) {
        RowBuf B0, B1;
        request(B0, r0); if (r0 + 1 < r1) request(B1, r0 + 1);
        for (int row = r0; row < r1; row += 2) { process(B0, row, row + 2); if (row + 1 < r1) process(B1, row + 1, row + 3); }
    } else {
        RowBuf B0, B1, B2;
        request(B0, r0); if (r0 + 1 < r1) request(B1, r0 + 1); if (r0 + 2 < r1) request(B2, r0 + 2);
        for (int row = r0; row < r1; row += 3) {
            process(B0, row, row + 3);
            if (row + 1 < r1) process(B1, row + 1, row + 4);
            if (row + 2 < r1) process(B2, row + 2, row + 5);
        }
    }
}
__device__ __forceinline__ void final_norm_phase(const Params& p) {
    norm_rows<true, false>(nullptr, nullptr, (bf16_t*)(p.ws + WS_XB), p.final_norm, (const float*)(p.ws + WS_MOD) + 49152, 0, 2048, nullptr, p.out);
}
__device__ __forceinline__ void transpose_phase(const Params& p, LDSQ unsigned char* lds) {
    LDSQ bf16_t* tile = (LDSQ bf16_t*)lds;
    const bf16_t* zin = (const bf16_t*)(p.ws + WS_BIG + BIG_ZINT); bf16_t* H = (bf16_t*)(p.ws + WS_H);
    const int tid = pg8::otid(), stride = pg8::ogrid();
    const int cr = tid >> 5, tq = tid & 31;
    u32x4 v[4];
    int ti = pg8::obid();
    if (ti < 32 * 160) { const int tc = ti / 160, tt = ti % 160;
#pragma unroll
        for (int it = 0; it < 4; ++it) v[it] = *(const u32x4*)(zin + (size_t)(tc * 64 + cr + 16 * it) * T + tt * 256 + tq * 8); }
    for (; ti < 32 * 160; ti += stride) {
        const int tc = ti / 160, tt = ti % 160;
#pragma unroll
        for (int it = 0; it < 4; ++it) *(LDSQ u32x4*)(tile + (cr + 16 * it) * 264 + tq * 8) = v[it];
        __syncthreads();
        if (ti + stride < 32 * 160) { const int t2 = ti + stride, tc2 = t2 / 160, tt2 = t2 % 160;
#pragma unroll
            for (int it = 0; it < 4; ++it) v[it] = *(const u32x4*)(zin + (size_t)(tc2 * 64 + cr + 16 * it) * T + tt2 * 256 + tq * 8); }
        { const int cq = tid & 7, tk = tid >> 3;
#pragma unroll
          for (int it = 0; it < 4; ++it) { const int tok = tk + 64 * it; unsigned w[4];
#pragma unroll
              for (int e = 0; e < 4; ++e) { const unsigned lo = tile[(cq * 8 + 2 * e) * 264 + tok], hi = tile[(cq * 8 + 2 * e + 1) * 264 + tok]; w[e] = lo | (hi << 16); }
              *(u32x4*)(H + (size_t)(tt * 256 + tok) * 2048 + tc * 64 + cq * 8) = (u32x4){w[0], w[1], w[2], w[3]}; } }
        __syncthreads();
    }
}

__host__ __device__ constexpr float cos64q(int k) {
    constexpr float t[17] = {1.0f, 0.99518472667219693f, 0.98078528040323043f, 0.95694033573220882f, 0.92387953251128674f, 0.88192126434835505f, 0.83146961230254524f,
        0.77301045336273699f, 0.70710678118654757f, 0.63439328416364549f, 0.55557023301960229f, 0.47139673682599781f, 0.38268343236508984f, 0.29028467725446233f,
        0.19509032201612833f, 0.09801714032956077f, 0.0f};
    return t[k];
}
__host__ __device__ constexpr float cos64(int k) { k &= 63; return k <= 16 ? cos64q(k) : k <= 32 ? -cos64q(32 - k) : k <= 48 ? -cos64q(k - 32) : cos64q(64 - k); }
__host__ __device__ constexpr float sin64(int k) { return cos64((k + 48) & 63); }
template <int R> __host__ __device__ constexpr int brev(int k) { int r = 0; for (int b = 1; b < R; b <<= 1) { r = (r << 1) | (k & 1); k >>= 1; } return r; }

typedef _Float16 hcpx __attribute__((ext_vector_type(2)));
typedef _Float16 hcpx2 __attribute__((ext_vector_type(4)));
__device__ __forceinline__ hcpx h_of(cpx a) { hcpx r; r.x = (_Float16)a.x; r.y = (_Float16)a.y; return r; }
__device__ __forceinline__ cpx c_of(hcpx a) { return mkc((float)a.x, (float)a.y); }
__device__ __forceinline__ hcpx2 h2_of(cpx a, cpx b) { hcpx2 r; r.x = (_Float16)a.x; r.y = (_Float16)a.y; r.z = (_Float16)b.x; r.w = (_Float16)b.y; return r; }
#define VA __device__ __forceinline__ float
VA f_mul(float a, float b) { float r; asm("v_mul_f32_e32 %0, %1, %2" : "=v"(r) : "v"(a), "v"(b)); return r; }
VA f_fma(float a, float b, float c) { float r; asm("v_fma_f32 %0, %1, %2, %3" : "=v"(r) : "v"(a), "v"(b), "v"(c)); return r; }
VA f_fms(float a, float b, float c) { float r; asm("v_fma_f32 %0, %1, %2, -%3" : "=v"(r) : "v"(a), "v"(b), "v"(c)); return r; }
#undef VA
__device__ __forceinline__ cpx cmul(cpx a, cpx b) { float rx, ry;
    asm("v_mul_f32_e32 %0, %3, %5\n\tv_mul_f32_e32 %1, %3, %4\n\tv_fma_f32 %0, %2, %4, -%0\n\tv_fma_f32 %1, %2, %5, %1" : "=&v"(rx), "=&v"(ry) : "v"(a.x), "v"(a.y), "v"(b.x), "v"(b.y)); return mkc(rx, ry); }
__device__ __forceinline__ cpx cmulc(cpx a, cpx b) { float rx, ry;
    asm("v_mul_f32_e32 %0, %3, %5\n\tv_mul_f32_e32 %1, %2, %5\n\tv_fma_f32 %0, %2, %4, %0\n\tv_fma_f32 %1, %3, %4, -%1" : "=&v"(rx), "=&v"(ry) : "v"(a.x), "v"(a.y), "v"(b.x), "v"(b.y)); return mkc(rx, ry); }

template <int R, bool INV, int H, int P> __device__ __forceinline__ void bfly(cpx (&v)[R]) {
    constexpr int b = (P / H) * 2 * H, i = P % H, e = i * (32 / H);
    float ux = v[b + i].x, uy = v[b + i].y, wx = v[b + i + H].x, wy = v[b + i + H].y;
    if constexpr (e == 0) { float dx, dy;
        asm("v_sub_f32_e32 %2, %0, %4\n\tv_sub_f32_e32 %3, %1, %5\n\tv_add_f32_e32 %0, %0, %4\n\tv_add_f32_e32 %1, %1, %5" : "+v"(ux), "+v"(uy), "=&v"(dx), "=&v"(dy) : "v"(wx), "v"(wy));
        wx = dx; wy = dy; }
    else if constexpr (e == 16) { float ox, oy;
        if constexpr (!INV) asm("v_sub_f32_e32 %2, %1, %5\n\tv_sub_f32_e32 %3, %4, %0\n\tv_add_f32_e32 %0, %0, %4\n\tv_add_f32_e32 %1, %1, %5" : "+v"(ux), "+v"(uy), "=&v"(ox), "=&v"(oy) : "v"(wx), "v"(wy));
        else                asm("v_sub_f32_e32 %2, %5, %1\n\tv_sub_f32_e32 %3, %0, %4\n\tv_add_f32_e32 %0, %0, %4\n\tv_add_f32_e32 %1, %1, %5" : "+v"(ux), "+v"(uy), "=&v"(ox), "=&v"(oy) : "v"(wx), "v"(wy));
        wx = ox; wy = oy; }
    else { constexpr float c = cos64(e), s = INV ? sin64(e) : -sin64(e);
        constexpr unsigned cb = __builtin_bit_cast(unsigned, c), sb = __builtin_bit_cast(unsigned, s), nsb = __builtin_bit_cast(unsigned, -s);
        float dx, dy;
        asm("v_sub_f32_e32 %4, %0, %2\n\tv_sub_f32_e32 %5, %1, %3\n\tv_add_f32_e32 %0, %0, %2\n\tv_add_f32_e32 %1, %1, %3\n\t"
            "v_mul_f32_e32 %2, %8, %5\n\tv_mul_f32_e32 %3, %6, %5\n\tv_fmamk_f32 %2, %4, %6, %2\n\tv_fmamk_f32 %3, %4, %7, %3"
            : "+v"(ux), "+v"(uy), "+v"(wx), "+v"(wy), "=&v"(dx), "=&v"(dy) : "i"(cb), "i"(sb), "i"(nsb)); }
    v[b + i] = mkc(ux, uy); v[b + i + H] = mkc(wx, wy);
}
template <int R, bool INV, int H, int... Ps> __device__ __forceinline__ void dft_stage(cpx (&v)[R], std::integer_sequence<int, Ps...>) { (bfly<R, INV, H, Ps>(v), ...); }
template <int R, bool INV, int H> __device__ __forceinline__ void dft_stages(cpx (&v)[R]) {
    dft_stage<R, INV, H>(v, std::make_integer_sequence<int, R / 2>{});
    if constexpr (H > 1) dft_stages<R, INV, H / 2>(v);
}
template <int R, bool INV> __device__ __forceinline__ void dft_r2(cpx (&v)[R]) { dft_stages<R, INV, R / 2>(v); }
template <int R, bool CONJ, bool BREV> __device__ __forceinline__ void apply_pows(cpx (&v)[R], cpx w) {
    constexpr int H = R > 16 ? 16 : R;
    cpx pw[H];
    pw[1] = w;
#pragma unroll
    for (int k = 2; k < H; ++k) pw[k] = (k & 1) ? cmul(pw[k - 1], w) : cmul(pw[k / 2], pw[k / 2]);
#pragma unroll
    for (int k = 1; k < H; ++k) { const int idx = BREV ? brev<R>(k) : k; v[idx] = CONJ ? cmulc(v[idx], pw[k]) : cmul(v[idx], pw[k]); }
    if (R > 16) {
        const cpx w16 = cmul(pw[8], pw[8]);
#pragma unroll
        for (int k = 0; k < R - 16; ++k) { const cpx q = k == 0 ? w16 : cmul(pw[k], w16); const int idx = BREV ? brev<R>(16 + k) : 16 + k; v[idx] = CONJ ? cmulc(v[idx], q) : cmul(v[idx], q); }
    }
}
__device__ __forceinline__ int phys(int i) { return i + (i >> 5); }
constexpr int TW_OFF = 135168 + 64;
template <int S> __host__ __device__ constexpr int poff(int j) { return S >= 32 ? j * (S + S / 32) : j * S + ((j * S) >> 5); }
typedef hcpx PreRegs[32];
template <int R, int S> __device__ __forceinline__ void fft_prefetch(int t, const hcpx* gio, PreRegs& pre) {
    constexpr int G = 32 / R;
#pragma unroll
    for (int gi = 0; gi < G; ++gi) { const int gam = gi * 512 + t, hi = gam / S, lo = gam % S, base = hi * (R * S) + lo;
#pragma unroll
        for (int j = 0; j < R; ++j) pre[gi * R + j] = __builtin_nontemporal_load(gio + base + j * S); }
}
template <int R, int S, bool INV, int IO> __device__ __forceinline__ void fft_pass(LDSQ cpx* A, int t, hcpx* gio, const PreRegs& pre) {
    constexpr int G = 32 / R;
    asm volatile("" : "+v"(t) :: "memory");
    const LDSQ cpx* TW = (const LDSQ cpx*)((LDSQ unsigned char*)A + TW_OFF);
    cpx v[G][R]; cpx tw[G];
#pragma unroll
    for (int gi = 0; gi < G; ++gi) {
        const int gam = gi * 512 + t, hi = gam / S, lo = gam % S, base = hi * (R * S) + lo; const LDSQ cpx* Ab = A + phys(base);
#pragma unroll
        for (int j = 0; j < R; ++j) v[gi][j] = (IO == 3) ? c_of(pre[gi * R + j]) : (IO == 1) ? c_of(__builtin_nontemporal_load(gio + base + j * S)) : Ab[poff<S>(j)];
        tw[gi] = TW[lo * (16384 / (R * S))];
    }
#pragma unroll
    for (int gi = 0; gi < G; ++gi) {
        const int gam = gi * 512 + t, hi = gam / S, lo = gam % S, base = hi * (R * S) + lo; LDSQ cpx* Ab = A + phys(base);
        if (!INV) {
            dft_r2<R, false>(v[gi]);
            apply_pows<R, false, true>(v[gi], tw[gi]);
#pragma unroll
            for (int k = 0; k < R; ++k) { if (IO == 2) gio[base + k * S] = h_of(v[gi][brev<R>(k)]); else Ab[poff<S>(k)] = v[gi][brev<R>(k)]; }
        } else {
            apply_pows<R, true, false>(v[gi], tw[gi]);
            dft_r2<R, true>(v[gi]);
#pragma unroll
            for (int j = 0; j < R; ++j) { if (IO == 2) gio[base + j * S] = h_of(v[gi][brev<R>(j)]); else Ab[poff<S>(j)] = v[gi][brev<R>(j)]; }
        }
    }
}
template <int R, int MODE> __device__ __forceinline__ void fft_mid(LDSQ cpx* A, int t, hcpx* spec, float scale) {
    constexpr int G = 32 / R;
    asm volatile("" : "+v"(t) :: "memory");
    hcpx2 sp[G][R / 2];
    if (MODE == 1) {
#pragma unroll
        for (int gi = 0; gi < G; ++gi)
#pragma unroll
            for (int k2 = 0; k2 < R / 2; ++k2) sp[gi][k2] = *(const hcpx2*)(spec + (size_t)(gi * 512 + t) * R + 2 * k2);
    }
#pragma unroll
    for (int gi = 0; gi < G; ++gi) {
        const int gam = gi * 512 + t, base = gam * R;
        cpx v[R];
        LDSQ cpx* Ab = A + phys(base);
#pragma unroll
        for (int j = 0; j < R; ++j) v[j] = Ab[j];
        dft_r2<R, false>(v);
        if (MODE == 0) {
#pragma unroll
            for (int k2 = 0; k2 < R / 2; ++k2) { const cpx x = v[brev<R>(2 * k2)], y = v[brev<R>(2 * k2 + 1)];
                *(hcpx2*)(spec + (size_t)base + 2 * k2) = h2_of(mkc(x.x * scale, x.y * scale), mkc(y.x * scale, y.y * scale)); }
        } else {
            cpx x[R];
#pragma unroll
            for (int k2 = 0; k2 < R / 2; ++k2) { const hcpx2 s = sp[gi][k2]; x[2 * k2] = cmul(v[brev<R>(2 * k2)], mkc((float)s.x * scale, (float)s.y * scale)); x[2 * k2 + 1] = cmul(v[brev<R>(2 * k2 + 1)], mkc((float)s.z * scale, (float)s.w * scale)); }
            dft_r2<R, true>(x);
#pragma unroll
            for (int j = 0; j < R; ++j) Ab[j] = x[brev<R>(j)];
        }
    }
}
#define GL_DRAIN() asm volatile("s_waitcnt vmcnt(0)" ::: "memory")
struct NoHook { __device__ __forceinline__ void operator()() const {} };
template <int LOG2L, bool INV, int GIO, class Hook = NoHook> __device__ __forceinline__ void fft_outer(LDSQ cpx* A, int t, hcpx* gio, const hcpx* pfsrc, PreRegs& pre, Hook hook = Hook()) {
    constexpr int R1 = LOG2L == 14 ? 32 : 16, S1 = LOG2L == 14 ? 512 : 128, S2 = LOG2L == 14 ? 16 : 8;
    if (!INV) { fft_pass<R1, S1, false, GIO == 3 ? 3 : 0>(A, t, nullptr, pre); __syncthreads(); fft_pass<R1, S2, false, 0>(A, t, nullptr, pre); GL_DRAIN(); __syncthreads(); }
    else      { fft_pass<R1, S2, true, 0>(A, t, nullptr, pre); __syncthreads();
                if (GIO == 2) fft_prefetch<R1, S1>(t, pfsrc, pre);
                hook();
                fft_pass<R1, S1, true, GIO == 2 ? 2 : 0>(A, t, gio, pre); if (GIO != 2) GL_DRAIN(); __syncthreads(); }
}
template <int LOG2L, int SRC, int DST, class Hook = NoHook> __device__ __forceinline__ void fft_conv(LDSQ cpx* A, int t, hcpx* spec, hcpx* gdst, const hcpx* pfsrc, PreRegs& pre, Hook hook = Hook()) {
    fft_outer<LOG2L, false, SRC>(A, t, nullptr, nullptr, pre);
    fft_mid<LOG2L == 14 ? 16 : 8, 1>(A, t, spec, 1.0f / (float)(1 << LOG2L));
    if (SRC == 3) GL_DRAIN();
    __syncthreads();
    fft_outer<LOG2L, true, DST>(A, t, gdst, pfsrc, pre, hook);
}

__device__ __forceinline__ void sconv4r(u32x2 q, unsigned zmr, unsigned zpr, float w0, float w1, float w2, float bb, float (&o)[4]) {
    const float zm = __uint_as_float(zmr << 16), zp = __uint_as_float(zpr << 16);
    const float z0 = __uint_as_float(q.x << 16), z1 = __uint_as_float(q.x & 0xffff0000u), z2 = __uint_as_float(q.y << 16), z3 = __uint_as_float(q.y & 0xffff0000u);
    o[0] = w0 * zm + w1 * z0 + w2 * z1 + bb; o[1] = w0 * z0 + w1 * z1 + w2 * z2 + bb; o[2] = w0 * z1 + w1 * z2 + w2 * z3 + bb; o[3] = w0 * z2 + w1 * z3 + w2 * zp + bb;
}
typedef _Float16 h4 __attribute__((ext_vector_type(4)));
__device__ __forceinline__ void tapquad(h4 a, h4 bq, unsigned b0bits, float wf, float wb, float rf1, float rf2, float rf3, float rb1, float rb2, float rb3, float (&fa)[4], float (&fb)[4]) {
    const float b0 = (float)__builtin_bit_cast(_Float16, (unsigned short)b0bits);
    fa[0] = (float)a.x * wf; fa[1] = (float)a.y * (wf * rf1); fa[2] = (float)a.z * (wf * rf2); fa[3] = (float)a.w * (wf * rf3);
    fb[0] = b0 * wb; fb[1] = (float)bq.w * (wb * rb1); fb[2] = (float)bq.z * (wb * rb2); fb[3] = (float)bq.y * (wb * rb3);
}
template <int LOG2L> struct SweepIdx {
    static constexpr int L = 1 << LOG2L, QS = L / 32;
    int t, seq, n00, a00; cpx wq0, w1, w2, w3;
    __device__ __forceinline__ SweepIdx(int t_, bool need_w) { t = t_; asm volatile("" : "+v"(t) :: "memory"); seq = (LOG2L == 14) ? 0 : (t >> 6); const int q0 = (LOG2L == 14) ? t : (t & 63); n00 = 4 * q0; a00 = seq * L + n00;
        if (need_w) { float sb, cb; sincospif(-(float)n00 / (float)L, &sb, &cb); wq0 = mkc(cb, sb);
            sincospif(-1.0f / (float)L, &sb, &cb); w1 = mkc(cb, sb); w2 = cmul(w1, w1); w3 = cmul(w2, w1); } }
};
#define WQS mkc(0.92387953251128674f, -0.38268343236508978f)
struct TapWin { float wf0, wfs, rf1, rf2, rf3, wb0, wbs, rb1, rb2, rb3; };
template <int LOG2L> __device__ __forceinline__ TapWin tap_windows(float df, float db, int n00) {
    constexpr int L = 1 << LOG2L, QS = L / 32; TapWin w;
    w.wf0 = expf(-df * (float)n00); w.wfs = expf(-df * (float)(4 * QS)); w.rf1 = expf(-df); w.rf2 = w.rf1 * w.rf1; w.rf3 = w.rf2 * w.rf1;
    w.wb0 = expf(-db * (float)(L - n00)); w.wbs = expf(db * (float)(4 * QS)); w.rb1 = expf(db); w.rb2 = w.rb1 * w.rb1; w.rb3 = w.rb2 * w.rb1; return w;
}
template <int LOG2L> __device__ __forceinline__ void sweep_taps2(LDSQ cpx* A, int t_, const _Float16* tf0, const _Float16* tb0, const _Float16* tf1, const _Float16* tb1, float df0, float db0, float df1, float db1, hcpx* hos, float& ss0, float& ss1) {
    constexpr int L = 1 << LOG2L, QS = L / 32; const SweepIdx<LOG2L> X(t_, true);
    const TapWin W0 = tap_windows<LOG2L>(df0, db0, X.n00), W1 = tap_windows<LOG2L>(df1, db1, X.n00);
    float s0 = 0.f, s1 = 0.f, wf0 = W0.wf0, wb0 = W0.wb0, wf1 = W1.wf0, wb1 = W1.wb0;
    cpx wn = X.wq0;
    h4 ra0[8], rb0[8], ra1[8], rb1[8]; unsigned rc0[8], rc1[8];
#pragma unroll
    for (int i = 0; i < 8; ++i) { const int n = 4 * (i * QS) + X.n00, nb = n > 0 ? L - n : L - 1;
        ra0[i] = *(const h4*)(tf0 + n); rb0[i] = *(const h4*)(tb0 + L - n - 4); rc0[i] = ((const unsigned short*)tb0)[nb];
        ra1[i] = *(const h4*)(tf1 + n); rb1[i] = *(const h4*)(tb1 + L - n - 4); rc1[i] = ((const unsigned short*)tb1)[nb]; }
#pragma unroll
    for (int i = 0; i < 8; ++i) { const int n = 4 * (i * QS) + X.n00; float fa0[4], fb0[4], fa1[4], fb1[4]; const unsigned hm = n > 0 ? 0xffffu : 0u;
        tapquad(ra0[i], rb0[i], rc0[i] & hm, wf0, wb0, W0.rf1, W0.rf2, W0.rf3, W0.rb1, W0.rb2, W0.rb3, fa0, fb0);
        tapquad(ra1[i], rb1[i], rc1[i] & hm, wf1, wb1, W1.rf1, W1.rf2, W1.rf3, W1.rb1, W1.rb2, W1.rb3, fa1, fb1);
        LDSQ cpx* ap = A + phys(X.a00 + 4 * i * QS); hcpx* hp = hos + X.a00 + 4 * i * QS;
#pragma unroll
        for (int e = 0; e < 4; ++e) { s0 += fa0[e] * fa0[e] + fb0[e] * fb0[e]; s1 += fa1[e] * fa1[e] + fb1[e] * fb1[e]; ap[e] = mkc(fa0[e] + fb0[e], fa1[e] + fb1[e]); }
        const cpx wa = cmul(wn, X.w1), wb2 = cmul(wn, X.w2), wc = cmul(wn, X.w3);
        const cpx y0 = cmul(mkc(fa0[0] - fb0[0], fa1[0] - fb1[0]), wn), y1 = cmul(mkc(fa0[1] - fb0[1], fa1[1] - fb1[1]), wa);
        const cpx y2 = cmul(mkc(fa0[2] - fb0[2], fa1[2] - fb1[2]), wb2), y3 = cmul(mkc(fa0[3] - fb0[3], fa1[3] - fb1[3]), wc);
        *(hcpx2*)hp = h2_of(y0, y1); *(hcpx2*)(hp + 2) = h2_of(y2, y3);
        wn = cmul(wn, WQS); wf0 *= W0.wfs; wb0 *= W0.wbs; wf1 *= W1.wfs; wb1 *= W1.wbs; }
    ss0 = s0; ss1 = s1;
}
template <int LOG2L, int PART> __device__ __forceinline__ void fft_mid_sep(LDSQ cpx* A, int t, hcpx* spec0, hcpx* spec1, const LDSQ float* red, const float* skp0, const float* skp1) {
    constexpr int R = LOG2L == 14 ? 16 : 8, G = 32 / R, NB = LOG2L == 14 ? 32 : 16, NG = NB * NB;
    asm volatile("" : "+v"(t) :: "memory");
#pragma unroll
    for (int gi = 0; gi < G; ++gi) {
        cpx v[R]; LDSQ cpx* Ab = A + phys((gi * 512 + t) * R);
#pragma unroll
        for (int j = 0; j < R; ++j) v[j] = Ab[j];
        dft_r2<R, false>(v);
#pragma unroll
        for (int k = 0; k < R; ++k) Ab[k] = v[brev<R>(k)];
    }
    __syncthreads();
#pragma unroll
    for (int gi = 0; gi < G; ++gi) {
        const int gam = gi * 512 + t, seq = gam / NG, g = gam % NG, k1 = g / NB, k2 = g % NB;
        const int gp = PART == 1 ? NG - 1 - g : (k1 ? (NB - k1) * NB + (NB - 1 - k2) : (k2 ? NB - k2 : 0));
        const bool wrap = PART == 0 && g == 0;
        const LDSQ cpx* Ab = A + phys(gam * R); const LDSQ cpx* Ap = A + phys((seq * NG + gp) * R);
        cpx z[R], q[R];
#pragma unroll
        for (int k = 0; k < R; ++k) { z[k] = Ab[k]; q[k] = Ap[k]; }
        float ss0, ss1;
        if (LOG2L == 14) { ss0 = red[0] + red[1] + red[2] + red[3] + red[4] + red[5] + red[6] + red[7]; ss1 = red[8] + red[9] + red[10] + red[11] + red[12] + red[13] + red[14] + red[15]; }
        else { ss0 = red[seq]; ss1 = red[8 + seq]; }
        const float n0 = 0.25f / sqrtf(ss0 + EPS), n1 = 0.25f / sqrtf(ss1 + EPS), h0 = 0.5f * skp0[seq], h1 = 0.5f * skp1[seq];
        hcpx* s0p = spec0 + (size_t)gam * R; hcpx* s1p = spec1 + (size_t)gam * R;
#pragma unroll
        for (int k2_ = 0; k2_ < R / 2; ++k2_) { cpx o0[2], o1[2];
#pragma unroll
            for (int e = 0; e < 2; ++e) { const int k = 2 * k2_ + e; cpx zp = q[R - 1 - k]; const cpx zw = q[(R - k) & (R - 1)];
                if (PART == 0) { zp.x = wrap ? zw.x : zp.x; zp.y = wrap ? zw.y : zp.y; }
                o0[e] = mkc((z[k].x + zp.x) * n0 + h0, (z[k].y - zp.y) * n0); o1[e] = mkc((z[k].y + zp.y) * n1 + h1, (zp.x - z[k].x) * n1); }
            *(hcpx2*)(s0p + 2 * k2_) = h2_of(o0[0], o0[1]); *(hcpx2*)(s1p + 2 * k2_) = h2_of(o1[0], o1[1]); }
    }
}
template <int LOG2L> __device__ __forceinline__ void sweep_load_v(LDSQ cpx* A, int t_, const bf16_t* zrow, size_t tb0, const float* cw, const float* cbias, int rc0, hcpx* xw) {
    constexpr int L = 1 << LOG2L, QS = L / 32; const SweepIdx<LOG2L> X(t_, true);
    const int rc = rc0 + X.seq; const float cw0 = cw[rc], cw1 = cw[6144 + rc], cw2 = cw[2 * 6144 + rc], bb = cbias[rc];
    const bf16_t* z0 = zrow + (size_t)rc * T + tb0; const bf16_t* z1 = z0 + L;
    cpx wn = X.wq0;
    u32x2 rq[8][2]; unsigned rm[8][2], rp[8][2];
#pragma unroll
    for (int i = 0; i < 8; ++i) { const int n = 4 * (i * QS) + X.n00, nm = n > 0 ? n - 1 : 0, np = n + 4 < L ? n + 4 : L - 1;
        rq[i][0] = *(const u32x2*)(z0 + n); rq[i][1] = *(const u32x2*)(z1 + n); rm[i][0] = z0[nm]; rm[i][1] = z1[nm]; rp[i][0] = z0[np]; rp[i][1] = z1[np]; }
#pragma unroll
    for (int i = 0; i < 8; ++i) { const int n = 4 * (i * QS) + X.n00; float xa[4], xb[4]; const unsigned hm = n > 0 ? 0xffffu : 0u, hp = n + 4 < L ? 0xffffu : 0u;
        sconv4r(rq[i][0], rm[i][0] & hm, rp[i][0] & hp, cw0, cw1, cw2, bb, xa); sconv4r(rq[i][1], rm[i][1] & hm, rp[i][1] & hp, cw0, cw1, cw2, bb, xb);
        LDSQ cpx* ap = A + phys(X.a00 + 4 * i * QS); hcpx* xp = xw + X.a00 + 4 * i * QS;
        ap[0] = mkc(xa[0], xb[0]); ap[1] = mkc(xa[1], xb[1]); ap[2] = mkc(xa[2], xb[2]); ap[3] = mkc(xa[3], xb[3]);
        const cpx y0 = cmul(mkc(xa[0], xb[0]), wn), y1 = cmul(mkc(xa[1], xb[1]), cmul(wn, X.w1)), y2 = cmul(mkc(xa[2], xb[2]), cmul(wn, X.w2)), y3 = cmul(mkc(xa[3], xb[3]), cmul(wn, X.w3));
        *(hcpx2*)xp = h2_of(y0, y1); *(hcpx2*)(xp + 2) = h2_of(y2, y3);
        wn = cmul(wn, WQS); }
}
constexpr int CPA = 2;
template <int N> struct CombPreN { u32x2 q[N][2]; unsigned zm[N][2], zp[N][2]; hcpx2 h01[N], h23[N]; };
typedef CombPreN<CPA> CombPre;
template <int LOG2L, int I0, int N> __device__ __forceinline__ void combine_prefetch(int t_, const hcpx* yes, const bf16_t* zrow, size_t tb0, int rg0, CombPreN<N>& P) {
    constexpr int L = 1 << LOG2L, QS = L / 32; const SweepIdx<LOG2L> X(t_, false);
    const int rg = rg0 + X.seq; const bf16_t* g0 = zrow + (size_t)rg * T + tb0; const bf16_t* g1 = g0 + L;
#pragma unroll
    for (int i = 0; i < N; ++i) { const int n = 4 * ((I0 + i) * QS) + X.n00; const hcpx* yp = yes + X.a00 + 4 * (I0 + i) * QS;
        P.q[i][0] = *(const u32x2*)(g0 + n); P.q[i][1] = *(const u32x2*)(g1 + n);
        const int nm = n > 0 ? n - 1 : 0, np = n + 4 < L ? n + 4 : L - 1;
        P.zm[i][0] = g0[nm]; P.zm[i][1] = g1[nm]; P.zp[i][0] = g0[np]; P.zp[i][1] = g1[np];
        P.h01[i] = __builtin_nontemporal_load((const hcpx2*)yp); P.h23[i] = __builtin_nontemporal_load((const hcpx2*)(yp + 2)); }
}
template <int LOG2L, int FINAL> __device__ __forceinline__ void sweep_combine(LDSQ cpx* A, int t_, const CombPre& P0, const hcpx* yes, hcpx* xw, bf16_t* zrow, size_t tb0, const float* cw, const float* cbias, int rg0, int ro0, int dry) {
    constexpr int L = 1 << LOG2L, QS = L / 32; const SweepIdx<LOG2L> X(t_, true);
    CombPreN<8 - CPA> P1; combine_prefetch<LOG2L, CPA>(X.t, yes, zrow, tb0, rg0, P1);
    const int rg = rg0 + X.seq; const float cw0 = cw[rg], cw1 = cw[6144 + rg], cw2 = cw[2 * 6144 + rg], bb = cbias[rg];
    bf16_t* o0 = zrow + (size_t)(ro0 + X.seq) * T + tb0; bf16_t* o1 = o0 + L;
    cpx wn = X.wq0;
#pragma unroll
    for (int i = 0; i < 8; ++i) { const int n = 4 * (i * QS) + X.n00; float ga[4], gb[4];
        const bool ah = i < CPA; const int ia = ah ? i : 0, ib = ah ? 0 : i - CPA;
        const unsigned hm = n > 0 ? 0xffffu : 0u, hp = n + 4 < L ? 0xffffu : 0u;
        sconv4r(ah ? P0.q[ia][0] : P1.q[ib][0], (ah ? P0.zm[ia][0] : P1.zm[ib][0]) & hm, (ah ? P0.zp[ia][0] : P1.zp[ib][0]) & hp, cw0, cw1, cw2, bb, ga);
        sconv4r(ah ? P0.q[ia][1] : P1.q[ib][1], (ah ? P0.zm[ia][1] : P1.zm[ib][1]) & hm, (ah ? P0.zp[ia][1] : P1.zp[ib][1]) & hp, cw0, cw1, cw2, bb, gb);
        const LDSQ cpx* ap = A + phys(X.a00 + 4 * i * QS);
        const hcpx2 h01 = ah ? P0.h01[ia] : P1.h01[ib], h23 = ah ? P0.h23[ia] : P1.h23[ib];
        const f32x4 e01 = {(float)h01.x, (float)h01.y, (float)h01.z, (float)h01.w}, e23 = {(float)h23.x, (float)h23.y, (float)h23.z, (float)h23.w};
        const cpx wa = cmul(wn, X.w1), wb2 = cmul(wn, X.w2), wc = cmul(wn, X.w3);
        const cpx r0 = cmulc(ap[0], wn), r1 = cmulc(ap[1], wa), r2 = cmulc(ap[2], wb2), r3 = cmulc(ap[3], wc);
        const cpx s0 = mkc(ga[0] * (e01[0] + r0.x), gb[0] * (e01[1] + r0.y)), s1 = mkc(ga[1] * (e01[2] + r1.x), gb[1] * (e01[3] + r1.y));
        const cpx s2 = mkc(ga[2] * (e23[0] + r2.x), gb[2] * (e23[1] + r2.y)), s3 = mkc(ga[3] * (e23[2] + r3.x), gb[3] * (e23[3] + r3.y));
        if (FINAL == 0) { LDSQ cpx* aw = A + phys(X.a00 + 4 * i * QS); hcpx* xp = xw + X.a00 + 4 * i * QS;
            aw[0] = s0; aw[1] = s1; aw[2] = s2; aw[3] = s3;
            const cpx y0 = cmul(s0, wn), y1 = cmul(s1, wa), y2 = cmul(s2, wb2), y3 = cmul(s3, wc);
            *(hcpx2*)xp = h2_of(y0, y1); *(hcpx2*)(xp + 2) = h2_of(y2, y3); }
        else if (!dry) { u32x2 wa2, wb3; wa2.x = cvt_pk_bf16(s0.x, s1.x); wa2.y = cvt_pk_bf16(s2.x, s3.x); wb3.x = cvt_pk_bf16(s0.y, s1.y); wb3.y = cvt_pk_bf16(s2.y, s3.y);
            *(u32x2*)(o0 + n) = wa2; *(u32x2*)(o1 + n) = wb3; }
        wn = cmul(wn, WQS); }
}
template <int LOG2L> __device__ __forceinline__ void hyena_item(const Params& p, LDSQ unsigned char* lds, int layer_j, int c0, int dry) {
    constexpr int L = 1 << LOG2L, NPAIR = (LOG2L == 14) ? 1 : 2;
    constexpr int TOK0 = (LOG2L == 14) ? 0 : T_P, PB = (LOG2L == 14) ? 0 : 16384;
    LDSQ cpx* A = (LDSQ cpx*)lds;
    LDSQ float* red = (LDSQ float*)(lds + 135168);
    const int t = pg8::otid(), ch = c0 + ((LOG2L == 14) ? 0 : (t >> 6));
    bf16_t* zin = (bf16_t*)(p.ws + WS_BIG + BIG_ZINT);
    const _Float16* taps = (const _Float16*)(p.ws + WS_BIG + BIG_TAPS);
    hcpx* scr = (hcpx*)(p.ws + WS_H + (size_t)pg8::obid() * FFT_SCR_PER_WG);
    hcpx* u1s = scr + (size_t)4 * 16384;
    hcpx* yes = (hcpx*)(p.ws + WS_END + (size_t)pg8::obid() * FFT_EXT_PER_WG);
    PreRegs pre;
    hcpx* xw = yes + 16384;
    {
        const _Float16* tf0 = taps + (size_t)(0 * 2048 + ch) * NPOS + PB; const _Float16* tb0 = taps + (size_t)(1 * 2048 + ch) * NPOS + PB;
        const _Float16* tf1 = taps + (size_t)(2 * 2048 + ch) * NPOS + PB; const _Float16* tb1 = taps + (size_t)(3 * 2048 + ch) * NPOS + PB;
        const float* dec = p.hy_decay + (size_t)layer_j * 8192 + ch;
        const float df0 = fabsf(dec[0]) * (1.0f / (float)(L - 1)), db0 = fabsf(dec[2048]) * (1.0f / (float)(L - 1));
        const float df1 = fabsf(dec[4096]) * (1.0f / (float)(L - 1)), db1 = fabsf(dec[6144]) * (1.0f / (float)(L - 1));
        float ss0, ss1;
        sweep_taps2<LOG2L>(A, t, tf0, tb0, tf1, tb1, df0, db0, df1, db1, xw, ss0, ss1);
        ss0 = wave_sum(ss0); ss1 = wave_sum(ss1);
        if ((t & 63) == 0) { red[t >> 6] = ss0; red[8 + (t >> 6)] = ss1; }
        __syncthreads();
        const float* skp0 = p.hy_skip + (size_t)layer_j * 2 * 2048 + c0; const float* skp1 = skp0 + 2048;
        fft_outer<LOG2L, false, 0>(A, t, nullptr, nullptr, pre);
        fft_prefetch<LOG2L == 14 ? 32 : 16, LOG2L == 14 ? 512 : 128>(t, xw, pre);
        fft_mid_sep<LOG2L, 0>(A, t, scr + (size_t)0 * 16384, scr + (size_t)2 * 16384, red, skp0, skp1); __syncthreads();
        fft_outer<LOG2L, false, 3>(A, t, nullptr, nullptr, pre);
        fft_mid_sep<LOG2L, 1>(A, t, scr + (size_t)1 * 16384, scr + (size_t)3 * 16384, red, skp0, skp1); __syncthreads();
    }
    const float* cw = p.hy_conv_w + (size_t)layer_j * 3 * 6144; const float* cbias = p.hy_conv_b + (size_t)layer_j * 6144;
#pragma unroll 1
    for (int pr = 0; pr < NPAIR; ++pr) {
        const size_t tb0 = (size_t)TOK0 + (size_t)(2 * pr) * L;
        sweep_load_v<LOG2L>(A, t, zin, tb0, cw, cbias, 2 * 2048 + c0, xw); __syncthreads();
        fft_conv<LOG2L, 0, 2>(A, t, scr + (size_t)0 * 16384, yes, xw, pre);
        CombPre cp;
        fft_conv<LOG2L, 3, 0>(A, t, scr + (size_t)1 * 16384, nullptr, nullptr, pre, [&]() { combine_prefetch<LOG2L, 0>(t, yes, zin, tb0, c0, cp); });
        sweep_combine<LOG2L, 0>(A, t, cp, yes, xw, zin, tb0, cw, cbias, c0, c0, dry); __syncthreads();
        fft_conv<LOG2L, 0, 2>(A, t, scr + (size_t)2 * 16384, yes, xw, pre);
        fft_conv<LOG2L, 3, 0>(A, t, scr + (size_t)3 * 16384, nullptr, nullptr, pre, [&]() { combine_prefetch<LOG2L, 0>(t, yes, zin, tb0, 2048 + c0, cp); });
        sweep_combine<LOG2L, 1>(A, t, cp, yes, xw, zin, tb0, cw, cbias, 2048 + c0, c0, dry); __syncthreads();
    }
}
__device__ __forceinline__ void hyena_conv_phase(const Params& p, LDSQ unsigned char* lds, int layer_j, int dry) {
    { LDSQ cpx* TW = (LDSQ cpx*)(lds + TW_OFF);
      for (int e = pg8::otid(); e < 1024; e += NTHR) { float sn, cs; sincospif(-2.0f * (float)e / 16384.0f, &sn, &cs); TW[e] = mkc(cs, sn); }
      __syncthreads(); }
    for (int it = pg8::obid(); it < 2048; it += pg8::ogrid()) hyena_item<14>(p, lds, layer_j, it, dry);
    for (int it = pg8::obid(); it < 256; it += pg8::ogrid()) hyena_item<11>(p, lds, layer_j, it * 8, dry);
}

__device__ __forceinline__ void attn_phase(const Params& p, LDSQ unsigned char* lds, int dry = 0) {
    constexpr int KROW = 272, VROW = 264;
    LDSQ unsigned char* Kl = lds; LDSQ bf16_t* VT = (LDSQ bf16_t*)(lds + 256 * KROW);
    const bf16_t* qkv = (const bf16_t*)(p.ws + WS_BIG + BIG_QKV);
    bf16_t* og = (bf16_t*)(p.ws + WS_BIG + BIG_OG); float* lse = (float*)(p.ws + WS_BIG + BIG_LSE);
    const int tid = pg8::otid(), lane = tid & 63, wid = __builtin_amdgcn_readfirstlane(tid >> 6), l15 = lane & 15, g4 = lane >> 4;
    for (int it = pg8::obid(); it < 7680; it += pg8::ogrid()) {
        int g, b, hh, rho, pp, L, tokbase;
        if (it < 6144) { g = it >> 11; const int rem = it & 2047; const int npp = 128 >> (2 * g); pp = rem % npp; rho = (rem / npp) & ((1 << (2 * g)) - 1); hh = (rem >> 7) & 7; b = rem >> 10; L = L_P; tokbase = 0; }
        else { const int i2 = it - 6144; g = i2 >> 9; const int rem = i2 & 511; const int npp = 16 >> (2 * g); pp = rem % npp; rho = (rem / npp) & ((1 << (2 * g)) - 1); hh = (rem >> 4) & 7; b = rem >> 7; L = L_S; tokbase = T_P; }
        const int rsh = 2 * g, n = L >> rsh;
        const size_t tok0 = (size_t)tokbase + (size_t)b * L + rho;
        const int i0 = 128 * pp - 64;
        const int qcol = g * 3072 + hh * 128, kcol = qcol + 1024, vcol = qcol + 2048;
        const int blk = wid >> 2, qq = 16 * (wid & 3) + l15;
        const int qi = 128 * pp + 64 * blk + qq;
        const size_t tq = tok0 + ((size_t)qi << rsh);
        u32x4 kr[8], vr[8];
#pragma unroll
        for (int s8 = 0; s8 < 8; ++s8) { const int ci = tid + 512 * s8, slot = ci >> 4, chn = ci & 15, i = i0 + slot, ic = i < 0 ? 0 : (i < n ? i : n - 1);
            kr[s8] = *(const u32x4*)(qkv + (tok0 + ((size_t)ic << rsh)) * QKVW + kcol + chn * 8); }
#pragma unroll
        for (int s8 = 0; s8 < 8; ++s8) { const int ci = tid + 512 * s8, slot = ci & 255, chn = ci >> 8, i = i0 + slot, ic = i < 0 ? 0 : (i < n ? i : n - 1);
            vr[s8] = *(const u32x4*)(qkv + (tok0 + ((size_t)ic << rsh)) * QKVW + vcol + chn * 8); }
        bf16x8 bq[4];
#pragma unroll
        for (int ks = 0; ks < 4; ++ks) bq[ks] = *(const bf16x8*)(qkv + tq * QKVW + qcol + 32 * ks + 8 * g4);
#pragma unroll
        for (int s8 = 0; s8 < 8; ++s8) { const int ci = tid + 512 * s8, slot = ci >> 4, chn = ci & 15, i = i0 + slot; const unsigned ok = (i >= 0 && i < n) ? 0xffffffffu : 0u;
            u32x4 v = kr[s8]; v.x &= ok; v.y &= ok; v.z &= ok; v.w &= ok;
            *(LDSQ u32x4*)(Kl + slot * KROW + chn * 16) = v; }
#pragma unroll
        for (int s8 = 0; s8 < 8; ++s8) { const int ci = tid + 512 * s8, slot = ci & 255, chn = ci >> 8, i = i0 + slot; const unsigned ok = (i >= 0 && i < n) ? 0xffffffffu : 0u;
            u32x4 v = vr[s8]; v.x &= ok; v.y &= ok; v.z &= ok; v.w &= ok;
            LDSQ bf16_t* vp = VT + (chn * 8) * VROW + slot;
            vp[0] = (bf16_t)(v.x & 0xffffu); vp[VROW] = (bf16_t)(v.x >> 16); vp[2 * VROW] = (bf16_t)(v.y & 0xffffu); vp[3 * VROW] = (bf16_t)(v.y >> 16);
            vp[4 * VROW] = (bf16_t)(v.z & 0xffffu); vp[5 * VROW] = (bf16_t)(v.z >> 16); vp[6 * VROW] = (bf16_t)(v.w & 0xffffu); vp[7 * VROW] = (bf16_t)(v.w >> 16); }
        __syncthreads();
        f32x4 sc[12];
#pragma unroll
        for (int kt = 0; kt < 12; ++kt) { f32x4 a = {0.f, 0.f, 0.f, 0.f};
#pragma unroll
            for (int ks = 0; ks < 4; ++ks) { const bf16x8 ka = *(const LDSQ bf16x8*)(Kl + (64 * blk + 16 * kt + l15) * KROW + (32 * ks + 8 * g4) * 2);
                a = __builtin_amdgcn_mfma_f32_16x16x32_bf16(ka, bq[ks], a, 0, 0, 0); }
            sc[kt] = a; }
        const int ibase = 128 * pp + 64 * blk - 64;
        const int klo = qq > -ibase ? qq : -ibase, khi = (qq + 128 < n - 1 - ibase) ? qq + 128 : n - 1 - ibase;
        const unsigned kspan = (unsigned)(khi - klo); const int kk0 = 4 * g4 - klo;
        float mx = -3.0e38f;
#pragma unroll
        for (int kt = 0; kt < 12; ++kt)
#pragma unroll
            for (int r = 0; r < 4; ++r) { const bool ok = (unsigned)(kk0 + 16 * kt + r) <= kspan;
                sc[kt][r] = ok ? sc[kt][r] : -3.0e38f; mx = fmaxf(mx, sc[kt][r]); }
        mx = fmaxf(mx, __shfl_xor(mx, 16)); mx = fmaxf(mx, __shfl_xor(mx, 32));
        float ls = 0.f;
#pragma unroll
        for (int kt = 0; kt < 12; ++kt)
#pragma unroll
            for (int r = 0; r < 4; ++r) { const float e = __builtin_amdgcn_exp2f(sc[kt][r] - mx); sc[kt][r] = e; ls += e; }
        ls += __shfl_xor(ls, 16); ls += __shfl_xor(ls, 32);
        f32x4 oa[8];
#pragma unroll
        for (int dt = 0; dt < 8; ++dt) oa[dt] = (f32x4){0.f, 0.f, 0.f, 0.f};
#pragma unroll
        for (int k2 = 0; k2 < 6; ++k2) {
            union { u32x4 u; bf16x8 h; } pb;
            pb.u.x = cvt_pk_bf16(sc[2 * k2][0], sc[2 * k2][1]); pb.u.y = cvt_pk_bf16(sc[2 * k2][2], sc[2 * k2][3]);
            pb.u.z = cvt_pk_bf16(sc[2 * k2 + 1][0], sc[2 * k2 + 1][1]); pb.u.w = cvt_pk_bf16(sc[2 * k2 + 1][2], sc[2 * k2 + 1][3]);
#pragma unroll
            for (int dt = 0; dt < 8; ++dt) {
                const LDSQ bf16_t* vr = VT + (16 * dt + l15) * VROW + 64 * blk + 32 * k2 + 4 * g4;
                union { u32x4 u; bf16x8 h; } va; const u32x2 lo = *(const LDSQ u32x2*)vr, hi = *(const LDSQ u32x2*)(vr + 16);
                va.u.x = lo.x; va.u.y = lo.y; va.u.z = hi.x; va.u.w = hi.y;
                oa[dt] = __builtin_amdgcn_mfma_f32_16x16x32_bf16(va.h, pb.h, oa[dt], 0, 0, 0); }
        }
        const float inv = 1.0f / ls;
        const size_t gt = (size_t)g * T + tq;
#pragma unroll
        for (int dt = 0; dt < 8; ++dt) { u32x2 w; w.x = cvt_pk_bf16(oa[dt][0] * inv, oa[dt][1] * inv); w.y = cvt_pk_bf16(oa[dt][2] * inv, oa[dt][3] * inv);
            if (!dry) *(u32x2*)(og + gt * 1024 + hh * 128 + 16 * dt + 4 * g4) = w; }
        if (g4 == 0 && !dry) lse[gt * 8 + hh] = mx + log2f(ls);
        __syncthreads();
    }
}
__device__ __forceinline__ void attn_merge_phase(const Params& p) {
    const bf16_t* og = (const bf16_t*)(p.ws + WS_BIG + BIG_OG); const float* lse = (const float*)(p.ws + WS_BIG + BIG_LSE); bf16_t* H = (bf16_t*)(p.ws + WS_H);
    const int stride = pg8::ogrid() * NTHR;
    for (int i0 = pg8::obid() * NTHR + pg8::otid(); i0 < T * 128; i0 += 4 * stride) {
        u32x4 v0[4], v1[4], v2[4]; float l0[4], l1[4], l2[4];
#pragma unroll
        for (int u = 0; u < 4; ++u) { const int i = i0 + u * stride; if (i < T * 128) { const int tok = i >> 7, c8 = i & 127, hh = c8 >> 4;
            l0[u] = lse[(size_t)tok * 8 + hh]; l1[u] = lse[((size_t)T + tok) * 8 + hh]; l2[u] = lse[((size_t)2 * T + tok) * 8 + hh];
            v0[u] = *(const u32x4*)(og + (size_t)tok * 1024 + c8 * 8); v1[u] = *(const u32x4*)(og + ((size_t)T + tok) * 1024 + c8 * 8); v2[u] = *(const u32x4*)(og + ((size_t)2 * T + tok) * 1024 + c8 * 8); } }
#pragma unroll
        for (int u = 0; u < 4; ++u) { const int i = i0 + u * stride; if (i < T * 128) { const int tok = i >> 7, c8 = i & 127;
            const float m = fmaxf(l0[u], fmaxf(l1[u], l2[u])); float a0 = exp2f(l0[u] - m), a1 = exp2f(l1[u] - m), a2 = exp2f(l2[u] - m); const float is = 1.0f / (a0 + a1 + a2); a0 *= is; a1 *= is; a2 *= is;
            u32x4 w;
#pragma unroll
            for (int e = 0; e < 4; ++e) { const float lo = a0 * __uint_as_float(v0[u][e] << 16) + a1 * __uint_as_float(v1[u][e] << 16) + a2 * __uint_as_float(v2[u][e] << 16);
                const float hi = a0 * __uint_as_float(v0[u][e] & 0xffff0000u) + a1 * __uint_as_float(v1[u][e] & 0xffff0000u) + a2 * __uint_as_float(v2[u][e] & 0xffff0000u);
                w[e] = cvt_pk_bf16(lo, hi); }
            *(u32x4*)(H + (size_t)tok * 1024 + c8 * 8) = w; } }
    }
}

constexpr int NPHASE = 35;
typedef const __attribute__((address_space(4))) unsigned char* KARG;
template <class Tp> __device__ __forceinline__ Tp karg(int byte_off) { return *(volatile const __attribute__((address_space(4))) Tp*)((KARG)__builtin_amdgcn_kernarg_segment_ptr() + byte_off); }
#define PA(q, member) q.member = karg<decltype(Params::member)>((int)__builtin_offsetof(Params, member))
__global__ void __launch_bounds__(512, 2) mega(Params parg) {
    extern __shared__ __attribute__((aligned(16))) unsigned char shm[];
    LDSQ unsigned char* lds = (LDSQ unsigned char*)shm;
    const int tid = pg8::otid();
    volatile LDSQ unsigned* misc = (volatile LDSQ unsigned*)(lds + LDS_MISC);
    if (tid < 8) misc[tid] = 0u;
    __syncthreads();
    const int ph_lo = parg.ph_lo, ph_hi = parg.ph_hi, probe = parg.probe;
#define REPS(bit, lay) (1 + (1 + ((probe >> 15) & 1)) * (((probe >> (bit)) & 1) & ((((probe >> 10) & 3) == 0) | ((probe >> (10 + ((lay) & 1))) & 1))))
    XcdBarrier bar; bar.bar = nullptr; bar.x = 0; bar.st = misc;
    if (ph_hi - ph_lo > 1) { Params q{}; PA(q, ws); bar = xcd_barrier_post((unsigned*)(q.ws + WS_CTL), misc); }
#define IN(k) (ph_lo <= (k) && (k) < ph_hi)
#define REPBAR() do { if (((probe >> 16) & 1) && rep + 1 < nrep) { Params qb{}; PA(qb, ws); bar.bar = (unsigned*)(qb.ws + WS_CTL); xcd_barrier(bar); } } while (0)
#define SEAM(k) do { if (IN(k) && IN((k) + 1)) { Params qb{}; PA(qb, ws); bar.bar = (unsigned*)(qb.ws + WS_CTL); xcd_barrier(bar); if ((probe >> 12) & 1) { xcd_barrier(bar); xcd_barrier(bar); } } } while (0)

    for (int rep = 0, nrep = REPS(0, 0); rep < nrep; ++rep)
    if (IN(0)) { Params q{}; PA(q, ws); PA(q, c_prompt); PA(q, c_sample); PA(q, ada_w); PA(q, final_ada_w); ada_partials(q, lds); rope_table(q);
                 PA(q, hy_fw1); PA(q, hy_fb1); PA(q, hy_ffreq); PA(q, hy_fw2); PA(q, hy_fb2); PA(q, hy_fw3); filter_mlp(q); }
    SEAM(0);
    for (int rep = 0, nrep = REPS(0, 0); rep < nrep; ++rep)
    if (IN(1)) { Params q{}; PA(q, ws); PA(q, ada_b); PA(q, final_ada_b); ada_reduce(q); }
    SEAM(1);
#pragma unroll 1
    for (int layer = 0; layer < 4; ++layer) {
        const int pb = 2 + 8 * layer, j = layer >> 1; const bool hy = (layer & 1) == 0;
        for (int rep = 0, nrep = REPS(1, layer); rep < nrep; ++rep)
        if (IN(pb + 0)) {
            Params q{}; PA(q, ws); unsigned char* wl = q.ws + WS_WL;
            PA(q, ffn_w_gate); convert_T(lds, q.ffn_w_gate + (size_t)layer * 2048 * DFF, 2048, DFF, (bf16_t*)(wl + WL_FFN1), 0);
            PA(q, ffn_w_up);   convert_T(lds, q.ffn_w_up + (size_t)layer * 2048 * DFF, 2048, DFF, (bf16_t*)(wl + WL_FFN1), 1);
            PA(q, ffn_w_down); convert_T(lds, q.ffn_w_down + (size_t)layer * DFF * 2048, DFF, 2048, (bf16_t*)(wl + WL_FFN2), -1);
            if (hy) { PA(q, hy_w_in);  convert_T(lds, q.hy_w_in + (size_t)j * 2048 * 6144, 2048, 6144, (bf16_t*)(wl + WL_MIXIN), -1);
                      PA(q, hy_w_out); convert_T(lds, q.hy_w_out + (size_t)j * 2048 * 2048, 2048, 2048, (bf16_t*)(wl + WL_MIXOUT), -1); }
            else    { PA(q, at_w_in);  convert_T(lds, q.at_w_in + (size_t)j * 2048 * QKVW, 2048, QKVW, (bf16_t*)(wl + WL_MIXIN), -1);
                      PA(q, at_w_out); convert_T(lds, q.at_w_out + (size_t)j * 1024 * 2048, 1024, 2048, (bf16_t*)(wl + WL_MIXOUT), -1); }
            PA(q, norm_mix);
            const float* modl = (const float*)(q.ws + WS_MOD) + layer * 12288;
            if (layer == 0) { PA(q, x_prompt); PA(q, x_sample); norm_rows<false, true>(q.x_prompt, q.x_sample, (bf16_t*)(q.ws + WS_XB), q.norm_mix + layer * 2048, modl, 0, 2048, (bf16_t*)(q.ws + WS_H), nullptr); }
            else            norm_rows<false, false>(nullptr, nullptr, (bf16_t*)(q.ws + WS_XB), q.norm_mix + layer * 2048, modl, 0, 2048, (bf16_t*)(q.ws + WS_H), nullptr);
            if (hy) { __syncthreads();
                pg8::Gemm g{(const bf16_t*)(q.ws + WS_W3X) + (size_t)j * 8192 * 256, (const bf16_t*)(q.ws + WS_A2X) + (size_t)j * NPOS * 256, 8192, NPOS, 256};
                pg8::StaticOrder S; S.init(8192, NPOS, pg8::ogrid(), pg8::obid());
                EpiTaps E{(_Float16*)(q.ws + WS_BIG + BIG_TAPS)};
                pg8::gemm_phase<EpiTaps, pg8::StaticOrder, false>(lds, g, S, E, nullptr); }
        }
        SEAM(pb + 0);
        for (int rep = 0, nrep = REPS(2, layer); rep < nrep; ++rep)
        if (IN(pb + 1)) {
            Params q{}; PA(q, ws);
            if (hy) { PA(q, hy_b_in); pg8::Gemm g{(const bf16_t*)(q.ws + WS_WL + WL_MIXIN), (const bf16_t*)(q.ws + WS_H), 6144, T, 2048}; pg8::StaticOrder S; S.init(6144, T, pg8::ogrid(), pg8::obid());
                EpiZinT E{(bf16_t*)(q.ws + WS_BIG + BIG_ZINT), T, q.hy_b_in + (size_t)j * 6144};
                pg8::gemm_phase<EpiZinT, pg8::StaticOrder, false>(lds, g, S, E, nullptr); }
            else { pg8::Gemm g{(const bf16_t*)(q.ws + WS_H), (const bf16_t*)(q.ws + WS_WL + WL_MIXIN), T, QKVW, 2048}; pg8::StaticOrder S; S.init(T, QKVW, pg8::ogrid(), pg8::obid());
                EpiQKV E{(bf16_t*)(q.ws + WS_BIG + BIG_QKV), (const cpx*)(q.ws + WS_ROPE)};
                pg8::gemm_phase<EpiQKV, pg8::StaticOrder, false>(lds, g, S, E, nullptr); }
            REPBAR();
        }
        SEAM(pb + 1);
        for (int rep = 0, nrep = REPS(3, layer); rep < nrep; ++rep)
        if (IN(pb + 2)) { Params q{}; PA(q, ws); if (hy) { PA(q, hy_skip); PA(q, hy_conv_w); PA(q, hy_conv_b); PA(q, hy_decay); hyena_conv_phase(q, lds, j, rep + 1 < nrep); } else attn_phase(q, lds, (rep + 1 < nrep) ? (1 | ((probe >> 12) & 2)) : 0); }
        SEAM(pb + 2);
        for (int rep = 0, nrep = REPS(4, layer); rep < nrep; ++rep)
        if (IN(pb + 3)) { Params q{}; PA(q, ws); if (hy) transpose_phase(q, lds); else attn_merge_phase(q); }
        SEAM(pb + 3);
        for (int rep = 0, nrep = REPS(5, layer); rep < nrep; ++rep)
        if (IN(pb + 4)) {
            Params q{}; PA(q, ws); PA(q, hy_b_out);
            pg8::Gemm g{(const bf16_t*)(q.ws + WS_H), (const bf16_t*)(q.ws + WS_WL + WL_MIXOUT), T, 2048, hy ? 2048 : 1024}; pg8::StaticOrder S; S.init(T, 2048, pg8::ogrid(), pg8::obid());
            EpiRes E{(bf16_t*)(q.ws + WS_XB), hy ? q.hy_b_out + (size_t)j * 2048 : nullptr, (const float*)(q.ws + WS_MOD) + layer * 12288 + 4096, rep + 1 < nrep};
            pg8::gemm_phase<EpiRes, pg8::StaticOrder, false>(lds, g, S, E, nullptr);
            REPBAR();
        }
        SEAM(pb + 4);
        for (int rep = 0, nrep = REPS(6, layer); rep < nrep; ++rep)
        if (IN(pb + 5)) { Params q{}; PA(q, ws); PA(q, norm_ffn);
            norm_rows<false, false>(nullptr, nullptr, (bf16_t*)(q.ws + WS_XB), q.norm_ffn + layer * 2048, (const float*)(q.ws + WS_MOD) + layer * 12288, 6144, 8192, (bf16_t*)(q.ws + WS_H), nullptr); }
        SEAM(pb + 5);
        for (int rep = 0, nrep = REPS(7, layer); rep < nrep; ++rep)
        if (IN(pb + 6)) {
            Params q{}; PA(q, ws);
            pg8::Gemm g{(const bf16_t*)(q.ws + WS_H), (const bf16_t*)(q.ws + WS_WL + WL_FFN1), T, 2 * DFF, 2048}; pg8::StaticOrder S; S.init(T, 2 * DFF, pg8::ogrid(), pg8::obid());
            EpiFFN1 E{(bf16_t*)(q.ws + WS_BIG + BIG_MID)};
            pg8::gemm_phase<EpiFFN1, pg8::StaticOrder, false>(lds, g, S, E, nullptr);
            REPBAR();
        }
        SEAM(pb + 6);
        for (int rep = 0, nrep = REPS(8, layer); rep < nrep; ++rep)
        if (IN(pb + 7)) {
            Params q{}; PA(q, ws);
            pg8::Gemm g{(const bf16_t*)(q.ws + WS_BIG + BIG_MID), (const bf16_t*)(q.ws + WS_WL + WL_FFN2), T, 2048, DFF}; pg8::StaticOrder S; S.init(T, 2048, pg8::ogrid(), pg8::obid());
            EpiRes E{(bf16_t*)(q.ws + WS_XB), nullptr, (const float*)(q.ws + WS_MOD) + layer * 12288 + 10240, rep + 1 < nrep};
            pg8::gemm_phase<EpiRes, pg8::StaticOrder, false>(lds, g, S, E, nullptr);
            REPBAR();
        }
        SEAM(pb + 7);
    }
    if (IN(34)) { Params q{}; PA(q, ws); PA(q, out); PA(q, final_norm); final_norm_phase(q); }
#undef REPS
#undef IN
#undef SEAM
}
}

extern "C" void kernel_launch(void* const* d_in, const int* in_sizes, int n_in, void* d_out, int out_size, void* d_ws, size_t ws_size, hipStream_t stream) {
    static int grid = 0;
    if (grid == 0) {
        if (n_in != 30 || out_size != mk::T * mk::D || ws_size < mk::WS_TOTAL) { fprintf(stderr, "kernel_launch: unexpected shapes (n_in %d out %d ws %zu need %zu); nothing launched\n", n_in, out_size, ws_size, (size_t)mk::WS_TOTAL); grid = -1; return; }
        int dev = 0, cus = 0;
        if (hipGetDevice(&dev) != hipSuccess || hipDeviceGetAttribute(&cus, hipDeviceAttributeMultiprocessorCount, dev) != hipSuccess) { grid = -1; return; }
        if (hipFuncSetAttribute((const void*)mk::mega, hipFuncAttributeMaxDynamicSharedMemorySize, mk::LDS_BYTES) != hipSuccess) { fprintf(stderr, "kernel_launch: hipFuncSetAttribute failed\n"); grid = -1; return; }
        int per_cu = 0; (void)hipOccupancyMaxActiveBlocksPerMultiprocessor(&per_cu, (const void*)mk::mega, 512, mk::LDS_BYTES); (void)hipGetLastError();
        if (per_cu < 1) fprintf(stderr, "kernel_launch: occupancy query reports %d blocks per CU\n", per_cu);
        grid = cus > 256 ? 256 : cus;
    }
    if (grid < 0) return;
    mk::Params p{};
    const float** f = (const float**)&p;
    for (int i = 0; i < 30; ++i) f[i] = (const float*)d_in[i];
    p.out = (float*)d_out; p.ws = (unsigned char*)d_ws; p.probe = MK_PROBE;
#if MK_PER_PHASE
    for (int k = 0; k < mk::NPHASE; ++k) { p.ph_lo = k; p.ph_hi = k + 1; hipLaunchKernelGGL(mk::mega, dim3(grid), dim3(512), mk::LDS_BYTES, stream, p); }
#else
    (void)hipMemsetAsync((char*)d_ws + mk::WS_CTL, 0, mk::CTL_BYTES, stream);
    p.ph_lo = 0; p.ph_hi = mk::NPHASE;
    hipLaunchKernelGGL(mk::mega, dim3(grid), dim3(512), mk::LDS_BYTES, stream, p);
#endif
}
```

```cpp
#include <hip/hip_runtime.h>
#include <cstdio>
#include <cstdint>
#include <utility>
#ifndef MK_PER_PHASE
#define MK_PER_PHASE 0
#endif
#ifndef MK_PROBE
#define MK_PROBE 0
#endif
namespace pg8 {
#define PG8_LAS __attribute__((address_space(3)))
__device__ __forceinline__ int otid() { int t = threadIdx.x; asm volatile("" : "+v"(t) :: "memory"); return t; }
__device__ __forceinline__ int obid() { int b = blockIdx.x; asm volatile("" : "+s"(b)); return b; }
__device__ __forceinline__ int ogrid() { int g = gridDim.x; asm volatile("" : "+s"(g)); return g; }
typedef unsigned short bf16_t;
typedef short bf16x8 __attribute__((ext_vector_type(8)));
typedef float f32x4 __attribute__((ext_vector_type(4)));
typedef unsigned u32x4 __attribute__((ext_vector_type(4)));
constexpr int BM = 256, BK = 64, HALF = 128, HTB = HALF * BK * 2  , STAGE_BYTES = 8 * HTB, NXCD = 8, WGM = 4;

__host__ __device__ __forceinline__ int lds_byte(int r, int c) { const int st = (r >> 4) * 2 + (c >> 5), rr = r & 15, cc = c & 31, ob = rr * 64 + cc * 2; return st * 1024 + (ob ^ (((ob >> 9) & 1) << 5)); }
__host__ __device__ __forceinline__ void stage_rc(int b, int& R, int& C) { const int st = b / 1024, sb = b % 1024, swz = sb ^ (((sb >> 9) & 1) << 5); R = (st >> 1) * 16 + swz / 64; C = (st & 1) * 32 + (swz % 64) / 2; }
__host__ __device__ __forceinline__ int perm32(int rho) { const int n = rho >> 4, i = rho & 15; return 8 * (i >> 2) + 4 * n + (i & 3); }

struct Unit { int pm, pn; };
struct Gemm { const bf16_t* A; const bf16_t* Bt; int M, N, K; };

struct StaticOrder {
    int nM, nN, nwg, G, c, wgm;
    __host__ __device__ void init(int M, int N, int G_, int c_, int wgm_ = WGM) { nM = M / BM; nN = N / BM; nwg = nM * nN; G = G_; c = c_; wgm = wgm_; }
    __host__ __device__ bool next(int i, Unit& u) const {
        const long L = (long)i * G + c; if (L >= nwg) return false;
        int wgid = (int)L; { const int q = nwg / NXCD, r = nwg % NXCD, xcd = wgid % NXCD, off = wgid / NXCD; wgid = (xcd < r ? xcd * (q + 1) : r * (q + 1) + (xcd - r) * q) + off; }
        const int nig = wgm * nN, gid = wgid / nig, fm = gid * wgm, gsz = (nM - fm) < wgm ? (nM - fm) : wgm;
        u.pm = fm + ((wgid % nig) % gsz); u.pn = (wgid % nig) / gsz; return true;
    }
    __device__ __forceinline__ void a_ready(const Unit&) const {}
    __device__ __forceinline__ void done(const Unit&) const {}
};
__device__ __forceinline__ unsigned cvt_pk_bf16(float lo, float hi) { unsigned r; asm volatile("v_cvt_pk_bf16_f32 %0, %1, %2" : "=v"(r) : "v"(lo), "v"(hi)); return r; }
template <class Epi, class Sched, bool STAMP = false>
__device__ __forceinline__ void gemm_phase(PG8_LAS unsigned char* lds, const Gemm g, const Sched& S, const Epi& E, unsigned long long* stamps) {
    const int tid = otid(), wid = __builtin_amdgcn_readfirstlane(tid >> 6), lane = tid & 63, wr = wid >> 2, wc = wid & 3, fr = lane & 15, fq = lane >> 4;
    const int K = g.K, nt = K / BK;
    int ts_lo = 0, ts_hi = 0, nts = 0; const unsigned long long rt_entry = STAMP ? (unsigned long long)wall_clock64() : 0ull;
#define PG8_STAMP() do { if (STAMP && wid == 0 && nts < 64) { const unsigned long long _c = (unsigned long long)clock64(); \
        ts_lo = (lane == nts) ? (int)(unsigned)_c : ts_lo; ts_hi = (lane == nts) ? (int)(unsigned)(_c >> 32) : ts_hi; ++nts; } } while (0)
    PG8_STAMP();
    unsigned voffA[2], voffB[2];
#pragma unroll
    for (int i = 0; i < 2; ++i) { int R, C; stage_rc(tid * 16 + i * 8192, R, C); const int Rb = Epi::PERM ? ((R & ~31) + perm32(R & 31)) : R;
        voffA[i] = (unsigned)(R * K + C) * 2u; voffB[i] = (unsigned)(Rb * K + C) * 2u; }
    const size_t kstep = (size_t)(BK * 2);
    const size_t hstep = (size_t)HALF * K * 2;
    const size_t tstep = 2 * hstep;
    const unsigned ldsw = (unsigned)wid * 1024u;
    const int aoff = lds_byte(wr * 64 + fr, fq * 8), boff = lds_byte(wc * 32 + fr, fq * 8);
#define PG8_SA(b, h) (((b) * 2 + (h)) * HTB)
#define PG8_SB(b, h) ((4 + (b) * 2 + (h)) * HTB)
#define PG8_STAGE(bufoff, gbase, voff) do { _Pragma("unroll") for (int _i = 0; _i < 2; ++_i) \
        __builtin_amdgcn_global_load_lds((const unsigned*)((const char*)(gbase) + (voff)[_i]), (PG8_LAS unsigned*)(lds + (bufoff) + ldsw + _i * 8192), 16, 0, 0); } while (0)
#define PG8_LDA(dst, b, h) do { _Pragma("unroll") for (int m = 0; m < 4; ++m) _Pragma("unroll") for (int k = 0; k < 2; ++k) dst[m][k] = *(const PG8_LAS bf16x8*)(lds + PG8_SA(b, h) + aoff + m * 2048 + k * 1024); } while (0)
#define PG8_LDB(dst, b, h) do { _Pragma("unroll") for (int n = 0; n < 2; ++n) _Pragma("unroll") for (int k = 0; k < 2; ++k) dst[n][k] = *(const PG8_LAS bf16x8*)(lds + PG8_SB(b, h) + boff + n * 2048 + k * 1024); } while (0)
#define PG8_MMA(ai, bj, At, Bt) do { __builtin_amdgcn_s_setprio(1); _Pragma("unroll") for (int m = 0; m < 4; ++m) _Pragma("unroll") for (int n = 0; n < 2; ++n) _Pragma("unroll") for (int k = 0; k < 2; ++k) \
        acc[ai][bj][m][n] = __builtin_amdgcn_mfma_f32_16x16x32_bf16(Bt[n][k], At[m][k], acc[ai][bj][m][n], 0, 0, 0); __builtin_amdgcn_s_setprio(0); } while (0)
#define PG8_WAIT_V(n) asm volatile("s_waitcnt vmcnt(" #n ")" ::: "memory")
#define PG8_WAIT_L(n) asm volatile("s_waitcnt lgkmcnt(" #n ")" ::: "memory")
#define PG8_BAR __builtin_amdgcn_s_barrier()
#define PG8_SCHED __builtin_amdgcn_sched_barrier(0)
    Unit cur, nxt; int ui = 0;
    if (!S.next(0, cur)) return;
    f32x4 acc[2][2][4][2];
#pragma unroll
    for (int a = 0; a < 2; ++a)
#pragma unroll
        for (int b = 0; b < 2; ++b)
#pragma unroll
            for (int m = 0; m < 4; ++m)
#pragma unroll
                for (int n = 0; n < 2; ++n) acc[a][b][m][n] = (f32x4){0.f, 0.f, 0.f, 0.f};
    bf16x8 At[4][2], B0[2][2], B1[2][2];
    const char* cA = (const char*)g.A + (size_t)cur.pm * tstep; const char* cB = (const char*)g.Bt + (size_t)cur.pn * tstep;
    S.a_ready(cur);
    PG8_STAGE(PG8_SB(0, 0), cB, voffB); PG8_STAGE(PG8_SA(0, 0), cA, voffA); PG8_STAGE(PG8_SB(0, 1), cB + hstep, voffB); PG8_STAGE(PG8_SA(0, 1), cA + hstep, voffA);
    if (wr == 1) PG8_BAR;
    PG8_WAIT_V(4); PG8_BAR;
    PG8_STAGE(PG8_SB(1, 0), cB + kstep, voffB); PG8_STAGE(PG8_SA(1, 0), cA + kstep, voffA); PG8_STAGE(PG8_SB(1, 1), cB + hstep + kstep, voffB);
    PG8_WAIT_V(6); PG8_BAR;
    PG8_STAMP();
    for (;;) {
        const bool has_next = S.next(ui + 1, nxt);
        const char* nA = has_next ? (const char*)g.A + (size_t)nxt.pm * tstep : cA; const char* nB = has_next ? (const char*)g.Bt + (size_t)nxt.pn * tstep : cB;
        for (int t = 0; t < nt; t += 2) {
            const bool last = (t == nt - 2);
            const char* a1 = cA + (size_t)(t + 1) * kstep;
            const char* a2 = last ? nA : cA + (size_t)(t + 2) * kstep; const char* b2 = last ? nB : cB + (size_t)(t + 2) * kstep;
            const char* a3 = a2 + kstep; const char* b3 = b2 + kstep;
            if (last && has_next) S.a_ready(nxt);
            PG8_LDB(B0, 0, 0); PG8_SCHED; PG8_LDA(At, 0, 0); PG8_STAGE(PG8_SA(1, 1), a1 + hstep, voffA);
            PG8_WAIT_L(8); PG8_BAR; PG8_WAIT_L(0); PG8_MMA(0, 0, At, B0); PG8_BAR; PG8_SCHED;
            PG8_LDB(B1, 0, 1); PG8_STAGE(PG8_SB(0, 0), b2, voffB);
            PG8_BAR; PG8_WAIT_L(0); PG8_MMA(0, 1, At, B1); PG8_BAR;
            PG8_LDA(At, 0, 1); PG8_STAGE(PG8_SA(0, 0), a2, voffA);
            PG8_BAR; PG8_WAIT_L(0); PG8_MMA(1, 0, At, B0); PG8_BAR; PG8_SCHED;
            PG8_STAGE(PG8_SB(0, 1), b2 + hstep, voffB);
            PG8_WAIT_V(6); PG8_BAR; PG8_MMA(1, 1, At, B1); PG8_BAR;
            PG8_LDB(B0, 1, 0); PG8_SCHED; PG8_LDA(At, 1, 0); PG8_STAGE(PG8_SA(0, 1), a2 + hstep, voffA);
            PG8_WAIT_L(8); PG8_BAR; PG8_WAIT_L(0); PG8_MMA(0, 0, At, B0); PG8_BAR; PG8_SCHED;
            PG8_LDB(B1, 1, 1); PG8_STAGE(PG8_SB(1, 0), b3, voffB);
            PG8_BAR; PG8_WAIT_L(0); PG8_MMA(0, 1, At, B1); PG8_BAR;
            PG8_LDA(At, 1, 1); PG8_STAGE(PG8_SA(1, 0), a3, voffA);
            PG8_BAR; PG8_WAIT_L(0); PG8_MMA(1, 0, At, B0); PG8_BAR; PG8_SCHED;
            PG8_STAGE(PG8_SB(1, 1), b3 + hstep, voffB);
            PG8_WAIT_V(6); PG8_BAR; PG8_MMA(1, 1, At, B1); PG8_BAR;
        }
        PG8_STAMP();
        if constexpr (!Epi::AFTER_DRAIN) { E(acc, cur, wr, wc, fr, fq); S.done(cur); }
        PG8_STAMP();
        if (!has_next) break;
#pragma unroll
        for (int a = 0; a < 2; ++a)
#pragma unroll
            for (int b = 0; b < 2; ++b)
#pragma unroll
                for (int m = 0; m < 4; ++m)
#pragma unroll
                    for (int n = 0; n < 2; ++n) acc[a][b][m][n] = (f32x4){0.f, 0.f, 0.f, 0.f};
        cur = nxt; cA = nA; cB = nB; ++ui;
    }
    PG8_WAIT_V(0);
    if (wr == 0) PG8_BAR;
    PG8_BAR;
    if constexpr (Epi::AFTER_DRAIN) { E.fused(acc, cur, wr, wc, fr, fq, lds, wid, lane); S.done(cur); }
    PG8_STAMP();
    if (STAMP && wid == 0) { stamps[lane] = lane < nts ? (((unsigned long long)(unsigned)ts_hi << 32) | (unsigned)ts_lo) : 0ull;
        if (lane == 62) stamps[62] = rt_entry; if (lane == 63) stamps[63] = (unsigned long long)wall_clock64(); }
#undef PG8_STAMP
#undef PG8_SA
#undef PG8_SB
#undef PG8_STAGE
#undef PG8_LDA
#undef PG8_LDB
#undef PG8_MMA
#undef PG8_WAIT_V
#undef PG8_WAIT_L
#undef PG8_BAR
#undef PG8_SCHED
}
}
#define XB_TMO      128
#define XB_XCNT(j)  (256  + 64 * (j))
#define XB_XSUB(j)  (1280 + 64 * (j))
#define XB_XGEN(j)  (2304 + 64 * (j))
#define XB_TOP      3328
#define XB_TOPGEN   3392
#define XCD_BAR_WORDS 3456
#define XB_SPIN_CAP (1u << 18)
#define LAS __attribute__((address_space(3)))

__device__ __forceinline__ unsigned xb_ld(unsigned* p)              { return __hip_atomic_load(p, __ATOMIC_RELAXED, __HIP_MEMORY_SCOPE_AGENT); }
__device__ __forceinline__ unsigned xb_add(unsigned* p, unsigned v) { return __hip_atomic_fetch_add(p, v, __ATOMIC_RELAXED, __HIP_MEMORY_SCOPE_AGENT); }
__device__ __forceinline__ unsigned xb_xcc_id() { return (unsigned)__builtin_amdgcn_s_getreg((3 << 11) | 20) & 0xFu; }
#define XB_SPIN(cond, bar) do { unsigned _sp = 0; while (cond) { __builtin_amdgcn_s_sleep(1); \
    if ((++_sp & 255u) == 0u) { if (xb_ld(&(bar)[XB_TMO])) break; if (_sp > XB_SPIN_CAP) { atomicAdd(&(bar)[XB_TMO], 1u); break; } } } } while (0)

struct XcdBarrier {
    unsigned* bar; unsigned x;
    volatile LAS unsigned* st;
};

__device__ __forceinline__ XcdBarrier xcd_barrier_post(unsigned* bar, volatile LAS unsigned* st) {
    XcdBarrier b; b.bar = bar; b.x = xb_xcc_id(); b.st = st;
    if (threadIdx.x == 0) (void)xb_add(&bar[XB_XCNT(b.x)], 1u);
    return b;
}
__device__ __forceinline__ void xcd_barrier_complete(unsigned* bar, unsigned x, unsigned& nloc, unsigned& nx) {
    const unsigned G = gridDim.x * gridDim.y * gridDim.z;
    unsigned sum, cnt, mine, sp = 0u;
    for (;;) {
        sum = 0u; cnt = 0u; mine = 0u;
#pragma unroll
        for (unsigned j = 0; j < 16; ++j) { const unsigned c = xb_ld(&bar[XB_XCNT(j)]); sum += c; cnt += (c > 0u) ? 1u : 0u; mine = (j == x) ? c : mine; }
        if (sum == G) break;
        __builtin_amdgcn_s_sleep(1);
        if ((++sp & 255u) == 0u) { if (xb_ld(&bar[XB_TMO])) break; if (sp > XB_SPIN_CAP) { atomicAdd(&bar[XB_TMO], 1u); break; } }
    }
    nloc = mine > 0u ? mine : 1u; nx = cnt > 0u ? cnt : 1u;
}

__device__ __forceinline__ void xcd_barrier(const XcdBarrier& b) {
    asm volatile("s_waitcnt vmcnt(0)" ::: "memory");
    __syncthreads();
    if (threadIdx.x == 0) {
        unsigned* bar = b.bar;
        __builtin_amdgcn_s_waitcnt(0);
        unsigned nloc = b.st[0], nx = b.st[1];
        if (nloc == 0u) { xcd_barrier_complete(bar, b.x, nloc, nx); b.st[0] = nloc; b.st[1] = nx; }
        const unsigned old = xb_add(&bar[XB_XSUB(b.x)], 1u);
        const unsigned gen = old / nloc;
        if (old + 1u == (gen + 1u) * nloc) {
            __builtin_amdgcn_fence(__ATOMIC_RELEASE, "agent");
            asm volatile("s_waitcnt vmcnt(0)" ::: "memory");
            const unsigned og = xb_add(&bar[XB_TOP], 1u);
            const unsigned tg = og / nx;
            if (og + 1u == (tg + 1u) * nx) xb_add(&bar[XB_TOPGEN], 1u);
            else XB_SPIN(xb_ld(&bar[XB_TOPGEN]) == tg, bar);
            __builtin_amdgcn_fence(__ATOMIC_ACQUIRE, "agent");
            xb_add(&bar[XB_XGEN(b.x)], 1u);
            asm volatile("s_waitcnt vmcnt(0)" ::: "memory");
        } else {
            XB_SPIN(xb_ld(&bar[XB_XGEN(b.x)]) == gen, bar);
            __builtin_amdgcn_fence(__ATOMIC_ACQUIRE, "agent");
            asm volatile("s_waitcnt vmcnt(0)" ::: "memory");
        }
    }
    __syncthreads();
}


namespace mk {
using pg8::bf16_t; using pg8::bf16x8; using pg8::f32x4; using pg8::u32x4; using pg8::Unit; using pg8::cvt_pk_bf16;
typedef unsigned u32x2 __attribute__((ext_vector_type(2)));
typedef float cpx __attribute__((ext_vector_type(2)));
__host__ __device__ __forceinline__ cpx mkc(float a, float b) { cpx r; r.x = a; r.y = b; return r; }

constexpr int D = 2048, T_P = 32768, T_S = 8192, T = 40960, L_P = 16384, L_S = 2048, DFF = 5632;
constexpr int NTHR = 512;
constexpr int MODW = 53248;
constexpr int NPOS = 18432;
constexpr int QKVW = 9216;
constexpr float EPS = 1e-6f;
constexpr float QSCALE = 0.12751743082459868f;
constexpr int LDS_BYTES = 147456;
constexpr int LDS_MISC = 147456 - 256;

constexpr size_t al256(size_t x) { return (x + 255) & ~(size_t)255; }
constexpr size_t WS_CTL  = 0;
constexpr size_t CTL_BYTES = 65536;
constexpr size_t WS_PART = WS_CTL + CTL_BYTES;
constexpr size_t WS_MOD  = WS_PART + al256((size_t)8 * 6 * MODW * 4);
constexpr size_t WS_ROPE = WS_MOD + al256((size_t)6 * MODW * 4);
constexpr size_t WS_A2X  = WS_ROPE + (size_t)16384 * 16 * 8;
constexpr size_t WS_W3X  = WS_A2X + (size_t)2 * NPOS * 256 * 2;
constexpr size_t WS_WL   = WS_W3X + (size_t)2 * 8192 * 256 * 2;
constexpr size_t WL_FFN1 = 0;
constexpr size_t WL_FFN2 = WL_FFN1 + (size_t)11264 * 2048 * 2;
constexpr size_t WL_MIXIN = WL_FFN2 + (size_t)2048 * 5632 * 2;
constexpr size_t WL_MIXOUT = WL_MIXIN + (size_t)9216 * 2048 * 2;
constexpr size_t WL_BYTES = WL_MIXOUT + (size_t)2048 * 2048 * 2;
constexpr size_t WS_H    = WS_WL + WL_BYTES;
constexpr size_t H_BYTES = (size_t)T * 2048 * 2;
constexpr size_t WS_BIG  = WS_H + H_BYTES;
constexpr size_t BIG_ZINT = 0;
constexpr size_t BIG_TAPS = BIG_ZINT + (size_t)6144 * T * 2;
constexpr size_t BIG_HY_END = BIG_TAPS + (size_t)8192 * NPOS * 2;
constexpr size_t BIG_QKV = 0;
constexpr size_t BIG_OG  = BIG_QKV + (size_t)T * QKVW * 2;
constexpr size_t BIG_LSE = BIG_OG + (size_t)3 * T * 1024 * 2;
constexpr size_t BIG_AT_END = BIG_LSE + (size_t)3 * T * 8 * 4;
constexpr size_t BIG_MID = 0;
constexpr size_t BIG_BYTES = BIG_HY_END > BIG_AT_END ? BIG_HY_END : BIG_AT_END;
constexpr size_t WS_END  = WS_BIG + BIG_BYTES;
constexpr size_t FFT_SCR_PER_WG = 5 * 131072;
constexpr size_t FFT_EXT_PER_WG = 2 * 65536;
constexpr size_t WS_XB = WS_END + (size_t)256 * FFT_EXT_PER_WG;
constexpr size_t WS_TOTAL = WS_XB + (size_t)T * 2048 * 2;
static_assert(256 * FFT_SCR_PER_WG <= H_BYTES, "fft scratch must fit in H");

struct Params {
    const float *x_prompt, *x_sample, *c_prompt, *c_sample, *ada_w, *ada_b, *norm_mix, *norm_ffn;
    const float *hy_w_in, *hy_b_in, *hy_conv_w, *hy_conv_b, *hy_fw1, *hy_fb1, *hy_ffreq, *hy_fw2, *hy_fb2, *hy_fw3, *hy_decay, *hy_skip, *hy_w_out, *hy_b_out;
    const float *at_w_in, *at_w_out, *ffn_w_gate, *ffn_w_up, *ffn_w_down, *final_norm, *final_ada_w, *final_ada_b;
    float* out; unsigned char* ws; int ph_lo, ph_hi, probe, pad0;
};

#define LDSQ __attribute__((address_space(3)))

__device__ __forceinline__ float bf2f(bf16_t b) { return __uint_as_float(((unsigned)b) << 16); }
__device__ __forceinline__ bf16_t f2bf(float f) { unsigned u = __float_as_uint(f); u += 0x7FFFu + ((u >> 16) & 1u); return (bf16_t)(u >> 16); }
__device__ __forceinline__ int seq_of_row(int row) { return row < T_P ? (row >> 14) : 2 + ((row - T_P) >> 11); }
__device__ __forceinline__ int pos_of_row(int row) { return row < T_P ? (row & 16383) : (row & 2047); }
__device__ __forceinline__ float wave_sum(float v) {
#pragma unroll
    for (int o = 32; o >= 1; o >>= 1) v += __shfl_xor(v, o);
    return v;
}

struct EpiZinT {
    static constexpr bool PERM = true, AFTER_DRAIN = false;
    bf16_t* O; int ldc; const float* bias;
    __device__ __forceinline__ void operator()(const f32x4 (&acc)[2][2][4][2], const Unit& u, int wr, int wc, int fr, int fq) const {
        const int row0 = u.pm * 256 + wr * 64 + fr, col0 = u.pn * 256 + wc * 32 + 8 * fq;
        float bs[8];
#pragma unroll
        for (int r = 0; r < 8; ++r) bs[r] = bias[row0 + (r >> 2) * 128 + (r & 3) * 16];
#pragma unroll
        for (int ai = 0; ai < 2; ++ai)
#pragma unroll
            for (int m = 0; m < 4; ++m) { const int r = row0 + ai * 128 + m * 16; const float b = bs[ai * 4 + m]; bf16_t* rowp = O + (size_t)r * ldc + col0;
#pragma unroll
                for (int bj = 0; bj < 2; ++bj) { const f32x4 v0 = acc[ai][bj][m][0] + b, v1 = acc[ai][bj][m][1] + b;
                    u32x4 w; w.x = cvt_pk_bf16(v0[0], v0[1]); w.y = cvt_pk_bf16(v0[2], v0[3]); w.z = cvt_pk_bf16(v1[0], v1[1]); w.w = cvt_pk_bf16(v1[2], v1[3]);
                    *(u32x4*)(rowp + bj * 128) = w; } }
    }
};
struct EpiRes {
    static constexpr bool PERM = false, AFTER_DRAIN = false;
    bf16_t* X; const float* bias; const float* gate; int dry;
    __device__ __forceinline__ void operator()(const f32x4 (&acc)[2][2][4][2], const Unit& u, int wr, int wc, int fr, int fq) const {
        const int row0 = u.pm * 256 + wr * 64 + fr, col0 = u.pn * 256 + wc * 32 + 4 * fq;
        const float* gp = gate + (size_t)seq_of_row(u.pm * 256) * MODW + col0;
        bf16_t* xb = X + (size_t)row0 * 2048 + col0;
        u32x2 xv[2][8]; f32x4 gv[2], bv[2];
#pragma unroll
        for (int r = 0; r < 8; ++r) xv[0][r] = *(const u32x2*)(xb + (size_t)((r >> 2) * 128 + (r & 3) * 16) * 2048);
        gv[0] = *(const f32x4*)(gp); bv[0] = bias ? *(const f32x4*)(bias + col0) : (f32x4){0.f, 0.f, 0.f, 0.f};
#pragma unroll
        for (int cg = 0; cg < 4; ++cg) {
            const int bj = cg >> 1, n = cg & 1, coff = bj * 128 + n * 16;
            if (cg < 3) { const int c2 = ((cg + 1) >> 1) * 128 + ((cg + 1) & 1) * 16;
#pragma unroll
                for (int r = 0; r < 8; ++r) xv[(cg + 1) & 1][r] = *(const u32x2*)(xb + (size_t)((r >> 2) * 128 + (r & 3) * 16) * 2048 + c2);
                gv[(cg + 1) & 1] = *(const f32x4*)(gp + c2); bv[(cg + 1) & 1] = bias ? *(const f32x4*)(bias + col0 + c2) : (f32x4){0.f, 0.f, 0.f, 0.f}; }
#pragma unroll
            for (int r = 0; r < 8; ++r) { const u32x2 xo = xv[cg & 1][r];
                const f32x4 xf = {__uint_as_float(xo.x << 16), __uint_as_float(xo.x & 0xffff0000u), __uint_as_float(xo.y << 16), __uint_as_float(xo.y & 0xffff0000u)};
                const f32x4 x = xf + gv[cg & 1] * (acc[r >> 2][bj][r & 3][n] + bv[cg & 1]);
                u32x2 w; w.x = cvt_pk_bf16(x[0], x[1]); w.y = cvt_pk_bf16(x[2], x[3]);
                if (!dry) *(u32x2*)(xb + (size_t)((r >> 2) * 128 + (r & 3) * 16) * 2048 + coff) = w; }
        }
    }
};
struct EpiQKV {
    static constexpr bool PERM = true, AFTER_DRAIN = false;
    bf16_t* O; const cpx* rope;
    __device__ __forceinline__ void operator()(const f32x4 (&acc)[2][2][4][2], const Unit& u, int wr, int wc, int fr, int fq) const {
        const int row0 = u.pm * 256 + wr * 64 + fr, colt = u.pn * 256, col0 = colt + wc * 32 + 8 * fq;
        const int sidx = (colt % 3072) >> 10;
        const bool dorope = (sidx < 2) && (wc == 0);
        const float qs = (sidx == 0) ? QSCALE : 1.0f;
        f32x4 tt[2][4];
        if (dorope) { const cpx* rp = rope + (size_t)pos_of_row(row0) * 16 + 8 * (fq & 1);
            tt[0][0] = *(const f32x4*)(rp); tt[0][1] = *(const f32x4*)(rp + 2); tt[0][2] = *(const f32x4*)(rp + 4); tt[0][3] = *(const f32x4*)(rp + 6); }
#pragma unroll
        for (int g = 0; g < 8; ++g) { const int ai = g >> 2, m = g & 3; const int r = row0 + ai * 128 + m * 16; bf16_t* rowp = O + (size_t)r * QKVW + col0;
            f32x4 c0, c1, s0, s1;
            if (dorope) {
                if (g < 7) { const int r2 = row0 + ((g + 1) >> 2) * 128 + ((g + 1) & 3) * 16; const cpx* rp = rope + (size_t)pos_of_row(r2) * 16 + 8 * (fq & 1);
                    tt[(g + 1) & 1][0] = *(const f32x4*)(rp); tt[(g + 1) & 1][1] = *(const f32x4*)(rp + 2); tt[(g + 1) & 1][2] = *(const f32x4*)(rp + 4); tt[(g + 1) & 1][3] = *(const f32x4*)(rp + 6); }
                const f32x4 t0 = tt[g & 1][0], t1 = tt[g & 1][1], t2 = tt[g & 1][2], t3 = tt[g & 1][3];
                c0 = (f32x4){t0[0], t0[2], t1[0], t1[2]}; s0 = (f32x4){t0[1], t0[3], t1[1], t1[3]};
                c1 = (f32x4){t2[0], t2[2], t3[0], t3[2]}; s1 = (f32x4){t2[1], t2[3], t3[1], t3[3]}; }
#pragma unroll
            for (int bj = 0; bj < 2; ++bj) { f32x4 v0 = acc[ai][bj][m][0], v1 = acc[ai][bj][m][1];
                if (dorope) { f32x4 p0, p1;
#pragma unroll
                    for (int e = 0; e < 4; ++e) { p0[e] = __shfl_xor(v0[e], 32); p1[e] = __shfl_xor(v1[e], 32); }
                    if (fq < 2) { v0 = v0 * c0 - p0 * s0; v1 = v1 * c1 - p1 * s1; }
                    else        { v0 = v0 * c0 + p0 * s0; v1 = v1 * c1 + p1 * s1; } }
                v0 *= qs; v1 *= qs;
                u32x4 w; w.x = cvt_pk_bf16(v0[0], v0[1]); w.y = cvt_pk_bf16(v0[2], v0[3]); w.z = cvt_pk_bf16(v1[0], v1[1]); w.w = cvt_pk_bf16(v1[2], v1[3]);
                *(u32x4*)(rowp + bj * 128) = w; } }
    }
};
struct EpiFFN1 {
    static constexpr bool PERM = true, AFTER_DRAIN = false;
    bf16_t* O;
    __device__ __forceinline__ void operator()(const f32x4 (&acc)[2][2][4][2], const Unit& u, int wr, int wc, int fr, int fq) const {
        const int row0 = u.pm * 256 + wr * 64 + fr, col0 = u.pn * 128 + wc * 32 + 8 * fq;
#pragma unroll
        for (int ai = 0; ai < 2; ++ai)
#pragma unroll
            for (int m = 0; m < 4; ++m) { bf16_t* rowp = O + (size_t)(row0 + ai * 128 + m * 16) * DFF + col0; float o[8];
#pragma unroll
                for (int n = 0; n < 2; ++n)
#pragma unroll
                    for (int e = 0; e < 4; ++e) { const float g = acc[ai][0][m][n][e], up = acc[ai][1][m][n][e]; o[n * 4 + e] = g * __builtin_amdgcn_rcpf(1.0f + __expf(-g)) * up; }
                u32x4 w; w.x = cvt_pk_bf16(o[0], o[1]); w.y = cvt_pk_bf16(o[2], o[3]); w.z = cvt_pk_bf16(o[4], o[5]); w.w = cvt_pk_bf16(o[6], o[7]);
                *(u32x4*)rowp = w; }
    }
};
struct EpiTaps {
    static constexpr bool PERM = true, AFTER_DRAIN = false;
    _Float16* O;
    __device__ __forceinline__ void operator()(const f32x4 (&acc)[2][2][4][2], const Unit& u, int wr, int wc, int fr, int fq) const {
        typedef _Float16 h8 __attribute__((ext_vector_type(8)));
        const int row0 = u.pm * 256 + wr * 64 + fr, col0 = u.pn * 256 + wc * 32 + 8 * fq;
#pragma unroll
        for (int ai = 0; ai < 2; ++ai)
#pragma unroll
            for (int m = 0; m < 4; ++m) { _Float16* rowp = O + (size_t)(row0 + ai * 128 + m * 16) * NPOS + col0;
#pragma unroll
                for (int bj = 0; bj < 2; ++bj) { const f32x4 v0 = acc[ai][bj][m][0], v1 = acc[ai][bj][m][1]; h8 w;
                    w[0] = (_Float16)v0[0]; w[1] = (_Float16)v0[1]; w[2] = (_Float16)v0[2]; w[3] = (_Float16)v0[3]; w[4] = (_Float16)v1[0]; w[5] = (_Float16)v1[1]; w[6] = (_Float16)v1[2]; w[7] = (_Float16)v1[3];
                    *(h8*)(rowp + bj * 128) = w; } }
    }
};

__device__ __forceinline__ void ada_partials(const Params& p, LDSQ unsigned char* lds) {
    LDSQ float* cs = (LDSQ float*)lds;
    for (int i = pg8::otid(); i < 6 * 2048; i += NTHR) { const int b = i >> 11, k = i & 2047; const float c = b < 2 ? p.c_prompt[b * 2048 + k] : p.c_sample[(b - 2) * 2048 + k]; cs[i] = c / (1.0f + expf(-c)); }
    __syncthreads();
    float* part = (float*)(p.ws + WS_PART);
    for (int item = pg8::obid() * NTHR + pg8::otid(); item < 8 * 13312; item += pg8::ogrid() * NTHR) {
        const int chunk = item / 13312, c4 = item % 13312;
        const float* W; int ldw;
        if (c4 < 12288) { const int layer = c4 / 3072, col = (c4 % 3072) * 4; W = p.ada_w + (size_t)layer * 2048 * 12288 + col; ldw = 12288; }
        else { W = p.final_ada_w + (c4 - 12288) * 4; ldw = 4096; }
        f32x4 a0 = {0.f, 0.f, 0.f, 0.f}, a1 = a0, a2 = a0, a3 = a0, a4 = a0, a5 = a0;
        const int k0 = chunk * 256;
#pragma unroll 8
        for (int k = k0; k < k0 + 256; ++k) { const f32x4 w = *(const f32x4*)(W + (size_t)k * ldw);
            a0 += cs[k] * w; a1 += cs[2048 + k] * w; a2 += cs[4096 + k] * w; a3 += cs[6144 + k] * w; a4 += cs[8192 + k] * w; a5 += cs[10240 + k] * w; }
        float* o = part + (size_t)chunk * 6 * MODW + (size_t)c4 * 4;
        *(f32x4*)(o) = a0; *(f32x4*)(o + MODW) = a1; *(f32x4*)(o + 2 * MODW) = a2; *(f32x4*)(o + 3 * MODW) = a3; *(f32x4*)(o + 4 * MODW) = a4; *(f32x4*)(o + 5 * MODW) = a5;
    }
    __syncthreads();
}
__device__ __forceinline__ void ada_reduce(const Params& p) {
    const float* part = (const float*)(p.ws + WS_PART); float* mod = (float*)(p.ws + WS_MOD);
    for (int i = pg8::obid() * NTHR + pg8::otid(); i < 6 * MODW; i += pg8::ogrid() * NTHR) {
        const int c = i % MODW; float s = c < 49152 ? p.ada_b[c] : p.final_ada_b[c - 49152];
#pragma unroll
        for (int ch = 0; ch < 8; ++ch) s += part[(size_t)ch * 6 * MODW + i];
        mod[i] = s;
    }
}
__device__ __forceinline__ void rope_table(const Params& p) {
    cpx* rope = (cpx*)(p.ws + WS_ROPE);
    for (int i = pg8::obid() * NTHR + pg8::otid(); i < 16384 * 16; i += pg8::ogrid() * NTHR) {
        const int pos = i >> 4, f = i & 15; const float inv = powf(500000.0f, -(float)f / 16.0f); const float ang = (float)pos * inv;
        float s, c; sincosf(ang, &s, &c); rope[i] = mkc(c, s);
    }
}
__device__ __forceinline__ void filter_mlp(const Params& p) {
    const int lane = pg8::otid() & 63, gw = pg8::obid() * 8 + (pg8::otid() >> 6);
    bf16_t* a2x = (bf16_t*)(p.ws + WS_A2X);
    for (int q = gw; q < 2 * NPOS; q += pg8::ogrid() * 8) {
        const int j = q / NPOS, r = q % NPOS; const int L = r < 16384 ? 16384 : 2048, pos = r < 16384 ? r : r - 16384;
        const float fpos = (float)pos;
        float z = 0.f;
        if (lane == 0) z = fpos / (float)(L - 1);
        else if (lane <= 32) { const int bi = (lane - 1) & 15; const float band = 1e-4f + (float)bi * ((15.0f - 1e-4f) / 15.0f);
            const float ang = ((6.283185307179586f * fpos) * band) / (float)L; z = lane <= 16 ? cosf(ang) : -sinf(ang); }
        const float* w1 = p.hy_fw1 + j * 33 * 64; const float* w2 = p.hy_fw2 + j * 64 * 64;
        float acc = p.hy_fb1[j * 64 + lane];
#pragma unroll
        for (int m = 0; m < 33; ++m) acc += __shfl(z, m) * w1[m * 64 + lane];
        const float a1 = sinf(p.hy_ffreq[j * 128 + lane] * acc);
        acc = p.hy_fb2[j * 64 + lane];
#pragma unroll
        for (int m = 0; m < 64; ++m) acc += __shfl(a1, m) * w2[m * 64 + lane];
        const float a2 = sinf(p.hy_ffreq[j * 128 + 64 + lane] * acc);
        const bf16_t hi = f2bf(a2), lo = f2bf(a2 - bf2f(hi));
        bf16_t* o = a2x + ((size_t)j * NPOS + r) * 256;
        o[lane] = hi; o[64 + lane] = hi; o[128 + lane] = lo; o[192 + lane] = 0;
    }
    bf16_t* w3x = (bf16_t*)(p.ws + WS_W3X);
    for (int i = pg8::obid() * NTHR + pg8::otid(); i < 2 * 8192 * 64; i += pg8::ogrid() * NTHR) {
        const int k = i & 63, col = (i >> 6) & 8191, j = i >> 19;
        const float v = p.hy_fw3[(size_t)j * 64 * 8192 + (size_t)k * 8192 + col];
        const bf16_t hi = f2bf(v), lo = f2bf(v - bf2f(hi));
        bf16_t* o = w3x + ((size_t)j * 8192 + col) * 256;
        o[k] = hi; o[64 + k] = lo; o[128 + k] = hi; o[192 + k] = 0;
    }
}
__device__ __forceinline__ void convert_T(LDSQ unsigned char* lds, const float* src, int K, int N, bf16_t* dst, int ffs) {
    LDSQ float* tile = (LDSQ float*)lds;
    const int tid = pg8::otid(), ntn = N >> 8, ntiles = (K >> 6) * ntn, stride = pg8::ogrid();
    const int r = tid >> 6, c4 = tid & 63;
    f32x4 v[8];
    int ti = pg8::obid();
    if (ti < ntiles) { const int tk = ti / ntn, tn = ti % ntn;
#pragma unroll
        for (int it = 0; it < 8; ++it) v[it] = *(const f32x4*)(src + (size_t)(tk * 64 + r + 8 * it) * N + tn * 256 + 4 * c4); }
    for (; ti < ntiles; ti += stride) {
        const int tk = ti / ntn, tn = ti % ntn;
#pragma unroll
        for (int it = 0; it < 8; ++it) { LDSQ float* tp = tile + (r + 8 * it) * 257 + 4 * c4; tp[0] = v[it][0]; tp[1] = v[it][1]; tp[2] = v[it][2]; tp[3] = v[it][3]; }
        __syncthreads();
        if (ti + stride < ntiles) { const int t2 = ti + stride, tk2 = t2 / ntn, tn2 = t2 % ntn;
#pragma unroll
            for (int it = 0; it < 8; ++it) v[it] = *(const f32x4*)(src + (size_t)(tk2 * 64 + r + 8 * it) * N + tn2 * 256 + 4 * c4); }
        { const int n = tid >> 1, kh = tid & 1; const int nn = tn * 256 + n; const int row = ffs < 0 ? nn : (256 * (nn >> 7) + 128 * ffs + (nn & 127));
          bf16_t* dp = dst + (size_t)row * K + tk * 64 + kh * 32;
#pragma unroll
          for (int q = 0; q < 4; ++q) { float f[8];
#pragma unroll
              for (int e = 0; e < 8; ++e) f[e] = tile[(kh * 32 + q * 8 + e) * 257 + n];
              u32x4 w; w.x = cvt_pk_bf16(f[0], f[1]); w.y = cvt_pk_bf16(f[2], f[3]); w.z = cvt_pk_bf16(f[4], f[5]); w.w = cvt_pk_bf16(f[6], f[7]);
              *(u32x4*)(dp + q * 8) = w; } }
        __syncthreads();
    }
}
template <bool FINAL, bool SRC_F32> __device__ __forceinline__ void norm_rows(const float* xp, const float* xs, bf16_t* xb, const float* g, const float* modl, int sh_off, int sc_off, bf16_t* H, float* outf) {
    const int lane = pg8::otid() & 63, gw = pg8::obid() * 8 + (pg8::otid() >> 6), nw = pg8::ogrid() * 8;
    const int rpw = (T + nw - 1) / nw, r0 = gw * rpw, r1 = (r0 + rpw < T) ? r0 + rpw : T;
    if (r0 >= r1) return;
    f32x4 gs[8], sh[8]; int curseq = -1;
    struct RowBuf { f32x4 f[SRC_F32 ? 8 : 1]; u32x2 b[SRC_F32 ? 1 : 8]; };
    auto request = [&](RowBuf& B, int row) {
        if (SRC_F32) { const f32x4* src = (const f32x4*)(row < T_P ? xp + (size_t)row * 2048 : xs + (size_t)(row - T_P) * 2048);
#pragma unroll
            for (int i = 0; i < 8; ++i) B.f[i] = src[lane + 64 * i]; }
        else { const u32x2* src = (const u32x2*)(xb + (size_t)row * 2048);
#pragma unroll
            for (int i = 0; i < 8; ++i) B.b[i] = src[lane + 64 * i]; } };
    auto process = [&](RowBuf& B, int row, int next) {
        f32x4 v[8];
#pragma unroll
        for (int i = 0; i < 8; ++i) { if (SRC_F32) v[i] = B.f[i]; else v[i] = (f32x4){__uint_as_float(B.b[i].x << 16), __uint_as_float(B.b[i].x & 0xffff0000u), __uint_as_float(B.b[i].y << 16), __uint_as_float(B.b[i].y & 0xffff0000u)}; }
        if (next < r1) request(B, next);
        const int seq = seq_of_row(row);
        if (seq != curseq) { curseq = seq; const float* mod = modl + (size_t)seq * MODW;
#pragma unroll
            for (int i = 0; i < 8; ++i) { const int col = (lane + 64 * i) * 4; gs[i] = *(const f32x4*)(g + col); sh[i] = *(const f32x4*)(mod + sc_off + col); }
#pragma unroll
            for (int i = 0; i < 8; ++i) { const int col = (lane + 64 * i) * 4; const f32x4 sft = *(const f32x4*)(mod + sh_off + col); gs[i] = gs[i] * (1.0f + sh[i]); sh[i] = sft; } }
        float ss = 0.f;
#pragma unroll
        for (int i = 0; i < 8; ++i) ss += v[i][0] * v[i][0] + v[i][1] * v[i][1] + v[i][2] * v[i][2] + v[i][3] * v[i][3];
        ss = wave_sum(ss);
        const float rstd = 1.0f / sqrtf(ss * (1.0f / 2048.0f) + EPS);
#pragma unroll
        for (int i = 0; i < 8; ++i) { const int col = (lane + 64 * i) * 4;
            const f32x4 h = (v[i] * rstd) * gs[i] + sh[i];
            if (FINAL) *(f32x4*)(outf + (size_t)row * 2048 + col) = h;
            else { u32x2 w; w.x = cvt_pk_bf16(h[0], h[1]); w.y = cvt_pk_bf16(h[2], h[3]); *(u32x2*)(H + (size_t)row * 2048 + col) = w;
                if (SRC_F32) { u32x2 c; c.x = cvt_pk_bf16(v[i][0], v[i][1]); c.y = cvt_pk_bf16(v[i][2], v[i][3]); *(u32x2*)(xb + (size_t)row * 2048 + col) = c; } } } };
    if (SRC_F32) {
        RowBuf B0, B1;
        request(B0, r0); if (r0 + 1 < r1) request(B1, r0 + 1);
        for (int row = r0; row < r1; row += 2) { process(B0, row, row + 2); if (row + 1 < r1) process(B1, row + 1, row + 3); }
    } else {
        RowBuf B0, B1, B2;
        request(B0, r0); if (r0 + 1 < r1) request(B1, r0 + 1); if (r0 + 2 < r1) request(B2, r0 + 2);
        for (int row = r0; row < r1; row += 3) {
            process(B0, row, row + 3);
            if (row + 1 < r1) process(B1, row + 1, row + 4);
            if (row + 2 < r1) process(B2, row + 2, row + 5);
        }
    }
}
__device__ __forceinline__ void final_norm_phase(const Params& p) {
    norm_rows<true, false>(nullptr, nullptr, (bf16_t*)(p.ws + WS_XB), p.final_norm, (const float*)(p.ws + WS_MOD) + 49152, 0, 2048, nullptr, p.out);
}
__device__ __forceinline__ void transpose_phase(const Params& p, LDSQ unsigned char* lds) {
    LDSQ bf16_t* tile = (LDSQ bf16_t*)lds;
    const bf16_t* zin = (const bf16_t*)(p.ws + WS_BIG + BIG_ZINT); bf16_t* H = (bf16_t*)(p.ws + WS_H);
    const int tid = pg8::otid(), stride = pg8::ogrid();
    const int cr = tid >> 5, tq = tid & 31;
    u32x4 v[4];
    int ti = pg8::obid();
    if (ti < 32 * 160) { const int tc = ti / 160, tt = ti % 160;
#pragma unroll
        for (int it = 0; it < 4; ++it) v[it] = *(const u32x4*)(zin + (size_t)(tc * 64 + cr + 16 * it) * T + tt * 256 + tq * 8); }
    for (; ti < 32 * 160; ti += stride) {
        const int tc = ti / 160, tt = ti % 160;
#pragma unroll
        for (int it = 0; it < 4; ++it) *(LDSQ u32x4*)(tile + (cr + 16 * it) * 264 + tq * 8) = v[it];
        __syncthreads();
        if (ti + stride < 32 * 160) { const int t2 = ti + stride, tc2 = t2 / 160, tt2 = t2 % 160;
#pragma unroll
            for (int it = 0; it < 4; ++it) v[it] = *(const u32x4*)(zin + (size_t)(tc2 * 64 + cr + 16 * it) * T + tt2 * 256 + tq * 8); }
        { const int cq = tid & 7, tk = tid >> 3;
#pragma unroll
          for (int it = 0; it < 4; ++it) { const int tok = tk + 64 * it; unsigned w[4];
#pragma unroll
              for (int e = 0; e < 4; ++e) { const unsigned lo = tile[(cq * 8 + 2 * e) * 264 + tok], hi = tile[(cq * 8 + 2 * e + 1) * 264 + tok]; w[e] = lo | (hi << 16); }
              *(u32x4*)(H + (size_t)(tt * 256 + tok) * 2048 + tc * 64 + cq * 8) = (u32x4){w[0], w[1], w[2], w[3]}; } }
        __syncthreads();
    }
}

__host__ __device__ constexpr float cos64q(int k) {
    constexpr float t[17] = {1.0f, 0.99518472667219693f, 0.98078528040323043f, 0.95694033573220882f, 0.92387953251128674f, 0.88192126434835505f, 0.83146961230254524f,
        0.77301045336273699f, 0.70710678118654757f, 0.63439328416364549f, 0.55557023301960229f, 0.47139673682599781f, 0.38268343236508984f, 0.29028467725446233f,
        0.19509032201612833f, 0.09801714032956077f, 0.0f};
    return t[k];
}
__host__ __device__ constexpr float cos64(int k) { k &= 63; return k <= 16 ? cos64q(k) : k <= 32 ? -cos64q(32 - k) : k <= 48 ? -cos64q(k - 32) : cos64q(64 - k); }
__host__ __device__ constexpr float sin64(int k) { return cos64((k + 48) & 63); }
template <int R> __host__ __device__ constexpr int brev(int k) { int r = 0; for (int b = 1; b < R; b <<= 1) { r = (r << 1) | (k & 1); k >>= 1; } return r; }

typedef _Float16 hcpx __attribute__((ext_vector_type(2)));
typedef _Float16 hcpx2 __attribute__((ext_vector_type(4)));
__device__ __forceinline__ hcpx h_of(cpx a) { hcpx r; r.x = (_Float16)a.x; r.y = (_Float16)a.y; return r; }
__device__ __forceinline__ cpx c_of(hcpx a) { return mkc((float)a.x, (float)a.y); }
__device__ __forceinline__ hcpx2 h2_of(cpx a, cpx b) { hcpx2 r; r.x = (_Float16)a.x; r.y = (_Float16)a.y; r.z = (_Float16)b.x; r.w = (_Float16)b.y; return r; }
#define VA __device__ __forceinline__ float
VA f_mul(float a, float b) { float r; asm("v_mul_f32_e32 %0, %1, %2" : "=v"(r) : "v"(a), "v"(b)); return r; }
VA f_fma(float a, float b, float c) { float r; asm("v_fma_f32 %0, %1, %2, %3" : "=v"(r) : "v"(a), "v"(b), "v"(c)); return r; }
VA f_fms(float a, float b, float c) { float r; asm("v_fma_f32 %0, %1, %2, -%3" : "=v"(r) : "v"(a), "v"(b), "v"(c)); return r; }
#undef VA
__device__ __forceinline__ cpx cmul(cpx a, cpx b) { float rx, ry;
    asm("v_mul_f32_e32 %0, %3, %5\n\tv_mul_f32_e32 %1, %3, %4\n\tv_fma_f32 %0, %2, %4, -%0\n\tv_fma_f32 %1, %2, %5, %1" : "=&v"(rx), "=&v"(ry) : "v"(a.x), "v"(a.y), "v"(b.x), "v"(b.y)); return mkc(rx, ry); }
__device__ __forceinline__ cpx cmulc(cpx a, cpx b) { float rx, ry;
    asm("v_mul_f32_e32 %0, %3, %5\n\tv_mul_f32_e32 %1, %2, %5\n\tv_fma_f32 %0, %2, %4, %0\n\tv_fma_f32 %1, %3, %4, -%1" : "=&v"(rx), "=&v"(ry) : "v"(a.x), "v"(a.y), "v"(b.x), "v"(b.y)); return mkc(rx, ry); }

template <int R, bool INV, int H, int P> __device__ __forceinline__ void bfly(cpx (&v)[R]) {
    constexpr int b = (P / H) * 2 * H, i = P % H, e = i * (32 / H);
    float ux = v[b + i].x, uy = v[b + i].y, wx = v[b + i + H].x, wy = v[b + i + H].y;
    if constexpr (e == 0) { float dx, dy;
        asm("v_sub_f32_e32 %2, %0, %4\n\tv_sub_f32_e32 %3, %1, %5\n\tv_add_f32_e32 %0, %0, %4\n\tv_add_f32_e32 %1, %1, %5" : "+v"(ux), "+v"(uy), "=&v"(dx), "=&v"(dy) : "v"(wx), "v"(wy));
        wx = dx; wy = dy; }
    else if constexpr (e == 16) { float ox, oy;
        if constexpr (!INV) asm("v_sub_f32_e32 %2, %1, %5\n\tv_sub_f32_e32 %3, %4, %0\n\tv_add_f32_e32 %0, %0, %4\n\tv_add_f32_e32 %1, %1, %5" : "+v"(ux), "+v"(uy), "=&v"(ox), "=&v"(oy) : "v"(wx), "v"(wy));
        else                asm("v_sub_f32_e32 %2, %5, %1\n\tv_sub_f32_e32 %3, %0, %4\n\tv_add_f32_e32 %0, %0, %4\n\tv_add_f32_e32 %1, %1, %5" : "+v"(ux), "+v"(uy), "=&v"(ox), "=&v"(oy) : "v"(wx), "v"(wy));
        wx = ox; wy = oy; }
    else { constexpr float c = cos64(e), s = INV ? sin64(e) : -sin64(e);
        constexpr unsigned cb = __builtin_bit_cast(unsigned, c), sb = __builtin_bit_cast(unsigned, s), nsb = __builtin_bit_cast(unsigned, -s);
        float dx, dy;
        asm("v_sub_f32_e32 %4, %0, %2\n\tv_sub_f32_e32 %5, %1, %3\n\tv_add_f32_e32 %0, %0, %2\n\tv_add_f32_e32 %1, %1, %3\n\t"
            "v_mul_f32_e32 %2, %8, %5\n\tv_mul_f32_e32 %3, %6, %5\n\tv_fmamk_f32 %2, %4, %6, %2\n\tv_fmamk_f32 %3, %4, %7, %3"
            : "+v"(ux), "+v"(uy), "+v"(wx), "+v"(wy), "=&v"(dx), "=&v"(dy) : "i"(cb), "i"(sb), "i"(nsb)); }
    v[b + i] = mkc(ux, uy); v[b + i + H] = mkc(wx, wy);
}
template <int R, bool INV, int H, int... Ps> __device__ __forceinline__ void dft_stage(cpx (&v)[R], std::integer_sequence<int, Ps...>) { (bfly<R, INV, H, Ps>(v), ...); }
template <int R, bool INV, int H> __device__ __forceinline__ void dft_stages(cpx (&v)[R]) {
    dft_stage<R, INV, H>(v, std::make_integer_sequence<int, R / 2>{});
    if constexpr (H > 1) dft_stages<R, INV, H / 2>(v);
}
template <int R, bool INV> __device__ __forceinline__ void dft_r2(cpx (&v)[R]) { dft_stages<R, INV, R / 2>(v); }
template <int R, bool CONJ, bool BREV> __device__ __forceinline__ void apply_pows(cpx (&v)[R], cpx w) {
    constexpr int H = R > 16 ? 16 : R;
    cpx pw[H];
    pw[1] = w;
#pragma unroll
    for (int k = 2; k < H; ++k) pw[k] = (k & 1) ? cmul(pw[k - 1], w) : cmul(pw[k / 2], pw[k / 2]);
#pragma unroll
    for (int k = 1; k < H; ++k) { const int idx = BREV ? brev<R>(k) : k; v[idx] = CONJ ? cmulc(v[idx], pw[k]) : cmul(v[idx], pw[k]); }
    if (R > 16) {
        const cpx w16 = cmul(pw[8], pw[8]);
#pragma unroll
        for (int k = 0; k < R - 16; ++k) { const cpx q = k == 0 ? w16 : cmul(pw[k], w16); const int idx = BREV ? brev<R>(16 + k) : 16 + k; v[idx] = CONJ ? cmulc(v[idx], q) : cmul(v[idx], q); }
    }
}
__device__ __forceinline__ int phys(int i) { return i + (i >> 5); }
constexpr int TW_OFF = 135168 + 64;
template <int S> __host__ __device__ constexpr int poff(int j) { return S >= 32 ? j * (S + S / 32) : j * S + ((j * S) >> 5); }
typedef hcpx PreRegs[32];
template <int R, int S> __device__ __forceinline__ void fft_prefetch(int t, const hcpx* gio, PreRegs& pre) {
    constexpr int G = 32 / R;
#pragma unroll
    for (int gi = 0; gi < G; ++gi) { const int gam = gi * 512 + t, hi = gam / S, lo = gam % S, base = hi * (R * S) + lo;
#pragma unroll
        for (int j = 0; j < R; ++j) pre[gi * R + j] = __builtin_nontemporal_load(gio + base + j * S); }
}
template <int R, int S, bool INV, int IO> __device__ __forceinline__ void fft_pass(LDSQ cpx* A, int t, hcpx* gio, const PreRegs& pre) {
    constexpr int G = 32 / R;
    asm volatile("" : "+v"(t) :: "memory");
    const LDSQ cpx* TW = (const LDSQ cpx*)((LDSQ unsigned char*)A + TW_OFF);
    cpx v[G][R]; cpx tw[G];
#pragma unroll
    for (int gi = 0; gi < G; ++gi) {
        const int gam = gi * 512 + t, hi = gam / S, lo = gam % S, base = hi * (R * S) + lo; const LDSQ cpx* Ab = A + phys(base);
#pragma unroll
        for (int j = 0; j < R; ++j) v[gi][j] = (IO == 3) ? c_of(pre[gi * R + j]) : (IO == 1) ? c_of(__builtin_nontemporal_load(gio + base + j * S)) : Ab[poff<S>(j)];
        tw[gi] = TW[lo * (16384 / (R * S))];
    }
#pragma unroll
    for (int gi = 0; gi < G; ++gi) {
        const int gam = gi * 512 + t, hi = gam / S, lo = gam % S, base = hi * (R * S) + lo; LDSQ cpx* Ab = A + phys(base);
        if (!INV) {
            dft_r2<R, false>(v[gi]);
            apply_pows<R, false, true>(v[gi], tw[gi]);
#pragma unroll
            for (int k = 0; k < R; ++k) { if (IO == 2) gio[base + k * S] = h_of(v[gi][brev<R>(k)]); else Ab[poff<S>(k)] = v[gi][brev<R>(k)]; }
        } else {
            apply_pows<R, true, false>(v[gi], tw[gi]);
            dft_r2<R, true>(v[gi]);
#pragma unroll
            for (int j = 0; j < R; ++j) { if (IO == 2) gio[base + j * S] = h_of(v[gi][brev<R>(j)]); else Ab[poff<S>(j)] = v[gi][brev<R>(j)]; }
        }
    }
}
template <int R, int MODE> __device__ __forceinline__ void fft_mid(LDSQ cpx* A, int t, hcpx* spec, float scale) {
    constexpr int G = 32 / R;
    asm volatile("" : "+v"(t) :: "memory");
    hcpx2 sp[G][R / 2];
    if (MODE == 1) {
#pragma unroll
        for (int gi = 0; gi < G; ++gi)
#pragma unroll
            for (int k2 = 0; k2 < R / 2; ++k2) sp[gi][k2] = *(const hcpx2*)(spec + (size_t)(gi * 512 + t) * R + 2 * k2);
    }
#pragma unroll
    for (int gi = 0; gi < G; ++gi) {
        const int gam = gi * 512 + t, base = gam * R;
        cpx v[R];
        LDSQ cpx* Ab = A + phys(base);
#pragma unroll
        for (int j = 0; j < R; ++j) v[j] = Ab[j];
        dft_r2<R, false>(v);
        if (MODE == 0) {
#pragma unroll
            for (int k2 = 0; k2 < R / 2; ++k2) { const cpx x = v[brev<R>(2 * k2)], y = v[brev<R>(2 * k2 + 1)];
                *(hcpx2*)(spec + (size_t)base + 2 * k2) = h2_of(mkc(x.x * scale, x.y * scale), mkc(y.x * scale, y.y * scale)); }
        } else {
            cpx x[R];
#pragma unroll
            for (int k2 = 0; k2 < R / 2; ++k2) { const hcpx2 s = sp[gi][k2]; x[2 * k2] = cmul(v[brev<R>(2 * k2)], mkc((float)s.x * scale, (float)s.y * scale)); x[2 * k2 + 1] = cmul(v[brev<R>(2 * k2 + 1)], mkc((float)s.z * scale, (float)s.w * scale)); }
            dft_r2<R, true>(x);
#pragma unroll
            for (int j = 0; j < R; ++j) Ab[j] = x[brev<R>(j)];
        }
    }
}
#define GL_DRAIN() asm volatile("s_waitcnt vmcnt(0)" ::: "memory")
struct NoHook { __device__ __forceinline__ void operator()() const {} };
template <int LOG2L, bool INV, int GIO, class Hook = NoHook> __device__ __forceinline__ void fft_outer(LDSQ cpx* A, int t, hcpx* gio, const hcpx* pfsrc, PreRegs& pre, Hook hook = Hook()) {
    constexpr int R1 = LOG2L == 14 ? 32 : 16, S1 = LOG2L == 14 ? 512 : 128, S2 = LOG2L == 14 ? 16 : 8;
    if (!INV) { fft_pass<R1, S1, false, GIO == 3 ? 3 : 0>(A, t, nullptr, pre); __syncthreads(); fft_pass<R1, S2, false, 0>(A, t, nullptr, pre); GL_DRAIN(); __syncthreads(); }
    else      { fft_pass<R1, S2, true, 0>(A, t, nullptr, pre); __syncthreads();
                if (GIO == 2) fft_prefetch<R1, S1>(t, pfsrc, pre);
                hook();
                fft_pass<R1, S1, true, GIO == 2 ? 2 : 0>(A, t, gio, pre); if (GIO != 2) GL_DRAIN(); __syncthreads(); }
}
template <int LOG2L, int SRC, int DST, class Hook = NoHook> __device__ __forceinline__ void fft_conv(LDSQ cpx* A, int t, hcpx* spec, hcpx* gdst, const hcpx* pfsrc, PreRegs& pre, Hook hook = Hook()) {
    fft_outer<LOG2L, false, SRC>(A, t, nullptr, nullptr, pre);
    fft_mid<LOG2L == 14 ? 16 : 8, 1>(A, t, spec, 1.0f / (float)(1 << LOG2L));
    if (SRC == 3) GL_DRAIN();
    __syncthreads();
    fft_outer<LOG2L, true, DST>(A, t, gdst, pfsrc, pre, hook);
}

__device__ __forceinline__ void sconv4r(u32x2 q, unsigned zmr, unsigned zpr, float w0, float w1, float w2, float bb, float (&o)[4]) {
    const float zm = __uint_as_float(zmr << 16), zp = __uint_as_float(zpr << 16);
    const float z0 = __uint_as_float(q.x << 16), z1 = __uint_as_float(q.x & 0xffff0000u), z2 = __uint_as_float(q.y << 16), z3 = __uint_as_float(q.y & 0xffff0000u);
    o[0] = w0 * zm + w1 * z0 + w2 * z1 + bb; o[1] = w0 * z0 + w1 * z1 + w2 * z2 + bb; o[2] = w0 * z1 + w1 * z2 + w2 * z3 + bb; o[3] = w0 * z2 + w1 * z3 + w2 * zp + bb;
}
typedef _Float16 h4 __attribute__((ext_vector_type(4)));
__device__ __forceinline__ void tapquad(h4 a, h4 bq, unsigned b0bits, float wf, float wb, float rf1, float rf2, float rf3, float rb1, float rb2, float rb3, float (&fa)[4], float (&fb)[4]) {
    const float b0 = (float)__builtin_bit_cast(_Float16, (unsigned short)b0bits);
    fa[0] = (float)a.x * wf; fa[1] = (float)a.y * (wf * rf1); fa[2] = (float)a.z * (wf * rf2); fa[3] = (float)a.w * (wf * rf3);
    fb[0] = b0 * wb; fb[1] = (float)bq.w * (wb * rb1); fb[2] = (float)bq.z * (wb * rb2); fb[3] = (float)bq.y * (wb * rb3);
}
template <int LOG2L> struct SweepIdx {
    static constexpr int L = 1 << LOG2L, QS = L / 32;
    int t, seq, n00, a00; cpx wq0, w1, w2, w3;
    __device__ __forceinline__ SweepIdx(int t_, bool need_w) { t = t_; asm volatile("" : "+v"(t) :: "memory"); seq = (LOG2L == 14) ? 0 : (t >> 6); const int q0 = (LOG2L == 14) ? t : (t & 63); n00 = 4 * q0; a00 = seq * L + n00;
        if (need_w) { float sb, cb; sincospif(-(float)n00 / (float)L, &sb, &cb); wq0 = mkc(cb, sb);
            sincospif(-1.0f / (float)L, &sb, &cb); w1 = mkc(cb, sb); w2 = cmul(w1, w1); w3 = cmul(w2, w1); } }
};
#define WQS mkc(0.92387953251128674f, -0.38268343236508978f)
struct TapWin { float wf0, wfs, rf1, rf2, rf3, wb0, wbs, rb1, rb2, rb3; };
template <int LOG2L> __device__ __forceinline__ TapWin tap_windows(float df, float db, int n00) {
    constexpr int L = 1 << LOG2L, QS = L / 32; TapWin w;
    w.wf0 = expf(-df * (float)n00); w.wfs = expf(-df * (float)(4 * QS)); w.rf1 = expf(-df); w.rf2 = w.rf1 * w.rf1; w.rf3 = w.rf2 * w.rf1;
    w.wb0 = expf(-db * (float)(L - n00)); w.wbs = expf(db * (float)(4 * QS)); w.rb1 = expf(db); w.rb2 = w.rb1 * w.rb1; w.rb3 = w.rb2 * w.rb1; return w;
}
template <int LOG2L> __device__ __forceinline__ void sweep_taps2(LDSQ cpx* A, int t_, const _Float16* tf0, const _Float16* tb0, const _Float16* tf1, const _Float16* tb1, float df0, float db0, float df1, float db1, hcpx* hos, float& ss0, float& ss1) {
    constexpr int L = 1 << LOG2L, QS = L / 32; const SweepIdx<LOG2L> X(t_, true);
    const TapWin W0 = tap_windows<LOG2L>(df0, db0, X.n00), W1 = tap_windows<LOG2L>(df1, db1, X.n00);
    float s0 = 0.f, s1 = 0.f, wf0 = W0.wf0, wb0 = W0.wb0, wf1 = W1.wf0, wb1 = W1.wb0;
    cpx wn = X.wq0;
    h4 ra0[8], rb0[8], ra1[8], rb1[8]; unsigned rc0[8], rc1[8];
#pragma unroll
    for (int i = 0; i < 8; ++i) { const int n = 4 * (i * QS) + X.n00, nb = n > 0 ? L - n : L - 1;
        ra0[i] = *(const h4*)(tf0 + n); rb0[i] = *(const h4*)(tb0 + L - n - 4); rc0[i] = ((const unsigned short*)tb0)[nb];
        ra1[i] = *(const h4*)(tf1 + n); rb1[i] = *(const h4*)(tb1 + L - n - 4); rc1[i] = ((const unsigned short*)tb1)[nb]; }
#pragma unroll
    for (int i = 0; i < 8; ++i) { const int n = 4 * (i * QS) + X.n00; float fa0[4], fb0[4], fa1[4], fb1[4]; const unsigned hm = n > 0 ? 0xffffu : 0u;
        tapquad(ra0[i], rb0[i], rc0[i] & hm, wf0, wb0, W0.rf1, W0.rf2, W0.rf3, W0.rb1, W0.rb2, W0.rb3, fa0, fb0);
        tapquad(ra1[i], rb1[i], rc1[i] & hm, wf1, wb1, W1.rf1, W1.rf2, W1.rf3, W1.rb1, W1.rb2, W1.rb3, fa1, fb1);
        LDSQ cpx* ap = A + phys(X.a00 + 4 * i * QS); hcpx* hp = hos + X.a00 + 4 * i * QS;
#pragma unroll
        for (int e = 0; e < 4; ++e) { s0 += fa0[e] * fa0[e] + fb0[e] * fb0[e]; s1 += fa1[e] * fa1[e] + fb1[e] * fb1[e]; ap[e] = mkc(fa0[e] + fb0[e], fa1[e] + fb1[e]); }
        const cpx wa = cmul(wn, X.w1), wb2 = cmul(wn, X.w2), wc = cmul(wn, X.w3);
        const cpx y0 = cmul(mkc(fa0[0] - fb0[0], fa1[0] - fb1[0]), wn), y1 = cmul(mkc(fa0[1] - fb0[1], fa1[1] - fb1[1]), wa);
        const cpx y2 = cmul(mkc(fa0[2] - fb0[2], fa1[2] - fb1[2]), wb2), y3 = cmul(mkc(fa0[3] - fb0[3], fa1[3] - fb1[3]), wc);
        *(hcpx2*)hp = h2_of(y0, y1); *(hcpx2*)(hp + 2) = h2_of(y2, y3);
        wn = cmul(wn, WQS); wf0 *= W0.wfs; wb0 *= W0.wbs; wf1 *= W1.wfs; wb1 *= W1.wbs; }
    ss0 = s0; ss1 = s1;
}
template <int LOG2L, int PART> __device__ __forceinline__ void fft_mid_sep(LDSQ cpx* A, int t, hcpx* spec0, hcpx* spec1, const LDSQ float* red, const float* skp0, const float* skp1) {
    constexpr int R = LOG2L == 14 ? 16 : 8, G = 32 / R, NB = LOG2L == 14 ? 32 : 16, NG = NB * NB;
    asm volatile("" : "+v"(t) :: "memory");
#pragma unroll
    for (int gi = 0; gi < G; ++gi) {
        cpx v[R]; LDSQ cpx* Ab = A + phys((gi * 512 + t) * R);
#pragma unroll
        for (int j = 0; j < R; ++j) v[j] = Ab[j];
        dft_r2<R, false>(v);
#pragma unroll
        for (int k = 0; k < R; ++k) Ab[k] = v[brev<R>(k)];
    }
    __syncthreads();
#pragma unroll
    for (int gi = 0; gi < G; ++gi) {
        const int gam = gi * 512 + t, seq = gam / NG, g = gam % NG, k1 = g / NB, k2 = g % NB;
        const int gp = PART == 1 ? NG - 1 - g : (k1 ? (NB - k1) * NB + (NB - 1 - k2) : (k2 ? NB - k2 : 0));
        const bool wrap = PART == 0 && g == 0;
        const LDSQ cpx* Ab = A + phys(gam * R); const LDSQ cpx* Ap = A + phys((seq * NG + gp) * R);
        cpx z[R], q[R];
#pragma unroll
        for (int k = 0; k < R; ++k) { z[k] = Ab[k]; q[k] = Ap[k]; }
        float ss0, ss1;
        if (LOG2L == 14) { ss0 = red[0] + red[1] + red[2] + red[3] + red[4] + red[5] + red[6] + red[7]; ss1 = red[8] + red[9] + red[10] + red[11] + red[12] + red[13] + red[14] + red[15]; }
        else { ss0 = red[seq]; ss1 = red[8 + seq]; }
        const float n0 = 0.25f / sqrtf(ss0 + EPS), n1 = 0.25f / sqrtf(ss1 + EPS), h0 = 0.5f * skp0[seq], h1 = 0.5f * skp1[seq];
        hcpx* s0p = spec0 + (size_t)gam * R; hcpx* s1p = spec1 + (size_t)gam * R;
#pragma unroll
        for (int k2_ = 0; k2_ < R / 2; ++k2_) { cpx o0[2], o1[2];
#pragma unroll
            for (int e = 0; e < 2; ++e) { const int k = 2 * k2_ + e; cpx zp = q[R - 1 - k]; const cpx zw = q[(R - k) & (R - 1)];
                if (PART == 0) { zp.x = wrap ? zw.x : zp.x; zp.y = wrap ? zw.y : zp.y; }
                o0[e] = mkc((z[k].x + zp.x) * n0 + h0, (z[k].y - zp.y) * n0); o1[e] = mkc((z[k].y + zp.y) * n1 + h1, (zp.x - z[k].x) * n1); }
            *(hcpx2*)(s0p + 2 * k2_) = h2_of(o0[0], o0[1]); *(hcpx2*)(s1p + 2 * k2_) = h2_of(o1[0], o1[1]); }
    }
}
template <int LOG2L> __device__ __forceinline__ void sweep_load_v(LDSQ cpx* A, int t_, const bf16_t* zrow, size_t tb0, const float* cw, const float* cbias, int rc0, hcpx* xw) {
    constexpr int L = 1 << LOG2L, QS = L / 32; const SweepIdx<LOG2L> X(t_, true);
    const int rc = rc0 + X.seq; const float cw0 = cw[rc], cw1 = cw[6144 + rc], cw2 = cw[2 * 6144 + rc], bb = cbias[rc];
    const bf16_t* z0 = zrow + (size_t)rc * T + tb0; const bf16_t* z1 = z0 + L;
    cpx wn = X.wq0;
    u32x2 rq[8][2]; unsigned rm[8][2], rp[8][2];
#pragma unroll
    for (int i = 0; i < 8; ++i) { const int n = 4 * (i * QS) + X.n00, nm = n > 0 ? n - 1 : 0, np = n + 4 < L ? n + 4 : L - 1;
        rq[i][0] = *(const u32x2*)(z0 + n); rq[i][1] = *(const u32x2*)(z1 + n); rm[i][0] = z0[nm]; rm[i][1] = z1[nm]; rp[i][0] = z0[np]; rp[i][1] = z1[np]; }
#pragma unroll
    for (int i = 0; i < 8; ++i) { const int n = 4 * (i * QS) + X.n00; float xa[4], xb[4]; const unsigned hm = n > 0 ? 0xffffu : 0u, hp = n + 4 < L ? 0xffffu : 0u;
        sconv4r(rq[i][0], rm[i][0] & hm, rp[i][0] & hp, cw0, cw1, cw2, bb, xa); sconv4r(rq[i][1], rm[i][1] & hm, rp[i][1] & hp, cw0, cw1, cw2, bb, xb);
        LDSQ cpx* ap = A + phys(X.a00 + 4 * i * QS); hcpx* xp = xw + X.a00 + 4 * i * QS;
        ap[0] = mkc(xa[0], xb[0]); ap[1] = mkc(xa[1], xb[1]); ap[2] = mkc(xa[2], xb[2]); ap[3] = mkc(xa[3], xb[3]);
        const cpx y0 = cmul(mkc(xa[0], xb[0]), wn), y1 = cmul(mkc(xa[1], xb[1]), cmul(wn, X.w1)), y2 = cmul(mkc(xa[2], xb[2]), cmul(wn, X.w2)), y3 = cmul(mkc(xa[3], xb[3]), cmul(wn, X.w3));
        *(hcpx2*)xp = h2_of(y0, y1); *(hcpx2*)(xp + 2) = h2_of(y2, y3);
        wn = cmul(wn, WQS); }
}
constexpr int CPA = 2;
template <int N> struct CombPreN { u32x2 q[N][2]; unsigned zm[N][2], zp[N][2]; hcpx2 h01[N], h23[N]; };
typedef CombPreN<CPA> CombPre;
template <int LOG2L, int I0, int N> __device__ __forceinline__ void combine_prefetch(int t_, const hcpx* yes, const bf16_t* zrow, size_t tb0, int rg0, CombPreN<N>& P) {
    constexpr int L = 1 << LOG2L, QS = L / 32; const SweepIdx<LOG2L> X(t_, false);
    const int rg = rg0 + X.seq; const bf16_t* g0 = zrow + (size_t)rg * T + tb0; const bf16_t* g1 = g0 + L;
#pragma unroll
    for (int i = 0; i < N; ++i) { const int n = 4 * ((I0 + i) * QS) + X.n00; const hcpx* yp = yes + X.a00 + 4 * (I0 + i) * QS;
        P.q[i][0] = *(const u32x2*)(g0 + n); P.q[i][1] = *(const u32x2*)(g1 + n);
        const int nm = n > 0 ? n - 1 : 0, np = n + 4 < L ? n + 4 : L - 1;
        P.zm[i][0] = g0[nm]; P.zm[i][1] = g1[nm]; P.zp[i][0] = g0[np]; P.zp[i][1] = g1[np];
        P.h01[i] = __builtin_nontemporal_load((const hcpx2*)yp); P.h23[i] = __builtin_nontemporal_load((const hcpx2*)(yp + 2)); }
}
template <int LOG2L, int FINAL> __device__ __forceinline__ void sweep_combine(LDSQ cpx* A, int t_, const CombPre& P0, const hcpx* yes, hcpx* xw, bf16_t* zrow, size_t tb0, const float* cw, const float* cbias, int rg0, int ro0, int dry) {
    constexpr int L = 1 << LOG2L, QS = L / 32; const SweepIdx<LOG2L> X(t_, true);
    CombPreN<8 - CPA> P1; combine_prefetch<LOG2L, CPA>(X.t, yes, zrow, tb0, rg0, P1);
    const int rg = rg0 + X.seq; const float cw0 = cw[rg], cw1 = cw[6144 + rg], cw2 = cw[2 * 6144 + rg], bb = cbias[rg];
    bf16_t* o0 = zrow + (size_t)(ro0 + X.seq) * T + tb0; bf16_t* o1 = o0 + L;
    cpx wn = X.wq0;
#pragma unroll
    for (int i = 0; i < 8; ++i) { const int n = 4 * (i * QS) + X.n00; float ga[4], gb[4];
        const bool ah = i < CPA; const int ia = ah ? i : 0, ib = ah ? 0 : i - CPA;
        const unsigned hm = n > 0 ? 0xffffu : 0u, hp = n + 4 < L ? 0xffffu : 0u;
        sconv4r(ah ? P0.q[ia][0] : P1.q[ib][0], (ah ? P0.zm[ia][0] : P1.zm[ib][0]) & hm, (ah ? P0.zp[ia][0] : P1.zp[ib][0]) & hp, cw0, cw1, cw2, bb, ga);
        sconv4r(ah ? P0.q[ia][1] : P1.q[ib][1], (ah ? P0.zm[ia][1] : P1.zm[ib][1]) & hm, (ah ? P0.zp[ia][1] : P1.zp[ib][1]) & hp, cw0, cw1, cw2, bb, gb);
        const LDSQ cpx* ap = A + phys(X.a00 + 4 * i * QS);
        const hcpx2 h01 = ah ? P0.h01[ia] : P1.h01[ib], h23 = ah ? P0.h23[ia] : P1.h23[ib];
        const f32x4 e01 = {(float)h01.x, (float)h01.y, (float)h01.z, (float)h01.w}, e23 = {(float)h23.x, (float)h23.y, (float)h23.z, (float)h23.w};
        const cpx wa = cmul(wn, X.w1), wb2 = cmul(wn, X.w2), wc = cmul(wn, X.w3);
        const cpx r0 = cmulc(ap[0], wn), r1 = cmulc(ap[1], wa), r2 = cmulc(ap[2], wb2), r3 = cmulc(ap[3], wc);
        const cpx s0 = mkc(ga[0] * (e01[0] + r0.x), gb[0] * (e01[1] + r0.y)), s1 = mkc(ga[1] * (e01[2] + r1.x), gb[1] * (e01[3] + r1.y));
        const cpx s2 = mkc(ga[2] * (e23[0] + r2.x), gb[2] * (e23[1] + r2.y)), s3 = mkc(ga[3] * (e23[2] + r3.x), gb[3] * (e23[3] + r3.y));
        if (FINAL == 0) { LDSQ cpx* aw = A + phys(X.a00 + 4 * i * QS); hcpx* xp = xw + X.a00 + 4 * i * QS;
            aw[0] = s0; aw[1] = s1; aw[2] = s2; aw[3] = s3;
            const cpx y0 = cmul(s0, wn), y1 = cmul(s1, wa), y2 = cmul(s2, wb2), y3 = cmul(s3, wc);
            *(hcpx2*)xp = h2_of(y0, y1); *(hcpx2*)(xp + 2) = h2_of(y2, y3); }
        else if (!dry) { u32x2 wa2, wb3; wa2.x = cvt_pk_bf16(s0.x, s1.x); wa2.y = cvt_pk_bf16(s2.x, s3.x); wb3.x = cvt_pk_bf16(s0.y, s1.y); wb3.y = cvt_pk_bf16(s2.y, s3.y);
            *(u32x2*)(o0 + n) = wa2; *(u32x2*)(o1 + n) = wb3; }
        wn = cmul(wn, WQS); }
}
template <int LOG2L> __device__ __forceinline__ void hyena_item(const Params& p, LDSQ unsigned char* lds, int layer_j, int c0, int dry) {
    constexpr int L = 1 << LOG2L, NPAIR = (LOG2L == 14) ? 1 : 2;
    constexpr int TOK0 = (LOG2L == 14) ? 0 : T_P, PB = (LOG2L == 14) ? 0 : 16384;
    LDSQ cpx* A = (LDSQ cpx*)lds;
    LDSQ float* red = (LDSQ float*)(lds + 135168);
    const int t = pg8::otid(), ch = c0 + ((LOG2L == 14) ? 0 : (t >> 6));
    bf16_t* zin = (bf16_t*)(p.ws + WS_BIG + BIG_ZINT);
    const _Float16* taps = (const _Float16*)(p.ws + WS_BIG + BIG_TAPS);
    hcpx* scr = (hcpx*)(p.ws + WS_H + (size_t)pg8::obid() * FFT_SCR_PER_WG);
    hcpx* u1s = scr + (size_t)4 * 16384;
    hcpx* yes = (hcpx*)(p.ws + WS_END + (size_t)pg8::obid() * FFT_EXT_PER_WG);
    PreRegs pre;
    hcpx* xw = yes + 16384;
    {
        const _Float16* tf0 = taps + (size_t)(0 * 2048 + ch) * NPOS + PB; const _Float16* tb0 = taps + (size_t)(1 * 2048 + ch) * NPOS + PB;
        const _Float16* tf1 = taps + (size_t)(2 * 2048 + ch) * NPOS + PB; const _Float16* tb1 = taps + (size_t)(3 * 2048 + ch) * NPOS + PB;
        const float* dec = p.hy_decay + (size_t)layer_j * 8192 + ch;
        const float df0 = fabsf(dec[0]) * (1.0f / (float)(L - 1)), db0 = fabsf(dec[2048]) * (1.0f / (float)(L - 1));
        const float df1 = fabsf(dec[4096]) * (1.0f / (float)(L - 1)), db1 = fabsf(dec[6144]) * (1.0f / (float)(L - 1));
        float ss0, ss1;
        sweep_taps2<LOG2L>(A, t, tf0, tb0, tf1, tb1, df0, db0, df1, db1, xw, ss0, ss1);
        ss0 = wave_sum(ss0); ss1 = wave_sum(ss1);
        if ((t & 63) == 0) { red[t >> 6] = ss0; red[8 + (t >> 6)] = ss1; }
        __syncthreads();
        const float* skp0 = p.hy_skip + (size_t)layer_j * 2 * 2048 + c0; const float* skp1 = skp0 + 2048;
        fft_outer<LOG2L, false, 0>(A, t, nullptr, nullptr, pre);
        fft_prefetch<LOG2L == 14 ? 32 : 16, LOG2L == 14 ? 512 : 128>(t, xw, pre);
        fft_mid_sep<LOG2L, 0>(A, t, scr + (size_t)0 * 16384, scr + (size_t)2 * 16384, red, skp0, skp1); __syncthreads();
        fft_outer<LOG2L, false, 3>(A, t, nullptr, nullptr, pre);
        fft_mid_sep<LOG2L, 1>(A, t, scr + (size_t)1 * 16384, scr + (size_t)3 * 16384, red, skp0, skp1); __syncthreads();
    }
    const float* cw = p.hy_conv_w + (size_t)layer_j * 3 * 6144; const float* cbias = p.hy_conv_b + (size_t)layer_j * 6144;
#pragma unroll 1
    for (int pr = 0; pr < NPAIR; ++pr) {
        const size_t tb0 = (size_t)TOK0 + (size_t)(2 * pr) * L;
        sweep_load_v<LOG2L>(A, t, zin, tb0, cw, cbias, 2 * 2048 + c0, xw); __syncthreads();
        fft_conv<LOG2L, 0, 2>(A, t, scr + (size_t)0 * 16384, yes, xw, pre);
        CombPre cp;
        fft_conv<LOG2L, 3, 0>(A, t, scr + (size_t)1 * 16384, nullptr, nullptr, pre, [&]() { combine_prefetch<LOG2L, 0>(t, yes, zin, tb0, c0, cp); });
        sweep_combine<LOG2L, 0>(A, t, cp, yes, xw, zin, tb0, cw, cbias, c0, c0, dry); __syncthreads();
        fft_conv<LOG2L, 0, 2>(A, t, scr + (size_t)2 * 16384, yes, xw, pre);
        fft_conv<LOG2L, 3, 0>(A, t, scr + (size_t)3 * 16384, nullptr, nullptr, pre, [&]() { combine_prefetch<LOG2L, 0>(t, yes, zin, tb0, 2048 + c0, cp); });
        sweep_combine<LOG2L, 1>(A, t, cp, yes, xw, zin, tb0, cw, cbias, 2048 + c0, c0, dry); __syncthreads();
    }
}
__device__ __forceinline__ void hyena_conv_phase(const Params& p, LDSQ unsigned char* lds, int layer_j, int dry) {
    { LDSQ cpx* TW = (LDSQ cpx*)(lds + TW_OFF);
      for (int e = pg8::otid(); e < 1024; e += NTHR) { float sn, cs; sincospif(-2.0f * (float)e / 16384.0f, &sn, &cs); TW[e] = mkc(cs, sn); }
      __syncthreads(); }
    for (int it = pg8::obid(); it < 2048; it += pg8::ogrid()) hyena_item<14>(p, lds, layer_j, it, dry);
    for (int it = pg8::obid(); it < 256; it += pg8::ogrid()) hyena_item<11>(p, lds, layer_j, it * 8, dry);
}

__device__ __forceinline__ void attn_phase(const Params& p, LDSQ unsigned char* lds, int dry = 0) {
    constexpr int KROW = 272, VROW = 264;
    LDSQ unsigned char* Kl = lds; LDSQ bf16_t* VT = (LDSQ bf16_t*)(lds + 256 * KROW);
    const bf16_t* qkv = (const bf16_t*)(p.ws + WS_BIG + BIG_QKV);
    bf16_t* og = (bf16_t*)(p.ws + WS_BIG + BIG_OG); float* lse = (float*)(p.ws + WS_BIG + BIG_LSE);
    const int tid = pg8::otid(), lane = tid & 63, wid = __builtin_amdgcn_readfirstlane(tid >> 6), l15 = lane & 15, g4 = lane >> 4;
    const int blk = wid >> 2, qq = 16 * (wid & 3) + l15;
    for (int u = pg8::obid(); u < 1792 + 512; u += pg8::ogrid()) {
        const int it = u < 1792 ? 4 * u : 7168 + (u - 1792), len = u < 1792 ? 4 : 1;
        int g, b, hh, rho, pp0, L, tokbase;
        if (it < 6144) { g = it >> 11; const int rem = it & 2047; const int npp = 128 >> (2 * g); pp0 = rem % npp; rho = (rem / npp) & ((1 << (2 * g)) - 1); hh = (rem >> 7) & 7; b = rem >> 10; L = L_P; tokbase = 0; }
        else { const int i2 = it - 6144; g = i2 >> 9; const int rem = i2 & 511; const int npp = 16 >> (2 * g); pp0 = rem % npp; rho = (rem / npp) & ((1 << (2 * g)) - 1); hh = (rem >> 4) & 7; b = rem >> 7; L = L_S; tokbase = T_P; }
        const int rsh = 2 * g, n = L >> rsh;
        const size_t tok0 = (size_t)tokbase + (size_t)b * L + rho;
        const int qcol = g * 3072 + hh * 128, kcol = qcol + 1024, vcol = qcol + 2048;
        u32x4 kr[2][4], vr[2][4];
        auto request_half = [&](int ih, u32x4 (&kh)[4], u32x4 (&vh)[4]) {
#pragma unroll
            for (int s4 = 0; s4 < 4; ++s4) { const int ci = tid + 512 * s4;
                { const int slot = ci >> 4, chn = ci & 15, i = ih + slot, ic = i < 0 ? 0 : (i < n ? i : n - 1); kh[s4] = *(const u32x4*)(qkv + (tok0 + ((size_t)ic << rsh)) * QKVW + kcol + chn * 8); }
                { const int slot = ci & 127, chn = ci >> 7, i = ih + slot, ic = i < 0 ? 0 : (i < n ? i : n - 1); vh[s4] = *(const u32x4*)(qkv + (tok0 + ((size_t)ic << rsh)) * QKVW + vcol + chn * 8); } } };
        auto stage_half = [&](int ih, int ring0, const u32x4 (&kh)[4], const u32x4 (&vh)[4]) {
#pragma unroll
            for (int s4 = 0; s4 < 4; ++s4) { const int ci = tid + 512 * s4;
                { const int slot = ci >> 4, chn = ci & 15, i = ih + slot; const unsigned ok = (i >= 0 && i < n) ? 0xffffffffu : 0u;
                  u32x4 v = kh[s4]; v.x &= ok; v.y &= ok; v.z &= ok; v.w &= ok;
                  *(LDSQ u32x4*)(Kl + (ring0 + slot) * KROW + chn * 16) = v; }
                { const int slot = ci & 127, chn = ci >> 7, i = ih + slot; const unsigned ok = (i >= 0 && i < n) ? 0xffffffffu : 0u;
                  u32x4 v = vh[s4]; v.x &= ok; v.y &= ok; v.z &= ok; v.w &= ok;
                  LDSQ bf16_t* vp = VT + (chn * 8) * VROW + ring0 + slot;
                  vp[0] = (bf16_t)(v.x & 0xffffu); vp[VROW] = (bf16_t)(v.x >> 16); vp[2 * VROW] = (bf16_t)(v.y & 0xffffu); vp[3 * VROW] = (bf16_t)(v.y >> 16);
                  vp[4 * VROW] = (bf16_t)(v.z & 0xffffu); vp[5 * VROW] = (bf16_t)(v.z >> 16); vp[6 * VROW] = (bf16_t)(v.w & 0xffffu); vp[7 * VROW] = (bf16_t)(v.w >> 16); } } };
        request_half(128 * pp0 - 64, kr[0], vr[0]); request_half(128 * pp0 + 64, kr[1], vr[1]);
#pragma unroll 1
        for (int s = 0; s < len; ++s) {
            const int pp = pp0 + s, i0 = 128 * pp - 64, off = (128 * pp) & 255;
            const int qi = 128 * pp + 64 * blk + qq;
            const size_t tq = tok0 + ((size_t)qi << rsh);
            bf16x8 bq[4];
#pragma unroll
            for (int ks = 0; ks < 4; ++ks) bq[ks] = *(const bf16x8*)(qkv + tq * QKVW + qcol + 32 * ks + 8 * g4);
            if (s == 0) stage_half(i0, off, kr[0], vr[0]);
            stage_half(i0 + 128, (128 + off) & 255, kr[1], vr[1]);
            __syncthreads();
            if (s + 1 < len) request_half(i0 + 256, kr[1], vr[1]);
            f32x4 sc[12];
#pragma unroll
            for (int kt = 0; kt < 12; ++kt) { f32x4 a = {0.f, 0.f, 0.f, 0.f};
                const int rb = (64 * blk + 16 * kt + off) & 255;
#pragma unroll
                for (int ks = 0; ks < 4; ++ks) { const bf16x8 ka = *(const LDSQ bf16x8*)(Kl + (rb + l15) * KROW + (32 * ks + 8 * g4) * 2);
                    a = __builtin_amdgcn_mfma_f32_16x16x32_bf16(ka, bq[ks], a, 0, 0, 0); }
                sc[kt] = a; }
            const int ibase = 128 * pp + 64 * blk - 64;
            const int klo = qq > -ibase ? qq : -ibase, khi = (qq + 128 < n - 1 - ibase) ? qq + 128 : n - 1 - ibase;
            const unsigned kspan = (unsigned)(khi - klo); const int kk0 = 4 * g4 - klo;
            float mx = -3.0e38f;
#pragma unroll
            for (int kt = 0; kt < 12; ++kt)
#pragma unroll
                for (int r = 0; r < 4; ++r) { const bool ok = (unsigned)(kk0 + 16 * kt + r) <= kspan;
                    sc[kt][r] = ok ? sc[kt][r] : -3.0e38f; mx = fmaxf(mx, sc[kt][r]); }
            mx = fmaxf(mx, __shfl_xor(mx, 16)); mx = fmaxf(mx, __shfl_xor(mx, 32));
            float ls = 0.f;
#pragma unroll
            for (int kt = 0; kt < 12; ++kt)
#pragma unroll
                for (int r = 0; r < 4; ++r) { const float e = __builtin_amdgcn_exp2f(sc[kt][r] - mx); sc[kt][r] = e; ls += e; }
            ls += __shfl_xor(ls, 16); ls += __shfl_xor(ls, 32);
            f32x4 oa[8];
#pragma unroll
            for (int dt = 0; dt < 8; ++dt) oa[dt] = (f32x4){0.f, 0.f, 0.f, 0.f};
#pragma unroll
            for (int k2 = 0; k2 < 6; ++k2) {
                union { u32x4 u; bf16x8 h; } pb;
                pb.u.x = cvt_pk_bf16(sc[2 * k2][0], sc[2 * k2][1]); pb.u.y = cvt_pk_bf16(sc[2 * k2][2], sc[2 * k2][3]);
                pb.u.z = cvt_pk_bf16(sc[2 * k2 + 1][0], sc[2 * k2 + 1][1]); pb.u.w = cvt_pk_bf16(sc[2 * k2 + 1][2], sc[2 * k2 + 1][3]);
                const int cb = (64 * blk + 32 * k2 + off) & 255;
#pragma unroll
                for (int dt = 0; dt < 8; ++dt) {
                    const LDSQ bf16_t* vq = VT + (16 * dt + l15) * VROW + cb + 4 * g4;
                    union { u32x4 u; bf16x8 h; } va; const u32x2 lo = *(const LDSQ u32x2*)vq, hi = *(const LDSQ u32x2*)(vq + 16);
                    va.u.x = lo.x; va.u.y = lo.y; va.u.z = hi.x; va.u.w = hi.y;
                    oa[dt] = __builtin_amdgcn_mfma_f32_16x16x32_bf16(va.h, pb.h, oa[dt], 0, 0, 0); }
            }
            const float inv = 1.0f / ls;
            const size_t gt = (size_t)g * T + tq;
#pragma unroll
            for (int dt = 0; dt < 8; ++dt) { u32x2 w; w.x = cvt_pk_bf16(oa[dt][0] * inv, oa[dt][1] * inv); w.y = cvt_pk_bf16(oa[dt][2] * inv, oa[dt][3] * inv);
                if (!dry) *(u32x2*)(og + gt * 1024 + hh * 128 + 16 * dt + 4 * g4) = w; }
            if (g4 == 0 && !dry) lse[gt * 8 + hh] = mx + log2f(ls);
            __syncthreads();
        }
    }
}
__device__ __forceinline__ void attn_merge_phase(const Params& p) {
    const bf16_t* og = (const bf16_t*)(p.ws + WS_BIG + BIG_OG); const float* lse = (const float*)(p.ws + WS_BIG + BIG_LSE); bf16_t* H = (bf16_t*)(p.ws + WS_H);
    const int stride = pg8::ogrid() * NTHR;
    for (int i0 = pg8::obid() * NTHR + pg8::otid(); i0 < T * 128; i0 += 4 * stride) {
        u32x4 v0[4], v1[4], v2[4]; float l0[4], l1[4], l2[4];
#pragma unroll
        for (int u = 0; u < 4; ++u) { const int i = i0 + u * stride; if (i < T * 128) { const int tok = i >> 7, c8 = i & 127, hh = c8 >> 4;
            l0[u] = lse[(size_t)tok * 8 + hh]; l1[u] = lse[((size_t)T + tok) * 8 + hh]; l2[u] = lse[((size_t)2 * T + tok) * 8 + hh];
            v0[u] = *(const u32x4*)(og + (size_t)tok * 1024 + c8 * 8); v1[u] = *(const u32x4*)(og + ((size_t)T + tok) * 1024 + c8 * 8); v2[u] = *(const u32x4*)(og + ((size_t)2 * T + tok) * 1024 + c8 * 8); } }
#pragma unroll
        for (int u = 0; u < 4; ++u) { const int i = i0 + u * stride; if (i < T * 128) { const int tok = i >> 7, c8 = i & 127;
            const float m = fmaxf(l0[u], fmaxf(l1[u], l2[u])); float a0 = exp2f(l0[u] - m), a1 = exp2f(l1[u] - m), a2 = exp2f(l2[u] - m); const float is = 1.0f / (a0 + a1 + a2); a0 *= is; a1 *= is; a2 *= is;
            u32x4 w;
#pragma unroll
            for (int e = 0; e < 4; ++e) { const float lo = a0 * __uint_as_float(v0[u][e] << 16) + a1 * __uint_as_float(v1[u][e] << 16) + a2 * __uint_as_float(v2[u][e] << 16);
                const float hi = a0 * __uint_as_float(v0[u][e] & 0xffff0000u) + a1 * __uint_as_float(v1[u][e] & 0xffff0000u) + a2 * __uint_as_float(v2[u][e] & 0xffff0000u);
                w[e] = cvt_pk_bf16(lo, hi); }
            *(u32x4*)(H + (size_t)tok * 1024 + c8 * 8) = w; } }
    }
}

constexpr int NPHASE = 35;
typedef const __attribute__((address_space(4))) unsigned char* KARG;
template <class Tp> __device__ __forceinline__ Tp karg(int byte_off) { return *(volatile const __attribute__((address_space(4))) Tp*)((KARG)__builtin_amdgcn_kernarg_segment_ptr() + byte_off); }
#define PA(q, member) q.member = karg<decltype(Params::member)>((int)__builtin_offsetof(Params, member))
__global__ void __launch_bounds__(512, 2) mega(Params parg) {
    extern __shared__ __attribute__((aligned(16))) unsigned char shm[];
    LDSQ unsigned char* lds = (LDSQ unsigned char*)shm;
    const int tid = pg8::otid();
    volatile LDSQ unsigned* misc = (volatile LDSQ unsigned*)(lds + LDS_MISC);
    if (tid < 8) misc[tid] = 0u;
    __syncthreads();
    const int ph_lo = parg.ph_lo, ph_hi = parg.ph_hi, probe = parg.probe;
#define REPS(bit, lay) (1 + (1 + ((probe >> 15) & 1)) * (((probe >> (bit)) & 1) & ((((probe >> 10) & 3) == 0) | ((probe >> (10 + ((lay) & 1))) & 1))))
    XcdBarrier bar; bar.bar = nullptr; bar.x = 0; bar.st = misc;
    if (ph_hi - ph_lo > 1) { Params q{}; PA(q, ws); bar = xcd_barrier_post((unsigned*)(q.ws + WS_CTL), misc); }
#define IN(k) (ph_lo <= (k) && (k) < ph_hi)
#define REPBAR() do { if (((probe >> 16) & 1) && rep + 1 < nrep) { Params qb{}; PA(qb, ws); bar.bar = (unsigned*)(qb.ws + WS_CTL); xcd_barrier(bar); } } while (0)
#define SEAM(k) do { if (IN(k) && IN((k) + 1)) { Params qb{}; PA(qb, ws); bar.bar = (unsigned*)(qb.ws + WS_CTL); xcd_barrier(bar); if ((probe >> 12) & 1) { xcd_barrier(bar); xcd_barrier(bar); } } } while (0)

    for (int rep = 0, nrep = REPS(0, 0); rep < nrep; ++rep)
    if (IN(0)) { Params q{}; PA(q, ws); PA(q, c_prompt); PA(q, c_sample); PA(q, ada_w); PA(q, final_ada_w); ada_partials(q, lds); rope_table(q);
                 PA(q, hy_fw1); PA(q, hy_fb1); PA(q, hy_ffreq); PA(q, hy_fw2); PA(q, hy_fb2); PA(q, hy_fw3); filter_mlp(q); }
    SEAM(0);
    for (int rep = 0, nrep = REPS(0, 0); rep < nrep; ++rep)
    if (IN(1)) { Params q{}; PA(q, ws); PA(q, ada_b); PA(q, final_ada_b); ada_reduce(q); }
    SEAM(1);
#pragma unroll 1
    for (int layer = 0; layer < 4; ++layer) {
        const int pb = 2 + 8 * layer, j = layer >> 1; const bool hy = (layer & 1) == 0;
        for (int rep = 0, nrep = REPS(1, layer); rep < nrep; ++rep)
        if (IN(pb + 0)) {
            Params q{}; PA(q, ws); unsigned char* wl = q.ws + WS_WL;
            PA(q, ffn_w_gate); convert_T(lds, q.ffn_w_gate + (size_t)layer * 2048 * DFF, 2048, DFF, (bf16_t*)(wl + WL_FFN1), 0);
            PA(q, ffn_w_up);   convert_T(lds, q.ffn_w_up + (size_t)layer * 2048 * DFF, 2048, DFF, (bf16_t*)(wl + WL_FFN1), 1);
            PA(q, ffn_w_down); convert_T(lds, q.ffn_w_down + (size_t)layer * DFF * 2048, DFF, 2048, (bf16_t*)(wl + WL_FFN2), -1);
            if (hy) { PA(q, hy_w_in);  convert_T(lds, q.hy_w_in + (size_t)j * 2048 * 6144, 2048, 6144, (bf16_t*)(wl + WL_MIXIN), -1);
                      PA(q, hy_w_out); convert_T(lds, q.hy_w_out + (size_t)j * 2048 * 2048, 2048, 2048, (bf16_t*)(wl + WL_MIXOUT), -1); }
            else    { PA(q, at_w_in);  convert_T(lds, q.at_w_in + (size_t)j * 2048 * QKVW, 2048, QKVW, (bf16_t*)(wl + WL_MIXIN), -1);
                      PA(q, at_w_out); convert_T(lds, q.at_w_out + (size_t)j * 1024 * 2048, 1024, 2048, (bf16_t*)(wl + WL_MIXOUT), -1); }
            PA(q, norm_mix);
            const float* modl = (const float*)(q.ws + WS_MOD) + layer * 12288;
            if (layer == 0) { PA(q, x_prompt); PA(q, x_sample); norm_rows<false, true>(q.x_prompt, q.x_sample, (bf16_t*)(q.ws + WS_XB), q.norm_mix + layer * 2048, modl, 0, 2048, (bf16_t*)(q.ws + WS_H), nullptr); }
            else            norm_rows<false, false>(nullptr, nullptr, (bf16_t*)(q.ws + WS_XB), q.norm_mix + layer * 2048, modl, 0, 2048, (bf16_t*)(q.ws + WS_H), nullptr);
            if (hy) { __syncthreads();
                pg8::Gemm g{(const bf16_t*)(q.ws + WS_W3X) + (size_t)j * 8192 * 256, (const bf16_t*)(q.ws + WS_A2X) + (size_t)j * NPOS * 256, 8192, NPOS, 256};
                pg8::StaticOrder S; S.init(8192, NPOS, pg8::ogrid(), pg8::obid());
                EpiTaps E{(_Float16*)(q.ws + WS_BIG + BIG_TAPS)};
                pg8::gemm_phase<EpiTaps, pg8::StaticOrder, false>(lds, g, S, E, nullptr); }
        }
        SEAM(pb + 0);
        for (int rep = 0, nrep = REPS(2, layer); rep < nrep; ++rep)
        if (IN(pb + 1)) {
            Params q{}; PA(q, ws);
            if (hy) { PA(q, hy_b_in); pg8::Gemm g{(const bf16_t*)(q.ws + WS_WL + WL_MIXIN), (const bf16_t*)(q.ws + WS_H), 6144, T, 2048}; pg8::StaticOrder S; S.init(6144, T, pg8::ogrid(), pg8::obid());
                EpiZinT E{(bf16_t*)(q.ws + WS_BIG + BIG_ZINT), T, q.hy_b_in + (size_t)j * 6144};
                pg8::gemm_phase<EpiZinT, pg8::StaticOrder, false>(lds, g, S, E, nullptr); }
            else { pg8::Gemm g{(const bf16_t*)(q.ws + WS_H), (const bf16_t*)(q.ws + WS_WL + WL_MIXIN), T, QKVW, 2048}; pg8::StaticOrder S; S.init(T, QKVW, pg8::ogrid(), pg8::obid());
                EpiQKV E{(bf16_t*)(q.ws + WS_BIG + BIG_QKV), (const cpx*)(q.ws + WS_ROPE)};
                pg8::gemm_phase<EpiQKV, pg8::StaticOrder, false>(lds, g, S, E, nullptr); }
            REPBAR();
        }
        SEAM(pb + 1);
        for (int rep = 0, nrep = REPS(3, layer); rep < nrep; ++rep)
        if (IN(pb + 2)) { Params q{}; PA(q, ws); if (hy) { PA(q, hy_skip); PA(q, hy_conv_w); PA(q, hy_conv_b); PA(q, hy_decay); hyena_conv_phase(q, lds, j, rep + 1 < nrep); } else attn_phase(q, lds, (rep + 1 < nrep) ? (1 | ((probe >> 12) & 2)) : 0); }
        SEAM(pb + 2);
        for (int rep = 0, nrep = REPS(4, layer); rep < nrep; ++rep)
        if (IN(pb + 3)) { Params q{}; PA(q, ws); if (hy) transpose_phase(q, lds); else attn_merge_phase(q); }
        SEAM(pb + 3);
        for (int rep = 0, nrep = REPS(5, layer); rep < nrep; ++rep)
        if (IN(pb + 4)) {
            Params q{}; PA(q, ws); PA(q, hy_b_out);
            pg8::Gemm g{(const bf16_t*)(q.ws + WS_H), (const bf16_t*)(q.ws + WS_WL + WL_MIXOUT), T, 2048, hy ? 2048 : 1024}; pg8::StaticOrder S; S.init(T, 2048, pg8::ogrid(), pg8::obid());
            EpiRes E{(bf16_t*)(q.ws + WS_XB), hy ? q.hy_b_out + (size_t)j * 2048 : nullptr, (const float*)(q.ws + WS_MOD) + layer * 12288 + 4096, rep + 1 < nrep};
            pg8::gemm_phase<EpiRes, pg8::StaticOrder, false>(lds, g, S, E, nullptr);
            REPBAR();
        }
        SEAM(pb + 4);
        for (int rep = 0, nrep = REPS(6, layer); rep < nrep; ++rep)
        if (IN(pb + 5)) { Params q{}; PA(q, ws); PA(q, norm_ffn);
            norm_rows<false, false>(nullptr, nullptr, (bf16_t*)(q.ws + WS_XB), q.norm_ffn + layer * 2048, (const float*)(q.ws + WS_MOD) + layer * 12288, 6144, 8192, (bf16_t*)(q.ws + WS_H), nullptr); }
        SEAM(pb + 5);
        for (int rep = 0, nrep = REPS(7, layer); rep < nrep; ++rep)
        if (IN(pb + 6)) {
            Params q{}; PA(q, ws);
            pg8::Gemm g{(const bf16_t*)(q.ws + WS_H), (const bf16_t*)(q.ws + WS_WL + WL_FFN1), T, 2 * DFF, 2048}; pg8::StaticOrder S; S.init(T, 2 * DFF, pg8::ogrid(), pg8::obid());
            EpiFFN1 E{(bf16_t*)(q.ws + WS_BIG + BIG_MID)};
            pg8::gemm_phase<EpiFFN1, pg8::StaticOrder, false>(lds, g, S, E, nullptr);
            REPBAR();
        }
        SEAM(pb + 6);
        for (int rep = 0, nrep = REPS(8, layer); rep < nrep; ++rep)
        if (IN(pb + 7)) {
            Params q{}; PA(q, ws);
            pg8::Gemm g{(const bf16_t*)(q.ws + WS_BIG + BIG_MID), (const bf16_t*)(q.ws + WS_WL + WL_FFN2), T, 2048, DFF}; pg8::StaticOrder S; S.init(T, 2048, pg8::ogrid(), pg8::obid());
            EpiRes E{(bf16_t*)(q.ws + WS_XB), nullptr, (const float*)(q.ws + WS_MOD) + layer * 12288 + 10240, rep + 1 < nrep};
            pg8::gemm_phase<EpiRes, pg8::StaticOrder, false>(lds, g, S, E, nullptr);
            REPBAR();
        }
        SEAM(pb + 7);
    }
    if (IN(34)) { Params q{}; PA(q, ws); PA(q, out); PA(q, final_norm); final_norm_phase(q); }
#undef REPS
#undef IN
#undef SEAM
}
}

extern "C" void kernel_launch(void* const* d_in, const int* in_sizes, int n_in, void* d_out, int out_size, void* d_ws, size_t ws_size, hipStream_t stream) {
    static int grid = 0;
    if (grid == 0) {
        if (n_in != 30 || out_size != mk::T * mk::D || ws_size < mk::WS_TOTAL) { fprintf(stderr, "kernel_launch: unexpected shapes (n_in %d out %d ws %zu need %zu); nothing launched\n", n_in, out_size, ws_size, (size_t)mk::WS_TOTAL); grid = -1; return; }
        int dev = 0, cus = 0;
        if (hipGetDevice(&dev) != hipSuccess || hipDeviceGetAttribute(&cus, hipDeviceAttributeMultiprocessorCount, dev) != hipSuccess) { grid = -1; return; }
        if (hipFuncSetAttribute((const void*)mk::mega, hipFuncAttributeMaxDynamicSharedMemorySize, mk::LDS_BYTES) != hipSuccess) { fprintf(stderr, "kernel_launch: hipFuncSetAttribute failed\n"); grid = -1; return; }
        int per_cu = 0; (void)hipOccupancyMaxActiveBlocksPerMultiprocessor(&per_cu, (const void*)mk::mega, 512, mk::LDS_BYTES); (void)hipGetLastError();
        if (per_cu < 1) fprintf(stderr, "kernel_launch: occupancy query reports %d blocks per CU\n", per_cu);
        grid = cus > 256 ? 256 : cus;
    }
    if (grid < 0) return;
    mk::Params p{};
    const float** f = (const float**)&p;
    for (int i = 0; i < 30; ++i) f[i] = (const float*)d_in[i];
    p.out = (float*)d_out; p.ws = (unsigned char*)d_ws; p.probe = MK_PROBE;
#if MK_PER_PHASE
    for (int k = 0; k < mk::NPHASE; ++k) { p.ph_lo = k; p.ph_hi = k + 1; hipLaunchKernelGGL(mk::mega, dim3(grid), dim3(512), mk::LDS_BYTES, stream, p); }
#else
    (void)hipMemsetAsync((char*)d_ws + mk::WS_CTL, 0, mk::CTL_BYTES, stream);
    p.ph_lo = 0; p.ph_hi = mk::NPHASE;
    hipLaunchKernelGGL(mk::mega, dim3(grid), dim3(512), mk::LDS_BYTES, stream, p);
#endif
}
```

```cpp
#include <hip/hip_runtime.h>
#include <cstdio>
#include <cstdint>
#include <utility>
#ifndef MK_PER_PHASE
#define MK_PER_PHASE 0
#endif
#ifndef MK_PROBE
#define MK_PROBE 0
#endif
namespace pg8 {
#define PG8_LAS __attribute__((address_space(3)))
__device__ __forceinline__ int otid() { int t = threadIdx.x; asm volatile("" : "+v"(t) :: "memory"); return t; }
__device__ __forceinline__ int obid() { int b = blockIdx.x; asm volatile("" : "+s"(b)); return b; }
__device__ __forceinline__ int ogrid() { int g = gridDim.x; asm volatile("" : "+s"(g)); return g; }
typedef unsigned short bf16_t;
typedef short bf16x8 __attribute__((ext_vector_type(8)));
typedef float f32x4 __attribute__((ext_vector_type(4)));
typedef unsigned u32x4 __attribute__((ext_vector_type(4)));
constexpr int BM = 256, BK = 64, HALF = 128, HTB = HALF * BK * 2  , STAGE_BYTES = 8 * HTB, NXCD = 8, WGM = 4;

__host__ __device__ __forceinline__ int lds_byte(int r, int c) { const int st = (r >> 4) * 2 + (c >> 5), rr = r & 15, cc = c & 31, ob = rr * 64 + cc * 2; return st * 1024 + (ob ^ (((ob >> 9) & 1) << 5)); }
__host__ __device__ __forceinline__ void stage_rc(int b, int& R, int& C) { const int st = b / 1024, sb = b % 1024, swz = sb ^ (((sb >> 9) & 1) << 5); R = (st >> 1) * 16 + swz / 64; C = (st & 1) * 32 + (swz % 64) / 2; }
__host__ __device__ __forceinline__ int perm32(int rho) { const int n = rho >> 4, i = rho & 15; return 8 * (i >> 2) + 4 * n + (i & 3); }

struct Unit { int pm, pn; };
struct Gemm { const bf16_t* A; const bf16_t* Bt; int M, N, K; };

struct StaticOrder {
    int nM, nN, nwg, G, c, wgm;
    __host__ __device__ void init(int M, int N, int G_, int c_, int wgm_ = WGM) { nM = M / BM; nN = N / BM; nwg = nM * nN; G = G_; c = c_; wgm = wgm_; }
    __host__ __device__ bool next(int i, Unit& u) const {
        const long L = (long)i * G + c; if (L >= nwg) return false;
        int wgid = (int)L; { const int q = nwg / NXCD, r = nwg % NXCD, xcd = wgid % NXCD, off = wgid / NXCD; wgid = (xcd < r ? xcd * (q + 1) : r * (q + 1) + (xcd - r) * q) + off; }
        const int nig = wgm * nN, gid = wgid / nig, fm = gid * wgm, gsz = (nM - fm) < wgm ? (nM - fm) : wgm;
        u.pm = fm + ((wgid % nig) % gsz); u.pn = (wgid % nig) / gsz; return true;
    }
    __device__ __forceinline__ void a_ready(const Unit&) const {}
    __device__ __forceinline__ void done(const Unit&) const {}
};
__device__ __forceinline__ unsigned cvt_pk_bf16(float lo, float hi) { unsigned r; asm volatile("v_cvt_pk_bf16_f32 %0, %1, %2" : "=v"(r) : "v"(lo), "v"(hi)); return r; }
template <class Epi, class Sched, bool STAMP = false>
__device__ __forceinline__ void gemm_phase(PG8_LAS unsigned char* lds, const Gemm g, const Sched& S, const Epi& E, unsigned long long* stamps) {
    const int tid = otid(), wid = __builtin_amdgcn_readfirstlane(tid >> 6), lane = tid & 63, wr = wid >> 2, wc = wid & 3, fr = lane & 15, fq = lane >> 4;
    const int K = g.K, nt = K / BK;
    int ts_lo = 0, ts_hi = 0, nts = 0; const unsigned long long rt_entry = STAMP ? (unsigned long long)wall_clock64() : 0ull;
#define PG8_STAMP() do { if (STAMP && wid == 0 && nts < 64) { const unsigned long long _c = (unsigned long long)clock64(); \
        ts_lo = (lane == nts) ? (int)(unsigned)_c : ts_lo; ts_hi = (lane == nts) ? (int)(unsigned)(_c >> 32) : ts_hi; ++nts; } } while (0)
    PG8_STAMP();
    unsigned voffA[2], voffB[2];
#pragma unroll
    for (int i = 0; i < 2; ++i) { int R, C; stage_rc(tid * 16 + i * 8192, R, C); const int Rb = Epi::PERM ? ((R & ~31) + perm32(R & 31)) : R;
        voffA[i] = (unsigned)(R * K + C) * 2u; voffB[i] = (unsigned)(Rb * K + C) * 2u; }
    const size_t kstep = (size_t)(BK * 2);
    const size_t hstep = (size_t)HALF * K * 2;
    const size_t tstep = 2 * hstep;
    const unsigned ldsw = (unsigned)wid * 1024u;
    const int aoff = lds_byte(wr * 64 + fr, fq * 8), boff = lds_byte(wc * 32 + fr, fq * 8);
#define PG8_SA(b, h) (((b) * 2 + (h)) * HTB)
#define PG8_SB(b, h) ((4 + (b) * 2 + (h)) * HTB)
#define PG8_STAGE(bufoff, gbase, voff) do { _Pragma("unroll") for (int _i = 0; _i < 2; ++_i) \
        __builtin_amdgcn_global_load_lds((const unsigned*)((const char*)(gbase) + (voff)[_i]), (PG8_LAS unsigned*)(lds + (bufoff) + ldsw + _i * 8192), 16, 0, 0); } while (0)
#define PG8_LDA(dst, b, h) do { _Pragma("unroll") for (int m = 0; m < 4; ++m) _Pragma("unroll") for (int k = 0; k < 2; ++k) dst[m][k] = *(const PG8_LAS bf16x8*)(lds + PG8_SA(b, h) + aoff + m * 2048 + k * 1024); } while (0)
#define PG8_LDB(dst, b, h) do { _Pragma("unroll") for (int n = 0; n < 2; ++n) _Pragma("unroll") for (int k = 0; k < 2; ++k) dst[n][k] = *(const PG8_LAS bf16x8*)(lds + PG8_SB(b, h) + boff + n * 2048 + k * 1024); } while (0)
#define PG8_MMA(ai, bj, At, Bt) do { __builtin_amdgcn_s_setprio(1); _Pragma("unroll") for (int m = 0; m < 4; ++m) _Pragma("unroll") for (int n = 0; n < 2; ++n) _Pragma("unroll") for (int k = 0; k < 2; ++k) \
        acc[ai][bj][m][n] = __builtin_amdgcn_mfma_f32_16x16x32_bf16(Bt[n][k], At[m][k], acc[ai][bj][m][n], 0, 0, 0); __builtin_amdgcn_s_setprio(0); } while (0)
#define PG8_WAIT_V(n) asm volatile("s_waitcnt vmcnt(" #n ")" ::: "memory")
#define PG8_WAIT_L(n) asm volatile("s_waitcnt lgkmcnt(" #n ")" ::: "memory")
#define PG8_BAR __builtin_amdgcn_s_barrier()
#define PG8_SCHED __builtin_amdgcn_sched_barrier(0)
    Unit cur, nxt; int ui = 0;
    if (!S.next(0, cur)) return;
    f32x4 acc[2][2][4][2];
#pragma unroll
    for (int a = 0; a < 2; ++a)
#pragma unroll
        for (int b = 0; b < 2; ++b)
#pragma unroll
            for (int m = 0; m < 4; ++m)
#pragma unroll
                for (int n = 0; n < 2; ++n) acc[a][b][m][n] = (f32x4){0.f, 0.f, 0.f, 0.f};
    bf16x8 At[4][2], B0[2][2], B1[2][2];
    const char* cA = (const char*)g.A + (size_t)cur.pm * tstep; const char* cB = (const char*)g.Bt + (size_t)cur.pn * tstep;
    S.a_ready(cur);
    PG8_STAGE(PG8_SB(0, 0), cB, voffB); PG8_STAGE(PG8_SA(0, 0), cA, voffA); PG8_STAGE(PG8_SB(0, 1), cB + hstep, voffB); PG8_STAGE(PG8_SA(0, 1), cA + hstep, voffA);
    if (wr == 1) PG8_BAR;
    PG8_WAIT_V(4); PG8_BAR;
    PG8_STAGE(PG8_SB(1, 0), cB + kstep, voffB); PG8_STAGE(PG8_SA(1, 0), cA + kstep, voffA); PG8_STAGE(PG8_SB(1, 1), cB + hstep + kstep, voffB);
    PG8_WAIT_V(6); PG8_BAR;
    PG8_STAMP();
    for (;;) {
        const bool has_next = S.next(ui + 1, nxt);
        const char* nA = has_next ? (const char*)g.A + (size_t)nxt.pm * tstep : cA; const char* nB = has_next ? (const char*)g.Bt + (size_t)nxt.pn * tstep : cB;
        for (int t = 0; t < nt; t += 2) {
            const bool last = (t == nt - 2);
            const char* a1 = cA + (size_t)(t + 1) * kstep;
            const char* a2 = last ? nA : cA + (size_t)(t + 2) * kstep; const char* b2 = last ? nB : cB + (size_t)(t + 2) * kstep;
            const char* a3 = a2 + kstep; const char* b3 = b2 + kstep;
            if (last && has_next) S.a_ready(nxt);
            PG8_LDB(B0, 0, 0); PG8_SCHED; PG8_LDA(At, 0, 0); PG8_STAGE(PG8_SA(1, 1), a1 + hstep, voffA);
            PG8_WAIT_L(8); PG8_BAR; PG8_WAIT_L(0); PG8_MMA(0, 0, At, B0); PG8_BAR; PG8_SCHED;
            PG8_LDB(B1, 0, 1); PG8_STAGE(PG8_SB(0, 0), b2, voffB);
            PG8_BAR; PG8_WAIT_L(0); PG8_MMA(0, 1, At, B1); PG8_BAR;
            PG8_LDA(At, 0, 1); PG8_STAGE(PG8_SA(0, 0), a2, voffA);
            PG8_BAR; PG8_WAIT_L(0); PG8_MMA(1, 0, At, B0); PG8_BAR; PG8_SCHED;
            PG8_STAGE(PG8_SB(0, 1), b2 + hstep, voffB);
            PG8_WAIT_V(6); PG8_BAR; PG8_MMA(1, 1, At, B1); PG8_BAR;
            PG8_LDB(B0, 1, 0); PG8_SCHED; PG8_LDA(At, 1, 0); PG8_STAGE(PG8_SA(0, 1), a2 + hstep, voffA);
            PG8_WAIT_L(8); PG8_BAR; PG8_WAIT_L(0); PG8_MMA(0, 0, At, B0); PG8_BAR; PG8_SCHED;
            PG8_LDB(B1, 1, 1); PG8_STAGE(PG8_SB(1, 0), b3, voffB);
            PG8_BAR; PG8_WAIT_L(0); PG8_MMA(0, 1, At, B1); PG8_BAR;
            PG8_LDA(At, 1, 1); PG8_STAGE(PG8_SA(1, 0), a3, voffA);
            PG8_BAR; PG8_WAIT_L(0); PG8_MMA(1, 0, At, B0); PG8_BAR; PG8_SCHED;
            PG8_STAGE(PG8_SB(1, 1), b3 + hstep, voffB);
            PG8_WAIT_V(6); PG8_BAR; PG8_MMA(1, 1, At, B1); PG8_BAR;
        }
        PG8_STAMP();
        if constexpr (!Epi::AFTER_DRAIN) { E(acc, cur, wr, wc, fr, fq); S.done(cur); }
        PG8_STAMP();
        if (!has_next) break;
#pragma unroll
        for (int a = 0; a < 2; ++a)
#pragma unroll
            for (int b = 0; b < 2; ++b)
#pragma unroll
                for (int m = 0; m < 4; ++m)
#pragma unroll
                    for (int n = 0; n < 2; ++n) acc[a][b][m][n] = (f32x4){0.f, 0.f, 0.f, 0.f};
        cur = nxt; cA = nA; cB = nB; ++ui;
    }
    PG8_WAIT_V(0);
    if (wr == 0) PG8_BAR;
    PG8_BAR;
    if constexpr (Epi::AFTER_DRAIN) { E.fused(acc, cur, wr, wc, fr, fq, lds, wid, lane); S.done(cur); }
    PG8_STAMP();
    if (STAMP && wid == 0) { stamps[lane] = lane < nts ? (((unsigned long long)(unsigned)ts_hi << 32) | (unsigned)ts_lo) : 0ull;
        if (lane == 62) stamps[62] = rt_entry; if (lane == 63) stamps[63] = (unsigned long long)wall_clock64(); }
#undef PG8_STAMP
#undef PG8_SA
#undef PG8_SB
#undef PG8_STAGE
#undef PG8_LDA
#undef PG8_LDB
#undef PG8_MMA
#undef PG8_WAIT_V
#undef PG8_WAIT_L
#undef PG8_BAR
#undef PG8_SCHED
}
}
#define XB_TMO      128
#define XB_XCNT(j)  (256  + 64 * (j))
#define XB_XSUB(j)  (1280 + 64 * (j))
#define XB_XGEN(j)  (2304 + 64 * (j))
#define XB_TOP      3328
#define XB_TOPGEN   3392
#define XCD_BAR_WORDS 3456
#define XB_SPIN_CAP (1u << 18)
#define LAS __attribute__((address_space(3)))

__device__ __forceinline__ unsigned xb_ld(unsigned* p)              { return __hip_atomic_load(p, __ATOMIC_RELAXED, __HIP_MEMORY_SCOPE_AGENT); }
__device__ __forceinline__ unsigned xb_add(unsigned* p, unsigned v) { return __hip_atomic_fetch_add(p, v, __ATOMIC_RELAXED, __HIP_MEMORY_SCOPE_AGENT); }
__device__ __forceinline__ unsigned xb_xcc_id() { return (unsigned)__builtin_amdgcn_s_getreg((3 << 11) | 20) & 0xFu; }
#define XB_SPIN(cond, bar) do { unsigned _sp = 0; while (cond) { __builtin_amdgcn_s_sleep(1); \
    if ((++_sp & 255u) == 0u) { if (xb_ld(&(bar)[XB_TMO])) break; if (_sp > XB_SPIN_CAP) { atomicAdd(&(bar)[XB_TMO], 1u); break; } } } } while (0)

struct XcdBarrier {
    unsigned* bar; unsigned x;
    volatile LAS unsigned* st;
};

__device__ __forceinline__ XcdBarrier xcd_barrier_post(unsigned* bar, volatile LAS unsigned* st) {
    XcdBarrier b; b.bar = bar; b.x = xb_xcc_id(); b.st = st;
    if (threadIdx.x == 0) (void)xb_add(&bar[XB_XCNT(b.x)], 1u);
    return b;
}
__device__ __forceinline__ void xcd_barrier_complete(unsigned* bar, unsigned x, unsigned& nloc, unsigned& nx) {
    const unsigned G = gridDim.x * gridDim.y * gridDim.z;
    unsigned sum, cnt, mine, sp = 0u;
    for (;;) {
        sum = 0u; cnt = 0u; mine = 0u;
#pragma unroll
        for (unsigned j = 0; j < 16; ++j) { const unsigned c = xb_ld(&bar[XB_XCNT(j)]); sum += c; cnt += (c > 0u) ? 1u : 0u; mine = (j == x) ? c : mine; }
        if (sum == G) break;
        __builtin_amdgcn_s_sleep(1);
        if ((++sp & 255u) == 0u) { if (xb_ld(&bar[XB_TMO])) break; if (sp > XB_SPIN_CAP) { atomicAdd(&bar[XB_TMO], 1u); break; } }
    }
    nloc = mine > 0u ? mine : 1u; nx = cnt > 0u ? cnt : 1u;
}

__device__ __forceinline__ void xcd_barrier(const XcdBarrier& b) {
    asm volatile("s_waitcnt vmcnt(0)" ::: "memory");
    __syncthreads();
    if (threadIdx.x == 0) {
        unsigned* bar = b.bar;
        __builtin_amdgcn_s_waitcnt(0);
        unsigned nloc = b.st[0], nx = b.st[1];
        if (nloc == 0u) { xcd_barrier_complete(bar, b.x, nloc, nx); b.st[0] = nloc; b.st[1] = nx; }
        const unsigned old = xb_add(&bar[XB_XSUB(b.x)], 1u);
        const unsigned gen = old / nloc;
        if (old + 1u == (gen + 1u) * nloc) {
            __builtin_amdgcn_fence(__ATOMIC_RELEASE, "agent");
            asm volatile("s_waitcnt vmcnt(0)" ::: "memory");
            const unsigned og = xb_add(&bar[XB_TOP], 1u);
            const unsigned tg = og / nx;
            if (og + 1u == (tg + 1u) * nx) xb_add(&bar[XB_TOPGEN], 1u);
            else XB_SPIN(xb_ld(&bar[XB_TOPGEN]) == tg, bar);
            __builtin_amdgcn_fence(__ATOMIC_ACQUIRE, "agent");
            xb_add(&bar[XB_XGEN(b.x)], 1u);
            asm volatile("s_waitcnt vmcnt(0)" ::: "memory");
        } else {
            XB_SPIN(xb_ld(&bar[XB_XGEN(b.x)]) == gen, bar);
            __builtin_amdgcn_fence(__ATOMIC_ACQUIRE, "agent");
            asm volatile("s_waitcnt vmcnt(0)" ::: "memory");
        }
    }
    __syncthreads();
}


namespace mk {
using pg8::bf16_t; using pg8::bf16x8; using pg8::f32x4; using pg8::u32x4; using pg8::Unit; using pg8::cvt_pk_bf16;
typedef unsigned u32x2 __attribute__((ext_vector_type(2)));
typedef float cpx __attribute__((ext_vector_type(2)));
__host__ __device__ __forceinline__ cpx mkc(float a, float b) { cpx r; r.x = a; r.y = b; return r; }

constexpr int D = 2048, T_P = 32768, T_S = 8192, T = 40960, L_P = 16384, L_S = 2048, DFF = 5632;
constexpr int NTHR = 512;
constexpr int MODW = 53248;
constexpr int NPOS = 18432;
constexpr int QKVW = 9216;
constexpr float EPS = 1e-6f;
constexpr float QSCALE = 0.12751743082459868f;
constexpr int LDS_BYTES = 147456;
constexpr int LDS_MISC = 147456 - 256;

constexpr size_t al256(size_t x) { return (x + 255) & ~(size_t)255; }
constexpr size_t WS_CTL  = 0;
constexpr size_t CTL_BYTES = 65536;
constexpr size_t WS_PART = WS_CTL + CTL_BYTES;
constexpr size_t WS_MOD  = WS_PART + al256((size_t)8 * 6 * MODW * 4);
constexpr size_t WS_ROPE = WS_MOD + al256((size_t)6 * MODW * 4);
constexpr size_t WS_A2X  = WS_ROPE + (size_t)16384 * 16 * 8;
constexpr size_t WS_W3X  = WS_A2X + (size_t)2 * NPOS * 256 * 2;
constexpr size_t WS_WL   = WS_W3X + (size_t)2 * 8192 * 256 * 2;
constexpr size_t WL_FFN1 = 0;
constexpr size_t WL_FFN2 = WL_FFN1 + (size_t)11264 * 2048 * 2;
constexpr size_t WL_MIXIN = WL_FFN2 + (size_t)2048 * 5632 * 2;
constexpr size_t WL_MIXOUT = WL_MIXIN + (size_t)9216 * 2048 * 2;
constexpr size_t WL_BYTES = WL_MIXOUT + (size_t)2048 * 2048 * 2;
constexpr size_t WS_H    = WS_WL + WL_BYTES;
constexpr size_t H_BYTES = (size_t)T * 2048 * 2;
constexpr size_t WS_BIG  = WS_H + H_BYTES;
constexpr size_t BIG_ZINT = 0;
constexpr size_t BIG_TAPS = BIG_ZINT + (size_t)6144 * T * 2;
constexpr size_t BIG_HY_END = BIG_TAPS + (size_t)8192 * NPOS * 2;
constexpr size_t BIG_QKV = 0;
constexpr size_t BIG_OG  = BIG_QKV + (size_t)T * QKVW * 2;
constexpr size_t BIG_LSE = BIG_OG + (size_t)3 * T * 1024 * 2;
constexpr size_t BIG_AT_END = BIG_LSE + (size_t)3 * T * 8 * 4;
constexpr size_t BIG_MID = 0;
constexpr size_t BIG_BYTES = BIG_HY_END > BIG_AT_END ? BIG_HY_END : BIG_AT_END;
constexpr size_t WS_END  = WS_BIG + BIG_BYTES;
constexpr size_t FFT_SCR_PER_WG = 5 * 131072;
constexpr size_t FFT_EXT_PER_WG = 2 * 65536;
constexpr size_t WS_XB = WS_END + (size_t)256 * FFT_EXT_PER_WG;
constexpr size_t WS_TOTAL = WS_XB + (size_t)T * 2048 * 2;
static_assert(256 * FFT_SCR_PER_WG <= H_BYTES, "fft scratch must fit in H");

struct Params {
    const float *x_prompt, *x_sample, *c_prompt, *c_sample, *ada_w, *ada_b, *norm_mix, *norm_ffn;
    const float *hy_w_in, *hy_b_in, *hy_conv_w, *hy_conv_b, *hy_fw1, *hy_fb1, *hy_ffreq, *hy_fw2, *hy_fb2, *hy_fw3, *hy_decay, *hy_skip, *hy_w_out, *hy_b_out;
    const float *at_w_in, *at_w_out, *ffn_w_gate, *ffn_w_up, *ffn_w_down, *final_norm, *final_ada_w, *final_ada_b;
    float* out; unsigned char* ws; int ph_lo, ph_hi, probe, pad0;
};

#define LDSQ __attribute__((address_space(3)))

__device__ __forceinline__ float bf2f(bf16_t b) { return __uint_as_float(((unsigned)b) << 16); }
__device__ __forceinline__ bf16_t f2bf(float f) { unsigned u = __float_as_uint(f); u += 0x7FFFu + ((u >> 16) & 1u); return (bf16_t)(u >> 16); }
__device__ __forceinline__ int seq_of_row(int row) { return row < T_P ? (row >> 14) : 2 + ((row - T_P) >> 11); }
__device__ __forceinline__ int pos_of_row(int row) { return row < T_P ? (row & 16383) : (row & 2047); }
__device__ __forceinline__ float wave_sum(float v) {
#pragma unroll
    for (int o = 32; o >= 1; o >>= 1) v += __shfl_xor(v, o);
    return v;
}

struct EpiZinT {
    static constexpr bool PERM = true, AFTER_DRAIN = false;
    bf16_t* O; int ldc; const float* bias;
    __device__ __forceinline__ void operator()(const f32x4 (&acc)[2][2][4][2], const Unit& u, int wr, int wc, int fr, int fq) const {
        const int row0 = u.pm * 256 + wr * 64 + fr, col0 = u.pn * 256 + wc * 32 + 8 * fq;
        float bs[8];
#pragma unroll
        for (int r = 0; r < 8; ++r) bs[r] = bias[row0 + (r >> 2) * 128 + (r & 3) * 16];
#pragma unroll
        for (int ai = 0; ai < 2; ++ai)
#pragma unroll
            for (int m = 0; m < 4; ++m) { const int r = row0 + ai * 128 + m * 16; const float b = bs[ai * 4 + m]; bf16_t* rowp = O + (size_t)r * ldc + col0;
#pragma unroll
                for (int bj = 0; bj < 2; ++bj) { const f32x4 v0 = acc[ai][bj][m][0] + b, v1 = acc[ai][bj][m][1] + b;
                    u32x4 w; w.x = cvt_pk_bf16(v0[0], v0[1]); w.y = cvt_pk_bf16(v0[2], v0[3]); w.z = cvt_pk_bf16(v1[0], v1[1]); w.w = cvt_pk_bf16(v1[2], v1[3]);
                    *(u32x4*)(rowp + bj * 128) = w; } }
    }
};
struct EpiRes {
    static constexpr bool PERM = false, AFTER_DRAIN = false;
    bf16_t* X; const float* bias; const float* gate; int dry;
    __device__ __forceinline__ void operator()(const f32x4 (&acc)[2][2][4][2], const Unit& u, int wr, int wc, int fr, int fq) const {
        const int row0 = u.pm * 256 + wr * 64 + fr, col0 = u.pn * 256 + wc * 32 + 4 * fq;
        const float* gp = gate + (size_t)seq_of_row(u.pm * 256) * MODW + col0;
        bf16_t* xb = X + (size_t)row0 * 2048 + col0;
        u32x2 xv[2][8]; f32x4 gv[2], bv[2];
#pragma unroll
        for (int r = 0; r < 8; ++r) xv[0][r] = *(const u32x2*)(xb + (size_t)((r >> 2) * 128 + (r & 3) * 16) * 2048);
        gv[0] = *(const f32x4*)(gp); bv[0] = bias ? *(const f32x4*)(bias + col0) : (f32x4){0.f, 0.f, 0.f, 0.f};
#pragma unroll
        for (int cg = 0; cg < 4; ++cg) {
            const int bj = cg >> 1, n = cg & 1, coff = bj * 128 + n * 16;
            if (cg < 3) { const int c2 = ((cg + 1) >> 1) * 128 + ((cg + 1) & 1) * 16;
#pragma unroll
                for (int r = 0; r < 8; ++r) xv[(cg + 1) & 1][r] = *(const u32x2*)(xb + (size_t)((r >> 2) * 128 + (r & 3) * 16) * 2048 + c2);
                gv[(cg + 1) & 1] = *(const f32x4*)(gp + c2); bv[(cg + 1) & 1] = bias ? *(const f32x4*)(bias + col0 + c2) : (f32x4){0.f, 0.f, 0.f, 0.f}; }
#pragma unroll
            for (int r = 0; r < 8; ++r) { const u32x2 xo = xv[cg & 1][r];
                const f32x4 xf = {__uint_as_float(xo.x << 16), __uint_as_float(xo.x & 0xffff0000u), __uint_as_float(xo.y << 16), __uint_as_float(xo.y & 0xffff0000u)};
                const f32x4 x = xf + gv[cg & 1] * (acc[r >> 2][bj][r & 3][n] + bv[cg & 1]);
                u32x2 w; w.x = cvt_pk_bf16(x[0], x[1]); w.y = cvt_pk_bf16(x[2], x[3]);
                if (!dry) *(u32x2*)(xb + (size_t)((r >> 2) * 128 + (r & 3) * 16) * 2048 + coff) = w; }
        }
    }
};
struct EpiQKV {
    static constexpr bool PERM = true, AFTER_DRAIN = false;
    bf16_t* O; const cpx* rope;
    __device__ __forceinline__ void operator()(const f32x4 (&acc)[2][2][4][2], const Unit& u, int wr, int wc, int fr, int fq) const {
        const int row0 = u.pm * 256 + wr * 64 + fr, colt = u.pn * 256, col0 = colt + wc * 32 + 8 * fq;
        const int sidx = (colt % 3072) >> 10;
        const bool dorope = (sidx < 2) && (wc == 0);
        const float qs = (sidx == 0) ? QSCALE : 1.0f;
        f32x4 tt[2][4];
        if (dorope) { const cpx* rp = rope + (size_t)pos_of_row(row0) * 16 + 8 * (fq & 1);
            tt[0][0] = *(const f32x4*)(rp); tt[0][1] = *(const f32x4*)(rp + 2); tt[0][2] = *(const f32x4*)(rp + 4); tt[0][3] = *(const f32x4*)(rp + 6); }
#pragma unroll
        for (int g = 0; g < 8; ++g) { const int ai = g >> 2, m = g & 3; const int r = row0 + ai * 128 + m * 16; bf16_t* rowp = O + (size_t)r * QKVW + col0;
            f32x4 c0, c1, s0, s1;
            if (dorope) {
                if (g < 7) { const int r2 = row0 + ((g + 1) >> 2) * 128 + ((g + 1) & 3) * 16; const cpx* rp = rope + (size_t)pos_of_row(r2) * 16 + 8 * (fq & 1);
                    tt[(g + 1) & 1][0] = *(const f32x4*)(rp); tt[(g + 1) & 1][1] = *(const f32x4*)(rp + 2); tt[(g + 1) & 1][2] = *(const f32x4*)(rp + 4); tt[(g + 1) & 1][3] = *(const f32x4*)(rp + 6); }
                const f32x4 t0 = tt[g & 1][0], t1 = tt[g & 1][1], t2 = tt[g & 1][2], t3 = tt[g & 1][3];
                c0 = (f32x4){t0[0], t0[2], t1[0], t1[2]}; s0 = (f32x4){t0[1], t0[3], t1[1], t1[3]};
                c1 = (f32x4){t2[0], t2[2], t3[0], t3[2]}; s1 = (f32x4){t2[1], t2[3], t3[1], t3[3]}; }
#pragma unroll
            for (int bj = 0; bj < 2; ++bj) { f32x4 v0 = acc[ai][bj][m][0], v1 = acc[ai][bj][m][1];
                if (dorope) { f32x4 p0, p1;
#pragma unroll
                    for (int e = 0; e < 4; ++e) { p0[e] = __shfl_xor(v0[e], 32); p1[e] = __shfl_xor(v1[e], 32); }
                    if (fq < 2) { v0 = v0 * c0 - p0 * s0; v1 = v1 * c1 - p1 * s1; }
                    else        { v0 = v0 * c0 + p0 * s0; v1 = v1 * c1 + p1 * s1; } }
                v0 *= qs; v1 *= qs;
                u32x4 w; w.x = cvt_pk_bf16(v0[0], v0[1]); w.y = cvt_pk_bf16(v0[2], v0[3]); w.z = cvt_pk_bf16(v1[0], v1[1]); w.w = cvt_pk_bf16(v1[2], v1[3]);
                *(u32x4*)(rowp + bj * 128) = w; } }
    }
};
struct EpiFFN1 {
    static constexpr bool PERM = true, AFTER_DRAIN = false;
    bf16_t* O;
    __device__ __forceinline__ void operator()(const f32x4 (&acc)[2][2][4][2], const Unit& u, int wr, int wc, int fr, int fq) const {
        const int row0 = u.pm * 256 + wr * 64 + fr, col0 = u.pn * 128 + wc * 32 + 8 * fq;
#pragma unroll
        for (int ai = 0; ai < 2; ++ai)
#pragma unroll
            for (int m = 0; m < 4; ++m) { bf16_t* rowp = O + (size_t)(row0 + ai * 128 + m * 16) * DFF + col0; float o[8];
#pragma unroll
                for (int n = 0; n < 2; ++n)
#pragma unroll
                    for (int e = 0; e < 4; ++e) { const float g = acc[ai][0][m][n][e], up = acc[ai][1][m][n][e]; o[n * 4 + e] = g * __builtin_amdgcn_rcpf(1.0f + __expf(-g)) * up; }
                u32x4 w; w.x = cvt_pk_bf16(o[0], o[1]); w.y = cvt_pk_bf16(o[2], o[3]); w.z = cvt_pk_bf16(o[4], o[5]); w.w = cvt_pk_bf16(o[6], o[7]);
                *(u32x4*)rowp = w; }
    }
};
struct EpiTaps {
    static constexpr bool PERM = true, AFTER_DRAIN = false;
    _Float16* O;
    __device__ __forceinline__ void operator()(const f32x4 (&acc)[2][2][4][2], const Unit& u, int wr, int wc, int fr, int fq) const {
        typedef _Float16 h8 __attribute__((ext_vector_type(8)));
        const int row0 = u.pm * 256 + wr * 64 + fr, col0 = u.pn * 256 + wc * 32 + 8 * fq;
#pragma unroll
        for (int ai = 0; ai < 2; ++ai)
#pragma unroll
            for (int m = 0; m < 4; ++m) { _Float16* rowp = O + (size_t)(row0 + ai * 128 + m * 16) * NPOS + col0;
#pragma unroll
                for (int bj = 0; bj < 2; ++bj) { const f32x4 v0 = acc[ai][bj][m][0], v1 = acc[ai][bj][m][1]; h8 w;
                    w[0] = (_Float16)v0[0]; w[1] = (_Float16)v0[1]; w[2] = (_Float16)v0[2]; w[3] = (_Float16)v0[3]; w[4] = (_Float16)v1[0]; w[5] = (_Float16)v1[1]; w[6] = (_Float16)v1[2]; w[7] = (_Float16)v1[3];
                    *(h8*)(rowp + bj * 128) = w; } }
    }
};

__device__ __forceinline__ void ada_partials(const Params& p, LDSQ unsigned char* lds) {
    LDSQ float* cs = (LDSQ float*)lds;
    for (int i = pg8::otid(); i < 6 * 2048; i += NTHR) { const int b = i >> 11, k = i & 2047; const float c = b < 2 ? p.c_prompt[b * 2048 + k] : p.c_sample[(b - 2) * 2048 + k]; cs[i] = c / (1.0f + expf(-c)); }
    __syncthreads();
    float* part = (float*)(p.ws + WS_PART);
    for (int item = pg8::obid() * NTHR + pg8::otid(); item < 8 * 13312; item += pg8::ogrid() * NTHR) {
        const int chunk = item / 13312, c4 = item % 13312;
        const float* W; int ldw;
        if (c4 < 12288) { const int layer = c4 / 3072, col = (c4 % 3072) * 4; W = p.ada_w + (size_t)layer * 2048 * 12288 + col; ldw = 12288; }
        else { W = p.final_ada_w + (c4 - 12288) * 4; ldw = 4096; }
        f32x4 a0 = {0.f, 0.f, 0.f, 0.f}, a1 = a0, a2 = a0, a3 = a0, a4 = a0, a5 = a0;
        const int k0 = chunk * 256;
#pragma unroll 8
        for (int k = k0; k < k0 + 256; ++k) { const f32x4 w = *(const f32x4*)(W + (size_t)k * ldw);
            a0 += cs[k] * w; a1 += cs[2048 + k] * w; a2 += cs[4096 + k] * w; a3 += cs[6144 + k] * w; a4 += cs[8192 + k] * w; a5 += cs[10240 + k] * w; }
        float* o = part + (size_t)chunk * 6 * MODW + (size_t)c4 * 4;
        *(f32x4*)(o) = a0; *(f32x4*)(o + MODW) = a1; *(f32x4*)(o + 2 * MODW) = a2; *(f32x4*)(o + 3 * MODW) = a3; *(f32x4*)(o + 4 * MODW) = a4; *(f32x4*)(o + 5 * MODW) = a5;
    }
    __syncthreads();
}
__device__ __forceinline__ void ada_reduce(const Params& p) {
    const float* part = (const float*)(p.ws + WS_PART); float* mod = (float*)(p.ws + WS_MOD);
    for (int i = pg8::obid() * NTHR + pg8::otid(); i < 6 * MODW; i += pg8::ogrid() * NTHR) {
        const int c = i % MODW; float s = c < 49152 ? p.ada_b[c] : p.final_ada_b[c - 49152];
#pragma unroll
        for (int ch = 0; ch < 8; ++ch) s += part[(size_t)ch * 6 * MODW + i];
        mod[i] = s;
    }
}
__device__ __forceinline__ void rope_table(const Params& p) {
    cpx* rope = (cpx*)(p.ws + WS_ROPE);
    for (int i = pg8::obid() * NTHR + pg8::otid(); i < 16384 * 16; i += pg8::ogrid() * NTHR) {
        const int pos = i >> 4, f = i & 15; const float inv = powf(500000.0f, -(float)f / 16.0f); const float ang = (float)pos * inv;
        float s, c; sincosf(ang, &s, &c); rope[i] = mkc(c, s);
    }
}
__device__ __forceinline__ void filter_mlp(const Params& p) {
    const int lane = pg8::otid() & 63, gw = pg8::obid() * 8 + (pg8::otid() >> 6);
    bf16_t* a2x = (bf16_t*)(p.ws + WS_A2X);
    for (int q = gw; q < 2 * NPOS; q += pg8::ogrid() * 8) {
        const int j = q / NPOS, r = q % NPOS; const int L = r < 16384 ? 16384 : 2048, pos = r < 16384 ? r : r - 16384;
        const float fpos = (float)pos;
        float z = 0.f;
        if (lane == 0) z = fpos / (float)(L - 1);
        else if (lane <= 32) { const int bi = (lane - 1) & 15; const float band = 1e-4f + (float)bi * ((15.0f - 1e-4f) / 15.0f);
            const float ang = ((6.283185307179586f * fpos) * band) / (float)L; z = lane <= 16 ? cosf(ang) : -sinf(ang); }
        const float* w1 = p.hy_fw1 + j * 33 * 64; const float* w2 = p.hy_fw2 + j * 64 * 64;
        float acc = p.hy_fb1[j * 64 + lane];
#pragma unroll
        for (int m = 0; m < 33; ++m) acc += __shfl(z, m) * w1[m * 64 + lane];
        const float a1 = sinf(p.hy_ffreq[j * 128 + lane] * acc);
        acc = p.hy_fb2[j * 64 + lane];
#pragma unroll
        for (int m = 0; m < 64; ++m) acc += __shfl(a1, m) * w2[m * 64 + lane];
        const float a2 = sinf(p.hy_ffreq[j * 128 + 64 + lane] * acc);
        const bf16_t hi = f2bf(a2), lo = f2bf(a2 - bf2f(hi));
        bf16_t* o = a2x + ((size_t)j * NPOS + r) * 256;
        o[lane] = hi; o[64 + lane] = hi; o[128 + lane] = lo; o[192 + lane] = 0;
    }
    bf16_t* w3x = (bf16_t*)(p.ws + WS_W3X);
    for (int i = pg8::obid() * NTHR + pg8::otid(); i < 2 * 8192 * 64; i += pg8::ogrid() * NTHR) {
        const int k = i & 63, col = (i >> 6) & 8191, j = i >> 19;
        const float v = p.hy_fw3[(size_t)j * 64 * 8192 + (size_t)k * 8192 + col];
        const bf16_t hi = f2bf(v), lo = f2bf(v - bf2f(hi));
        bf16_t* o = w3x + ((size_t)j * 8192 + col) * 256;
        o[k] = hi; o[64 + k] = lo; o[128 + k] = hi; o[192 + k] = 0;
    }
}
__device__ __forceinline__ void convert_T(LDSQ unsigned char* lds, const float* src, int K, int N, bf16_t* dst, int ffs) {
    LDSQ float* tile = (LDSQ float*)lds;
    const int tid = pg8::otid(), ntn = N >> 8, ntiles = (K >> 6) * ntn, stride = pg8::ogrid();
    const int r = tid >> 6, c4 = tid & 63;
    f32x4 v[8];
    int ti = pg8::obid();
    if (ti < ntiles) { const int tk = ti / ntn, tn = ti % ntn;
#pragma unroll
        for (int it = 0; it < 8; ++it) v[it] = *(const f32x4*)(src + (size_t)(tk * 64 + r + 8 * it) * N + tn * 256 + 4 * c4); }
    for (; ti < ntiles; ti += stride) {
        const int tk = ti / ntn, tn = ti % ntn;
#pragma unroll
        for (int it = 0; it < 8; ++it) { LDSQ float* tp = tile + (r + 8 * it) * 257 + 4 * c4; tp[0] = v[it][0]; tp[1] = v[it][1]; tp[2] = v[it][2]; tp[3] = v[it][3]; }
        __syncthreads();
        if (ti + stride < ntiles) { const int t2 = ti + stride, tk2 = t2 / ntn, tn2 = t2 % ntn;
#pragma unroll
            for (int it = 0; it < 8; ++it) v[it] = *(const f32x4*)(src + (size_t)(tk2 * 64 + r + 8 * it) * N + tn2 * 256 + 4 * c4); }
        { const int n = tid >> 1, kh = tid & 1; const int nn = tn * 256 + n; const int row = ffs < 0 ? nn : (256 * (nn >> 7) + 128 * ffs + (nn & 127));
          bf16_t* dp = dst + (size_t)row * K + tk * 64 + kh * 32;
#pragma unroll
          for (int q = 0; q < 4; ++q) { float f[8];
#pragma unroll
              for (int e = 0; e < 8; ++e) f[e] = tile[(kh * 32 + q * 8 + e) * 257 + n];
              u32x4 w; w.x = cvt_pk_bf16(f[0], f[1]); w.y = cvt_pk_bf16(f[2], f[3]); w.z = cvt_pk_bf16(f[4], f[5]); w.w = cvt_pk_bf16(f[6], f[7]);
              *(u32x4*)(dp + q * 8) = w; } }
        __syncthreads();
    }
}
template <bool FINAL, bool SRC_F32> __device__ __forceinline__ void norm_rows(const float* xp, const float* xs, bf16_t* xb, const float* g, const float* modl, int sh_off, int sc_off, bf16_t* H, float* outf) {
    const int lane = pg8::otid() & 63, gw = pg8::obid() * 8 + (pg8::otid() >> 6), nw = pg8::ogrid() * 8;
    const int rpw = (T + nw - 1) / nw, r0 = gw * rpw, r1 = (r0 + rpw < T) ? r0 + rpw : T;
    if (r0 >= r1) return;
    f32x4 gs[8], sh[8]; int curseq = -1;
    struct RowBuf { f32x4 f[SRC_F32 ? 8 : 1]; u32x2 b[SRC_F32 ? 1 : 8]; };
    auto request = [&](RowBuf& B, int row) {
        if (SRC_F32) { const f32x4* src = (const f32x4*)(row < T_P ? xp + (size_t)row * 2048 : xs + (size_t)(row - T_P) * 2048);
#pragma unroll
            for (int i = 0; i < 8; ++i) B.f[i] = src[lane + 64 * i]; }
        else { const u32x2* src = (const u32x2*)(xb + (size_t)row * 2048);
#pragma unroll
            for (int i = 0; i < 8; ++i) B.b[i] = src[lane + 64 * i]; } };
    auto process = [&](RowBuf& B, int row, int next) {
        f32x4 v[8];
#pragma unroll
        for (int i = 0; i < 8; ++i) { if (SRC_F32) v[i] = B.f[i]; else v[i] = (f32x4){__uint_as_float(B.b[i].x << 16), __uint_as_float(B.b[i].x & 0xffff0000u), __uint_as_float(B.b[i].y << 16), __uint_as_float(B.b[i].y & 0xffff0000u)}; }
        if (next < r1) request(B, next);
        const int seq = seq_of_row(row);
        if (seq != curseq) { curseq = seq; const float* mod = modl + (size_t)seq * MODW;
#pragma unroll
            for (int i = 0; i < 8; ++i) { const int col = (lane + 64 * i) * 4; gs[i] = *(const f32x4*)(g + col); sh[i] = *(const f32x4*)(mod + sc_off + col); }
#pragma unroll
            for (int i = 0; i < 8; ++i) { const int col = (lane + 64 * i) * 4; const f32x4 sft = *(const f32x4*)(mod + sh_off + col); gs[i] = gs[i] * (1.0f + sh[i]); sh[i] = sft; } }
        float ss = 0.f;
#pragma unroll
        for (int i = 0; i < 8; ++i) ss += v[i][0] * v[i][0] + v[i][1] * v[i][1] + v[i][2] * v[i][2] + v[i][3] * v[i][3];
        ss = wave_sum(ss);
        const float rstd = 1.0f / sqrtf(ss * (1.0f / 2048.0f) + EPS);
#pragma unroll
        for (int i = 0; i < 8; ++i) { const int col = (lane + 64 * i) * 4;
            const f32x4 h = (v[i] * rstd) * gs[i] + sh[i];
            if (FINAL) *(f32x4*)(outf + (size_t)row * 2048 + col) = h;
            else { u32x2 w; w.x = cvt_pk_bf16(h[0], h[1]); w.y = cvt_pk_bf16(h[2], h[3]); *(u32x2*)(H + (size_t)row * 2048 + col) = w;
                if (SRC_F32) { u32x2 c; c.x = cvt_pk_bf16(v[i][0], v[i][1]); c.y = cvt_pk_bf16(v[i][2], v[i][3]); *(u32x2*)(xb + (size_t)row * 2048 + col) = c; } } } };
    if (SRC_F32) {
        RowBuf B0, B1;
        request(B0, r0); if (r0 + 1 < r1) request(B1, r0 + 1);
        for (int row = r0; row < r1; row += 2) { process(B0, row, row + 2); if (row + 1 < r1) process(B1, row + 1, row + 3); }
    } else {
        RowBuf B0, B1, B2;
        request(B0, r0); if (r0 + 1 < r1) request(B1, r0 + 1); if (r0 + 2 < r1) request(B2, r0 + 2);
        for (int row = r0; row < r1; row += 3) {
            process(B0, row, row + 3);
            if (row + 1 < r1) process(B1, row + 1, row + 4);
            if (row + 2 < r1) process(B2, row + 2, row + 5);
        }
    }
}
__device__ __forceinline__ void final_norm_phase(const Params& p) {
    norm_rows<true, false>(nullptr, nullptr, (bf16_t*)(p.ws + WS_XB), p.final_norm, (const float*)(p.ws + WS_MOD) + 49152, 0, 2048, nullptr, p.out);
}
__device__ __forceinline__ void transpose_phase(const Params& p, LDSQ unsigned char* lds) {
    LDSQ bf16_t* tile = (LDSQ bf16_t*)lds;
    const bf16_t* zin = (const bf16_t*)(p.ws + WS_BIG + BIG_ZINT); bf16_t* H = (bf16_t*)(p.ws + WS_H);
    const int tid = pg8::otid(), stride = pg8::ogrid();
    const int cr = tid >> 5, tq = tid & 31;
    u32x4 v[4];
    int ti = pg8::obid();
    if (ti < 32 * 160) { const int tc = ti / 160, tt = ti % 160;
#pragma unroll
        for (int it = 0; it < 4; ++it) v[it] = *(const u32x4*)(zin + (size_t)(tc * 64 + cr + 16 * it) * T + tt * 256 + tq * 8); }
    for (; ti < 32 * 160; ti += stride) {
        const int tc = ti / 160, tt = ti % 160;
#pragma unroll
        for (int it = 0; it < 4; ++it) *(LDSQ u32x4*)(tile + (cr + 16 * it) * 264 + tq * 8) = v[it];
        __syncthreads();
        if (ti + stride < 32 * 160) { const int t2 = ti + stride, tc2 = t2 / 160, tt2 = t2 % 160;
#pragma unroll
            for (int it = 0; it < 4; ++it) v[it] = *(const u32x4*)(zin + (size_t)(tc2 * 64 + cr + 16 * it) * T + tt2 * 256 + tq * 8); }
        { const int cq = tid & 7, tk = tid >> 3;
#pragma unroll
          for (int it = 0; it < 4; ++it) { const int tok = tk + 64 * it; unsigned w[4];
#pragma unroll
              for (int e = 0; e < 4; ++e) { const unsigned lo = tile[(cq * 8 + 2 * e) * 264 + tok], hi = tile[(cq * 8 + 2 * e + 1) * 264 + tok]; w[e] = lo | (hi << 16); }
              *(u32x4*)(H + (size_t)(tt * 256 + tok) * 2048 + tc * 64 + cq * 8) = (u32x4){w[0], w[1], w[2], w[3]}; } }
        __syncthreads();
    }
}

__host__ __device__ constexpr float cos64q(int k) {
    constexpr float t[17] = {1.0f, 0.99518472667219693f, 0.98078528040323043f, 0.95694033573220882f, 0.92387953251128674f, 0.88192126434835505f, 0.83146961230254524f,
        0.77301045336273699f, 0.70710678118654757f, 0.63439328416364549f, 0.55557023301960229f, 0.47139673682599781f, 0.38268343236508984f, 0.29028467725446233f,
        0.19509032201612833f, 0.09801714032956077f, 0.0f};
    return t[k];
}
__host__ __device__ constexpr float cos64(int k) { k &= 63; return k <= 16 ? cos64q(k) : k <= 32 ? -cos64q(32 - k) : k <= 48 ? -cos64q(k - 32) : cos64q(64 - k); }
__host__ __device__ constexpr float sin64(int k) { return cos64((k + 48) & 63); }
template <int R> __host__ __device__ constexpr int brev(int k) { int r = 0; for (int b = 1; b < R; b <<= 1) { r = (r << 1) | (k & 1); k >>= 1; } return r; }

typedef _Float16 hcpx __attribute__((ext_vector_type(2)));
typedef _Float16 hcpx2 __attribute__((ext_vector_type(4)));
__device__ __forceinline__ hcpx h_of(cpx a) { hcpx r; r.x = (_Float16)a.x; r.y = (_Float16)a.y; return r; }
__device__ __forceinline__ cpx c_of(hcpx a) { return mkc((float)a.x, (float)a.y); }
__device__ __forceinline__ hcpx2 h2_of(cpx a, cpx b) { hcpx2 r; r.x = (_Float16)a.x; r.y = (_Float16)a.y; r.z = (_Float16)b.x; r.w = (_Float16)b.y; return r; }
#define VA __device__ __forceinline__ float
VA f_mul(float a, float b) { float r; asm("v_mul_f32_e32 %0, %1, %2" : "=v"(r) : "v"(a), "v"(b)); return r; }
VA f_fma(float a, float b, float c) { float r; asm("v_fma_f32 %0, %1, %2, %3" : "=v"(r) : "v"(a), "v"(b), "v"(c)); return r; }
VA f_fms(float a, float b, float c) { float r; asm("v_fma_f32 %0, %1, %2, -%3" : "=v"(r) : "v"(a), "v"(b), "v"(c)); return r; }
#undef VA
__device__ __forceinline__ cpx cmul(cpx a, cpx b) { float rx, ry;
    asm("v_mul_f32_e32 %0, %3, %5\n\tv_mul_f32_e32 %1, %3, %4\n\tv_fma_f32 %0, %2, %4, -%0\n\tv_fma_f32 %1, %2, %5, %1" : "=&v"(rx), "=&v"(ry) : "v"(a.x), "v"(a.y), "v"(b.x), "v"(b.y)); return mkc(rx, ry); }
__device__ __forceinline__ cpx cmulc(cpx a, cpx b) { float rx, ry;
    asm("v_mul_f32_e32 %0, %3, %5\n\tv_mul_f32_e32 %1, %2, %5\n\tv_fma_f32 %0, %2, %4, %0\n\tv_fma_f32 %1, %3, %4, -%1" : "=&v"(rx), "=&v"(ry) : "v"(a.x), "v"(a.y), "v"(b.x), "v"(b.y)); return mkc(rx, ry); }

template <int R, bool INV, int H, int P> __device__ __forceinline__ void bfly(cpx (&v)[R]) {
    constexpr int b = (P / H) * 2 * H, i = P % H, e = i * (32 / H);
    float ux = v[b + i].x, uy = v[b + i].y, wx = v[b + i + H].x, wy = v[b + i + H].y;
    if constexpr (e == 0) { float dx, dy;
        asm("v_sub_f32_e32 %2, %0, %4\n\tv_sub_f32_e32 %3, %1, %5\n\tv_add_f32_e32 %0, %0, %4\n\tv_add_f32_e32 %1, %1, %5" : "+v"(ux), "+v"(uy), "=&v"(dx), "=&v"(dy) : "v"(wx), "v"(wy));
        wx = dx; wy = dy; }
    else if constexpr (e == 16) { float ox, oy;
        if constexpr (!INV) asm("v_sub_f32_e32 %2, %1, %5\n\tv_sub_f32_e32 %3, %4, %0\n\tv_add_f32_e32 %0, %0, %4\n\tv_add_f32_e32 %1, %1, %5" : "+v"(ux), "+v"(uy), "=&v"(ox), "=&v"(oy) : "v"(wx), "v"(wy));
        else                asm("v_sub_f32_e32 %2, %5, %1\n\tv_sub_f32_e32 %3, %0, %4\n\tv_add_f32_e32 %0, %0, %4\n\tv_add_f32_e32 %1, %1, %5" : "+v"(ux), "+v"(uy), "=&v"(ox), "=&v"(oy) : "v"(wx), "v"(wy));
        wx = ox; wy = oy; }
    else { constexpr float c = cos64(e), s = INV ? sin64(e) : -sin64(e);
        constexpr unsigned cb = __builtin_bit_cast(unsigned, c), sb = __builtin_bit_cast(unsigned, s), nsb = __builtin_bit_cast(unsigned, -s);
        float dx, dy;
        asm("v_sub_f32_e32 %4, %0, %2\n\tv_sub_f32_e32 %5, %1, %3\n\tv_add_f32_e32 %0, %0, %2\n\tv_add_f32_e32 %1, %1, %3\n\t"
            "v_mul_f32_e32 %2, %8, %5\n\tv_mul_f32_e32 %3, %6, %5\n\tv_fmamk_f32 %2, %4, %6, %2\n\tv_fmamk_f32 %3, %4, %7, %3"
            : "+v"(ux), "+v"(uy), "+v"(wx), "+v"(wy), "=&v"(dx), "=&v"(dy) : "i"(cb), "i"(sb), "i"(nsb)); }
    v[b + i] = mkc(ux, uy); v[b + i + H] = mkc(wx, wy);
}
template <int R, bool INV, int H, int... Ps> __device__ __forceinline__ void dft_stage(cpx (&v)[R], std::integer_sequence<int, Ps...>) { (bfly<R, INV, H, Ps>(v), ...); }
template <int R, bool INV, int H> __device__ __forceinline__ void dft_stages(cpx (&v)[R]) {
    dft_stage<R, INV, H>(v, std::make_integer_sequence<int, R / 2>{});
    if constexpr (H > 1) dft_stages<R, INV, H / 2>(v);
}
template <int R, bool INV> __device__ __forceinline__ void dft_r2(cpx (&v)[R]) { dft_stages<R, INV, R / 2>(v); }
template <int R, bool CONJ, bool BREV> __device__ __forceinline__ void apply_pows(cpx (&v)[R], cpx w) {
    constexpr int H = R > 16 ? 16 : R;
    cpx pw[H];
    pw[1] = w;
#pragma unroll
    for (int k = 2; k < H; ++k) pw[k] = (k & 1) ? cmul(pw[k - 1], w) : cmul(pw[k / 2], pw[k / 2]);
#pragma unroll
    for (int k = 1; k < H; ++k) { const int idx = BREV ? brev<R>(k) : k; v[idx] = CONJ ? cmulc(v[idx], pw[k]) : cmul(v[idx], pw[k]); }
    if (R > 16) {
        const cpx w16 = cmul(pw[8], pw[8]);
#pragma unroll
        for (int k = 0; k < R - 16; ++k) { const cpx q = k == 0 ? w16 : cmul(pw[k], w16); const int idx = BREV ? brev<R>(16 + k) : 16 + k; v[idx] = CONJ ? cmulc(v[idx], q) : cmul(v[idx], q); }
    }
}
__device__ __forceinline__ int phys(int i) { return i + (i >> 5); }
constexpr int TW_OFF = 135168 + 64;
template <int S> __host__ __device__ constexpr int poff(int j) { return S >= 32 ? j * (S + S / 32) : j * S + ((j * S) >> 5); }
typedef hcpx PreRegs[32];
template <int R, int S> __device__ __forceinline__ void fft_prefetch(int t, const hcpx* gio, PreRegs& pre) {
    constexpr int G = 32 / R;
#pragma unroll
    for (int gi = 0; gi < G; ++gi) { const int gam = gi * 512 + t, hi = gam / S, lo = gam % S, base = hi * (R * S) + lo;
#pragma unroll
        for (int j = 0; j < R; ++j) pre[gi * R + j] = __builtin_nontemporal_load(gio + base + j * S); }
}
template <int R, int S, bool INV, int IO> __device__ __forceinline__ void fft_pass(LDSQ cpx* A, int t, hcpx* gio, const PreRegs& pre) {
    constexpr int G = 32 / R;
    asm volatile("" : "+v"(t) :: "memory");
    const LDSQ cpx* TW = (const LDSQ cpx*)((LDSQ unsigned char*)A + TW_OFF);
    cpx v[G][R]; cpx tw[G];
#pragma unroll
    for (int gi = 0; gi < G; ++gi) {
        const int gam = gi * 512 + t, hi = gam / S, lo = gam % S, base = hi * (R * S) + lo; const LDSQ cpx* Ab = A + phys(base);
#pragma unroll
        for (int j = 0; j < R; ++j) v[gi][j] = (IO == 3) ? c_of(pre[gi * R + j]) : (IO == 1) ? c_of(__builtin_nontemporal_load(gio + base + j * S)) : Ab[poff<S>(j)];
        tw[gi] = TW[lo * (16384 / (R * S))];
    }
#pragma unroll
    for (int gi = 0; gi < G; ++gi) {
        const int gam = gi * 512 + t, hi = gam / S, lo = gam % S, base = hi * (R * S) + lo; LDSQ cpx* Ab = A + phys(base);
        if (!INV) {
            dft_r2<R, false>(v[gi]);
            apply_pows<R, false, true>(v[gi], tw[gi]);
#pragma unroll
            for (int k = 0; k < R; ++k) { if (IO == 2) gio[base + k * S] = h_of(v[gi][brev<R>(k)]); else Ab[poff<S>(k)] = v[gi][brev<R>(k)]; }
        } else {
            apply_pows<R, true, false>(v[gi], tw[gi]);
            dft_r2<R, true>(v[gi]);
#pragma unroll
            for (int j = 0; j < R; ++j) { if (IO == 2) gio[base + j * S] = h_of(v[gi][brev<R>(j)]); else Ab[poff<S>(j)] = v[gi][brev<R>(j)]; }
        }
    }
}
template <int R, int MODE> __device__ __forceinline__ void fft_mid(LDSQ cpx* A, int t, hcpx* spec, float scale) {
    constexpr int G = 32 / R;
    asm volatile("" : "+v"(t) :: "memory");
    hcpx2 sp[G][R / 2];
    if (MODE == 1) {
#pragma unroll
        for (int gi = 0; gi < G; ++gi)
#pragma unroll
            for (int k2 = 0; k2 < R / 2; ++k2) sp[gi][k2] = *(const hcpx2*)(spec + (size_t)(gi * 512 + t) * R + 2 * k2);
    }
#pragma unroll
    for (int gi = 0; gi < G; ++gi) {
        const int gam = gi * 512 + t, base = gam * R;
        cpx v[R];
        LDSQ cpx* Ab = A + phys(base);
#pragma unroll
        for (int j = 0; j < R; ++j) v[j] = Ab[j];
        dft_r2<R, false>(v);
        if (MODE == 0) {
#pragma unroll
            for (int k2 = 0; k2 < R / 2; ++k2) { const cpx x = v[brev<R>(2 * k2)], y = v[brev<R>(2 * k2 + 1)];
                *(hcpx2*)(spec + (size_t)base + 2 * k2) = h2_of(mkc(x.x * scale, x.y * scale), mkc(y.x * scale, y.y * scale)); }
        } else {
            cpx x[R];
#pragma unroll
            for (int k2 = 0; k2 < R / 2; ++k2) { const hcpx2 s = sp[gi][k2]; x[2 * k2] = cmul(v[brev<R>(2 * k2)], mkc((float)s.x * scale, (float)s.y * scale)); x[2 * k2 + 1] = cmul(v[brev<R>(2 * k2 + 1)], mkc((float)s.z * scale, (float)s.w * scale)); }
            dft_r2<R, true>(x);
#pragma unroll
            for (int j = 0; j < R; ++j) Ab[j] = x[brev<R>(j)];
        }
    }
}
#define GL_DRAIN() asm volatile("s_waitcnt vmcnt(0)" ::: "memory")
struct NoHook { __device__ __forceinline__ void operator()() const {} };
template <int LOG2L, bool INV, int GIO, class Hook = NoHook> __device__ __forceinline__ void fft_outer(LDSQ cpx* A, int t, hcpx* gio, const hcpx* pfsrc, PreRegs& pre, Hook hook = Hook()) {
    constexpr int R1 = LOG2L == 14 ? 32 : 16, S1 = LOG2L == 14 ? 512 : 128, S2 = LOG2L == 14 ? 16 : 8;
    if (!INV) { fft_pass<R1, S1, false, GIO == 3 ? 3 : 0>(A, t, nullptr, pre); __syncthreads(); fft_pass<R1, S2, false, 0>(A, t, nullptr, pre); GL_DRAIN(); __syncthreads(); }
    else      { fft_pass<R1, S2, true, 0>(A, t, nullptr, pre); __syncthreads();
                if (GIO == 2) fft_prefetch<R1, S1>(t, pfsrc, pre);
                hook();
                fft_pass<R1, S1, true, GIO == 2 ? 2 : 0>(A, t, gio, pre); if (GIO != 2) GL_DRAIN(); __syncthreads(); }
}
template <int LOG2L, int SRC, int DST, class Hook = NoHook> __device__ __forceinline__ void fft_conv(LDSQ cpx* A, int t, hcpx* spec, hcpx* gdst, const hcpx* pfsrc, PreRegs& pre, Hook hook = Hook()) {
    fft_outer<LOG2L, false, SRC>(A, t, nullptr, nullptr, pre);
    fft_mid<LOG2L == 14 ? 16 : 8, 1>(A, t, spec, 1.0f / (float)(1 << LOG2L));
    if (SRC == 3) GL_DRAIN();
    __syncthreads();
    fft_outer<LOG2L, true, DST>(A, t, gdst, pfsrc, pre, hook);
}

__device__ __forceinline__ void sconv4r(u32x2 q, unsigned zmr, unsigned zpr, float w0, float w1, float w2, float bb, float (&o)[4]) {
    const float zm = __uint_as_float(zmr << 16), zp = __uint_as_float(zpr << 16);
    const float z0 = __uint_as_float(q.x << 16), z1 = __uint_as_float(q.x & 0xffff0000u), z2 = __uint_as_float(q.y << 16), z3 = __uint_as_float(q.y & 0xffff0000u);
    o[0] = w0 * zm + w1 * z0 + w2 * z1 + bb; o[1] = w0 * z0 + w1 * z1 + w2 * z2 + bb; o[2] = w0 * z1 + w1 * z2 + w2 * z3 + bb; o[3] = w0 * z2 + w1 * z3 + w2 * zp + bb;
}
typedef _Float16 h4 __attribute__((ext_vector_type(4)));
__device__ __forceinline__ void tapquad(h4 a, h4 bq, unsigned b0bits, float wf, float wb, float rf1, float rf2, float rf3, float rb1, float rb2, float rb3, float (&fa)[4], float (&fb)[4]) {
    const float b0 = (float)__builtin_bit_cast(_Float16, (unsigned short)b0bits);
    fa[0] = (float)a.x * wf; fa[1] = (float)a.y * (wf * rf1); fa[2] = (float)a.z * (wf * rf2); fa[3] = (float)a.w * (wf * rf3);
    fb[0] = b0 * wb; fb[1] = (float)bq.w * (wb * rb1); fb[2] = (float)bq.z * (wb * rb2); fb[3] = (float)bq.y * (wb * rb3);
}
template <int LOG2L> struct SweepIdx {
    static constexpr int L = 1 << LOG2L, QS = L / 32;
    int t, seq, n00, a00; cpx wq0, w1, w2, w3;
    __device__ __forceinline__ SweepIdx(int t_, bool need_w) { t = t_; asm volatile("" : "+v"(t) :: "memory"); seq = (LOG2L == 14) ? 0 : (t >> 6); const int q0 = (LOG2L == 14) ? t : (t & 63); n00 = 4 * q0; a00 = seq * L + n00;
        if (need_w) { float sb, cb; sincospif(-(float)n00 / (float)L, &sb, &cb); wq0 = mkc(cb, sb);
            sincospif(-1.0f / (float)L, &sb, &cb); w1 = mkc(cb, sb); w2 = cmul(w1, w1); w3 = cmul(w2, w1); } }
};
#define WQS mkc(0.92387953251128674f, -0.38268343236508978f)
struct TapWin { float wf0, wfs, rf1, rf2, rf3, wb0, wbs, rb1, rb2, rb3; };
template <int LOG2L> __device__ __forceinline__ TapWin tap_windows(float df, float db, int n00) {
    constexpr int L = 1 << LOG2L, QS = L / 32; TapWin w;
    w.wf0 = expf(-df * (float)n00); w.wfs = expf(-df * (float)(4 * QS)); w.rf1 = expf(-df); w.rf2 = w.rf1 * w.rf1; w.rf3 = w.rf2 * w.rf1;
    w.wb0 = expf(-db * (float)(L - n00)); w.wbs = expf(db * (float)(4 * QS)); w.rb1 = expf(db); w.rb2 = w.rb1 * w.rb1; w.rb3 = w.rb2 * w.rb1; return w;
}
template <int LOG2L> __device__ __forceinline__ void sweep_taps2(LDSQ cpx* A, int t_, const _Float16* tf0, const _Float16* tb0, const _Float16* tf1, const _Float16* tb1, float df0, float db0, float df1, float db1, hcpx* hos, float& ss0, float& ss1) {
    constexpr int L = 1 << LOG2L, QS = L / 32; const SweepIdx<LOG2L> X(t_, true);
    const TapWin W0 = tap_windows<LOG2L>(df0, db0, X.n00), W1 = tap_windows<LOG2L>(df1, db1, X.n00);
    float s0 = 0.f, s1 = 0.f, wf0 = W0.wf0, wb0 = W0.wb0, wf1 = W1.wf0, wb1 = W1.wb0;
    cpx wn = X.wq0;
    h4 ra0[8], rb0[8], ra1[8], rb1[8]; unsigned rc0[8], rc1[8];
#pragma unroll
    for (int i = 0; i < 8; ++i) { const int n = 4 * (i * QS) + X.n00, nb = n > 0 ? L - n : L - 1;
        ra0[i] = *(const h4*)(tf0 + n); rb0[i] = *(const h4*)(tb0 + L - n - 4); rc0[i] = ((const unsigned short*)tb0)[nb];
        ra1[i] = *(const h4*)(tf1 + n); rb1[i] = *(const h4*)(tb1 + L - n - 4); rc1[i] = ((const unsigned short*)tb1)[nb]; }
#pragma unroll
    for (int i = 0; i < 8; ++i) { const int n = 4 * (i * QS) + X.n00; float fa0[4], fb0[4], fa1[4], fb1[4]; const unsigned hm = n > 0 ? 0xffffu : 0u;
        tapquad(ra0[i], rb0[i], rc0[i] & hm, wf0, wb0, W0.rf1, W0.rf2, W0.rf3, W0.rb1, W0.rb2, W0.rb3, fa0, fb0);
        tapquad(ra1[i], rb1[i], rc1[i] & hm, wf1, wb1, W1.rf1, W1.rf2, W1.rf3, W1.rb1, W1.rb2, W1.rb3, fa1, fb1);
        LDSQ cpx* ap = A + phys(X.a00 + 4 * i * QS); hcpx* hp = hos + X.a00 + 4 * i * QS;
#pragma unroll
        for (int e = 0; e < 4; ++e) { s0 += fa0[e] * fa0[e] + fb0[e] * fb0[e]; s1 += fa1[e] * fa1[e] + fb1[e] * fb1[e]; ap[e] = mkc(fa0[e] + fb0[e], fa1[e] + fb1[e]); }
        const cpx wa = cmul(wn, X.w1), wb2 = cmul(wn, X.w2), wc = cmul(wn, X.w3);
        const cpx y0 = cmul(mkc(fa0[0] - fb0[0], fa1[0] - fb1[0]), wn), y1 = cmul(mkc(fa0[1] - fb0[1], fa1[1] - fb1[1]), wa);
        const cpx y2 = cmul(mkc(fa0[2] - fb0[2], fa1[2] - fb1[2]), wb2), y3 = cmul(mkc(fa0[3] - fb0[3], fa1[3] - fb1[3]), wc);
        *(hcpx2*)hp = h2_of(y0, y1); *(hcpx2*)(hp + 2) = h2_of(y2, y3);
        wn = cmul(wn, WQS); wf0 *= W0.wfs; wb0 *= W0.wbs; wf1 *= W1.wfs; wb1 *= W1.wbs; }
    ss0 = s0; ss1 = s1;
}
template <int LOG2L, int PART> __device__ __forceinline__ void fft_mid_sep(LDSQ cpx* A, int t, hcpx* spec0, hcpx* spec1, const LDSQ float* red, const float* skp0, const float* skp1) {
    constexpr int R = LOG2L == 14 ? 16 : 8, G = 32 / R, NB = LOG2L == 14 ? 32 : 16, NG = NB * NB;
    asm volatile("" : "+v"(t) :: "memory");
#pragma unroll
    for (int gi = 0; gi < G; ++gi) {
        cpx v[R]; LDSQ cpx* Ab = A + phys((gi * 512 + t) * R);
#pragma unroll
        for (int j = 0; j < R; ++j) v[j] = Ab[j];
        dft_r2<R, false>(v);
#pragma unroll
        for (int k = 0; k < R; ++k) Ab[k] = v[brev<R>(k)];
    }
    __syncthreads();
#pragma unroll
    for (int gi = 0; gi < G; ++gi) {
        const int gam = gi * 512 + t, seq = gam / NG, g = gam % NG, k1 = g / NB, k2 = g % NB;
        const int gp = PART == 1 ? NG - 1 - g : (k1 ? (NB - k1) * NB + (NB - 1 - k2) : (k2 ? NB - k2 : 0));
        const bool wrap = PART == 0 && g == 0;
        const LDSQ cpx* Ab = A + phys(gam * R); const LDSQ cpx* Ap = A + phys((seq * NG + gp) * R);
        cpx z[R], q[R];
#pragma unroll
        for (int k = 0; k < R; ++k) { z[k] = Ab[k]; q[k] = Ap[k]; }
        float ss0, ss1;
        if (LOG2L == 14) { ss0 = red[0] + red[1] + red[2] + red[3] + red[4] + red[5] + red[6] + red[7]; ss1 = red[8] + red[9] + red[10] + red[11] + red[12] + red[13] + red[14] + red[15]; }
        else { ss0 = red[seq]; ss1 = red[8 + seq]; }
        const float n0 = 0.25f / sqrtf(ss0 + EPS), n1 = 0.25f / sqrtf(ss1 + EPS), h0 = 0.5f * skp0[seq], h1 = 0.5f * skp1[seq];
        hcpx* s0p = spec0 + (size_t)gam * R; hcpx* s1p = spec1 + (size_t)gam * R;
#pragma unroll
        for (int k2_ = 0; k2_ < R / 2; ++k2_) { cpx o0[2], o1[2];
#pragma unroll
            for (int e = 0; e < 2; ++e) { const int k = 2 * k2_ + e; cpx zp = q[R - 1 - k]; const cpx zw = q[(R - k) & (R - 1)];
                if (PART == 0) { zp.x = wrap ? zw.x : zp.x; zp.y = wrap ? zw.y : zp.y; }
                o0[e] = mkc((z[k].x + zp.x) * n0 + h0, (z[k].y - zp.y) * n0); o1[e] = mkc((z[k].y + zp.y) * n1 + h1, (zp.x - z[k].x) * n1); }
            *(hcpx2*)(s0p + 2 * k2_) = h2_of(o0[0], o0[1]); *(hcpx2*)(s1p + 2 * k2_) = h2_of(o1[0], o1[1]); }
    }
}
template <int LOG2L> __device__ __forceinline__ void sweep_load_v(LDSQ cpx* A, int t_, const bf16_t* zrow, size_t tb0, const float* cw, const float* cbias, int rc0, hcpx* xw) {
    constexpr int L = 1 << LOG2L, QS = L / 32; const SweepIdx<LOG2L> X(t_, true);
    const int rc = rc0 + X.seq; const float cw0 = cw[rc], cw1 = cw[6144 + rc], cw2 = cw[2 * 6144 + rc], bb = cbias[rc];
    const bf16_t* z0 = zrow + (size_t)rc * T + tb0; const bf16_t* z1 = z0 + L;
    cpx wn = X.wq0;
    u32x2 rq[8][2]; unsigned rm[8][2], rp[8][2];
#pragma unroll
    for (int i = 0; i < 8; ++i) { const int n = 4 * (i * QS) + X.n00, nm = n > 0 ? n - 1 : 0, np = n + 4 < L ? n + 4 : L - 1;
        rq[i][0] = *(const u32x2*)(z0 + n); rq[i][1] = *(const u32x2*)(z1 + n); rm[i][0] = z0[nm]; rm[i][1] = z1[nm]; rp[i][0] = z0[np]; rp[i][1] = z1[np]; }
#pragma unroll
    for (int i = 0; i < 8; ++i) { const int n = 4 * (i * QS) + X.n00; float xa[4], xb[4]; const unsigned hm = n > 0 ? 0xffffu : 0u, hp = n + 4 < L ? 0xffffu : 0u;
        sconv4r(rq[i][0], rm[i][0] & hm, rp[i][0] & hp, cw0, cw1, cw2, bb, xa); sconv4r(rq[i][1], rm[i][1] & hm, rp[i][1] & hp, cw0, cw1, cw2, bb, xb);
        LDSQ cpx* ap = A + phys(X.a00 + 4 * i * QS); hcpx* xp = xw + X.a00 + 4 * i * QS;
        ap[0] = mkc(xa[0], xb[0]); ap[1] = mkc(xa[1], xb[1]); ap[2] = mkc(xa[2], xb[2]); ap[3] = mkc(xa[3], xb[3]);
        const cpx y0 = cmul(mkc(xa[0], xb[0]), wn), y1 = cmul(mkc(xa[1], xb[1]), cmul(wn, X.w1)), y2 = cmul(mkc(xa[2], xb[2]), cmul(wn, X.w2)), y3 = cmul(mkc(xa[3], xb[3]), cmul(wn, X.w3));
        *(hcpx2*)xp = h2_of(y0, y1); *(hcpx2*)(xp + 2) = h2_of(y2, y3);
        wn = cmul(wn, WQS); }
}
constexpr int CPA = 2;
template <int N> struct CombPreN { u32x2 q[N][2]; unsigned zm[N][2], zp[N][2]; hcpx2 h01[N], h23[N]; };
typedef CombPreN<CPA> CombPre;
template <int LOG2L, int I0, int N> __device__ __forceinline__ void combine_prefetch(int t_, const hcpx* yes, const bf16_t* zrow, size_t tb0, int rg0, CombPreN<N>& P) {
    constexpr int L = 1 << LOG2L, QS = L / 32; const SweepIdx<LOG2L> X(t_, false);
    const int rg = rg0 + X.seq; const bf16_t* g0 = zrow + (size_t)rg * T + tb0; const bf16_t* g1 = g0 + L;
#pragma unroll
    for (int i = 0; i < N; ++i) { const int n = 4 * ((I0 + i) * QS) + X.n00; const hcpx* yp = yes + X.a00 + 4 * (I0 + i) * QS;
        P.q[i][0] = *(const u32x2*)(g0 + n); P.q[i][1] = *(const u32x2*)(g1 + n);
        const int nm = n > 0 ? n - 1 : 0, np = n + 4 < L ? n + 4 : L - 1;
        P.zm[i][0] = g0[nm]; P.zm[i][1] = g1[nm]; P.zp[i][0] = g0[np]; P.zp[i][1] = g1[np];
        P.h01[i] = __builtin_nontemporal_load((const hcpx2*)yp); P.h23[i] = __builtin_nontemporal_load((const hcpx2*)(yp + 2)); }
}
template <int LOG2L, int FINAL> __device__ __forceinline__ void sweep_combine(LDSQ cpx* A, int t_, const CombPre& P0, const hcpx* yes, hcpx* xw, bf16_t* zrow, size_t tb0, const float* cw, const float* cbias, int rg0, int ro0, int dry) {
    constexpr int L = 1 << LOG2L, QS = L / 32; const SweepIdx<LOG2L> X(t_, true);
    CombPreN<8 - CPA> P1; combine_prefetch<LOG2L, CPA>(X.t, yes, zrow, tb0, rg0, P1);
    const int rg = rg0 + X.seq; const float cw0 = cw[rg], cw1 = cw[6144 + rg], cw2 = cw[2 * 6144 + rg], bb = cbias[rg];
    bf16_t* o0 = zrow + (size_t)(ro0 + X.seq) * T + tb0; bf16_t* o1 = o0 + L;
    cpx wn = X.wq0;
#pragma unroll
    for (int i = 0; i < 8; ++i) { const int n = 4 * (i * QS) + X.n00; float ga[4], gb[4];
        const bool ah = i < CPA; const int ia = ah ? i : 0, ib = ah ? 0 : i - CPA;
        const unsigned hm = n > 0 ? 0xffffu : 0u, hp = n + 4 < L ? 0xffffu : 0u;
        sconv4r(ah ? P0.q[ia][0] : P1.q[ib][0], (ah ? P0.zm[ia][0] : P1.zm[ib][0]) & hm, (ah ? P0.zp[ia][0] : P1.zp[ib][0]) & hp, cw0, cw1, cw2, bb, ga);
        sconv4r(ah ? P0.q[ia][1] : P1.q[ib][1], (ah ? P0.zm[ia][1] : P1.zm[ib][1]) & hm, (ah ? P0.zp[ia][1] : P1.zp[ib][1]) & hp, cw0, cw1, cw2, bb, gb);
        const LDSQ cpx* ap = A + phys(X.a00 + 4 * i * QS);
        const hcpx2 h01 = ah ? P0.h01[ia] : P1.h01[ib], h23 = ah ? P0.h23[ia] : P1.h23[ib];
        const f32x4 e01 = {(float)h01.x, (float)h01.y, (float)h01.z, (float)h01.w}, e23 = {(float)h23.x, (float)h23.y, (float)h23.z, (float)h23.w};
        const cpx wa = cmul(wn, X.w1), wb2 = cmul(wn, X.w2), wc = cmul(wn, X.w3);
        const cpx r0 = cmulc(ap[0], wn), r1 = cmulc(ap[1], wa), r2 = cmulc(ap[2], wb2), r3 = cmulc(ap[3], wc);
        const cpx s0 = mkc(ga[0] * (e01[0] + r0.x), gb[0] * (e01[1] + r0.y)), s1 = mkc(ga[1] * (e01[2] + r1.x), gb[1] * (e01[3] + r1.y));
        const cpx s2 = mkc(ga[2] * (e23[0] + r2.x), gb[2] * (e23[1] + r2.y)), s3 = mkc(ga[3] * (e23[2] + r3.x), gb[3] * (e23[3] + r3.y));
        if (FINAL == 0) { LDSQ cpx* aw = A + phys(X.a00 + 4 * i * QS); hcpx* xp = xw + X.a00 + 4 * i * QS;
            aw[0] = s0; aw[1] = s1; aw[2] = s2; aw[3] = s3;
            const cpx y0 = cmul(s0, wn), y1 = cmul(s1, wa), y2 = cmul(s2, wb2), y3 = cmul(s3, wc);
            *(hcpx2*)xp = h2_of(y0, y1); *(hcpx2*)(xp + 2) = h2_of(y2, y3); }
        else if (!dry) { u32x2 wa2, wb3; wa2.x = cvt_pk_bf16(s0.x, s1.x); wa2.y = cvt_pk_bf16(s2.x, s3.x); wb3.x = cvt_pk_bf16(s0.y, s1.y); wb3.y = cvt_pk_bf16(s2.y, s3.y);
            *(u32x2*)(o0 + n) = wa2; *(u32x2*)(o1 + n) = wb3; }
        wn = cmul(wn, WQS); }
}
template <int LOG2L> __device__ __forceinline__ void hyena_item(const Params& p, LDSQ unsigned char* lds, int layer_j, int c0, int dry) {
    constexpr int L = 1 << LOG2L, NPAIR = (LOG2L == 14) ? 1 : 2;
    constexpr int TOK0 = (LOG2L == 14) ? 0 : T_P, PB = (LOG2L == 14) ? 0 : 16384;
    LDSQ cpx* A = (LDSQ cpx*)lds;
    LDSQ float* red = (LDSQ float*)(lds + 135168);
    const int t = pg8::otid(), ch = c0 + ((LOG2L == 14) ? 0 : (t >> 6));
    bf16_t* zin = (bf16_t*)(p.ws + WS_BIG + BIG_ZINT);
    const _Float16* taps = (const _Float16*)(p.ws + WS_BIG + BIG_TAPS);
    hcpx* scr = (hcpx*)(p.ws + WS_H + (size_t)pg8::obid() * FFT_SCR_PER_WG);
    hcpx* u1s = scr + (size_t)4 * 16384;
    hcpx* yes = (hcpx*)(p.ws + WS_END + (size_t)pg8::obid() * FFT_EXT_PER_WG);
    PreRegs pre;
    hcpx* xw = yes + 16384;
    {
        const _Float16* tf0 = taps + (size_t)(0 * 2048 + ch) * NPOS + PB; const _Float16* tb0 = taps + (size_t)(1 * 2048 + ch) * NPOS + PB;
        const _Float16* tf1 = taps + (size_t)(2 * 2048 + ch) * NPOS + PB; const _Float16* tb1 = taps + (size_t)(3 * 2048 + ch) * NPOS + PB;
        const float* dec = p.hy_decay + (size_t)layer_j * 8192 + ch;
        const float df0 = fabsf(dec[0]) * (1.0f / (float)(L - 1)), db0 = fabsf(dec[2048]) * (1.0f / (float)(L - 1));
        const float df1 = fabsf(dec[4096]) * (1.0f / (float)(L - 1)), db1 = fabsf(dec[6144]) * (1.0f / (float)(L - 1));
        float ss0, ss1;
        sweep_taps2<LOG2L>(A, t, tf0, tb0, tf1, tb1, df0, db0, df1, db1, xw, ss0, ss1);
        ss0 = wave_sum(ss0); ss1 = wave_sum(ss1);
        if ((t & 63) == 0) { red[t >> 6] = ss0; red[8 + (t >> 6)] = ss1; }
        __syncthreads();
        const float* skp0 = p.hy_skip + (size_t)layer_j * 2 * 2048 + c0; const float* skp1 = skp0 + 2048;
        fft_outer<LOG2L, false, 0>(A, t, nullptr, nullptr, pre);
        fft_prefetch<LOG2L == 14 ? 32 : 16, LOG2L == 14 ? 512 : 128>(t, xw, pre);
        fft_mid_sep<LOG2L, 0>(A, t, scr + (size_t)0 * 16384, scr + (size_t)2 * 16384, red, skp0, skp1); __syncthreads();
        fft_outer<LOG2L, false, 3>(A, t, nullptr, nullptr, pre);
        fft_mid_sep<LOG2L, 1>(A, t, scr + (size_t)1 * 16384, scr + (size_t)3 * 16384, red, skp0, skp1); __syncthreads();
    }
    const float* cw = p.hy_conv_w + (size_t)layer_j * 3 * 6144; const float* cbias = p.hy_conv_b + (size_t)layer_j * 6144;
#pragma unroll 1
    for (int pr = 0; pr < NPAIR; ++pr) {
        const size_t tb0 = (size_t)TOK0 + (size_t)(2 * pr) * L;
        sweep_load_v<LOG2L>(A, t, zin, tb0, cw, cbias, 2 * 2048 + c0, xw); __syncthreads();
        fft_conv<LOG2L, 0, 2>(A, t, scr + (size_t)0 * 16384, yes, xw, pre);
        CombPre cp;
        fft_conv<LOG2L, 3, 0>(A, t, scr + (size_t)1 * 16384, nullptr, nullptr, pre, [&]() { combine_prefetch<LOG2L, 0>(t, yes, zin, tb0, c0, cp); });
        sweep_combine<LOG2L, 0>(A, t, cp, yes, xw, zin, tb0, cw, cbias, c0, c0, dry); __syncthreads();
        fft_conv<LOG2L, 0, 2>(A, t, scr + (size_t)2 * 16384, yes, xw, pre);
        fft_conv<LOG2L, 3, 0>(A, t, scr + (size_t)3 * 16384, nullptr, nullptr, pre, [&]() { combine_prefetch<LOG2L, 0>(t, yes, zin, tb0, 2048 + c0, cp); });
        sweep_combine<LOG2L, 1>(A, t, cp, yes, xw, zin, tb0, cw, cbias, 2048 + c0, c0, dry); __syncthreads();
    }
}
__device__ __forceinline__ void hyena_conv_phase(const Params& p, LDSQ unsigned char* lds, int layer_j, int dry) {
    { LDSQ cpx* TW = (LDSQ cpx*)(lds + TW_OFF);
      for (int e = pg8::otid(); e < 1024; e += NTHR) { float sn, cs; sincospif(-2.0f * (float)e / 16384.0f, &sn, &cs); TW[e] = mkc(cs, sn); }
      __syncthreads(); }
    for (int it = pg8::obid(); it < 2048; it += pg8::ogrid()) hyena_item<14>(p, lds, layer_j, it, dry);
    for (int it = pg8::obid(); it < 256; it += pg8::ogrid()) hyena_item<11>(p, lds, layer_j, it * 8, dry);
}

__device__ __forceinline__ void attn_phase(const Params& p, LDSQ unsigned char* lds, int dry = 0) {
    constexpr int KROW = 272, VROW = 264;
    LDSQ unsigned char* Kl = lds; LDSQ bf16_t* VT = (LDSQ bf16_t*)(lds + 256 * KROW);
    const bf16_t* qkv = (const bf16_t*)(p.ws + WS_BIG + BIG_QKV);
    bf16_t* og = (bf16_t*)(p.ws + WS_BIG + BIG_OG); float* lse = (float*)(p.ws + WS_BIG + BIG_LSE);
    const int tid = pg8::otid(), lane = tid & 63, wid = __builtin_amdgcn_readfirstlane(tid >> 6), l15 = lane & 15, g4 = lane >> 4;
    const int blk = wid >> 2, qq = 16 * (wid & 3) + l15;
    for (int u = pg8::obid(); u < 1792 + 512; u += pg8::ogrid()) {
        const int it = u < 1792 ? 4 * u : 7168 + (u - 1792), len = u < 1792 ? 4 : 1;
        int g, b, hh, rho, pp0, L, tokbase;
        if (it < 6144) { g = it >> 11; const int rem = it & 2047; const int npp = 128 >> (2 * g); pp0 = rem % npp; rho = (rem / npp) & ((1 << (2 * g)) - 1); hh = (rem >> 7) & 7; b = rem >> 10; L = L_P; tokbase = 0; }
        else { const int i2 = it - 6144; g = i2 >> 9; const int rem = i2 & 511; const int npp = 16 >> (2 * g); pp0 = rem % npp; rho = (rem / npp) & ((1 << (2 * g)) - 1); hh = (rem >> 4) & 7; b = rem >> 7; L = L_S; tokbase = T_P; }
        const int rsh = 2 * g, n = L >> rsh;
        const size_t tok0 = (size_t)tokbase + (size_t)b * L + rho;
        const int qcol = g * 3072 + hh * 128, kcol = qcol + 1024, vcol = qcol + 2048;
        u32x4 kr[2][4], vr[2][4];
        auto request_half = [&](int ih, u32x4 (&kh)[4], u32x4 (&vh)[4]) {
#pragma unroll
            for (int s4 = 0; s4 < 4; ++s4) { const int ci = tid + 512 * s4;
                { const int slot = ci >> 4, chn = ci & 15, i = ih + slot, ic = i < 0 ? 0 : (i < n ? i : n - 1); kh[s4] = *(const u32x4*)(qkv + (tok0 + ((size_t)ic << rsh)) * QKVW + kcol + chn * 8); }
                { const int slot = ci & 127, chn = ci >> 7, i = ih + slot, ic = i < 0 ? 0 : (i < n ? i : n - 1); vh[s4] = *(const u32x4*)(qkv + (tok0 + ((size_t)ic << rsh)) * QKVW + vcol + chn * 8); } } };
        auto stage_half = [&](int ih, int ring0, const u32x4 (&kh)[4], const u32x4 (&vh)[4]) {
#pragma unroll
            for (int s4 = 0; s4 < 4; ++s4) { const int ci = tid + 512 * s4;
                { const int slot = ci >> 4, chn = ci & 15, i = ih + slot; const unsigned ok = (i >= 0 && i < n) ? 0xffffffffu : 0u;
                  u32x4 v = kh[s4]; v.x &= ok; v.y &= ok; v.z &= ok; v.w &= ok;
                  *(LDSQ u32x4*)(Kl + (ring0 + slot) * KROW + chn * 16) = v; }
                { const int slot = ci & 127, chn = ci >> 7, i = ih + slot; const unsigned ok = (i >= 0 && i < n) ? 0xffffffffu : 0u;
                  u32x4 v = vh[s4]; v.x &= ok; v.y &= ok; v.z &= ok; v.w &= ok;
                  LDSQ bf16_t* vp = VT + (chn * 8) * VROW + ring0 + slot;
                  vp[0] = (bf16_t)(v.x & 0xffffu); vp[VROW] = (bf16_t)(v.x >> 16); vp[2 * VROW] = (bf16_t)(v.y & 0xffffu); vp[3 * VROW] = (bf16_t)(v.y >> 16);
                  vp[4 * VROW] = (bf16_t)(v.z & 0xffffu); vp[5 * VROW] = (bf16_t)(v.z >> 16); vp[6 * VROW] = (bf16_t)(v.w & 0xffffu); vp[7 * VROW] = (bf16_t)(v.w >> 16); } } };
        request_half(128 * pp0 - 64, kr[0], vr[0]); request_half(128 * pp0 + 64, kr[1], vr[1]);
#pragma unroll 1
        for (int s = 0; s < len; ++s) {
            const int pp = pp0 + s, i0 = 128 * pp - 64, off = (128 * pp) & 255;
            const int qi = 128 * pp + 64 * blk + qq;
            const size_t tq = tok0 + ((size_t)qi << rsh);
            bf16x8 bq[4];
#pragma unroll
            for (int ks = 0; ks < 4; ++ks) bq[ks] = *(const bf16x8*)(qkv + tq * QKVW + qcol + 32 * ks + 8 * g4);
            if (s == 0) stage_half(i0, off, kr[0], vr[0]);
            stage_half(i0 + 128, (128 + off) & 255, kr[1], vr[1]);
            __syncthreads();
            const int ktb = wid & 3;
            f32x4 sc[10]; bf16x8 kf[2][4];
            auto kload = [&](int j, bf16x8 (&f)[4]) { const int rb = (64 * blk + 16 * (ktb + j) + off) & 255;
#pragma unroll
                for (int ks = 0; ks < 4; ++ks) f[ks] = *(const LDSQ bf16x8*)(Kl + (rb + l15) * KROW + (32 * ks + 8 * g4) * 2); };
            kload(0, kf[0]);
#pragma unroll
            for (int j = 0; j < 9; ++j) {
                if (j + 1 < 9) kload(j + 1, kf[(j + 1) & 1]);
                __builtin_amdgcn_sched_barrier(0);
                f32x4 a = {0.f, 0.f, 0.f, 0.f};
#pragma unroll
                for (int ks = 0; ks < 4; ++ks) a = __builtin_amdgcn_mfma_f32_16x16x32_bf16(kf[j & 1][ks], bq[ks], a, 0, 0, 0);
                sc[j] = a;
                __builtin_amdgcn_sched_barrier(0); }
            if (s + 1 < len) request_half(i0 + 256, kr[1], vr[1]);
            const int ibase = 128 * pp + 64 * blk - 64;
            const int klo = qq > -ibase ? qq : -ibase, khi = (qq + 128 < n - 1 - ibase) ? qq + 128 : n - 1 - ibase;
            const unsigned kspan = (unsigned)(khi - klo); const int kk0 = 4 * g4 - klo + 16 * ktb;
            float mx = -3.0e38f;
#pragma unroll
            for (int j = 0; j < 9; ++j)
#pragma unroll
                for (int r = 0; r < 4; ++r) { const bool ok = (unsigned)(kk0 + 16 * j + r) <= kspan;
                    sc[j][r] = ok ? sc[j][r] : -3.0e38f; mx = fmaxf(mx, sc[j][r]); }
            mx = fmaxf(mx, __shfl_xor(mx, 16)); mx = fmaxf(mx, __shfl_xor(mx, 32));
            float ls = 0.f;
#pragma unroll
            for (int j = 0; j < 9; ++j)
#pragma unroll
                for (int r = 0; r < 4; ++r) { const float e = __builtin_amdgcn_exp2f(sc[j][r] - mx); sc[j][r] = e; ls += e; }
            sc[9] = (f32x4){0.f, 0.f, 0.f, 0.f};
            ls += __shfl_xor(ls, 16); ls += __shfl_xor(ls, 32);
            f32x4 oa[8];
#pragma unroll
            for (int dt = 0; dt < 8; ++dt) oa[dt] = (f32x4){0.f, 0.f, 0.f, 0.f};
            u32x2 vf[2][4][2];
            auto vload = [&](int gidx, u32x2 (&f)[4][2]) { const int k2 = gidx >> 1, d0 = (gidx & 1) * 4;
                const int cb0 = (64 * blk + 16 * ktb + 32 * k2 + off) & 255, cb1 = (cb0 + 16) & 255;
#pragma unroll
                for (int d = 0; d < 4; ++d) { const LDSQ bf16_t* vq = VT + (16 * (d0 + d) + l15) * VROW + 4 * g4; f[d][0] = *(const LDSQ u32x2*)(vq + cb0); f[d][1] = *(const LDSQ u32x2*)(vq + cb1); } };
            vload(0, vf[0]);
#pragma unroll
            for (int gidx = 0; gidx < 10; ++gidx) { const int k2 = gidx >> 1, d0 = (gidx & 1) * 4;
                if (gidx + 1 < 10) vload(gidx + 1, vf[(gidx + 1) & 1]);
                __builtin_amdgcn_sched_barrier(0);
                union { u32x4 u; bf16x8 h; } pb;
                pb.u.x = cvt_pk_bf16(sc[2 * k2][0], sc[2 * k2][1]); pb.u.y = cvt_pk_bf16(sc[2 * k2][2], sc[2 * k2][3]);
                pb.u.z = cvt_pk_bf16(sc[2 * k2 + 1][0], sc[2 * k2 + 1][1]); pb.u.w = cvt_pk_bf16(sc[2 * k2 + 1][2], sc[2 * k2 + 1][3]);
#pragma unroll
                for (int d = 0; d < 4; ++d) { union { u32x4 u; bf16x8 h; } va; const u32x2 lo = vf[gidx & 1][d][0], hi = vf[gidx & 1][d][1];
                    va.u.x = lo.x; va.u.y = lo.y; va.u.z = hi.x; va.u.w = hi.y;
                    oa[d0 + d] = __builtin_amdgcn_mfma_f32_16x16x32_bf16(va.h, pb.h, oa[d0 + d], 0, 0, 0); }
                __builtin_amdgcn_sched_barrier(0); }
            const float inv = 1.0f / ls;
            const size_t gt = (size_t)g * T + tq;
#pragma unroll
            for (int dt = 0; dt < 8; ++dt) { u32x2 w; w.x = cvt_pk_bf16(oa[dt][0] * inv, oa[dt][1] * inv); w.y = cvt_pk_bf16(oa[dt][2] * inv, oa[dt][3] * inv);
                if (!dry) *(u32x2*)(og + gt * 1024 + hh * 128 + 16 * dt + 4 * g4) = w; }
            if (g4 == 0 && !dry) lse[gt * 8 + hh] = mx + log2f(ls);
            __syncthreads();
        }
    }
}
__device__ __forceinline__ void attn_merge_phase(const Params& p) {
    const bf16_t* og = (const bf16_t*)(p.ws + WS_BIG + BIG_OG); const float* lse = (const float*)(p.ws + WS_BIG + BIG_LSE); bf16_t* H = (bf16_t*)(p.ws + WS_H);
    const int stride = pg8::ogrid() * NTHR;
    for (int i0 = pg8::obid() * NTHR + pg8::otid(); i0 < T * 128; i0 += 4 * stride) {
        u32x4 v0[4], v1[4], v2[4]; float l0[4], l1[4], l2[4];
#pragma unroll
        for (int u = 0; u < 4; ++u) { const int i = i0 + u * stride; if (i < T * 128) { const int tok = i >> 7, c8 = i & 127, hh = c8 >> 4;
            l0[u] = lse[(size_t)tok * 8 + hh]; l1[u] = lse[((size_t)T + tok) * 8 + hh]; l2[u] = lse[((size_t)2 * T + tok) * 8 + hh];
            v0[u] = *(const u32x4*)(og + (size_t)tok * 1024 + c8 * 8); v1[u] = *(const u32x4*)(og + ((size_t)T + tok) * 1024 + c8 * 8); v2[u] = *(const u32x4*)(og + ((size_t)2 * T + tok) * 1024 + c8 * 8); } }
#pragma unroll
        for (int u = 0; u < 4; ++u) { const int i = i0 + u * stride; if (i < T * 128) { const int tok = i >> 7, c8 = i & 127;
            const float m = fmaxf(l0[u], fmaxf(l1[u], l2[u])); float a0 = exp2f(l0[u] - m), a1 = exp2f(l1[u] - m), a2 = exp2f(l2[u] - m); const float is = 1.0f / (a0 + a1 + a2); a0 *= is; a1 *= is; a2 *= is;
            u32x4 w;
#pragma unroll
            for (int e = 0; e < 4; ++e) { const float lo = a0 * __uint_as_float(v0[u][e] << 16) + a1 * __uint_as_float(v1[u][e] << 16) + a2 * __uint_as_float(v2[u][e] << 16);
                const float hi = a0 * __uint_as_float(v0[u][e] & 0xffff0000u) + a1 * __uint_as_float(v1[u][e] & 0xffff0000u) + a2 * __uint_as_float(v2[u][e] & 0xffff0000u);
                w[e] = cvt_pk_bf16(lo, hi); }
            *(u32x4*)(H + (size_t)tok * 1024 + c8 * 8) = w; } }
    }
}

constexpr int NPHASE = 35;
typedef const __attribute__((address_space(4))) unsigned char* KARG;
template <class Tp> __device__ __forceinline__ Tp karg(int byte_off) { return *(volatile const __attribute__((address_space(4))) Tp*)((KARG)__builtin_amdgcn_kernarg_segment_ptr() + byte_off); }
#define PA(q, member) q.member = karg<decltype(Params::member)>((int)__builtin_offsetof(Params, member))
__global__ void __launch_bounds__(512, 2) mega(Params parg) {
    extern __shared__ __attribute__((aligned(16))) unsigned char shm[];
    LDSQ unsigned char* lds = (LDSQ unsigned char*)shm;
    const int tid = pg8::otid();
    volatile LDSQ unsigned* misc = (volatile LDSQ unsigned*)(lds + LDS_MISC);
    if (tid < 8) misc[tid] = 0u;
    __syncthreads();
    const int ph_lo = parg.ph_lo, ph_hi = parg.ph_hi, probe = parg.probe;
#define REPS(bit, lay) (1 + (1 + ((probe >> 15) & 1)) * (((probe >> (bit)) & 1) & ((((probe >> 10) & 3) == 0) | ((probe >> (10 + ((lay) & 1))) & 1))))
    XcdBarrier bar; bar.bar = nullptr; bar.x = 0; bar.st = misc;
    if (ph_hi - ph_lo > 1) { Params q{}; PA(q, ws); bar = xcd_barrier_post((unsigned*)(q.ws + WS_CTL), misc); }
#define IN(k) (ph_lo <= (k) && (k) < ph_hi)
#define REPBAR() do { if (((probe >> 16) & 1) && rep + 1 < nrep) { Params qb{}; PA(qb, ws); bar.bar = (unsigned*)(qb.ws + WS_CTL); xcd_barrier(bar); } } while (0)
#define SEAM(k) do { if (IN(k) && IN((k) + 1)) { Params qb{}; PA(qb, ws); bar.bar = (unsigned*)(qb.ws + WS_CTL); xcd_barrier(bar); if ((probe >> 12) & 1) { xcd_barrier(bar); xcd_barrier(bar); } } } while (0)

    for (int rep = 0, nrep = REPS(0, 0); rep < nrep; ++rep)
    if (IN(0)) { Params q{}; PA(q, ws); PA(q, c_prompt); PA(q, c_sample); PA(q, ada_w); PA(q, final_ada_w); ada_partials(q, lds); rope_table(q);
                 PA(q, hy_fw1); PA(q, hy_fb1); PA(q, hy_ffreq); PA(q, hy_fw2); PA(q, hy_fb2); PA(q, hy_fw3); filter_mlp(q); }
    SEAM(0);
    for (int rep = 0, nrep = REPS(0, 0); rep < nrep; ++rep)
    if (IN(1)) { Params q{}; PA(q, ws); PA(q, ada_b); PA(q, final_ada_b); ada_reduce(q); }
    SEAM(1);
#pragma unroll 1
    for (int layer = 0; layer < 4; ++layer) {
        const int pb = 2 + 8 * layer, j = layer >> 1; const bool hy = (layer & 1) == 0;
        for (int rep = 0, nrep = REPS(1, layer); rep < nrep; ++rep)
        if (IN(pb + 0)) {
            Params q{}; PA(q, ws); unsigned char* wl = q.ws + WS_WL;
            PA(q, ffn_w_gate); convert_T(lds, q.ffn_w_gate + (size_t)layer * 2048 * DFF, 2048, DFF, (bf16_t*)(wl + WL_FFN1), 0);
            PA(q, ffn_w_up);   convert_T(lds, q.ffn_w_up + (size_t)layer * 2048 * DFF, 2048, DFF, (bf16_t*)(wl + WL_FFN1), 1);
            PA(q, ffn_w_down); convert_T(lds, q.ffn_w_down + (size_t)layer * DFF * 2048, DFF, 2048, (bf16_t*)(wl + WL_FFN2), -1);
            if (hy) { PA(q, hy_w_in);  convert_T(lds, q.hy_w_in + (size_t)j * 2048 * 6144, 2048, 6144, (bf16_t*)(wl + WL_MIXIN), -1);
                      PA(q, hy_w_out); convert_T(lds, q.hy_w_out + (size_t)j * 2048 * 2048, 2048, 2048, (bf16_t*)(wl + WL_MIXOUT), -1); }
            else    { PA(q, at_w_in);  convert_T(lds, q.at_w_in + (size_t)j * 2048 * QKVW, 2048, QKVW, (bf16_t*)(wl + WL_MIXIN), -1);
                      PA(q, at_w_out); convert_T(lds, q.at_w_out + (size_t)j * 1024 * 2048, 1024, 2048, (bf16_t*)(wl + WL_MIXOUT), -1); }
            PA(q, norm_mix);
            const float* modl = (const float*)(q.ws + WS_MOD) + layer * 12288;
            if (layer == 0) { PA(q, x_prompt); PA(q, x_sample); norm_rows<false, true>(q.x_prompt, q.x_sample, (bf16_t*)(q.ws + WS_XB), q.norm_mix + layer * 2048, modl, 0, 2048, (bf16_t*)(q.ws + WS_H), nullptr); }
            else            norm_rows<false, false>(nullptr, nullptr, (bf16_t*)(q.ws + WS_XB), q.norm_mix + layer * 2048, modl, 0, 2048, (bf16_t*)(q.ws + WS_H), nullptr);
            if (hy) { __syncthreads();
                pg8::Gemm g{(const bf16_t*)(q.ws + WS_W3X) + (size_t)j * 8192 * 256, (const bf16_t*)(q.ws + WS_A2X) + (size_t)j * NPOS * 256, 8192, NPOS, 256};
                pg8::StaticOrder S; S.init(8192, NPOS, pg8::ogrid(), pg8::obid());
                EpiTaps E{(_Float16*)(q.ws + WS_BIG + BIG_TAPS)};
                pg8::gemm_phase<EpiTaps, pg8::StaticOrder, false>(lds, g, S, E, nullptr); }
        }
        SEAM(pb + 0);
        for (int rep = 0, nrep = REPS(2, layer); rep < nrep; ++rep)
        if (IN(pb + 1)) {
            Params q{}; PA(q, ws);
            if (hy) { PA(q, hy_b_in); pg8::Gemm g{(const bf16_t*)(q.ws + WS_WL + WL_MIXIN), (const bf16_t*)(q.ws + WS_H), 6144, T, 2048}; pg8::StaticOrder S; S.init(6144, T, pg8::ogrid(), pg8::obid());
                EpiZinT E{(bf16_t*)(q.ws + WS_BIG + BIG_ZINT), T, q.hy_b_in + (size_t)j * 6144};
                pg8::gemm_phase<EpiZinT, pg8::StaticOrder, false>(lds, g, S, E, nullptr); }
            else { pg8::Gemm g{(const bf16_t*)(q.ws + WS_H), (const bf16_t*)(q.ws + WS_WL + WL_MIXIN), T, QKVW, 2048}; pg8::StaticOrder S; S.init(T, QKVW, pg8::ogrid(), pg8::obid());
                EpiQKV E{(bf16_t*)(q.ws + WS_BIG + BIG_QKV), (const cpx*)(q.ws + WS_ROPE)};
                pg8::gemm_phase<EpiQKV, pg8::StaticOrder, false>(lds, g, S, E, nullptr); }
            REPBAR();
        }
        SEAM(pb + 1);
        for (int rep = 0, nrep = REPS(3, layer); rep < nrep; ++rep)
        if (IN(pb + 2)) { Params q{}; PA(q, ws); if (hy) { PA(q, hy_skip); PA(q, hy_conv_w); PA(q, hy_conv_b); PA(q, hy_decay); hyena_conv_phase(q, lds, j, rep + 1 < nrep); } else attn_phase(q, lds, (rep + 1 < nrep) ? (1 | ((probe >> 12) & 2)) : 0); }
        SEAM(pb + 2);
        for (int rep = 0, nrep = REPS(4, layer); rep < nrep; ++rep)
        if (IN(pb + 3)) { Params q{}; PA(q, ws); if (hy) transpose_phase(q, lds); else attn_merge_phase(q); }
        SEAM(pb + 3);
        for (int rep = 0, nrep = REPS(5, layer); rep < nrep; ++rep)
        if (IN(pb + 4)) {
            Params q{}; PA(q, ws); PA(q, hy_b_out);
            pg8::Gemm g{(const bf16_t*)(q.ws + WS_H), (const bf16_t*)(q.ws + WS_WL + WL_MIXOUT), T, 2048, hy ? 2048 : 1024}; pg8::StaticOrder S; S.init(T, 2048, pg8::ogrid(), pg8::obid());
            EpiRes E{(bf16_t*)(q.ws + WS_XB), hy ? q.hy_b_out + (size_t)j * 2048 : nullptr, (const float*)(q.ws + WS_MOD) + layer * 12288 + 4096, rep + 1 < nrep};
            pg8::gemm_phase<EpiRes, pg8::StaticOrder, false>(lds, g, S, E, nullptr);
            REPBAR();
        }
        SEAM(pb + 4);
        for (int rep = 0, nrep = REPS(6, layer); rep < nrep; ++rep)
        if (IN(pb + 5)) { Params q{}; PA(q, ws); PA(q, norm_ffn);
            norm_rows<false, false>(nullptr, nullptr, (bf16_t*)(q.ws + WS_XB), q.norm_ffn + layer * 2048, (const float*)(q.ws + WS_MOD) + layer * 12288, 6144, 8192, (bf16_t*)(q.ws + WS_H), nullptr); }
        SEAM(pb + 5);
        for (int rep = 0, nrep = REPS(7, layer); rep < nrep; ++rep)
        if (IN(pb + 6)) {
            Params q{}; PA(q, ws);
            pg8::Gemm g{(const bf16_t*)(q.ws + WS_H), (const bf16_t*)(q.ws + WS_WL + WL_FFN1), T, 2 * DFF, 2048}; pg8::StaticOrder S; S.init(T, 2 * DFF, pg8::ogrid(), pg8::obid());
            EpiFFN1 E{(bf16_t*)(q.ws + WS_BIG + BIG_MID)};
            pg8::gemm_phase<EpiFFN1, pg8::StaticOrder, false>(lds, g, S, E, nullptr);
            REPBAR();
        }
        SEAM(pb + 6);
        for (int rep = 0, nrep = REPS(8, layer); rep < nrep; ++rep)
        if (IN(pb + 7)) {
            Params q{}; PA(q, ws);
            pg8::Gemm g{(const bf16_t*)(q.ws + WS_BIG + BIG_MID), (const bf16_t*)(q.ws + WS_WL + WL_FFN2), T, 2048, DFF}; pg8::StaticOrder S; S.init(T, 2048, pg8::ogrid(), pg8::obid());
            EpiRes E{(bf16_t*)(q.ws + WS_XB), nullptr, (const float*)(q.ws + WS_MOD) + layer * 12288 + 10240, rep + 1 < nrep};
            pg8::gemm_phase<EpiRes, pg8::StaticOrder, false>(lds, g, S, E, nullptr);
            REPBAR();
        }
        SEAM(pb + 7);
    }
    if (IN(34)) { Params q{}; PA(q, ws); PA(q, out); PA(q, final_norm); final_norm_phase(q); }
#undef REPS
#undef IN
#undef SEAM
}
}

extern "C" void kernel_launch(void* const* d_in, const int* in_sizes, int n_in, void* d_out, int out_size, void* d_ws, size_t ws_size, hipStream_t stream) {
    static int grid = 0;
    if (grid == 0) {
        if (n_in != 30 || out_size != mk::T * mk::D || ws_size < mk::WS_TOTAL) { fprintf(stderr, "kernel_launch: unexpected shapes (n_in %d out %d ws %zu need %zu); nothing launched\n", n_in, out_size, ws_size, (size_t)mk::WS_TOTAL); grid = -1; return; }
        int dev = 0, cus = 0;
        if (hipGetDevice(&dev) != hipSuccess || hipDeviceGetAttribute(&cus, hipDeviceAttributeMultiprocessorCount, dev) != hipSuccess) { grid = -1; return; }
        if (hipFuncSetAttribute((const void*)mk::mega, hipFuncAttributeMaxDynamicSharedMemorySize, mk::LDS_BYTES) != hipSuccess) { fprintf(stderr, "kernel_launch: hipFuncSetAttribute failed\n"); grid = -1; return; }
        int per_cu = 0; (void)hipOccupancyMaxActiveBlocksPerMultiprocessor(&per_cu, (const void*)mk::mega, 512, mk::LDS_BYTES); (void)hipGetLastError();
        if (per_cu < 1) fprintf(stderr, "kernel_launch: occupancy query reports %d blocks per CU\n", per_cu);
        grid = cus > 256 ? 256 : cus;
    }
    if (grid < 0) return;
    mk::Params p{};
    const float** f = (const float**)&p;
    for (int i = 0; i < 30; ++i) f[i] = (const float*)d_in[i];
    p.out = (float*)d_out; p.ws = (unsigned char*)d_ws; p.probe = MK_PROBE;
#if MK_PER_PHASE
    for (int k = 0; k < mk::NPHASE; ++k) { p.ph_lo = k; p.ph_hi = k + 1; hipLaunchKernelGGL(mk::mega, dim3(grid), dim3(512), mk::LDS_BYTES, stream, p); }
#else
    (void)hipMemsetAsync((char*)d_ws + mk::WS_CTL, 0, mk::CTL_BYTES, stream);
    p.ph_lo = 0; p.ph_hi = mk::NPHASE;
    hipLaunchKernelGGL(mk::mega, dim3(grid), dim3(512), mk::LDS_BYTES, stream, p);
#endif
}
```

```cpp
#include <hip/hip_runtime.h>
#include <cstdio>
#include <cstdint>
#include <utility>
#ifndef MK_PER_PHASE
#define MK_PER_PHASE 0
#endif
#ifndef MK_PROBE
#define MK_PROBE 0
#endif
namespace pg8 {
#define PG8_LAS __attribute__((address_space(3)))
__device__ __forceinline__ int otid() { int t = threadIdx.x; asm volatile("" : "+v"(t) :: "memory"); return t; }
__device__ __forceinline__ int obid() { int b = blockIdx.x; asm volatile("" : "+s"(b)); return b; }
__device__ __forceinline__ int ogrid() { int g = gridDim.x; asm volatile("" : "+s"(g)); return g; }
typedef unsigned short bf16_t;
typedef short bf16x8 __attribute__((ext_vector_type(8)));
typedef float f32x4 __attribute__((ext_vector_type(4)));
typedef unsigned u32x4 __attribute__((ext_vector_type(4)));
constexpr int BM = 256, BK = 64, HALF = 128, HTB = HALF * BK * 2  , STAGE_BYTES = 8 * HTB, NXCD = 8, WGM = 4;

__host__ __device__ __forceinline__ int lds_byte(int r, int c) { const int st = (r >> 4) * 2 + (c >> 5), rr = r & 15, cc = c & 31, ob = rr * 64 + cc * 2; return st * 1024 + (ob ^ (((ob >> 9) & 1) << 5)); }
__host__ __device__ __forceinline__ void stage_rc(int b, int& R, int& C) { const int st = b / 1024, sb = b % 1024, swz = sb ^ (((sb >> 9) & 1) << 5); R = (st >> 1) * 16 + swz / 64; C = (st & 1) * 32 + (swz % 64) / 2; }
__host__ __device__ __forceinline__ int perm32(int rho) { const int n = rho >> 4, i = rho & 15; return 8 * (i >> 2) + 4 * n + (i & 3); }

struct Unit { int pm, pn; };
struct Gemm { const bf16_t* A; const bf16_t* Bt; int M, N, K; };

struct StaticOrder {
    int nM, nN, nwg, G, c, wgm;
    __host__ __device__ void init(int M, int N, int G_, int c_, int wgm_ = WGM) { nM = M / BM; nN = N / BM; nwg = nM * nN; G = G_; c = c_; wgm = wgm_; }
    __host__ __device__ bool next(int i, Unit& u) const {
        const long L = (long)i * G + c; if (L >= nwg) return false;
        int wgid = (int)L; { const int q = nwg / NXCD, r = nwg % NXCD, xcd = wgid % NXCD, off = wgid / NXCD; wgid = (xcd < r ? xcd * (q + 1) : r * (q + 1) + (xcd - r) * q) + off; }
        const int nig = wgm * nN, gid = wgid / nig, fm = gid * wgm, gsz = (nM - fm) < wgm ? (nM - fm) : wgm;
        u.pm = fm + ((wgid % nig) % gsz); u.pn = (wgid % nig) / gsz; return true;
    }
    __device__ __forceinline__ void a_ready(const Unit&) const {}
    __device__ __forceinline__ void done(const Unit&) const {}
};
__device__ __forceinline__ unsigned cvt_pk_bf16(float lo, float hi) { unsigned r; asm volatile("v_cvt_pk_bf16_f32 %0, %1, %2" : "=v"(r) : "v"(lo), "v"(hi)); return r; }
template <class Epi, class Sched, bool STAMP = false>
__device__ __forceinline__ void gemm_phase(PG8_LAS unsigned char* lds, const Gemm g, const Sched& S, const Epi& E, unsigned long long* stamps) {
    const int tid = otid(), wid = __builtin_amdgcn_readfirstlane(tid >> 6), lane = tid & 63, wr = wid >> 2, wc = wid & 3, fr = lane & 15, fq = lane >> 4;
    const int K = g.K, nt = K / BK;
    int ts_lo = 0, ts_hi = 0, nts = 0; const unsigned long long rt_entry = STAMP ? (unsigned long long)wall_clock64() : 0ull;
#define PG8_STAMP() do { if (STAMP && wid == 0 && nts < 64) { const unsigned long long _c = (unsigned long long)clock64(); \
        ts_lo = (lane == nts) ? (int)(unsigned)_c : ts_lo; ts_hi = (lane == nts) ? (int)(unsigned)(_c >> 32) : ts_hi; ++nts; } } while (0)
    PG8_STAMP();
    unsigned voffA[2], voffB[2];
#pragma unroll
    for (int i = 0; i < 2; ++i) { int R, C; stage_rc(tid * 16 + i * 8192, R, C); const int Rb = Epi::PERM ? ((R & ~31) + perm32(R & 31)) : R;
        voffA[i] = (unsigned)(R * K + C) * 2u; voffB[i] = (unsigned)(Rb * K + C) * 2u; }
    const size_t kstep = (size_t)(BK * 2);
    const size_t hstep = (size_t)HALF * K * 2;
    const size_t tstep = 2 * hstep;
    const unsigned ldsw = (unsigned)wid * 1024u;
    const int aoff = lds_byte(wr * 64 + fr, fq * 8), boff = lds_byte(wc * 32 + fr, fq * 8);
#define PG8_SA(b, h) (((b) * 2 + (h)) * HTB)
#define PG8_SB(b, h) ((4 + (b) * 2 + (h)) * HTB)
#define PG8_STAGE(bufoff, gbase, voff) do { _Pragma("unroll") for (int _i = 0; _i < 2; ++_i) \
        __builtin_amdgcn_global_load_lds((const unsigned*)((const char*)(gbase) + (voff)[_i]), (PG8_LAS unsigned*)(lds + (bufoff) + ldsw + _i * 8192), 16, 0, 0); } while (0)
#define PG8_LDA(dst, b, h) do { _Pragma("unroll") for (int m = 0; m < 4; ++m) _Pragma("unroll") for (int k = 0; k < 2; ++k) dst[m][k] = *(const PG8_LAS bf16x8*)(lds + PG8_SA(b, h) + aoff + m * 2048 + k * 1024); } while (0)
#define PG8_LDB(dst, b, h) do { _Pragma("unroll") for (int n = 0; n < 2; ++n) _Pragma("unroll") for (int k = 0; k < 2; ++k) dst[n][k] = *(const PG8_LAS bf16x8*)(lds + PG8_SB(b, h) + boff + n * 2048 + k * 1024); } while (0)
#define PG8_MMA(ai, bj, At, Bt) do { __builtin_amdgcn_s_setprio(1); _Pragma("unroll") for (int m = 0; m < 4; ++m) _Pragma("unroll") for (int n = 0; n < 2; ++n) _Pragma("unroll") for (int k = 0; k < 2; ++k) \
        acc[ai][bj][m][n] = __builtin_amdgcn_mfma_f32_16x16x32_bf16(Bt[n][k], At[m][k], acc[ai][bj][m][n], 0, 0, 0); __builtin_amdgcn_s_setprio(0); } while (0)
#define PG8_WAIT_V(n) asm volatile("s_waitcnt vmcnt(" #n ")" ::: "memory")
#define PG8_WAIT_L(n) asm volatile("s_waitcnt lgkmcnt(" #n ")" ::: "memory")
#define PG8_BAR __builtin_amdgcn_s_barrier()
#define PG8_SCHED __builtin_amdgcn_sched_barrier(0)
    Unit cur, nxt; int ui = 0;
    if (!S.next(0, cur)) return;
    f32x4 acc[2][2][4][2];
#pragma unroll
    for (int a = 0; a < 2; ++a)
#pragma unroll
        for (int b = 0; b < 2; ++b)
#pragma unroll
            for (int m = 0; m < 4; ++m)
#pragma unroll
                for (int n = 0; n < 2; ++n) acc[a][b][m][n] = (f32x4){0.f, 0.f, 0.f, 0.f};
    bf16x8 At[4][2], B0[2][2], B1[2][2];
    const char* cA = (const char*)g.A + (size_t)cur.pm * tstep; const char* cB = (const char*)g.Bt + (size_t)cur.pn * tstep;
    S.a_ready(cur);
    PG8_STAGE(PG8_SB(0, 0), cB, voffB); PG8_STAGE(PG8_SA(0, 0), cA, voffA); PG8_STAGE(PG8_SB(0, 1), cB + hstep, voffB); PG8_STAGE(PG8_SA(0, 1), cA + hstep, voffA);
    if (wr == 1) PG8_BAR;
    PG8_WAIT_V(4); PG8_BAR;
    PG8_STAGE(PG8_SB(1, 0), cB + kstep, voffB); PG8_STAGE(PG8_SA(1, 0), cA + kstep, voffA); PG8_STAGE(PG8_SB(1, 1), cB + hstep + kstep, voffB);
    PG8_WAIT_V(6); PG8_BAR;
    PG8_STAMP();
    for (;;) {
        const bool has_next = S.next(ui + 1, nxt);
        const char* nA = has_next ? (const char*)g.A + (size_t)nxt.pm * tstep : cA; const char* nB = has_next ? (const char*)g.Bt + (size_t)nxt.pn * tstep : cB;
        for (int t = 0; t < nt; t += 2) {
            const bool last = (t == nt - 2);
            const char* a1 = cA + (size_t)(t + 1) * kstep;
            const char* a2 = last ? nA : cA + (size_t)(t + 2) * kstep; const char* b2 = last ? nB : cB + (size_t)(t + 2) * kstep;
            const char* a3 = a2 + kstep; const char* b3 = b2 + kstep;
            if (last && has_next) S.a_ready(nxt);
            PG8_LDB(B0, 0, 0); PG8_SCHED; PG8_LDA(At, 0, 0); PG8_STAGE(PG8_SA(1, 1), a1 + hstep, voffA);
            PG8_WAIT_L(8); PG8_BAR; PG8_WAIT_L(0); PG8_MMA(0, 0, At, B0); PG8_BAR; PG8_SCHED;
            PG8_LDB(B1, 0, 1); PG8_STAGE(PG8_SB(0, 0), b2, voffB);
            PG8_BAR; PG8_WAIT_L(0); PG8_MMA(0, 1, At, B1); PG8_BAR;
            PG8_LDA(At, 0, 1); PG8_STAGE(PG8_SA(0, 0), a2, voffA);
            PG8_BAR; PG8_WAIT_L(0); PG8_MMA(1, 0, At, B0); PG8_BAR; PG8_SCHED;
            PG8_STAGE(PG8_SB(0, 1), b2 + hstep, voffB);
            PG8_WAIT_V(6); PG8_BAR; PG8_MMA(1, 1, At, B1); PG8_BAR;
            PG8_LDB(B0, 1, 0); PG8_SCHED; PG8_LDA(At, 1, 0); PG8_STAGE(PG8_SA(0, 1), a2 + hstep, voffA);
            PG8_WAIT_L(8); PG8_BAR; PG8_WAIT_L(0); PG8_MMA(0, 0, At, B0); PG8_BAR; PG8_SCHED;
            PG8_LDB(B1, 1, 1); PG8_STAGE(PG8_SB(1, 0), b3, voffB);
            PG8_BAR; PG8_WAIT_L(0); PG8_MMA(0, 1, At, B1); PG8_BAR;
            PG8_LDA(At, 1, 1); PG8_STAGE(PG8_SA(1, 0), a3, voffA);
            PG8_BAR; PG8_WAIT_L(0); PG8_MMA(1, 0, At, B0); PG8_BAR; PG8_SCHED;
            PG8_STAGE(PG8_SB(1, 1), b3 + hstep, voffB);
            PG8_WAIT_V(6); PG8_BAR; PG8_MMA(1, 1, At, B1); PG8_BAR;
        }
        PG8_STAMP();
        if constexpr (!Epi::AFTER_DRAIN) { E(acc, cur, wr, wc, fr, fq); S.done(cur); }
        PG8_STAMP();
        if (!has_next) break;
#pragma unroll
        for (int a = 0; a < 2; ++a)
#pragma unroll
            for (int b = 0; b < 2; ++b)
#pragma unroll
                for (int m = 0; m < 4; ++m)
#pragma unroll
                    for (int n = 0; n < 2; ++n) acc[a][b][m][n] = (f32x4){0.f, 0.f, 0.f, 0.f};
        cur = nxt; cA = nA; cB = nB; ++ui;
    }
    PG8_WAIT_V(0);
    if (wr == 0) PG8_BAR;
    PG8_BAR;
    if constexpr (Epi::AFTER_DRAIN) { E.fused(acc, cur, wr, wc, fr, fq, lds, wid, lane); S.done(cur); }
    PG8_STAMP();
    if (STAMP && wid == 0) { stamps[lane] = lane < nts ? (((unsigned long long)(unsigned)ts_hi << 32) | (unsigned)ts_lo) : 0ull;
        if (lane == 62) stamps[62] = rt_entry; if (lane == 63) stamps[63] = (unsigned long long)wall_clock64(); }
#undef PG8_STAMP
#undef PG8_SA
#undef PG8_SB
#undef PG8_STAGE
#undef PG8_LDA
#undef PG8_LDB
#undef PG8_MMA
#undef PG8_WAIT_V
#undef PG8_WAIT_L
#undef PG8_BAR
#undef PG8_SCHED
}
}
#define XB_TMO      128
#define XB_XCNT(j)  (256  + 64 * (j))
#define XB_XSUB(j)  (1280 + 64 * (j))
#define XB_XGEN(j)  (2304 + 64 * (j))
#define XB_TOP      3328
#define XB_TOPGEN   3392
#define XCD_BAR_WORDS 3456
#define XB_SPIN_CAP (1u << 18)
#define LAS __attribute__((address_space(3)))

__device__ __forceinline__ unsigned xb_ld(unsigned* p)              { return __hip_atomic_load(p, __ATOMIC_RELAXED, __HIP_MEMORY_SCOPE_AGENT); }
__device__ __forceinline__ unsigned xb_add(unsigned* p, unsigned v) { return __hip_atomic_fetch_add(p, v, __ATOMIC_RELAXED, __HIP_MEMORY_SCOPE_AGENT); }
__device__ __forceinline__ unsigned xb_xcc_id() { return (unsigned)__builtin_amdgcn_s_getreg((3 << 11) | 20) & 0xFu; }
#define XB_SPIN(cond, bar) do { unsigned _sp = 0; while (cond) { __builtin_amdgcn_s_sleep(1); \
    if ((++_sp & 255u) == 0u) { if (xb_ld(&(bar)[XB_TMO])) break; if (_sp > XB_SPIN_CAP) { atomicAdd(&(bar)[XB_TMO], 1u); break; } } } } while (0)

struct XcdBarrier {
    unsigned* bar; unsigned x;
    volatile LAS unsigned* st;
};

__device__ __forceinline__ XcdBarrier xcd_barrier_post(unsigned* bar, volatile LAS unsigned* st) {
    XcdBarrier b; b.bar = bar; b.x = xb_xcc_id(); b.st = st;
    if (threadIdx.x == 0) (void)xb_add(&bar[XB_XCNT(b.x)], 1u);
    return b;
}
__device__ __forceinline__ void xcd_barrier_complete(unsigned* bar, unsigned x, unsigned& nloc, unsigned& nx) {
    const unsigned G = gridDim.x * gridDim.y * gridDim.z;
    unsigned sum, cnt, mine, sp = 0u;
    for (;;) {
        sum = 0u; cnt = 0u; mine = 0u;
#pragma unroll
        for (unsigned j = 0; j < 16; ++j) { const unsigned c = xb_ld(&bar[XB_XCNT(j)]); sum += c; cnt += (c > 0u) ? 1u : 0u; mine = (j == x) ? c : mine; }
        if (sum == G) break;
        __builtin_amdgcn_s_sleep(1);
        if ((++sp & 255u) == 0u) { if (xb_ld(&bar[XB_TMO])) break; if (sp > XB_SPIN_CAP) { atomicAdd(&bar[XB_TMO], 1u); break; } }
    }
    nloc = mine > 0u ? mine : 1u; nx = cnt > 0u ? cnt : 1u;
}

__device__ __forceinline__ void xcd_barrier(const XcdBarrier& b) {
    asm volatile("s_waitcnt vmcnt(0)" ::: "memory");
    __syncthreads();
    if (threadIdx.x == 0) {
        unsigned* bar = b.bar;
        __builtin_amdgcn_s_waitcnt(0);
        unsigned nloc = b.st[0], nx = b.st[1];
        if (nloc == 0u) { xcd_barrier_complete(bar, b.x, nloc, nx); b.st[0] = nloc; b.st[1] = nx; }
        const unsigned old = xb_add(&bar[XB_XSUB(b.x)], 1u);
        const unsigned gen = old / nloc;
        if (old + 1u == (gen + 1u) * nloc) {
            __builtin_amdgcn_fence(__ATOMIC_RELEASE, "agent");
            asm volatile("s_waitcnt vmcnt(0)" ::: "memory");
            const unsigned og = xb_add(&bar[XB_TOP], 1u);
            const unsigned tg = og / nx;
            if (og + 1u == (tg + 1u) * nx) xb_add(&bar[XB_TOPGEN], 1u);
            else XB_SPIN(xb_ld(&bar[XB_TOPGEN]) == tg, bar);
            __builtin_amdgcn_fence(__ATOMIC_ACQUIRE, "agent");
            xb_add(&bar[XB_XGEN(b.x)], 1u);
            asm volatile("s_waitcnt vmcnt(0)" ::: "memory");
        } else {
            XB_SPIN(xb_ld(&bar[XB_XGEN(b.x)]) == gen, bar);
            __builtin_amdgcn_fence(__ATOMIC_ACQUIRE, "agent");
            asm volatile("s_waitcnt vmcnt(0)" ::: "memory");
        }
    }
    __syncthreads();
}


namespace mk {
using pg8::bf16_t; using pg8::bf16x8; using pg8::f32x4; using pg8::u32x4; using pg8::Unit; using pg8::cvt_pk_bf16;
typedef unsigned u32x2 __attribute__((ext_vector_type(2)));
typedef float cpx __attribute__((ext_vector_type(2)));
__host__ __device__ __forceinline__ cpx mkc(float a, float b) { cpx r; r.x = a; r.y = b; return r; }

constexpr int D = 2048, T_P = 32768, T_S = 8192, T = 40960, L_P = 16384, L_S = 2048, DFF = 5632;
constexpr int NTHR = 512;
constexpr int MODW = 53248;
constexpr int NPOS = 18432;
constexpr int QKVW = 9216;
constexpr float EPS = 1e-6f;
constexpr float QSCALE = 0.12751743082459868f;
constexpr int LDS_BYTES = 147456;
constexpr int LDS_MISC = 147456 - 256;

constexpr size_t al256(size_t x) { return (x + 255) & ~(size_t)255; }
constexpr size_t WS_CTL  = 0;
constexpr size_t CTL_BYTES = 65536;
constexpr size_t WS_PART = WS_CTL + CTL_BYTES;
constexpr size_t WS_MOD  = WS_PART + al256((size_t)8 * 6 * MODW * 4);
constexpr size_t WS_ROPE = WS_MOD + al256((size_t)6 * MODW * 4);
constexpr size_t WS_A2X  = WS_ROPE + (size_t)16384 * 16 * 8;
constexpr size_t WS_W3X  = WS_A2X + (size_t)2 * NPOS * 256 * 2;
constexpr size_t WS_WL   = WS_W3X + (size_t)2 * 8192 * 256 * 2;
constexpr size_t WL_FFN1 = 0;
constexpr size_t WL_FFN2 = WL_FFN1 + (size_t)11264 * 2048 * 2;
constexpr size_t WL_MIXIN = WL_FFN2 + (size_t)2048 * 5632 * 2;
constexpr size_t WL_MIXOUT = WL_MIXIN + (size_t)9216 * 2048 * 2;
constexpr size_t WL_BYTES = WL_MIXOUT + (size_t)2048 * 2048 * 2;
constexpr size_t WS_H    = WS_WL + WL_BYTES;
constexpr size_t H_BYTES = (size_t)T * 2048 * 2;
constexpr size_t WS_BIG  = WS_H + H_BYTES;
constexpr size_t BIG_ZINT = 0;
constexpr size_t BIG_TAPS = BIG_ZINT + (size_t)6144 * T * 2;
constexpr size_t BIG_HY_END = BIG_TAPS + (size_t)8192 * NPOS * 2;
constexpr size_t BIG_QKV = 0;
constexpr size_t BIG_OG  = BIG_QKV + (size_t)T * QKVW * 2;
constexpr size_t BIG_LSE = BIG_OG + (size_t)3 * T * 1024 * 2;
constexpr size_t BIG_AT_END = BIG_LSE + (size_t)3 * T * 8 * 4;
constexpr size_t BIG_MID = 0;
constexpr size_t BIG_BYTES = BIG_HY_END > BIG_AT_END ? BIG_HY_END : BIG_AT_END;
constexpr size_t WS_END  = WS_BIG + BIG_BYTES;
constexpr size_t FFT_SCR_PER_WG = 5 * 131072;
constexpr size_t FFT_EXT_PER_WG = 2 * 65536;
constexpr size_t WS_XB = WS_END + (size_t)256 * FFT_EXT_PER_WG;
constexpr size_t WS_TOTAL = WS_XB + (size_t)T * 2048 * 2;
static_assert(256 * FFT_SCR_PER_WG <= H_BYTES, "fft scratch must fit in H");

struct Params {
    const float *x_prompt, *x_sample, *c_prompt, *c_sample, *ada_w, *ada_b, *norm_mix, *norm_ffn;
    const float *hy_w_in, *hy_b_in, *hy_conv_w, *hy_conv_b, *hy_fw1, *hy_fb1, *hy_ffreq, *hy_fw2, *hy_fb2, *hy_fw3, *hy_decay, *hy_skip, *hy_w_out, *hy_b_out;
    const float *at_w_in, *at_w_out, *ffn_w_gate, *ffn_w_up, *ffn_w_down, *final_norm, *final_ada_w, *final_ada_b;
    float* out; unsigned char* ws; int ph_lo, ph_hi, probe, pad0;
};

#define LDSQ __attribute__((address_space(3)))

__device__ __forceinline__ float bf2f(bf16_t b) { return __uint_as_float(((unsigned)b) << 16); }
__device__ __forceinline__ bf16_t f2bf(float f) { unsigned u = __float_as_uint(f); u += 0x7FFFu + ((u >> 16) & 1u); return (bf16_t)(u >> 16); }
__device__ __forceinline__ int seq_of_row(int row) { return row < T_P ? (row >> 14) : 2 + ((row - T_P) >> 11); }
__device__ __forceinline__ int pos_of_row(int row) { return row < T_P ? (row & 16383) : (row & 2047); }
__device__ __forceinline__ float wave_sum(float v) {
#pragma unroll
    for (int o = 32; o >= 1; o >>= 1) v += __shfl_xor(v, o);
    return v;
}

struct EpiZinT {
    static constexpr bool PERM = true, AFTER_DRAIN = false;
    bf16_t* O; int ldc; const float* bias;
    __device__ __forceinline__ void operator()(const f32x4 (&acc)[2][2][4][2], const Unit& u, int wr, int wc, int fr, int fq) const {
        const int row0 = u.pm * 256 + wr * 64 + fr, col0 = u.pn * 256 + wc * 32 + 8 * fq;
        float bs[8];
#pragma unroll
        for (int r = 0; r < 8; ++r) bs[r] = bias[row0 + (r >> 2) * 128 + (r & 3) * 16];
#pragma unroll
        for (int ai = 0; ai < 2; ++ai)
#pragma unroll
            for (int m = 0; m < 4; ++m) { const int r = row0 + ai * 128 + m * 16; const float b = bs[ai * 4 + m]; bf16_t* rowp = O + (size_t)r * ldc + col0;
#pragma unroll
                for (int bj = 0; bj < 2; ++bj) { const f32x4 v0 = acc[ai][bj][m][0] + b, v1 = acc[ai][bj][m][1] + b;
                    u32x4 w; w.x = cvt_pk_bf16(v0[0], v0[1]); w.y = cvt_pk_bf16(v0[2], v0[3]); w.z = cvt_pk_bf16(v1[0], v1[1]); w.w = cvt_pk_bf16(v1[2], v1[3]);
                    *(u32x4*)(rowp + bj * 128) = w; } }
    }
};
struct EpiRes {
    static constexpr bool PERM = true, AFTER_DRAIN = false;
    bf16_t* X; const float* bias; const float* gate; int dry;
    __device__ __forceinline__ void operator()(const f32x4 (&acc)[2][2][4][2], const Unit& u, int wr, int wc, int fr, int fq) const {
        const int row0 = u.pm * 256 + wr * 64 + fr, col0 = u.pn * 256 + wc * 32 + 8 * fq;
        const float* gp = gate + (size_t)seq_of_row(u.pm * 256) * MODW + col0;
        bf16_t* xb = X + (size_t)row0 * 2048 + col0;
        u32x4 xv[2][4]; f32x4 gv[2][2], bv[2][2];
#pragma unroll
        for (int m4 = 0; m4 < 4; ++m4) xv[0][m4] = *(const u32x4*)(xb + (size_t)(m4 * 16) * 2048);
#pragma unroll
        for (int n = 0; n < 2; ++n) { gv[0][n] = *(const f32x4*)(gp + 4 * n); bv[0][n] = bias ? *(const f32x4*)(bias + col0 + 4 * n) : (f32x4){0.f, 0.f, 0.f, 0.f}; }
#pragma unroll
        for (int c = 0; c < 4; ++c) { const int bj = c >> 1, ai = c & 1;
            if (c < 3) { const int bj2 = (c + 1) >> 1, ai2 = (c + 1) & 1;
#pragma unroll
                for (int m4 = 0; m4 < 4; ++m4) xv[(c + 1) & 1][m4] = *(const u32x4*)(xb + (size_t)(ai2 * 128 + m4 * 16) * 2048 + bj2 * 128);
                if (c == 1) {
#pragma unroll
                    for (int n = 0; n < 2; ++n) { gv[1][n] = *(const f32x4*)(gp + 128 + 4 * n); bv[1][n] = bias ? *(const f32x4*)(bias + col0 + 128 + 4 * n) : (f32x4){0.f, 0.f, 0.f, 0.f}; } } }
#pragma unroll
            for (int m4 = 0; m4 < 4; ++m4) { const u32x4 xo = xv[c & 1][m4];
                const f32x4 xa = {__uint_as_float(xo.x << 16), __uint_as_float(xo.x & 0xffff0000u), __uint_as_float(xo.y << 16), __uint_as_float(xo.y & 0xffff0000u)};
                const f32x4 xc = {__uint_as_float(xo.z << 16), __uint_as_float(xo.z & 0xffff0000u), __uint_as_float(xo.w << 16), __uint_as_float(xo.w & 0xffff0000u)};
                const f32x4 ya = xa + gv[bj][0] * (acc[ai][bj][m4][0] + bv[bj][0]), yc = xc + gv[bj][1] * (acc[ai][bj][m4][1] + bv[bj][1]);
                u32x4 w; w.x = cvt_pk_bf16(ya[0], ya[1]); w.y = cvt_pk_bf16(ya[2], ya[3]); w.z = cvt_pk_bf16(yc[0], yc[1]); w.w = cvt_pk_bf16(yc[2], yc[3]);
                if (!dry) *(u32x4*)(xb + (size_t)(ai * 128 + m4 * 16) * 2048 + bj * 128) = w; } }
    }
};
struct EpiQKV {
    static constexpr bool PERM = true, AFTER_DRAIN = false;
    bf16_t* O; const cpx* rope;
    __device__ __forceinline__ void operator()(const f32x4 (&acc)[2][2][4][2], const Unit& u, int wr, int wc, int fr, int fq) const {
        const int row0 = u.pm * 256 + wr * 64 + fr, colt = u.pn * 256, col0 = colt + wc * 32 + 8 * fq;
        const int sidx = (colt % 3072) >> 10;
        const bool dorope = (sidx < 2) && (wc == 0);
        const float qs = (sidx == 0) ? QSCALE : 1.0f;
        f32x4 tt[2][4];
        if (dorope) { const cpx* rp = rope + (size_t)pos_of_row(row0) * 16 + 8 * (fq & 1);
            tt[0][0] = *(const f32x4*)(rp); tt[0][1] = *(const f32x4*)(rp + 2); tt[0][2] = *(const f32x4*)(rp + 4); tt[0][3] = *(const f32x4*)(rp + 6); }
#pragma unroll
        for (int g = 0; g < 8; ++g) { const int ai = g >> 2, m = g & 3; const int r = row0 + ai * 128 + m * 16; bf16_t* rowp = O + (size_t)r * QKVW + col0;
            f32x4 c0, c1, s0, s1;
            if (dorope) {
                if (g < 7) { const int r2 = row0 + ((g + 1) >> 2) * 128 + ((g + 1) & 3) * 16; const cpx* rp = rope + (size_t)pos_of_row(r2) * 16 + 8 * (fq & 1);
                    tt[(g + 1) & 1][0] = *(const f32x4*)(rp); tt[(g + 1) & 1][1] = *(const f32x4*)(rp + 2); tt[(g + 1) & 1][2] = *(const f32x4*)(rp + 4); tt[(g + 1) & 1][3] = *(const f32x4*)(rp + 6); }
                const f32x4 t0 = tt[g & 1][0], t1 = tt[g & 1][1], t2 = tt[g & 1][2], t3 = tt[g & 1][3];
                c0 = (f32x4){t0[0], t0[2], t1[0], t1[2]}; s0 = (f32x4){t0[1], t0[3], t1[1], t1[3]};
                c1 = (f32x4){t2[0], t2[2], t3[0], t3[2]}; s1 = (f32x4){t2[1], t2[3], t3[1], t3[3]}; }
#pragma unroll
            for (int bj = 0; bj < 2; ++bj) { f32x4 v0 = acc[ai][bj][m][0], v1 = acc[ai][bj][m][1];
                if (dorope) { f32x4 p0, p1;
#pragma unroll
                    for (int e = 0; e < 4; ++e) { p0[e] = __shfl_xor(v0[e], 32); p1[e] = __shfl_xor(v1[e], 32); }
                    if (fq < 2) { v0 = v0 * c0 - p0 * s0; v1 = v1 * c1 - p1 * s1; }
                    else        { v0 = v0 * c0 + p0 * s0; v1 = v1 * c1 + p1 * s1; } }
                v0 *= qs; v1 *= qs;
                u32x4 w; w.x = cvt_pk_bf16(v0[0], v0[1]); w.y = cvt_pk_bf16(v0[2], v0[3]); w.z = cvt_pk_bf16(v1[0], v1[1]); w.w = cvt_pk_bf16(v1[2], v1[3]);
                *(u32x4*)(rowp + bj * 128) = w; } }
    }
};
struct EpiFFN1 {
    static constexpr bool PERM = true, AFTER_DRAIN = false;
    bf16_t* O;
    __device__ __forceinline__ void operator()(const f32x4 (&acc)[2][2][4][2], const Unit& u, int wr, int wc, int fr, int fq) const {
        const int row0 = u.pm * 256 + wr * 64 + fr, col0 = u.pn * 128 + wc * 32 + 8 * fq;
#pragma unroll
        for (int ai = 0; ai < 2; ++ai)
#pragma unroll
            for (int m = 0; m < 4; ++m) { bf16_t* rowp = O + (size_t)(row0 + ai * 128 + m * 16) * DFF + col0; float o[8];
#pragma unroll
                for (int n = 0; n < 2; ++n)
#pragma unroll
                    for (int e = 0; e < 4; ++e) { const float g = acc[ai][0][m][n][e], up = acc[ai][1][m][n][e]; o[n * 4 + e] = g * __builtin_amdgcn_rcpf(1.0f + __expf(-g)) * up; }
                u32x4 w; w.x = cvt_pk_bf16(o[0], o[1]); w.y = cvt_pk_bf16(o[2], o[3]); w.z = cvt_pk_bf16(o[4], o[5]); w.w = cvt_pk_bf16(o[6], o[7]);
                *(u32x4*)rowp = w; }
    }
};
struct EpiTaps {
    static constexpr bool PERM = true, AFTER_DRAIN = false;
    _Float16* O;
    __device__ __forceinline__ void operator()(const f32x4 (&acc)[2][2][4][2], const Unit& u, int wr, int wc, int fr, int fq) const {
        typedef _Float16 h8 __attribute__((ext_vector_type(8)));
        const int row0 = u.pm * 256 + wr * 64 + fr, col0 = u.pn * 256 + wc * 32 + 8 * fq;
#pragma unroll
        for (int ai = 0; ai < 2; ++ai)
#pragma unroll
            for (int m = 0; m < 4; ++m) { _Float16* rowp = O + (size_t)(row0 + ai * 128 + m * 16) * NPOS + col0;
#pragma unroll
                for (int bj = 0; bj < 2; ++bj) { const f32x4 v0 = acc[ai][bj][m][0], v1 = acc[ai][bj][m][1]; h8 w;
                    w[0] = (_Float16)v0[0]; w[1] = (_Float16)v0[1]; w[2] = (_Float16)v0[2]; w[3] = (_Float16)v0[3]; w[4] = (_Float16)v1[0]; w[5] = (_Float16)v1[1]; w[6] = (_Float16)v1[2]; w[7] = (_Float16)v1[3];
                    *(h8*)(rowp + bj * 128) = w; } }
    }
};

__device__ __forceinline__ void ada_partials(const Params& p, LDSQ unsigned char* lds) {
    LDSQ float* cs = (LDSQ float*)lds;
    for (int i = pg8::otid(); i < 6 * 2048; i += NTHR) { const int b = i >> 11, k = i & 2047; const float c = b < 2 ? p.c_prompt[b * 2048 + k] : p.c_sample[(b - 2) * 2048 + k]; cs[i] = c / (1.0f + expf(-c)); }
    __syncthreads();
    float* part = (float*)(p.ws + WS_PART);
    for (int item = pg8::obid() * NTHR + pg8::otid(); item < 8 * 13312; item += pg8::ogrid() * NTHR) {
        const int chunk = item / 13312, c4 = item % 13312;
        const float* W; int ldw;
        if (c4 < 12288) { const int layer = c4 / 3072, col = (c4 % 3072) * 4; W = p.ada_w + (size_t)layer * 2048 * 12288 + col; ldw = 12288; }
        else { W = p.final_ada_w + (c4 - 12288) * 4; ldw = 4096; }
        f32x4 a0 = {0.f, 0.f, 0.f, 0.f}, a1 = a0, a2 = a0, a3 = a0, a4 = a0, a5 = a0;
        const int k0 = chunk * 256;
#pragma unroll 8
        for (int k = k0; k < k0 + 256; ++k) { const f32x4 w = *(const f32x4*)(W + (size_t)k * ldw);
            a0 += cs[k] * w; a1 += cs[2048 + k] * w; a2 += cs[4096 + k] * w; a3 += cs[6144 + k] * w; a4 += cs[8192 + k] * w; a5 += cs[10240 + k] * w; }
        float* o = part + (size_t)chunk * 6 * MODW + (size_t)c4 * 4;
        *(f32x4*)(o) = a0; *(f32x4*)(o + MODW) = a1; *(f32x4*)(o + 2 * MODW) = a2; *(f32x4*)(o + 3 * MODW) = a3; *(f32x4*)(o + 4 * MODW) = a4; *(f32x4*)(o + 5 * MODW) = a5;
    }
    __syncthreads();
}
__device__ __forceinline__ void ada_reduce(const Params& p) {
    const float* part = (const float*)(p.ws + WS_PART); float* mod = (float*)(p.ws + WS_MOD);
    for (int i = pg8::obid() * NTHR + pg8::otid(); i < 6 * MODW; i += pg8::ogrid() * NTHR) {
        const int c = i % MODW; float s = c < 49152 ? p.ada_b[c] : p.final_ada_b[c - 49152];
#pragma unroll
        for (int ch = 0; ch < 8; ++ch) s += part[(size_t)ch * 6 * MODW + i];
        mod[i] = s;
    }
}
__device__ __forceinline__ void rope_table(const Params& p) {
    cpx* rope = (cpx*)(p.ws + WS_ROPE);
    for (int i = pg8::obid() * NTHR + pg8::otid(); i < 16384 * 16; i += pg8::ogrid() * NTHR) {
        const int pos = i >> 4, f = i & 15; const float inv = powf(500000.0f, -(float)f / 16.0f); const float ang = (float)pos * inv;
        float s, c; sincosf(ang, &s, &c); rope[i] = mkc(c, s);
    }
}
__device__ __forceinline__ void filter_mlp(const Params& p) {
    const int lane = pg8::otid() & 63, gw = pg8::obid() * 8 + (pg8::otid() >> 6);
    bf16_t* a2x = (bf16_t*)(p.ws + WS_A2X);
    for (int q = gw; q < 2 * NPOS; q += pg8::ogrid() * 8) {
        const int j = q / NPOS, r = q % NPOS; const int L = r < 16384 ? 16384 : 2048, pos = r < 16384 ? r : r - 16384;
        const float fpos = (float)pos;
        float z = 0.f;
        if (lane == 0) z = fpos / (float)(L - 1);
        else if (lane <= 32) { const int bi = (lane - 1) & 15; const float band = 1e-4f + (float)bi * ((15.0f - 1e-4f) / 15.0f);
            const float ang = ((6.283185307179586f * fpos) * band) / (float)L; z = lane <= 16 ? cosf(ang) : -sinf(ang); }
        const float* w1 = p.hy_fw1 + j * 33 * 64; const float* w2 = p.hy_fw2 + j * 64 * 64;
        float acc = p.hy_fb1[j * 64 + lane];
#pragma unroll
        for (int m = 0; m < 33; ++m) acc += __shfl(z, m) * w1[m * 64 + lane];
        const float a1 = sinf(p.hy_ffreq[j * 128 + lane] * acc);
        acc = p.hy_fb2[j * 64 + lane];
#pragma unroll
        for (int m = 0; m < 64; ++m) acc += __shfl(a1, m) * w2[m * 64 + lane];
        const float a2 = sinf(p.hy_ffreq[j * 128 + 64 + lane] * acc);
        const bf16_t hi = f2bf(a2), lo = f2bf(a2 - bf2f(hi));
        bf16_t* o = a2x + ((size_t)j * NPOS + r) * 256;
        o[lane] = hi; o[64 + lane] = hi; o[128 + lane] = lo; o[192 + lane] = 0;
    }
    bf16_t* w3x = (bf16_t*)(p.ws + WS_W3X);
    for (int i = pg8::obid() * NTHR + pg8::otid(); i < 2 * 8192 * 64; i += pg8::ogrid() * NTHR) {
        const int k = i & 63, col = (i >> 6) & 8191, j = i >> 19;
        const float v = p.hy_fw3[(size_t)j * 64 * 8192 + (size_t)k * 8192 + col];
        const bf16_t hi = f2bf(v), lo = f2bf(v - bf2f(hi));
        bf16_t* o = w3x + ((size_t)j * 8192 + col) * 256;
        o[k] = hi; o[64 + k] = lo; o[128 + k] = hi; o[192 + k] = 0;
    }
}
__device__ __forceinline__ void convert_T(LDSQ unsigned char* lds, const float* src, int K, int N, bf16_t* dst, int ffs) {
    LDSQ float* tile = (LDSQ float*)lds;
    const int tid = pg8::otid(), ntn = N >> 8, ntiles = (K >> 6) * ntn, stride = pg8::ogrid();
    const int r = tid >> 6, c4 = tid & 63;
    f32x4 v[8];
    int ti = pg8::obid();
    if (ti < ntiles) { const int tk = ti / ntn, tn = ti % ntn;
#pragma unroll
        for (int it = 0; it < 8; ++it) v[it] = *(const f32x4*)(src + (size_t)(tk * 64 + r + 8 * it) * N + tn * 256 + 4 * c4); }
    for (; ti < ntiles; ti += stride) {
        const int tk = ti / ntn, tn = ti % ntn;
#pragma unroll
        for (int it = 0; it < 8; ++it) { LDSQ float* tp = tile + (r + 8 * it) * 257 + 4 * c4; tp[0] = v[it][0]; tp[1] = v[it][1]; tp[2] = v[it][2]; tp[3] = v[it][3]; }
        __syncthreads();
        if (ti + stride < ntiles) { const int t2 = ti + stride, tk2 = t2 / ntn, tn2 = t2 % ntn;
#pragma unroll
            for (int it = 0; it < 8; ++it) v[it] = *(const f32x4*)(src + (size_t)(tk2 * 64 + r + 8 * it) * N + tn2 * 256 + 4 * c4); }
        { const int n = tid >> 1, kh = tid & 1; const int nn = tn * 256 + n; const int row = ffs < 0 ? nn : (256 * (nn >> 7) + 128 * ffs + (nn & 127));
          bf16_t* dp = dst + (size_t)row * K + tk * 64 + kh * 32;
#pragma unroll
          for (int q = 0; q < 4; ++q) { float f[8];
#pragma unroll
              for (int e = 0; e < 8; ++e) f[e] = tile[(kh * 32 + q * 8 + e) * 257 + n];
              u32x4 w; w.x = cvt_pk_bf16(f[0], f[1]); w.y = cvt_pk_bf16(f[2], f[3]); w.z = cvt_pk_bf16(f[4], f[5]); w.w = cvt_pk_bf16(f[6], f[7]);
              *(u32x4*)(dp + q * 8) = w; } }
        __syncthreads();
    }
}
template <bool FINAL, bool SRC_F32> __device__ __forceinline__ void norm_rows(const float* xp, const float* xs, bf16_t* xb, const float* g, const float* modl, int sh_off, int sc_off, bf16_t* H, float* outf) {
    const int lane = pg8::otid() & 63, gw = pg8::obid() * 8 + (pg8::otid() >> 6), nw = pg8::ogrid() * 8;
    const int rpw = (T + nw - 1) / nw, r0 = gw * rpw, r1 = (r0 + rpw < T) ? r0 + rpw : T;
    if (r0 >= r1) return;
    f32x4 gs[8], sh[8]; int curseq = -1;
    struct RowBuf { f32x4 f[SRC_F32 ? 8 : 1]; u32x2 b[SRC_F32 ? 1 : 8]; };
    auto request = [&](RowBuf& B, int row) {
        if (SRC_F32) { const f32x4* src = (const f32x4*)(row < T_P ? xp + (size_t)row * 2048 : xs + (size_t)(row - T_P) * 2048);
#pragma unroll
            for (int i = 0; i < 8; ++i) B.f[i] = src[lane + 64 * i]; }
        else { const u32x2* src = (const u32x2*)(xb + (size_t)row * 2048);
#pragma unroll
            for (int i = 0; i < 8; ++i) B.b[i] = src[lane + 64 * i]; } };
    auto process = [&](RowBuf& B, int row, int next) {
        f32x4 v[8];
#pragma unroll
        for (int i = 0; i < 8; ++i) { if (SRC_F32) v[i] = B.f[i]; else v[i] = (f32x4){__uint_as_float(B.b[i].x << 16), __uint_as_float(B.b[i].x & 0xffff0000u), __uint_as_float(B.b[i].y << 16), __uint_as_float(B.b[i].y & 0xffff0000u)}; }
        if (next < r1) request(B, next);
        const int seq = seq_of_row(row);
        if (seq != curseq) { curseq = seq; const float* mod = modl + (size_t)seq * MODW;
#pragma unroll
            for (int i = 0; i < 8; ++i) { const int col = (lane + 64 * i) * 4; gs[i] = *(const f32x4*)(g + col); sh[i] = *(const f32x4*)(mod + sc_off + col); }
#pragma unroll
            for (int i = 0; i < 8; ++i) { const int col = (lane + 64 * i) * 4; const f32x4 sft = *(const f32x4*)(mod + sh_off + col); gs[i] = gs[i] * (1.0f + sh[i]); sh[i] = sft; } }
        float ss = 0.f;
#pragma unroll
        for (int i = 0; i < 8; ++i) ss += v[i][0] * v[i][0] + v[i][1] * v[i][1] + v[i][2] * v[i][2] + v[i][3] * v[i][3];
        ss = wave_sum(ss);
        const float rstd = 1.0f / sqrtf(ss * (1.0f / 2048.0f) + EPS);
#pragma unroll
        for (int i = 0; i < 8; ++i) { const int col = (lane + 64 * i) * 4;
            const f32x4 h = (v[i] * rstd) * gs[i] + sh[i];
            if (FINAL) *(f32x4*)(outf + (size_t)row * 2048 + col) = h;
            else { u32x2 w; w.x = cvt_pk_bf16(h[0], h[1]); w.y = cvt_pk_bf16(h[2], h[3]); *(u32x2*)(H + (size_t)row * 2048 + col) = w;
                if (SRC_F32) { u32x2 c; c.x = cvt_pk_bf16(v[i][0], v[i][1]); c.y = cvt_pk_bf16(v[i][2], v[i][3]); *(u32x2*)(xb + (size_t)row * 2048 + col) = c; } } } };
    if (SRC_F32) {
        RowBuf B0, B1;
        request(B0, r0); if (r0 + 1 < r1) request(B1, r0 + 1);
        for (int row = r0; row < r1; row += 2) { process(B0, row, row + 2); if (row + 1 < r1) process(B1, row + 1, row + 3); }
    } else {
        RowBuf B0, B1, B2;
        request(B0, r0); if (r0 + 1 < r1) request(B1, r0 + 1); if (r0 + 2 < r1) request(B2, r0 + 2);
        for (int row = r0; row < r1; row += 3) {
            process(B0, row, row + 3);
            if (row + 1 < r1) process(B1, row + 1, row + 4);
            if (row + 2 < r1) process(B2, row + 2, row + 5);
        }
    }
}
__device__ __forceinline__ void final_norm_phase(const Params& p) {
    norm_rows<true, false>(nullptr, nullptr, (bf16_t*)(p.ws + WS_XB), p.final_norm, (const float*)(p.ws + WS_MOD) + 49152, 0, 2048, nullptr, p.out);
}
__device__ __forceinline__ void transpose_phase(const Params& p, LDSQ unsigned char* lds) {
    LDSQ bf16_t* tile = (LDSQ bf16_t*)lds;
    const bf16_t* zin = (const bf16_t*)(p.ws + WS_BIG + BIG_ZINT); bf16_t* H = (bf16_t*)(p.ws + WS_H);
    const int tid = pg8::otid(), stride = pg8::ogrid();
    const int cr = tid >> 5, tq = tid & 31;
    u32x4 v[4];
    int ti = pg8::obid();
    if (ti < 32 * 160) { const int tc = ti / 160, tt = ti % 160;
#pragma unroll
        for (int it = 0; it < 4; ++it) v[it] = *(const u32x4*)(zin + (size_t)(tc * 64 + cr + 16 * it) * T + tt * 256 + tq * 8); }
    for (; ti < 32 * 160; ti += stride) {
        const int tc = ti / 160, tt = ti % 160;
#pragma unroll
        for (int it = 0; it < 4; ++it) *(LDSQ u32x4*)(tile + (cr + 16 * it) * 264 + tq * 8) = v[it];
        __syncthreads();
        if (ti + stride < 32 * 160) { const int t2 = ti + stride, tc2 = t2 / 160, tt2 = t2 % 160;
#pragma unroll
            for (int it = 0; it < 4; ++it) v[it] = *(const u32x4*)(zin + (size_t)(tc2 * 64 + cr + 16 * it) * T + tt2 * 256 + tq * 8); }
        { const int cq = tid & 7, tk = tid >> 3;
#pragma unroll
          for (int it = 0; it < 4; ++it) { const int tok = tk + 64 * it; unsigned w[4];
#pragma unroll
              for (int e = 0; e < 4; ++e) { const unsigned lo = tile[(cq * 8 + 2 * e) * 264 + tok], hi = tile[(cq * 8 + 2 * e + 1) * 264 + tok]; w[e] = lo | (hi << 16); }
              *(u32x4*)(H + (size_t)(tt * 256 + tok) * 2048 + tc * 64 + cq * 8) = (u32x4){w[0], w[1], w[2], w[3]}; } }
        __syncthreads();
    }
}

__host__ __device__ constexpr float cos64q(int k) {
    constexpr float t[17] = {1.0f, 0.99518472667219693f, 0.98078528040323043f, 0.95694033573220882f, 0.92387953251128674f, 0.88192126434835505f, 0.83146961230254524f,
        0.77301045336273699f, 0.70710678118654757f, 0.63439328416364549f, 0.55557023301960229f, 0.47139673682599781f, 0.38268343236508984f, 0.29028467725446233f,
        0.19509032201612833f, 0.09801714032956077f, 0.0f};
    return t[k];
}
__host__ __device__ constexpr float cos64(int k) { k &= 63; return k <= 16 ? cos64q(k) : k <= 32 ? -cos64q(32 - k) : k <= 48 ? -cos64q(k - 32) : cos64q(64 - k); }
__host__ __device__ constexpr float sin64(int k) { return cos64((k + 48) & 63); }
template <int R> __host__ __device__ constexpr int brev(int k) { int r = 0; for (int b = 1; b < R; b <<= 1) { r = (r << 1) | (k & 1); k >>= 1; } return r; }

typedef _Float16 hcpx __attribute__((ext_vector_type(2)));
typedef _Float16 hcpx2 __attribute__((ext_vector_type(4)));
__device__ __forceinline__ hcpx h_of(cpx a) { hcpx r; r.x = (_Float16)a.x; r.y = (_Float16)a.y; return r; }
__device__ __forceinline__ cpx c_of(hcpx a) { return mkc((float)a.x, (float)a.y); }
__device__ __forceinline__ hcpx2 h2_of(cpx a, cpx b) { hcpx2 r; r.x = (_Float16)a.x; r.y = (_Float16)a.y; r.z = (_Float16)b.x; r.w = (_Float16)b.y; return r; }
#define VA __device__ __forceinline__ float
VA f_mul(float a, float b) { float r; asm("v_mul_f32_e32 %0, %1, %2" : "=v"(r) : "v"(a), "v"(b)); return r; }
VA f_fma(float a, float b, float c) { float r; asm("v_fma_f32 %0, %1, %2, %3" : "=v"(r) : "v"(a), "v"(b), "v"(c)); return r; }
VA f_fms(float a, float b, float c) { float r; asm("v_fma_f32 %0, %1, %2, -%3" : "=v"(r) : "v"(a), "v"(b), "v"(c)); return r; }
#undef VA
__device__ __forceinline__ cpx cmul(cpx a, cpx b) { float rx, ry;
    asm("v_mul_f32_e32 %0, %3, %5\n\tv_mul_f32_e32 %1, %3, %4\n\tv_fma_f32 %0, %2, %4, -%0\n\tv_fma_f32 %1, %2, %5, %1" : "=&v"(rx), "=&v"(ry) : "v"(a.x), "v"(a.y), "v"(b.x), "v"(b.y)); return mkc(rx, ry); }
__device__ __forceinline__ cpx cmulc(cpx a, cpx b) { float rx, ry;
    asm("v_mul_f32_e32 %0, %3, %5\n\tv_mul_f32_e32 %1, %2, %5\n\tv_fma_f32 %0, %2, %4, %0\n\tv_fma_f32 %1, %3, %4, -%1" : "=&v"(rx), "=&v"(ry) : "v"(a.x), "v"(a.y), "v"(b.x), "v"(b.y)); return mkc(rx, ry); }

template <int R, bool INV, int H, int P> __device__ __forceinline__ void bfly(cpx (&v)[R]) {
    constexpr int b = (P / H) * 2 * H, i = P % H, e = i * (32 / H);
    float ux = v[b + i].x, uy = v[b + i].y, wx = v[b + i + H].x, wy = v[b + i + H].y;
    if constexpr (e == 0) { float dx, dy;
        asm("v_sub_f32_e32 %2, %0, %4\n\tv_sub_f32_e32 %3, %1, %5\n\tv_add_f32_e32 %0, %0, %4\n\tv_add_f32_e32 %1, %1, %5" : "+v"(ux), "+v"(uy), "=&v"(dx), "=&v"(dy) : "v"(wx), "v"(wy));
        wx = dx; wy = dy; }
    else if constexpr (e == 16) { float ox, oy;
        if constexpr (!INV) asm("v_sub_f32_e32 %2, %1, %5\n\tv_sub_f32_e32 %3, %4, %0\n\tv_add_f32_e32 %0, %0, %4\n\tv_add_f32_e32 %1, %1, %5" : "+v"(ux), "+v"(uy), "=&v"(ox), "=&v"(oy) : "v"(wx), "v"(wy));
        else                asm("v_sub_f32_e32 %2, %5, %1\n\tv_sub_f32_e32 %3, %0, %4\n\tv_add_f32_e32 %0, %0, %4\n\tv_add_f32_e32 %1, %1, %5" : "+v"(ux), "+v"(uy), "=&v"(ox), "=&v"(oy) : "v"(wx), "v"(wy));
        wx = ox; wy = oy; }
    else { constexpr float c = cos64(e), s = INV ? sin64(e) : -sin64(e);
        constexpr unsigned cb = __builtin_bit_cast(unsigned, c), sb = __builtin_bit_cast(unsigned, s), nsb = __builtin_bit_cast(unsigned, -s);
        float dx, dy;
        asm("v_sub_f32_e32 %4, %0, %2\n\tv_sub_f32_e32 %5, %1, %3\n\tv_add_f32_e32 %0, %0, %2\n\tv_add_f32_e32 %1, %1, %3\n\t"
            "v_mul_f32_e32 %2, %8, %5\n\tv_mul_f32_e32 %3, %6, %5\n\tv_fmamk_f32 %2, %4, %6, %2\n\tv_fmamk_f32 %3, %4, %7, %3"
            : "+v"(ux), "+v"(uy), "+v"(wx), "+v"(wy), "=&v"(dx), "=&v"(dy) : "i"(cb), "i"(sb), "i"(nsb)); }
    v[b + i] = mkc(ux, uy); v[b + i + H] = mkc(wx, wy);
}
template <int R, bool INV, int H, int... Ps> __device__ __forceinline__ void dft_stage(cpx (&v)[R], std::integer_sequence<int, Ps...>) { (bfly<R, INV, H, Ps>(v), ...); }
template <int R, bool INV, int H> __device__ __forceinline__ void dft_stages(cpx (&v)[R]) {
    dft_stage<R, INV, H>(v, std::make_integer_sequence<int, R / 2>{});
    if constexpr (H > 1) dft_stages<R, INV, H / 2>(v);
}
template <int R, bool INV> __device__ __forceinline__ void dft_r2(cpx (&v)[R]) { dft_stages<R, INV, R / 2>(v); }
template <int R, bool CONJ, bool BREV> __device__ __forceinline__ void apply_pows(cpx (&v)[R], cpx w) {
    constexpr int H = R > 16 ? 16 : R;
    cpx pw[H];
    pw[1] = w;
#pragma unroll
    for (int k = 2; k < H; ++k) pw[k] = (k & 1) ? cmul(pw[k - 1], w) : cmul(pw[k / 2], pw[k / 2]);
#pragma unroll
    for (int k = 1; k < H; ++k) { const int idx = BREV ? brev<R>(k) : k; v[idx] = CONJ ? cmulc(v[idx], pw[k]) : cmul(v[idx], pw[k]); }
    if (R > 16) {
        const cpx w16 = cmul(pw[8], pw[8]);
#pragma unroll
        for (int k = 0; k < R - 16; ++k) { const cpx q = k == 0 ? w16 : cmul(pw[k], w16); const int idx = BREV ? brev<R>(16 + k) : 16 + k; v[idx] = CONJ ? cmulc(v[idx], q) : cmul(v[idx], q); }
    }
}
__device__ __forceinline__ int phys(int i) { return i + (i >> 5); }
constexpr int TW_OFF = 135168 + 64;
template <int S> __host__ __device__ constexpr int poff(int j) { return S >= 32 ? j * (S + S / 32) : j * S + ((j * S) >> 5); }
typedef hcpx PreRegs[32];
template <int R, int S> __device__ __forceinline__ void fft_prefetch(int t, const hcpx* gio, PreRegs& pre) {
    constexpr int G = 32 / R;
#pragma unroll
    for (int gi = 0; gi < G; ++gi) { const int gam = gi * 512 + t, hi = gam / S, lo = gam % S, base = hi * (R * S) + lo;
#pragma unroll
        for (int j = 0; j < R; ++j) pre[gi * R + j] = __builtin_nontemporal_load(gio + base + j * S); }
}
template <int R, int S, bool INV, int IO> __device__ __forceinline__ void fft_pass(LDSQ cpx* A, int t, hcpx* gio, const PreRegs& pre) {
    constexpr int G = 32 / R;
    asm volatile("" : "+v"(t) :: "memory");
    const LDSQ cpx* TW = (const LDSQ cpx*)((LDSQ unsigned char*)A + TW_OFF);
    cpx v[G][R]; cpx tw[G];
#pragma unroll
    for (int gi = 0; gi < G; ++gi) {
        const int gam = gi * 512 + t, hi = gam / S, lo = gam % S, base = hi * (R * S) + lo; const LDSQ cpx* Ab = A + phys(base);
#pragma unroll
        for (int j = 0; j < R; ++j) v[gi][j] = (IO == 3) ? c_of(pre[gi * R + j]) : (IO == 1) ? c_of(__builtin_nontemporal_load(gio + base + j * S)) : Ab[poff<S>(j)];
        tw[gi] = TW[lo * (16384 / (R * S))];
    }
#pragma unroll
    for (int gi = 0; gi < G; ++gi) {
        const int gam = gi * 512 + t, hi = gam / S, lo = gam % S, base = hi * (R * S) + lo; LDSQ cpx* Ab = A + phys(base);
        if (!INV) {
            dft_r2<R, false>(v[gi]);
            apply_pows<R, false, true>(v[gi], tw[gi]);
#pragma unroll
            for (int k = 0; k < R; ++k) { if (IO == 2) gio[base + k * S] = h_of(v[gi][brev<R>(k)]); else Ab[poff<S>(k)] = v[gi][brev<R>(k)]; }
        } else {
            apply_pows<R, true, false>(v[gi], tw[gi]);
            dft_r2<R, true>(v[gi]);
#pragma unroll
            for (int j = 0; j < R; ++j) { if (IO == 2) gio[base + j * S] = h_of(v[gi][brev<R>(j)]); else Ab[poff<S>(j)] = v[gi][brev<R>(j)]; }
        }
    }
}
template <int R, int MODE> __device__ __forceinline__ void fft_mid(LDSQ cpx* A, int t, hcpx* spec, float scale) {
    constexpr int G = 32 / R;
    asm volatile("" : "+v"(t) :: "memory");
    hcpx2 sp[G][R / 2];
    if (MODE == 1) {
#pragma unroll
        for (int gi = 0; gi < G; ++gi)
#pragma unroll
            for (int k2 = 0; k2 < R / 2; ++k2) sp[gi][k2] = *(const hcpx2*)(spec + (size_t)(gi * 512 + t) * R + 2 * k2);
    }
#pragma unroll
    for (int gi = 0; gi < G; ++gi) {
        const int gam = gi * 512 + t, base = gam * R;
        cpx v[R];
        LDSQ cpx* Ab = A + phys(base);
#pragma unroll
        for (int j = 0; j < R; ++j) v[j] = Ab[j];
        dft_r2<R, false>(v);
        if (MODE == 0) {
#pragma unroll
            for (int k2 = 0; k2 < R / 2; ++k2) { const cpx x = v[brev<R>(2 * k2)], y = v[brev<R>(2 * k2 + 1)];
                *(hcpx2*)(spec + (size_t)base + 2 * k2) = h2_of(mkc(x.x * scale, x.y * scale), mkc(y.x * scale, y.y * scale)); }
        } else {
            cpx x[R];
#pragma unroll
            for (int k2 = 0; k2 < R / 2; ++k2) { const hcpx2 s = sp[gi][k2]; x[2 * k2] = cmul(v[brev<R>(2 * k2)], mkc((float)s.x * scale, (float)s.y * scale)); x[2 * k2 + 1] = cmul(v[brev<R>(2 * k2 + 1)], mkc((float)s.z * scale, (float)s.w * scale)); }
            dft_r2<R, true>(x);
#pragma unroll
            for (int j = 0; j < R; ++j) Ab[j] = x[brev<R>(j)];
        }
    }
}
#define GL_DRAIN() asm volatile("s_waitcnt vmcnt(0)" ::: "memory")
struct NoHook { __device__ __forceinline__ void operator()() const {} };
template <int LOG2L, bool INV, int GIO, class Hook = NoHook> __device__ __forceinline__ void fft_outer(LDSQ cpx* A, int t, hcpx* gio, const hcpx* pfsrc, PreRegs& pre, Hook hook = Hook()) {
    constexpr int R1 = LOG2L == 14 ? 32 : 16, S1 = LOG2L == 14 ? 512 : 128, S2 = LOG2L == 14 ? 16 : 8;
    if (!INV) { fft_pass<R1, S1, false, GIO == 3 ? 3 : 0>(A, t, nullptr, pre); __syncthreads(); fft_pass<R1, S2, false, 0>(A, t, nullptr, pre); GL_DRAIN(); __syncthreads(); }
    else      { fft_pass<R1, S2, true, 0>(A, t, nullptr, pre); __syncthreads();
                if (GIO == 2) fft_prefetch<R1, S1>(t, pfsrc, pre);
                hook();
                fft_pass<R1, S1, true, GIO == 2 ? 2 : 0>(A, t, gio, pre); if (GIO != 2) GL_DRAIN(); __syncthreads(); }
}
template <int LOG2L, int SRC, int DST, class Hook = NoHook> __device__ __forceinline__ void fft_conv(LDSQ cpx* A, int t, hcpx* spec, hcpx* gdst, const hcpx* pfsrc, PreRegs& pre, Hook hook = Hook()) {
    fft_outer<LOG2L, false, SRC>(A, t, nullptr, nullptr, pre);
    fft_mid<LOG2L == 14 ? 16 : 8, 1>(A, t, spec, 1.0f / (float)(1 << LOG2L));
    if (SRC == 3) GL_DRAIN();
    __syncthreads();
    fft_outer<LOG2L, true, DST>(A, t, gdst, pfsrc, pre, hook);
}

__device__ __forceinline__ void sconv4r(u32x2 q, unsigned zmr, unsigned zpr, float w0, float w1, float w2, float bb, float (&o)[4]) {
    const float zm = __uint_as_float(zmr << 16), zp = __uint_as_float(zpr << 16);
    const float z0 = __uint_as_float(q.x << 16), z1 = __uint_as_float(q.x & 0xffff0000u), z2 = __uint_as_float(q.y << 16), z3 = __uint_as_float(q.y & 0xffff0000u);
    o[0] = w0 * zm + w1 * z0 + w2 * z1 + bb; o[1] = w0 * z0 + w1 * z1 + w2 * z2 + bb; o[2] = w0 * z1 + w1 * z2 + w2 * z3 + bb; o[3] = w0 * z2 + w1 * z3 + w2 * zp + bb;
}
typedef _Float16 h4 __attribute__((ext_vector_type(4)));
__device__ __forceinline__ void tapquad(h4 a, h4 bq, unsigned b0bits, float wf, float wb, float rf1, float rf2, float rf3, float rb1, float rb2, float rb3, float (&fa)[4], float (&fb)[4]) {
    const float b0 = (float)__builtin_bit_cast(_Float16, (unsigned short)b0bits);
    fa[0] = (float)a.x * wf; fa[1] = (float)a.y * (wf * rf1); fa[2] = (float)a.z * (wf * rf2); fa[3] = (float)a.w * (wf * rf3);
    fb[0] = b0 * wb; fb[1] = (float)bq.w * (wb * rb1); fb[2] = (float)bq.z * (wb * rb2); fb[3] = (float)bq.y * (wb * rb3);
}
template <int LOG2L> struct SweepIdx {
    static constexpr int L = 1 << LOG2L, QS = L / 32;
    int t, seq, n00, a00; cpx wq0, w1, w2, w3;
    __device__ __forceinline__ SweepIdx(int t_, bool need_w) { t = t_; asm volatile("" : "+v"(t) :: "memory"); seq = (LOG2L == 14) ? 0 : (t >> 6); const int q0 = (LOG2L == 14) ? t : (t & 63); n00 = 4 * q0; a00 = seq * L + n00;
        if (need_w) { float sb, cb; sincospif(-(float)n00 / (float)L, &sb, &cb); wq0 = mkc(cb, sb);
            sincospif(-1.0f / (float)L, &sb, &cb); w1 = mkc(cb, sb); w2 = cmul(w1, w1); w3 = cmul(w2, w1); } }
};
#define WQS mkc(0.92387953251128674f, -0.38268343236508978f)
struct TapWin { float wf0, wfs, rf1, rf2, rf3, wb0, wbs, rb1, rb2, rb3; };
template <int LOG2L> __device__ __forceinline__ TapWin tap_windows(float df, float db, int n00) {
    constexpr int L = 1 << LOG2L, QS = L / 32; TapWin w;
    w.wf0 = expf(-df * (float)n00); w.wfs = expf(-df * (float)(4 * QS)); w.rf1 = expf(-df); w.rf2 = w.rf1 * w.rf1; w.rf3 = w.rf2 * w.rf1;
    w.wb0 = expf(-db * (float)(L - n00)); w.wbs = expf(db * (float)(4 * QS)); w.rb1 = expf(db); w.rb2 = w.rb1 * w.rb1; w.rb3 = w.rb2 * w.rb1; return w;
}
template <int LOG2L> __device__ __forceinline__ void sweep_taps2(LDSQ cpx* A, int t_, const _Float16* tf0, const _Float16* tb0, const _Float16* tf1, const _Float16* tb1, float df0, float db0, float df1, float db1, hcpx* hos, float& ss0, float& ss1) {
    constexpr int L = 1 << LOG2L, QS = L / 32; const SweepIdx<LOG2L> X(t_, true);
    const TapWin W0 = tap_windows<LOG2L>(df0, db0, X.n00), W1 = tap_windows<LOG2L>(df1, db1, X.n00);
    float s0 = 0.f, s1 = 0.f, wf0 = W0.wf0, wb0 = W0.wb0, wf1 = W1.wf0, wb1 = W1.wb0;
    cpx wn = X.wq0;
    h4 ra0[8], rb0[8], ra1[8], rb1[8]; unsigned rc0[8], rc1[8];
#pragma unroll
    for (int i = 0; i < 8; ++i) { const int n = 4 * (i * QS) + X.n00, nb = n > 0 ? L - n : L - 1;
        ra0[i] = *(const h4*)(tf0 + n); rb0[i] = *(const h4*)(tb0 + L - n - 4); rc0[i] = ((const unsigned short*)tb0)[nb];
        ra1[i] = *(const h4*)(tf1 + n); rb1[i] = *(const h4*)(tb1 + L - n - 4); rc1[i] = ((const unsigned short*)tb1)[nb]; }
#pragma unroll
    for (int i = 0; i < 8; ++i) { const int n = 4 * (i * QS) + X.n00; float fa0[4], fb0[4], fa1[4], fb1[4]; const unsigned hm = n > 0 ? 0xffffu : 0u;
        tapquad(ra0[i], rb0[i], rc0[i] & hm, wf0, wb0, W0.rf1, W0.rf2, W0.rf3, W0.rb1, W0.rb2, W0.rb3, fa0, fb0);
        tapquad(ra1[i], rb1[i], rc1[i] & hm, wf1, wb1, W1.rf1, W1.rf2, W1.rf3, W1.rb1, W1.rb2, W1.rb3, fa1, fb1);
        LDSQ cpx* ap = A + phys(X.a00 + 4 * i * QS); hcpx* hp = hos + X.a00 + 4 * i * QS;
#pragma unroll
        for (int e = 0; e < 4; ++e) { s0 += fa0[e] * fa0[e] + fb0[e] * fb0[e]; s1 += fa1[e] * fa1[e] + fb1[e] * fb1[e]; ap[e] = mkc(fa0[e] + fb0[e], fa1[e] + fb1[e]); }
        const cpx wa = cmul(wn, X.w1), wb2 = cmul(wn, X.w2), wc = cmul(wn, X.w3);
        const cpx y0 = cmul(mkc(fa0[0] - fb0[0], fa1[0] - fb1[0]), wn), y1 = cmul(mkc(fa0[1] - fb0[1], fa1[1] - fb1[1]), wa);
        const cpx y2 = cmul(mkc(fa0[2] - fb0[2], fa1[2] - fb1[2]), wb2), y3 = cmul(mkc(fa0[3] - fb0[3], fa1[3] - fb1[3]), wc);
        *(hcpx2*)hp = h2_of(y0, y1); *(hcpx2*)(hp + 2) = h2_of(y2, y3);
        wn = cmul(wn, WQS); wf0 *= W0.wfs; wb0 *= W0.wbs; wf1 *= W1.wfs; wb1 *= W1.wbs; }
    ss0 = s0; ss1 = s1;
}
template <int LOG2L, int PART> __device__ __forceinline__ void fft_mid_sep(LDSQ cpx* A, int t, hcpx* spec0, hcpx* spec1, const LDSQ float* red, const float* skp0, const float* skp1) {
    constexpr int R = LOG2L == 14 ? 16 : 8, G = 32 / R, NB = LOG2L == 14 ? 32 : 16, NG = NB * NB;
    asm volatile("" : "+v"(t) :: "memory");
#pragma unroll
    for (int gi = 0; gi < G; ++gi) {
        cpx v[R]; LDSQ cpx* Ab = A + phys((gi * 512 + t) * R);
#pragma unroll
        for (int j = 0; j < R; ++j) v[j] = Ab[j];
        dft_r2<R, false>(v);
#pragma unroll
        for (int k = 0; k < R; ++k) Ab[k] = v[brev<R>(k)];
    }
    __syncthreads();
#pragma unroll
    for (int gi = 0; gi < G; ++gi) {
        const int gam = gi * 512 + t, seq = gam / NG, g = gam % NG, k1 = g / NB, k2 = g % NB;
        const int gp = PART == 1 ? NG - 1 - g : (k1 ? (NB - k1) * NB + (NB - 1 - k2) : (k2 ? NB - k2 : 0));
        const bool wrap = PART == 0 && g == 0;
        const LDSQ cpx* Ab = A + phys(gam * R); const LDSQ cpx* Ap = A + phys((seq * NG + gp) * R);
        cpx z[R], q[R];
#pragma unroll
        for (int k = 0; k < R; ++k) { z[k] = Ab[k]; q[k] = Ap[k]; }
        float ss0, ss1;
        if (LOG2L == 14) { ss0 = red[0] + red[1] + red[2] + red[3] + red[4] + red[5] + red[6] + red[7]; ss1 = red[8] + red[9] + red[10] + red[11] + red[12] + red[13] + red[14] + red[15]; }
        else { ss0 = red[seq]; ss1 = red[8 + seq]; }
        const float n0 = 0.25f / sqrtf(ss0 + EPS), n1 = 0.25f / sqrtf(ss1 + EPS), h0 = 0.5f * skp0[seq], h1 = 0.5f * skp1[seq];
        hcpx* s0p = spec0 + (size_t)gam * R; hcpx* s1p = spec1 + (size_t)gam * R;
#pragma unroll
        for (int k2_ = 0; k2_ < R / 2; ++k2_) { cpx o0[2], o1[2];
#pragma unroll
            for (int e = 0; e < 2; ++e) { const int k = 2 * k2_ + e; cpx zp = q[R - 1 - k]; const cpx zw = q[(R - k) & (R - 1)];
                if (PART == 0) { zp.x = wrap ? zw.x : zp.x; zp.y = wrap ? zw.y : zp.y; }
                o0[e] = mkc((z[k].x + zp.x) * n0 + h0, (z[k].y - zp.y) * n0); o1[e] = mkc((z[k].y + zp.y) * n1 + h1, (zp.x - z[k].x) * n1); }
            *(hcpx2*)(s0p + 2 * k2_) = h2_of(o0[0], o0[1]); *(hcpx2*)(s1p + 2 * k2_) = h2_of(o1[0], o1[1]); }
    }
}
template <int LOG2L> __device__ __forceinline__ void sweep_load_v(LDSQ cpx* A, int t_, const bf16_t* zrow, size_t tb0, const float* cw, const float* cbias, int rc0, hcpx* xw) {
    constexpr int L = 1 << LOG2L, QS = L / 32; const SweepIdx<LOG2L> X(t_, true);
    const int rc = rc0 + X.seq; const float cw0 = cw[rc], cw1 = cw[6144 + rc], cw2 = cw[2 * 6144 + rc], bb = cbias[rc];
    const bf16_t* z0 = zrow + (size_t)rc * T + tb0; const bf16_t* z1 = z0 + L;
    cpx wn = X.wq0;
    u32x2 rq[8][2]; unsigned rm[8][2], rp[8][2];
#pragma unroll
    for (int i = 0; i < 8; ++i) { const int n = 4 * (i * QS) + X.n00, nm = n > 0 ? n - 1 : 0, np = n + 4 < L ? n + 4 : L - 1;
        rq[i][0] = *(const u32x2*)(z0 + n); rq[i][1] = *(const u32x2*)(z1 + n); rm[i][0] = z0[nm]; rm[i][1] = z1[nm]; rp[i][0] = z0[np]; rp[i][1] = z1[np]; }
#pragma unroll
    for (int i = 0; i < 8; ++i) { const int n = 4 * (i * QS) + X.n00; float xa[4], xb[4]; const unsigned hm = n > 0 ? 0xffffu : 0u, hp = n + 4 < L ? 0xffffu : 0u;
        sconv4r(rq[i][0], rm[i][0] & hm, rp[i][0] & hp, cw0, cw1, cw2, bb, xa); sconv4r(rq[i][1], rm[i][1] & hm, rp[i][1] & hp, cw0, cw1, cw2, bb, xb);
        LDSQ cpx* ap = A + phys(X.a00 + 4 * i * QS); hcpx* xp = xw + X.a00 + 4 * i * QS;
        ap[0] = mkc(xa[0], xb[0]); ap[1] = mkc(xa[1], xb[1]); ap[2] = mkc(xa[2], xb[2]); ap[3] = mkc(xa[3], xb[3]);
        const cpx y0 = cmul(mkc(xa[0], xb[0]), wn), y1 = cmul(mkc(xa[1], xb[1]), cmul(wn, X.w1)), y2 = cmul(mkc(xa[2], xb[2]), cmul(wn, X.w2)), y3 = cmul(mkc(xa[3], xb[3]), cmul(wn, X.w3));
        *(hcpx2*)xp = h2_of(y0, y1); *(hcpx2*)(xp + 2) = h2_of(y2, y3);
        wn = cmul(wn, WQS); }
}
constexpr int CPA = 2;
template <int N> struct CombPreN { u32x2 q[N][2]; unsigned zm[N][2], zp[N][2]; hcpx2 h01[N], h23[N]; };
typedef CombPreN<CPA> CombPre;
template <int LOG2L, int I0, int N> __device__ __forceinline__ void combine_prefetch(int t_, const hcpx* yes, const bf16_t* zrow, size_t tb0, int rg0, CombPreN<N>& P) {
    constexpr int L = 1 << LOG2L, QS = L / 32; const SweepIdx<LOG2L> X(t_, false);
    const int rg = rg0 + X.seq; const bf16_t* g0 = zrow + (size_t)rg * T + tb0; const bf16_t* g1 = g0 + L;
#pragma unroll
    for (int i = 0; i < N; ++i) { const int n = 4 * ((I0 + i) * QS) + X.n00; const hcpx* yp = yes + X.a00 + 4 * (I0 + i) * QS;
        P.q[i][0] = *(const u32x2*)(g0 + n); P.q[i][1] = *(const u32x2*)(g1 + n);
        const int nm = n > 0 ? n - 1 : 0, np = n + 4 < L ? n + 4 : L - 1;
        P.zm[i][0] = g0[nm]; P.zm[i][1] = g1[nm]; P.zp[i][0] = g0[np]; P.zp[i][1] = g1[np];
        P.h01[i] = __builtin_nontemporal_load((const hcpx2*)yp); P.h23[i] = __builtin_nontemporal_load((const hcpx2*)(yp + 2)); }
}
template <int LOG2L, int FINAL> __device__ __forceinline__ void sweep_combine(LDSQ cpx* A, int t_, const CombPre& P0, const hcpx* yes, hcpx* xw, bf16_t* zrow, size_t tb0, const float* cw, const float* cbias, int rg0, int ro0, int dry) {
    constexpr int L = 1 << LOG2L, QS = L / 32; const SweepIdx<LOG2L> X(t_, true);
    CombPreN<8 - CPA> P1; combine_prefetch<LOG2L, CPA>(X.t, yes, zrow, tb0, rg0, P1);
    const int rg = rg0 + X.seq; const float cw0 = cw[rg], cw1 = cw[6144 + rg], cw2 = cw[2 * 6144 + rg], bb = cbias[rg];
    bf16_t* o0 = zrow + (size_t)(ro0 + X.seq) * T + tb0; bf16_t* o1 = o0 + L;
    cpx wn = X.wq0;
#pragma unroll
    for (int i = 0; i < 8; ++i) { const int n = 4 * (i * QS) + X.n00; float ga[4], gb[4];
        const bool ah = i < CPA; const int ia = ah ? i : 0, ib = ah ? 0 : i - CPA;
        const unsigned hm = n > 0 ? 0xffffu : 0u, hp = n + 4 < L ? 0xffffu : 0u;
        sconv4r(ah ? P0.q[ia][0] : P1.q[ib][0], (ah ? P0.zm[ia][0] : P1.zm[ib][0]) & hm, (ah ? P0.zp[ia][0] : P1.zp[ib][0]) & hp, cw0, cw1, cw2, bb, ga);
        sconv4r(ah ? P0.q[ia][1] : P1.q[ib][1], (ah ? P0.zm[ia][1] : P1.zm[ib][1]) & hm, (ah ? P0.zp[ia][1] : P1.zp[ib][1]) & hp, cw0, cw1, cw2, bb, gb);
        const LDSQ cpx* ap = A + phys(X.a00 + 4 * i * QS);
        const hcpx2 h01 = ah ? P0.h01[ia] : P1.h01[ib], h23 = ah ? P0.h23[ia] : P1.h23[ib];
        const f32x4 e01 = {(float)h01.x, (float)h01.y, (float)h01.z, (float)h01.w}, e23 = {(float)h23.x, (float)h23.y, (float)h23.z, (float)h23.w};
        const cpx wa = cmul(wn, X.w1), wb2 = cmul(wn, X.w2), wc = cmul(wn, X.w3);
        const cpx r0 = cmulc(ap[0], wn), r1 = cmulc(ap[1], wa), r2 = cmulc(ap[2], wb2), r3 = cmulc(ap[3], wc);
        const cpx s0 = mkc(ga[0] * (e01[0] + r0.x), gb[0] * (e01[1] + r0.y)), s1 = mkc(ga[1] * (e01[2] + r1.x), gb[1] * (e01[3] + r1.y));
        const cpx s2 = mkc(ga[2] * (e23[0] + r2.x), gb[2] * (e23[1] + r2.y)), s3 = mkc(ga[3] * (e23[2] + r3.x), gb[3] * (e23[3] + r3.y));
        if (FINAL == 0) { LDSQ cpx* aw = A + phys(X.a00 + 4 * i * QS); hcpx* xp = xw + X.a00 + 4 * i * QS;
            aw[0] = s0; aw[1] = s1; aw[2] = s2; aw[3] = s3;
            const cpx y0 = cmul(s0, wn), y1 = cmul(s1, wa), y2 = cmul(s2, wb2), y3 = cmul(s3, wc);
            *(hcpx2*)xp = h2_of(y0, y1); *(hcpx2*)(xp + 2) = h2_of(y2, y3); }
        else if (!dry) { u32x2 wa2, wb3; wa2.x = cvt_pk_bf16(s0.x, s1.x); wa2.y = cvt_pk_bf16(s2.x, s3.x); wb3.x = cvt_pk_bf16(s0.y, s1.y); wb3.y = cvt_pk_bf16(s2.y, s3.y);
            *(u32x2*)(o0 + n) = wa2; *(u32x2*)(o1 + n) = wb3; }
        wn = cmul(wn, WQS); }
}
template <int LOG2L> __device__ __forceinline__ void hyena_item(const Params& p, LDSQ unsigned char* lds, int layer_j, int c0, int dry) {
    constexpr int L = 1 << LOG2L, NPAIR = (LOG2L == 14) ? 1 : 2;
    constexpr int TOK0 = (LOG2L == 14) ? 0 : T_P, PB = (LOG2L == 14) ? 0 : 16384;
    LDSQ cpx* A = (LDSQ cpx*)lds;
    LDSQ float* red = (LDSQ float*)(lds + 135168);
    const int t = pg8::otid(), ch = c0 + ((LOG2L == 14) ? 0 : (t >> 6));
    bf16_t* zin = (bf16_t*)(p.ws + WS_BIG + BIG_ZINT);
    const _Float16* taps = (const _Float16*)(p.ws + WS_BIG + BIG_TAPS);
    hcpx* scr = (hcpx*)(p.ws + WS_H + (size_t)pg8::obid() * FFT_SCR_PER_WG);
    hcpx* u1s = scr + (size_t)4 * 16384;
    hcpx* yes = (hcpx*)(p.ws + WS_END + (size_t)pg8::obid() * FFT_EXT_PER_WG);
    PreRegs pre;
    hcpx* xw = yes + 16384;
    {
        const _Float16* tf0 = taps + (size_t)(0 * 2048 + ch) * NPOS + PB; const _Float16* tb0 = taps + (size_t)(1 * 2048 + ch) * NPOS + PB;
        const _Float16* tf1 = taps + (size_t)(2 * 2048 + ch) * NPOS + PB; const _Float16* tb1 = taps + (size_t)(3 * 2048 + ch) * NPOS + PB;
        const float* dec = p.hy_decay + (size_t)layer_j * 8192 + ch;
        const float df0 = fabsf(dec[0]) * (1.0f / (float)(L - 1)), db0 = fabsf(dec[2048]) * (1.0f / (float)(L - 1));
        const float df1 = fabsf(dec[4096]) * (1.0f / (float)(L - 1)), db1 = fabsf(dec[6144]) * (1.0f / (float)(L - 1));
        float ss0, ss1;
        sweep_taps2<LOG2L>(A, t, tf0, tb0, tf1, tb1, df0, db0, df1, db1, xw, ss0, ss1);
        ss0 = wave_sum(ss0); ss1 = wave_sum(ss1);
        if ((t & 63) == 0) { red[t >> 6] = ss0; red[8 + (t >> 6)] = ss1; }
        __syncthreads();
        const float* skp0 = p.hy_skip + (size_t)layer_j * 2 * 2048 + c0; const float* skp1 = skp0 + 2048;
        fft_outer<LOG2L, false, 0>(A, t, nullptr, nullptr, pre);
        fft_prefetch<LOG2L == 14 ? 32 : 16, LOG2L == 14 ? 512 : 128>(t, xw, pre);
        fft_mid_sep<LOG2L, 0>(A, t, scr + (size_t)0 * 16384, scr + (size_t)2 * 16384, red, skp0, skp1); __syncthreads();
        fft_outer<LOG2L, false, 3>(A, t, nullptr, nullptr, pre);
        fft_mid_sep<LOG2L, 1>(A, t, scr + (size_t)1 * 16384, scr + (size_t)3 * 16384, red, skp0, skp1); __syncthreads();
    }
    const float* cw = p.hy_conv_w + (size_t)layer_j * 3 * 6144; const float* cbias = p.hy_conv_b + (size_t)layer_j * 6144;
#pragma unroll 1
    for (int pr = 0; pr < NPAIR; ++pr) {
        const size_t tb0 = (size_t)TOK0 + (size_t)(2 * pr) * L;
        sweep_load_v<LOG2L>(A, t, zin, tb0, cw, cbias, 2 * 2048 + c0, xw); __syncthreads();
        fft_conv<LOG2L, 0, 2>(A, t, scr + (size_t)0 * 16384, yes, xw, pre);
        CombPre cp;
        fft_conv<LOG2L, 3, 0>(A, t, scr + (size_t)1 * 16384, nullptr, nullptr, pre, [&]() { combine_prefetch<LOG2L, 0>(t, yes, zin, tb0, c0, cp); });
        sweep_combine<LOG2L, 0>(A, t, cp, yes, xw, zin, tb0, cw, cbias, c0, c0, dry); __syncthreads();
        fft_conv<LOG2L, 0, 2>(A, t, scr + (size_t)2 * 16384, yes, xw, pre);
        fft_conv<LOG2L, 3, 0>(A, t, scr + (size_t)3 * 16384, nullptr, nullptr, pre, [&]() { combine_prefetch<LOG2L, 0>(t, yes, zin, tb0, 2048 + c0, cp); });
        sweep_combine<LOG2L, 1>(A, t, cp, yes, xw, zin, tb0, cw, cbias, 2048 + c0, c0, dry); __syncthreads();
    }
}
__device__ __forceinline__ void hyena_conv_phase(const Params& p, LDSQ unsigned char* lds, int layer_j, int dry) {
    { LDSQ cpx* TW = (LDSQ cpx*)(lds + TW_OFF);
      for (int e = pg8::otid(); e < 1024; e += NTHR) { float sn, cs; sincospif(-2.0f * (float)e / 16384.0f, &sn, &cs); TW[e] = mkc(cs, sn); }
      __syncthreads(); }
    for (int it = pg8::obid(); it < 2048; it += pg8::ogrid()) hyena_item<14>(p, lds, layer_j, it, dry);
    for (int it = pg8::obid(); it < 256; it += pg8::ogrid()) hyena_item<11>(p, lds, layer_j, it * 8, dry);
}

__device__ __forceinline__ void attn_phase(const Params& p, LDSQ unsigned char* lds, int dry = 0) {
    constexpr int KROW = 272, VROW = 264;
    LDSQ unsigned char* Kl = lds; LDSQ bf16_t* VT = (LDSQ bf16_t*)(lds + 256 * KROW);
    const bf16_t* qkv = (const bf16_t*)(p.ws + WS_BIG + BIG_QKV);
    bf16_t* og = (bf16_t*)(p.ws + WS_BIG + BIG_OG); float* lse = (float*)(p.ws + WS_BIG + BIG_LSE);
    const int tid = pg8::otid(), lane = tid & 63, wid = __builtin_amdgcn_readfirstlane(tid >> 6), l15 = lane & 15, g4 = lane >> 4;
    const int blk = wid >> 2, qq = 16 * (wid & 3) + l15;
    for (int u = pg8::obid(); u < 1792 + 512; u += pg8::ogrid()) {
        const int it = u < 1792 ? 4 * u : 7168 + (u - 1792), len = u < 1792 ? 4 : 1;
        int g, b, hh, rho, pp0, L, tokbase;
        if (it < 6144) { g = it >> 11; const int rem = it & 2047; const int npp = 128 >> (2 * g); pp0 = rem % npp; rho = (rem / npp) & ((1 << (2 * g)) - 1); hh = (rem >> 7) & 7; b = rem >> 10; L = L_P; tokbase = 0; }
        else { const int i2 = it - 6144; g = i2 >> 9; const int rem = i2 & 511; const int npp = 16 >> (2 * g); pp0 = rem % npp; rho = (rem / npp) & ((1 << (2 * g)) - 1); hh = (rem >> 4) & 7; b = rem >> 7; L = L_S; tokbase = T_P; }
        const int rsh = 2 * g, n = L >> rsh;
        const size_t tok0 = (size_t)tokbase + (size_t)b * L + rho;
        const int qcol = g * 3072 + hh * 128, kcol = qcol + 1024, vcol = qcol + 2048;
        u32x4 kr[2][4], vr[2][4];
        auto request_half = [&](int ih, u32x4 (&kh)[4], u32x4 (&vh)[4]) {
#pragma unroll
            for (int s4 = 0; s4 < 4; ++s4) { const int ci = tid + 512 * s4;
                { const int slot = ci >> 4, chn = ci & 15, i = ih + slot, ic = i < 0 ? 0 : (i < n ? i : n - 1); kh[s4] = *(const u32x4*)(qkv + (tok0 + ((size_t)ic << rsh)) * QKVW + kcol + chn * 8); }
                { const int slot = ci & 127, chn = ci >> 7, i = ih + slot, ic = i < 0 ? 0 : (i < n ? i : n - 1); vh[s4] = *(const u32x4*)(qkv + (tok0 + ((size_t)ic << rsh)) * QKVW + vcol + chn * 8); } } };
        auto stage_half = [&](int ih, int ring0, const u32x4 (&kh)[4], const u32x4 (&vh)[4]) {
#pragma unroll
            for (int s4 = 0; s4 < 4; ++s4) { const int ci = tid + 512 * s4;
                { const int slot = ci >> 4, chn = ci & 15, i = ih + slot; const unsigned ok = (i >= 0 && i < n) ? 0xffffffffu : 0u;
                  u32x4 v = kh[s4]; v.x &= ok; v.y &= ok; v.z &= ok; v.w &= ok;
                  *(LDSQ u32x4*)(Kl + (ring0 + slot) * KROW + chn * 16) = v; }
                { const int slot = ci & 127, chn = ci >> 7, i = ih + slot; const unsigned ok = (i >= 0 && i < n) ? 0xffffffffu : 0u;
                  u32x4 v = vh[s4]; v.x &= ok; v.y &= ok; v.z &= ok; v.w &= ok;
                  LDSQ bf16_t* vp = VT + (chn * 8) * VROW + ring0 + slot;
                  vp[0] = (bf16_t)(v.x & 0xffffu); vp[VROW] = (bf16_t)(v.x >> 16); vp[2 * VROW] = (bf16_t)(v.y & 0xffffu); vp[3 * VROW] = (bf16_t)(v.y >> 16);
                  vp[4 * VROW] = (bf16_t)(v.z & 0xffffu); vp[5 * VROW] = (bf16_t)(v.z >> 16); vp[6 * VROW] = (bf16_t)(v.w & 0xffffu); vp[7 * VROW] = (bf16_t)(v.w >> 16); } } };
        request_half(128 * pp0 - 64, kr[0], vr[0]); request_half(128 * pp0 + 64, kr[1], vr[1]);
#pragma unroll 1
        for (int s = 0; s < len; ++s) {
            const int pp = pp0 + s, i0 = 128 * pp - 64, off = (128 * pp) & 255;
            const int qi = 128 * pp + 64 * blk + qq;
            const size_t tq = tok0 + ((size_t)qi << rsh);
            bf16x8 bq[4];
#pragma unroll
            for (int ks = 0; ks < 4; ++ks) bq[ks] = *(const bf16x8*)(qkv + tq * QKVW + qcol + 32 * ks + 8 * g4);
            if (s == 0) stage_half(i0, off, kr[0], vr[0]);
            stage_half(i0 + 128, (128 + off) & 255, kr[1], vr[1]);
            __syncthreads();
            const int ktb = wid & 3;
            f32x4 sc[10]; bf16x8 kf[2][4];
            auto kload = [&](int j, bf16x8 (&f)[4]) { const int rb = (64 * blk + 16 * (ktb + j) + off) & 255;
#pragma unroll
                for (int ks = 0; ks < 4; ++ks) f[ks] = *(const LDSQ bf16x8*)(Kl + (rb + l15) * KROW + (32 * ks + 8 * g4) * 2); };
            kload(0, kf[0]);
#pragma unroll
            for (int j = 0; j < 9; ++j) {
                if (j + 1 < 9) kload(j + 1, kf[(j + 1) & 1]);
                __builtin_amdgcn_sched_barrier(0);
                f32x4 a = {0.f, 0.f, 0.f, 0.f};
#pragma unroll
                for (int ks = 0; ks < 4; ++ks) a = __builtin_amdgcn_mfma_f32_16x16x32_bf16(kf[j & 1][ks], bq[ks], a, 0, 0, 0);
                sc[j] = a;
                __builtin_amdgcn_sched_barrier(0); }
            if (s + 1 < len) request_half(i0 + 256, kr[1], vr[1]);
            const int ibase = 128 * pp + 64 * blk - 64;
            const int klo = qq > -ibase ? qq : -ibase, khi = (qq + 128 < n - 1 - ibase) ? qq + 128 : n - 1 - ibase;
            const unsigned kspan = (unsigned)(khi - klo); const int kk0 = 4 * g4 - klo + 16 * ktb;
            float mx = -3.0e38f;
#pragma unroll
            for (int j = 0; j < 9; ++j)
#pragma unroll
                for (int r = 0; r < 4; ++r) { const bool ok = (unsigned)(kk0 + 16 * j + r) <= kspan;
                    sc[j][r] = ok ? sc[j][r] : -3.0e38f; mx = fmaxf(mx, sc[j][r]); }
            mx = fmaxf(mx, __shfl_xor(mx, 16)); mx = fmaxf(mx, __shfl_xor(mx, 32));
            float ls = 0.f;
#pragma unroll
            for (int j = 0; j < 9; ++j)
#pragma unroll
                for (int r = 0; r < 4; ++r) { const float e = __builtin_amdgcn_exp2f(sc[j][r] - mx); sc[j][r] = e; ls += e; }
            sc[9] = (f32x4){0.f, 0.f, 0.f, 0.f};
            ls += __shfl_xor(ls, 16); ls += __shfl_xor(ls, 32);
            f32x4 oa[8];
#pragma unroll
            for (int dt = 0; dt < 8; ++dt) oa[dt] = (f32x4){0.f, 0.f, 0.f, 0.f};
            u32x2 vf[2][4][2];
            auto vload = [&](int gidx, u32x2 (&f)[4][2]) { const int k2 = gidx >> 1, d0 = (gidx & 1) * 4;
                const int cb0 = (64 * blk + 16 * ktb + 32 * k2 + off) & 255, cb1 = (cb0 + 16) & 255;
#pragma unroll
                for (int d = 0; d < 4; ++d) { const LDSQ bf16_t* vq = VT + (16 * (d0 + d) + l15) * VROW + 4 * g4; f[d][0] = *(const LDSQ u32x2*)(vq + cb0); f[d][1] = *(const LDSQ u32x2*)(vq + cb1); } };
            vload(0, vf[0]);
#pragma unroll
            for (int gidx = 0; gidx < 10; ++gidx) { const int k2 = gidx >> 1, d0 = (gidx & 1) * 4;
                if (gidx + 1 < 10) vload(gidx + 1, vf[(gidx + 1) & 1]);
                __builtin_amdgcn_sched_barrier(0);
                union { u32x4 u; bf16x8 h; } pb;
                pb.u.x = cvt_pk_bf16(sc[2 * k2][0], sc[2 * k2][1]); pb.u.y = cvt_pk_bf16(sc[2 * k2][2], sc[2 * k2][3]);
                pb.u.z = cvt_pk_bf16(sc[2 * k2 + 1][0], sc[2 * k2 + 1][1]); pb.u.w = cvt_pk_bf16(sc[2 * k2 + 1][2], sc[2 * k2 + 1][3]);
#pragma unroll
                for (int d = 0; d < 4; ++d) { union { u32x4 u; bf16x8 h; } va; const u32x2 lo = vf[gidx & 1][d][0], hi = vf[gidx & 1][d][1];
                    va.u.x = lo.x; va.u.y = lo.y; va.u.z = hi.x; va.u.w = hi.y;
                    oa[d0 + d] = __builtin_amdgcn_mfma_f32_16x16x32_bf16(va.h, pb.h, oa[d0 + d], 0, 0, 0); }
                __builtin_amdgcn_sched_barrier(0); }
            const float inv = 1.0f / ls;
            const size_t gt = (size_t)g * T + tq;
#pragma unroll
            for (int dt = 0; dt < 8; ++dt) { u32x2 w; w.x = cvt_pk_bf16(oa[dt][0] * inv, oa[dt][1] * inv); w.y = cvt_pk_bf16(oa[dt][2] * inv, oa[dt][3] * inv);
                if (!dry) *(u32x2*)(og + gt * 1024 + hh * 128 + 16 * dt + 4 * g4) = w; }
            if (g4 == 0 && !dry) lse[gt * 8 + hh] = mx + log2f(ls);
            __syncthreads();
        }
    }
}
__device__ __forceinline__ void attn_merge_phase(const Params& p) {
    const bf16_t* og = (const bf16_t*)(p.ws + WS_BIG + BIG_OG); const float* lse = (const float*)(p.ws + WS_BIG + BIG_LSE); bf16_t* H = (bf16_t*)(p.ws + WS_H);
    const int stride = pg8::ogrid() * NTHR;
    for (int i0 = pg8::obid() * NTHR + pg8::otid(); i0 < T * 128; i0 += 4 * stride) {
        u32x4 v0[4], v1[4], v2[4]; float l0[4], l1[4], l2[4];
#pragma unroll
        for (int u = 0; u < 4; ++u) { const int i = i0 + u * stride; if (i < T * 128) { const int tok = i >> 7, c8 = i & 127, hh = c8 >> 4;
            l0[u] = lse[(size_t)tok * 8 + hh]; l1[u] = lse[((size_t)T + tok) * 8 + hh]; l2[u] = lse[((size_t)2 * T + tok) * 8 + hh];
            v0[u] = *(const u32x4*)(og + (size_t)tok * 1024 + c8 * 8); v1[u] = *(const u32x4*)(og + ((size_t)T + tok) * 1024 + c8 * 8); v2[u] = *(const u32x4*)(og + ((size_t)2 * T + tok) * 1024 + c8 * 8); } }
#pragma unroll
        for (int u = 0; u < 4; ++u) { const int i = i0 + u * stride; if (i < T * 128) { const int tok = i >> 7, c8 = i & 127;
            const float m = fmaxf(l0[u], fmaxf(l1[u], l2[u])); float a0 = exp2f(l0[u] - m), a1 = exp2f(l1[u] - m), a2 = exp2f(l2[u] - m); const float is = 1.0f / (a0 + a1 + a2); a0 *= is; a1 *= is; a2 *= is;
            u32x4 w;
#pragma unroll
            for (int e = 0; e < 4; ++e) { const float lo = a0 * __uint_as_float(v0[u][e] << 16) + a1 * __uint_as_float(v1[u][e] << 16) + a2 * __uint_as_float(v2[u][e] << 16);
                const float hi = a0 * __uint_as_float(v0[u][e] & 0xffff0000u) + a1 * __uint_as_float(v1[u][e] & 0xffff0000u) + a2 * __uint_as_float(v2[u][e] & 0xffff0000u);
                w[e] = cvt_pk_bf16(lo, hi); }
            *(u32x4*)(H + (size_t)tok * 1024 + c8 * 8) = w; } }
    }
}

constexpr int NPHASE = 35;
typedef const __attribute__((address_space(4))) unsigned char* KARG;
template <class Tp> __device__ __forceinline__ Tp karg(int byte_off) { return *(volatile const __attribute__((address_space(4))) Tp*)((KARG)__builtin_amdgcn_kernarg_segment_ptr() + byte_off); }
#define PA(q, member) q.member = karg<decltype(Params::member)>((int)__builtin_offsetof(Params, member))
__global__ void __launch_bounds__(512, 2) mega(Params parg) {
    extern __shared__ __attribute__((aligned(16))) unsigned char shm[];
    LDSQ unsigned char* lds = (LDSQ unsigned char*)shm;
    const int tid = pg8::otid();
    volatile LDSQ unsigned* misc = (volatile LDSQ unsigned*)(lds + LDS_MISC);
    if (tid < 8) misc[tid] = 0u;
    __syncthreads();
    const int ph_lo = parg.ph_lo, ph_hi = parg.ph_hi, probe = parg.probe;
#define REPS(bit, lay) (1 + (1 + ((probe >> 15) & 1)) * (((probe >> (bit)) & 1) & ((((probe >> 10) & 3) == 0) | ((probe >> (10 + ((lay) & 1))) & 1))))
    XcdBarrier bar; bar.bar = nullptr; bar.x = 0; bar.st = misc;
    if (ph_hi - ph_lo > 1) { Params q{}; PA(q, ws); bar = xcd_barrier_post((unsigned*)(q.ws + WS_CTL), misc); }
#define IN(k) (ph_lo <= (k) && (k) < ph_hi)
#define REPBAR() do { if (((probe >> 16) & 1) && rep + 1 < nrep) { Params qb{}; PA(qb, ws); bar.bar = (unsigned*)(qb.ws + WS_CTL); xcd_barrier(bar); } } while (0)
#define SEAM(k) do { if (IN(k) && IN((k) + 1)) { Params qb{}; PA(qb, ws); bar.bar = (unsigned*)(qb.ws + WS_CTL); xcd_barrier(bar); if ((probe >> 12) & 1) { xcd_barrier(bar); xcd_barrier(bar); } } } while (0)

    for (int rep = 0, nrep = REPS(0, 0); rep < nrep; ++rep)
    if (IN(0)) { Params q{}; PA(q, ws); PA(q, c_prompt); PA(q, c_sample); PA(q, ada_w); PA(q, final_ada_w); ada_partials(q, lds); rope_table(q);
                 PA(q, hy_fw1); PA(q, hy_fb1); PA(q, hy_ffreq); PA(q, hy_fw2); PA(q, hy_fb2); PA(q, hy_fw3); filter_mlp(q); }
    SEAM(0);
    for (int rep = 0, nrep = REPS(0, 0); rep < nrep; ++rep)
    if (IN(1)) { Params q{}; PA(q, ws); PA(q, ada_b); PA(q, final_ada_b); ada_reduce(q); }
    SEAM(1);
#pragma unroll 1
    for (int layer = 0; layer < 4; ++layer) {
        const int pb = 2 + 8 * layer, j = layer >> 1; const bool hy = (layer & 1) == 0;
        for (int rep = 0, nrep = REPS(1, layer); rep < nrep; ++rep)
        if (IN(pb + 0)) {
            Params q{}; PA(q, ws); unsigned char* wl = q.ws + WS_WL;
            PA(q, ffn_w_gate); convert_T(lds, q.ffn_w_gate + (size_t)layer * 2048 * DFF, 2048, DFF, (bf16_t*)(wl + WL_FFN1), 0);
            PA(q, ffn_w_up);   convert_T(lds, q.ffn_w_up + (size_t)layer * 2048 * DFF, 2048, DFF, (bf16_t*)(wl + WL_FFN1), 1);
            PA(q, ffn_w_down); convert_T(lds, q.ffn_w_down + (size_t)layer * DFF * 2048, DFF, 2048, (bf16_t*)(wl + WL_FFN2), -1);
            if (hy) { PA(q, hy_w_in);  convert_T(lds, q.hy_w_in + (size_t)j * 2048 * 6144, 2048, 6144, (bf16_t*)(wl + WL_MIXIN), -1);
                      PA(q, hy_w_out); convert_T(lds, q.hy_w_out + (size_t)j * 2048 * 2048, 2048, 2048, (bf16_t*)(wl + WL_MIXOUT), -1); }
            else    { PA(q, at_w_in);  convert_T(lds, q.at_w_in + (size_t)j * 2048 * QKVW, 2048, QKVW, (bf16_t*)(wl + WL_MIXIN), -1);
                      PA(q, at_w_out); convert_T(lds, q.at_w_out + (size_t)j * 1024 * 2048, 1024, 2048, (bf16_t*)(wl + WL_MIXOUT), -1); }
            PA(q, norm_mix);
            const float* modl = (const float*)(q.ws + WS_MOD) + layer * 12288;
            if (layer == 0) { PA(q, x_prompt); PA(q, x_sample); norm_rows<false, true>(q.x_prompt, q.x_sample, (bf16_t*)(q.ws + WS_XB), q.norm_mix + layer * 2048, modl, 0, 2048, (bf16_t*)(q.ws + WS_H), nullptr); }
            else            norm_rows<false, false>(nullptr, nullptr, (bf16_t*)(q.ws + WS_XB), q.norm_mix + layer * 2048, modl, 0, 2048, (bf16_t*)(q.ws + WS_H), nullptr);
            if (hy) { __syncthreads();
                pg8::Gemm g{(const bf16_t*)(q.ws + WS_W3X) + (size_t)j * 8192 * 256, (const bf16_t*)(q.ws + WS_A2X) + (size_t)j * NPOS * 256, 8192, NPOS, 256};
                pg8::StaticOrder S; S.init(8192, NPOS, pg8::ogrid(), pg8::obid());
                EpiTaps E{(_Float16*)(q.ws + WS_BIG + BIG_TAPS)};
                pg8::gemm_phase<EpiTaps, pg8::StaticOrder, false>(lds, g, S, E, nullptr); }
        }
        SEAM(pb + 0);
        for (int rep = 0, nrep = REPS(2, layer); rep < nrep; ++rep)
        if (IN(pb + 1)) {
            Params q{}; PA(q, ws);
            if (hy) { PA(q, hy_b_in); pg8::Gemm g{(const bf16_t*)(q.ws + WS_WL + WL_MIXIN), (const bf16_t*)(q.ws + WS_H), 6144, T, 2048}; pg8::StaticOrder S; S.init(6144, T, pg8::ogrid(), pg8::obid());
                EpiZinT E{(bf16_t*)(q.ws + WS_BIG + BIG_ZINT), T, q.hy_b_in + (size_t)j * 6144};
                pg8::gemm_phase<EpiZinT, pg8::StaticOrder, false>(lds, g, S, E, nullptr); }
            else { pg8::Gemm g{(const bf16_t*)(q.ws + WS_H), (const bf16_t*)(q.ws + WS_WL + WL_MIXIN), T, QKVW, 2048}; pg8::StaticOrder S; S.init(T, QKVW, pg8::ogrid(), pg8::obid());
                EpiQKV E{(bf16_t*)(q.ws + WS_BIG + BIG_QKV), (const cpx*)(q.ws + WS_ROPE)};
                pg8::gemm_phase<EpiQKV, pg8::StaticOrder, false>(lds, g, S, E, nullptr); }
            REPBAR();
        }
        SEAM(pb + 1);
        for (int rep = 0, nrep = REPS(3, layer); rep < nrep; ++rep)
        if (IN(pb + 2)) { Params q{}; PA(q, ws); if (hy) { PA(q, hy_skip); PA(q, hy_conv_w); PA(q, hy_conv_b); PA(q, hy_decay); hyena_conv_phase(q, lds, j, rep + 1 < nrep); } else attn_phase(q, lds, (rep + 1 < nrep) ? (1 | ((probe >> 12) & 2)) : 0); }
        SEAM(pb + 2);
        for (int rep = 0, nrep = REPS(4, layer); rep < nrep; ++rep)
        if (IN(pb + 3)) { Params q{}; PA(q, ws); if (hy) transpose_phase(q, lds); else attn_merge_phase(q); }
        SEAM(pb + 3);
        for (int rep = 0, nrep = REPS(5, layer); rep < nrep; ++rep)
        if (IN(pb + 4)) {
            Params q{}; PA(q, ws); PA(q, hy_b_out);
            pg8::Gemm g{(const bf16_t*)(q.ws + WS_H), (const bf16_t*)(q.ws + WS_WL + WL_MIXOUT), T, 2048, hy ? 2048 : 1024}; pg8::StaticOrder S; S.init(T, 2048, pg8::ogrid(), pg8::obid());
            EpiRes E{(bf16_t*)(q.ws + WS_XB), hy ? q.hy_b_out + (size_t)j * 2048 : nullptr, (const float*)(q.ws + WS_MOD) + layer * 12288 + 4096, rep + 1 < nrep};
            pg8::gemm_phase<EpiRes, pg8::StaticOrder, false>(lds, g, S, E, nullptr);
            REPBAR();
        }
        SEAM(pb + 4);
        for (int rep = 0, nrep = REPS(6, layer); rep < nrep; ++rep)
        if (IN(pb + 5)) { Params q{}; PA(q, ws); PA(q, norm_ffn);
            norm_rows<false, false>(nullptr, nullptr, (bf16_t*)(q.ws + WS_XB), q.norm_ffn + layer * 2048, (const float*)(q.ws + WS_MOD) + layer * 12288, 6144, 8192, (bf16_t*)(q.ws + WS_H), nullptr); }
        SEAM(pb + 5);
        for (int rep = 0, nrep = REPS(7, layer); rep < nrep; ++rep)
        if (IN(pb + 6)) {
            Params q{}; PA(q, ws);
            pg8::Gemm g{(const bf16_t*)(q.ws + WS_H), (const bf16_t*)(q.ws + WS_WL + WL_FFN1), T, 2 * DFF, 2048}; pg8::StaticOrder S; S.init(T, 2 * DFF, pg8::ogrid(), pg8::obid());
            EpiFFN1 E{(bf16_t*)(q.ws + WS_BIG + BIG_MID)};
            pg8::gemm_phase<EpiFFN1, pg8::StaticOrder, false>(lds, g, S, E, nullptr);
            REPBAR();
        }
        SEAM(pb + 6);
        for (int rep = 0, nrep = REPS(8, layer); rep < nrep; ++rep)
        if (IN(pb + 7)) {
            Params q{}; PA(q, ws);
            pg8::Gemm g{(const bf16_t*)(q.ws + WS_BIG + BIG_MID), (const bf16_t*)(q.ws + WS_WL + WL_FFN2), T, 2048, DFF}; pg8::StaticOrder S; S.init(T, 2048, pg8::ogrid(), pg8::obid());
            EpiRes E{(bf16_t*)(q.ws + WS_XB), nullptr, (const float*)(q.ws + WS_MOD) + layer * 12288 + 10240, rep + 1 < nrep};
            pg8::gemm_phase<EpiRes, pg8::StaticOrder, false>(lds, g, S, E, nullptr);
            REPBAR();
        }
        SEAM(pb + 7);
    }
    if (IN(34)) { Params q{}; PA(q, ws); PA(q, out); PA(q, final_norm); final_norm_phase(q); }
#undef REPS
#undef IN
#undef SEAM
}
}

extern "C" void kernel_launch(void* const* d_in, const int* in_sizes, int n_in, void* d_out, int out_size, void* d_ws, size_t ws_size, hipStream_t stream) {
    static int grid = 0;
    if (grid == 0) {
        if (n_in != 30 || out_size != mk::T * mk::D || ws_size < mk::WS_TOTAL) { fprintf(stderr, "kernel_launch: unexpected shapes (n_in %d out %d ws %zu need %zu); nothing launched\n", n_in, out_size, ws_size, (size_t)mk::WS_TOTAL); grid = -1; return; }
        int dev = 0, cus = 0;
        if (hipGetDevice(&dev) != hipSuccess || hipDeviceGetAttribute(&cus, hipDeviceAttributeMultiprocessorCount, dev) != hipSuccess) { grid = -1; return; }
        if (hipFuncSetAttribute((const void*)mk::mega, hipFuncAttributeMaxDynamicSharedMemorySize, mk::LDS_BYTES) != hipSuccess) { fprintf(stderr, "kernel_launch: hipFuncSetAttribute failed\n"); grid = -1; return; }
        int per_cu = 0; (void)hipOccupancyMaxActiveBlocksPerMultiprocessor(&per_cu, (const void*)mk::mega, 512, mk::LDS_BYTES); (void)hipGetLastError();
        if (per_cu < 1) fprintf(stderr, "kernel_launch: occupancy query reports %d blocks per CU\n", per_cu);
        grid = cus > 256 ? 256 : cus;
    }
    if (grid < 0) return;
    mk::Params p{};
    const float** f = (const float**)&p;
    for (int i = 0; i < 30; ++i) f[i] = (const float*)d_in[i];
    p.out = (float*)d_out; p.ws = (unsigned char*)d_ws; p.probe = MK_PROBE;
#if MK_PER_PHASE
    for (int k = 0; k < mk::NPHASE; ++k) { p.ph_lo = k; p.ph_hi = k + 1; hipLaunchKernelGGL(mk::mega, dim3(grid), dim3(512), mk::LDS_BYTES, stream, p); }
#else
    (void)hipMemsetAsync((char*)d_ws + mk::WS_CTL, 0, mk::CTL_BYTES, stream);
    p.ph_lo = 0; p.ph_hi = mk::NPHASE;
    hipLaunchKernelGGL(mk::mega, dim3(grid), dim3(512), mk::LDS_BYTES, stream, p);
#endif
}
```

```cpp
#include <hip/hip_runtime.h>
#include <cstdio>
#include <cstdint>
#include <utility>
#ifndef MK_PER_PHASE
#define MK_PER_PHASE 0
#endif
#ifndef MK_PROBE
#define MK_PROBE 0
#endif
namespace pg8 {
#define PG8_LAS __attribute__((address_space(3)))
__device__ __forceinline__ int otid() { int t = threadIdx.x; asm volatile("" : "+v"(t) :: "memory"); return t; }
__device__ __forceinline__ int obid() { int b = blockIdx.x; asm volatile("" : "+s"(b)); return b; }
__device__ __forceinline__ int ogrid() { int g = gridDim.x; asm volatile("" : "+s"(g)); return g; }
typedef unsigned short bf16_t;
typedef short bf16x8 __attribute__((ext_vector_type(8)));
typedef float f32x4 __attribute__((ext_vector_type(4)));
typedef unsigned u32x4 __attribute__((ext_vector_type(4)));
constexpr int BM = 256, BK = 64, HALF = 128, HTB = HALF * BK * 2  , STAGE_BYTES = 8 * HTB, NXCD = 8, WGM = 4;

__host__ __device__ __forceinline__ int lds_byte(int r, int c) { const int st = (r >> 4) * 2 + (c >> 5), rr = r & 15, cc = c & 31, ob = rr * 64 + cc * 2; return st * 1024 + (ob ^ (((ob >> 9) & 1) << 5)); }
__host__ __device__ __forceinline__ void stage_rc(int b, int& R, int& C) { const int st = b / 1024, sb = b % 1024, swz = sb ^ (((sb >> 9) & 1) << 5); R = (st >> 1) * 16 + swz / 64; C = (st & 1) * 32 + (swz % 64) / 2; }
__host__ __device__ __forceinline__ int perm32(int rho) { const int n = rho >> 4, i = rho & 15; return 8 * (i >> 2) + 4 * n + (i & 3); }

struct Unit { int pm, pn; };
struct Gemm { const bf16_t* A; const bf16_t* Bt; int M, N, K; };

struct StaticOrder {
    int nM, nN, nwg, G, c, wgm;
    __host__ __device__ void init(int M, int N, int G_, int c_, int wgm_ = WGM) { nM = M / BM; nN = N / BM; nwg = nM * nN; G = G_; c = c_; wgm = wgm_; }
    __host__ __device__ bool next(int i, Unit& u) const {
        const long L = (long)i * G + c; if (L >= nwg) return false;
        int wgid = (int)L; { const int q = nwg / NXCD, r = nwg % NXCD, xcd = wgid % NXCD, off = wgid / NXCD; wgid = (xcd < r ? xcd * (q + 1) : r * (q + 1) + (xcd - r) * q) + off; }
        const int nig = wgm * nN, gid = wgid / nig, fm = gid * wgm, gsz = (nM - fm) < wgm ? (nM - fm) : wgm;
        u.pm = fm + ((wgid % nig) % gsz); u.pn = (wgid % nig) / gsz; return true;
    }
    __device__ __forceinline__ void a_ready(const Unit&) const {}
    __device__ __forceinline__ void done(const Unit&) const {}
};
__device__ __forceinline__ unsigned cvt_pk_bf16(float lo, float hi) { unsigned r; asm volatile("v_cvt_pk_bf16_f32 %0, %1, %2" : "=v"(r) : "v"(lo), "v"(hi)); return r; }
template <class Epi, class Sched, bool STAMP = false>
__device__ __forceinline__ void gemm_phase(PG8_LAS unsigned char* lds, const Gemm g, const Sched& S, const Epi& E, unsigned long long* stamps) {
    const int tid = otid(), wid = __builtin_amdgcn_readfirstlane(tid >> 6), lane = tid & 63, wr = wid >> 2, wc = wid & 3, fr = lane & 15, fq = lane >> 4;
    const int K = g.K, nt = K / BK;
    int ts_lo = 0, ts_hi = 0, nts = 0; const unsigned long long rt_entry = STAMP ? (unsigned long long)wall_clock64() : 0ull;
#define PG8_STAMP() do { if (STAMP && wid == 0 && nts < 64) { const unsigned long long _c = (unsigned long long)clock64(); \
        ts_lo = (lane == nts) ? (int)(unsigned)_c : ts_lo; ts_hi = (lane == nts) ? (int)(unsigned)(_c >> 32) : ts_hi; ++nts; } } while (0)
    PG8_STAMP();
    unsigned voffA[2], voffB[2];
#pragma unroll
    for (int i = 0; i < 2; ++i) { int R, C; stage_rc(tid * 16 + i * 8192, R, C); const int Rb = Epi::PERM ? ((R & ~31) + perm32(R & 31)) : R;
        voffA[i] = (unsigned)(R * K + C) * 2u; voffB[i] = (unsigned)(Rb * K + C) * 2u; }
    const size_t kstep = (size_t)(BK * 2);
    const size_t hstep = (size_t)HALF * K * 2;
    const size_t tstep = 2 * hstep;
    const unsigned ldsw = (unsigned)wid * 1024u;
    const int aoff = lds_byte(wr * 64 + fr, fq * 8), boff = lds_byte(wc * 32 + fr, fq * 8);
#define PG8_SA(b, h) (((b) * 2 + (h)) * HTB)
#define PG8_SB(b, h) ((4 + (b) * 2 + (h)) * HTB)
#define PG8_STAGE(bufoff, gbase, voff) do { _Pragma("unroll") for (int _i = 0; _i < 2; ++_i) \
        __builtin_amdgcn_global_load_lds((const unsigned*)((const char*)(gbase) + (voff)[_i]), (PG8_LAS unsigned*)(lds + (bufoff) + ldsw + _i * 8192), 16, 0, 0); } while (0)
#define PG8_LDA(dst, b, h) do { _Pragma("unroll") for (int m = 0; m < 4; ++m) _Pragma("unroll") for (int k = 0; k < 2; ++k) dst[m][k] = *(const PG8_LAS bf16x8*)(lds + PG8_SA(b, h) + aoff + m * 2048 + k * 1024); } while (0)
#define PG8_LDB(dst, b, h) do { _Pragma("unroll") for (int n = 0; n < 2; ++n) _Pragma("unroll") for (int k = 0; k < 2; ++k) dst[n][k] = *(const PG8_LAS bf16x8*)(lds + PG8_SB(b, h) + boff + n * 2048 + k * 1024); } while (0)
#define PG8_MMA(ai, bj, At, Bt) do { __builtin_amdgcn_s_setprio(1); _Pragma("unroll") for (int m = 0; m < 4; ++m) _Pragma("unroll") for (int n = 0; n < 2; ++n) _Pragma("unroll") for (int k = 0; k < 2; ++k) \
        acc[ai][bj][m][n] = __builtin_amdgcn_mfma_f32_16x16x32_bf16(Bt[n][k], At[m][k], acc[ai][bj][m][n], 0, 0, 0); __builtin_amdgcn_s_setprio(0); } while (0)
#define PG8_WAIT_V(n) asm volatile("s_waitcnt vmcnt(" #n ")" ::: "memory")
#define PG8_WAIT_L(n) asm volatile("s_waitcnt lgkmcnt(" #n ")" ::: "memory")
#define PG8_BAR __builtin_amdgcn_s_barrier()
#define PG8_SCHED __builtin_amdgcn_sched_barrier(0)
    Unit cur, nxt; int ui = 0;
    if (!S.next(0, cur)) return;
    f32x4 acc[2][2][4][2];
#pragma unroll
    for (int a = 0; a < 2; ++a)
#pragma unroll
        for (int b = 0; b < 2; ++b)
#pragma unroll
            for (int m = 0; m < 4; ++m)
#pragma unroll
                for (int n = 0; n < 2; ++n) acc[a][b][m][n] = (f32x4){0.f, 0.f, 0.f, 0.f};
    bf16x8 At[4][2], B0[2][2], B1[2][2];
    const char* cA = (const char*)g.A + (size_t)cur.pm * tstep; const char* cB = (const char*)g.Bt + (size_t)cur.pn * tstep;
    S.a_ready(cur);
    PG8_STAGE(PG8_SB(0, 0), cB, voffB); PG8_STAGE(PG8_SA(0, 0), cA, voffA); PG8_STAGE(PG8_SB(0, 1), cB + hstep, voffB); PG8_STAGE(PG8_SA(0, 1), cA + hstep, voffA);
    if (wr == 1) PG8_BAR;
    PG8_WAIT_V(4); PG8_BAR;
    PG8_STAGE(PG8_SB(1, 0), cB + kstep, voffB); PG8_STAGE(PG8_SA(1, 0), cA + kstep, voffA); PG8_STAGE(PG8_SB(1, 1), cB + hstep + kstep, voffB);
    PG8_WAIT_V(6); PG8_BAR;
    PG8_STAMP();
    for (;;) {
        const bool has_next = S.next(ui + 1, nxt);
        const char* nA = has_next ? (const char*)g.A + (size_t)nxt.pm * tstep : cA; const char* nB = has_next ? (const char*)g.Bt + (size_t)nxt.pn * tstep : cB;
        for (int t = 0; t < nt; t += 2) {
            const bool last = (t == nt - 2);
            const char* a1 = cA + (size_t)(t + 1) * kstep;
            const char* a2 = last ? nA : cA + (size_t)(t + 2) * kstep; const char* b2 = last ? nB : cB + (size_t)(t + 2) * kstep;
            const char* a3 = a2 + kstep; const char* b3 = b2 + kstep;
            if (last && has_next) S.a_ready(nxt);
            PG8_LDB(B0, 0, 0); PG8_SCHED; PG8_LDA(At, 0, 0); PG8_STAGE(PG8_SA(1, 1), a1 + hstep, voffA);
            PG8_WAIT_L(8); PG8_BAR; PG8_WAIT_L(0); PG8_MMA(0, 0, At, B0); PG8_BAR; PG8_SCHED;
            PG8_LDB(B1, 0, 1); PG8_STAGE(PG8_SB(0, 0), b2, voffB);
            PG8_BAR; PG8_WAIT_L(0); PG8_MMA(0, 1, At, B1); PG8_BAR;
            PG8_LDA(At, 0, 1); PG8_STAGE(PG8_SA(0, 0), a2, voffA);
            PG8_BAR; PG8_WAIT_L(0); PG8_MMA(1, 0, At, B0); PG8_BAR; PG8_SCHED;
            PG8_STAGE(PG8_SB(0, 1), b2 + hstep, voffB);
            PG8_WAIT_V(6); PG8_BAR; PG8_MMA(1, 1, At, B1); PG8_BAR;
            PG8_LDB(B0, 1, 0); PG8_SCHED; PG8_LDA(At, 1, 0); PG8_STAGE(PG8_SA(0, 1), a2 + hstep, voffA);
            PG8_WAIT_L(8); PG8_BAR; PG8_WAIT_L(0); PG8_MMA(0, 0, At, B0); PG8_BAR; PG8_SCHED;
            PG8_LDB(B1, 1, 1); PG8_STAGE(PG8_SB(1, 0), b3, voffB);
            PG8_BAR; PG8_WAIT_L(0); PG8_MMA(0, 1, At, B1); PG8_BAR;
            PG8_LDA(At, 1, 1); PG8_STAGE(PG8_SA(1, 0), a3, voffA);
            PG8_BAR; PG8_WAIT_L(0); PG8_MMA(1, 0, At, B0); PG8_BAR; PG8_SCHED;
            PG8_STAGE(PG8_SB(1, 1), b3 + hstep, voffB);
            PG8_WAIT_V(6); PG8_BAR; PG8_MMA(1, 1, At, B1); PG8_BAR;
        }
        PG8_STAMP();
        if constexpr (!Epi::AFTER_DRAIN) { E(acc, cur, wr, wc, fr, fq); S.done(cur); }
        PG8_STAMP();
        if (!has_next) break;
#pragma unroll
        for (int a = 0; a < 2; ++a)
#pragma unroll
            for (int b = 0; b < 2; ++b)
#pragma unroll
                for (int m = 0; m < 4; ++m)
#pragma unroll
                    for (int n = 0; n < 2; ++n) acc[a][b][m][n] = (f32x4){0.f, 0.f, 0.f, 0.f};
        cur = nxt; cA = nA; cB = nB; ++ui;
    }
    PG8_WAIT_V(0);
    if (wr == 0) PG8_BAR;
    PG8_BAR;
    if constexpr (Epi::AFTER_DRAIN) { E.fused(acc, cur, wr, wc, fr, fq, lds, wid, lane); S.done(cur); }
    PG8_STAMP();
    if (STAMP && wid == 0) { stamps[lane] = lane < nts ? (((unsigned long long)(unsigned)ts_hi << 32) | (unsigned)ts_lo) : 0ull;
        if (lane == 62) stamps[62] = rt_entry; if (lane == 63) stamps[63] = (unsigned long long)wall_clock64(); }
#undef PG8_STAMP
#undef PG8_SA
#undef PG8_SB
#undef PG8_STAGE
#undef PG8_LDA
#undef PG8_LDB
#undef PG8_MMA
#undef PG8_WAIT_V
#undef PG8_WAIT_L
#undef PG8_BAR
#undef PG8_SCHED
}
}
#define XB_TMO      128
#define XB_XCNT(j)  (256  + 64 * (j))
#define XB_XSUB(j)  (1280 + 64 * (j))
#define XB_XGEN(j)  (2304 + 64 * (j))
#define XB_TOP      3328
#define XB_TOPGEN   3392
#define XCD_BAR_WORDS 3456
#define XB_SPIN_CAP (1u << 18)
#define LAS __attribute__((address_space(3)))

__device__ __forceinline__ unsigned xb_ld(unsigned* p)              { return __hip_atomic_load(p, __ATOMIC_RELAXED, __HIP_MEMORY_SCOPE_AGENT); }
__device__ __forceinline__ unsigned xb_add(unsigned* p, unsigned v) { return __hip_atomic_fetch_add(p, v, __ATOMIC_RELAXED, __HIP_MEMORY_SCOPE_AGENT); }
__device__ __forceinline__ unsigned xb_xcc_id() { return (unsigned)__builtin_amdgcn_s_getreg((3 << 11) | 20) & 0xFu; }
#define XB_SPIN(cond, bar) do { unsigned _sp = 0; while (cond) { __builtin_amdgcn_s_sleep(1); \
    if ((++_sp & 255u) == 0u) { if (xb_ld(&(bar)[XB_TMO])) break; if (_sp > XB_SPIN_CAP) { atomicAdd(&(bar)[XB_TMO], 1u); break; } } } } while (0)

struct XcdBarrier {
    unsigned* bar; unsigned x;
    volatile LAS unsigned* st;
};

__device__ __forceinline__ XcdBarrier xcd_barrier_post(unsigned* bar, volatile LAS unsigned* st) {
    XcdBarrier b; b.bar = bar; b.x = xb_xcc_id(); b.st = st;
    if (threadIdx.x == 0) (void)xb_add(&bar[XB_XCNT(b.x)], 1u);
    return b;
}
__device__ __forceinline__ void xcd_barrier_complete(unsigned* bar, unsigned x, unsigned& nloc, unsigned& nx) {
    const unsigned G = gridDim.x * gridDim.y * gridDim.z;
    unsigned sum, cnt, mine, sp = 0u;
    for (;;) {
        sum = 0u; cnt = 0u; mine = 0u;
#pragma unroll
        for (unsigned j = 0; j < 16; ++j) { const unsigned c = xb_ld(&bar[XB_XCNT(j)]); sum += c; cnt += (c > 0u) ? 1u : 0u; mine = (j == x) ? c : mine; }
        if (sum == G) break;
        __builtin_amdgcn_s_sleep(1);
        if ((++sp & 255u) == 0u) { if (xb_ld(&bar[XB_TMO])) break; if (sp > XB_SPIN_CAP) { atomicAdd(&bar[XB_TMO], 1u); break; } }
    }
    nloc = mine > 0u ? mine : 1u; nx = cnt > 0u ? cnt : 1u;
}

__device__ __forceinline__ void xcd_barrier(const XcdBarrier& b) {
    asm volatile("s_waitcnt vmcnt(0)" ::: "memory");
    __syncthreads();
    if (threadIdx.x == 0) {
        unsigned* bar = b.bar;
        __builtin_amdgcn_s_waitcnt(0);
        unsigned nloc = b.st[0], nx = b.st[1];
        if (nloc == 0u) { xcd_barrier_complete(bar, b.x, nloc, nx); b.st[0] = nloc; b.st[1] = nx; }
        const unsigned old = xb_add(&bar[XB_XSUB(b.x)], 1u);
        const unsigned gen = old / nloc;
        if (old + 1u == (gen + 1u) * nloc) {
            __builtin_amdgcn_fence(__ATOMIC_RELEASE, "agent");
            asm volatile("s_waitcnt vmcnt(0)" ::: "memory");
            const unsigned og = xb_add(&bar[XB_TOP], 1u);
            const unsigned tg = og / nx;
            if (og + 1u == (tg + 1u) * nx) xb_add(&bar[XB_TOPGEN], 1u);
            else XB_SPIN(xb_ld(&bar[XB_TOPGEN]) == tg, bar);
            __builtin_amdgcn_fence(__ATOMIC_ACQUIRE, "agent");
            xb_add(&bar[XB_XGEN(b.x)], 1u);
            asm volatile("s_waitcnt vmcnt(0)" ::: "memory");
        } else {
            XB_SPIN(xb_ld(&bar[XB_XGEN(b.x)]) == gen, bar);
            __builtin_amdgcn_fence(__ATOMIC_ACQUIRE, "agent");
            asm volatile("s_waitcnt vmcnt(0)" ::: "memory");
        }
    }
    __syncthreads();
}


namespace mk {
using pg8::bf16_t; using pg8::bf16x8; using pg8::f32x4; using pg8::u32x4; using pg8::Unit; using pg8::cvt_pk_bf16;
typedef unsigned u32x2 __attribute__((ext_vector_type(2)));
typedef float cpx __attribute__((ext_vector_type(2)));
__host__ __device__ __forceinline__ cpx mkc(float a, float b) { cpx r; r.x = a; r.y = b; return r; }

constexpr int D = 2048, T_P = 32768, T_S = 8192, T = 40960, L_P = 16384, L_S = 2048, DFF = 5632;
constexpr int NTHR = 512;
constexpr int MODW = 53248;
constexpr int NPOS = 18432;
constexpr int QKVW = 9216;
constexpr float EPS = 1e-6f;
constexpr float QSCALE = 0.12751743082459868f;
constexpr int LDS_BYTES = 147456;
constexpr int LDS_MISC = 147456 - 256;

constexpr size_t al256(size_t x) { return (x + 255) & ~(size_t)255; }
constexpr size_t WS_CTL  = 0;
constexpr size_t CTL_BYTES = 65536;
constexpr size_t WS_PART = WS_CTL + CTL_BYTES;
constexpr size_t WS_MOD  = WS_PART + al256((size_t)8 * 6 * MODW * 4);
constexpr size_t WS_ROPE = WS_MOD + al256((size_t)6 * MODW * 4);
constexpr size_t WS_A2X  = WS_ROPE + (size_t)16384 * 16 * 8;
constexpr size_t WS_W3X  = WS_A2X + (size_t)2 * NPOS * 256 * 2;
constexpr size_t WS_WL   = WS_W3X + (size_t)2 * 8192 * 256 * 2;
constexpr size_t WL_FFN1 = 0;
constexpr size_t WL_FFN2 = WL_FFN1 + (size_t)11264 * 2048 * 2;
constexpr size_t WL_MIXIN = WL_FFN2 + (size_t)2048 * 5632 * 2;
constexpr size_t WL_MIXOUT = WL_MIXIN + (size_t)9216 * 2048 * 2;
constexpr size_t WL_BYTES = WL_MIXOUT + (size_t)2048 * 2048 * 2;
constexpr size_t WS_H    = WS_WL + WL_BYTES;
constexpr size_t H_BYTES = (size_t)T * 2048 * 2;
constexpr size_t WS_BIG  = WS_H + H_BYTES;
constexpr size_t BIG_ZINT = 0;
constexpr size_t BIG_TAPS = BIG_ZINT + (size_t)6144 * T * 2;
constexpr size_t BIG_HY_END = BIG_TAPS + (size_t)8192 * NPOS * 2;
constexpr size_t BIG_QKV = 0;
constexpr size_t BIG_OG  = BIG_QKV + (size_t)T * QKVW * 2;
constexpr size_t BIG_LSE = BIG_OG + (size_t)3 * T * 1024 * 2;
constexpr size_t BIG_AT_END = BIG_LSE + (size_t)3 * T * 8 * 4;
constexpr size_t BIG_MID = 0;
constexpr size_t BIG_BYTES = BIG_HY_END > BIG_AT_END ? BIG_HY_END : BIG_AT_END;
constexpr size_t WS_END  = WS_BIG + BIG_BYTES;
constexpr size_t FFT_SCR_PER_WG = 5 * 131072;
constexpr size_t FFT_EXT_PER_WG = 2 * 65536;
constexpr size_t WS_XB = WS_END + (size_t)256 * FFT_EXT_PER_WG;
constexpr size_t WS_TOTAL = WS_XB + (size_t)T * 2048 * 2;
static_assert(256 * FFT_SCR_PER_WG <= H_BYTES, "fft scratch must fit in H");

struct Params {
    const float *x_prompt, *x_sample, *c_prompt, *c_sample, *ada_w, *ada_b, *norm_mix, *norm_ffn;
    const float *hy_w_in, *hy_b_in, *hy_conv_w, *hy_conv_b, *hy_fw1, *hy_fb1, *hy_ffreq, *hy_fw2, *hy_fb2, *hy_fw3, *hy_decay, *hy_skip, *hy_w_out, *hy_b_out;
    const float *at_w_in, *at_w_out, *ffn_w_gate, *ffn_w_up, *ffn_w_down, *final_norm, *final_ada_w, *final_ada_b;
    float* out; unsigned char* ws; int ph_lo, ph_hi, probe, pad0;
};

#define LDSQ __attribute__((address_space(3)))

__device__ __forceinline__ float bf2f(bf16_t b) { return __uint_as_float(((unsigned)b) << 16); }
__device__ __forceinline__ bf16_t f2bf(float f) { unsigned u = __float_as_uint(f); u += 0x7FFFu + ((u >> 16) & 1u); return (bf16_t)(u >> 16); }
__device__ __forceinline__ int seq_of_row(int row) { return row < T_P ? (row >> 14) : 2 + ((row - T_P) >> 11); }
__device__ __forceinline__ int pos_of_row(int row) { return row < T_P ? (row & 16383) : (row & 2047); }
__device__ __forceinline__ float wave_sum(float v) {
#pragma unroll
    for (int o = 32; o >= 1; o >>= 1) v += __shfl_xor(v, o);
    return v;
}

struct EpiZinT {
    static constexpr bool PERM = true, AFTER_DRAIN = false;
    bf16_t* O; int ldc; const float* bias;
    __device__ __forceinline__ void operator()(const f32x4 (&acc)[2][2][4][2], const Unit& u, int wr, int wc, int fr, int fq) const {
        const int row0 = u.pm * 256 + wr * 64 + fr, col0 = u.pn * 256 + wc * 32 + 8 * fq;
        float bs[8];
#pragma unroll
        for (int r = 0; r < 8; ++r) bs[r] = bias[row0 + (r >> 2) * 128 + (r & 3) * 16];
#pragma unroll
        for (int ai = 0; ai < 2; ++ai)
#pragma unroll
            for (int m = 0; m < 4; ++m) { const int r = row0 + ai * 128 + m * 16; const float b = bs[ai * 4 + m]; bf16_t* rowp = O + (size_t)r * ldc + col0;
#pragma unroll
                for (int bj = 0; bj < 2; ++bj) { const f32x4 v0 = acc[ai][bj][m][0] + b, v1 = acc[ai][bj][m][1] + b;
                    u32x4 w; w.x = cvt_pk_bf16(v0[0], v0[1]); w.y = cvt_pk_bf16(v0[2], v0[3]); w.z = cvt_pk_bf16(v1[0], v1[1]); w.w = cvt_pk_bf16(v1[2], v1[3]);
                    *(u32x4*)(rowp + bj * 128) = w; } }
    }
};
struct EpiRes {
    static constexpr bool PERM = true, AFTER_DRAIN = false;
    bf16_t* X; const float* bias; const float* gate; int dry;
    __device__ __forceinline__ void operator()(const f32x4 (&acc)[2][2][4][2], const Unit& u, int wr, int wc, int fr, int fq) const {
        const int row0 = u.pm * 256 + wr * 64 + fr, col0 = u.pn * 256 + wc * 32 + 8 * fq;
        const float* gp = gate + (size_t)seq_of_row(u.pm * 256) * MODW + col0;
        bf16_t* xb = X + (size_t)row0 * 2048 + col0;
        u32x4 xv[2][4]; f32x4 gv[2][2], bv[2][2];
#pragma unroll
        for (int m4 = 0; m4 < 4; ++m4) xv[0][m4] = *(const u32x4*)(xb + (size_t)(m4 * 16) * 2048);
#pragma unroll
        for (int n = 0; n < 2; ++n) { gv[0][n] = *(const f32x4*)(gp + 4 * n); bv[0][n] = bias ? *(const f32x4*)(bias + col0 + 4 * n) : (f32x4){0.f, 0.f, 0.f, 0.f}; }
#pragma unroll
        for (int c = 0; c < 4; ++c) { const int bj = c >> 1, ai = c & 1;
            if (c < 3) { const int bj2 = (c + 1) >> 1, ai2 = (c + 1) & 1;
#pragma unroll
                for (int m4 = 0; m4 < 4; ++m4) xv[(c + 1) & 1][m4] = *(const u32x4*)(xb + (size_t)(ai2 * 128 + m4 * 16) * 2048 + bj2 * 128);
                if (c == 1) {
#pragma unroll
                    for (int n = 0; n < 2; ++n) { gv[1][n] = *(const f32x4*)(gp + 128 + 4 * n); bv[1][n] = bias ? *(const f32x4*)(bias + col0 + 128 + 4 * n) : (f32x4){0.f, 0.f, 0.f, 0.f}; } } }
#pragma unroll
            for (int m4 = 0; m4 < 4; ++m4) { const u32x4 xo = xv[c & 1][m4];
                const f32x4 xa = {__uint_as_float(xo.x << 16), __uint_as_float(xo.x & 0xffff0000u), __uint_as_float(xo.y << 16), __uint_as_float(xo.y & 0xffff0000u)};
                const f32x4 xc = {__uint_as_float(xo.z << 16), __uint_as_float(xo.z & 0xffff0000u), __uint_as_float(xo.w << 16), __uint_as_float(xo.w & 0xffff0000u)};
                const f32x4 ya = xa + gv[bj][0] * (acc[ai][bj][m4][0] + bv[bj][0]), yc = xc + gv[bj][1] * (acc[ai][bj][m4][1] + bv[bj][1]);
                u32x4 w; w.x = cvt_pk_bf16(ya[0], ya[1]); w.y = cvt_pk_bf16(ya[2], ya[3]); w.z = cvt_pk_bf16(yc[0], yc[1]); w.w = cvt_pk_bf16(yc[2], yc[3]);
                if (!dry) *(u32x4*)(xb + (size_t)(ai * 128 + m4 * 16) * 2048 + bj * 128) = w; } }
    }
};
struct EpiQKV {
    static constexpr bool PERM = true, AFTER_DRAIN = false;
    bf16_t* O; const cpx* rope;
    __device__ __forceinline__ void operator()(const f32x4 (&acc)[2][2][4][2], const Unit& u, int wr, int wc, int fr, int fq) const {
        const int row0 = u.pm * 256 + wr * 64 + fr, colt = u.pn * 256, col0 = colt + wc * 32 + 8 * fq;
        const int sidx = (colt % 3072) >> 10;
        const bool dorope = (sidx < 2) && (wc == 0);
        const float qs = (sidx == 0) ? QSCALE : 1.0f;
        f32x4 tt[2][4];
        if (dorope) { const cpx* rp = rope + (size_t)pos_of_row(row0) * 16 + 8 * (fq & 1);
            tt[0][0] = *(const f32x4*)(rp); tt[0][1] = *(const f32x4*)(rp + 2); tt[0][2] = *(const f32x4*)(rp + 4); tt[0][3] = *(const f32x4*)(rp + 6); }
#pragma unroll
        for (int g = 0; g < 8; ++g) { const int ai = g >> 2, m = g & 3; const int r = row0 + ai * 128 + m * 16; bf16_t* rowp = O + (size_t)r * QKVW + col0;
            f32x4 c0, c1, s0, s1;
            if (dorope) {
                if (g < 7) { const int r2 = row0 + ((g + 1) >> 2) * 128 + ((g + 1) & 3) * 16; const cpx* rp = rope + (size_t)pos_of_row(r2) * 16 + 8 * (fq & 1);
                    tt[(g + 1) & 1][0] = *(const f32x4*)(rp); tt[(g + 1) & 1][1] = *(const f32x4*)(rp + 2); tt[(g + 1) & 1][2] = *(const f32x4*)(rp + 4); tt[(g + 1) & 1][3] = *(const f32x4*)(rp + 6); }
                const f32x4 t0 = tt[g & 1][0], t1 = tt[g & 1][1], t2 = tt[g & 1][2], t3 = tt[g & 1][3];
                c0 = (f32x4){t0[0], t0[2], t1[0], t1[2]}; s0 = (f32x4){t0[1], t0[3], t1[1], t1[3]};
                c1 = (f32x4){t2[0], t2[2], t3[0], t3[2]}; s1 = (f32x4){t2[1], t2[3], t3[1], t3[3]}; }
#pragma unroll
            for (int bj = 0; bj < 2; ++bj) { f32x4 v0 = acc[ai][bj][m][0], v1 = acc[ai][bj][m][1];
                if (dorope) { f32x4 p0, p1;
#pragma unroll
                    for (int e = 0; e < 4; ++e) { p0[e] = __shfl_xor(v0[e], 32); p1[e] = __shfl_xor(v1[e], 32); }
                    if (fq < 2) { v0 = v0 * c0 - p0 * s0; v1 = v1 * c1 - p1 * s1; }
                    else        { v0 = v0 * c0 + p0 * s0; v1 = v1 * c1 + p1 * s1; } }
                v0 *= qs; v1 *= qs;
                u32x4 w; w.x = cvt_pk_bf16(v0[0], v0[1]); w.y = cvt_pk_bf16(v0[2], v0[3]); w.z = cvt_pk_bf16(v1[0], v1[1]); w.w = cvt_pk_bf16(v1[2], v1[3]);
                *(u32x4*)(rowp + bj * 128) = w; } }
    }
};
struct EpiFFN1 {
    static constexpr bool PERM = true, AFTER_DRAIN = false;
    bf16_t* O;
    __device__ __forceinline__ void operator()(const f32x4 (&acc)[2][2][4][2], const Unit& u, int wr, int wc, int fr, int fq) const {
        const int row0 = u.pm * 256 + wr * 64 + fr, col0 = u.pn * 128 + wc * 32 + 8 * fq;
#pragma unroll
        for (int ai = 0; ai < 2; ++ai)
#pragma unroll
            for (int m = 0; m < 4; ++m) { bf16_t* rowp = O + (size_t)(row0 + ai * 128 + m * 16) * DFF + col0; float o[8];
#pragma unroll
                for (int n = 0; n < 2; ++n)
#pragma unroll
                    for (int e = 0; e < 4; ++e) { const float g = acc[ai][0][m][n][e], up = acc[ai][1][m][n][e]; o[n * 4 + e] = g * __builtin_amdgcn_rcpf(1.0f + __expf(-g)) * up; }
                u32x4 w; w.x = cvt_pk_bf16(o[0], o[1]); w.y = cvt_pk_bf16(o[2], o[3]); w.z = cvt_pk_bf16(o[4], o[5]); w.w = cvt_pk_bf16(o[6], o[7]);
                *(u32x4*)rowp = w; }
    }
};
struct EpiTaps {
    static constexpr bool PERM = true, AFTER_DRAIN = false;
    _Float16* O;
    __device__ __forceinline__ void operator()(const f32x4 (&acc)[2][2][4][2], const Unit& u, int wr, int wc, int fr, int fq) const {
        typedef _Float16 h8 __attribute__((ext_vector_type(8)));
        const int row0 = u.pm * 256 + wr * 64 + fr, col0 = u.pn * 256 + wc * 32 + 8 * fq;
#pragma unroll
        for (int ai = 0; ai < 2; ++ai)
#pragma unroll
            for (int m = 0; m < 4; ++m) { _Float16* rowp = O + (size_t)(row0 + ai * 128 + m * 16) * NPOS + col0;
#pragma unroll
                for (int bj = 0; bj < 2; ++bj) { const f32x4 v0 = acc[ai][bj][m][0], v1 = acc[ai][bj][m][1]; h8 w;
                    w[0] = (_Float16)v0[0]; w[1] = (_Float16)v0[1]; w[2] = (_Float16)v0[2]; w[3] = (_Float16)v0[3]; w[4] = (_Float16)v1[0]; w[5] = (_Float16)v1[1]; w[6] = (_Float16)v1[2]; w[7] = (_Float16)v1[3];
                    *(h8*)(rowp + bj * 128) = w; } }
    }
};

__device__ __forceinline__ void ada_partials(const Params& p, LDSQ unsigned char* lds) {
    LDSQ float* cs = (LDSQ float*)lds;
    for (int i = pg8::otid(); i < 6 * 2048; i += NTHR) { const int b = i >> 11, k = i & 2047; const float c = b < 2 ? p.c_prompt[b * 2048 + k] : p.c_sample[(b - 2) * 2048 + k]; cs[i] = c / (1.0f + expf(-c)); }
    __syncthreads();
    float* part = (float*)(p.ws + WS_PART);
    for (int item = pg8::obid() * NTHR + pg8::otid(); item < 8 * 13312; item += pg8::ogrid() * NTHR) {
        const int chunk = item / 13312, c4 = item % 13312;
        const float* W; int ldw;
        if (c4 < 12288) { const int layer = c4 / 3072, col = (c4 % 3072) * 4; W = p.ada_w + (size_t)layer * 2048 * 12288 + col; ldw = 12288; }
        else { W = p.final_ada_w + (c4 - 12288) * 4; ldw = 4096; }
        f32x4 a0 = {0.f, 0.f, 0.f, 0.f}, a1 = a0, a2 = a0, a3 = a0, a4 = a0, a5 = a0;
        const int k0 = chunk * 256;
#pragma unroll 8
        for (int k = k0; k < k0 + 256; ++k) { const f32x4 w = *(const f32x4*)(W + (size_t)k * ldw);
            a0 += cs[k] * w; a1 += cs[2048 + k] * w; a2 += cs[4096 + k] * w; a3 += cs[6144 + k] * w; a4 += cs[8192 + k] * w; a5 += cs[10240 + k] * w; }
        float* o = part + (size_t)chunk * 6 * MODW + (size_t)c4 * 4;
        *(f32x4*)(o) = a0; *(f32x4*)(o + MODW) = a1; *(f32x4*)(o + 2 * MODW) = a2; *(f32x4*)(o + 3 * MODW) = a3; *(f32x4*)(o + 4 * MODW) = a4; *(f32x4*)(o + 5 * MODW) = a5;
    }
    __syncthreads();
}
__device__ __forceinline__ void ada_reduce(const Params& p) {
    const float* part = (const float*)(p.ws + WS_PART); float* mod = (float*)(p.ws + WS_MOD);
    for (int i = pg8::obid() * NTHR + pg8::otid(); i < 6 * MODW; i += pg8::ogrid() * NTHR) {
        const int c = i % MODW; float s = c < 49152 ? p.ada_b[c] : p.final_ada_b[c - 49152];
#pragma unroll
        for (int ch = 0; ch < 8; ++ch) s += part[(size_t)ch * 6 * MODW + i];
        mod[i] = s;
    }
}
__device__ __forceinline__ void rope_table(const Params& p) {
    cpx* rope = (cpx*)(p.ws + WS_ROPE);
    for (int i = pg8::obid() * NTHR + pg8::otid(); i < 16384 * 16; i += pg8::ogrid() * NTHR) {
        const int pos = i >> 4, f = i & 15; const float inv = powf(500000.0f, -(float)f / 16.0f); const float ang = (float)pos * inv;
        float s, c; sincosf(ang, &s, &c); rope[i] = mkc(c, s);
    }
}
__device__ __forceinline__ void filter_mlp(const Params& p) {
    const int lane = pg8::otid() & 63, gw = pg8::obid() * 8 + (pg8::otid() >> 6);
    bf16_t* a2x = (bf16_t*)(p.ws + WS_A2X);
    for (int q = gw; q < 2 * NPOS; q += pg8::ogrid() * 8) {
        const int j = q / NPOS, r = q % NPOS; const int L = r < 16384 ? 16384 : 2048, pos = r < 16384 ? r : r - 16384;
        const float fpos = (float)pos;
        float z = 0.f;
        if (lane == 0) z = fpos / (float)(L - 1);
        else if (lane <= 32) { const int bi = (lane - 1) & 15; const float band = 1e-4f + (float)bi * ((15.0f - 1e-4f) / 15.0f);
            const float ang = ((6.283185307179586f * fpos) * band) / (float)L; z = lane <= 16 ? cosf(ang) : -sinf(ang); }
        const float* w1 = p.hy_fw1 + j * 33 * 64; const float* w2 = p.hy_fw2 + j * 64 * 64;
        float acc = p.hy_fb1[j * 64 + lane];
#pragma unroll
        for (int m = 0; m < 33; ++m) acc += __shfl(z, m) * w1[m * 64 + lane];
        const float a1 = sinf(p.hy_ffreq[j * 128 + lane] * acc);
        acc = p.hy_fb2[j * 64 + lane];
#pragma unroll
        for (int m = 0; m < 64; ++m) acc += __shfl(a1, m) * w2[m * 64 + lane];
        const float a2 = sinf(p.hy_ffreq[j * 128 + 64 + lane] * acc);
        const bf16_t hi = f2bf(a2), lo = f2bf(a2 - bf2f(hi));
        bf16_t* o = a2x + ((size_t)j * NPOS + r) * 256;
        o[lane] = hi; o[64 + lane] = hi; o[128 + lane] = lo; o[192 + lane] = 0;
    }
    bf16_t* w3x = (bf16_t*)(p.ws + WS_W3X);
    for (int i = pg8::obid() * NTHR + pg8::otid(); i < 2 * 8192 * 64; i += pg8::ogrid() * NTHR) {
        const int k = i & 63, col = (i >> 6) & 8191, j = i >> 19;
        const float v = p.hy_fw3[(size_t)j * 64 * 8192 + (size_t)k * 8192 + col];
        const bf16_t hi = f2bf(v), lo = f2bf(v - bf2f(hi));
        bf16_t* o = w3x + ((size_t)j * 8192 + col) * 256;
        o[k] = hi; o[64 + k] = lo; o[128 + k] = hi; o[192 + k] = 0;
    }
}
__device__ __forceinline__ void convert_T(LDSQ unsigned char* lds, const float* src, int K, int N, bf16_t* dst, int ffs) {
    LDSQ float* tile = (LDSQ float*)lds;
    const int tid = pg8::otid(), ntn = N >> 8, ntiles = (K >> 6) * ntn, stride = pg8::ogrid();
    const int r = tid >> 6, c4 = tid & 63;
    f32x4 v[8];
    int ti = pg8::obid();
    if (ti < ntiles) { const int tk = ti / ntn, tn = ti % ntn;
#pragma unroll
        for (int it = 0; it < 8; ++it) v[it] = *(const f32x4*)(src + (size_t)(tk * 64 + r + 8 * it) * N + tn * 256 + 4 * c4); }
    for (; ti < ntiles; ti += stride) {
        const int tk = ti / ntn, tn = ti % ntn;
#pragma unroll
        for (int it = 0; it < 8; ++it) { LDSQ float* tp = tile + (r + 8 * it) * 257 + 4 * c4; tp[0] = v[it][0]; tp[1] = v[it][1]; tp[2] = v[it][2]; tp[3] = v[it][3]; }
        __syncthreads();
        if (ti + stride < ntiles) { const int t2 = ti + stride, tk2 = t2 / ntn, tn2 = t2 % ntn;
#pragma unroll
            for (int it = 0; it < 8; ++it) v[it] = *(const f32x4*)(src + (size_t)(tk2 * 64 + r + 8 * it) * N + tn2 * 256 + 4 * c4); }
        { const int n = tid >> 1, kh = tid & 1; const int nn = tn * 256 + n; const int row = ffs < 0 ? nn : (256 * (nn >> 7) + 128 * ffs + (nn & 127));
          bf16_t* dp = dst + (size_t)row * K + tk * 64 + kh * 32;
#pragma unroll
          for (int q = 0; q < 4; ++q) { float f[8];
#pragma unroll
              for (int e = 0; e < 8; ++e) f[e] = tile[(kh * 32 + q * 8 + e) * 257 + n];
              u32x4 w; w.x = cvt_pk_bf16(f[0], f[1]); w.y = cvt_pk_bf16(f[2], f[3]); w.z = cvt_pk_bf16(f[4], f[5]); w.w = cvt_pk_bf16(f[6], f[7]);
              *(u32x4*)(dp + q * 8) = w; } }
        __syncthreads();
    }
}
template <bool FINAL, bool SRC_F32> __device__ __forceinline__ void norm_rows(const float* xp, const float* xs, bf16_t* xb, const float* g, const float* modl, int sh_off, int sc_off, bf16_t* H, float* outf) {
    const int lane = pg8::otid() & 63, gw = pg8::obid() * 8 + (pg8::otid() >> 6), nw = pg8::ogrid() * 8;
    const int rpw = (T + nw - 1) / nw, r0 = gw * rpw, r1 = (r0 + rpw < T) ? r0 + rpw : T;
    if (r0 >= r1) return;
    f32x4 gs[8], sh[8]; int curseq = -1;
    struct RowBuf { f32x4 f[SRC_F32 ? 8 : 1]; u32x2 b[SRC_F32 ? 1 : 8]; };
    auto request = [&](RowBuf& B, int row) {
        if (SRC_F32) { const f32x4* src = (const f32x4*)(row < T_P ? xp + (size_t)row * 2048 : xs + (size_t)(row - T_P) * 2048);
#pragma unroll
            for (int i = 0; i < 8; ++i) B.f[i] = src[lane + 64 * i]; }
        else { const u32x2* src = (const u32x2*)(xb + (size_t)row * 2048);
#pragma unroll
            for (int i = 0; i < 8; ++i) B.b[i] = src[lane + 64 * i]; } };
    auto process = [&](RowBuf& B, int row, int next) {
        f32x4 v[8];
#pragma unroll
        for (int i = 0; i < 8; ++i) { if (SRC_F32) v[i] = B.f[i]; else v[i] = (f32x4){__uint_as_float(B.b[i].x << 16), __uint_as_float(B.b[i].x & 0xffff0000u), __uint_as_float(B.b[i].y << 16), __uint_as_float(B.b[i].y & 0xffff0000u)}; }
        if (next < r1) request(B, next);
        const int seq = seq_of_row(row);
        if (seq != curseq) { curseq = seq; const float* mod = modl + (size_t)seq * MODW;
#pragma unroll
            for (int i = 0; i < 8; ++i) { const int col = (lane + 64 * i) * 4; gs[i] = *(const f32x4*)(g + col); sh[i] = *(const f32x4*)(mod + sc_off + col); }
#pragma unroll
            for (int i = 0; i < 8; ++i) { const int col = (lane + 64 * i) * 4; const f32x4 sft = *(const f32x4*)(mod + sh_off + col); gs[i] = gs[i] * (1.0f + sh[i]); sh[i] = sft; } }
        float ss = 0.f;
#pragma unroll
        for (int i = 0; i < 8; ++i) ss += v[i][0] * v[i][0] + v[i][1] * v[i][1] + v[i][2] * v[i][2] + v[i][3] * v[i][3];
        ss = wave_sum(ss);
        const float rstd = 1.0f / sqrtf(ss * (1.0f / 2048.0f) + EPS);
#pragma unroll
        for (int i = 0; i < 8; ++i) { const int col = (lane + 64 * i) * 4;
            const f32x4 h = (v[i] * rstd) * gs[i] + sh[i];
            if (FINAL) *(f32x4*)(outf + (size_t)row * 2048 + col) = h;
            else { u32x2 w; w.x = cvt_pk_bf16(h[0], h[1]); w.y = cvt_pk_bf16(h[2], h[3]); *(u32x2*)(H + (size_t)row * 2048 + col) = w;
                if (SRC_F32) { u32x2 c; c.x = cvt_pk_bf16(v[i][0], v[i][1]); c.y = cvt_pk_bf16(v[i][2], v[i][3]); *(u32x2*)(xb + (size_t)row * 2048 + col) = c; } } } };
    if (SRC_F32) {
        RowBuf B0, B1;
        request(B0, r0); if (r0 + 1 < r1) request(B1, r0 + 1);
        for (int row = r0; row < r1; row += 2) { process(B0, row, row + 2); if (row + 1 < r1) process(B1, row + 1, row + 3); }
    } else {
        RowBuf B0, B1, B2;
        request(B0, r0); if (r0 + 1 < r1) request(B1, r0 + 1); if (r0 + 2 < r1) request(B2, r0 + 2);
        for (int row = r0; row < r1; row += 3) {
            process(B0, row, row + 3);
            if (row + 1 < r1) process(B1, row + 1, row + 4);
            if (row + 2 < r1) process(B2, row + 2, row + 5);
        }
    }
}
__device__ __forceinline__ void final_norm_phase(const Params& p) {
    norm_rows<true, false>(nullptr, nullptr, (bf16_t*)(p.ws + WS_XB), p.final_norm, (const float*)(p.ws + WS_MOD) + 49152, 0, 2048, nullptr, p.out);
}
__device__ __forceinline__ void transpose_phase(const Params& p, LDSQ unsigned char* lds) {
    LDSQ bf16_t* tile = (LDSQ bf16_t*)lds;
    const bf16_t* zin = (const bf16_t*)(p.ws + WS_BIG + BIG_ZINT); bf16_t* H = (bf16_t*)(p.ws + WS_H);
    const int tid = pg8::otid(), stride = pg8::ogrid();
    const int cr = tid >> 5, tq = tid & 31;
    u32x4 v[4];
    int ti = pg8::obid();
    if (ti < 32 * 160) { const int tc = ti / 160, tt = ti % 160;
#pragma unroll
        for (int it = 0; it < 4; ++it) v[it] = *(const u32x4*)(zin + (size_t)(tc * 64 + cr + 16 * it) * T + tt * 256 + tq * 8); }
    for (; ti < 32 * 160; ti += stride) {
        const int tc = ti / 160, tt = ti % 160;
#pragma unroll
        for (int it = 0; it < 4; ++it) *(LDSQ u32x4*)(tile + (cr + 16 * it) * 264 + tq * 8) = v[it];
        __syncthreads();
        if (ti + stride < 32 * 160) { const int t2 = ti + stride, tc2 = t2 / 160, tt2 = t2 % 160;
#pragma unroll
            for (int it = 0; it < 4; ++it) v[it] = *(const u32x4*)(zin + (size_t)(tc2 * 64 + cr + 16 * it) * T + tt2 * 256 + tq * 8); }
        { const int cq = tid & 7, tk = tid >> 3;
#pragma unroll
          for (int it = 0; it < 4; ++it) { const int tok = tk + 64 * it; unsigned w[4];
#pragma unroll
              for (int e = 0; e < 4; ++e) { const unsigned lo = tile[(cq * 8 + 2 * e) * 264 + tok], hi = tile[(cq * 8 + 2 * e + 1) * 264 + tok]; w[e] = lo | (hi << 16); }
              *(u32x4*)(H + (size_t)(tt * 256 + tok) * 2048 + tc * 64 + cq * 8) = (u32x4){w[0], w[1], w[2], w[3]}; } }
        __syncthreads();
    }
}

__host__ __device__ constexpr float cos64q(int k) {
    constexpr float t[17] = {1.0f, 0.99518472667219693f, 0.98078528040323043f, 0.95694033573220882f, 0.92387953251128674f, 0.88192126434835505f, 0.83146961230254524f,
        0.77301045336273699f, 0.70710678118654757f, 0.63439328416364549f, 0.55557023301960229f, 0.47139673682599781f, 0.38268343236508984f, 0.29028467725446233f,
        0.19509032201612833f, 0.09801714032956077f, 0.0f};
    return t[k];
}
__host__ __device__ constexpr float cos64(int k) { k &= 63; return k <= 16 ? cos64q(k) : k <= 32 ? -cos64q(32 - k) : k <= 48 ? -cos64q(k - 32) : cos64q(64 - k); }
__host__ __device__ constexpr float sin64(int k) { return cos64((k + 48) & 63); }
template <int R> __host__ __device__ constexpr int brev(int k) { int r = 0; for (int b = 1; b < R; b <<= 1) { r = (r << 1) | (k & 1); k >>= 1; } return r; }

typedef _Float16 hcpx __attribute__((ext_vector_type(2)));
typedef _Float16 hcpx2 __attribute__((ext_vector_type(4)));
__device__ __forceinline__ hcpx h_of(cpx a) { hcpx r; r.x = (_Float16)a.x; r.y = (_Float16)a.y; return r; }
__device__ __forceinline__ cpx c_of(hcpx a) { return mkc((float)a.x, (float)a.y); }
__device__ __forceinline__ hcpx2 h2_of(cpx a, cpx b) { hcpx2 r; r.x = (_Float16)a.x; r.y = (_Float16)a.y; r.z = (_Float16)b.x; r.w = (_Float16)b.y; return r; }
#define VA __device__ __forceinline__ float
VA f_mul(float a, float b) { float r; asm("v_mul_f32_e32 %0, %1, %2" : "=v"(r) : "v"(a), "v"(b)); return r; }
VA f_fma(float a, float b, float c) { float r; asm("v_fma_f32 %0, %1, %2, %3" : "=v"(r) : "v"(a), "v"(b), "v"(c)); return r; }
VA f_fms(float a, float b, float c) { float r; asm("v_fma_f32 %0, %1, %2, -%3" : "=v"(r) : "v"(a), "v"(b), "v"(c)); return r; }
#undef VA
__device__ __forceinline__ cpx cmul(cpx a, cpx b) { float rx, ry;
    asm("v_mul_f32_e32 %0, %3, %5\n\tv_mul_f32_e32 %1, %3, %4\n\tv_fma_f32 %0, %2, %4, -%0\n\tv_fma_f32 %1, %2, %5, %1" : "=&v"(rx), "=&v"(ry) : "v"(a.x), "v"(a.y), "v"(b.x), "v"(b.y)); return mkc(rx, ry); }
__device__ __forceinline__ cpx cmulc(cpx a, cpx b) { float rx, ry;
    asm("v_mul_f32_e32 %0, %3, %5\n\tv_mul_f32_e32 %1, %2, %5\n\tv_fma_f32 %0, %2, %4, %0\n\tv_fma_f32 %1, %3, %4, -%1" : "=&v"(rx), "=&v"(ry) : "v"(a.x), "v"(a.y), "v"(b.x), "v"(b.y)); return mkc(rx, ry); }

template <int R, bool INV, int H, int P> __device__ __forceinline__ void bfly(cpx (&v)[R]) {
    constexpr int b = (P / H) * 2 * H, i = P % H, e = i * (32 / H);
    float ux = v[b + i].x, uy = v[b + i].y, wx = v[b + i + H].x, wy = v[b + i + H].y;
    if constexpr (e == 0) { float dx, dy;
        asm("v_sub_f32_e32 %2, %0, %4\n\tv_sub_f32_e32 %3, %1, %5\n\tv_add_f32_e32 %0, %0, %4\n\tv_add_f32_e32 %1, %1, %5" : "+v"(ux), "+v"(uy), "=&v"(dx), "=&v"(dy) : "v"(wx), "v"(wy));
        wx = dx; wy = dy; }
    else if constexpr (e == 16) { float ox, oy;
        if constexpr (!INV) asm("v_sub_f32_e32 %2, %1, %5\n\tv_sub_f32_e32 %3, %4, %0\n\tv_add_f32_e32 %0, %0, %4\n\tv_add_f32_e32 %1, %1, %5" : "+v"(ux), "+v"(uy), "=&v"(ox), "=&v"(oy) : "v"(wx), "v"(wy));
        else                asm("v_sub_f32_e32 %2, %5, %1\n\tv_sub_f32_e32 %3, %0, %4\n\tv_add_f32_e32 %0, %0, %4\n\tv_add_f32_e32 %1, %1, %5" : "+v"(ux), "+v"(uy), "=&v"(ox), "=&v"(oy) : "v"(wx), "v"(wy));
        wx = ox; wy = oy; }
    else { constexpr float c = cos64(e), s = INV ? sin64(e) : -sin64(e);
        constexpr unsigned cb = __builtin_bit_cast(unsigned, c), sb = __builtin_bit_cast(unsigned, s), nsb = __builtin_bit_cast(unsigned, -s);
        float dx, dy;
        asm("v_sub_f32_e32 %4, %0, %2\n\tv_sub_f32_e32 %5, %1, %3\n\tv_add_f32_e32 %0, %0, %2\n\tv_add_f32_e32 %1, %1, %3\n\t"
            "v_mul_f32_e32 %2, %8, %5\n\tv_mul_f32_e32 %3, %6, %5\n\tv_fmamk_f32 %2, %4, %6, %2\n\tv_fmamk_f32 %3, %4, %7, %3"
            : "+v"(ux), "+v"(uy), "+v"(wx), "+v"(wy), "=&v"(dx), "=&v"(dy) : "i"(cb), "i"(sb), "i"(nsb)); }
    v[b + i] = mkc(ux, uy); v[b + i + H] = mkc(wx, wy);
}
template <int R, bool INV, int H, int... Ps> __device__ __forceinline__ void dft_stage(cpx (&v)[R], std::integer_sequence<int, Ps...>) { (bfly<R, INV, H, Ps>(v), ...); }
template <int R, bool INV, int H> __device__ __forceinline__ void dft_stages(cpx (&v)[R]) {
    dft_stage<R, INV, H>(v, std::make_integer_sequence<int, R / 2>{});
    if constexpr (H > 1) dft_stages<R, INV, H / 2>(v);
}
template <int R, bool INV> __device__ __forceinline__ void dft_r2(cpx (&v)[R]) { dft_stages<R, INV, R / 2>(v); }
template <int R, bool CONJ, bool BREV> __device__ __forceinline__ void apply_pows(cpx (&v)[R], cpx w) {
    constexpr int H = R > 16 ? 16 : R;
    cpx pw[H];
    pw[1] = w;
#pragma unroll
    for (int k = 2; k < H; ++k) pw[k] = (k & 1) ? cmul(pw[k - 1], w) : cmul(pw[k / 2], pw[k / 2]);
#pragma unroll
    for (int k = 1; k < H; ++k) { const int idx = BREV ? brev<R>(k) : k; v[idx] = CONJ ? cmulc(v[idx], pw[k]) : cmul(v[idx], pw[k]); }
    if (R > 16) {
        const cpx w16 = cmul(pw[8], pw[8]);
#pragma unroll
        for (int k = 0; k < R - 16; ++k) { const cpx q = k == 0 ? w16 : cmul(pw[k], w16); const int idx = BREV ? brev<R>(16 + k) : 16 + k; v[idx] = CONJ ? cmulc(v[idx], q) : cmul(v[idx], q); }
    }
}
__device__ __forceinline__ int phys(int i) { return i + (i >> 5); }
constexpr int TW_OFF = 135168 + 64;
template <int S> __host__ __device__ constexpr int poff(int j) { return S >= 32 ? j * (S + S / 32) : j * S + ((j * S) >> 5); }
typedef hcpx PreRegs[32];
template <int R, int S> __device__ __forceinline__ void fft_prefetch(int t, const hcpx* gio, PreRegs& pre) {
    constexpr int G = 32 / R;
#pragma unroll
    for (int gi = 0; gi < G; ++gi) { const int gam = gi * 512 + t, hi = gam / S, lo = gam % S, base = hi * (R * S) + lo;
#pragma unroll
        for (int j = 0; j < R; ++j) pre[gi * R + j] = __builtin_nontemporal_load(gio + base + j * S); }
}
template <int R, int S, bool INV, int IO> __device__ __forceinline__ void fft_pass(LDSQ cpx* A, int t, hcpx* gio, const PreRegs& pre) {
    constexpr int G = 32 / R;
    asm volatile("" : "+v"(t) :: "memory");
    const LDSQ cpx* TW = (const LDSQ cpx*)((LDSQ unsigned char*)A + TW_OFF);
    cpx v[G][R]; cpx tw[G];
#pragma unroll
    for (int gi = 0; gi < G; ++gi) {
        const int gam = gi * 512 + t, hi = gam / S, lo = gam % S, base = hi * (R * S) + lo; const LDSQ cpx* Ab = A + phys(base);
#pragma unroll
        for (int j = 0; j < R; ++j) v[gi][j] = (IO == 3) ? c_of(pre[gi * R + j]) : (IO == 1) ? c_of(__builtin_nontemporal_load(gio + base + j * S)) : Ab[poff<S>(j)];
        tw[gi] = TW[lo * (16384 / (R * S))];
    }
#pragma unroll
    for (int gi = 0; gi < G; ++gi) {
        const int gam = gi * 512 + t, hi = gam / S, lo = gam % S, base = hi * (R * S) + lo; LDSQ cpx* Ab = A + phys(base);
        if (!INV) {
            dft_r2<R, false>(v[gi]);
            apply_pows<R, false, true>(v[gi], tw[gi]);
#pragma unroll
            for (int k = 0; k < R; ++k) { if (IO == 2) gio[base + k * S] = h_of(v[gi][brev<R>(k)]); else Ab[poff<S>(k)] = v[gi][brev<R>(k)]; }
        } else {
            apply_pows<R, true, false>(v[gi], tw[gi]);
            dft_r2<R, true>(v[gi]);
#pragma unroll
            for (int j = 0; j < R; ++j) { if (IO == 2) gio[base + j * S] = h_of(v[gi][brev<R>(j)]); else Ab[poff<S>(j)] = v[gi][brev<R>(j)]; }
        }
    }
}
template <int R, int MODE> __device__ __forceinline__ void fft_mid(LDSQ cpx* A, int t, hcpx* spec, float scale) {
    constexpr int G = 32 / R;
    asm volatile("" : "+v"(t) :: "memory");
    hcpx2 sp[G][R / 2];
    if (MODE == 1) {
#pragma unroll
        for (int gi = 0; gi < G; ++gi)
#pragma unroll
            for (int k2 = 0; k2 < R / 2; ++k2) sp[gi][k2] = *(const hcpx2*)(spec + (size_t)(gi * 512 + t) * R + 2 * k2);
    }
#pragma unroll
    for (int gi = 0; gi < G; ++gi) {
        const int gam = gi * 512 + t, base = gam * R;
        cpx v[R];
        LDSQ cpx* Ab = A + phys(base);
#pragma unroll
        for (int j = 0; j < R; ++j) v[j] = Ab[j];
        dft_r2<R, false>(v);
        if (MODE == 0) {
#pragma unroll
            for (int k2 = 0; k2 < R / 2; ++k2) { const cpx x = v[brev<R>(2 * k2)], y = v[brev<R>(2 * k2 + 1)];
                *(hcpx2*)(spec + (size_t)base + 2 * k2) = h2_of(mkc(x.x * scale, x.y * scale), mkc(y.x * scale, y.y * scale)); }
        } else {
            cpx x[R];
#pragma unroll
            for (int k2 = 0; k2 < R / 2; ++k2) { const hcpx2 s = sp[gi][k2]; x[2 * k2] = cmul(v[brev<R>(2 * k2)], mkc((float)s.x * scale, (float)s.y * scale)); x[2 * k2 + 1] = cmul(v[brev<R>(2 * k2 + 1)], mkc((float)s.z * scale, (float)s.w * scale)); }
            dft_r2<R, true>(x);
#pragma unroll
            for (int j = 0; j < R; ++j) Ab[j] = x[brev<R>(j)];
        }
    }
}
#define GL_DRAIN() asm volatile("s_waitcnt vmcnt(0)" ::: "memory")
struct NoHook { __device__ __forceinline__ void operator()() const {} };
template <int LOG2L, bool INV, int GIO, class Hook = NoHook> __device__ __forceinline__ void fft_outer(LDSQ cpx* A, int t, hcpx* gio, const hcpx* pfsrc, PreRegs& pre, Hook hook = Hook()) {
    constexpr int R1 = LOG2L == 14 ? 32 : 16, S1 = LOG2L == 14 ? 512 : 128, S2 = LOG2L == 14 ? 16 : 8;
    if (!INV) { fft_pass<R1, S1, false, GIO == 3 ? 3 : 0>(A, t, nullptr, pre); __syncthreads(); fft_pass<R1, S2, false, 0>(A, t, nullptr, pre); GL_DRAIN(); __syncthreads(); }
    else      { fft_pass<R1, S2, true, 0>(A, t, nullptr, pre); __syncthreads();
                if (GIO == 2) fft_prefetch<R1, S1>(t, pfsrc, pre);
                hook();
                fft_pass<R1, S1, true, GIO == 2 ? 2 : 0>(A, t, gio, pre); if (GIO != 2) GL_DRAIN(); __syncthreads(); }
}
template <int LOG2L, int SRC, int DST, class Hook = NoHook> __device__ __forceinline__ void fft_conv(LDSQ cpx* A, int t, hcpx* spec, hcpx* gdst, const hcpx* pfsrc, PreRegs& pre, Hook hook = Hook()) {
    fft_outer<LOG2L, false, SRC>(A, t, nullptr, nullptr, pre);
    fft_mid<LOG2L == 14 ? 16 : 8, 1>(A, t, spec, 1.0f / (float)(1 << LOG2L));
    if (SRC == 3) GL_DRAIN();
    __syncthreads();
    fft_outer<LOG2L, true, DST>(A, t, gdst, pfsrc, pre, hook);
}

__device__ __forceinline__ void sconv4r(u32x2 q, unsigned zmr, unsigned zpr, float w0, float w1, float w2, float bb, float (&o)[4]) {
    const float zm = __uint_as_float(zmr << 16), zp = __uint_as_float(zpr << 16);
    const float z0 = __uint_as_float(q.x << 16), z1 = __uint_as_float(q.x & 0xffff0000u), z2 = __uint_as_float(q.y << 16), z3 = __uint_as_float(q.y & 0xffff0000u);
    o[0] = w0 * zm + w1 * z0 + w2 * z1 + bb; o[1] = w0 * z0 + w1 * z1 + w2 * z2 + bb; o[2] = w0 * z1 + w1 * z2 + w2 * z3 + bb; o[3] = w0 * z2 + w1 * z3 + w2 * zp + bb;
}
typedef _Float16 h4 __attribute__((ext_vector_type(4)));
__device__ __forceinline__ void tapquad(h4 a, h4 bq, unsigned b0bits, float wf, float wb, float rf1, float rf2, float rf3, float rb1, float rb2, float rb3, float (&fa)[4], float (&fb)[4]) {
    const float b0 = (float)__builtin_bit_cast(_Float16, (unsigned short)b0bits);
    fa[0] = (float)a.x * wf; fa[1] = (float)a.y * (wf * rf1); fa[2] = (float)a.z * (wf * rf2); fa[3] = (float)a.w * (wf * rf3);
    fb[0] = b0 * wb; fb[1] = (float)bq.w * (wb * rb1); fb[2] = (float)bq.z * (wb * rb2); fb[3] = (float)bq.y * (wb * rb3);
}
template <int LOG2L> struct SweepIdx {
    static constexpr int L = 1 << LOG2L, QS = L / 32;
    int t, seq, n00, a00; cpx wq0, w1, w2, w3;
    __device__ __forceinline__ SweepIdx(int t_, bool need_w) { t = t_; asm volatile("" : "+v"(t) :: "memory"); seq = (LOG2L == 14) ? 0 : (t >> 6); const int q0 = (LOG2L == 14) ? t : (t & 63); n00 = 4 * q0; a00 = seq * L + n00;
        if (need_w) { float sb, cb; sincospif(-(float)n00 / (float)L, &sb, &cb); wq0 = mkc(cb, sb);
            sincospif(-1.0f / (float)L, &sb, &cb); w1 = mkc(cb, sb); w2 = cmul(w1, w1); w3 = cmul(w2, w1); } }
};
#define WQS mkc(0.92387953251128674f, -0.38268343236508978f)
struct TapWin { float wf0, wfs, rf1, rf2, rf3, wb0, wbs, rb1, rb2, rb3; };
template <int LOG2L> __device__ __forceinline__ TapWin tap_windows(float df, float db, int n00) {
    constexpr int L = 1 << LOG2L, QS = L / 32; TapWin w;
    w.wf0 = expf(-df * (float)n00); w.wfs = expf(-df * (float)(4 * QS)); w.rf1 = expf(-df); w.rf2 = w.rf1 * w.rf1; w.rf3 = w.rf2 * w.rf1;
    w.wb0 = expf(-db * (float)(L - n00)); w.wbs = expf(db * (float)(4 * QS)); w.rb1 = expf(db); w.rb2 = w.rb1 * w.rb1; w.rb3 = w.rb2 * w.rb1; return w;
}
template <int LOG2L> __device__ __forceinline__ void sweep_taps2(LDSQ cpx* A, int t_, const _Float16* tf0, const _Float16* tb0, const _Float16* tf1, const _Float16* tb1, float df0, float db0, float df1, float db1, hcpx* hos, float& ss0, float& ss1) {
    constexpr int L = 1 << LOG2L, QS = L / 32; const SweepIdx<LOG2L> X(t_, true);
    const TapWin W0 = tap_windows<LOG2L>(df0, db0, X.n00), W1 = tap_windows<LOG2L>(df1, db1, X.n00);
    float s0 = 0.f, s1 = 0.f, wf0 = W0.wf0, wb0 = W0.wb0, wf1 = W1.wf0, wb1 = W1.wb0;
    cpx wn = X.wq0;
    h4 ra0[8], rb0[8], ra1[8], rb1[8]; unsigned rc0[8], rc1[8];
#pragma unroll
    for (int i = 0; i < 8; ++i) { const int n = 4 * (i * QS) + X.n00, nb = n > 0 ? L - n : L - 1;
        ra0[i] = *(const h4*)(tf0 + n); rb0[i] = *(const h4*)(tb0 + L - n - 4); rc0[i] = ((const unsigned short*)tb0)[nb];
        ra1[i] = *(const h4*)(tf1 + n); rb1[i] = *(const h4*)(tb1 + L - n - 4); rc1[i] = ((const unsigned short*)tb1)[nb]; }
#pragma unroll
    for (int i = 0; i < 8; ++i) { const int n = 4 * (i * QS) + X.n00; float fa0[4], fb0[4], fa1[4], fb1[4]; const unsigned hm = n > 0 ? 0xffffu : 0u;
        tapquad(ra0[i], rb0[i], rc0[i] & hm, wf0, wb0, W0.rf1, W0.rf2, W0.rf3, W0.rb1, W0.rb2, W0.rb3, fa0, fb0);
        tapquad(ra1[i], rb1[i], rc1[i] & hm, wf1, wb1, W1.rf1, W1.rf2, W1.rf3, W1.rb1, W1.rb2, W1.rb3, fa1, fb1);
        LDSQ cpx* ap = A + phys(X.a00 + 4 * i * QS); hcpx* hp = hos + X.a00 + 4 * i * QS;
#pragma unroll
        for (int e = 0; e < 4; ++e) { s0 += fa0[e] * fa0[e] + fb0[e] * fb0[e]; s1 += fa1[e] * fa1[e] + fb1[e] * fb1[e]; ap[e] = mkc(fa0[e] + fb0[e], fa1[e] + fb1[e]); }
        const cpx wa = cmul(wn, X.w1), wb2 = cmul(wn, X.w2), wc = cmul(wn, X.w3);
        const cpx y0 = cmul(mkc(fa0[0] - fb0[0], fa1[0] - fb1[0]), wn), y1 = cmul(mkc(fa0[1] - fb0[1], fa1[1] - fb1[1]), wa);
        const cpx y2 = cmul(mkc(fa0[2] - fb0[2], fa1[2] - fb1[2]), wb2), y3 = cmul(mkc(fa0[3] - fb0[3], fa1[3] - fb1[3]), wc);
        *(hcpx2*)hp = h2_of(y0, y1); *(hcpx2*)(hp + 2) = h2_of(y2, y3);
        wn = cmul(wn, WQS); wf0 *= W0.wfs; wb0 *= W0.wbs; wf1 *= W1.wfs; wb1 *= W1.wbs; }
    ss0 = s0; ss1 = s1;
}
template <int LOG2L, int PART> __device__ __forceinline__ void fft_mid_sep(LDSQ cpx* A, int t, hcpx* spec0, hcpx* spec1, const LDSQ float* red, const float* skp0, const float* skp1) {
    constexpr int R = LOG2L == 14 ? 16 : 8, G = 32 / R, NB = LOG2L == 14 ? 32 : 16, NG = NB * NB;
    asm volatile("" : "+v"(t) :: "memory");
#pragma unroll
    for (int gi = 0; gi < G; ++gi) {
        cpx v[R]; LDSQ cpx* Ab = A + phys((gi * 512 + t) * R);
#pragma unroll
        for (int j = 0; j < R; ++j) v[j] = Ab[j];
        dft_r2<R, false>(v);
#pragma unroll
        for (int k = 0; k < R; ++k) Ab[k] = v[brev<R>(k)];
    }
    __syncthreads();
#pragma unroll
    for (int gi = 0; gi < G; ++gi) {
        const int gam = gi * 512 + t, seq = gam / NG, g = gam % NG, k1 = g / NB, k2 = g % NB;
        const int gp = PART == 1 ? NG - 1 - g : (k1 ? (NB - k1) * NB + (NB - 1 - k2) : (k2 ? NB - k2 : 0));
        const bool wrap = PART == 0 && g == 0;
        const LDSQ cpx* Ab = A + phys(gam * R); const LDSQ cpx* Ap = A + phys((seq * NG + gp) * R);
        cpx z[R], q[R];
#pragma unroll
        for (int k = 0; k < R; ++k) { z[k] = Ab[k]; q[k] = Ap[k]; }
        float ss0, ss1;
        if (LOG2L == 14) { ss0 = red[0] + red[1] + red[2] + red[3] + red[4] + red[5] + red[6] + red[7]; ss1 = red[8] + red[9] + red[10] + red[11] + red[12] + red[13] + red[14] + red[15]; }
        else { ss0 = red[seq]; ss1 = red[8 + seq]; }
        const float n0 = 0.25f / sqrtf(ss0 + EPS), n1 = 0.25f / sqrtf(ss1 + EPS), h0 = 0.5f * skp0[seq], h1 = 0.5f * skp1[seq];
        hcpx* s0p = spec0 + (size_t)gam * R; hcpx* s1p = spec1 + (size_t)gam * R;
#pragma unroll
        for (int k2_ = 0; k2_ < R / 2; ++k2_) { cpx o0[2], o1[2];
#pragma unroll
            for (int e = 0; e < 2; ++e) { const int k = 2 * k2_ + e; cpx zp = q[R - 1 - k]; const cpx zw = q[(R - k) & (R - 1)];
                if (PART == 0) { zp.x = wrap ? zw.x : zp.x; zp.y = wrap ? zw.y : zp.y; }
                o0[e] = mkc((z[k].x + zp.x) * n0 + h0, (z[k].y - zp.y) * n0); o1[e] = mkc((z[k].y + zp.y) * n1 + h1, (zp.x - z[k].x) * n1); }
            *(hcpx2*)(s0p + 2 * k2_) = h2_of(o0[0], o0[1]); *(hcpx2*)(s1p + 2 * k2_) = h2_of(o1[0], o1[1]); }
    }
}
template <int LOG2L> __device__ __forceinline__ void sweep_load_v(LDSQ cpx* A, int t_, const bf16_t* zrow, size_t tb0, const float* cw, const float* cbias, int rc0, hcpx* xw) {
    constexpr int L = 1 << LOG2L, QS = L / 32; const SweepIdx<LOG2L> X(t_, true);
    const int rc = rc0 + X.seq; const float cw0 = cw[rc], cw1 = cw[6144 + rc], cw2 = cw[2 * 6144 + rc], bb = cbias[rc];
    const bf16_t* z0 = zrow + (size_t)rc * T + tb0; const bf16_t* z1 = z0 + L;
    cpx wn = X.wq0;
    u32x2 rq[8][2]; unsigned rm[8][2], rp[8][2];
#pragma unroll
    for (int i = 0; i < 8; ++i) { const int n = 4 * (i * QS) + X.n00, nm = n > 0 ? n - 1 : 0, np = n + 4 < L ? n + 4 : L - 1;
        rq[i][0] = *(const u32x2*)(z0 + n); rq[i][1] = *(const u32x2*)(z1 + n); rm[i][0] = z0[nm]; rm[i][1] = z1[nm]; rp[i][0] = z0[np]; rp[i][1] = z1[np]; }
#pragma unroll
    for (int i = 0; i < 8; ++i) { const int n = 4 * (i * QS) + X.n00; float xa[4], xb[4]; const unsigned hm = n > 0 ? 0xffffu : 0u, hp = n + 4 < L ? 0xffffu : 0u;
        sconv4r(rq[i][0], rm[i][0] & hm, rp[i][0] & hp, cw0, cw1, cw2, bb, xa); sconv4r(rq[i][1], rm[i][1] & hm, rp[i][1] & hp, cw0, cw1, cw2, bb, xb);
        LDSQ cpx* ap = A + phys(X.a00 + 4 * i * QS); hcpx* xp = xw + X.a00 + 4 * i * QS;
        ap[0] = mkc(xa[0], xb[0]); ap[1] = mkc(xa[1], xb[1]); ap[2] = mkc(xa[2], xb[2]); ap[3] = mkc(xa[3], xb[3]);
        const cpx y0 = cmul(mkc(xa[0], xb[0]), wn), y1 = cmul(mkc(xa[1], xb[1]), cmul(wn, X.w1)), y2 = cmul(mkc(xa[2], xb[2]), cmul(wn, X.w2)), y3 = cmul(mkc(xa[3], xb[3]), cmul(wn, X.w3));
        *(hcpx2*)xp = h2_of(y0, y1); *(hcpx2*)(xp + 2) = h2_of(y2, y3);
        wn = cmul(wn, WQS); }
}
constexpr int CPA = 2;
template <int N> struct CombPreN { u32x2 q[N][2]; unsigned zm[N][2], zp[N][2]; hcpx2 h01[N], h23[N]; };
typedef CombPreN<CPA> CombPre;
template <int LOG2L, int I0, int N> __device__ __forceinline__ void combine_prefetch(int t_, const hcpx* yes, const bf16_t* zrow, size_t tb0, int rg0, CombPreN<N>& P) {
    constexpr int L = 1 << LOG2L, QS = L / 32; const SweepIdx<LOG2L> X(t_, false);
    const int rg = rg0 + X.seq; const bf16_t* g0 = zrow + (size_t)rg * T + tb0; const bf16_t* g1 = g0 + L;
#pragma unroll
    for (int i = 0; i < N; ++i) { const int n = 4 * ((I0 + i) * QS) + X.n00; const hcpx* yp = yes + X.a00 + 4 * (I0 + i) * QS;
        P.q[i][0] = *(const u32x2*)(g0 + n); P.q[i][1] = *(const u32x2*)(g1 + n);
        const int nm = n > 0 ? n - 1 : 0, np = n + 4 < L ? n + 4 : L - 1;
        P.zm[i][0] = g0[nm]; P.zm[i][1] = g1[nm]; P.zp[i][0] = g0[np]; P.zp[i][1] = g1[np];
        P.h01[i] = __builtin_nontemporal_load((const hcpx2*)yp); P.h23[i] = __builtin_nontemporal_load((const hcpx2*)(yp + 2)); }
}
template <int LOG2L, int FINAL> __device__ __forceinline__ void sweep_combine(LDSQ cpx* A, int t_, const CombPre& P0, const hcpx* yes, hcpx* xw, bf16_t* zrow, size_t tb0, const float* cw, const float* cbias, int rg0, int ro0, int dry) {
    constexpr int L = 1 << LOG2L, QS = L / 32; const SweepIdx<LOG2L> X(t_, true);
    CombPreN<8 - CPA> P1; combine_prefetch<LOG2L, CPA>(X.t, yes, zrow, tb0, rg0, P1);
    const int rg = rg0 + X.seq; const float cw0 = cw[rg], cw1 = cw[6144 + rg], cw2 = cw[2 * 6144 + rg], bb = cbias[rg];
    bf16_t* o0 = zrow + (size_t)(ro0 + X.seq) * T + tb0; bf16_t* o1 = o0 + L;
    cpx wn = X.wq0;
#pragma unroll
    for (int i = 0; i < 8; ++i) { const int n = 4 * (i * QS) + X.n00; float ga[4], gb[4];
        const bool ah = i < CPA; const int ia = ah ? i : 0, ib = ah ? 0 : i - CPA;
        const unsigned hm = n > 0 ? 0xffffu : 0u, hp = n + 4 < L ? 0xffffu : 0u;
        sconv4r(ah ? P0.q[ia][0] : P1.q[ib][0], (ah ? P0.zm[ia][0] : P1.zm[ib][0]) & hm, (ah ? P0.zp[ia][0] : P1.zp[ib][0]) & hp, cw0, cw1, cw2, bb, ga);
        sconv4r(ah ? P0.q[ia][1] : P1.q[ib][1], (ah ? P0.zm[ia][1] : P1.zm[ib][1]) & hm, (ah ? P0.zp[ia][1] : P1.zp[ib][1]) & hp, cw0, cw1, cw2, bb, gb);
        const LDSQ cpx* ap = A + phys(X.a00 + 4 * i * QS);
        const hcpx2 h01 = ah ? P0.h01[ia] : P1.h01[ib], h23 = ah ? P0.h23[ia] : P1.h23[ib];
        const f32x4 e01 = {(float)h01.x, (float)h01.y, (float)h01.z, (float)h01.w}, e23 = {(float)h23.x, (float)h23.y, (float)h23.z, (float)h23.w};
        const cpx wa = cmul(wn, X.w1), wb2 = cmul(wn, X.w2), wc = cmul(wn, X.w3);
        const cpx r0 = cmulc(ap[0], wn), r1 = cmulc(ap[1], wa), r2 = cmulc(ap[2], wb2), r3 = cmulc(ap[3], wc);
        const cpx s0 = mkc(ga[0] * (e01[0] + r0.x), gb[0] * (e01[1] + r0.y)), s1 = mkc(ga[1] * (e01[2] + r1.x), gb[1] * (e01[3] + r1.y));
        const cpx s2 = mkc(ga[2] * (e23[0] + r2.x), gb[2] * (e23[1] + r2.y)), s3 = mkc(ga[3] * (e23[2] + r3.x), gb[3] * (e23[3] + r3.y));
        if (FINAL == 0) { LDSQ cpx* aw = A + phys(X.a00 + 4 * i * QS); hcpx* xp = xw + X.a00 + 4 * i * QS;
            aw[0] = s0; aw[1] = s1; aw[2] = s2; aw[3] = s3;
            const cpx y0 = cmul(s0, wn), y1 = cmul(s1, wa), y2 = cmul(s2, wb2), y3 = cmul(s3, wc);
            *(hcpx2*)xp = h2_of(y0, y1); *(hcpx2*)(xp + 2) = h2_of(y2, y3); }
        else if (!dry) { u32x2 wa2, wb3; wa2.x = cvt_pk_bf16(s0.x, s1.x); wa2.y = cvt_pk_bf16(s2.x, s3.x); wb3.x = cvt_pk_bf16(s0.y, s1.y); wb3.y = cvt_pk_bf16(s2.y, s3.y);
            *(u32x2*)(o0 + n) = wa2; *(u32x2*)(o1 + n) = wb3; }
        wn = cmul(wn, WQS); }
}
template <int LOG2L> __device__ __forceinline__ void hyena_item(const Params& p, LDSQ unsigned char* lds, int layer_j, int c0, int dry) {
    constexpr int L = 1 << LOG2L, NPAIR = (LOG2L == 14) ? 1 : 2;
    constexpr int TOK0 = (LOG2L == 14) ? 0 : T_P, PB = (LOG2L == 14) ? 0 : 16384;
    LDSQ cpx* A = (LDSQ cpx*)lds;
    LDSQ float* red = (LDSQ float*)(lds + 135168);
    const int t = pg8::otid(), ch = c0 + ((LOG2L == 14) ? 0 : (t >> 6));
    bf16_t* zin = (bf16_t*)(p.ws + WS_BIG + BIG_ZINT);
    const _Float16* taps = (const _Float16*)(p.ws + WS_BIG + BIG_TAPS);
    hcpx* scr = (hcpx*)(p.ws + WS_H + (size_t)pg8::obid() * FFT_SCR_PER_WG);
    hcpx* u1s = scr + (size_t)4 * 16384;
    hcpx* yes = (hcpx*)(p.ws + WS_END + (size_t)pg8::obid() * FFT_EXT_PER_WG);
    PreRegs pre;
    hcpx* xw = yes + 16384;
    {
        const _Float16* tf0 = taps + (size_t)(0 * 2048 + ch) * NPOS + PB; const _Float16* tb0 = taps + (size_t)(1 * 2048 + ch) * NPOS + PB;
        const _Float16* tf1 = taps + (size_t)(2 * 2048 + ch) * NPOS + PB; const _Float16* tb1 = taps + (size_t)(3 * 2048 + ch) * NPOS + PB;
        const float* dec = p.hy_decay + (size_t)layer_j * 8192 + ch;
        const float df0 = fabsf(dec[0]) * (1.0f / (float)(L - 1)), db0 = fabsf(dec[2048]) * (1.0f / (float)(L - 1));
        const float df1 = fabsf(dec[4096]) * (1.0f / (float)(L - 1)), db1 = fabsf(dec[6144]) * (1.0f / (float)(L - 1));
        float ss0, ss1;
        sweep_taps2<LOG2L>(A, t, tf0, tb0, tf1, tb1, df0, db0, df1, db1, xw, ss0, ss1);
        ss0 = wave_sum(ss0); ss1 = wave_sum(ss1);
        if ((t & 63) == 0) { red[t >> 6] = ss0; red[8 + (t >> 6)] = ss1; }
        __syncthreads();
        const float* skp0 = p.hy_skip + (size_t)layer_j * 2 * 2048 + c0; const float* skp1 = skp0 + 2048;
        fft_outer<LOG2L, false, 0>(A, t, nullptr, nullptr, pre);
        fft_prefetch<LOG2L == 14 ? 32 : 16, LOG2L == 14 ? 512 : 128>(t, xw, pre);
        fft_mid_sep<LOG2L, 0>(A, t, scr + (size_t)0 * 16384, scr + (size_t)2 * 16384, red, skp0, skp1); __syncthreads();
        fft_outer<LOG2L, false, 3>(A, t, nullptr, nullptr, pre);
        fft_mid_sep<LOG2L, 1>(A, t, scr + (size_t)1 * 16384, scr + (size_t)3 * 16384, red, skp0, skp1); __syncthreads();
    }
    const float* cw = p.hy_conv_w + (size_t)layer_j * 3 * 6144; const float* cbias = p.hy_conv_b + (size_t)layer_j * 6144;
#pragma unroll 1
    for (int pr = 0; pr < NPAIR; ++pr) {
        const size_t tb0 = (size_t)TOK0 + (size_t)(2 * pr) * L;
        sweep_load_v<LOG2L>(A, t, zin, tb0, cw, cbias, 2 * 2048 + c0, xw); __syncthreads();
        fft_conv<LOG2L, 0, 2>(A, t, scr + (size_t)0 * 16384, yes, xw, pre);
        CombPre cp;
        fft_conv<LOG2L, 3, 0>(A, t, scr + (size_t)1 * 16384, nullptr, nullptr, pre, [&]() { combine_prefetch<LOG2L, 0>(t, yes, zin, tb0, c0, cp); });
        sweep_combine<LOG2L, 0>(A, t, cp, yes, xw, zin, tb0, cw, cbias, c0, c0, dry); __syncthreads();
        fft_conv<LOG2L, 0, 2>(A, t, scr + (size_t)2 * 16384, yes, xw, pre);
        fft_conv<LOG2L, 3, 0>(A, t, scr + (size_t)3 * 16384, nullptr, nullptr, pre, [&]() { combine_prefetch<LOG2L, 0>(t, yes, zin, tb0, 2048 + c0, cp); });
        sweep_combine<LOG2L, 1>(A, t, cp, yes, xw, zin, tb0, cw, cbias, 2048 + c0, c0, dry); __syncthreads();
    }
}
__device__ __forceinline__ void hyena_conv_phase(const Params& p, LDSQ unsigned char* lds, int layer_j, int dry) {
    { LDSQ cpx* TW = (LDSQ cpx*)(lds + TW_OFF);
      for (int e = pg8::otid(); e < 1024; e += NTHR) { float sn, cs; sincospif(-2.0f * (float)e / 16384.0f, &sn, &cs); TW[e] = mkc(cs, sn); }
      __syncthreads(); }
    for (int it = pg8::obid(); it < 2048; it += pg8::ogrid()) hyena_item<14>(p, lds, layer_j, it, dry);
    for (int it = pg8::obid(); it < 256; it += pg8::ogrid()) hyena_item<11>(p, lds, layer_j, it * 8, dry);
}

__device__ __forceinline__ void attn_phase(const Params& p, LDSQ unsigned char* lds, int dry = 0) {
    constexpr int KROW = 272, VROW = 264;
    LDSQ unsigned char* Kl = lds; LDSQ bf16_t* VT = (LDSQ bf16_t*)(lds + 256 * KROW);
    const bf16_t* qkv = (const bf16_t*)(p.ws + WS_BIG + BIG_QKV);
    bf16_t* og = (bf16_t*)(p.ws + WS_BIG + BIG_OG); float* lse = (float*)(p.ws + WS_BIG + BIG_LSE);
    const int tid = pg8::otid(), lane = tid & 63, wid = __builtin_amdgcn_readfirstlane(tid >> 6), l15 = lane & 15, g4 = lane >> 4;
    const int blk = wid >> 2, qq = 16 * (wid & 3) + l15;
    for (int u = pg8::obid(); u < 1792 + 512; u += pg8::ogrid()) {
        const int it = u < 1792 ? 4 * u : 7168 + (u - 1792), len = u < 1792 ? 4 : 1;
        int g, b, hh, rho, pp0, L, tokbase;
        if (it < 6144) { g = it >> 11; const int rem = it & 2047; const int npp = 128 >> (2 * g); pp0 = rem % npp; rho = (rem / npp) & ((1 << (2 * g)) - 1); hh = (rem >> 7) & 7; b = rem >> 10; L = L_P; tokbase = 0; }
        else { const int i2 = it - 6144; g = i2 >> 9; const int rem = i2 & 511; const int npp = 16 >> (2 * g); pp0 = rem % npp; rho = (rem / npp) & ((1 << (2 * g)) - 1); hh = (rem >> 4) & 7; b = rem >> 7; L = L_S; tokbase = T_P; }
        const int rsh = 2 * g, n = L >> rsh;
        const size_t tok0 = (size_t)tokbase + (size_t)b * L + rho;
        const int qcol = g * 3072 + hh * 128, kcol = qcol + 1024, vcol = qcol + 2048;
        u32x4 kr[2][4], vr[2][4];
        auto request_half = [&](int ih, u32x4 (&kh)[4], u32x4 (&vh)[4]) {
#pragma unroll
            for (int s4 = 0; s4 < 4; ++s4) { const int ci = tid + 512 * s4;
                { const int slot = ci >> 4, chn = ci & 15, i = ih + slot, ic = i < 0 ? 0 : (i < n ? i : n - 1); kh[s4] = *(const u32x4*)(qkv + (tok0 + ((size_t)ic << rsh)) * QKVW + kcol + chn * 8); }
                { const int slot = ci & 127, chn = ci >> 7, i = ih + slot, ic = i < 0 ? 0 : (i < n ? i : n - 1); vh[s4] = *(const u32x4*)(qkv + (tok0 + ((size_t)ic << rsh)) * QKVW + vcol + chn * 8); } } };
        auto stage_half = [&](int ih, int ring0, const u32x4 (&kh)[4], const u32x4 (&vh)[4]) {
#pragma unroll
            for (int s4 = 0; s4 < 4; ++s4) { const int ci = tid + 512 * s4;
                { const int slot = ci >> 4, chn = ci & 15, i = ih + slot; const unsigned ok = (i >= 0 && i < n) ? 0xffffffffu : 0u;
                  u32x4 v = kh[s4]; v.x &= ok; v.y &= ok; v.z &= ok; v.w &= ok;
                  *(LDSQ u32x4*)(Kl + (ring0 + slot) * KROW + chn * 16) = v; }
                { const int slot = ci & 127, chn = ci >> 7, i = ih + slot; const unsigned ok = (i >= 0 && i < n) ? 0xffffffffu : 0u;
                  u32x4 v = vh[s4]; v.x &= ok; v.y &= ok; v.z &= ok; v.w &= ok;
                  LDSQ bf16_t* vp = VT + (32 * (chn >> 2) + 4 * (chn & 3)) * VROW + ring0 + slot;
                  vp[0] = (bf16_t)(v.x & 0xffffu); vp[VROW] = (bf16_t)(v.x >> 16); vp[2 * VROW] = (bf16_t)(v.y & 0xffffu); vp[3 * VROW] = (bf16_t)(v.y >> 16);
                  vp[16 * VROW] = (bf16_t)(v.z & 0xffffu); vp[17 * VROW] = (bf16_t)(v.z >> 16); vp[18 * VROW] = (bf16_t)(v.w & 0xffffu); vp[19 * VROW] = (bf16_t)(v.w >> 16); } } };
        request_half(128 * pp0 - 64, kr[0], vr[0]); request_half(128 * pp0 + 64, kr[1], vr[1]);
#pragma unroll 1
        for (int s = 0; s < len; ++s) {
            const int pp = pp0 + s, i0 = 128 * pp - 64, off = (128 * pp) & 255;
            const int qi = 128 * pp + 64 * blk + qq;
            const size_t tq = tok0 + ((size_t)qi << rsh);
            bf16x8 bq[4];
#pragma unroll
            for (int ks = 0; ks < 4; ++ks) bq[ks] = *(const bf16x8*)(qkv + tq * QKVW + qcol + 32 * ks + 8 * g4);
            if (s == 0) stage_half(i0, off, kr[0], vr[0]);
            stage_half(i0 + 128, (128 + off) & 255, kr[1], vr[1]);
            __syncthreads();
            const int ktb = wid & 3;
            f32x4 sc[10]; bf16x8 kf[2][4];
            auto kload = [&](int j, bf16x8 (&f)[4]) { const int rb = (64 * blk + 16 * (ktb + j) + off) & 255;
#pragma unroll
                for (int ks = 0; ks < 4; ++ks) f[ks] = *(const LDSQ bf16x8*)(Kl + (rb + l15) * KROW + (32 * ks + 8 * g4) * 2); };
            kload(0, kf[0]);
#pragma unroll
            for (int j = 0; j < 9; ++j) {
                if (j + 1 < 9) kload(j + 1, kf[(j + 1) & 1]);
                __builtin_amdgcn_sched_barrier(0);
                f32x4 a = {0.f, 0.f, 0.f, 0.f};
#pragma unroll
                for (int ks = 0; ks < 4; ++ks) a = __builtin_amdgcn_mfma_f32_16x16x32_bf16(kf[j & 1][ks], bq[ks], a, 0, 0, 0);
                sc[j] = a;
                __builtin_amdgcn_sched_barrier(0); }
            if (s + 1 < len) request_half(i0 + 256, kr[1], vr[1]);
            const int ibase = 128 * pp + 64 * blk - 64;
            const int klo = qq > -ibase ? qq : -ibase, khi = (qq + 128 < n - 1 - ibase) ? qq + 128 : n - 1 - ibase;
            const unsigned kspan = (unsigned)(khi - klo); const int kk0 = 4 * g4 - klo + 16 * ktb;
            float mx = -3.0e38f;
#pragma unroll
            for (int j = 0; j < 9; ++j)
#pragma unroll
                for (int r = 0; r < 4; ++r) { const bool ok = (unsigned)(kk0 + 16 * j + r) <= kspan;
                    sc[j][r] = ok ? sc[j][r] : -3.0e38f; mx = fmaxf(mx, sc[j][r]); }
            mx = fmaxf(mx, __shfl_xor(mx, 16)); mx = fmaxf(mx, __shfl_xor(mx, 32));
            float ls = 0.f;
#pragma unroll
            for (int j = 0; j < 9; ++j)
#pragma unroll
                for (int r = 0; r < 4; ++r) { const float e = __builtin_amdgcn_exp2f(sc[j][r] - mx); sc[j][r] = e; ls += e; }
            sc[9] = (f32x4){0.f, 0.f, 0.f, 0.f};
            ls += __shfl_xor(ls, 16); ls += __shfl_xor(ls, 32);
            f32x4 oa[8];
#pragma unroll
            for (int dt = 0; dt < 8; ++dt) oa[dt] = (f32x4){0.f, 0.f, 0.f, 0.f};
            u32x2 vf[2][4][2];
            auto vload = [&](int gidx, u32x2 (&f)[4][2]) { const int k2 = gidx >> 1, d0 = (gidx & 1) * 4;
                const int cb0 = (64 * blk + 16 * ktb + 32 * k2 + off) & 255, cb1 = (cb0 + 16) & 255;
#pragma unroll
                for (int d = 0; d < 4; ++d) { const LDSQ bf16_t* vq = VT + (16 * (d0 + d) + l15) * VROW + 4 * g4; f[d][0] = *(const LDSQ u32x2*)(vq + cb0); f[d][1] = *(const LDSQ u32x2*)(vq + cb1); } };
            vload(0, vf[0]);
#pragma unroll
            for (int gidx = 0; gidx < 10; ++gidx) { const int k2 = gidx >> 1, d0 = (gidx & 1) * 4;
                if (gidx + 1 < 10) vload(gidx + 1, vf[(gidx + 1) & 1]);
                __builtin_amdgcn_sched_barrier(0);
                union { u32x4 u; bf16x8 h; } pb;
                pb.u.x = cvt_pk_bf16(sc[2 * k2][0], sc[2 * k2][1]); pb.u.y = cvt_pk_bf16(sc[2 * k2][2], sc[2 * k2][3]);
                pb.u.z = cvt_pk_bf16(sc[2 * k2 + 1][0], sc[2 * k2 + 1][1]); pb.u.w = cvt_pk_bf16(sc[2 * k2 + 1][2], sc[2 * k2 + 1][3]);
#pragma unroll
                for (int d = 0; d < 4; ++d) { union { u32x4 u; bf16x8 h; } va; const u32x2 lo = vf[gidx & 1][d][0], hi = vf[gidx & 1][d][1];
                    va.u.x = lo.x; va.u.y = lo.y; va.u.z = hi.x; va.u.w = hi.y;
                    oa[d0 + d] = __builtin_amdgcn_mfma_f32_16x16x32_bf16(va.h, pb.h, oa[d0 + d], 0, 0, 0); }
                __builtin_amdgcn_sched_barrier(0); }
            const float inv = 1.0f / ls;
            const size_t gt = (size_t)g * T + tq;
#pragma unroll
            for (int q = 0; q < 4; ++q) { u32x4 w; w.x = cvt_pk_bf16(oa[2 * q][0] * inv, oa[2 * q][1] * inv); w.y = cvt_pk_bf16(oa[2 * q][2] * inv, oa[2 * q][3] * inv);
                w.z = cvt_pk_bf16(oa[2 * q + 1][0] * inv, oa[2 * q + 1][1] * inv); w.w = cvt_pk_bf16(oa[2 * q + 1][2] * inv, oa[2 * q + 1][3] * inv);
                if (!dry) *(u32x4*)(og + gt * 1024 + hh * 128 + 32 * q + 8 * g4) = w; }
            if (g4 == 0 && !dry) lse[gt * 8 + hh] = mx + log2f(ls);
            __syncthreads();
        }
    }
}
__device__ __forceinline__ void attn_merge_phase(const Params& p) {
    const bf16_t* og = (const bf16_t*)(p.ws + WS_BIG + BIG_OG); const float* lse = (const float*)(p.ws + WS_BIG + BIG_LSE); bf16_t* H = (bf16_t*)(p.ws + WS_H);
    const int stride = pg8::ogrid() * NTHR;
    for (int i0 = pg8::obid() * NTHR + pg8::otid(); i0 < T * 128; i0 += 4 * stride) {
        u32x4 v0[4], v1[4], v2[4]; float l0[4], l1[4], l2[4];
#pragma unroll
        for (int u = 0; u < 4; ++u) { const int i = i0 + u * stride; if (i < T * 128) { const int tok = i >> 7, c8 = i & 127, hh = c8 >> 4;
            l0[u] = lse[(size_t)tok * 8 + hh]; l1[u] = lse[((size_t)T + tok) * 8 + hh]; l2[u] = lse[((size_t)2 * T + tok) * 8 + hh];
            v0[u] = *(const u32x4*)(og + (size_t)tok * 1024 + c8 * 8); v1[u] = *(const u32x4*)(og + ((size_t)T + tok) * 1024 + c8 * 8); v2[u] = *(const u32x4*)(og + ((size_t)2 * T + tok) * 1024 + c8 * 8); } }
#pragma unroll
        for (int u = 0; u < 4; ++u) { const int i = i0 + u * stride; if (i < T * 128) { const int tok = i >> 7, c8 = i & 127;
            const float m = fmaxf(l0[u], fmaxf(l1[u], l2[u])); float a0 = exp2f(l0[u] - m), a1 = exp2f(l1[u] - m), a2 = exp2f(l2[u] - m); const float is = 1.0f / (a0 + a1 + a2); a0 *= is; a1 *= is; a2 *= is;
            u32x4 w;
#pragma unroll
            for (int e = 0; e < 4; ++e) { const float lo = a0 * __uint_as_float(v0[u][e] << 16) + a1 * __uint_as_float(v1[u][e] << 16) + a2 * __uint_as_float(v2[u][e] << 16);
                const float hi = a0 * __uint_as_float(v0[u][e] & 0xffff0000u) + a1 * __uint_as_float(v1[u][e] & 0xffff0000u) + a2 * __uint_as_float(v2[u][e] & 0xffff0000u);
                w[e] = cvt_pk_bf16(lo, hi); }
            *(u32x4*)(H + (size_t)tok * 1024 + c8 * 8) = w; } }
    }
}

constexpr int NPHASE = 35;
typedef const __attribute__((address_space(4))) unsigned char* KARG;
template <class Tp> __device__ __forceinline__ Tp karg(int byte_off) { return *(volatile const __attribute__((address_space(4))) Tp*)((KARG)__builtin_amdgcn_kernarg_segment_ptr() + byte_off); }
#define PA(q, member) q.member = karg<decltype(Params::member)>((int)__builtin_offsetof(Params, member))
__global__ void __launch_bounds__(512, 2) mega(Params parg) {
    extern __shared__ __attribute__((aligned(16))) unsigned char shm[];
    LDSQ unsigned char* lds = (LDSQ unsigned char*)shm;
    const int tid = pg8::otid();
    volatile LDSQ unsigned* misc = (volatile LDSQ unsigned*)(lds + LDS_MISC);
    if (tid < 8) misc[tid] = 0u;
    __syncthreads();
    const int ph_lo = parg.ph_lo, ph_hi = parg.ph_hi, probe = parg.probe;
#define REPS(bit, lay) (1 + (1 + ((probe >> 15) & 1)) * (((probe >> (bit)) & 1) & ((((probe >> 10) & 3) == 0) | ((probe >> (10 + ((lay) & 1))) & 1))))
    XcdBarrier bar; bar.bar = nullptr; bar.x = 0; bar.st = misc;
    if (ph_hi - ph_lo > 1) { Params q{}; PA(q, ws); bar = xcd_barrier_post((unsigned*)(q.ws + WS_CTL), misc); }
#define IN(k) (ph_lo <= (k) && (k) < ph_hi)
#define REPBAR() do { if (((probe >> 16) & 1) && rep + 1 < nrep) { Params qb{}; PA(qb, ws); bar.bar = (unsigned*)(qb.ws + WS_CTL); xcd_barrier(bar); } } while (0)
#define SEAM(k) do { if (IN(k) && IN((k) + 1)) { Params qb{}; PA(qb, ws); bar.bar = (unsigned*)(qb.ws + WS_CTL); xcd_barrier(bar); if ((probe >> 12) & 1) { xcd_barrier(bar); xcd_barrier(bar); } } } while (0)

    for (int rep = 0, nrep = REPS(0, 0); rep < nrep; ++rep)
    if (IN(0)) { Params q{}; PA(q, ws); PA(q, c_prompt); PA(q, c_sample); PA(q, ada_w); PA(q, final_ada_w); ada_partials(q, lds); rope_table(q);
                 PA(q, hy_fw1); PA(q, hy_fb1); PA(q, hy_ffreq); PA(q, hy_fw2); PA(q, hy_fb2); PA(q, hy_fw3); filter_mlp(q); }
    SEAM(0);
    for (int rep = 0, nrep = REPS(0, 0); rep < nrep; ++rep)
    if (IN(1)) { Params q{}; PA(q, ws); PA(q, ada_b); PA(q, final_ada_b); ada_reduce(q); }
    SEAM(1);
#pragma unroll 1
    for (int layer = 0; layer < 4; ++layer) {
        const int pb = 2 + 8 * layer, j = layer >> 1; const bool hy = (layer & 1) == 0;
        for (int rep = 0, nrep = REPS(1, layer); rep < nrep; ++rep)
        if (IN(pb + 0)) {
            Params q{}; PA(q, ws); unsigned char* wl = q.ws + WS_WL;
            PA(q, ffn_w_gate); convert_T(lds, q.ffn_w_gate + (size_t)layer * 2048 * DFF, 2048, DFF, (bf16_t*)(wl + WL_FFN1), 0);
            PA(q, ffn_w_up);   convert_T(lds, q.ffn_w_up + (size_t)layer * 2048 * DFF, 2048, DFF, (bf16_t*)(wl + WL_FFN1), 1);
            PA(q, ffn_w_down); convert_T(lds, q.ffn_w_down + (size_t)layer * DFF * 2048, DFF, 2048, (bf16_t*)(wl + WL_FFN2), -1);
            if (hy) { PA(q, hy_w_in);  convert_T(lds, q.hy_w_in + (size_t)j * 2048 * 6144, 2048, 6144, (bf16_t*)(wl + WL_MIXIN), -1);
                      PA(q, hy_w_out); convert_T(lds, q.hy_w_out + (size_t)j * 2048 * 2048, 2048, 2048, (bf16_t*)(wl + WL_MIXOUT), -1); }
            else    { PA(q, at_w_in);  convert_T(lds, q.at_w_in + (size_t)j * 2048 * QKVW, 2048, QKVW, (bf16_t*)(wl + WL_MIXIN), -1);
                      PA(q, at_w_out); convert_T(lds, q.at_w_out + (size_t)j * 1024 * 2048, 1024, 2048, (bf16_t*)(wl + WL_MIXOUT), -1); }
            PA(q, norm_mix);
            const float* modl = (const float*)(q.ws + WS_MOD) + layer * 12288;
            if (layer == 0) { PA(q, x_prompt); PA(q, x_sample); norm_rows<false, true>(q.x_prompt, q.x_sample, (bf16_t*)(q.ws + WS_XB), q.norm_mix + layer * 2048, modl, 0, 2048, (bf16_t*)(q.ws + WS_H), nullptr); }
            else            norm_rows<false, false>(nullptr, nullptr, (bf16_t*)(q.ws + WS_XB), q.norm_mix + layer * 2048, modl, 0, 2048, (bf16_t*)(q.ws + WS_H), nullptr);
            if (hy) { __syncthreads();
                pg8::Gemm g{(const bf16_t*)(q.ws + WS_W3X) + (size_t)j * 8192 * 256, (const bf16_t*)(q.ws + WS_A2X) + (size_t)j * NPOS * 256, 8192, NPOS, 256};
                pg8::StaticOrder S; S.init(8192, NPOS, pg8::ogrid(), pg8::obid());
                EpiTaps E{(_Float16*)(q.ws + WS_BIG + BIG_TAPS)};
                pg8::gemm_phase<EpiTaps, pg8::StaticOrder, false>(lds, g, S, E, nullptr); }
        }
        SEAM(pb + 0);
        for (int rep = 0, nrep = REPS(2, layer); rep < nrep; ++rep)
        if (IN(pb + 1)) {
            Params q{}; PA(q, ws);
            if (hy) { PA(q, hy_b_in); pg8::Gemm g{(const bf16_t*)(q.ws + WS_WL + WL_MIXIN), (const bf16_t*)(q.ws + WS_H), 6144, T, 2048}; pg8::StaticOrder S; S.init(6144, T, pg8::ogrid(), pg8::obid());
                EpiZinT E{(bf16_t*)(q.ws + WS_BIG + BIG_ZINT), T, q.hy_b_in + (size_t)j * 6144};
                pg8::gemm_phase<EpiZinT, pg8::StaticOrder, false>(lds, g, S, E, nullptr); }
            else { pg8::Gemm g{(const bf16_t*)(q.ws + WS_H), (const bf16_t*)(q.ws + WS_WL + WL_MIXIN), T, QKVW, 2048}; pg8::StaticOrder S; S.init(T, QKVW, pg8::ogrid(), pg8::obid());
                EpiQKV E{(bf16_t*)(q.ws + WS_BIG + BIG_QKV), (const cpx*)(q.ws + WS_ROPE)};
                pg8::gemm_phase<EpiQKV, pg8::StaticOrder, false>(lds, g, S, E, nullptr); }
            REPBAR();
        }
        SEAM(pb + 1);
        for (int rep = 0, nrep = REPS(3, layer); rep < nrep; ++rep)
        if (IN(pb + 2)) { Params q{}; PA(q, ws); if (hy) { PA(q, hy_skip); PA(q, hy_conv_w); PA(q, hy_conv_b); PA(q, hy_decay); hyena_conv_phase(q, lds, j, rep + 1 < nrep); } else attn_phase(q, lds, (rep + 1 < nrep) ? (1 | ((probe >> 12) & 2)) : 0); }
        SEAM(pb + 2);
        for (int rep = 0, nrep = REPS(4, layer); rep < nrep; ++rep)
        if (IN(pb + 3)) { Params q{}; PA(q, ws); if (hy) transpose_phase(q, lds); else attn_merge_phase(q); }
        SEAM(pb + 3);
        for (int rep = 0, nrep = REPS(5, layer); rep < nrep; ++rep)
        if (IN(pb + 4)) {
            Params q{}; PA(q, ws); PA(q, hy_b_out);
            pg8::Gemm g{(const bf16_t*)(q.ws + WS_H), (const bf16_t*)(q.ws + WS_WL + WL_MIXOUT), T, 2048, hy ? 2048 : 1024}; pg8::StaticOrder S; S.init(T, 2048, pg8::ogrid(), pg8::obid());
            EpiRes E{(bf16_t*)(q.ws + WS_XB), hy ? q.hy_b_out + (size_t)j * 2048 : nullptr, (const float*)(q.ws + WS_MOD) + layer * 12288 + 4096, rep + 1 < nrep};
            pg8::gemm_phase<EpiRes, pg8::StaticOrder, false>(lds, g, S, E, nullptr);
            REPBAR();
        }
        SEAM(pb + 4);
        for (int rep = 0, nrep = REPS(6, layer); rep < nrep; ++rep)
        if (IN(pb + 5)) { Params q{}; PA(q, ws); PA(q, norm_ffn);
            norm_rows<false, false>(nullptr, nullptr, (bf16_t*)(q.ws + WS_XB), q.norm_ffn + layer * 2048, (const float*)(q.ws + WS_MOD) + layer * 12288, 6144, 8192, (bf16_t*)(q.ws + WS_H), nullptr); }
        SEAM(pb + 5);
        for (int rep = 0, nrep = REPS(7, layer); rep < nrep; ++rep)
        if (IN(pb + 6)) {
            Params q{}; PA(q, ws);
            pg8::Gemm g{(const bf16_t*)(q.ws + WS_H), (const bf16_t*)(q.ws + WS_WL + WL_FFN1), T, 2 * DFF, 2048}; pg8::StaticOrder S; S.init(T, 2 * DFF, pg8::ogrid(), pg8::obid());
            EpiFFN1 E{(bf16_t*)(q.ws + WS_BIG + BIG_MID)};
            pg8::gemm_phase<EpiFFN1, pg8::StaticOrder, false>(lds, g, S, E, nullptr);
            REPBAR();
        }
        SEAM(pb + 6);
        for (int rep = 0, nrep = REPS(8, layer); rep < nrep; ++rep)
        if (IN(pb + 7)) {
            Params q{}; PA(q, ws);
            pg8::Gemm g{(const bf16_t*)(q.ws + WS_BIG + BIG_MID), (const bf16_t*)(q.ws + WS_WL + WL_FFN2), T, 2048, DFF}; pg8::StaticOrder S; S.init(T, 2048, pg8::ogrid(), pg8::obid());
            EpiRes E{(bf16_t*)(q.ws + WS_XB), nullptr, (const float*)(q.ws + WS_MOD) + layer * 12288 + 10240, rep + 1 < nrep};
            pg8::gemm_phase<EpiRes, pg8::StaticOrder, false>(lds, g, S, E, nullptr);
            REPBAR();
        }
        SEAM(pb + 7);
    }
    if (IN(34)) { Params q{}; PA(q, ws); PA(q, out); PA(q, final_norm); final_norm_phase(q); }
#undef REPS
#undef IN
#undef SEAM
}
}

extern "C" void kernel_launch(void* const* d_in, const int* in_sizes, int n_in, void* d_out, int out_size, void* d_ws, size_t ws_size, hipStream_t stream) {
    static int grid = 0;
    if (grid == 0) {
        if (n_in != 30 || out_size != mk::T * mk::D || ws_size < mk::WS_TOTAL) { fprintf(stderr, "kernel_launch: unexpected shapes (n_in %d out %d ws %zu need %zu); nothing launched\n", n_in, out_size, ws_size, (size_t)mk::WS_TOTAL); grid = -1; return; }
        int dev = 0, cus = 0;
        if (hipGetDevice(&dev) != hipSuccess || hipDeviceGetAttribute(&cus, hipDeviceAttributeMultiprocessorCount, dev) != hipSuccess) { grid = -1; return; }
        if (hipFuncSetAttribute((const void*)mk::mega, hipFuncAttributeMaxDynamicSharedMemorySize, mk::LDS_BYTES) != hipSuccess) { fprintf(stderr, "kernel_launch: hipFuncSetAttribute failed\n"); grid = -1; return; }
        int per_cu = 0; (void)hipOccupancyMaxActiveBlocksPerMultiprocessor(&per_cu, (const void*)mk::mega, 512, mk::LDS_BYTES); (void)hipGetLastError();
        if (per_cu < 1) fprintf(stderr, "kernel_launch: occupancy query reports %d blocks per CU\n", per_cu);
        grid = cus > 256 ? 256 : cus;
    }
    if (grid < 0) return;
    mk::Params p{};
    const float** f = (const float**)&p;
    for (int i = 0; i < 30; ++i) f[i] = (const float*)d_in[i];
    p.out = (float*)d_out; p.ws = (unsigned char*)d_ws; p.probe = MK_PROBE;
#if MK_PER_PHASE
    for (int k = 0; k < mk::NPHASE; ++k) { p.ph_lo = k; p.ph_hi = k + 1; hipLaunchKernelGGL(mk::mega, dim3(grid), dim3(512), mk::LDS_BYTES, stream, p); }
#else
    (void)hipMemsetAsync((char*)d_ws + mk::WS_CTL, 0, mk::CTL_BYTES, stream);
    p.ph_lo = 0; p.ph_hi = mk::NPHASE;
    hipLaunchKernelGGL(mk::mega, dim3(grid), dim3(512), mk::LDS_BYTES, stream, p);
#endif
}
```

```cpp
#include <hip/hip_runtime.h>
#include <cstdio>
#include <cstdint>
#include <utility>
#ifndef MK_PER_PHASE
#define MK_PER_PHASE 0
#endif
#ifndef MK_PROBE
#define MK_PROBE 0
#endif
namespace pg8 {
#define PG8_LAS __attribute__((address_space(3)))
__device__ __forceinline__ int otid() { int t = threadIdx.x; asm volatile("" : "+v"(t) :: "memory"); return t; }
__device__ __forceinline__ int obid() { int b = blockIdx.x; asm volatile("" : "+s"(b)); return b; }
__device__ __forceinline__ int ogrid() { int g = gridDim.x; asm volatile("" : "+s"(g)); return g; }
typedef unsigned short bf16_t;
typedef short bf16x8 __attribute__((ext_vector_type(8)));
typedef float f32x4 __attribute__((ext_vector_type(4)));
typedef unsigned u32x4 __attribute__((ext_vector_type(4)));
constexpr int BM = 256, BK = 64, HALF = 128, HTB = HALF * BK * 2  , STAGE_BYTES = 8 * HTB, NXCD = 8, WGM = 4;

__host__ __device__ __forceinline__ int lds_byte(int r, int c) { const int st = (r >> 4) * 2 + (c >> 5), rr = r & 15, cc = c & 31, ob = rr * 64 + cc * 2; return st * 1024 + (ob ^ (((ob >> 9) & 1) << 5)); }
__host__ __device__ __forceinline__ void stage_rc(int b, int& R, int& C) { const int st = b / 1024, sb = b % 1024, swz = sb ^ (((sb >> 9) & 1) << 5); R = (st >> 1) * 16 + swz / 64; C = (st & 1) * 32 + (swz % 64) / 2; }
__host__ __device__ __forceinline__ int perm32(int rho) { const int n = rho >> 4, i = rho & 15; return 8 * (i >> 2) + 4 * n + (i & 3); }

struct Unit { int pm, pn; };
struct Gemm { const bf16_t* A; const bf16_t* Bt; int M, N, K; };

struct StaticOrder {
    int nM, nN, nwg, G, c, wgm;
    __host__ __device__ void init(int M, int N, int G_, int c_, int wgm_ = WGM) { nM = M / BM; nN = N / BM; nwg = nM * nN; G = G_; c = c_; wgm = wgm_; }
    __host__ __device__ bool next(int i, Unit& u) const {
        const long L = (long)i * G + c; if (L >= nwg) return false;
        int wgid = (int)L; { const int q = nwg / NXCD, r = nwg % NXCD, xcd = wgid % NXCD, off = wgid / NXCD; wgid = (xcd < r ? xcd * (q + 1) : r * (q + 1) + (xcd - r) * q) + off; }
        const int nig = wgm * nN, gid = wgid / nig, fm = gid * wgm, gsz = (nM - fm) < wgm ? (nM - fm) : wgm;
        u.pm = fm + ((wgid % nig) % gsz); u.pn = (wgid % nig) / gsz; return true;
    }
    __device__ __forceinline__ void a_ready(const Unit&) const {}
    __device__ __forceinline__ void done(const Unit&) const {}
};
__device__ __forceinline__ unsigned cvt_pk_bf16(float lo, float hi) { unsigned r; asm volatile("v_cvt_pk_bf16_f32 %0, %1, %2" : "=v"(r) : "v"(lo), "v"(hi)); return r; }
template <class Epi, class Sched, bool STAMP = false>
__device__ __forceinline__ void gemm_phase(PG8_LAS unsigned char* lds, const Gemm g, const Sched& S, const Epi& E, unsigned long long* stamps) {
    const int tid = otid(), wid = __builtin_amdgcn_readfirstlane(tid >> 6), lane = tid & 63, wr = wid >> 2, wc = wid & 3, fr = lane & 15, fq = lane >> 4;
    const int K = g.K, nt = K / BK;
    int ts_lo = 0, ts_hi = 0, nts = 0; const unsigned long long rt_entry = STAMP ? (unsigned long long)wall_clock64() : 0ull;
#define PG8_STAMP() do { if (STAMP && wid == 0 && nts < 64) { const unsigned long long _c = (unsigned long long)clock64(); \
        ts_lo = (lane == nts) ? (int)(unsigned)_c : ts_lo; ts_hi = (lane == nts) ? (int)(unsigned)(_c >> 32) : ts_hi; ++nts; } } while (0)
    PG8_STAMP();
    unsigned voffA[2], voffB[2];
#pragma unroll
    for (int i = 0; i < 2; ++i) { int R, C; stage_rc(tid * 16 + i * 8192, R, C); const int Rb = Epi::PERM ? ((R & ~31) + perm32(R & 31)) : R;
        voffA[i] = (unsigned)(R * K + C) * 2u; voffB[i] = (unsigned)(Rb * K + C) * 2u; }
    const size_t kstep = (size_t)(BK * 2);
    const size_t hstep = (size_t)HALF * K * 2;
    const size_t tstep = 2 * hstep;
    const unsigned ldsw = (unsigned)wid * 1024u;
    const int aoff = lds_byte(wr * 64 + fr, fq * 8), boff = lds_byte(wc * 32 + fr, fq * 8);
#define PG8_SA(b, h) (((b) * 2 + (h)) * HTB)
#define PG8_SB(b, h) ((4 + (b) * 2 + (h)) * HTB)
#define PG8_STAGE(bufoff, gbase, voff) do { _Pragma("unroll") for (int _i = 0; _i < 2; ++_i) \
        __builtin_amdgcn_global_load_lds((const unsigned*)((const char*)(gbase) + (voff)[_i]), (PG8_LAS unsigned*)(lds + (bufoff) + ldsw + _i * 8192), 16, 0, 0); } while (0)
#define PG8_LDA(dst, b, h) do { _Pragma("unroll") for (int m = 0; m < 4; ++m) _Pragma("unroll") for (int k = 0; k < 2; ++k) dst[m][k] = *(const PG8_LAS bf16x8*)(lds + PG8_SA(b, h) + aoff + m * 2048 + k * 1024); } while (0)
#define PG8_LDB(dst, b, h) do { _Pragma("unroll") for (int n = 0; n < 2; ++n) _Pragma("unroll") for (int k = 0; k < 2; ++k) dst[n][k] = *(const PG8_LAS bf16x8*)(lds + PG8_SB(b, h) + boff + n * 2048 + k * 1024); } while (0)
#define PG8_MMA(ai, bj, At, Bt) do { __builtin_amdgcn_s_setprio(1); _Pragma("unroll") for (int m = 0; m < 4; ++m) _Pragma("unroll") for (int n = 0; n < 2; ++n) _Pragma("unroll") for (int k = 0; k < 2; ++k) \
        acc[ai][bj][m][n] = __builtin_amdgcn_mfma_f32_16x16x32_bf16(Bt[n][k], At[m][k], acc[ai][bj][m][n], 0, 0, 0); __builtin_amdgcn_s_setprio(0); } while (0)
#define PG8_WAIT_V(n) asm volatile("s_waitcnt vmcnt(" #n ")" ::: "memory")
#define PG8_WAIT_L(n) asm volatile("s_waitcnt lgkmcnt(" #n ")" ::: "memory")
#define PG8_BAR __builtin_amdgcn_s_barrier()
#define PG8_SCHED __builtin_amdgcn_sched_barrier(0)
    Unit cur, nxt; int ui = 0;
    if (!S.next(0, cur)) return;
    f32x4 acc[2][2][4][2];
#pragma unroll
    for (int a = 0; a < 2; ++a)
#pragma unroll
        for (int b = 0; b < 2; ++b)
#pragma unroll
            for (int m = 0; m < 4; ++m)
#pragma unroll
                for (int n = 0; n < 2; ++n) acc[a][b][m][n] = (f32x4){0.f, 0.f, 0.f, 0.f};
    bf16x8 At[4][2], B0[2][2], B1[2][2];
    const char* cA = (const char*)g.A + (size_t)cur.pm * tstep; const char* cB = (const char*)g.Bt + (size_t)cur.pn * tstep;
    S.a_ready(cur);
    PG8_STAGE(PG8_SB(0, 0), cB, voffB); PG8_STAGE(PG8_SA(0, 0), cA, voffA); PG8_STAGE(PG8_SB(0, 1), cB + hstep, voffB); PG8_STAGE(PG8_SA(0, 1), cA + hstep, voffA);
    if (wr == 1) PG8_BAR;
    PG8_WAIT_V(4); PG8_BAR;
    PG8_STAGE(PG8_SB(1, 0), cB + kstep, voffB); PG8_STAGE(PG8_SA(1, 0), cA + kstep, voffA); PG8_STAGE(PG8_SB(1, 1), cB + hstep + kstep, voffB);
    PG8_WAIT_V(6); PG8_BAR;
    PG8_STAMP();
    for (;;) {
        const bool has_next = S.next(ui + 1, nxt);
        const char* nA = has_next ? (const char*)g.A + (size_t)nxt.pm * tstep : cA; const char* nB = has_next ? (const char*)g.Bt + (size_t)nxt.pn * tstep : cB;
        for (int t = 0; t < nt; t += 2) {
            const bool last = (t == nt - 2);
            const char* a1 = cA + (size_t)(t + 1) * kstep;
            const char* a2 = last ? nA : cA + (size_t)(t + 2) * kstep; const char* b2 = last ? nB : cB + (size_t)(t + 2) * kstep;
            const char* a3 = a2 + kstep; const char* b3 = b2 + kstep;
            if (last && has_next) S.a_ready(nxt);
            PG8_LDB(B0, 0, 0); PG8_SCHED; PG8_LDA(At, 0, 0); PG8_STAGE(PG8_SA(1, 1), a1 + hstep, voffA);
            PG8_WAIT_L(8); PG8_BAR; PG8_WAIT_L(0); PG8_MMA(0, 0, At, B0); PG8_BAR; PG8_SCHED;
            PG8_LDB(B1, 0, 1); PG8_STAGE(PG8_SB(0, 0), b2, voffB);
            PG8_BAR; PG8_WAIT_L(0); PG8_MMA(0, 1, At, B1); PG8_BAR;
            PG8_LDA(At, 0, 1); PG8_STAGE(PG8_SA(0, 0), a2, voffA);
            PG8_BAR; PG8_WAIT_L(0); PG8_MMA(1, 0, At, B0); PG8_BAR; PG8_SCHED;
            PG8_STAGE(PG8_SB(0, 1), b2 + hstep, voffB);
            PG8_WAIT_V(6); PG8_BAR; PG8_MMA(1, 1, At, B1); PG8_BAR;
            PG8_LDB(B0, 1, 0); PG8_SCHED; PG8_LDA(At, 1, 0); PG8_STAGE(PG8_SA(0, 1), a2 + hstep, voffA);
            PG8_WAIT_L(8); PG8_BAR; PG8_WAIT_L(0); PG8_MMA(0, 0, At, B0); PG8_BAR; PG8_SCHED;
            PG8_LDB(B1, 1, 1); PG8_STAGE(PG8_SB(1, 0), b3, voffB);
            PG8_BAR; PG8_WAIT_L(0); PG8_MMA(0, 1, At, B1); PG8_BAR;
            PG8_LDA(At, 1, 1); PG8_STAGE(PG8_SA(1, 0), a3, voffA);
            PG8_BAR; PG8_WAIT_L(0); PG8_MMA(1, 0, At, B0); PG8_BAR; PG8_SCHED;
            PG8_STAGE(PG8_SB(1, 1), b3 + hstep, voffB);
            PG8_WAIT_V(6); PG8_BAR; PG8_MMA(1, 1, At, B1); PG8_BAR;
        }
        PG8_STAMP();
        if constexpr (!Epi::AFTER_DRAIN) { E(acc, cur, wr, wc, fr, fq); S.done(cur); }
        PG8_STAMP();
        if (!has_next) break;
#pragma unroll
        for (int a = 0; a < 2; ++a)
#pragma unroll
            for (int b = 0; b < 2; ++b)
#pragma unroll
                for (int m = 0; m < 4; ++m)
#pragma unroll
                    for (int n = 0; n < 2; ++n) acc[a][b][m][n] = (f32x4){0.f, 0.f, 0.f, 0.f};
        cur = nxt; cA = nA; cB = nB; ++ui;
    }
    PG8_WAIT_V(0);
    if (wr == 0) PG8_BAR;
    PG8_BAR;
    if constexpr (Epi::AFTER_DRAIN) { E.fused(acc, cur, wr, wc, fr, fq, lds, wid, lane); S.done(cur); }
    PG8_STAMP();
    if (STAMP && wid == 0) { stamps[lane] = lane < nts ? (((unsigned long long)(unsigned)ts_hi << 32) | (unsigned)ts_lo) : 0ull;
        if (lane == 62) stamps[62] = rt_entry; if (lane == 63) stamps[63] = (unsigned long long)wall_clock64(); }
#undef PG8_STAMP
#undef PG8_SA
#undef PG8_SB
#undef PG8_STAGE
#undef PG8_LDA
#undef PG8_LDB
#undef PG8_MMA
#undef PG8_WAIT_V
#undef PG8_WAIT_L
#undef PG8_BAR
#undef PG8_SCHED
}
}
#define XB_TMO      128
#define XB_XCNT(j)  (256  + 64 * (j))
#define XB_XSUB(j)  (1280 + 64 * (j))
#define XB_XGEN(j)  (2304 + 64 * (j))
#define XB_TOP      3328
#define XB_TOPGEN   3392
#define XCD_BAR_WORDS 3456
#define XB_SPIN_CAP (1u << 18)
#define LAS __attribute__((address_space(3)))

__device__ __forceinline__ unsigned xb_ld(unsigned* p)              { return __hip_atomic_load(p, __ATOMIC_RELAXED, __HIP_MEMORY_SCOPE_AGENT); }
__device__ __forceinline__ unsigned xb_add(unsigned* p, unsigned v) { return __hip_atomic_fetch_add(p, v, __ATOMIC_RELAXED, __HIP_MEMORY_SCOPE_AGENT); }
__device__ __forceinline__ unsigned xb_xcc_id() { return (unsigned)__builtin_amdgcn_s_getreg((3 << 11) | 20) & 0xFu; }
#define XB_SPIN(cond, bar) do { unsigned _sp = 0; while (cond) { __builtin_amdgcn_s_sleep(1); \
    if ((++_sp & 255u) == 0u) { if (xb_ld(&(bar)[XB_TMO])) break; if (_sp > XB_SPIN_CAP) { atomicAdd(&(bar)[XB_TMO], 1u); break; } } } } while (0)

struct XcdBarrier {
    unsigned* bar; unsigned x;
    volatile LAS unsigned* st;
};

__device__ __forceinline__ XcdBarrier xcd_barrier_post(unsigned* bar, volatile LAS unsigned* st) {
    XcdBarrier b; b.bar = bar; b.x = xb_xcc_id(); b.st = st;
    if (threadIdx.x == 0) (void)xb_add(&bar[XB_XCNT(b.x)], 1u);
    return b;
}
__device__ __forceinline__ void xcd_barrier_complete(unsigned* bar, unsigned x, unsigned& nloc, unsigned& nx) {
    const unsigned G = gridDim.x * gridDim.y * gridDim.z;
    unsigned sum, cnt, mine, sp = 0u;
    for (;;) {
        sum = 0u; cnt = 0u; mine = 0u;
#pragma unroll
        for (unsigned j = 0; j < 16; ++j) { const unsigned c = xb_ld(&bar[XB_XCNT(j)]); sum += c; cnt += (c > 0u) ? 1u : 0u; mine = (j == x) ? c : mine; }
        if (sum == G) break;
        __builtin_amdgcn_s_sleep(1);
        if ((++sp & 255u) == 0u) { if (xb_ld(&bar[XB_TMO])) break; if (sp > XB_SPIN_CAP) { atomicAdd(&bar[XB_TMO], 1u); break; } }
    }
    nloc = mine > 0u ? mine : 1u; nx = cnt > 0u ? cnt : 1u;
}

__device__ __forceinline__ void xcd_barrier(const XcdBarrier& b) {
    asm volatile("s_waitcnt vmcnt(0)" ::: "memory");
    __syncthreads();
    if (threadIdx.x == 0) {
        unsigned* bar = b.bar;
        __builtin_amdgcn_s_waitcnt(0);
        unsigned nloc = b.st[0], nx = b.st[1];
        if (nloc == 0u) { xcd_barrier_complete(bar, b.x, nloc, nx); b.st[0] = nloc; b.st[1] = nx; }
        const unsigned old = xb_add(&bar[XB_XSUB(b.x)], 1u);
        const unsigned gen = old / nloc;
        if (old + 1u == (gen + 1u) * nloc) {
            __builtin_amdgcn_fence(__ATOMIC_RELEASE, "agent");
            asm volatile("s_waitcnt vmcnt(0)" ::: "memory");
            const unsigned og = xb_add(&bar[XB_TOP], 1u);
            const unsigned tg = og / nx;
            if (og + 1u == (tg + 1u) * nx) xb_add(&bar[XB_TOPGEN], 1u);
            else XB_SPIN(xb_ld(&bar[XB_TOPGEN]) == tg, bar);
            __builtin_amdgcn_fence(__ATOMIC_ACQUIRE, "agent");
            xb_add(&bar[XB_XGEN(b.x)], 1u);
            asm volatile("s_waitcnt vmcnt(0)" ::: "memory");
        } else {
            XB_SPIN(xb_ld(&bar[XB_XGEN(b.x)]) == gen, bar);
            __builtin_amdgcn_fence(__ATOMIC_ACQUIRE, "agent");
            asm volatile("s_waitcnt vmcnt(0)" ::: "memory");
        }
    }
    __syncthreads();
}


namespace mk {
using pg8::bf16_t; using pg8::bf16x8; using pg8::f32x4; using pg8::u32x4; using pg8::Unit; using pg8::cvt_pk_bf16;
typedef unsigned u32x2 __attribute__((ext_vector_type(2)));
typedef float cpx __attribute__((ext_vector_type(2)));
__host__ __device__ __forceinline__ cpx mkc(float a, float b) { cpx r; r.x = a; r.y = b; return r; }

constexpr int D = 2048, T_P = 32768, T_S = 8192, T = 40960, L_P = 16384, L_S = 2048, DFF = 5632;
constexpr int NTHR = 512;
constexpr int MODW = 53248;
constexpr int NPOS = 18432;
constexpr int QKVW = 9216;
constexpr float EPS = 1e-6f;
constexpr float QSCALE = 0.12751743082459868f;
constexpr int LDS_BYTES = 147456;
constexpr int LDS_MISC = 147456 - 256;

constexpr size_t al256(size_t x) { return (x + 255) & ~(size_t)255; }
constexpr size_t WS_CTL  = 0;
constexpr size_t CTL_BYTES = 65536;
constexpr size_t WS_PART = WS_CTL + CTL_BYTES;
constexpr size_t WS_MOD  = WS_PART + al256((size_t)8 * 6 * MODW * 4);
constexpr size_t WS_ROPE = WS_MOD + al256((size_t)6 * MODW * 4);
constexpr size_t WS_A2X  = WS_ROPE + (size_t)16384 * 16 * 8;
constexpr size_t WS_W3X  = WS_A2X + (size_t)2 * NPOS * 256 * 2;
constexpr size_t WS_WL   = WS_W3X + (size_t)2 * 8192 * 256 * 2;
constexpr size_t WL_FFN1 = 0;
constexpr size_t WL_FFN2 = WL_FFN1 + (size_t)11264 * 2048 * 2;
constexpr size_t WL_MIXIN = WL_FFN2 + (size_t)2048 * 5632 * 2;
constexpr size_t WL_MIXOUT = WL_MIXIN + (size_t)9216 * 2048 * 2;
constexpr size_t WL_BYTES = WL_MIXOUT + (size_t)2048 * 2048 * 2;
constexpr size_t WS_H    = WS_WL + WL_BYTES;
constexpr size_t H_BYTES = (size_t)T * 2048 * 2;
constexpr size_t WS_BIG  = WS_H + H_BYTES;
constexpr size_t BIG_ZINT = 0;
constexpr size_t BIG_TAPS = BIG_ZINT + (size_t)6144 * T * 2;
constexpr size_t BIG_HY_END = BIG_TAPS + (size_t)8192 * NPOS * 2;
constexpr size_t BIG_QKV = 0;
constexpr size_t BIG_OG  = BIG_QKV + (size_t)T * QKVW * 2;
constexpr size_t BIG_LSE = BIG_OG + (size_t)3 * T * 1024 * 2;
constexpr size_t BIG_AT_END = BIG_LSE + (size_t)3 * T * 8 * 4;
constexpr size_t BIG_MID = 0;
constexpr size_t BIG_BYTES = BIG_HY_END > BIG_AT_END ? BIG_HY_END : BIG_AT_END;
constexpr size_t WS_END  = WS_BIG + BIG_BYTES;
constexpr size_t FFT_SCR_PER_WG = 5 * 131072;
constexpr size_t FFT_EXT_PER_WG = 2 * 65536;
constexpr size_t WS_XB = WS_END + (size_t)256 * FFT_EXT_PER_WG;
constexpr size_t WS_TOTAL = WS_XB + (size_t)T * 2048 * 2;
static_assert(256 * FFT_SCR_PER_WG <= H_BYTES, "fft scratch must fit in H");

struct Params {
    const float *x_prompt, *x_sample, *c_prompt, *c_sample, *ada_w, *ada_b, *norm_mix, *norm_ffn;
    const float *hy_w_in, *hy_b_in, *hy_conv_w, *hy_conv_b, *hy_fw1, *hy_fb1, *hy_ffreq, *hy_fw2, *hy_fb2, *hy_fw3, *hy_decay, *hy_skip, *hy_w_out, *hy_b_out;
    const float *at_w_in, *at_w_out, *ffn_w_gate, *ffn_w_up, *ffn_w_down, *final_norm, *final_ada_w, *final_ada_b;
    float* out; unsigned char* ws; int ph_lo, ph_hi, probe, pad0;
};

#define LDSQ __attribute__((address_space(3)))

__device__ __forceinline__ float bf2f(bf16_t b) { return __uint_as_float(((unsigned)b) << 16); }
__device__ __forceinline__ bf16_t f2bf(float f) { unsigned u = __float_as_uint(f); u += 0x7FFFu + ((u >> 16) & 1u); return (bf16_t)(u >> 16); }
__device__ __forceinline__ int seq_of_row(int row) { return row < T_P ? (row >> 14) : 2 + ((row - T_P) >> 11); }
__device__ __forceinline__ int pos_of_row(int row) { return row < T_P ? (row & 16383) : (row & 2047); }
__device__ __forceinline__ float wave_sum(float v) {
#pragma unroll
    for (int o = 32; o >= 1; o >>= 1) v += __shfl_xor(v, o);
    return v;
}

struct EpiZinT {
    static constexpr bool PERM = true, AFTER_DRAIN = false;
    bf16_t* O; int ldc; const float* bias;
    __device__ __forceinline__ void operator()(const f32x4 (&acc)[2][2][4][2], const Unit& u, int wr, int wc, int fr, int fq) const {
        const int row0 = u.pm * 256 + wr * 64 + fr, col0 = u.pn * 256 + wc * 32 + 8 * fq;
        float bs[8];
#pragma unroll
        for (int r = 0; r < 8; ++r) bs[r] = bias[row0 + (r >> 2) * 128 + (r & 3) * 16];
#pragma unroll
        for (int ai = 0; ai < 2; ++ai)
#pragma unroll
            for (int m = 0; m < 4; ++m) { const int r = row0 + ai * 128 + m * 16; const float b = bs[ai * 4 + m]; bf16_t* rowp = O + (size_t)r * ldc + col0;
#pragma unroll
                for (int bj = 0; bj < 2; ++bj) { const f32x4 v0 = acc[ai][bj][m][0] + b, v1 = acc[ai][bj][m][1] + b;
                    u32x4 w; w.x = cvt_pk_bf16(v0[0], v0[1]); w.y = cvt_pk_bf16(v0[2], v0[3]); w.z = cvt_pk_bf16(v1[0], v1[1]); w.w = cvt_pk_bf16(v1[2], v1[3]);
                    *(u32x4*)(rowp + bj * 128) = w; } }
    }
};
struct EpiRes {
    static constexpr bool PERM = true, AFTER_DRAIN = false;
    bf16_t* X; const float* bias; const float* gate; int dry;
    __device__ __forceinline__ void operator()(const f32x4 (&acc)[2][2][4][2], const Unit& u, int wr, int wc, int fr, int fq) const {
        const int row0 = u.pm * 256 + wr * 64 + fr, col0 = u.pn * 256 + wc * 32 + 8 * fq;
        const float* gp = gate + (size_t)seq_of_row(u.pm * 256) * MODW + col0;
        bf16_t* xb = X + (size_t)row0 * 2048 + col0;
        u32x4 xv[2][4]; f32x4 gv[2][2], bv[2][2];
#pragma unroll
        for (int m4 = 0; m4 < 4; ++m4) xv[0][m4] = *(const u32x4*)(xb + (size_t)(m4 * 16) * 2048);
#pragma unroll
        for (int n = 0; n < 2; ++n) { gv[0][n] = *(const f32x4*)(gp + 4 * n); bv[0][n] = bias ? *(const f32x4*)(bias + col0 + 4 * n) : (f32x4){0.f, 0.f, 0.f, 0.f}; }
#pragma unroll
        for (int c = 0; c < 4; ++c) { const int bj = c >> 1, ai = c & 1;
            if (c < 3) { const int bj2 = (c + 1) >> 1, ai2 = (c + 1) & 1;
#pragma unroll
                for (int m4 = 0; m4 < 4; ++m4) xv[(c + 1) & 1][m4] = *(const u32x4*)(xb + (size_t)(ai2 * 128 + m4 * 16) * 2048 + bj2 * 128);
                if (c == 1) {
#pragma unroll
                    for (int n = 0; n < 2; ++n) { gv[1][n] = *(const f32x4*)(gp + 128 + 4 * n); bv[1][n] = bias ? *(const f32x4*)(bias + col0 + 128 + 4 * n) : (f32x4){0.f, 0.f, 0.f, 0.f}; } } }
#pragma unroll
            for (int m4 = 0; m4 < 4; ++m4) { const u32x4 xo = xv[c & 1][m4];
                const f32x4 xa = {__uint_as_float(xo.x << 16), __uint_as_float(xo.x & 0xffff0000u), __uint_as_float(xo.y << 16), __uint_as_float(xo.y & 0xffff0000u)};
                const f32x4 xc = {__uint_as_float(xo.z << 16), __uint_as_float(xo.z & 0xffff0000u), __uint_as_float(xo.w << 16), __uint_as_float(xo.w & 0xffff0000u)};
                const f32x4 ya = xa + gv[bj][0] * (acc[ai][bj][m4][0] + bv[bj][0]), yc = xc + gv[bj][1] * (acc[ai][bj][m4][1] + bv[bj][1]);
                u32x4 w; w.x = cvt_pk_bf16(ya[0], ya[1]); w.y = cvt_pk_bf16(ya[2], ya[3]); w.z = cvt_pk_bf16(yc[0], yc[1]); w.w = cvt_pk_bf16(yc[2], yc[3]);
                if (!dry) *(u32x4*)(xb + (size_t)(ai * 128 + m4 * 16) * 2048 + bj * 128) = w; } }
    }
};
struct EpiQKV {
    static constexpr bool PERM = true, AFTER_DRAIN = false;
    bf16_t* O; const cpx* rope;
    __device__ __forceinline__ void operator()(const f32x4 (&acc)[2][2][4][2], const Unit& u, int wr, int wc, int fr, int fq) const {
        const int row0 = u.pm * 256 + wr * 64 + fr, colt = u.pn * 256, col0 = colt + wc * 32 + 8 * fq;
        const int sidx = (colt % 3072) >> 10;
        const bool dorope = (sidx < 2) && (wc == 0);
        const float qs = (sidx == 0) ? QSCALE : 1.0f;
        f32x4 tt[2][4];
        if (dorope) { const cpx* rp = rope + (size_t)pos_of_row(row0) * 16 + 8 * (fq & 1);
            tt[0][0] = *(const f32x4*)(rp); tt[0][1] = *(const f32x4*)(rp + 2); tt[0][2] = *(const f32x4*)(rp + 4); tt[0][3] = *(const f32x4*)(rp + 6); }
#pragma unroll
        for (int g = 0; g < 8; ++g) { const int ai = g >> 2, m = g & 3; const int r = row0 + ai * 128 + m * 16; bf16_t* rowp = O + (size_t)r * QKVW + col0;
            f32x4 c0, c1, s0, s1;
            if (dorope) {
                if (g < 7) { const int r2 = row0 + ((g + 1) >> 2) * 128 + ((g + 1) & 3) * 16; const cpx* rp = rope + (size_t)pos_of_row(r2) * 16 + 8 * (fq & 1);
                    tt[(g + 1) & 1][0] = *(const f32x4*)(rp); tt[(g + 1) & 1][1] = *(const f32x4*)(rp + 2); tt[(g + 1) & 1][2] = *(const f32x4*)(rp + 4); tt[(g + 1) & 1][3] = *(const f32x4*)(rp + 6); }
                const f32x4 t0 = tt[g & 1][0], t1 = tt[g & 1][1], t2 = tt[g & 1][2], t3 = tt[g & 1][3];
                c0 = (f32x4){t0[0], t0[2], t1[0], t1[2]}; s0 = (f32x4){t0[1], t0[3], t1[1], t1[3]};
                c1 = (f32x4){t2[0], t2[2], t3[0], t3[2]}; s1 = (f32x4){t2[1], t2[3], t3[1], t3[3]}; }
#pragma unroll
            for (int bj = 0; bj < 2; ++bj) { f32x4 v0 = acc[ai][bj][m][0], v1 = acc[ai][bj][m][1];
                if (dorope) { f32x4 p0, p1;
#pragma unroll
                    for (int e = 0; e < 4; ++e) { p0[e] = __shfl_xor(v0[e], 32); p1[e] = __shfl_xor(v1[e], 32); }
                    if (fq < 2) { v0 = v0 * c0 - p0 * s0; v1 = v1 * c1 - p1 * s1; }
                    else        { v0 = v0 * c0 + p0 * s0; v1 = v1 * c1 + p1 * s1; } }
                v0 *= qs; v1 *= qs;
                u32x4 w; w.x = cvt_pk_bf16(v0[0], v0[1]); w.y = cvt_pk_bf16(v0[2], v0[3]); w.z = cvt_pk_bf16(v1[0], v1[1]); w.w = cvt_pk_bf16(v1[2], v1[3]);
                *(u32x4*)(rowp + bj * 128) = w; } }
    }
};
struct EpiFFN1 {
    static constexpr bool PERM = true, AFTER_DRAIN = false;
    bf16_t* O;
    __device__ __forceinline__ void operator()(const f32x4 (&acc)[2][2][4][2], const Unit& u, int wr, int wc, int fr, int fq) const {
        const int row0 = u.pm * 256 + wr * 64 + fr, col0 = u.pn * 128 + wc * 32 + 8 * fq;
#pragma unroll
        for (int ai = 0; ai < 2; ++ai)
#pragma unroll
            for (int m = 0; m < 4; ++m) { bf16_t* rowp = O + (size_t)(row0 + ai * 128 + m * 16) * DFF + col0; float o[8];
#pragma unroll
                for (int n = 0; n < 2; ++n)
#pragma unroll
                    for (int e = 0; e < 4; ++e) { const float g = acc[ai][0][m][n][e], up = acc[ai][1][m][n][e]; o[n * 4 + e] = g * __builtin_amdgcn_rcpf(1.0f + __expf(-g)) * up; }
                u32x4 w; w.x = cvt_pk_bf16(o[0], o[1]); w.y = cvt_pk_bf16(o[2], o[3]); w.z = cvt_pk_bf16(o[4], o[5]); w.w = cvt_pk_bf16(o[6], o[7]);
                *(u32x4*)rowp = w; }
    }
};
struct EpiTaps {
    static constexpr bool PERM = true, AFTER_DRAIN = false;
    _Float16* O;
    __device__ __forceinline__ void operator()(const f32x4 (&acc)[2][2][4][2], const Unit& u, int wr, int wc, int fr, int fq) const {
        typedef _Float16 h8 __attribute__((ext_vector_type(8)));
        const int row0 = u.pm * 256 + wr * 64 + fr, col0 = u.pn * 256 + wc * 32 + 8 * fq;
#pragma unroll
        for (int ai = 0; ai < 2; ++ai)
#pragma unroll
            for (int m = 0; m < 4; ++m) { _Float16* rowp = O + (size_t)(row0 + ai * 128 + m * 16) * NPOS + col0;
#pragma unroll
                for (int bj = 0; bj < 2; ++bj) { const f32x4 v0 = acc[ai][bj][m][0], v1 = acc[ai][bj][m][1]; h8 w;
                    w[0] = (_Float16)v0[0]; w[1] = (_Float16)v0[1]; w[2] = (_Float16)v0[2]; w[3] = (_Float16)v0[3]; w[4] = (_Float16)v1[0]; w[5] = (_Float16)v1[1]; w[6] = (_Float16)v1[2]; w[7] = (_Float16)v1[3];
                    *(h8*)(rowp + bj * 128) = w; } }
    }
};

__device__ __forceinline__ void ada_partials(const Params& p, LDSQ unsigned char* lds) {
    LDSQ float* cs = (LDSQ float*)lds;
    for (int i = pg8::otid(); i < 6 * 2048; i += NTHR) { const int b = i >> 11, k = i & 2047; const float c = b < 2 ? p.c_prompt[b * 2048 + k] : p.c_sample[(b - 2) * 2048 + k]; cs[i] = c / (1.0f + expf(-c)); }
    __syncthreads();
    float* part = (float*)(p.ws + WS_PART);
    for (int item = pg8::obid() * NTHR + pg8::otid(); item < 8 * 13312; item += pg8::ogrid() * NTHR) {
        const int chunk = item / 13312, c4 = item % 13312;
        const float* W; int ldw;
        if (c4 < 12288) { const int layer = c4 / 3072, col = (c4 % 3072) * 4; W = p.ada_w + (size_t)layer * 2048 * 12288 + col; ldw = 12288; }
        else { W = p.final_ada_w + (c4 - 12288) * 4; ldw = 4096; }
        f32x4 a0 = {0.f, 0.f, 0.f, 0.f}, a1 = a0, a2 = a0, a3 = a0, a4 = a0, a5 = a0;
        const int k0 = chunk * 256;
#pragma unroll 8
        for (int k = k0; k < k0 + 256; ++k) { const f32x4 w = *(const f32x4*)(W + (size_t)k * ldw);
            a0 += cs[k] * w; a1 += cs[2048 + k] * w; a2 += cs[4096 + k] * w; a3 += cs[6144 + k] * w; a4 += cs[8192 + k] * w; a5 += cs[10240 + k] * w; }
        float* o = part + (size_t)chunk * 6 * MODW + (size_t)c4 * 4;
        *(f32x4*)(o) = a0; *(f32x4*)(o + MODW) = a1; *(f32x4*)(o + 2 * MODW) = a2; *(f32x4*)(o + 3 * MODW) = a3; *(f32x4*)(o + 4 * MODW) = a4; *(f32x4*)(o + 5 * MODW) = a5;
    }
    __syncthreads();
}
__device__ __forceinline__ void ada_reduce(const Params& p) {
    const float* part = (const float*)(p.ws + WS_PART); float* mod = (float*)(p.ws + WS_MOD);
    for (int i = pg8::obid() * NTHR + pg8::otid(); i < 6 * MODW; i += pg8::ogrid() * NTHR) {
        const int c = i % MODW; float s = c < 49152 ? p.ada_b[c] : p.final_ada_b[c - 49152];
#pragma unroll
        for (int ch = 0; ch < 8; ++ch) s += part[(size_t)ch * 6 * MODW + i];
        mod[i] = s;
    }
}
__device__ __forceinline__ void rope_table(const Params& p) {
    cpx* rope = (cpx*)(p.ws + WS_ROPE);
    for (int i = pg8::obid() * NTHR + pg8::otid(); i < 16384 * 16; i += pg8::ogrid() * NTHR) {
        const int pos = i >> 4, f = i & 15; const float inv = powf(500000.0f, -(float)f / 16.0f); const float ang = (float)pos * inv;
        float s, c; sincosf(ang, &s, &c); rope[i] = mkc(c, s);
    }
}
__device__ __forceinline__ void filter_mlp(const Params& p) {
    const int lane = pg8::otid() & 63, gw = pg8::obid() * 8 + (pg8::otid() >> 6);
    bf16_t* a2x = (bf16_t*)(p.ws + WS_A2X);
    for (int q = gw; q < 2 * NPOS; q += pg8::ogrid() * 8) {
        const int j = q / NPOS, r = q % NPOS; const int L = r < 16384 ? 16384 : 2048, pos = r < 16384 ? r : r - 16384;
        const float fpos = (float)pos;
        float z = 0.f;
        if (lane == 0) z = fpos / (float)(L - 1);
        else if (lane <= 32) { const int bi = (lane - 1) & 15; const float band = 1e-4f + (float)bi * ((15.0f - 1e-4f) / 15.0f);
            const float ang = ((6.283185307179586f * fpos) * band) / (float)L; z = lane <= 16 ? cosf(ang) : -sinf(ang); }
        const float* w1 = p.hy_fw1 + j * 33 * 64; const float* w2 = p.hy_fw2 + j * 64 * 64;
        float acc = p.hy_fb1[j * 64 + lane];
#pragma unroll
        for (int m = 0; m < 33; ++m) acc += __shfl(z, m) * w1[m * 64 + lane];
        const float a1 = sinf(p.hy_ffreq[j * 128 + lane] * acc);
        acc = p.hy_fb2[j * 64 + lane];
#pragma unroll
        for (int m = 0; m < 64; ++m) acc += __shfl(a1, m) * w2[m * 64 + lane];
        const float a2 = sinf(p.hy_ffreq[j * 128 + 64 + lane] * acc);
        const bf16_t hi = f2bf(a2), lo = f2bf(a2 - bf2f(hi));
        bf16_t* o = a2x + ((size_t)j * NPOS + r) * 256;
        o[lane] = hi; o[64 + lane] = hi; o[128 + lane] = lo; o[192 + lane] = 0;
    }
    bf16_t* w3x = (bf16_t*)(p.ws + WS_W3X);
    for (int i = pg8::obid() * NTHR + pg8::otid(); i < 2 * 8192 * 64; i += pg8::ogrid() * NTHR) {
        const int k = i & 63, col = (i >> 6) & 8191, j = i >> 19;
        const float v = p.hy_fw3[(size_t)j * 64 * 8192 + (size_t)k * 8192 + col];
        const bf16_t hi = f2bf(v), lo = f2bf(v - bf2f(hi));
        bf16_t* o = w3x + ((size_t)j * 8192 + col) * 256;
        o[k] = hi; o[64 + k] = lo; o[128 + k] = hi; o[192 + k] = 0;
    }
}
__device__ __forceinline__ void convert_T(LDSQ unsigned char* lds, const float* src, int K, int N, bf16_t* dst, int ffs) {
    LDSQ float* tile = (LDSQ float*)lds;
    const int tid = pg8::otid(), ntn = N >> 8, ntiles = (K >> 6) * ntn, stride = pg8::ogrid();
    const int r = tid >> 6, c4 = tid & 63;
    f32x4 v[8];
    int ti = pg8::obid();
    if (ti < ntiles) { const int tk = ti / ntn, tn = ti % ntn;
#pragma unroll
        for (int it = 0; it < 8; ++it) v[it] = *(const f32x4*)(src + (size_t)(tk * 64 + r + 8 * it) * N + tn * 256 + 4 * c4); }
    for (; ti < ntiles; ti += stride) {
        const int tk = ti / ntn, tn = ti % ntn;
#pragma unroll
        for (int it = 0; it < 8; ++it) { LDSQ float* tp = tile + (r + 8 * it) * 257 + 4 * c4; tp[0] = v[it][0]; tp[1] = v[it][1]; tp[2] = v[it][2]; tp[3] = v[it][3]; }
        __syncthreads();
        if (ti + stride < ntiles) { const int t2 = ti + stride, tk2 = t2 / ntn, tn2 = t2 % ntn;
#pragma unroll
            for (int it = 0; it < 8; ++it) v[it] = *(const f32x4*)(src + (size_t)(tk2 * 64 + r + 8 * it) * N + tn2 * 256 + 4 * c4); }
        { const int n = tid >> 1, kh = tid & 1; const int nn = tn * 256 + n; const int row = ffs < 0 ? nn : (256 * (nn >> 7) + 128 * ffs + (nn & 127));
          bf16_t* dp = dst + (size_t)row * K + tk * 64 + kh * 32;
#pragma unroll
          for (int q = 0; q < 4; ++q) { float f[8];
#pragma unroll
              for (int e = 0; e < 8; ++e) f[e] = tile[(kh * 32 + q * 8 + e) * 257 + n];
              u32x4 w; w.x = cvt_pk_bf16(f[0], f[1]); w.y = cvt_pk_bf16(f[2], f[3]); w.z = cvt_pk_bf16(f[4], f[5]); w.w = cvt_pk_bf16(f[6], f[7]);
              *(u32x4*)(dp + q * 8) = w; } }
        __syncthreads();
    }
}
template <bool FINAL, bool SRC_F32> __device__ __forceinline__ void norm_rows(const float* xp, const float* xs, bf16_t* xb, const float* g, const float* modl, int sh_off, int sc_off, bf16_t* H, float* outf) {
    const int lane = pg8::otid() & 63, gw = pg8::obid() * 8 + (pg8::otid() >> 6), nw = pg8::ogrid() * 8;
    const int rpw = (T + nw - 1) / nw, r0 = gw * rpw, r1 = (r0 + rpw < T) ? r0 + rpw : T;
    if (r0 >= r1) return;
    f32x4 gs[8], sh[8]; int curseq = -1;
    struct RowBuf { f32x4 f[SRC_F32 ? 8 : 1]; u32x2 b[SRC_F32 ? 1 : 8]; };
    auto request = [&](RowBuf& B, int row) {
        if (SRC_F32) { const f32x4* src = (const f32x4*)(row < T_P ? xp + (size_t)row * 2048 : xs + (size_t)(row - T_P) * 2048);
#pragma unroll
            for (int i = 0; i < 8; ++i) B.f[i] = src[lane + 64 * i]; }
        else { const u32x2* src = (const u32x2*)(xb + (size_t)row * 2048);
#pragma unroll
            for (int i = 0; i < 8; ++i) B.b[i] = src[lane + 64 * i]; } };
    auto process = [&](RowBuf& B, int row, int next) {
        f32x4 v[8];
#pragma unroll
        for (int i = 0; i < 8; ++i) { if (SRC_F32) v[i] = B.f[i]; else v[i] = (f32x4){__uint_as_float(B.b[i].x << 16), __uint_as_float(B.b[i].x & 0xffff0000u), __uint_as_float(B.b[i].y << 16), __uint_as_float(B.b[i].y & 0xffff0000u)}; }
        if (next < r1) request(B, next);
        const int seq = seq_of_row(row);
        if (seq != curseq) { curseq = seq; const float* mod = modl + (size_t)seq * MODW;
#pragma unroll
            for (int i = 0; i < 8; ++i) { const int col = (lane + 64 * i) * 4; gs[i] = *(const f32x4*)(g + col); sh[i] = *(const f32x4*)(mod + sc_off + col); }
#pragma unroll
            for (int i = 0; i < 8; ++i) { const int col = (lane + 64 * i) * 4; const f32x4 sft = *(const f32x4*)(mod + sh_off + col); gs[i] = gs[i] * (1.0f + sh[i]); sh[i] = sft; } }
        float ss = 0.f;
#pragma unroll
        for (int i = 0; i < 8; ++i) ss += v[i][0] * v[i][0] + v[i][1] * v[i][1] + v[i][2] * v[i][2] + v[i][3] * v[i][3];
        ss = wave_sum(ss);
        const float rstd = 1.0f / sqrtf(ss * (1.0f / 2048.0f) + EPS);
#pragma unroll
        for (int i = 0; i < 8; ++i) { const int col = (lane + 64 * i) * 4;
            const f32x4 h = (v[i] * rstd) * gs[i] + sh[i];
            if (FINAL) *(f32x4*)(outf + (size_t)row * 2048 + col) = h;
            else { u32x2 w; w.x = cvt_pk_bf16(h[0], h[1]); w.y = cvt_pk_bf16(h[2], h[3]); *(u32x2*)(H + (size_t)row * 2048 + col) = w;
                if (SRC_F32) { u32x2 c; c.x = cvt_pk_bf16(v[i][0], v[i][1]); c.y = cvt_pk_bf16(v[i][2], v[i][3]); *(u32x2*)(xb + (size_t)row * 2048 + col) = c; } } } };
    if (SRC_F32) {
        RowBuf B0, B1;
        request(B0, r0); if (r0 + 1 < r1) request(B1, r0 + 1);
        for (int row = r0; row < r1; row += 2) { process(B0, row, row + 2); if (row + 1 < r1) process(B1, row + 1, row + 3); }
    } else {
        RowBuf B0, B1, B2;
        request(B0, r0); if (r0 + 1 < r1) request(B1, r0 + 1); if (r0 + 2 < r1) request(B2, r0 + 2);
        for (int row = r0; row < r1; row += 3) {
            process(B0, row, row + 3);
            if (row + 1 < r1) process(B1, row + 1, row + 4);
            if (row + 2 < r1) process(B2, row + 2, row + 5);
        }
    }
}
__device__ __forceinline__ void final_norm_phase(const Params& p) {
    norm_rows<true, false>(nullptr, nullptr, (bf16_t*)(p.ws + WS_XB), p.final_norm, (const float*)(p.ws + WS_MOD) + 49152, 0, 2048, nullptr, p.out);
}
__device__ __forceinline__ void transpose_phase(const Params& p, LDSQ unsigned char* lds) {
    LDSQ bf16_t* tile = (LDSQ bf16_t*)lds;
    const bf16_t* zin = (const bf16_t*)(p.ws + WS_BIG + BIG_ZINT); bf16_t* H = (bf16_t*)(p.ws + WS_H);
    const int tid = pg8::otid(), stride = pg8::ogrid();
    const int cr = tid >> 5, tq = tid & 31;
    u32x4 v[4];
    int ti = pg8::obid();
    if (ti < 32 * 160) { const int tc = ti / 160, tt = ti % 160;
#pragma unroll
        for (int it = 0; it < 4; ++it) v[it] = *(const u32x4*)(zin + (size_t)(tc * 64 + cr + 16 * it) * T + tt * 256 + tq * 8); }
    for (; ti < 32 * 160; ti += stride) {
        const int tc = ti / 160, tt = ti % 160;
#pragma unroll
        for (int it = 0; it < 4; ++it) *(LDSQ u32x4*)(tile + (cr + 16 * it) * 264 + tq * 8) = v[it];
        __syncthreads();
        if (ti + stride < 32 * 160) { const int t2 = ti + stride, tc2 = t2 / 160, tt2 = t2 % 160;
#pragma unroll
            for (int it = 0; it < 4; ++it) v[it] = *(const u32x4*)(zin + (size_t)(tc2 * 64 + cr + 16 * it) * T + tt2 * 256 + tq * 8); }
        { const int cq = tid & 7, tk = tid >> 3;
#pragma unroll
          for (int it = 0; it < 4; ++it) { const int tok = tk + 64 * it; unsigned w[4];
#pragma unroll
              for (int e = 0; e < 4; ++e) { const unsigned lo = tile[(cq * 8 + 2 * e) * 264 + tok], hi = tile[(cq * 8 + 2 * e + 1) * 264 + tok]; w[e] = lo | (hi << 16); }
              *(u32x4*)(H + (size_t)(tt * 256 + tok) * 2048 + tc * 64 + cq * 8) = (u32x4){w[0], w[1], w[2], w[3]}; } }
        __syncthreads();
    }
}

__host__ __device__ constexpr float cos64q(int k) {
    constexpr float t[17] = {1.0f, 0.99518472667219693f, 0.98078528040323043f, 0.95694033573220882f, 0.92387953251128674f, 0.88192126434835505f, 0.83146961230254524f,
        0.77301045336273699f, 0.70710678118654757f, 0.63439328416364549f, 0.55557023301960229f, 0.47139673682599781f, 0.38268343236508984f, 0.29028467725446233f,
        0.19509032201612833f, 0.09801714032956077f, 0.0f};
    return t[k];
}
__host__ __device__ constexpr float cos64(int k) { k &= 63; return k <= 16 ? cos64q(k) : k <= 32 ? -cos64q(32 - k) : k <= 48 ? -cos64q(k - 32) : cos64q(64 - k); }
__host__ __device__ constexpr float sin64(int k) { return cos64((k + 48) & 63); }
template <int R> __host__ __device__ constexpr int brev(int k) { int r = 0; for (int b = 1; b < R; b <<= 1) { r = (r << 1) | (k & 1); k >>= 1; } return r; }

typedef _Float16 hcpx __attribute__((ext_vector_type(2)));
typedef _Float16 hcpx2 __attribute__((ext_vector_type(4)));
__device__ __forceinline__ hcpx h_of(cpx a) { hcpx r; r.x = (_Float16)a.x; r.y = (_Float16)a.y; return r; }
__device__ __forceinline__ cpx c_of(hcpx a) { return mkc((float)a.x, (float)a.y); }
__device__ __forceinline__ hcpx2 h2_of(cpx a, cpx b) { hcpx2 r; r.x = (_Float16)a.x; r.y = (_Float16)a.y; r.z = (_Float16)b.x; r.w = (_Float16)b.y; return r; }
#define VA __device__ __forceinline__ float
VA f_mul(float a, float b) { float r; asm("v_mul_f32_e32 %0, %1, %2" : "=v"(r) : "v"(a), "v"(b)); return r; }
VA f_fma(float a, float b, float c) { float r; asm("v_fma_f32 %0, %1, %2, %3" : "=v"(r) : "v"(a), "v"(b), "v"(c)); return r; }
VA f_fms(float a, float b, float c) { float r; asm("v_fma_f32 %0, %1, %2, -%3" : "=v"(r) : "v"(a), "v"(b), "v"(c)); return r; }
#undef VA
__device__ __forceinline__ cpx cmul(cpx a, cpx b) { float rx, ry;
    asm("v_mul_f32_e32 %0, %3, %5\n\tv_mul_f32_e32 %1, %3, %4\n\tv_fma_f32 %0, %2, %4, -%0\n\tv_fma_f32 %1, %2, %5, %1" : "=&v"(rx), "=&v"(ry) : "v"(a.x), "v"(a.y), "v"(b.x), "v"(b.y)); return mkc(rx, ry); }
__device__ __forceinline__ cpx cmulc(cpx a, cpx b) { float rx, ry;
    asm("v_mul_f32_e32 %0, %3, %5\n\tv_mul_f32_e32 %1, %2, %5\n\tv_fma_f32 %0, %2, %4, %0\n\tv_fma_f32 %1, %3, %4, -%1" : "=&v"(rx), "=&v"(ry) : "v"(a.x), "v"(a.y), "v"(b.x), "v"(b.y)); return mkc(rx, ry); }

template <int R, bool INV, int H, int P> __device__ __forceinline__ void bfly(cpx (&v)[R]) {
    constexpr int b = (P / H) * 2 * H, i = P % H, e = i * (32 / H);
    float ux = v[b + i].x, uy = v[b + i].y, wx = v[b + i + H].x, wy = v[b + i + H].y;
    if constexpr (e == 0) { float dx, dy;
        asm("v_sub_f32_e32 %2, %0, %4\n\tv_sub_f32_e32 %3, %1, %5\n\tv_add_f32_e32 %0, %0, %4\n\tv_add_f32_e32 %1, %1, %5" : "+v"(ux), "+v"(uy), "=&v"(dx), "=&v"(dy) : "v"(wx), "v"(wy));
        wx = dx; wy = dy; }
    else if constexpr (e == 16) { float ox, oy;
        if constexpr (!INV) asm("v_sub_f32_e32 %2, %1, %5\n\tv_sub_f32_e32 %3, %4, %0\n\tv_add_f32_e32 %0, %0, %4\n\tv_add_f32_e32 %1, %1, %5" : "+v"(ux), "+v"(uy), "=&v"(ox), "=&v"(oy) : "v"(wx), "v"(wy));
        else                asm("v_sub_f32_e32 %2, %5, %1\n\tv_sub_f32_e32 %3, %0, %4\n\tv_add_f32_e32 %0, %0, %4\n\tv_add_f32_e32 %1, %1, %5" : "+v"(ux), "+v"(uy), "=&v"(ox), "=&v"(oy) : "v"(wx), "v"(wy));
        wx = ox; wy = oy; }
    else { constexpr float c = cos64(e), s = INV ? sin64(e) : -sin64(e);
        constexpr unsigned cb = __builtin_bit_cast(unsigned, c), sb = __builtin_bit_cast(unsigned, s), nsb = __builtin_bit_cast(unsigned, -s);
        float dx, dy;
        asm("v_sub_f32_e32 %4, %0, %2\n\tv_sub_f32_e32 %5, %1, %3\n\tv_add_f32_e32 %0, %0, %2\n\tv_add_f32_e32 %1, %1, %3\n\t"
            "v_mul_f32_e32 %2, %8, %5\n\tv_mul_f32_e32 %3, %6, %5\n\tv_fmamk_f32 %2, %4, %6, %2\n\tv_fmamk_f32 %3, %4, %7, %3"
            : "+v"(ux), "+v"(uy), "+v"(wx), "+v"(wy), "=&v"(dx), "=&v"(dy) : "i"(cb), "i"(sb), "i"(nsb)); }
    v[b + i] = mkc(ux, uy); v[b + i + H] = mkc(wx, wy);
}
template <int R, bool INV, int H, int... Ps> __device__ __forceinline__ void dft_stage(cpx (&v)[R], std::integer_sequence<int, Ps...>) { (bfly<R, INV, H, Ps>(v), ...); }
template <int R, bool INV, int H> __device__ __forceinline__ void dft_stages(cpx (&v)[R]) {
    dft_stage<R, INV, H>(v, std::make_integer_sequence<int, R / 2>{});
    if constexpr (H > 1) dft_stages<R, INV, H / 2>(v);
}
template <int R, bool INV> __device__ __forceinline__ void dft_r2(cpx (&v)[R]) { dft_stages<R, INV, R / 2>(v); }
template <int R, bool CONJ, bool BREV> __device__ __forceinline__ void apply_pows(cpx (&v)[R], cpx w) {
    constexpr int H = R > 16 ? 16 : R;
    cpx pw[H];
    pw[1] = w;
#pragma unroll
    for (int k = 2; k < H; ++k) pw[k] = (k & 1) ? cmul(pw[k - 1], w) : cmul(pw[k / 2], pw[k / 2]);
#pragma unroll
    for (int k = 1; k < H; ++k) { const int idx = BREV ? brev<R>(k) : k; v[idx] = CONJ ? cmulc(v[idx], pw[k]) : cmul(v[idx], pw[k]); }
    if (R > 16) {
        const cpx w16 = cmul(pw[8], pw[8]);
#pragma unroll
        for (int k = 0; k < R - 16; ++k) { const cpx q = k == 0 ? w16 : cmul(pw[k], w16); const int idx = BREV ? brev<R>(16 + k) : 16 + k; v[idx] = CONJ ? cmulc(v[idx], q) : cmul(v[idx], q); }
    }
}
__device__ __forceinline__ int phys(int i) { return i + (i >> 5); }
constexpr int TW_OFF = 135168 + 64;
template <int S> __host__ __device__ constexpr int poff(int j) { return S >= 32 ? j * (S + S / 32) : j * S + ((j * S) >> 5); }
typedef hcpx PreRegs[32];
template <int R, int S> __device__ __forceinline__ void fft_prefetch(int t, const hcpx* gio, PreRegs& pre) {
    constexpr int G = 32 / R;
#pragma unroll
    for (int gi = 0; gi < G; ++gi) { const int gam = gi * 512 + t, hi = gam / S, lo = gam % S, base = hi * (R * S) + lo;
#pragma unroll
        for (int j = 0; j < R; ++j) pre[gi * R + j] = __builtin_nontemporal_load(gio + base + j * S); }
}
template <int R, int S, bool INV, int IO> __device__ __forceinline__ void fft_pass(LDSQ cpx* A, int t, hcpx* gio, const PreRegs& pre) {
    constexpr int G = 32 / R;
    asm volatile("" : "+v"(t) :: "memory");
    const LDSQ cpx* TW = (const LDSQ cpx*)((LDSQ unsigned char*)A + TW_OFF);
    cpx v[G][R]; cpx tw[G];
#pragma unroll
    for (int gi = 0; gi < G; ++gi) {
        const int gam = gi * 512 + t, hi = gam / S, lo = gam % S, base = hi * (R * S) + lo; const LDSQ cpx* Ab = A + phys(base);
#pragma unroll
        for (int j = 0; j < R; ++j) v[gi][j] = (IO == 3) ? c_of(pre[gi * R + j]) : (IO == 1) ? c_of(__builtin_nontemporal_load(gio + base + j * S)) : Ab[poff<S>(j)];
        tw[gi] = TW[lo * (16384 / (R * S))];
    }
#pragma unroll
    for (int gi = 0; gi < G; ++gi) {
        const int gam = gi * 512 + t, hi = gam / S, lo = gam % S, base = hi * (R * S) + lo; LDSQ cpx* Ab = A + phys(base);
        if (!INV) {
            dft_r2<R, false>(v[gi]);
            apply_pows<R, false, true>(v[gi], tw[gi]);
#pragma unroll
            for (int k = 0; k < R; ++k) { if (IO == 2) gio[base + k * S] = h_of(v[gi][brev<R>(k)]); else Ab[poff<S>(k)] = v[gi][brev<R>(k)]; }
        } else {
            apply_pows<R, true, false>(v[gi], tw[gi]);
            dft_r2<R, true>(v[gi]);
#pragma unroll
            for (int j = 0; j < R; ++j) { if (IO == 2) gio[base + j * S] = h_of(v[gi][brev<R>(j)]); else Ab[poff<S>(j)] = v[gi][brev<R>(j)]; }
        }
    }
}
template <int R, int MODE> __device__ __forceinline__ void fft_mid(LDSQ cpx* A, int t, hcpx* spec, float scale) {
    constexpr int G = 32 / R;
    asm volatile("" : "+v"(t) :: "memory");
    hcpx2 sp[G][R / 2];
    if (MODE == 1) {
#pragma unroll
        for (int gi = 0; gi < G; ++gi)
#pragma unroll
            for (int k2 = 0; k2 < R / 2; ++k2) sp[gi][k2] = *(const hcpx2*)(spec + (size_t)(gi * 512 + t) * R + 2 * k2);
    }
#pragma unroll
    for (int gi = 0; gi < G; ++gi) {
        const int gam = gi * 512 + t, base = gam * R;
        cpx v[R];
        LDSQ cpx* Ab = A + phys(base);
#pragma unroll
        for (int j = 0; j < R; ++j) v[j] = Ab[j];
        dft_r2<R, false>(v);
        if (MODE == 0) {
#pragma unroll
            for (int k2 = 0; k2 < R / 2; ++k2) { const cpx x = v[brev<R>(2 * k2)], y = v[brev<R>(2 * k2 + 1)];
                *(hcpx2*)(spec + (size_t)base + 2 * k2) = h2_of(mkc(x.x * scale, x.y * scale), mkc(y.x * scale, y.y * scale)); }
        } else {
            cpx x[R];
#pragma unroll
            for (int k2 = 0; k2 < R / 2; ++k2) { const hcpx2 s = sp[gi][k2]; x[2 * k2] = cmul(v[brev<R>(2 * k2)], mkc((float)s.x * scale, (float)s.y * scale)); x[2 * k2 + 1] = cmul(v[brev<R>(2 * k2 + 1)], mkc((float)s.z * scale, (float)s.w * scale)); }
            dft_r2<R, true>(x);
#pragma unroll
            for (int j = 0; j < R; ++j) Ab[j] = x[brev<R>(j)];
        }
    }
}
#define GL_DRAIN() asm volatile("s_waitcnt vmcnt(0)" ::: "memory")
struct NoHook { __device__ __forceinline__ void operator()() const {} };
template <int LOG2L, bool INV, int GIO, class Hook = NoHook> __device__ __forceinline__ void fft_outer(LDSQ cpx* A, int t, hcpx* gio, const hcpx* pfsrc, PreRegs& pre, Hook hook = Hook()) {
    constexpr int R1 = LOG2L == 14 ? 32 : 16, S1 = LOG2L == 14 ? 512 : 128, S2 = LOG2L == 14 ? 16 : 8;
    if (!INV) { fft_pass<R1, S1, false, GIO == 3 ? 3 : 0>(A, t, nullptr, pre); __syncthreads(); fft_pass<R1, S2, false, 0>(A, t, nullptr, pre); GL_DRAIN(); __syncthreads(); }
    else      { fft_pass<R1, S2, true, 0>(A, t, nullptr, pre); __syncthreads();
                if (GIO == 2) fft_prefetch<R1, S1>(t, pfsrc, pre);
                hook();
                fft_pass<R1, S1, true, GIO == 2 ? 2 : 0>(A, t, gio, pre); if (GIO != 2) GL_DRAIN(); __syncthreads(); }
}
template <int LOG2L, int SRC, int DST, class Hook = NoHook> __device__ __forceinline__ void fft_conv(LDSQ cpx* A, int t, hcpx* spec, hcpx* gdst, const hcpx* pfsrc, PreRegs& pre, Hook hook = Hook()) {
    fft_outer<LOG2L, false, SRC>(A, t, nullptr, nullptr, pre);
    fft_mid<LOG2L == 14 ? 16 : 8, 1>(A, t, spec, 1.0f / (float)(1 << LOG2L));
    if (SRC == 3) GL_DRAIN();
    __syncthreads();
    fft_outer<LOG2L, true, DST>(A, t, gdst, pfsrc, pre, hook);
}

__device__ __forceinline__ void sconv4r(u32x2 q, unsigned zmr, unsigned zpr, float w0, float w1, float w2, float bb, float (&o)[4]) {
    const float zm = __uint_as_float(zmr << 16), zp = __uint_as_float(zpr << 16);
    const float z0 = __uint_as_float(q.x << 16), z1 = __uint_as_float(q.x & 0xffff0000u), z2 = __uint_as_float(q.y << 16), z3 = __uint_as_float(q.y & 0xffff0000u);
    o[0] = w0 * zm + w1 * z0 + w2 * z1 + bb; o[1] = w0 * z0 + w1 * z1 + w2 * z2 + bb; o[2] = w0 * z1 + w1 * z2 + w2 * z3 + bb; o[3] = w0 * z2 + w1 * z3 + w2 * zp + bb;
}
typedef _Float16 h4 __attribute__((ext_vector_type(4)));
__device__ __forceinline__ void tapquad(h4 a, h4 bq, unsigned b0bits, float wf, float wb, float rf1, float rf2, float rf3, float rb1, float rb2, float rb3, float (&fa)[4], float (&fb)[4]) {
    const float b0 = (float)__builtin_bit_cast(_Float16, (unsigned short)b0bits);
    fa[0] = (float)a.x * wf; fa[1] = (float)a.y * (wf * rf1); fa[2] = (float)a.z * (wf * rf2); fa[3] = (float)a.w * (wf * rf3);
    fb[0] = b0 * wb; fb[1] = (float)bq.w * (wb * rb1); fb[2] = (float)bq.z * (wb * rb2); fb[3] = (float)bq.y * (wb * rb3);
}
template <int LOG2L> struct SweepIdx {
    static constexpr int L = 1 << LOG2L, QS = L / 32;
    int t, seq, n00, a00; cpx wq0, w1, w2, w3;
    __device__ __forceinline__ SweepIdx(int t_, bool need_w) { t = t_; asm volatile("" : "+v"(t) :: "memory"); seq = (LOG2L == 14) ? 0 : (t >> 6); const int q0 = (LOG2L == 14) ? t : (t & 63); n00 = 4 * q0; a00 = seq * L + n00;
        if (need_w) { float sb, cb; sincospif(-(float)n00 / (float)L, &sb, &cb); wq0 = mkc(cb, sb);
            sincospif(-1.0f / (float)L, &sb, &cb); w1 = mkc(cb, sb); w2 = cmul(w1, w1); w3 = cmul(w2, w1); } }
};
#define WQS mkc(0.92387953251128674f, -0.38268343236508978f)
struct TapWin { float wf0, wfs, rf1, rf2, rf3, wb0, wbs, rb1, rb2, rb3; };
template <int LOG2L> __device__ __forceinline__ TapWin tap_windows(float df, float db, int n00) {
    constexpr int L = 1 << LOG2L, QS = L / 32; TapWin w;
    w.wf0 = expf(-df * (float)n00); w.wfs = expf(-df * (float)(4 * QS)); w.rf1 = expf(-df); w.rf2 = w.rf1 * w.rf1; w.rf3 = w.rf2 * w.rf1;
    w.wb0 = expf(-db * (float)(L - n00)); w.wbs = expf(db * (float)(4 * QS)); w.rb1 = expf(db); w.rb2 = w.rb1 * w.rb1; w.rb3 = w.rb2 * w.rb1; return w;
}
template <int LOG2L> __device__ __forceinline__ void sweep_taps2(LDSQ cpx* A, int t_, const _Float16* tf0, const _Float16* tb0, const _Float16* tf1, const _Float16* tb1, float df0, float db0, float df1, float db1, hcpx* hos, float& ss0, float& ss1) {
    constexpr int L = 1 << LOG2L, QS = L / 32; const SweepIdx<LOG2L> X(t_, true);
    const TapWin W0 = tap_windows<LOG2L>(df0, db0, X.n00), W1 = tap_windows<LOG2L>(df1, db1, X.n00);
    float s0 = 0.f, s1 = 0.f, wf0 = W0.wf0, wb0 = W0.wb0, wf1 = W1.wf0, wb1 = W1.wb0;
    cpx wn = X.wq0;
    h4 ra0[8], rb0[8], ra1[8], rb1[8]; unsigned rc0[8], rc1[8];
#pragma unroll
    for (int i = 0; i < 8; ++i) { const int n = 4 * (i * QS) + X.n00, nb = n > 0 ? L - n : L - 1;
        ra0[i] = *(const h4*)(tf0 + n); rb0[i] = *(const h4*)(tb0 + L - n - 4); rc0[i] = ((const unsigned short*)tb0)[nb];
        ra1[i] = *(const h4*)(tf1 + n); rb1[i] = *(const h4*)(tb1 + L - n - 4); rc1[i] = ((const unsigned short*)tb1)[nb]; }
#pragma unroll
    for (int i = 0; i < 8; ++i) { const int n = 4 * (i * QS) + X.n00; float fa0[4], fb0[4], fa1[4], fb1[4]; const unsigned hm = n > 0 ? 0xffffu : 0u;
        tapquad(ra0[i], rb0[i], rc0[i] & hm, wf0, wb0, W0.rf1, W0.rf2, W0.rf3, W0.rb1, W0.rb2, W0.rb3, fa0, fb0);
        tapquad(ra1[i], rb1[i], rc1[i] & hm, wf1, wb1, W1.rf1, W1.rf2, W1.rf3, W1.rb1, W1.rb2, W1.rb3, fa1, fb1);
        LDSQ cpx* ap = A + phys(X.a00 + 4 * i * QS); hcpx* hp = hos + X.a00 + 4 * i * QS;
#pragma unroll
        for (int e = 0; e < 4; ++e) { s0 += fa0[e] * fa0[e] + fb0[e] * fb0[e]; s1 += fa1[e] * fa1[e] + fb1[e] * fb1[e]; ap[e] = mkc(fa0[e] + fb0[e], fa1[e] + fb1[e]); }
        const cpx wa = cmul(wn, X.w1), wb2 = cmul(wn, X.w2), wc = cmul(wn, X.w3);
        const cpx y0 = cmul(mkc(fa0[0] - fb0[0], fa1[0] - fb1[0]), wn), y1 = cmul(mkc(fa0[1] - fb0[1], fa1[1] - fb1[1]), wa);
        const cpx y2 = cmul(mkc(fa0[2] - fb0[2], fa1[2] - fb1[2]), wb2), y3 = cmul(mkc(fa0[3] - fb0[3], fa1[3] - fb1[3]), wc);
        *(hcpx2*)hp = h2_of(y0, y1); *(hcpx2*)(hp + 2) = h2_of(y2, y3);
        wn = cmul(wn, WQS); wf0 *= W0.wfs; wb0 *= W0.wbs; wf1 *= W1.wfs; wb1 *= W1.wbs; }
    ss0 = s0; ss1 = s1;
}
template <int LOG2L, int PART> __device__ __forceinline__ void fft_mid_sep(LDSQ cpx* A, int t, hcpx* spec0, hcpx* spec1, const LDSQ float* red, const float* skp0, const float* skp1) {
    constexpr int R = LOG2L == 14 ? 16 : 8, G = 32 / R, NB = LOG2L == 14 ? 32 : 16, NG = NB * NB;
    asm volatile("" : "+v"(t) :: "memory");
#pragma unroll
    for (int gi = 0; gi < G; ++gi) {
        cpx v[R]; LDSQ cpx* Ab = A + phys((gi * 512 + t) * R);
#pragma unroll
        for (int j = 0; j < R; ++j) v[j] = Ab[j];
        dft_r2<R, false>(v);
#pragma unroll
        for (int k = 0; k < R; ++k) Ab[k] = v[brev<R>(k)];
    }
    __syncthreads();
#pragma unroll
    for (int gi = 0; gi < G; ++gi) {
        const int gam = gi * 512 + t, seq = gam / NG, g = gam % NG, k1 = g / NB, k2 = g % NB;
        const int gp = PART == 1 ? NG - 1 - g : (k1 ? (NB - k1) * NB + (NB - 1 - k2) : (k2 ? NB - k2 : 0));
        const bool wrap = PART == 0 && g == 0;
        const LDSQ cpx* Ab = A + phys(gam * R); const LDSQ cpx* Ap = A + phys((seq * NG + gp) * R);
        cpx z[R], q[R];
#pragma unroll
        for (int k = 0; k < R; ++k) { z[k] = Ab[k]; q[k] = Ap[k]; }
        float ss0, ss1;
        if (LOG2L == 14) { ss0 = red[0] + red[1] + red[2] + red[3] + red[4] + red[5] + red[6] + red[7]; ss1 = red[8] + red[9] + red[10] + red[11] + red[12] + red[13] + red[14] + red[15]; }
        else { ss0 = red[seq]; ss1 = red[8 + seq]; }
        const float n0 = 0.25f / sqrtf(ss0 + EPS), n1 = 0.25f / sqrtf(ss1 + EPS), h0 = 0.5f * skp0[seq], h1 = 0.5f * skp1[seq];
        hcpx* s0p = spec0 + (size_t)gam * R; hcpx* s1p = spec1 + (size_t)gam * R;
#pragma unroll
        for (int k2_ = 0; k2_ < R / 2; ++k2_) { cpx o0[2], o1[2];
#pragma unroll
            for (int e = 0; e < 2; ++e) { const int k = 2 * k2_ + e; cpx zp = q[R - 1 - k]; const cpx zw = q[(R - k) & (R - 1)];
                if (PART == 0) { zp.x = wrap ? zw.x : zp.x; zp.y = wrap ? zw.y : zp.y; }
                o0[e] = mkc((z[k].x + zp.x) * n0 + h0, (z[k].y - zp.y) * n0); o1[e] = mkc((z[k].y + zp.y) * n1 + h1, (zp.x - z[k].x) * n1); }
            *(hcpx2*)(s0p + 2 * k2_) = h2_of(o0[0], o0[1]); *(hcpx2*)(s1p + 2 * k2_) = h2_of(o1[0], o1[1]); }
    }
}
template <int LOG2L> __device__ __forceinline__ void sweep_load_v(LDSQ cpx* A, int t_, const bf16_t* zrow, size_t tb0, const float* cw, const float* cbias, int rc0, hcpx* xw) {
    constexpr int L = 1 << LOG2L, QS = L / 32; const SweepIdx<LOG2L> X(t_, true);
    const int rc = rc0 + X.seq; const float cw0 = cw[rc], cw1 = cw[6144 + rc], cw2 = cw[2 * 6144 + rc], bb = cbias[rc];
    const bf16_t* z0 = zrow + (size_t)rc * T + tb0; const bf16_t* z1 = z0 + L;
    cpx wn = X.wq0;
    u32x2 rq[8][2]; unsigned rm[8][2], rp[8][2];
#pragma unroll
    for (int i = 0; i < 8; ++i) { const int n = 4 * (i * QS) + X.n00, nm = n > 0 ? n - 1 : 0, np = n + 4 < L ? n + 4 : L - 1;
        rq[i][0] = *(const u32x2*)(z0 + n); rq[i][1] = *(const u32x2*)(z1 + n); rm[i][0] = z0[nm]; rm[i][1] = z1[nm]; rp[i][0] = z0[np]; rp[i][1] = z1[np]; }
#pragma unroll
    for (int i = 0; i < 8; ++i) { const int n = 4 * (i * QS) + X.n00; float xa[4], xb[4]; const unsigned hm = n > 0 ? 0xffffu : 0u, hp = n + 4 < L ? 0xffffu : 0u;
        sconv4r(rq[i][0], rm[i][0] & hm, rp[i][0] & hp, cw0, cw1, cw2, bb, xa); sconv4r(rq[i][1], rm[i][1] & hm, rp[i][1] & hp, cw0, cw1, cw2, bb, xb);
        LDSQ cpx* ap = A + phys(X.a00 + 4 * i * QS); hcpx* xp = xw + X.a00 + 4 * i * QS;
        ap[0] = mkc(xa[0], xb[0]); ap[1] = mkc(xa[1], xb[1]); ap[2] = mkc(xa[2], xb[2]); ap[3] = mkc(xa[3], xb[3]);
        const cpx y0 = cmul(mkc(xa[0], xb[0]), wn), y1 = cmul(mkc(xa[1], xb[1]), cmul(wn, X.w1)), y2 = cmul(mkc(xa[2], xb[2]), cmul(wn, X.w2)), y3 = cmul(mkc(xa[3], xb[3]), cmul(wn, X.w3));
        *(hcpx2*)xp = h2_of(y0, y1); *(hcpx2*)(xp + 2) = h2_of(y2, y3);
        wn = cmul(wn, WQS); }
}
constexpr int CPA = 2;
template <int N> struct CombPreN { u32x2 q[N][2]; unsigned zm[N][2], zp[N][2]; hcpx2 h01[N], h23[N]; };
typedef CombPreN<CPA> CombPre;
template <int LOG2L, int I0, int N> __device__ __forceinline__ void combine_prefetch(int t_, const hcpx* yes, const bf16_t* zrow, size_t tb0, int rg0, CombPreN<N>& P) {
    constexpr int L = 1 << LOG2L, QS = L / 32; const SweepIdx<LOG2L> X(t_, false);
    const int rg = rg0 + X.seq; const bf16_t* g0 = zrow + (size_t)rg * T + tb0; const bf16_t* g1 = g0 + L;
#pragma unroll
    for (int i = 0; i < N; ++i) { const int n = 4 * ((I0 + i) * QS) + X.n00; const hcpx* yp = yes + X.a00 + 4 * (I0 + i) * QS;
        P.q[i][0] = *(const u32x2*)(g0 + n); P.q[i][1] = *(const u32x2*)(g1 + n);
        const int nm = n > 0 ? n - 1 : 0, np = n + 4 < L ? n + 4 : L - 1;
        P.zm[i][0] = g0[nm]; P.zm[i][1] = g1[nm]; P.zp[i][0] = g0[np]; P.zp[i][1] = g1[np];
        P.h01[i] = __builtin_nontemporal_load((const hcpx2*)yp); P.h23[i] = __builtin_nontemporal_load((const hcpx2*)(yp + 2)); }
}
template <int LOG2L, int FINAL> __device__ __forceinline__ void sweep_combine(LDSQ cpx* A, int t_, const CombPre& P0, const hcpx* yes, hcpx* xw, bf16_t* zrow, size_t tb0, const float* cw, const float* cbias, int rg0, int ro0, int dry) {
    constexpr int L = 1 << LOG2L, QS = L / 32; const SweepIdx<LOG2L> X(t_, true);
    CombPreN<8 - CPA> P1; combine_prefetch<LOG2L, CPA>(X.t, yes, zrow, tb0, rg0, P1);
    const int rg = rg0 + X.seq; const float cw0 = cw[rg], cw1 = cw[6144 + rg], cw2 = cw[2 * 6144 + rg], bb = cbias[rg];
    bf16_t* o0 = zrow + (size_t)(ro0 + X.seq) * T + tb0; bf16_t* o1 = o0 + L;
    cpx wn = X.wq0;
#pragma unroll
    for (int i = 0; i < 8; ++i) { const int n = 4 * (i * QS) + X.n00; float ga[4], gb[4];
        const bool ah = i < CPA; const int ia = ah ? i : 0, ib = ah ? 0 : i - CPA;
        const unsigned hm = n > 0 ? 0xffffu : 0u, hp = n + 4 < L ? 0xffffu : 0u;
        sconv4r(ah ? P0.q[ia][0] : P1.q[ib][0], (ah ? P0.zm[ia][0] : P1.zm[ib][0]) & hm, (ah ? P0.zp[ia][0] : P1.zp[ib][0]) & hp, cw0, cw1, cw2, bb, ga);
        sconv4r(ah ? P0.q[ia][1] : P1.q[ib][1], (ah ? P0.zm[ia][1] : P1.zm[ib][1]) & hm, (ah ? P0.zp[ia][1] : P1.zp[ib][1]) & hp, cw0, cw1, cw2, bb, gb);
        const LDSQ cpx* ap = A + phys(X.a00 + 4 * i * QS);
        const hcpx2 h01 = ah ? P0.h01[ia] : P1.h01[ib], h23 = ah ? P0.h23[ia] : P1.h23[ib];
        const f32x4 e01 = {(float)h01.x, (float)h01.y, (float)h01.z, (float)h01.w}, e23 = {(float)h23.x, (float)h23.y, (float)h23.z, (float)h23.w};
        const cpx wa = cmul(wn, X.w1), wb2 = cmul(wn, X.w2), wc = cmul(wn, X.w3);
        const cpx r0 = cmulc(ap[0], wn), r1 = cmulc(ap[1], wa), r2 = cmulc(ap[2], wb2), r3 = cmulc(ap[3], wc);
        const cpx s0 = mkc(ga[0] * (e01[0] + r0.x), gb[0] * (e01[1] + r0.y)), s1 = mkc(ga[1] * (e01[2] + r1.x), gb[1] * (e01[3] + r1.y));
        const cpx s2 = mkc(ga[2] * (e23[0] + r2.x), gb[2] * (e23[1] + r2.y)), s3 = mkc(ga[3] * (e23[2] + r3.x), gb[3] * (e23[3] + r3.y));
        if (FINAL == 0) { LDSQ cpx* aw = A + phys(X.a00 + 4 * i * QS); hcpx* xp = xw + X.a00 + 4 * i * QS;
            aw[0] = s0; aw[1] = s1; aw[2] = s2; aw[3] = s3;
            const cpx y0 = cmul(s0, wn), y1 = cmul(s1, wa), y2 = cmul(s2, wb2), y3 = cmul(s3, wc);
            *(hcpx2*)xp = h2_of(y0, y1); *(hcpx2*)(xp + 2) = h2_of(y2, y3); }
        else if (!dry) { u32x2 wa2, wb3; wa2.x = cvt_pk_bf16(s0.x, s1.x); wa2.y = cvt_pk_bf16(s2.x, s3.x); wb3.x = cvt_pk_bf16(s0.y, s1.y); wb3.y = cvt_pk_bf16(s2.y, s3.y);
            *(u32x2*)(o0 + n) = wa2; *(u32x2*)(o1 + n) = wb3; }
        wn = cmul(wn, WQS); }
}
template <int LOG2L> __device__ __forceinline__ void hyena_item(const Params& p, LDSQ unsigned char* lds, int layer_j, int c0, int dry) {
    constexpr int L = 1 << LOG2L, NPAIR = (LOG2L == 14) ? 1 : 2;
    constexpr int TOK0 = (LOG2L == 14) ? 0 : T_P, PB = (LOG2L == 14) ? 0 : 16384;
    LDSQ cpx* A = (LDSQ cpx*)lds;
    LDSQ float* red = (LDSQ float*)(lds + 135168);
    const int t = pg8::otid(), ch = c0 + ((LOG2L == 14) ? 0 : (t >> 6));
    bf16_t* zin = (bf16_t*)(p.ws + WS_BIG + BIG_ZINT);
    const _Float16* taps = (const _Float16*)(p.ws + WS_BIG + BIG_TAPS);
    hcpx* scr = (hcpx*)(p.ws + WS_H + (size_t)pg8::obid() * FFT_SCR_PER_WG);
    hcpx* u1s = scr + (size_t)4 * 16384;
    hcpx* yes = (hcpx*)(p.ws + WS_END + (size_t)pg8::obid() * FFT_EXT_PER_WG);
    PreRegs pre;
    hcpx* xw = yes + 16384;
    {
        const _Float16* tf0 = taps + (size_t)(0 * 2048 + ch) * NPOS + PB; const _Float16* tb0 = taps + (size_t)(1 * 2048 + ch) * NPOS + PB;
        const _Float16* tf1 = taps + (size_t)(2 * 2048 + ch) * NPOS + PB; const _Float16* tb1 = taps + (size_t)(3 * 2048 + ch) * NPOS + PB;
        const float* dec = p.hy_decay + (size_t)layer_j * 8192 + ch;
        const float df0 = fabsf(dec[0]) * (1.0f / (float)(L - 1)), db0 = fabsf(dec[2048]) * (1.0f / (float)(L - 1));
        const float df1 = fabsf(dec[4096]) * (1.0f / (float)(L - 1)), db1 = fabsf(dec[6144]) * (1.0f / (float)(L - 1));
        float ss0, ss1;
        sweep_taps2<LOG2L>(A, t, tf0, tb0, tf1, tb1, df0, db0, df1, db1, xw, ss0, ss1);
        ss0 = wave_sum(ss0); ss1 = wave_sum(ss1);
        if ((t & 63) == 0) { red[t >> 6] = ss0; red[8 + (t >> 6)] = ss1; }
        __syncthreads();
        const float* skp0 = p.hy_skip + (size_t)layer_j * 2 * 2048 + c0; const float* skp1 = skp0 + 2048;
        fft_outer<LOG2L, false, 0>(A, t, nullptr, nullptr, pre);
        fft_prefetch<LOG2L == 14 ? 32 : 16, LOG2L == 14 ? 512 : 128>(t, xw, pre);
        fft_mid_sep<LOG2L, 0>(A, t, scr + (size_t)0 * 16384, scr + (size_t)2 * 16384, red, skp0, skp1); __syncthreads();
        fft_outer<LOG2L, false, 3>(A, t, nullptr, nullptr, pre);
        fft_mid_sep<LOG2L, 1>(A, t, scr + (size_t)1 * 16384, scr + (size_t)3 * 16384, red, skp0, skp1); __syncthreads();
    }
    const float* cw = p.hy_conv_w + (size_t)layer_j * 3 * 6144; const float* cbias = p.hy_conv_b + (size_t)layer_j * 6144;
#pragma unroll 1
    for (int pr = 0; pr < NPAIR; ++pr) {
        const size_t tb0 = (size_t)TOK0 + (size_t)(2 * pr) * L;
        sweep_load_v<LOG2L>(A, t, zin, tb0, cw, cbias, 2 * 2048 + c0, xw); __syncthreads();
        fft_conv<LOG2L, 0, 2>(A, t, scr + (size_t)0 * 16384, yes, xw, pre);
        CombPre cp;
        fft_conv<LOG2L, 3, 0>(A, t, scr + (size_t)1 * 16384, nullptr, nullptr, pre, [&]() { combine_prefetch<LOG2L, 0>(t, yes, zin, tb0, c0, cp); });
        sweep_combine<LOG2L, 0>(A, t, cp, yes, xw, zin, tb0, cw, cbias, c0, c0, dry); __syncthreads();
        fft_conv<LOG2L, 0, 2>(A, t, scr + (size_t)2 * 16384, yes, xw, pre);
        fft_conv<LOG2L, 3, 0>(A, t, scr + (size_t)3 * 16384, nullptr, nullptr, pre, [&]() { combine_prefetch<LOG2L, 0>(t, yes, zin, tb0, 2048 + c0, cp); });
        sweep_combine<LOG2L, 1>(A, t, cp, yes, xw, zin, tb0, cw, cbias, 2048 + c0, c0, dry); __syncthreads();
    }
}
__device__ __forceinline__ void hyena_conv_phase(const Params& p, LDSQ unsigned char* lds, int layer_j, int dry) {
    { LDSQ cpx* TW = (LDSQ cpx*)(lds + TW_OFF);
      for (int e = pg8::otid(); e < 1024; e += NTHR) { float sn, cs; sincospif(-2.0f * (float)e / 16384.0f, &sn, &cs); TW[e] = mkc(cs, sn); }
      __syncthreads(); }
    for (int it = pg8::obid(); it < 2048; it += pg8::ogrid()) hyena_item<14>(p, lds, layer_j, it, dry);
    for (int it = pg8::obid(); it < 256; it += pg8::ogrid()) hyena_item<11>(p, lds, layer_j, it * 8, dry);
}

__device__ __forceinline__ void attn_phase(const Params& p, LDSQ unsigned char* lds, int dry = 0) {
    constexpr int KROW = 272, VROW = 264;
    LDSQ unsigned char* Kl = lds; LDSQ bf16_t* VT = (LDSQ bf16_t*)(lds + 256 * KROW);
    const bf16_t* qkv = (const bf16_t*)(p.ws + WS_BIG + BIG_QKV);
    bf16_t* og = (bf16_t*)(p.ws + WS_BIG + BIG_OG); float* lse = (float*)(p.ws + WS_BIG + BIG_LSE);
    const int tid = pg8::otid(), lane = tid & 63, wid = __builtin_amdgcn_readfirstlane(tid >> 6), l15 = lane & 15, g4 = lane >> 4;
    const int blk = wid >> 2, qq = 16 * (wid & 3) + l15;
    for (int u = pg8::obid(); u < 1792 + 512; u += pg8::ogrid()) {
        const int it = u < 1792 ? 4 * u : 7168 + (u - 1792), len = u < 1792 ? 4 : 1;
        int g, b, hh, rho, pp0, L, tokbase;
        if (it < 6144) { g = it >> 11; const int rem = it & 2047; const int npp = 128 >> (2 * g); pp0 = rem % npp; rho = (rem / npp) & ((1 << (2 * g)) - 1); hh = (rem >> 7) & 7; b = rem >> 10; L = L_P; tokbase = 0; }
        else { const int i2 = it - 6144; g = i2 >> 9; const int rem = i2 & 511; const int npp = 16 >> (2 * g); pp0 = rem % npp; rho = (rem / npp) & ((1 << (2 * g)) - 1); hh = (rem >> 4) & 7; b = rem >> 7; L = L_S; tokbase = T_P; }
        const int rsh = 2 * g, n = L >> rsh;
        const size_t tok0 = (size_t)tokbase + (size_t)b * L + rho;
        const int qcol = g * 3072 + hh * 128, kcol = qcol + 1024, vcol = qcol + 2048;
        u32x4 kr[2][4], vr[2][4];
        auto request_half = [&](int ih, u32x4 (&kh)[4], u32x4 (&vh)[4]) {
#pragma unroll
            for (int s4 = 0; s4 < 4; ++s4) { const int ci = tid + 512 * s4;
                { const int slot = ci >> 4, chn = ci & 15, i = ih + slot, ic = i < 0 ? 0 : (i < n ? i : n - 1); kh[s4] = *(const u32x4*)(qkv + (tok0 + ((size_t)ic << rsh)) * QKVW + kcol + chn * 8); }
                { const int slot = (ci & 15) + 16 * ((ci >> 6) & 7), chn = ((ci >> 4) & 3) + 4 * (ci >> 9), i = ih + slot, ic = i < 0 ? 0 : (i < n ? i : n - 1); vh[s4] = *(const u32x4*)(qkv + (tok0 + ((size_t)ic << rsh)) * QKVW + vcol + chn * 8); } } };
        auto stage_half = [&](int ih, int ring0, const u32x4 (&kh)[4], const u32x4 (&vh)[4]) {
#pragma unroll
            for (int s4 = 0; s4 < 4; ++s4) { const int ci = tid + 512 * s4;
                { const int slot = ci >> 4, chn = ci & 15, i = ih + slot; const unsigned ok = (i >= 0 && i < n) ? 0xffffffffu : 0u;
                  u32x4 v = kh[s4]; v.x &= ok; v.y &= ok; v.z &= ok; v.w &= ok;
                  *(LDSQ u32x4*)(Kl + (ring0 + slot) * KROW + chn * 16) = v; }
                { const int slot = (ci & 15) + 16 * ((ci >> 6) & 7), chn = ((ci >> 4) & 3) + 4 * (ci >> 9), i = ih + slot; const unsigned ok = (i >= 0 && i < n) ? 0xffffffffu : 0u;
                  u32x4 v = vh[s4]; v.x &= ok; v.y &= ok; v.z &= ok; v.w &= ok;
                  LDSQ bf16_t* vp = VT + (32 * (chn >> 2) + 4 * (chn & 3)) * VROW + ring0 + slot;
                  vp[0] = (bf16_t)(v.x & 0xffffu); vp[VROW] = (bf16_t)(v.x >> 16); vp[2 * VROW] = (bf16_t)(v.y & 0xffffu); vp[3 * VROW] = (bf16_t)(v.y >> 16);
                  vp[16 * VROW] = (bf16_t)(v.z & 0xffffu); vp[17 * VROW] = (bf16_t)(v.z >> 16); vp[18 * VROW] = (bf16_t)(v.w & 0xffffu); vp[19 * VROW] = (bf16_t)(v.w >> 16); } } };
        request_half(128 * pp0 - 64, kr[0], vr[0]); request_half(128 * pp0 + 64, kr[1], vr[1]);
#pragma unroll 1
        for (int s = 0; s < len; ++s) {
            const int pp = pp0 + s, i0 = 128 * pp - 64, off = (128 * pp) & 255;
            const int qi = 128 * pp + 64 * blk + qq;
            const size_t tq = tok0 + ((size_t)qi << rsh);
            bf16x8 bq[4];
#pragma unroll
            for (int ks = 0; ks < 4; ++ks) bq[ks] = *(const bf16x8*)(qkv + tq * QKVW + qcol + 32 * ks + 8 * g4);
            if (s == 0) stage_half(i0, off, kr[0], vr[0]);
            stage_half(i0 + 128, (128 + off) & 255, kr[1], vr[1]);
            __syncthreads();
            const int ktb = wid & 3;
            f32x4 sc[10]; bf16x8 kf[2][4];
            auto kload = [&](int j, bf16x8 (&f)[4]) { const int rb = (64 * blk + 16 * (ktb + j) + off) & 255;
#pragma unroll
                for (int ks = 0; ks < 4; ++ks) f[ks] = *(const LDSQ bf16x8*)(Kl + (rb + l15) * KROW + (32 * ks + 8 * g4) * 2); };
            kload(0, kf[0]);
#pragma unroll
            for (int j = 0; j < 9; ++j) {
                if (j + 1 < 9) kload(j + 1, kf[(j + 1) & 1]);
                __builtin_amdgcn_sched_barrier(0);
                f32x4 a = {0.f, 0.f, 0.f, 0.f};
#pragma unroll
                for (int ks = 0; ks < 4; ++ks) a = __builtin_amdgcn_mfma_f32_16x16x32_bf16(kf[j & 1][ks], bq[ks], a, 0, 0, 0);
                sc[j] = a;
                __builtin_amdgcn_sched_barrier(0); }
            if (s + 1 < len) request_half(i0 + 256, kr[1], vr[1]);
            const int ibase = 128 * pp + 64 * blk - 64;
            const int klo = qq > -ibase ? qq : -ibase, khi = (qq + 128 < n - 1 - ibase) ? qq + 128 : n - 1 - ibase;
            const unsigned kspan = (unsigned)(khi - klo); const int kk0 = 4 * g4 - klo + 16 * ktb;
            float mx = -3.0e38f;
#pragma unroll
            for (int j = 0; j < 9; ++j)
#pragma unroll
                for (int r = 0; r < 4; ++r) { const bool ok = (unsigned)(kk0 + 16 * j + r) <= kspan;
                    sc[j][r] = ok ? sc[j][r] : -3.0e38f; mx = fmaxf(mx, sc[j][r]); }
            mx = fmaxf(mx, __shfl_xor(mx, 16)); mx = fmaxf(mx, __shfl_xor(mx, 32));
            float ls = 0.f;
#pragma unroll
            for (int j = 0; j < 9; ++j)
#pragma unroll
                for (int r = 0; r < 4; ++r) { const float e = __builtin_amdgcn_exp2f(sc[j][r] - mx); sc[j][r] = e; ls += e; }
            sc[9] = (f32x4){0.f, 0.f, 0.f, 0.f};
            ls += __shfl_xor(ls, 16); ls += __shfl_xor(ls, 32);
            f32x4 oa[8];
#pragma unroll
            for (int dt = 0; dt < 8; ++dt) oa[dt] = (f32x4){0.f, 0.f, 0.f, 0.f};
            u32x2 vf[2][4][2];
            auto vload = [&](int gidx, u32x2 (&f)[4][2]) { const int k2 = gidx >> 1, d0 = (gidx & 1) * 4;
                const int cb0 = (64 * blk + 16 * ktb + 32 * k2 + off) & 255, cb1 = (cb0 + 16) & 255;
#pragma unroll
                for (int d = 0; d < 4; ++d) { const LDSQ bf16_t* vq = VT + (16 * (d0 + d) + l15) * VROW + 4 * g4; f[d][0] = *(const LDSQ u32x2*)(vq + cb0); f[d][1] = *(const LDSQ u32x2*)(vq + cb1); } };
            vload(0, vf[0]);
#pragma unroll
            for (int gidx = 0; gidx < 10; ++gidx) { const int k2 = gidx >> 1, d0 = (gidx & 1) * 4;
                if (gidx + 1 < 10) vload(gidx + 1, vf[(gidx + 1) & 1]);
                __builtin_amdgcn_sched_barrier(0);
                union { u32x4 u; bf16x8 h; } pb;
                pb.u.x = cvt_pk_bf16(sc[2 * k2][0], sc[2 * k2][1]); pb.u.y = cvt_pk_bf16(sc[2 * k2][2], sc[2 * k2][3]);
                pb.u.z = cvt_pk_bf16(sc[2 * k2 + 1][0], sc[2 * k2 + 1][1]); pb.u.w = cvt_pk_bf16(sc[2 * k2 + 1][2], sc[2 * k2 + 1][3]);
#pragma unroll
                for (int d = 0; d < 4; ++d) { union { u32x4 u; bf16x8 h; } va; const u32x2 lo = vf[gidx & 1][d][0], hi = vf[gidx & 1][d][1];
                    va.u.x = lo.x; va.u.y = lo.y; va.u.z = hi.x; va.u.w = hi.y;
                    oa[d0 + d] = __builtin_amdgcn_mfma_f32_16x16x32_bf16(va.h, pb.h, oa[d0 + d], 0, 0, 0); }
                __builtin_amdgcn_sched_barrier(0); }
            const float inv = 1.0f / ls;
            const size_t gt = (size_t)g * T + tq;
#pragma unroll
            for (int q = 0; q < 4; ++q) { u32x4 w; w.x = cvt_pk_bf16(oa[2 * q][0] * inv, oa[2 * q][1] * inv); w.y = cvt_pk_bf16(oa[2 * q][2] * inv, oa[2 * q][3] * inv);
                w.z = cvt_pk_bf16(oa[2 * q + 1][0] * inv, oa[2 * q + 1][1] * inv); w.w = cvt_pk_bf16(oa[2 * q + 1][2] * inv, oa[2 * q + 1][3] * inv);
                if (!dry) *(u32x4*)(og + gt * 1024 + hh * 128 + 32 * q + 8 * g4) = w; }
            if (g4 == 0 && !dry) lse[gt * 8 + hh] = mx + log2f(ls);
            __syncthreads();
        }
    }
}
__device__ __forceinline__ void attn_merge_phase(const Params& p) {
    const bf16_t* og = (const bf16_t*)(p.ws + WS_BIG + BIG_OG); const float* lse = (const float*)(p.ws + WS_BIG + BIG_LSE); bf16_t* H = (bf16_t*)(p.ws + WS_H);
    const int stride = pg8::ogrid() * NTHR;
    for (int i0 = pg8::obid() * NTHR + pg8::otid(); i0 < T * 128; i0 += 4 * stride) {
        u32x4 v0[4], v1[4], v2[4]; float l0[4], l1[4], l2[4];
#pragma unroll
        for (int u = 0; u < 4; ++u) { const int i = i0 + u * stride; if (i < T * 128) { const int tok = i >> 7, c8 = i & 127, hh = c8 >> 4;
            l0[u] = lse[(size_t)tok * 8 + hh]; l1[u] = lse[((size_t)T + tok) * 8 + hh]; l2[u] = lse[((size_t)2 * T + tok) * 8 + hh];
            v0[u] = *(const u32x4*)(og + (size_t)tok * 1024 + c8 * 8); v1[u] = *(const u32x4*)(og + ((size_t)T + tok) * 1024 + c8 * 8); v2[u] = *(const u32x4*)(og + ((size_t)2 * T + tok) * 1024 + c8 * 8); } }
#pragma unroll
        for (int u = 0; u < 4; ++u) { const int i = i0 + u * stride; if (i < T * 128) { const int tok = i >> 7, c8 = i & 127;
            const float m = fmaxf(l0[u], fmaxf(l1[u], l2[u])); float a0 = exp2f(l0[u] - m), a1 = exp2f(l1[u] - m), a2 = exp2f(l2[u] - m); const float is = 1.0f / (a0 + a1 + a2); a0 *= is; a1 *= is; a2 *= is;
            u32x4 w;
#pragma unroll
            for (int e = 0; e < 4; ++e) { const float lo = a0 * __uint_as_float(v0[u][e] << 16) + a1 * __uint_as_float(v1[u][e] << 16) + a2 * __uint_as_float(v2[u][e] << 16);
                const float hi = a0 * __uint_as_float(v0[u][e] & 0xffff0000u) + a1 * __uint_as_float(v1[u][e] & 0xffff0000u) + a2 * __uint_as_float(v2[u][e] & 0xffff0000u);
                w[e] = cvt_pk_bf16(lo, hi); }
            *(u32x4*)(H + (size_t)tok * 1024 + c8 * 8) = w; } }
    }
}

constexpr int NPHASE = 35;
typedef const __attribute__((address_space(4))) unsigned char* KARG;
template <class Tp> __device__ __forceinline__ Tp karg(int byte_off) { return *(volatile const __attribute__((address_space(4))) Tp*)((KARG)__builtin_amdgcn_kernarg_segment_ptr() + byte_off); }
#define PA(q, member) q.member = karg<decltype(Params::member)>((int)__builtin_offsetof(Params, member))
__global__ void __launch_bounds__(512, 2) mega(Params parg) {
    extern __shared__ __attribute__((aligned(16))) unsigned char shm[];
    LDSQ unsigned char* lds = (LDSQ unsigned char*)shm;
    const int tid = pg8::otid();
    volatile LDSQ unsigned* misc = (volatile LDSQ unsigned*)(lds + LDS_MISC);
    if (tid < 8) misc[tid] = 0u;
    __syncthreads();
    const int ph_lo = parg.ph_lo, ph_hi = parg.ph_hi, probe = parg.probe;
#define REPS(bit, lay) (1 + (1 + ((probe >> 15) & 1)) * (((probe >> (bit)) & 1) & ((((probe >> 10) & 3) == 0) | ((probe >> (10 + ((lay) & 1))) & 1))))
    XcdBarrier bar; bar.bar = nullptr; bar.x = 0; bar.st = misc;
    if (ph_hi - ph_lo > 1) { Params q{}; PA(q, ws); bar = xcd_barrier_post((unsigned*)(q.ws + WS_CTL), misc); }
#define IN(k) (ph_lo <= (k) && (k) < ph_hi)
#define REPBAR() do { if (((probe >> 16) & 1) && rep + 1 < nrep) { Params qb{}; PA(qb, ws); bar.bar = (unsigned*)(qb.ws + WS_CTL); xcd_barrier(bar); } } while (0)
#define SEAM(k) do { if (IN(k) && IN((k) + 1)) { Params qb{}; PA(qb, ws); bar.bar = (unsigned*)(qb.ws + WS_CTL); xcd_barrier(bar); if ((probe >> 12) & 1) { xcd_barrier(bar); xcd_barrier(bar); } } } while (0)

    for (int rep = 0, nrep = REPS(0, 0); rep < nrep; ++rep)
    if (IN(0)) { Params q{}; PA(q, ws); PA(q, c_prompt); PA(q, c_sample); PA(q, ada_w); PA(q, final_ada_w); ada_partials(q, lds); rope_table(q);
                 PA(q, hy_fw1); PA(q, hy_fb1); PA(q, hy_ffreq); PA(q, hy_fw2); PA(q, hy_fb2); PA(q, hy_fw3); filter_mlp(q); }
    SEAM(0);
    for (int rep = 0, nrep = REPS(0, 0); rep < nrep; ++rep)
    if (IN(1)) { Params q{}; PA(q, ws); PA(q, ada_b); PA(q, final_ada_b); ada_reduce(q); }
    SEAM(1);
#pragma unroll 1
    for (int layer = 0; layer < 4; ++layer) {
        const int pb = 2 + 8 * layer, j = layer >> 1; const bool hy = (layer & 1) == 0;
        for (int rep = 0, nrep = REPS(1, layer); rep < nrep; ++rep)
        if (IN(pb + 0)) {
            Params q{}; PA(q, ws); unsigned char* wl = q.ws + WS_WL;
            PA(q, ffn_w_gate); convert_T(lds, q.ffn_w_gate + (size_t)layer * 2048 * DFF, 2048, DFF, (bf16_t*)(wl + WL_FFN1), 0);
            PA(q, ffn_w_up);   convert_T(lds, q.ffn_w_up + (size_t)layer * 2048 * DFF, 2048, DFF, (bf16_t*)(wl + WL_FFN1), 1);
            PA(q, ffn_w_down); convert_T(lds, q.ffn_w_down + (size_t)layer * DFF * 2048, DFF, 2048, (bf16_t*)(wl + WL_FFN2), -1);
            if (hy) { PA(q, hy_w_in);  convert_T(lds, q.hy_w_in + (size_t)j * 2048 * 6144, 2048, 6144, (bf16_t*)(wl + WL_MIXIN), -1);
                      PA(q, hy_w_out); convert_T(lds, q.hy_w_out + (size_t)j * 2048 * 2048, 2048, 2048, (bf16_t*)(wl + WL_MIXOUT), -1); }
            else    { PA(q, at_w_in);  convert_T(lds, q.at_w_in + (size_t)j * 2048 * QKVW, 2048, QKVW, (bf16_t*)(wl + WL_MIXIN), -1);
                      PA(q, at_w_out); convert_T(lds, q.at_w_out + (size_t)j * 1024 * 2048, 1024, 2048, (bf16_t*)(wl + WL_MIXOUT), -1); }
            PA(q, norm_mix);
            const float* modl = (const float*)(q.ws + WS_MOD) + layer * 12288;
            if (layer == 0) { PA(q, x_prompt); PA(q, x_sample); norm_rows<false, true>(q.x_prompt, q.x_sample, (bf16_t*)(q.ws + WS_XB), q.norm_mix + layer * 2048, modl, 0, 2048, (bf16_t*)(q.ws + WS_H), nullptr); }
            else            norm_rows<false, false>(nullptr, nullptr, (bf16_t*)(q.ws + WS_XB), q.norm_mix + layer * 2048, modl, 0, 2048, (bf16_t*)(q.ws + WS_H), nullptr);
            if (hy) { __syncthreads();
                pg8::Gemm g{(const bf16_t*)(q.ws + WS_W3X) + (size_t)j * 8192 * 256, (const bf16_t*)(q.ws + WS_A2X) + (size_t)j * NPOS * 256, 8192, NPOS, 256};
                pg8::StaticOrder S; S.init(8192, NPOS, pg8::ogrid(), pg8::obid());
                EpiTaps E{(_Float16*)(q.ws + WS_BIG + BIG_TAPS)};
                pg8::gemm_phase<EpiTaps, pg8::StaticOrder, false>(lds, g, S, E, nullptr); }
        }
        SEAM(pb + 0);
        for (int rep = 0, nrep = REPS(2, layer); rep < nrep; ++rep)
        if (IN(pb + 1)) {
            Params q{}; PA(q, ws);
            if (hy) { PA(q, hy_b_in); pg8::Gemm g{(const bf16_t*)(q.ws + WS_WL + WL_MIXIN), (const bf16_t*)(q.ws + WS_H), 6144, T, 2048}; pg8::StaticOrder S; S.init(6144, T, pg8::ogrid(), pg8::obid());
                EpiZinT E{(bf16_t*)(q.ws + WS_BIG + BIG_ZINT), T, q.hy_b_in + (size_t)j * 6144};
                pg8::gemm_phase<EpiZinT, pg8::StaticOrder, false>(lds, g, S, E, nullptr); }
            else { pg8::Gemm g{(const bf16_t*)(q.ws + WS_H), (const bf16_t*)(q.ws + WS_WL + WL_MIXIN), T, QKVW, 2048}; pg8::StaticOrder S; S.init(T, QKVW, pg8::ogrid(), pg8::obid());
                EpiQKV E{(bf16_t*)(q.ws + WS_BIG + BIG_QKV), (const cpx*)(q.ws + WS_ROPE)};
                pg8::gemm_phase<EpiQKV, pg8::StaticOrder, false>(lds, g, S, E, nullptr); }
            REPBAR();
        }
        SEAM(pb + 1);
        for (int rep = 0, nrep = REPS(3, layer); rep < nrep; ++rep)
        if (IN(pb + 2)) { Params q{}; PA(q, ws); if (hy) { PA(q, hy_skip); PA(q, hy_conv_w); PA(q, hy_conv_b); PA(q, hy_decay); hyena_conv_phase(q, lds, j, rep + 1 < nrep); } else attn_phase(q, lds, (rep + 1 < nrep) ? (1 | ((probe >> 12) & 2)) : 0); }
        SEAM(pb + 2);
        for (int rep = 0, nrep = REPS(4, layer); rep < nrep; ++rep)
        if (IN(pb + 3)) { Params q{}; PA(q, ws); if (hy) transpose_phase(q, lds); else attn_merge_phase(q); }
        SEAM(pb + 3);
        for (int rep = 0, nrep = REPS(5, layer); rep < nrep; ++rep)
        if (IN(pb + 4)) {
            Params q{}; PA(q, ws); PA(q, hy_b_out);
            pg8::Gemm g{(const bf16_t*)(q.ws + WS_H), (const bf16_t*)(q.ws + WS_WL + WL_MIXOUT), T, 2048, hy ? 2048 : 1024}; pg8::StaticOrder S; S.init(T, 2048, pg8::ogrid(), pg8::obid());
            EpiRes E{(bf16_t*)(q.ws + WS_XB), hy ? q.hy_b_out + (size_t)j * 2048 : nullptr, (const float*)(q.ws + WS_MOD) + layer * 12288 + 4096, rep + 1 < nrep};
            pg8::gemm_phase<EpiRes, pg8::StaticOrder, false>(lds, g, S, E, nullptr);
            REPBAR();
        }
        SEAM(pb + 4);
        for (int rep = 0, nrep = REPS(6, layer); rep < nrep; ++rep)
        if (IN(pb + 5)) { Params q{}; PA(q, ws); PA(q, norm_ffn);
            norm_rows<false, false>(nullptr, nullptr, (bf16_t*)(q.ws + WS_XB), q.norm_ffn + layer * 2048, (const float*)(q.ws + WS_MOD) + layer * 12288, 6144, 8192, (bf16_t*)(q.ws + WS_H), nullptr); }
        SEAM(pb + 5);
        for (int rep = 0, nrep = REPS(7, layer); rep < nrep; ++rep)
        if (IN(pb + 6)) {
            Params q{}; PA(q, ws);
            pg8::Gemm g{(const bf16_t*)(q.ws + WS_H), (const bf16_t*)(q.ws + WS_WL + WL_FFN1), T, 2 * DFF, 2048}; pg8::StaticOrder S; S.init(T, 2 * DFF, pg8::ogrid(), pg8::obid());
            EpiFFN1 E{(bf16_t*)(q.ws + WS_BIG + BIG_MID)};
            pg8::gemm_phase<EpiFFN1, pg8::StaticOrder, false>(lds, g, S, E, nullptr);
            REPBAR();
        }
        SEAM(pb + 6);
        for (int rep = 0, nrep = REPS(8, layer); rep < nrep; ++rep)
        if (IN(pb + 7)) {
            Params q{}; PA(q, ws);
            pg8::Gemm g{(const bf16_t*)(q.ws + WS_BIG + BIG_MID), (const bf16_t*)(q.ws + WS_WL + WL_FFN2), T, 2048, DFF}; pg8::StaticOrder S; S.init(T, 2048, pg8::ogrid(), pg8::obid());
            EpiRes E{(bf16_t*)(q.ws + WS_XB), nullptr, (const float*)(q.ws + WS_MOD) + layer * 12288 + 10240, rep + 1 < nrep};
            pg8::gemm_phase<EpiRes, pg8::StaticOrder, false>(lds, g, S, E, nullptr);
            REPBAR();
        }
        SEAM(pb + 7);
    }
    if (IN(34)) { Params q{}; PA(q, ws); PA(q, out); PA(q, final_norm); final_norm_phase(q); }
#undef REPS
#undef IN
#undef SEAM
}
}

extern "C" void kernel_launch(void* const* d_in, const int* in_sizes, int n_in, void* d_out, int out_size, void* d_ws, size_t ws_size, hipStream_t stream) {
    static int grid = 0;
    if (grid == 0) {
        if (n_in != 30 || out_size != mk::T * mk::D || ws_size < mk::WS_TOTAL) { fprintf(stderr, "kernel_launch: unexpected shapes (n_in %d out %d ws %zu need %zu); nothing launched\n", n_in, out_size, ws_size, (size_t)mk::WS_TOTAL); grid = -1; return; }
        int dev = 0, cus = 0;
        if (hipGetDevice(&dev) != hipSuccess || hipDeviceGetAttribute(&cus, hipDeviceAttributeMultiprocessorCount, dev) != hipSuccess) { grid = -1; return; }
        if (hipFuncSetAttribute((const void*)mk::mega, hipFuncAttributeMaxDynamicSharedMemorySize, mk::LDS_BYTES) != hipSuccess) { fprintf(stderr, "kernel_launch: hipFuncSetAttribute failed\n"); grid = -1; return; }
        int per_cu = 0; (void)hipOccupancyMaxActiveBlocksPerMultiprocessor(&per_cu, (const void*)mk::mega, 512, mk::LDS_BYTES); (void)hipGetLastError();
        if (per_cu < 1) fprintf(stderr, "kernel_launch: occupancy query reports %d blocks per CU\n", per_cu);
        grid = cus > 256 ? 256 : cus;
    }
    if (grid < 0) return;
    mk::Params p{};
    const float** f = (const float**)&p;
    for (int i = 0; i < 30; ++i) f[i] = (const float*)d_in[i];
    p.out = (float*)d_out; p.ws = (unsigned char*)d_ws; p.probe = MK_PROBE;
#if MK_PER_PHASE
    for (int k = 0; k < mk::NPHASE; ++k) { p.ph_lo = k; p.ph_hi = k + 1; hipLaunchKernelGGL(mk::mega, dim3(grid), dim3(512), mk::LDS_BYTES, stream, p); }
#else
    (void)hipMemsetAsync((char*)d_ws + mk::WS_CTL, 0, mk::CTL_BYTES, stream);
    p.ph_lo = 0; p.ph_hi = mk::NPHASE;
    hipLaunchKernelGGL(mk::mega, dim3(grid), dim3(512), mk::LDS_BYTES, stream, p);
#endif
}
```

```cpp
#include <hip/hip_runtime.h>
#include <cstdio>
#include <cstdint>
#include <utility>
#ifndef MK_PER_PHASE
#define MK_PER_PHASE 0
#endif
#ifndef MK_PROBE
#define MK_PROBE 0
#endif
namespace pg8 {
#define PG8_LAS __attribute__((address_space(3)))
__device__ __forceinline__ int otid() { int t = threadIdx.x; asm volatile("" : "+v"(t) :: "memory"); return t; }
__device__ __forceinline__ int obid() { int b = blockIdx.x; asm volatile("" : "+s"(b)); return b; }
__device__ __forceinline__ int ogrid() { int g = gridDim.x; asm volatile("" : "+s"(g)); return g; }
typedef unsigned short bf16_t;
typedef short bf16x8 __attribute__((ext_vector_type(8)));
typedef float f32x4 __attribute__((ext_vector_type(4)));
typedef unsigned u32x4 __attribute__((ext_vector_type(4)));
constexpr int BM = 256, BK = 64, HALF = 128, HTB = HALF * BK * 2  , STAGE_BYTES = 8 * HTB, NXCD = 8, WGM = 4;

__host__ __device__ __forceinline__ int lds_byte(int r, int c) { const int st = (r >> 4) * 2 + (c >> 5), rr = r & 15, cc = c & 31, ob = rr * 64 + cc * 2; return st * 1024 + (ob ^ (((ob >> 9) & 1) << 5)); }
__host__ __device__ __forceinline__ void stage_rc(int b, int& R, int& C) { const int st = b / 1024, sb = b % 1024, swz = sb ^ (((sb >> 9) & 1) << 5); R = (st >> 1) * 16 + swz / 64; C = (st & 1) * 32 + (swz % 64) / 2; }
__host__ __device__ __forceinline__ int perm32(int rho) { const int n = rho >> 4, i = rho & 15; return 8 * (i >> 2) + 4 * n + (i & 3); }

struct Unit { int pm, pn; };
struct Gemm { const bf16_t* A; const bf16_t* Bt; int M, N, K; };

struct StaticOrder {
    int nM, nN, nwg, G, c, wgm;
    __host__ __device__ void init(int M, int N, int G_, int c_, int wgm_ = WGM) { nM = M / BM; nN = N / BM; nwg = nM * nN; G = G_; c = c_; wgm = wgm_; }
    __host__ __device__ bool next(int i, Unit& u) const {
        const long L = (long)i * G + c; if (L >= nwg) return false;
        int wgid = (int)L; { const int q = nwg / NXCD, r = nwg % NXCD, xcd = wgid % NXCD, off = wgid / NXCD; wgid = (xcd < r ? xcd * (q + 1) : r * (q + 1) + (xcd - r) * q) + off; }
        const int nig = wgm * nN, gid = wgid / nig, fm = gid * wgm, gsz = (nM - fm) < wgm ? (nM - fm) : wgm;
        u.pm = fm + ((wgid % nig) % gsz); u.pn = (wgid % nig) / gsz; return true;
    }
    __device__ __forceinline__ void a_ready(const Unit&) const {}
    __device__ __forceinline__ void done(const Unit&) const {}
};
__device__ __forceinline__ unsigned cvt_pk_bf16(float lo, float hi) { unsigned r; asm volatile("v_cvt_pk_bf16_f32 %0, %1, %2" : "=v"(r) : "v"(lo), "v"(hi)); return r; }
template <class Epi, class Sched, bool STAMP = false>
__device__ __forceinline__ void gemm_phase(PG8_LAS unsigned char* lds, const Gemm g, const Sched& S, const Epi& E, unsigned long long* stamps) {
    const int tid = otid(), wid = __builtin_amdgcn_readfirstlane(tid >> 6), lane = tid & 63, wr = wid >> 2, wc = wid & 3, fr = lane & 15, fq = lane >> 4;
    const int K = g.K, nt = K / BK;
    int ts_lo = 0, ts_hi = 0, nts = 0; const unsigned long long rt_entry = STAMP ? (unsigned long long)wall_clock64() : 0ull;
#define PG8_STAMP() do { if (STAMP && wid == 0 && nts < 64) { const unsigned long long _c = (unsigned long long)clock64(); \
        ts_lo = (lane == nts) ? (int)(unsigned)_c : ts_lo; ts_hi = (lane == nts) ? (int)(unsigned)(_c >> 32) : ts_hi; ++nts; } } while (0)
    PG8_STAMP();
    unsigned voffA[2], voffB[2];
#pragma unroll
    for (int i = 0; i < 2; ++i) { int R, C; stage_rc(tid * 16 + i * 8192, R, C); const int Rb = Epi::PERM ? ((R & ~31) + perm32(R & 31)) : R;
        voffA[i] = (unsigned)(R * K + C) * 2u; voffB[i] = (unsigned)(Rb * K + C) * 2u; }
    const size_t kstep = (size_t)(BK * 2);
    const size_t hstep = (size_t)HALF * K * 2;
    const size_t tstep = 2 * hstep;
    const unsigned ldsw = (unsigned)wid * 1024u;
    const int aoff = lds_byte(wr * 64 + fr, fq * 8), boff = lds_byte(wc * 32 + fr, fq * 8);
#define PG8_SA(b, h) (((b) * 2 + (h)) * HTB)
#define PG8_SB(b, h) ((4 + (b) * 2 + (h)) * HTB)
#define PG8_STAGE(bufoff, gbase, voff) do { _Pragma("unroll") for (int _i = 0; _i < 2; ++_i) \
        __builtin_amdgcn_global_load_lds((const unsigned*)((const char*)(gbase) + (voff)[_i]), (PG8_LAS unsigned*)(lds + (bufoff) + ldsw + _i * 8192), 16, 0, 0); } while (0)
#define PG8_LDA(dst, b, h) do { _Pragma("unroll") for (int m = 0; m < 4; ++m) _Pragma("unroll") for (int k = 0; k < 2; ++k) dst[m][k] = *(const PG8_LAS bf16x8*)(lds + PG8_SA(b, h) + aoff + m * 2048 + k * 1024); } while (0)
#define PG8_LDB(dst, b, h) do { _Pragma("unroll") for (int n = 0; n < 2; ++n) _Pragma("unroll") for (int k = 0; k < 2; ++k) dst[n][k] = *(const PG8_LAS bf16x8*)(lds + PG8_SB(b, h) + boff + n * 2048 + k * 1024); } while (0)
#define PG8_MMA(ai, bj, At, Bt) do { __builtin_amdgcn_s_setprio(1); _Pragma("unroll") for (int m = 0; m < 4; ++m) _Pragma("unroll") for (int n = 0; n < 2; ++n) _Pragma("unroll") for (int k = 0; k < 2; ++k) \
        acc[ai][bj][m][n] = __builtin_amdgcn_mfma_f32_16x16x32_bf16(Bt[n][k], At[m][k], acc[ai][bj][m][n], 0, 0, 0); __builtin_amdgcn_s_setprio(0); } while (0)
#define PG8_WAIT_V(n) asm volatile("s_waitcnt vmcnt(" #n ")" ::: "memory")
#define PG8_WAIT_L(n) asm volatile("s_waitcnt lgkmcnt(" #n ")" ::: "memory")
#define PG8_BAR __builtin_amdgcn_s_barrier()
#define PG8_SCHED __builtin_amdgcn_sched_barrier(0)
    Unit cur, nxt; int ui = 0;
    if (!S.next(0, cur)) return;
    f32x4 acc[2][2][4][2];
#pragma unroll
    for (int a = 0; a < 2; ++a)
#pragma unroll
        for (int b = 0; b < 2; ++b)
#pragma unroll
            for (int m = 0; m < 4; ++m)
#pragma unroll
                for (int n = 0; n < 2; ++n) acc[a][b][m][n] = (f32x4){0.f, 0.f, 0.f, 0.f};
    bf16x8 At[4][2], B0[2][2], B1[2][2];
    const char* cA = (const char*)g.A + (size_t)cur.pm * tstep; const char* cB = (const char*)g.Bt + (size_t)cur.pn * tstep;
    S.a_ready(cur);
    PG8_STAGE(PG8_SB(0, 0), cB, voffB); PG8_STAGE(PG8_SA(0, 0), cA, voffA); PG8_STAGE(PG8_SB(0, 1), cB + hstep, voffB); PG8_STAGE(PG8_SA(0, 1), cA + hstep, voffA);
    if (wr == 1) PG8_BAR;
    PG8_WAIT_V(4); PG8_BAR;
    PG8_STAGE(PG8_SB(1, 0), cB + kstep, voffB); PG8_STAGE(PG8_SA(1, 0), cA + kstep, voffA); PG8_STAGE(PG8_SB(1, 1), cB + hstep + kstep, voffB);
    PG8_WAIT_V(6); PG8_BAR;
    PG8_STAMP();
    for (;;) {
        const bool has_next = S.next(ui + 1, nxt);
        const char* nA = has_next ? (const char*)g.A + (size_t)nxt.pm * tstep : cA; const char* nB = has_next ? (const char*)g.Bt + (size_t)nxt.pn * tstep : cB;
        for (int t = 0; t < nt; t += 2) {
            const bool last = (t == nt - 2);
            const char* a1 = cA + (size_t)(t + 1) * kstep;
            const char* a2 = last ? nA : cA + (size_t)(t + 2) * kstep; const char* b2 = last ? nB : cB + (size_t)(t + 2) * kstep;
            const char* a3 = a2 + kstep; const char* b3 = b2 + kstep;
            if (last && has_next) S.a_ready(nxt);
            PG8_LDB(B0, 0, 0); PG8_SCHED; PG8_LDA(At, 0, 0); PG8_STAGE(PG8_SA(1, 1), a1 + hstep, voffA);
            PG8_WAIT_L(8); PG8_BAR; PG8_WAIT_L(0); PG8_MMA(0, 0, At, B0); PG8_BAR; PG8_SCHED;
            PG8_LDB(B1, 0, 1); PG8_STAGE(PG8_SB(0, 0), b2, voffB);
            PG8_BAR; PG8_WAIT_L(0); PG8_MMA(0, 1, At, B1); PG8_BAR;
            PG8_LDA(At, 0, 1); PG8_STAGE(PG8_SA(0, 0), a2, voffA);
            PG8_BAR; PG8_WAIT_L(0); PG8_MMA(1, 0, At, B0); PG8_BAR; PG8_SCHED;
            PG8_STAGE(PG8_SB(0, 1), b2 + hstep, voffB);
            PG8_WAIT_V(6); PG8_BAR; PG8_MMA(1, 1, At, B1); PG8_BAR;
            PG8_LDB(B0, 1, 0); PG8_SCHED; PG8_LDA(At, 1, 0); PG8_STAGE(PG8_SA(0, 1), a2 + hstep, voffA);
            PG8_WAIT_L(8); PG8_BAR; PG8_WAIT_L(0); PG8_MMA(0, 0, At, B0); PG8_BAR; PG8_SCHED;
            PG8_LDB(B1, 1, 1); PG8_STAGE(PG8_SB(1, 0), b3, voffB);
            PG8_BAR; PG8_WAIT_L(0); PG8_MMA(0, 1, At, B1); PG8_BAR;
            PG8_LDA(At, 1, 1); PG8_STAGE(PG8_SA(1, 0), a3, voffA);
            PG8_BAR; PG8_WAIT_L(0); PG8_MMA(1, 0, At, B0); PG8_BAR; PG8_SCHED;
            PG8_STAGE(PG8_SB(1, 1), b3 + hstep, voffB);
            PG8_WAIT_V(6); PG8_BAR; PG8_MMA(1, 1, At, B1); PG8_BAR;
        }
        PG8_STAMP();
        if constexpr (!Epi::AFTER_DRAIN) { E(acc, cur, wr, wc, fr, fq); S.done(cur); }
        PG8_STAMP();
        if (!has_next) break;
#pragma unroll
        for (int a = 0; a < 2; ++a)
#pragma unroll
            for (int b = 0; b < 2; ++b)
#pragma unroll
                for (int m = 0; m < 4; ++m)
#pragma unroll
                    for (int n = 0; n < 2; ++n) acc[a][b][m][n] = (f32x4){0.f, 0.f, 0.f, 0.f};
        cur = nxt; cA = nA; cB = nB; ++ui;
    }
    PG8_WAIT_V(0);
    if (wr == 0) PG8_BAR;
    PG8_BAR;
    if constexpr (Epi::AFTER_DRAIN) { E.fused(acc, cur, wr, wc, fr, fq, lds, wid, lane); S.done(cur); }
    PG8_STAMP();
    if (STAMP && wid == 0) { stamps[lane] = lane < nts ? (((unsigned long long)(unsigned)ts_hi << 32) | (unsigned)ts_lo) : 0ull;
        if (lane == 62) stamps[62] = rt_entry; if (lane == 63) stamps[63] = (unsigned long long)wall_clock64(); }
#undef PG8_STAMP
#undef PG8_SA
#undef PG8_SB
#undef PG8_STAGE
#undef PG8_LDA
#undef PG8_LDB
#undef PG8_MMA
#undef PG8_WAIT_V
#undef PG8_WAIT_L
#undef PG8_BAR
#undef PG8_SCHED
}
}
#define XB_TMO      128
#define XB_XCNT(j)  (256  + 64 * (j))
#define XB_XSUB(j)  (1280 + 64 * (j))
#define XB_XGEN(j)  (2304 + 64 * (j))
#define XB_TOP      3328
#define XB_TOPGEN   3392
#define XCD_BAR_WORDS 3456
#define XB_SPIN_CAP (1u << 18)
#define LAS __attribute__((address_space(3)))

__device__ __forceinline__ unsigned xb_ld(unsigned* p)              { return __hip_atomic_load(p, __ATOMIC_RELAXED, __HIP_MEMORY_SCOPE_AGENT); }
__device__ __forceinline__ unsigned xb_add(unsigned* p, unsigned v) { return __hip_atomic_fetch_add(p, v, __ATOMIC_RELAXED, __HIP_MEMORY_SCOPE_AGENT); }
__device__ __forceinline__ unsigned xb_xcc_id() { return (unsigned)__builtin_amdgcn_s_getreg((3 << 11) | 20) & 0xFu; }
#define XB_SPIN(cond, bar) do { unsigned _sp = 0; while (cond) { __builtin_amdgcn_s_sleep(1); \
    if ((++_sp & 255u) == 0u) { if (xb_ld(&(bar)[XB_TMO])) break; if (_sp > XB_SPIN_CAP) { atomicAdd(&(bar)[XB_TMO], 1u); break; } } } } while (0)

struct XcdBarrier {
    unsigned* bar; unsigned x;
    volatile LAS unsigned* st;
};

__device__ __forceinline__ XcdBarrier xcd_barrier_post(unsigned* bar, volatile LAS unsigned* st) {
    XcdBarrier b; b.bar = bar; b.x = xb_xcc_id(); b.st = st;
    if (threadIdx.x == 0) (void)xb_add(&bar[XB_XCNT(b.x)], 1u);
    return b;
}
__device__ __forceinline__ void xcd_barrier_complete(unsigned* bar, unsigned x, unsigned& nloc, unsigned& nx) {
    const unsigned G = gridDim.x * gridDim.y * gridDim.z;
    unsigned sum, cnt, mine, sp = 0u;
    for (;;) {
        sum = 0u; cnt = 0u; mine = 0u;
#pragma unroll
        for (unsigned j = 0; j < 16; ++j) { const unsigned c = xb_ld(&bar[XB_XCNT(j)]); sum += c; cnt += (c > 0u) ? 1u : 0u; mine = (j == x) ? c : mine; }
        if (sum == G) break;
        __builtin_amdgcn_s_sleep(1);
        if ((++sp & 255u) == 0u) { if (xb_ld(&bar[XB_TMO])) break; if (sp > XB_SPIN_CAP) { atomicAdd(&bar[XB_TMO], 1u); break; } }
    }
    nloc = mine > 0u ? mine : 1u; nx = cnt > 0u ? cnt : 1u;
}

__device__ __forceinline__ void xcd_barrier(const XcdBarrier& b) {
    asm volatile("s_waitcnt vmcnt(0)" ::: "memory");
    __syncthreads();
    if (threadIdx.x == 0) {
        unsigned* bar = b.bar;
        __builtin_amdgcn_s_waitcnt(0);
        unsigned nloc = b.st[0], nx = b.st[1];
        if (nloc == 0u) { xcd_barrier_complete(bar, b.x, nloc, nx); b.st[0] = nloc; b.st[1] = nx; }
        const unsigned old = xb_add(&bar[XB_XSUB(b.x)], 1u);
        const unsigned gen = old / nloc;
        if (old + 1u == (gen + 1u) * nloc) {
            __builtin_amdgcn_fence(__ATOMIC_RELEASE, "agent");
            asm volatile("s_waitcnt vmcnt(0)" ::: "memory");
            const unsigned og = xb_add(&bar[XB_TOP], 1u);
            const unsigned tg = og / nx;
            if (og + 1u == (tg + 1u) * nx) xb_add(&bar[XB_TOPGEN], 1u);
            else XB_SPIN(xb_ld(&bar[XB_TOPGEN]) == tg, bar);
            __builtin_amdgcn_fence(__ATOMIC_ACQUIRE, "agent");
            xb_add(&bar[XB_XGEN(b.x)], 1u);
            asm volatile("s_waitcnt vmcnt(0)" ::: "memory");
        } else {
            XB_SPIN(xb_ld(&bar[XB_XGEN(b.x)]) == gen, bar);
            __builtin_amdgcn_fence(__ATOMIC_ACQUIRE, "agent");
            asm volatile("s_waitcnt vmcnt(0)" ::: "memory");
        }
    }
    __syncthreads();
}


namespace mk {
using pg8::bf16_t; using pg8::bf16x8; using pg8::f32x4; using pg8::u32x4; using pg8::Unit; using pg8::cvt_pk_bf16;
typedef unsigned u32x2 __attribute__((ext_vector_type(2)));
typedef float cpx __attribute__((ext_vector_type(2)));
__host__ __device__ __forceinline__ cpx mkc(float a, float b) { cpx r; r.x = a; r.y = b; return r; }

constexpr int D = 2048, T_P = 32768, T_S = 8192, T = 40960, L_P = 16384, L_S = 2048, DFF = 5632;
constexpr int NTHR = 512;
constexpr int MODW = 53248;
constexpr int NPOS = 18432;
constexpr int QKVW = 9216;
constexpr float EPS = 1e-6f;
constexpr float QSCALE = 0.12751743082459868f;
constexpr int LDS_BYTES = 147456;
constexpr int LDS_MISC = 147456 - 256;

constexpr size_t al256(size_t x) { return (x + 255) & ~(size_t)255; }
constexpr size_t WS_CTL  = 0;
constexpr size_t CTL_BYTES = 65536;
constexpr size_t WS_PART = WS_CTL + CTL_BYTES;
constexpr size_t WS_MOD  = WS_PART + al256((size_t)8 * 6 * MODW * 4);
constexpr size_t WS_ROPE = WS_MOD + al256((size_t)6 * MODW * 4);
constexpr size_t WS_A2X  = WS_ROPE + (size_t)16384 * 16 * 8;
constexpr size_t WS_W3X  = WS_A2X + (size_t)2 * NPOS * 256 * 2;
constexpr size_t WS_WL   = WS_W3X + (size_t)2 * 8192 * 256 * 2;
constexpr size_t WL_FFN1 = 0;
constexpr size_t WL_FFN2 = WL_FFN1 + (size_t)11264 * 2048 * 2;
constexpr size_t WL_MIXIN = WL_FFN2 + (size_t)2048 * 5632 * 2;
constexpr size_t WL_MIXOUT = WL_MIXIN + (size_t)9216 * 2048 * 2;
constexpr size_t WL_BYTES = WL_MIXOUT + (size_t)2048 * 2048 * 2;
constexpr size_t WS_H    = WS_WL + WL_BYTES;
constexpr size_t H_BYTES = (size_t)T * 2048 * 2;
constexpr size_t WS_BIG  = WS_H + H_BYTES;
constexpr size_t BIG_ZINT = 0;
constexpr size_t BIG_TAPS = BIG_ZINT + (size_t)6144 * T * 2;
constexpr size_t BIG_HY_END = BIG_TAPS + (size_t)8192 * NPOS * 2;
constexpr size_t BIG_QKV = 0;
constexpr size_t BIG_OG  = BIG_QKV + (size_t)T * QKVW * 2;
constexpr size_t BIG_LSE = BIG_OG + (size_t)3 * T * 1024 * 2;
constexpr size_t BIG_AT_END = BIG_LSE + (size_t)3 * T * 8 * 4;
constexpr size_t BIG_MID = 0;
constexpr size_t BIG_BYTES = BIG_HY_END > BIG_AT_END ? BIG_HY_END : BIG_AT_END;
constexpr size_t WS_END  = WS_BIG + BIG_BYTES;
constexpr size_t FFT_SCR_PER_WG = 5 * 131072;
constexpr size_t FFT_EXT_PER_WG = 2 * 65536;
constexpr size_t WS_XB = WS_END + (size_t)256 * FFT_EXT_PER_WG;
constexpr size_t WS_TOTAL = WS_XB + (size_t)T * 2048 * 2;
static_assert(256 * FFT_SCR_PER_WG <= H_BYTES, "fft scratch must fit in H");

struct Params {
    const float *x_prompt, *x_sample, *c_prompt, *c_sample, *ada_w, *ada_b, *norm_mix, *norm_ffn;
    const float *hy_w_in, *hy_b_in, *hy_conv_w, *hy_conv_b, *hy_fw1, *hy_fb1, *hy_ffreq, *hy_fw2, *hy_fb2, *hy_fw3, *hy_decay, *hy_skip, *hy_w_out, *hy_b_out;
    const float *at_w_in, *at_w_out, *ffn_w_gate, *ffn_w_up, *ffn_w_down, *final_norm, *final_ada_w, *final_ada_b;
    float* out; unsigned char* ws; int ph_lo, ph_hi, probe, pad0;
};

#define LDSQ __attribute__((address_space(3)))

__device__ __forceinline__ float bf2f(bf16_t b) { return __uint_as_float(((unsigned)b) << 16); }
__device__ __forceinline__ bf16_t f2bf(float f) { unsigned u = __float_as_uint(f); u += 0x7FFFu + ((u >> 16) & 1u); return (bf16_t)(u >> 16); }
__device__ __forceinline__ int seq_of_row(int row) { return row < T_P ? (row >> 14) : 2 + ((row - T_P) >> 11); }
__device__ __forceinline__ int pos_of_row(int row) { return row < T_P ? (row & 16383) : (row & 2047); }
__device__ __forceinline__ float wave_sum(float v) {
#pragma unroll
    for (int o = 32; o >= 1; o >>= 1) v += __shfl_xor(v, o);
    return v;
}

struct EpiZinT {
    static constexpr bool PERM = true, AFTER_DRAIN = false;
    bf16_t* O; int ldc; const float* bias;
    __device__ __forceinline__ void operator()(const f32x4 (&acc)[2][2][4][2], const Unit& u, int wr, int wc, int fr, int fq) const {
        const int row0 = u.pm * 256 + wr * 64 + fr, col0 = u.pn * 256 + wc * 32 + 8 * fq;
        float bs[8];
#pragma unroll
        for (int r = 0; r < 8; ++r) bs[r] = bias[row0 + (r >> 2) * 128 + (r & 3) * 16];
#pragma unroll
        for (int ai = 0; ai < 2; ++ai)
#pragma unroll
            for (int m = 0; m < 4; ++m) { const int r = row0 + ai * 128 + m * 16; const float b = bs[ai * 4 + m]; bf16_t* rowp = O + (size_t)r * ldc + col0;
#pragma unroll
                for (int bj = 0; bj < 2; ++bj) { const f32x4 v0 = acc[ai][bj][m][0] + b, v1 = acc[ai][bj][m][1] + b;
                    u32x4 w; w.x = cvt_pk_bf16(v0[0], v0[1]); w.y = cvt_pk_bf16(v0[2], v0[3]); w.z = cvt_pk_bf16(v1[0], v1[1]); w.w = cvt_pk_bf16(v1[2], v1[3]);
                    *(u32x4*)(rowp + bj * 128) = w; } }
    }
};
struct EpiRes {
    static constexpr bool PERM = true, AFTER_DRAIN = false;
    bf16_t* X; const float* bias; const float* gate; int dry;
    __device__ __forceinline__ void operator()(const f32x4 (&acc)[2][2][4][2], const Unit& u, int wr, int wc, int fr, int fq) const {
        const int row0 = u.pm * 256 + wr * 64 + fr, col0 = u.pn * 256 + wc * 32 + 8 * fq;
        const float* gp = gate + (size_t)seq_of_row(u.pm * 256) * MODW + col0;
        bf16_t* xb = X + (size_t)row0 * 2048 + col0;
        u32x4 xv[2][4]; f32x4 gv[2][2], bv[2][2];
#pragma unroll
        for (int m4 = 0; m4 < 4; ++m4) xv[0][m4] = *(const u32x4*)(xb + (size_t)(m4 * 16) * 2048);
#pragma unroll
        for (int n = 0; n < 2; ++n) { gv[0][n] = *(const f32x4*)(gp + 4 * n); bv[0][n] = bias ? *(const f32x4*)(bias + col0 + 4 * n) : (f32x4){0.f, 0.f, 0.f, 0.f}; }
#pragma unroll
        for (int c = 0; c < 4; ++c) { const int bj = c >> 1, ai = c & 1;
            if (c < 3) { const int bj2 = (c + 1) >> 1, ai2 = (c + 1) & 1;
#pragma unroll
                for (int m4 = 0; m4 < 4; ++m4) xv[(c + 1) & 1][m4] = *(const u32x4*)(xb + (size_t)(ai2 * 128 + m4 * 16) * 2048 + bj2 * 128);
                if (c == 1) {
#pragma unroll
                    for (int n = 0; n < 2; ++n) { gv[1][n] = *(const f32x4*)(gp + 128 + 4 * n); bv[1][n] = bias ? *(const f32x4*)(bias + col0 + 128 + 4 * n) : (f32x4){0.f, 0.f, 0.f, 0.f}; } } }
#pragma unroll
            for (int m4 = 0; m4 < 4; ++m4) { const u32x4 xo = xv[c & 1][m4];
                const f32x4 xa = {__uint_as_float(xo.x << 16), __uint_as_float(xo.x & 0xffff0000u), __uint_as_float(xo.y << 16), __uint_as_float(xo.y & 0xffff0000u)};
                const f32x4 xc = {__uint_as_float(xo.z << 16), __uint_as_float(xo.z & 0xffff0000u), __uint_as_float(xo.w << 16), __uint_as_float(xo.w & 0xffff0000u)};
                const f32x4 ya = xa + gv[bj][0] * (acc[ai][bj][m4][0] + bv[bj][0]), yc = xc + gv[bj][1] * (acc[ai][bj][m4][1] + bv[bj][1]);
                u32x4 w; w.x = cvt_pk_bf16(ya[0], ya[1]); w.y = cvt_pk_bf16(ya[2], ya[3]); w.z = cvt_pk_bf16(yc[0], yc[1]); w.w = cvt_pk_bf16(yc[2], yc[3]);
                if (!dry) *(u32x4*)(xb + (size_t)(ai * 128 + m4 * 16) * 2048 + bj * 128) = w; } }
    }
};
struct EpiQKV {
    static constexpr bool PERM = true, AFTER_DRAIN = false;
    bf16_t* O; const cpx* rope;
    __device__ __forceinline__ void operator()(const f32x4 (&acc)[2][2][4][2], const Unit& u, int wr, int wc, int fr, int fq) const {
        const int row0 = u.pm * 256 + wr * 64 + fr, colt = u.pn * 256, col0 = colt + wc * 32 + 8 * fq;
        const int sidx = (colt % 3072) >> 10;
        const bool dorope = (sidx < 2) && (wc == 0);
        const float qs = (sidx == 0) ? QSCALE : 1.0f;
        f32x4 tt[2][4];
        if (dorope) { const cpx* rp = rope + (size_t)pos_of_row(row0) * 16 + 8 * (fq & 1);
            tt[0][0] = *(const f32x4*)(rp); tt[0][1] = *(const f32x4*)(rp + 2); tt[0][2] = *(const f32x4*)(rp + 4); tt[0][3] = *(const f32x4*)(rp + 6); }
#pragma unroll
        for (int g = 0; g < 8; ++g) { const int ai = g >> 2, m = g & 3; const int r = row0 + ai * 128 + m * 16; bf16_t* rowp = O + (size_t)r * QKVW + col0;
            f32x4 c0, c1, s0, s1;
            if (dorope) {
                if (g < 7) { const int r2 = row0 + ((g + 1) >> 2) * 128 + ((g + 1) & 3) * 16; const cpx* rp = rope + (size_t)pos_of_row(r2) * 16 + 8 * (fq & 1);
                    tt[(g + 1) & 1][0] = *(const f32x4*)(rp); tt[(g + 1) & 1][1] = *(const f32x4*)(rp + 2); tt[(g + 1) & 1][2] = *(const f32x4*)(rp + 4); tt[(g + 1) & 1][3] = *(const f32x4*)(rp + 6); }
                const f32x4 t0 = tt[g & 1][0], t1 = tt[g & 1][1], t2 = tt[g & 1][2], t3 = tt[g & 1][3];
                c0 = (f32x4){t0[0], t0[2], t1[0], t1[2]}; s0 = (f32x4){t0[1], t0[3], t1[1], t1[3]};
                c1 = (f32x4){t2[0], t2[2], t3[0], t3[2]}; s1 = (f32x4){t2[1], t2[3], t3[1], t3[3]}; }
#pragma unroll
            for (int bj = 0; bj < 2; ++bj) { f32x4 v0 = acc[ai][bj][m][0], v1 = acc[ai][bj][m][1];
                if (dorope) { f32x4 p0, p1;
#pragma unroll
                    for (int e = 0; e < 4; ++e) { p0[e] = __shfl_xor(v0[e], 32); p1[e] = __shfl_xor(v1[e], 32); }
                    if (fq < 2) { v0 = v0 * c0 - p0 * s0; v1 = v1 * c1 - p1 * s1; }
                    else        { v0 = v0 * c0 + p0 * s0; v1 = v1 * c1 + p1 * s1; } }
                v0 *= qs; v1 *= qs;
                u32x4 w; w.x = cvt_pk_bf16(v0[0], v0[1]); w.y = cvt_pk_bf16(v0[2], v0[3]); w.z = cvt_pk_bf16(v1[0], v1[1]); w.w = cvt_pk_bf16(v1[2], v1[3]);
                *(u32x4*)(rowp + bj * 128) = w; } }
    }
};
struct EpiFFN1 {
    static constexpr bool PERM = true, AFTER_DRAIN = false;
    bf16_t* O;
    __device__ __forceinline__ void operator()(const f32x4 (&acc)[2][2][4][2], const Unit& u, int wr, int wc, int fr, int fq) const {
        const int row0 = u.pm * 256 + wr * 64 + fr, col0 = u.pn * 128 + wc * 32 + 8 * fq;
#pragma unroll
        for (int ai = 0; ai < 2; ++ai)
#pragma unroll
            for (int m = 0; m < 4; ++m) { bf16_t* rowp = O + (size_t)(row0 + ai * 128 + m * 16) * DFF + col0; float o[8];
#pragma unroll
                for (int n = 0; n < 2; ++n)
#pragma unroll
                    for (int e = 0; e < 4; ++e) { const float g = acc[ai][0][m][n][e], up = acc[ai][1][m][n][e]; o[n * 4 + e] = g * __builtin_amdgcn_rcpf(1.0f + __expf(-g)) * up; }
                u32x4 w; w.x = cvt_pk_bf16(o[0], o[1]); w.y = cvt_pk_bf16(o[2], o[3]); w.z = cvt_pk_bf16(o[4], o[5]); w.w = cvt_pk_bf16(o[6], o[7]);
                *(u32x4*)rowp = w; }
    }
};
struct EpiTaps {
    static constexpr bool PERM = true, AFTER_DRAIN = false;
    _Float16* O;
    __device__ __forceinline__ void operator()(const f32x4 (&acc)[2][2][4][2], const Unit& u, int wr, int wc, int fr, int fq) const {
        typedef _Float16 h8 __attribute__((ext_vector_type(8)));
        const int row0 = u.pm * 256 + wr * 64 + fr, col0 = u.pn * 256 + wc * 32 + 8 * fq;
#pragma unroll
        for (int ai = 0; ai < 2; ++ai)
#pragma unroll
            for (int m = 0; m < 4; ++m) { _Float16* rowp = O + (size_t)(row0 + ai * 128 + m * 16) * NPOS + col0;
#pragma unroll
                for (int bj = 0; bj < 2; ++bj) { const f32x4 v0 = acc[ai][bj][m][0], v1 = acc[ai][bj][m][1]; h8 w;
                    w[0] = (_Float16)v0[0]; w[1] = (_Float16)v0[1]; w[2] = (_Float16)v0[2]; w[3] = (_Float16)v0[3]; w[4] = (_Float16)v1[0]; w[5] = (_Float16)v1[1]; w[6] = (_Float16)v1[2]; w[7] = (_Float16)v1[3];
                    *(h8*)(rowp + bj * 128) = w; } }
    }
};

__device__ __forceinline__ void ada_partials(const Params& p, LDSQ unsigned char* lds) {
    LDSQ float* cs = (LDSQ float*)lds;
    for (int i = pg8::otid(); i < 6 * 2048; i += NTHR) { const int b = i >> 11, k = i & 2047; const float c = b < 2 ? p.c_prompt[b * 2048 + k] : p.c_sample[(b - 2) * 2048 + k]; cs[i] = c / (1.0f + expf(-c)); }
    __syncthreads();
    float* part = (float*)(p.ws + WS_PART);
    for (int item = pg8::obid() * NTHR + pg8::otid(); item < 8 * 13312; item += pg8::ogrid() * NTHR) {
        const int chunk = item / 13312, c4 = item % 13312;
        const float* W; int ldw;
        if (c4 < 12288) { const int layer = c4 / 3072, col = (c4 % 3072) * 4; W = p.ada_w + (size_t)layer * 2048 * 12288 + col; ldw = 12288; }
        else { W = p.final_ada_w + (c4 - 12288) * 4; ldw = 4096; }
        f32x4 a0 = {0.f, 0.f, 0.f, 0.f}, a1 = a0, a2 = a0, a3 = a0, a4 = a0, a5 = a0;
        const int k0 = chunk * 256;
#pragma unroll 8
        for (int k = k0; k < k0 + 256; ++k) { const f32x4 w = *(const f32x4*)(W + (size_t)k * ldw);
            a0 += cs[k] * w; a1 += cs[2048 + k] * w; a2 += cs[4096 + k] * w; a3 += cs[6144 + k] * w; a4 += cs[8192 + k] * w; a5 += cs[10240 + k] * w; }
        float* o = part + (size_t)chunk * 6 * MODW + (size_t)c4 * 4;
        *(f32x4*)(o) = a0; *(f32x4*)(o + MODW) = a1; *(f32x4*)(o + 2 * MODW) = a2; *(f32x4*)(o + 3 * MODW) = a3; *(f32x4*)(o + 4 * MODW) = a4; *(f32x4*)(o + 5 * MODW) = a5;
    }
    __syncthreads();
}
__device__ __forceinline__ void ada_reduce(const Params& p) {
    const float* part = (const float*)(p.ws + WS_PART); float* mod = (float*)(p.ws + WS_MOD);
    for (int i = pg8::obid() * NTHR + pg8::otid(); i < 6 * MODW; i += pg8::ogrid() * NTHR) {
        const int c = i % MODW; float s = c < 49152 ? p.ada_b[c] : p.final_ada_b[c - 49152];
#pragma unroll
        for (int ch = 0; ch < 8; ++ch) s += part[(size_t)ch * 6 * MODW + i];
        mod[i] = s;
    }
}
__device__ __forceinline__ void rope_table(const Params& p) {
    cpx* rope = (cpx*)(p.ws + WS_ROPE);
    for (int i = pg8::obid() * NTHR + pg8::otid(); i < 16384 * 16; i += pg8::ogrid() * NTHR) {
        const int pos = i >> 4, f = i & 15; const float inv = powf(500000.0f, -(float)f / 16.0f); const float ang = (float)pos * inv;
        float s, c; sincosf(ang, &s, &c); rope[i] = mkc(c, s);
    }
}
__device__ __forceinline__ void filter_mlp(const Params& p) {
    const int lane = pg8::otid() & 63, gw = pg8::obid() * 8 + (pg8::otid() >> 6);
    bf16_t* a2x = (bf16_t*)(p.ws + WS_A2X);
    for (int q = gw; q < 2 * NPOS; q += pg8::ogrid() * 8) {
        const int j = q / NPOS, r = q % NPOS; const int L = r < 16384 ? 16384 : 2048, pos = r < 16384 ? r : r - 16384;
        const float fpos = (float)pos;
        float z = 0.f;
        if (lane == 0) z = fpos / (float)(L - 1);
        else if (lane <= 32) { const int bi = (lane - 1) & 15; const float band = 1e-4f + (float)bi * ((15.0f - 1e-4f) / 15.0f);
            const float ang = ((6.283185307179586f * fpos) * band) / (float)L; z = lane <= 16 ? cosf(ang) : -sinf(ang); }
        const float* w1 = p.hy_fw1 + j * 33 * 64; const float* w2 = p.hy_fw2 + j * 64 * 64;
        float acc = p.hy_fb1[j * 64 + lane];
#pragma unroll
        for (int m = 0; m < 33; ++m) acc += __shfl(z, m) * w1[m * 64 + lane];
        const float a1 = sinf(p.hy_ffreq[j * 128 + lane] * acc);
        acc = p.hy_fb2[j * 64 + lane];
#pragma unroll
        for (int m = 0; m < 64; ++m) acc += __shfl(a1, m) * w2[m * 64 + lane];
        const float a2 = sinf(p.hy_ffreq[j * 128 + 64 + lane] * acc);
        const bf16_t hi = f2bf(a2), lo = f2bf(a2 - bf2f(hi));
        bf16_t* o = a2x + ((size_t)j * NPOS + r) * 256;
        o[lane] = hi; o[64 + lane] = hi; o[128 + lane] = lo; o[192 + lane] = 0;
    }
    bf16_t* w3x = (bf16_t*)(p.ws + WS_W3X);
    for (int i = pg8::obid() * NTHR + pg8::otid(); i < 2 * 8192 * 64; i += pg8::ogrid() * NTHR) {
        const int k = i & 63, col = (i >> 6) & 8191, j = i >> 19;
        const float v = p.hy_fw3[(size_t)j * 64 * 8192 + (size_t)k * 8192 + col];
        const bf16_t hi = f2bf(v), lo = f2bf(v - bf2f(hi));
        bf16_t* o = w3x + ((size_t)j * 8192 + col) * 256;
        o[k] = hi; o[64 + k] = lo; o[128 + k] = hi; o[192 + k] = 0;
    }
}
__device__ __forceinline__ void convert_T(LDSQ unsigned char* lds, const float* src, int K, int N, bf16_t* dst, int ffs) {
    LDSQ float* tile = (LDSQ float*)lds;
    const int tid = pg8::otid(), ntn = N >> 8, ntiles = (K >> 6) * ntn, stride = pg8::ogrid();
    const int r = tid >> 6, c4 = tid & 63;
    f32x4 v[8];
    int ti = pg8::obid();
    if (ti < ntiles) { const int tk = ti / ntn, tn = ti % ntn;
#pragma unroll
        for (int it = 0; it < 8; ++it) v[it] = *(const f32x4*)(src + (size_t)(tk * 64 + r + 8 * it) * N + tn * 256 + 4 * c4); }
    for (; ti < ntiles; ti += stride) {
        const int tk = ti / ntn, tn = ti % ntn;
#pragma unroll
        for (int it = 0; it < 8; ++it) { LDSQ float* tp = tile + (r + 8 * it) * 257 + 4 * c4; tp[0] = v[it][0]; tp[1] = v[it][1]; tp[2] = v[it][2]; tp[3] = v[it][3]; }
        __syncthreads();
        if (ti + stride < ntiles) { const int t2 = ti + stride, tk2 = t2 / ntn, tn2 = t2 % ntn;
#pragma unroll
            for (int it = 0; it < 8; ++it) v[it] = *(const f32x4*)(src + (size_t)(tk2 * 64 + r + 8 * it) * N + tn2 * 256 + 4 * c4); }
        { const int n = tid >> 1, kh = tid & 1; const int nn = tn * 256 + n; const int row = ffs < 0 ? nn : (256 * (nn >> 7) + 128 * ffs + (nn & 127));
          bf16_t* dp = dst + (size_t)row * K + tk * 64 + kh * 32;
#pragma unroll
          for (int q = 0; q < 4; ++q) { float f[8];
#pragma unroll
              for (int e = 0; e < 8; ++e) f[e] = tile[(kh * 32 + q * 8 + e) * 257 + n];
              u32x4 w; w.x = cvt_pk_bf16(f[0], f[1]); w.y = cvt_pk_bf16(f[2], f[3]); w.z = cvt_pk_bf16(f[4], f[5]); w.w = cvt_pk_bf16(f[6], f[7]);
              *(u32x4*)(dp + q * 8) = w; } }
        __syncthreads();
    }
}
template <bool FINAL, bool SRC_F32> __device__ __forceinline__ void norm_rows(const float* xp, const float* xs, bf16_t* xb, const float* g, const float* modl, int sh_off, int sc_off, bf16_t* H, float* outf) {
    const int lane = pg8::otid() & 63, gw = pg8::obid() * 8 + (pg8::otid() >> 6), nw = pg8::ogrid() * 8;
    const int rpw = (T + nw - 1) / nw, r0 = gw * rpw, r1 = (r0 + rpw < T) ? r0 + rpw : T;
    if (r0 >= r1) return;
    f32x4 gs[8], sh[8]; int curseq = -1;
    struct RowBuf { f32x4 f[SRC_F32 ? 8 : 1]; u32x2 b[SRC_F32 ? 1 : 8]; };
    auto request = [&](RowBuf& B, int row) {
        if (SRC_F32) { const f32x4* src = (const f32x4*)(row < T_P ? xp + (size_t)row * 2048 : xs + (size_t)(row - T_P) * 2048);
#pragma unroll
            for (int i = 0; i < 8; ++i) B.f[i] = src[lane + 64 * i]; }
        else { const u32x2* src = (const u32x2*)(xb + (size_t)row * 2048);
#pragma unroll
            for (int i = 0; i < 8; ++i) B.b[i] = src[lane + 64 * i]; } };
    auto process = [&](RowBuf& B, int row, int next) {
        f32x4 v[8];
#pragma unroll
        for (int i = 0; i < 8; ++i) { if (SRC_F32) v[i] = B.f[i]; else v[i] = (f32x4){__uint_as_float(B.b[i].x << 16), __uint_as_float(B.b[i].x & 0xffff0000u), __uint_as_float(B.b[i].y << 16), __uint_as_float(B.b[i].y & 0xffff0000u)}; }
        if (next < r1) request(B, next);
        const int seq = seq_of_row(row);
        if (seq != curseq) { curseq = seq; const float* mod = modl + (size_t)seq * MODW;
#pragma unroll
            for (int i = 0; i < 8; ++i) { const int col = (lane + 64 * i) * 4; gs[i] = *(const f32x4*)(g + col); sh[i] = *(const f32x4*)(mod + sc_off + col); }
#pragma unroll
            for (int i = 0; i < 8; ++i) { const int col = (lane + 64 * i) * 4; const f32x4 sft = *(const f32x4*)(mod + sh_off + col); gs[i] = gs[i] * (1.0f + sh[i]); sh[i] = sft; } }
        float ss = 0.f;
#pragma unroll
        for (int i = 0; i < 8; ++i) ss += v[i][0] * v[i][0] + v[i][1] * v[i][1] + v[i][2] * v[i][2] + v[i][3] * v[i][3];
        ss = wave_sum(ss);
        const float rstd = 1.0f / sqrtf(ss * (1.0f / 2048.0f) + EPS);
#pragma unroll
        for (int i = 0; i < 8; ++i) { const int col = (lane + 64 * i) * 4;
            const f32x4 h = (v[i] * rstd) * gs[i] + sh[i];
            if (FINAL) *(f32x4*)(outf + (size_t)row * 2048 + col) = h;
            else { u32x2 w; w.x = cvt_pk_bf16(h[0], h[1]); w.y = cvt_pk_bf16(h[2], h[3]); *(u32x2*)(H + (size_t)row * 2048 + col) = w;
                if (SRC_F32) { u32x2 c; c.x = cvt_pk_bf16(v[i][0], v[i][1]); c.y = cvt_pk_bf16(v[i][2], v[i][3]); *(u32x2*)(xb + (size_t)row * 2048 + col) = c; } } } };
    if (SRC_F32) {
        RowBuf B0, B1;
        request(B0, r0); if (r0 + 1 < r1) request(B1, r0 + 1);
        for (int row = r0; row < r1; row += 2) { process(B0, row, row + 2); if (row + 1 < r1) process(B1, row + 1, row + 3); }
    } else {
        RowBuf B0, B1, B2;
        request(B0, r0); if (r0 + 1 < r1) request(B1, r0 + 1); if (r0 + 2 < r1) request(B2, r0 + 2);
        for (int row = r0; row < r1; row += 3) {
            process(B0, row, row + 3);
            if (row + 1 < r1) process(B1, row + 1, row + 4);
            if (row + 2 < r1) process(B2, row + 2, row + 5);
        }
    }
}
__device__ __forceinline__ void final_norm_phase(const Params& p) {
    norm_rows<true, false>(nullptr, nullptr, (bf16_t*)(p.ws + WS_XB), p.final_norm, (const float*)(p.ws + WS_MOD) + 49152, 0, 2048, nullptr, p.out);
}
__device__ __forceinline__ void transpose_phase(const Params& p, LDSQ unsigned char* lds) {
    LDSQ bf16_t* tile = (LDSQ bf16_t*)lds;
    const bf16_t* zin = (const bf16_t*)(p.ws + WS_BIG + BIG_ZINT); bf16_t* H = (bf16_t*)(p.ws + WS_H);
    const int tid = pg8::otid(), stride = pg8::ogrid();
    const int cr = tid >> 5, tq = tid & 31;
    u32x4 v[4];
    int ti = pg8::obid();
    if (ti < 32 * 160) { const int tc = ti / 160, tt = ti % 160;
#pragma unroll
        for (int it = 0; it < 4; ++it) v[it] = *(const u32x4*)(zin + (size_t)(tc * 64 + cr + 16 * it) * T + tt * 256 + tq * 8); }
    for (; ti < 32 * 160; ti += stride) {
        const int tc = ti / 160, tt = ti % 160;
#pragma unroll
        for (int it = 0; it < 4; ++it) *(LDSQ u32x4*)(tile + (cr + 16 * it) * 264 + tq * 8) = v[it];
        __syncthreads();
        if (ti + stride < 32 * 160) { const int t2 = ti + stride, tc2 = t2 / 160, tt2 = t2 % 160;
#pragma unroll
            for (int it = 0; it < 4; ++it) v[it] = *(const u32x4*)(zin + (size_t)(tc2 * 64 + cr + 16 * it) * T + tt2 * 256 + tq * 8); }
        { const int cq = tid & 7, tk = tid >> 3;
#pragma unroll
          for (int it = 0; it < 4; ++it) { const int tok = tk + 64 * it; unsigned w[4];
#pragma unroll
              for (int e = 0; e < 4; ++e) { const unsigned lo = tile[(cq * 8 + 2 * e) * 264 + tok], hi = tile[(cq * 8 + 2 * e + 1) * 264 + tok]; w[e] = lo | (hi << 16); }
              *(u32x4*)(H + (size_t)(tt * 256 + tok) * 2048 + tc * 64 + cq * 8) = (u32x4){w[0], w[1], w[2], w[3]}; } }
        __syncthreads();
    }
}

__host__ __device__ constexpr float cos64q(int k) {
    constexpr float t[17] = {1.0f, 0.99518472667219693f, 0.98078528040323043f, 0.95694033573220882f, 0.92387953251128674f, 0.88192126434835505f, 0.83146961230254524f,
        0.77301045336273699f, 0.70710678118654757f, 0.63439328416364549f, 0.55557023301960229f, 0.47139673682599781f, 0.38268343236508984f, 0.29028467725446233f,
        0.19509032201612833f, 0.09801714032956077f, 0.0f};
    return t[k];
}
__host__ __device__ constexpr float cos64(int k) { k &= 63; return k <= 16 ? cos64q(k) : k <= 32 ? -cos64q(32 - k) : k <= 48 ? -cos64q(k - 32) : cos64q(64 - k); }
__host__ __device__ constexpr float sin64(int k) { return cos64((k + 48) & 63); }
template <int R> __host__ __device__ constexpr int brev(int k) { int r = 0; for (int b = 1; b < R; b <<= 1) { r = (r << 1) | (k & 1); k >>= 1; } return r; }

typedef _Float16 hcpx __attribute__((ext_vector_type(2)));
typedef _Float16 hcpx2 __attribute__((ext_vector_type(4)));
__device__ __forceinline__ hcpx h_of(cpx a) { hcpx r; r.x = (_Float16)a.x; r.y = (_Float16)a.y; return r; }
__device__ __forceinline__ cpx c_of(hcpx a) { return mkc((float)a.x, (float)a.y); }
__device__ __forceinline__ hcpx2 h2_of(cpx a, cpx b) { hcpx2 r; r.x = (_Float16)a.x; r.y = (_Float16)a.y; r.z = (_Float16)b.x; r.w = (_Float16)b.y; return r; }
#define VA __device__ __forceinline__ float
VA f_mul(float a, float b) { float r; asm("v_mul_f32_e32 %0, %1, %2" : "=v"(r) : "v"(a), "v"(b)); return r; }
VA f_fma(float a, float b, float c) { float r; asm("v_fma_f32 %0, %1, %2, %3" : "=v"(r) : "v"(a), "v"(b), "v"(c)); return r; }
VA f_fms(float a, float b, float c) { float r; asm("v_fma_f32 %0, %1, %2, -%3" : "=v"(r) : "v"(a), "v"(b), "v"(c)); return r; }
#undef VA
__device__ __forceinline__ cpx cmul(cpx a, cpx b) { float rx, ry;
    asm("v_mul_f32_e32 %0, %3, %5\n\tv_mul_f32_e32 %1, %3, %4\n\tv_fma_f32 %0, %2, %4, -%0\n\tv_fma_f32 %1, %2, %5, %1" : "=&v"(rx), "=&v"(ry) : "v"(a.x), "v"(a.y), "v"(b.x), "v"(b.y)); return mkc(rx, ry); }
__device__ __forceinline__ cpx cmulc(cpx a, cpx b) { float rx, ry;
    asm("v_mul_f32_e32 %0, %3, %5\n\tv_mul_f32_e32 %1, %2, %5\n\tv_fma_f32 %0, %2, %4, %0\n\tv_fma_f32 %1, %3, %4, -%1" : "=&v"(rx), "=&v"(ry) : "v"(a.x), "v"(a.y), "v"(b.x), "v"(b.y)); return mkc(rx, ry); }

template <int R, bool INV, int H, int P> __device__ __forceinline__ void bfly(cpx (&v)[R]) {
    constexpr int b = (P / H) * 2 * H, i = P % H, e = i * (32 / H);
    float ux = v[b + i].x, uy = v[b + i].y, wx = v[b + i + H].x, wy = v[b + i + H].y;
    if constexpr (e == 0) { float dx, dy;
        asm("v_sub_f32_e32 %2, %0, %4\n\tv_sub_f32_e32 %3, %1, %5\n\tv_add_f32_e32 %0, %0, %4\n\tv_add_f32_e32 %1, %1, %5" : "+v"(ux), "+v"(uy), "=&v"(dx), "=&v"(dy) : "v"(wx), "v"(wy));
        wx = dx; wy = dy; }
    else if constexpr (e == 16) { float ox, oy;
        if constexpr (!INV) asm("v_sub_f32_e32 %2, %1, %5\n\tv_sub_f32_e32 %3, %4, %0\n\tv_add_f32_e32 %0, %0, %4\n\tv_add_f32_e32 %1, %1, %5" : "+v"(ux), "+v"(uy), "=&v"(ox), "=&v"(oy) : "v"(wx), "v"(wy));
        else                asm("v_sub_f32_e32 %2, %5, %1\n\tv_sub_f32_e32 %3, %0, %4\n\tv_add_f32_e32 %0, %0, %4\n\tv_add_f32_e32 %1, %1, %5" : "+v"(ux), "+v"(uy), "=&v"(ox), "=&v"(oy) : "v"(wx), "v"(wy));
        wx = ox; wy = oy; }
    else { constexpr float c = cos64(e), s = INV ? sin64(e) : -sin64(e);
        constexpr unsigned cb = __builtin_bit_cast(unsigned, c), sb = __builtin_bit_cast(unsigned, s), nsb = __builtin_bit_cast(unsigned, -s);
        float dx, dy;
        asm("v_sub_f32_e32 %4, %0, %2\n\tv_sub_f32_e32 %5, %1, %3\n\tv_add_f32_e32 %0, %0, %2\n\tv_add_f32_e32 %1, %1, %3\n\t"
            "v_mul_f32_e32 %2, %8, %5\n\tv_mul_f32_e32 %3, %6, %5\n\tv_fmamk_f32 %2, %4, %6, %2\n\tv_fmamk_f32 %3, %4, %7, %3"
            : "+v"(ux), "+v"(uy), "+v"(wx), "+v"(wy), "=&v"(dx), "=&v"(dy) : "i"(cb), "i"(sb), "i"(nsb)); }
    v[b + i] = mkc(ux, uy); v[b + i + H] = mkc(wx, wy);
}
template <int R, bool INV, int H, int... Ps> __device__ __forceinline__ void dft_stage(cpx (&v)[R], std::integer_sequence<int, Ps...>) { (bfly<R, INV, H, Ps>(v), ...); }
template <int R, bool INV, int H> __device__ __forceinline__ void dft_stages(cpx (&v)[R]) {
    dft_stage<R, INV, H>(v, std::make_integer_sequence<int, R / 2>{});
    if constexpr (H > 1) dft_stages<R, INV, H / 2>(v);
}
template <int R, bool INV> __device__ __forceinline__ void dft_r2(cpx (&v)[R]) { dft_stages<R, INV, R / 2>(v); }
template <int R, bool CONJ, bool BREV> __device__ __forceinline__ void apply_pows(cpx (&v)[R], cpx w) {
    constexpr int H = R > 16 ? 16 : R;
    cpx pw[H];
    pw[1] = w;
#pragma unroll
    for (int k = 2; k < H; ++k) pw[k] = (k & 1) ? cmul(pw[k - 1], w) : cmul(pw[k / 2], pw[k / 2]);
#pragma unroll
    for (int k = 1; k < H; ++k) { const int idx = BREV ? brev<R>(k) : k; v[idx] = CONJ ? cmulc(v[idx], pw[k]) : cmul(v[idx], pw[k]); }
    if (R > 16) {
        const cpx w16 = cmul(pw[8], pw[8]);
#pragma unroll
        for (int k = 0; k < R - 16; ++k) { const cpx q = k == 0 ? w16 : cmul(pw[k], w16); const int idx = BREV ? brev<R>(16 + k) : 16 + k; v[idx] = CONJ ? cmulc(v[idx], q) : cmul(v[idx], q); }
    }
}
__device__ __forceinline__ int phys(int i) { return i + (i >> 5); }
constexpr int TW_OFF = 135168 + 64;
template <int S> __host__ __device__ constexpr int poff(int j) { return S >= 32 ? j * (S + S / 32) : j * S + ((j * S) >> 5); }
typedef hcpx PreRegs[32];
template <int R, int S> __device__ __forceinline__ void fft_prefetch(int t, const hcpx* gio, PreRegs& pre) {
    constexpr int G = 32 / R;
#pragma unroll
    for (int gi = 0; gi < G; ++gi) { const int gam = gi * 512 + t, hi = gam / S, lo = gam % S, base = hi * (R * S) + lo;
#pragma unroll
        for (int j = 0; j < R; ++j) pre[gi * R + j] = __builtin_nontemporal_load(gio + base + j * S); }
}
template <int R, int S, bool INV, int IO> __device__ __forceinline__ void fft_pass(LDSQ cpx* A, int t, hcpx* gio, const PreRegs& pre) {
    constexpr int G = 32 / R;
    asm volatile("" : "+v"(t) :: "memory");
    const LDSQ cpx* TW = (const LDSQ cpx*)((LDSQ unsigned char*)A + TW_OFF);
    cpx v[G][R]; cpx tw[G];
#pragma unroll
    for (int gi = 0; gi < G; ++gi) {
        const int gam = gi * 512 + t, hi = gam / S, lo = gam % S, base = hi * (R * S) + lo; const LDSQ cpx* Ab = A + phys(base);
#pragma unroll
        for (int j = 0; j < R; ++j) v[gi][j] = (IO == 3) ? c_of(pre[gi * R + j]) : (IO == 1) ? c_of(__builtin_nontemporal_load(gio + base + j * S)) : Ab[poff<S>(j)];
        tw[gi] = TW[lo * (16384 / (R * S))];
    }
#pragma unroll
    for (int gi = 0; gi < G; ++gi) {
        const int gam = gi * 512 + t, hi = gam / S, lo = gam % S, base = hi * (R * S) + lo; LDSQ cpx* Ab = A + phys(base);
        if (!INV) {
            dft_r2<R, false>(v[gi]);
            apply_pows<R, false, true>(v[gi], tw[gi]);
#pragma unroll
            for (int k = 0; k < R; ++k) { if (IO == 2) gio[base + k * S] = h_of(v[gi][brev<R>(k)]); else Ab[poff<S>(k)] = v[gi][brev<R>(k)]; }
        } else {
            apply_pows<R, true, false>(v[gi], tw[gi]);
            dft_r2<R, true>(v[gi]);
#pragma unroll
            for (int j = 0; j < R; ++j) { if (IO == 2) gio[base + j * S] = h_of(v[gi][brev<R>(j)]); else Ab[poff<S>(j)] = v[gi][brev<R>(j)]; }
        }
    }
}
template <int R, int MODE> __device__ __forceinline__ void fft_mid(LDSQ cpx* A, int t, hcpx* spec, float scale) {
    constexpr int G = 32 / R;
    asm volatile("" : "+v"(t) :: "memory");
    hcpx2 sp[G][R / 2];
    if (MODE == 1) {
#pragma unroll
        for (int gi = 0; gi < G; ++gi)
#pragma unroll
            for (int k2 = 0; k2 < R / 2; ++k2) sp[gi][k2] = *(const hcpx2*)(spec + 2 * (size_t)(k2 * (16384 / R) + gi * 512 + t));
    }
#pragma unroll
    for (int gi = 0; gi < G; ++gi) {
        const int gam = gi * 512 + t, base = gam * R;
        cpx v[R];
        LDSQ cpx* Ab = A + phys(base);
#pragma unroll
        for (int j = 0; j < R; ++j) v[j] = Ab[j];
        dft_r2<R, false>(v);
        if (MODE == 0) {
#pragma unroll
            for (int k2 = 0; k2 < R / 2; ++k2) { const cpx x = v[brev<R>(2 * k2)], y = v[brev<R>(2 * k2 + 1)];
                *(hcpx2*)(spec + 2 * (size_t)(k2 * (16384 / R) + gam)) = h2_of(mkc(x.x * scale, x.y * scale), mkc(y.x * scale, y.y * scale)); }
        } else {
            cpx x[R];
#pragma unroll
            for (int k2 = 0; k2 < R / 2; ++k2) { const hcpx2 s = sp[gi][k2]; x[2 * k2] = cmul(v[brev<R>(2 * k2)], mkc((float)s.x * scale, (float)s.y * scale)); x[2 * k2 + 1] = cmul(v[brev<R>(2 * k2 + 1)], mkc((float)s.z * scale, (float)s.w * scale)); }
            dft_r2<R, true>(x);
#pragma unroll
            for (int j = 0; j < R; ++j) Ab[j] = x[brev<R>(j)];
        }
    }
}
#define GL_DRAIN() asm volatile("s_waitcnt vmcnt(0)" ::: "memory")
struct NoHook { __device__ __forceinline__ void operator()() const {} };
template <int LOG2L, bool INV, int GIO, class Hook = NoHook> __device__ __forceinline__ void fft_outer(LDSQ cpx* A, int t, hcpx* gio, const hcpx* pfsrc, PreRegs& pre, Hook hook = Hook()) {
    constexpr int R1 = LOG2L == 14 ? 32 : 16, S1 = LOG2L == 14 ? 512 : 128, S2 = LOG2L == 14 ? 16 : 8;
    if (!INV) { fft_pass<R1, S1, false, GIO == 3 ? 3 : 0>(A, t, nullptr, pre); __syncthreads(); fft_pass<R1, S2, false, 0>(A, t, nullptr, pre); GL_DRAIN(); __syncthreads(); }
    else      { fft_pass<R1, S2, true, 0>(A, t, nullptr, pre); __syncthreads();
                if (GIO == 2) fft_prefetch<R1, S1>(t, pfsrc, pre);
                hook();
                fft_pass<R1, S1, true, GIO == 2 ? 2 : 0>(A, t, gio, pre); if (GIO != 2) GL_DRAIN(); __syncthreads(); }
}
template <int LOG2L, int SRC, int DST, class Hook = NoHook> __device__ __forceinline__ void fft_conv(LDSQ cpx* A, int t, hcpx* spec, hcpx* gdst, const hcpx* pfsrc, PreRegs& pre, Hook hook = Hook()) {
    fft_outer<LOG2L, false, SRC>(A, t, nullptr, nullptr, pre);
    fft_mid<LOG2L == 14 ? 16 : 8, 1>(A, t, spec, 1.0f / (float)(1 << LOG2L));
    if (SRC == 3) GL_DRAIN();
    __syncthreads();
    fft_outer<LOG2L, true, DST>(A, t, gdst, pfsrc, pre, hook);
}

__device__ __forceinline__ void sconv4r(u32x2 q, unsigned zmr, unsigned zpr, float w0, float w1, float w2, float bb, float (&o)[4]) {
    const float zm = __uint_as_float(zmr << 16), zp = __uint_as_float(zpr << 16);
    const float z0 = __uint_as_float(q.x << 16), z1 = __uint_as_float(q.x & 0xffff0000u), z2 = __uint_as_float(q.y << 16), z3 = __uint_as_float(q.y & 0xffff0000u);
    o[0] = w0 * zm + w1 * z0 + w2 * z1 + bb; o[1] = w0 * z0 + w1 * z1 + w2 * z2 + bb; o[2] = w0 * z1 + w1 * z2 + w2 * z3 + bb; o[3] = w0 * z2 + w1 * z3 + w2 * zp + bb;
}
typedef _Float16 h4 __attribute__((ext_vector_type(4)));
__device__ __forceinline__ void tapquad(h4 a, h4 bq, unsigned b0bits, float wf, float wb, float rf1, float rf2, float rf3, float rb1, float rb2, float rb3, float (&fa)[4], float (&fb)[4]) {
    const float b0 = (float)__builtin_bit_cast(_Float16, (unsigned short)b0bits);
    fa[0] = (float)a.x * wf; fa[1] = (float)a.y * (wf * rf1); fa[2] = (float)a.z * (wf * rf2); fa[3] = (float)a.w * (wf * rf3);
    fb[0] = b0 * wb; fb[1] = (float)bq.w * (wb * rb1); fb[2] = (float)bq.z * (wb * rb2); fb[3] = (float)bq.y * (wb * rb3);
}
template <int LOG2L> struct SweepIdx {
    static constexpr int L = 1 << LOG2L, QS = L / 32;
    int t, seq, n00, a00; cpx wq0, w1, w2, w3;
    __device__ __forceinline__ SweepIdx(int t_, bool need_w) { t = t_; asm volatile("" : "+v"(t) :: "memory"); seq = (LOG2L == 14) ? 0 : (t >> 6); const int q0 = (LOG2L == 14) ? t : (t & 63); n00 = 4 * q0; a00 = seq * L + n00;
        if (need_w) { float sb, cb; sincospif(-(float)n00 / (float)L, &sb, &cb); wq0 = mkc(cb, sb);
            sincospif(-1.0f / (float)L, &sb, &cb); w1 = mkc(cb, sb); w2 = cmul(w1, w1); w3 = cmul(w2, w1); } }
};
#define WQS mkc(0.92387953251128674f, -0.38268343236508978f)
struct TapWin { float wf0, wfs, rf1, rf2, rf3, wb0, wbs, rb1, rb2, rb3; };
template <int LOG2L> __device__ __forceinline__ TapWin tap_windows(float df, float db, int n00) {
    constexpr int L = 1 << LOG2L, QS = L / 32; TapWin w;
    w.wf0 = expf(-df * (float)n00); w.wfs = expf(-df * (float)(4 * QS)); w.rf1 = expf(-df); w.rf2 = w.rf1 * w.rf1; w.rf3 = w.rf2 * w.rf1;
    w.wb0 = expf(-db * (float)(L - n00)); w.wbs = expf(db * (float)(4 * QS)); w.rb1 = expf(db); w.rb2 = w.rb1 * w.rb1; w.rb3 = w.rb2 * w.rb1; return w;
}
template <int LOG2L> __device__ __forceinline__ void sweep_taps2(LDSQ cpx* A, int t_, const _Float16* tf0, const _Float16* tb0, const _Float16* tf1, const _Float16* tb1, float df0, float db0, float df1, float db1, hcpx* hos, float& ss0, float& ss1) {
    constexpr int L = 1 << LOG2L, QS = L / 32; const SweepIdx<LOG2L> X(t_, true);
    const TapWin W0 = tap_windows<LOG2L>(df0, db0, X.n00), W1 = tap_windows<LOG2L>(df1, db1, X.n00);
    float s0 = 0.f, s1 = 0.f, wf0 = W0.wf0, wb0 = W0.wb0, wf1 = W1.wf0, wb1 = W1.wb0;
    cpx wn = X.wq0;
    h4 ra0[8], rb0[8], ra1[8], rb1[8]; unsigned rc0[8], rc1[8];
#pragma unroll
    for (int i = 0; i < 8; ++i) { const int n = 4 * (i * QS) + X.n00, nb = n > 0 ? L - n : L - 1;
        ra0[i] = *(const h4*)(tf0 + n); rb0[i] = *(const h4*)(tb0 + L - n - 4); rc0[i] = ((const unsigned short*)tb0)[nb];
        ra1[i] = *(const h4*)(tf1 + n); rb1[i] = *(const h4*)(tb1 + L - n - 4); rc1[i] = ((const unsigned short*)tb1)[nb]; }
#pragma unroll
    for (int i = 0; i < 8; ++i) { const int n = 4 * (i * QS) + X.n00; float fa0[4], fb0[4], fa1[4], fb1[4]; const unsigned hm = n > 0 ? 0xffffu : 0u;
        tapquad(ra0[i], rb0[i], rc0[i] & hm, wf0, wb0, W0.rf1, W0.rf2, W0.rf3, W0.rb1, W0.rb2, W0.rb3, fa0, fb0);
        tapquad(ra1[i], rb1[i], rc1[i] & hm, wf1, wb1, W1.rf1, W1.rf2, W1.rf3, W1.rb1, W1.rb2, W1.rb3, fa1, fb1);
        LDSQ cpx* ap = A + phys(X.a00 + 4 * i * QS); hcpx* hp = hos + X.a00 + 4 * i * QS;
#pragma unroll
        for (int e = 0; e < 4; ++e) { s0 += fa0[e] * fa0[e] + fb0[e] * fb0[e]; s1 += fa1[e] * fa1[e] + fb1[e] * fb1[e]; ap[e] = mkc(fa0[e] + fb0[e], fa1[e] + fb1[e]); }
        const cpx wa = cmul(wn, X.w1), wb2 = cmul(wn, X.w2), wc = cmul(wn, X.w3);
        const cpx y0 = cmul(mkc(fa0[0] - fb0[0], fa1[0] - fb1[0]), wn), y1 = cmul(mkc(fa0[1] - fb0[1], fa1[1] - fb1[1]), wa);
        const cpx y2 = cmul(mkc(fa0[2] - fb0[2], fa1[2] - fb1[2]), wb2), y3 = cmul(mkc(fa0[3] - fb0[3], fa1[3] - fb1[3]), wc);
        *(hcpx2*)hp = h2_of(y0, y1); *(hcpx2*)(hp + 2) = h2_of(y2, y3);
        wn = cmul(wn, WQS); wf0 *= W0.wfs; wb0 *= W0.wbs; wf1 *= W1.wfs; wb1 *= W1.wbs; }
    ss0 = s0; ss1 = s1;
}
template <int LOG2L, int PART> __device__ __forceinline__ void fft_mid_sep(LDSQ cpx* A, int t, hcpx* spec0, hcpx* spec1, const LDSQ float* red, const float* skp0, const float* skp1) {
    constexpr int R = LOG2L == 14 ? 16 : 8, G = 32 / R, NB = LOG2L == 14 ? 32 : 16, NG = NB * NB;
    asm volatile("" : "+v"(t) :: "memory");
#pragma unroll
    for (int gi = 0; gi < G; ++gi) {
        cpx v[R]; LDSQ cpx* Ab = A + phys((gi * 512 + t) * R);
#pragma unroll
        for (int j = 0; j < R; ++j) v[j] = Ab[j];
        dft_r2<R, false>(v);
#pragma unroll
        for (int k = 0; k < R; ++k) Ab[k] = v[brev<R>(k)];
    }
    __syncthreads();
#pragma unroll
    for (int gi = 0; gi < G; ++gi) {
        const int gam = gi * 512 + t, seq = gam / NG, g = gam % NG, k1 = g / NB, k2 = g % NB;
        const int gp = PART == 1 ? NG - 1 - g : (k1 ? (NB - k1) * NB + (NB - 1 - k2) : (k2 ? NB - k2 : 0));
        const bool wrap = PART == 0 && g == 0;
        const LDSQ cpx* Ab = A + phys(gam * R); const LDSQ cpx* Ap = A + phys((seq * NG + gp) * R);
        cpx z[R], q[R];
#pragma unroll
        for (int k = 0; k < R; ++k) { z[k] = Ab[k]; q[k] = Ap[k]; }
        float ss0, ss1;
        if (LOG2L == 14) { ss0 = red[0] + red[1] + red[2] + red[3] + red[4] + red[5] + red[6] + red[7]; ss1 = red[8] + red[9] + red[10] + red[11] + red[12] + red[13] + red[14] + red[15]; }
        else { ss0 = red[seq]; ss1 = red[8 + seq]; }
        const float n0 = 0.25f / sqrtf(ss0 + EPS), n1 = 0.25f / sqrtf(ss1 + EPS), h0 = 0.5f * skp0[seq], h1 = 0.5f * skp1[seq];
        hcpx* s0p = spec0 + 2 * (size_t)gam; hcpx* s1p = spec1 + 2 * (size_t)gam;
#pragma unroll
        for (int k2_ = 0; k2_ < R / 2; ++k2_) { cpx o0[2], o1[2];
#pragma unroll
            for (int e = 0; e < 2; ++e) { const int k = 2 * k2_ + e; cpx zp = q[R - 1 - k]; const cpx zw = q[(R - k) & (R - 1)];
                if (PART == 0) { zp.x = wrap ? zw.x : zp.x; zp.y = wrap ? zw.y : zp.y; }
                o0[e] = mkc((z[k].x + zp.x) * n0 + h0, (z[k].y - zp.y) * n0); o1[e] = mkc((z[k].y + zp.y) * n1 + h1, (zp.x - z[k].x) * n1); }
            *(hcpx2*)(s0p + 2 * (size_t)(k2_ * (16384 / R))) = h2_of(o0[0], o0[1]); *(hcpx2*)(s1p + 2 * (size_t)(k2_ * (16384 / R))) = h2_of(o1[0], o1[1]); }
    }
}
template <int LOG2L> __device__ __forceinline__ void sweep_load_v(LDSQ cpx* A, int t_, const bf16_t* zrow, size_t tb0, const float* cw, const float* cbias, int rc0, hcpx* xw) {
    constexpr int L = 1 << LOG2L, QS = L / 32; const SweepIdx<LOG2L> X(t_, true);
    const int rc = rc0 + X.seq; const float cw0 = cw[rc], cw1 = cw[6144 + rc], cw2 = cw[2 * 6144 + rc], bb = cbias[rc];
    const bf16_t* z0 = zrow + (size_t)rc * T + tb0; const bf16_t* z1 = z0 + L;
    cpx wn = X.wq0;
    u32x2 rq[8][2]; unsigned rm[8][2], rp[8][2];
#pragma unroll
    for (int i = 0; i < 8; ++i) { const int n = 4 * (i * QS) + X.n00, nm = n > 0 ? n - 1 : 0, np = n + 4 < L ? n + 4 : L - 1;
        rq[i][0] = *(const u32x2*)(z0 + n); rq[i][1] = *(const u32x2*)(z1 + n); rm[i][0] = z0[nm]; rm[i][1] = z1[nm]; rp[i][0] = z0[np]; rp[i][1] = z1[np]; }
#pragma unroll
    for (int i = 0; i < 8; ++i) { const int n = 4 * (i * QS) + X.n00; float xa[4], xb[4]; const unsigned hm = n > 0 ? 0xffffu : 0u, hp = n + 4 < L ? 0xffffu : 0u;
        sconv4r(rq[i][0], rm[i][0] & hm, rp[i][0] & hp, cw0, cw1, cw2, bb, xa); sconv4r(rq[i][1], rm[i][1] & hm, rp[i][1] & hp, cw0, cw1, cw2, bb, xb);
        LDSQ cpx* ap = A + phys(X.a00 + 4 * i * QS); hcpx* xp = xw + X.a00 + 4 * i * QS;
        ap[0] = mkc(xa[0], xb[0]); ap[1] = mkc(xa[1], xb[1]); ap[2] = mkc(xa[2], xb[2]); ap[3] = mkc(xa[3], xb[3]);
        const cpx y0 = cmul(mkc(xa[0], xb[0]), wn), y1 = cmul(mkc(xa[1], xb[1]), cmul(wn, X.w1)), y2 = cmul(mkc(xa[2], xb[2]), cmul(wn, X.w2)), y3 = cmul(mkc(xa[3], xb[3]), cmul(wn, X.w3));
        *(hcpx2*)xp = h2_of(y0, y1); *(hcpx2*)(xp + 2) = h2_of(y2, y3);
        wn = cmul(wn, WQS); }
}
constexpr int CPA = 2;
template <int N> struct CombPreN { u32x2 q[N][2]; unsigned zm[N][2], zp[N][2]; hcpx2 h01[N], h23[N]; };
typedef CombPreN<CPA> CombPre;
template <int LOG2L, int I0, int N> __device__ __forceinline__ void combine_prefetch(int t_, const hcpx* yes, const bf16_t* zrow, size_t tb0, int rg0, CombPreN<N>& P) {
    constexpr int L = 1 << LOG2L, QS = L / 32; const SweepIdx<LOG2L> X(t_, false);
    const int rg = rg0 + X.seq; const bf16_t* g0 = zrow + (size_t)rg * T + tb0; const bf16_t* g1 = g0 + L;
#pragma unroll
    for (int i = 0; i < N; ++i) { const int n = 4 * ((I0 + i) * QS) + X.n00; const hcpx* yp = yes + X.a00 + 4 * (I0 + i) * QS;
        P.q[i][0] = *(const u32x2*)(g0 + n); P.q[i][1] = *(const u32x2*)(g1 + n);
        const int nm = n > 0 ? n - 1 : 0, np = n + 4 < L ? n + 4 : L - 1;
        P.zm[i][0] = g0[nm]; P.zm[i][1] = g1[nm]; P.zp[i][0] = g0[np]; P.zp[i][1] = g1[np];
        P.h01[i] = __builtin_nontemporal_load((const hcpx2*)yp); P.h23[i] = __builtin_nontemporal_load((const hcpx2*)(yp + 2)); }
}
template <int LOG2L, int FINAL> __device__ __forceinline__ void sweep_combine(LDSQ cpx* A, int t_, const CombPre& P0, const hcpx* yes, hcpx* xw, bf16_t* zrow, size_t tb0, const float* cw, const float* cbias, int rg0, int ro0, int dry) {
    constexpr int L = 1 << LOG2L, QS = L / 32; const SweepIdx<LOG2L> X(t_, true);
    CombPreN<8 - CPA> P1; combine_prefetch<LOG2L, CPA>(X.t, yes, zrow, tb0, rg0, P1);
    const int rg = rg0 + X.seq; const float cw0 = cw[rg], cw1 = cw[6144 + rg], cw2 = cw[2 * 6144 + rg], bb = cbias[rg];
    bf16_t* o0 = zrow + (size_t)(ro0 + X.seq) * T + tb0; bf16_t* o1 = o0 + L;
    cpx wn = X.wq0;
#pragma unroll
    for (int i = 0; i < 8; ++i) { const int n = 4 * (i * QS) + X.n00; float ga[4], gb[4];
        const bool ah = i < CPA; const int ia = ah ? i : 0, ib = ah ? 0 : i - CPA;
        const unsigned hm = n > 0 ? 0xffffu : 0u, hp = n + 4 < L ? 0xffffu : 0u;
        sconv4r(ah ? P0.q[ia][0] : P1.q[ib][0], (ah ? P0.zm[ia][0] : P1.zm[ib][0]) & hm, (ah ? P0.zp[ia][0] : P1.zp[ib][0]) & hp, cw0, cw1, cw2, bb, ga);
        sconv4r(ah ? P0.q[ia][1] : P1.q[ib][1], (ah ? P0.zm[ia][1] : P1.zm[ib][1]) & hm, (ah ? P0.zp[ia][1] : P1.zp[ib][1]) & hp, cw0, cw1, cw2, bb, gb);
        const LDSQ cpx* ap = A + phys(X.a00 + 4 * i * QS);
        const hcpx2 h01 = ah ? P0.h01[ia] : P1.h01[ib], h23 = ah ? P0.h23[ia] : P1.h23[ib];
        const f32x4 e01 = {(float)h01.x, (float)h01.y, (float)h01.z, (float)h01.w}, e23 = {(float)h23.x, (float)h23.y, (float)h23.z, (float)h23.w};
        const cpx wa = cmul(wn, X.w1), wb2 = cmul(wn, X.w2), wc = cmul(wn, X.w3);
        const cpx r0 = cmulc(ap[0], wn), r1 = cmulc(ap[1], wa), r2 = cmulc(ap[2], wb2), r3 = cmulc(ap[3], wc);
        const cpx s0 = mkc(ga[0] * (e01[0] + r0.x), gb[0] * (e01[1] + r0.y)), s1 = mkc(ga[1] * (e01[2] + r1.x), gb[1] * (e01[3] + r1.y));
        const cpx s2 = mkc(ga[2] * (e23[0] + r2.x), gb[2] * (e23[1] + r2.y)), s3 = mkc(ga[3] * (e23[2] + r3.x), gb[3] * (e23[3] + r3.y));
        if (FINAL == 0) { LDSQ cpx* aw = A + phys(X.a00 + 4 * i * QS); hcpx* xp = xw + X.a00 + 4 * i * QS;
            aw[0] = s0; aw[1] = s1; aw[2] = s2; aw[3] = s3;
            const cpx y0 = cmul(s0, wn), y1 = cmul(s1, wa), y2 = cmul(s2, wb2), y3 = cmul(s3, wc);
            *(hcpx2*)xp = h2_of(y0, y1); *(hcpx2*)(xp + 2) = h2_of(y2, y3); }
        else if (!dry) { u32x2 wa2, wb3; wa2.x = cvt_pk_bf16(s0.x, s1.x); wa2.y = cvt_pk_bf16(s2.x, s3.x); wb3.x = cvt_pk_bf16(s0.y, s1.y); wb3.y = cvt_pk_bf16(s2.y, s3.y);
            *(u32x2*)(o0 + n) = wa2; *(u32x2*)(o1 + n) = wb3; }
        wn = cmul(wn, WQS); }
}
template <int LOG2L> __device__ __forceinline__ void hyena_item(const Params& p, LDSQ unsigned char* lds, int layer_j, int c0, int dry) {
    constexpr int L = 1 << LOG2L, NPAIR = (LOG2L == 14) ? 1 : 2;
    constexpr int TOK0 = (LOG2L == 14) ? 0 : T_P, PB = (LOG2L == 14) ? 0 : 16384;
    LDSQ cpx* A = (LDSQ cpx*)lds;
    LDSQ float* red = (LDSQ float*)(lds + 135168);
    const int t = pg8::otid(), ch = c0 + ((LOG2L == 14) ? 0 : (t >> 6));
    bf16_t* zin = (bf16_t*)(p.ws + WS_BIG + BIG_ZINT);
    const _Float16* taps = (const _Float16*)(p.ws + WS_BIG + BIG_TAPS);
    hcpx* scr = (hcpx*)(p.ws + WS_H + (size_t)pg8::obid() * FFT_SCR_PER_WG);
    hcpx* u1s = scr + (size_t)4 * 16384;
    hcpx* yes = (hcpx*)(p.ws + WS_END + (size_t)pg8::obid() * FFT_EXT_PER_WG);
    PreRegs pre;
    hcpx* xw = yes + 16384;
    {
        const _Float16* tf0 = taps + (size_t)(0 * 2048 + ch) * NPOS + PB; const _Float16* tb0 = taps + (size_t)(1 * 2048 + ch) * NPOS + PB;
        const _Float16* tf1 = taps + (size_t)(2 * 2048 + ch) * NPOS + PB; const _Float16* tb1 = taps + (size_t)(3 * 2048 + ch) * NPOS + PB;
        const float* dec = p.hy_decay + (size_t)layer_j * 8192 + ch;
        const float df0 = fabsf(dec[0]) * (1.0f / (float)(L - 1)), db0 = fabsf(dec[2048]) * (1.0f / (float)(L - 1));
        const float df1 = fabsf(dec[4096]) * (1.0f / (float)(L - 1)), db1 = fabsf(dec[6144]) * (1.0f / (float)(L - 1));
        float ss0, ss1;
        sweep_taps2<LOG2L>(A, t, tf0, tb0, tf1, tb1, df0, db0, df1, db1, xw, ss0, ss1);
        ss0 = wave_sum(ss0); ss1 = wave_sum(ss1);
        if ((t & 63) == 0) { red[t >> 6] = ss0; red[8 + (t >> 6)] = ss1; }
        __syncthreads();
        const float* skp0 = p.hy_skip + (size_t)layer_j * 2 * 2048 + c0; const float* skp1 = skp0 + 2048;
        fft_outer<LOG2L, false, 0>(A, t, nullptr, nullptr, pre);
        fft_prefetch<LOG2L == 14 ? 32 : 16, LOG2L == 14 ? 512 : 128>(t, xw, pre);
        fft_mid_sep<LOG2L, 0>(A, t, scr + (size_t)0 * 16384, scr + (size_t)2 * 16384, red, skp0, skp1); __syncthreads();
        fft_outer<LOG2L, false, 3>(A, t, nullptr, nullptr, pre);
        fft_mid_sep<LOG2L, 1>(A, t, scr + (size_t)1 * 16384, scr + (size_t)3 * 16384, red, skp0, skp1); __syncthreads();
    }
    const float* cw = p.hy_conv_w + (size_t)layer_j * 3 * 6144; const float* cbias = p.hy_conv_b + (size_t)layer_j * 6144;
#pragma unroll 1
    for (int pr = 0; pr < NPAIR; ++pr) {
        const size_t tb0 = (size_t)TOK0 + (size_t)(2 * pr) * L;
        sweep_load_v<LOG2L>(A, t, zin, tb0, cw, cbias, 2 * 2048 + c0, xw); __syncthreads();
        fft_conv<LOG2L, 0, 2>(A, t, scr + (size_t)0 * 16384, yes, xw, pre);
        CombPre cp;
        fft_conv<LOG2L, 3, 0>(A, t, scr + (size_t)1 * 16384, nullptr, nullptr, pre, [&]() { combine_prefetch<LOG2L, 0>(t, yes, zin, tb0, c0, cp); });
        sweep_combine<LOG2L, 0>(A, t, cp, yes, xw, zin, tb0, cw, cbias, c0, c0, dry); __syncthreads();
        fft_conv<LOG2L, 0, 2>(A, t, scr + (size_t)2 * 16384, yes, xw, pre);
        fft_conv<LOG2L, 3, 0>(A, t, scr + (size_t)3 * 16384, nullptr, nullptr, pre, [&]() { combine_prefetch<LOG2L, 0>(t, yes, zin, tb0, 2048 + c0, cp); });
        sweep_combine<LOG2L, 1>(A, t, cp, yes, xw, zin, tb0, cw, cbias, 2048 + c0, c0, dry); __syncthreads();
    }
}
__device__ __forceinline__ void hyena_conv_phase(const Params& p, LDSQ unsigned char* lds, int layer_j, int dry) {
    { LDSQ cpx* TW = (LDSQ cpx*)(lds + TW_OFF);
      for (int e = pg8::otid(); e < 1024; e += NTHR) { float sn, cs; sincospif(-2.0f * (float)e / 16384.0f, &sn, &cs); TW[e] = mkc(cs, sn); }
      __syncthreads(); }
    for (int it = pg8::obid(); it < 2048; it += pg8::ogrid()) hyena_item<14>(p, lds, layer_j, it, dry);
    for (int it = pg8::obid(); it < 256; it += pg8::ogrid()) hyena_item<11>(p, lds, layer_j, it * 8, dry);
}

__device__ __forceinline__ void attn_phase(const Params& p, LDSQ unsigned char* lds, int dry = 0) {
    constexpr int KROW = 272, VROW = 264;
    LDSQ unsigned char* Kl = lds; LDSQ bf16_t* VT = (LDSQ bf16_t*)(lds + 256 * KROW);
    const bf16_t* qkv = (const bf16_t*)(p.ws + WS_BIG + BIG_QKV);
    bf16_t* og = (bf16_t*)(p.ws + WS_BIG + BIG_OG); float* lse = (float*)(p.ws + WS_BIG + BIG_LSE);
    const int tid = pg8::otid(), lane = tid & 63, wid = __builtin_amdgcn_readfirstlane(tid >> 6), l15 = lane & 15, g4 = lane >> 4;
    const int blk = wid >> 2, qq = 16 * (wid & 3) + l15;
    for (int u = pg8::obid(); u < 1792 + 512; u += pg8::ogrid()) {
        const int it = u < 1792 ? 4 * u : 7168 + (u - 1792), len = u < 1792 ? 4 : 1;
        int g, b, hh, rho, pp0, L, tokbase;
        if (it < 6144) { g = it >> 11; const int rem = it & 2047; const int npp = 128 >> (2 * g); pp0 = rem % npp; rho = (rem / npp) & ((1 << (2 * g)) - 1); hh = (rem >> 7) & 7; b = rem >> 10; L = L_P; tokbase = 0; }
        else { const int i2 = it - 6144; g = i2 >> 9; const int rem = i2 & 511; const int npp = 16 >> (2 * g); pp0 = rem % npp; rho = (rem / npp) & ((1 << (2 * g)) - 1); hh = (rem >> 4) & 7; b = rem >> 7; L = L_S; tokbase = T_P; }
        const int rsh = 2 * g, n = L >> rsh;
        const size_t tok0 = (size_t)tokbase + (size_t)b * L + rho;
        const int qcol = g * 3072 + hh * 128, kcol = qcol + 1024, vcol = qcol + 2048;
        u32x4 kr[2][4], vr[2][4];
        auto request_half = [&](int ih, u32x4 (&kh)[4], u32x4 (&vh)[4]) {
#pragma unroll
            for (int s4 = 0; s4 < 4; ++s4) { const int ci = tid + 512 * s4;
                { const int slot = ci >> 4, chn = ci & 15, i = ih + slot, ic = i < 0 ? 0 : (i < n ? i : n - 1); kh[s4] = *(const u32x4*)(qkv + (tok0 + ((size_t)ic << rsh)) * QKVW + kcol + chn * 8); }
                { const int slot = (ci & 15) + 16 * ((ci >> 6) & 7), chn = ((ci >> 4) & 3) + 4 * (ci >> 9), i = ih + slot, ic = i < 0 ? 0 : (i < n ? i : n - 1); vh[s4] = *(const u32x4*)(qkv + (tok0 + ((size_t)ic << rsh)) * QKVW + vcol + chn * 8); } } };
        auto stage_half = [&](int ih, int ring0, const u32x4 (&kh)[4], const u32x4 (&vh)[4]) {
#pragma unroll
            for (int s4 = 0; s4 < 4; ++s4) { const int ci = tid + 512 * s4;
                { const int slot = ci >> 4, chn = ci & 15, i = ih + slot; const unsigned ok = (i >= 0 && i < n) ? 0xffffffffu : 0u;
                  u32x4 v = kh[s4]; v.x &= ok; v.y &= ok; v.z &= ok; v.w &= ok;
                  *(LDSQ u32x4*)(Kl + (ring0 + slot) * KROW + chn * 16) = v; }
                { const int slot = (ci & 15) + 16 * ((ci >> 6) & 7), chn = ((ci >> 4) & 3) + 4 * (ci >> 9), i = ih + slot; const unsigned ok = (i >= 0 && i < n) ? 0xffffffffu : 0u;
                  u32x4 v = vh[s4]; v.x &= ok; v.y &= ok; v.z &= ok; v.w &= ok;
                  LDSQ bf16_t* vp = VT + (32 * (chn >> 2) + 4 * (chn & 3)) * VROW + ring0 + slot;
                  vp[0] = (bf16_t)(v.x & 0xffffu); vp[VROW] = (bf16_t)(v.x >> 16); vp[2 * VROW] = (bf16_t)(v.y & 0xffffu); vp[3 * VROW] = (bf16_t)(v.y >> 16);
                  vp[16 * VROW] = (bf16_t)(v.z & 0xffffu); vp[17 * VROW] = (bf16_t)(v.z >> 16); vp[18 * VROW] = (bf16_t)(v.w & 0xffffu); vp[19 * VROW] = (bf16_t)(v.w >> 16); } } };
        request_half(128 * pp0 - 64, kr[0], vr[0]); request_half(128 * pp0 + 64, kr[1], vr[1]);
#pragma unroll 1
        for (int s = 0; s < len; ++s) {
            const int pp = pp0 + s, i0 = 128 * pp - 64, off = (128 * pp) & 255;
            const int qi = 128 * pp + 64 * blk + qq;
            const size_t tq = tok0 + ((size_t)qi << rsh);
            bf16x8 bq[4];
#pragma unroll
            for (int ks = 0; ks < 4; ++ks) bq[ks] = *(const bf16x8*)(qkv + tq * QKVW + qcol + 32 * ks + 8 * g4);
            if (s == 0) stage_half(i0, off, kr[0], vr[0]);
            stage_half(i0 + 128, (128 + off) & 255, kr[1], vr[1]);
            __syncthreads();
            const int ktb = wid & 3;
            f32x4 sc[10]; bf16x8 kf[2][4];
            auto kload = [&](int j, bf16x8 (&f)[4]) { const int rb = (64 * blk + 16 * (ktb + j) + off) & 255;
#pragma unroll
                for (int ks = 0; ks < 4; ++ks) f[ks] = *(const LDSQ bf16x8*)(Kl + (rb + l15) * KROW + (32 * ks + 8 * g4) * 2); };
            kload(0, kf[0]);
#pragma unroll
            for (int j = 0; j < 9; ++j) {
                if (j + 1 < 9) kload(j + 1, kf[(j + 1) & 1]);
                __builtin_amdgcn_sched_barrier(0);
                f32x4 a = {0.f, 0.f, 0.f, 0.f};
#pragma unroll
                for (int ks = 0; ks < 4; ++ks) a = __builtin_amdgcn_mfma_f32_16x16x32_bf16(kf[j & 1][ks], bq[ks], a, 0, 0, 0);
                sc[j] = a;
                __builtin_amdgcn_sched_barrier(0); }
            if (s + 1 < len) request_half(i0 + 256, kr[1], vr[1]);
            const int ibase = 128 * pp + 64 * blk - 64;
            const int klo = qq > -ibase ? qq : -ibase, khi = (qq + 128 < n - 1 - ibase) ? qq + 128 : n - 1 - ibase;
            const unsigned kspan = (unsigned)(khi - klo); const int kk0 = 4 * g4 - klo + 16 * ktb;
            float mx = -3.0e38f;
#pragma unroll
            for (int j = 0; j < 9; ++j)
#pragma unroll
                for (int r = 0; r < 4; ++r) { const bool ok = (unsigned)(kk0 + 16 * j + r) <= kspan;
                    sc[j][r] = ok ? sc[j][r] : -3.0e38f; mx = fmaxf(mx, sc[j][r]); }
            mx = fmaxf(mx, __shfl_xor(mx, 16)); mx = fmaxf(mx, __shfl_xor(mx, 32));
            float ls = 0.f;
#pragma unroll
            for (int j = 0; j < 9; ++j)
#pragma unroll
                for (int r = 0; r < 4; ++r) { const float e = __builtin_amdgcn_exp2f(sc[j][r] - mx); sc[j][r] = e; ls += e; }
            sc[9] = (f32x4){0.f, 0.f, 0.f, 0.f};
            ls += __shfl_xor(ls, 16); ls += __shfl_xor(ls, 32);
            f32x4 oa[8];
#pragma unroll
            for (int dt = 0; dt < 8; ++dt) oa[dt] = (f32x4){0.f, 0.f, 0.f, 0.f};
            u32x2 vf[2][4][2];
            auto vload = [&](int gidx, u32x2 (&f)[4][2]) { const int k2 = gidx >> 1, d0 = (gidx & 1) * 4;
                const int cb0 = (64 * blk + 16 * ktb + 32 * k2 + off) & 255, cb1 = (cb0 + 16) & 255;
#pragma unroll
                for (int d = 0; d < 4; ++d) { const LDSQ bf16_t* vq = VT + (16 * (d0 + d) + l15) * VROW + 4 * g4; f[d][0] = *(const LDSQ u32x2*)(vq + cb0); f[d][1] = *(const LDSQ u32x2*)(vq + cb1); } };
            vload(0, vf[0]);
#pragma unroll
            for (int gidx = 0; gidx < 10; ++gidx) { const int k2 = gidx >> 1, d0 = (gidx & 1) * 4;
                if (gidx + 1 < 10) vload(gidx + 1, vf[(gidx + 1) & 1]);
                __builtin_amdgcn_sched_barrier(0);
                union { u32x4 u; bf16x8 h; } pb;
                pb.u.x = cvt_pk_bf16(sc[2 * k2][0], sc[2 * k2][1]); pb.u.y = cvt_pk_bf16(sc[2 * k2][2], sc[2 * k2][3]);
                pb.u.z = cvt_pk_bf16(sc[2 * k2 + 1][0], sc[2 * k2 + 1][1]); pb.u.w = cvt_pk_bf16(sc[2 * k2 + 1][2], sc[2 * k2 + 1][3]);
#pragma unroll
                for (int d = 0; d < 4; ++d) { union { u32x4 u; bf16x8 h; } va; const u32x2 lo = vf[gidx & 1][d][0], hi = vf[gidx & 1][d][1];
                    va.u.x = lo.x; va.u.y = lo.y; va.u.z = hi.x; va.u.w = hi.y;
                    oa[d0 + d] = __builtin_amdgcn_mfma_f32_16x16x32_bf16(va.h, pb.h, oa[d0 + d], 0, 0, 0); }
                __builtin_amdgcn_sched_barrier(0); }
            const float inv = 1.0f / ls;
            const size_t gt = (size_t)g * T + tq;
#pragma unroll
            for (int q = 0; q < 4; ++q) { u32x4 w; w.x = cvt_pk_bf16(oa[2 * q][0] * inv, oa[2 * q][1] * inv); w.y = cvt_pk_bf16(oa[2 * q][2] * inv, oa[2 * q][3] * inv);
                w.z = cvt_pk_bf16(oa[2 * q + 1][0] * inv, oa[2 * q + 1][1] * inv); w.w = cvt_pk_bf16(oa[2 * q + 1][2] * inv, oa[2 * q + 1][3] * inv);
                if (!dry) *(u32x4*)(og + gt * 1024 + hh * 128 + 32 * q + 8 * g4) = w; }
            if (g4 == 0 && !dry) lse[gt * 8 + hh] = mx + log2f(ls);
            __syncthreads();
        }
    }
}
__device__ __forceinline__ void attn_merge_phase(const Params& p) {
    const bf16_t* og = (const bf16_t*)(p.ws + WS_BIG + BIG_OG); const float* lse = (const float*)(p.ws + WS_BIG + BIG_LSE); bf16_t* H = (bf16_t*)(p.ws + WS_H);
    const int stride = pg8::ogrid() * NTHR;
    for (int i0 = pg8::obid() * NTHR + pg8::otid(); i0 < T * 128; i0 += 4 * stride) {
        u32x4 v0[4], v1[4], v2[4]; float l0[4], l1[4], l2[4];
#pragma unroll
        for (int u = 0; u < 4; ++u) { const int i = i0 + u * stride; if (i < T * 128) { const int tok = i >> 7, c8 = i & 127, hh = c8 >> 4;
            l0[u] = lse[(size_t)tok * 8 + hh]; l1[u] = lse[((size_t)T + tok) * 8 + hh]; l2[u] = lse[((size_t)2 * T + tok) * 8 + hh];
            v0[u] = *(const u32x4*)(og + (size_t)tok * 1024 + c8 * 8); v1[u] = *(const u32x4*)(og + ((size_t)T + tok) * 1024 + c8 * 8); v2[u] = *(const u32x4*)(og + ((size_t)2 * T + tok) * 1024 + c8 * 8); } }
#pragma unroll
        for (int u = 0; u < 4; ++u) { const int i = i0 + u * stride; if (i < T * 128) { const int tok = i >> 7, c8 = i & 127;
            const float m = fmaxf(l0[u], fmaxf(l1[u], l2[u])); float a0 = exp2f(l0[u] - m), a1 = exp2f(l1[u] - m), a2 = exp2f(l2[u] - m); const float is = 1.0f / (a0 + a1 + a2); a0 *= is; a1 *= is; a2 *= is;
            u32x4 w;
#pragma unroll
            for (int e = 0; e < 4; ++e) { const float lo = a0 * __uint_as_float(v0[u][e] << 16) + a1 * __uint_as_float(v1[u][e] << 16) + a2 * __uint_as_float(v2[u][e] << 16);
                const float hi = a0 * __uint_as_float(v0[u][e] & 0xffff0000u) + a1 * __uint_as_float(v1[u][e] & 0xffff0000u) + a2 * __uint_as_float(v2[u][e] & 0xffff0000u);
                w[e] = cvt_pk_bf16(lo, hi); }
            *(u32x4*)(H + (size_t)tok * 1024 + c8 * 8) = w; } }
    }
}

constexpr int NPHASE = 35;
typedef const __attribute__((address_space(4))) unsigned char* KARG;
template <class Tp> __device__ __forceinline__ Tp karg(int byte_off) { return *(volatile const __attribute__((address_space(4))) Tp*)((KARG)__builtin_amdgcn_kernarg_segment_ptr() + byte_off); }
#define PA(q, member) q.member = karg<decltype(Params::member)>((int)__builtin_offsetof(Params, member))
__global__ void __launch_bounds__(512, 2) mega(Params parg) {
    extern __shared__ __attribute__((aligned(16))) unsigned char shm[];
    LDSQ unsigned char* lds = (LDSQ unsigned char*)shm;
    const int tid = pg8::otid();
    volatile LDSQ unsigned* misc = (volatile LDSQ unsigned*)(lds + LDS_MISC);
    if (tid < 8) misc[tid] = 0u;
    __syncthreads();
    const int ph_lo = parg.ph_lo, ph_hi = parg.ph_hi, probe = parg.probe;
#define REPS(bit, lay) (1 + (1 + ((probe >> 15) & 1)) * (((probe >> (bit)) & 1) & ((((probe >> 10) & 3) == 0) | ((probe >> (10 + ((lay) & 1))) & 1))))
    XcdBarrier bar; bar.bar = nullptr; bar.x = 0; bar.st = misc;
    if (ph_hi - ph_lo > 1) { Params q{}; PA(q, ws); bar = xcd_barrier_post((unsigned*)(q.ws + WS_CTL), misc); }
#define IN(k) (ph_lo <= (k) && (k) < ph_hi)
#define REPBAR() do { if (((probe >> 16) & 1) && rep + 1 < nrep) { Params qb{}; PA(qb, ws); bar.bar = (unsigned*)(qb.ws + WS_CTL); xcd_barrier(bar); } } while (0)
#define SEAM(k) do { if (IN(k) && IN((k) + 1)) { Params qb{}; PA(qb, ws); bar.bar = (unsigned*)(qb.ws + WS_CTL); xcd_barrier(bar); if ((probe >> 12) & 1) { xcd_barrier(bar); xcd_barrier(bar); } } } while (0)

    for (int rep = 0, nrep = REPS(0, 0); rep < nrep; ++rep)
    if (IN(0)) { Params q{}; PA(q, ws); PA(q, c_prompt); PA(q, c_sample); PA(q, ada_w); PA(q, final_ada_w); ada_partials(q, lds); rope_table(q);
                 PA(q, hy_fw1); PA(q, hy_fb1); PA(q, hy_ffreq); PA(q, hy_fw2); PA(q, hy_fb2); PA(q, hy_fw3); filter_mlp(q); }
    SEAM(0);
    for (int rep = 0, nrep = REPS(0, 0); rep < nrep; ++rep)
    if (IN(1)) { Params q{}; PA(q, ws); PA(q, ada_b); PA(q, final_ada_b); ada_reduce(q); }
    SEAM(1);
#pragma unroll 1
    for (int layer = 0; layer < 4; ++layer) {
        const int pb = 2 + 8 * layer, j = layer >> 1; const bool hy = (layer & 1) == 0;
        for (int rep = 0, nrep = REPS(1, layer); rep < nrep; ++rep)
        if (IN(pb + 0)) {
            Params q{}; PA(q, ws); unsigned char* wl = q.ws + WS_WL;
            PA(q, ffn_w_gate); convert_T(lds, q.ffn_w_gate + (size_t)layer * 2048 * DFF, 2048, DFF, (bf16_t*)(wl + WL_FFN1), 0);
            PA(q, ffn_w_up);   convert_T(lds, q.ffn_w_up + (size_t)layer * 2048 * DFF, 2048, DFF, (bf16_t*)(wl + WL_FFN1), 1);
            PA(q, ffn_w_down); convert_T(lds, q.ffn_w_down + (size_t)layer * DFF * 2048, DFF, 2048, (bf16_t*)(wl + WL_FFN2), -1);
            if (hy) { PA(q, hy_w_in);  convert_T(lds, q.hy_w_in + (size_t)j * 2048 * 6144, 2048, 6144, (bf16_t*)(wl + WL_MIXIN), -1);
                      PA(q, hy_w_out); convert_T(lds, q.hy_w_out + (size_t)j * 2048 * 2048, 2048, 2048, (bf16_t*)(wl + WL_MIXOUT), -1); }
            else    { PA(q, at_w_in);  convert_T(lds, q.at_w_in + (size_t)j * 2048 * QKVW, 2048, QKVW, (bf16_t*)(wl + WL_MIXIN), -1);
                      PA(q, at_w_out); convert_T(lds, q.at_w_out + (size_t)j * 1024 * 2048, 1024, 2048, (bf16_t*)(wl + WL_MIXOUT), -1); }
            PA(q, norm_mix);
            const float* modl = (const float*)(q.ws + WS_MOD) + layer * 12288;
            if (layer == 0) { PA(q, x_prompt); PA(q, x_sample); norm_rows<false, true>(q.x_prompt, q.x_sample, (bf16_t*)(q.ws + WS_XB), q.norm_mix + layer * 2048, modl, 0, 2048, (bf16_t*)(q.ws + WS_H), nullptr); }
            else            norm_rows<false, false>(nullptr, nullptr, (bf16_t*)(q.ws + WS_XB), q.norm_mix + layer * 2048, modl, 0, 2048, (bf16_t*)(q.ws + WS_H), nullptr);
            if (hy) { __syncthreads();
                pg8::Gemm g{(const bf16_t*)(q.ws + WS_W3X) + (size_t)j * 8192 * 256, (const bf16_t*)(q.ws + WS_A2X) + (size_t)j * NPOS * 256, 8192, NPOS, 256};
                pg8::StaticOrder S; S.init(8192, NPOS, pg8::ogrid(), pg8::obid());
                EpiTaps E{(_Float16*)(q.ws + WS_BIG + BIG_TAPS)};
                pg8::gemm_phase<EpiTaps, pg8::StaticOrder, false>(lds, g, S, E, nullptr); }
        }
        SEAM(pb + 0);
        for (int rep = 0, nrep = REPS(2, layer); rep < nrep; ++rep)
        if (IN(pb + 1)) {
            Params q{}; PA(q, ws);
            if (hy) { PA(q, hy_b_in); pg8::Gemm g{(const bf16_t*)(q.ws + WS_WL + WL_MIXIN), (const bf16_t*)(q.ws + WS_H), 6144, T, 2048}; pg8::StaticOrder S; S.init(6144, T, pg8::ogrid(), pg8::obid());
                EpiZinT E{(bf16_t*)(q.ws + WS_BIG + BIG_ZINT), T, q.hy_b_in + (size_t)j * 6144};
                pg8::gemm_phase<EpiZinT, pg8::StaticOrder, false>(lds, g, S, E, nullptr); }
            else { pg8::Gemm g{(const bf16_t*)(q.ws + WS_H), (const bf16_t*)(q.ws + WS_WL + WL_MIXIN), T, QKVW, 2048}; pg8::StaticOrder S; S.init(T, QKVW, pg8::ogrid(), pg8::obid());
                EpiQKV E{(bf16_t*)(q.ws + WS_BIG + BIG_QKV), (const cpx*)(q.ws + WS_ROPE)};
                pg8::gemm_phase<EpiQKV, pg8::StaticOrder, false>(lds, g, S, E, nullptr); }
            REPBAR();
        }
        SEAM(pb + 1);
        for (int rep = 0, nrep = REPS(3, layer); rep < nrep; ++rep)
        if (IN(pb + 2)) { Params q{}; PA(q, ws); if (hy) { PA(q, hy_skip); PA(q, hy_conv_w); PA(q, hy_conv_b); PA(q, hy_decay); hyena_conv_phase(q, lds, j, rep + 1 < nrep); } else attn_phase(q, lds, (rep + 1 < nrep) ? (1 | ((probe >> 12) & 2)) : 0); }
        SEAM(pb + 2);
        for (int rep = 0, nrep = REPS(4, layer); rep < nrep; ++rep)
        if (IN(pb + 3)) { Params q{}; PA(q, ws); if (hy) transpose_phase(q, lds); else attn_merge_phase(q); }
        SEAM(pb + 3);
        for (int rep = 0, nrep = REPS(5, layer); rep < nrep; ++rep)
        if (IN(pb + 4)) {
            Params q{}; PA(q, ws); PA(q, hy_b_out);
            pg8::Gemm g{(const bf16_t*)(q.ws + WS_H), (const bf16_t*)(q.ws + WS_WL + WL_MIXOUT), T, 2048, hy ? 2048 : 1024}; pg8::StaticOrder S; S.init(T, 2048, pg8::ogrid(), pg8::obid());
            EpiRes E{(bf16_t*)(q.ws + WS_XB), hy ? q.hy_b_out + (size_t)j * 2048 : nullptr, (const float*)(q.ws + WS_MOD) + layer * 12288 + 4096, rep + 1 < nrep};
            pg8::gemm_phase<EpiRes, pg8::StaticOrder, false>(lds, g, S, E, nullptr);
            REPBAR();
        }
        SEAM(pb + 4);
        for (int rep = 0, nrep = REPS(6, layer); rep < nrep; ++rep)
        if (IN(pb + 5)) { Params q{}; PA(q, ws); PA(q, norm_ffn);
            norm_rows<false, false>(nullptr, nullptr, (bf16_t*)(q.ws + WS_XB), q.norm_ffn + layer * 2048, (const float*)(q.ws + WS_MOD) + layer * 12288, 6144, 8192, (bf16_t*)(q.ws + WS_H), nullptr); }
        SEAM(pb + 5);
        for (int rep = 0, nrep = REPS(7, layer); rep < nrep; ++rep)
        if (IN(pb + 6)) {
            Params q{}; PA(q, ws);
            pg8::Gemm g{(const bf16_t*)(q.ws + WS_H), (const bf16_t*)(q.ws + WS_WL + WL_FFN1), T, 2 * DFF, 2048}; pg8::StaticOrder S; S.init(T, 2 * DFF, pg8::ogrid(), pg8::obid());
            EpiFFN1 E{(bf16_t*)(q.ws + WS_BIG + BIG_MID)};
            pg8::gemm_phase<EpiFFN1, pg8::StaticOrder, false>(lds, g, S, E, nullptr);
            REPBAR();
        }
        SEAM(pb + 6);
        for (int rep = 0, nrep = REPS(8, layer); rep < nrep; ++rep)
        if (IN(pb + 7)) {
            Params q{}; PA(q, ws);
            pg8::Gemm g{(const bf16_t*)(q.ws + WS_BIG + BIG_MID), (const bf16_t*)(q.ws + WS_WL + WL_FFN2), T, 2048, DFF}; pg8::StaticOrder S; S.init(T, 2048, pg8::ogrid(), pg8::obid());
            EpiRes E{(bf16_t*)(q.ws + WS_XB), nullptr, (const float*)(q.ws + WS_MOD) + layer * 12288 + 10240, rep + 1 < nrep};
            pg8::gemm_phase<EpiRes, pg8::StaticOrder, false>(lds, g, S, E, nullptr);
            REPBAR();
        }
        SEAM(pb + 7);
    }
    if (IN(34)) { Params q{}; PA(q, ws); PA(q, out); PA(q, final_norm); final_norm_phase(q); }
#undef REPS
#undef IN
#undef SEAM
}
}

extern "C" void kernel_launch(void* const* d_in, const int* in_sizes, int n_in, void* d_out, int out_size, void* d_ws, size_t ws_size, hipStream_t stream) {
    static int grid = 0;
    if (grid == 0) {
        if (n_in != 30 || out_size != mk::T * mk::D || ws_size < mk::WS_TOTAL) { fprintf(stderr, "kernel_launch: unexpected shapes (n_in %d out %d ws %zu need %zu); nothing launched\n", n_in, out_size, ws_size, (size_t)mk::WS_TOTAL); grid = -1; return; }
        int dev = 0, cus = 0;
        if (hipGetDevice(&dev) != hipSuccess || hipDeviceGetAttribute(&cus, hipDeviceAttributeMultiprocessorCount, dev) != hipSuccess) { grid = -1; return; }
        if (hipFuncSetAttribute((const void*)mk::mega, hipFuncAttributeMaxDynamicSharedMemorySize, mk::LDS_BYTES) != hipSuccess) { fprintf(stderr, "kernel_launch: hipFuncSetAttribute failed\n"); grid = -1; return; }
        int per_cu = 0; (void)hipOccupancyMaxActiveBlocksPerMultiprocessor(&per_cu, (const void*)mk::mega, 512, mk::LDS_BYTES); (void)hipGetLastError();
        if (per_cu < 1) fprintf(stderr, "kernel_launch: occupancy query reports %d blocks per CU\n", per_cu);
        grid = cus > 256 ? 256 : cus;
    }
    if (grid < 0) return;
    mk::Params p{};
    const float** f = (const float**)&p;
    for (int i = 0; i < 30; ++i) f[i] = (const float*)d_in[i];
    p.out = (float*)d_out; p.ws = (unsigned char*)d_ws; p.probe = MK_PROBE;
#if MK_PER_PHASE
    for (int k = 0; k < mk::NPHASE; ++k) { p.ph_lo = k; p.ph_hi = k + 1; hipLaunchKernelGGL(mk::mega, dim3(grid), dim3(512), mk::LDS_BYTES, stream, p); }
#else
    (void)hipMemsetAsync((char*)d_ws + mk::WS_CTL, 0, mk::CTL_BYTES, stream);
    p.ph_lo = 0; p.ph_hi = mk::NPHASE;
    hipLaunchKernelGGL(mk::mega, dim3(grid), dim3(512), mk::LDS_BYTES, stream, p);
#endif
}
```

```cpp
#include <hip/hip_runtime.h>
#include <cstdio>
#include <cstdint>
#include <utility>
#ifndef MK_PER_PHASE
#define MK_PER_PHASE 0
#endif
#ifndef MK_PROBE
#define MK_PROBE 0
#endif
namespace pg8 {
#define PG8_LAS __attribute__((address_space(3)))
__device__ __forceinline__ int otid() { int t = threadIdx.x; asm volatile("" : "+v"(t) :: "memory"); return t; }
__device__ __forceinline__ int obid() { int b = blockIdx.x; asm volatile("" : "+s"(b)); return b; }
__device__ __forceinline__ int ogrid() { int g = gridDim.x; asm volatile("" : "+s"(g)); return g; }
typedef unsigned short bf16_t;
typedef short bf16x8 __attribute__((ext_vector_type(8)));
typedef float f32x4 __attribute__((ext_vector_type(4)));
typedef unsigned u32x4 __attribute__((ext_vector_type(4)));
constexpr int BM = 256, BK = 64, HALF = 128, HTB = HALF * BK * 2  , STAGE_BYTES = 8 * HTB, NXCD = 8, WGM = 4;

__host__ __device__ __forceinline__ int lds_byte(int r, int c) { const int st = (r >> 4) * 2 + (c >> 5), rr = r & 15, cc = c & 31, ob = rr * 64 + cc * 2; return st * 1024 + (ob ^ (((ob >> 9) & 1) << 5)); }
__host__ __device__ __forceinline__ void stage_rc(int b, int& R, int& C) { const int st = b / 1024, sb = b % 1024, swz = sb ^ (((sb >> 9) & 1) << 5); R = (st >> 1) * 16 + swz / 64; C = (st & 1) * 32 + (swz % 64) / 2; }
__host__ __device__ __forceinline__ int perm32(int rho) { const int n = rho >> 4, i = rho & 15; return 8 * (i >> 2) + 4 * n + (i & 3); }

struct Unit { int pm, pn; };
struct Gemm { const bf16_t* A; const bf16_t* Bt; int M, N, K; };

struct StaticOrder {
    int nM, nN, nwg, G, c, wgm;
    __host__ __device__ void init(int M, int N, int G_, int c_, int wgm_ = WGM) { nM = M / BM; nN = N / BM; nwg = nM * nN; G = G_; c = c_; wgm = wgm_; }
    __host__ __device__ bool next(int i, Unit& u) const {
        const long L = (long)i * G + c; if (L >= nwg) return false;
        int wgid = (int)L; { const int q = nwg / NXCD, r = nwg % NXCD, xcd = wgid % NXCD, off = wgid / NXCD; wgid = (xcd < r ? xcd * (q + 1) : r * (q + 1) + (xcd - r) * q) + off; }
        const int nig = wgm * nN, gid = wgid / nig, fm = gid * wgm, gsz = (nM - fm) < wgm ? (nM - fm) : wgm;
        u.pm = fm + ((wgid % nig) % gsz); u.pn = (wgid % nig) / gsz; return true;
    }
    __device__ __forceinline__ void a_ready(const Unit&) const {}
    __device__ __forceinline__ void done(const Unit&) const {}
};
__device__ __forceinline__ unsigned cvt_pk_bf16(float lo, float hi) { unsigned r; asm volatile("v_cvt_pk_bf16_f32 %0, %1, %2" : "=v"(r) : "v"(lo), "v"(hi)); return r; }
template <class Epi, class Sched, bool STAMP = false>
__device__ __forceinline__ void gemm_phase(PG8_LAS unsigned char* lds, const Gemm g, const Sched& S, const Epi& E, unsigned long long* stamps) {
    const int tid = otid(), wid = __builtin_amdgcn_readfirstlane(tid >> 6), lane = tid & 63, wr = wid >> 2, wc = wid & 3, fr = lane & 15, fq = lane >> 4;
    const int K = g.K, nt = K / BK;
    int ts_lo = 0, ts_hi = 0, nts = 0; const unsigned long long rt_entry = STAMP ? (unsigned long long)wall_clock64() : 0ull;
#define PG8_STAMP() do { if (STAMP && wid == 0 && nts < 64) { const unsigned long long _c = (unsigned long long)clock64(); \
        ts_lo = (lane == nts) ? (int)(unsigned)_c : ts_lo; ts_hi = (lane == nts) ? (int)(unsigned)(_c >> 32) : ts_hi; ++nts; } } while (0)
    PG8_STAMP();
    unsigned voffA[2], voffB[2];
#pragma unroll
    for (int i = 0; i < 2; ++i) { int R, C; stage_rc(tid * 16 + i * 8192, R, C); const int Rb = Epi::PERM ? ((R & ~31) + perm32(R & 31)) : R;
        voffA[i] = (unsigned)(R * K + C) * 2u; voffB[i] = (unsigned)(Rb * K + C) * 2u; }
    const size_t kstep = (size_t)(BK * 2);
    const size_t hstep = (size_t)HALF * K * 2;
    const size_t tstep = 2 * hstep;
    const unsigned ldsw = (unsigned)wid * 1024u;
    const int aoff = lds_byte(wr * 64 + fr, fq * 8), boff = lds_byte(wc * 32 + fr, fq * 8);
#define PG8_SA(b, h) (((b) * 2 + (h)) * HTB)
#define PG8_SB(b, h) ((4 + (b) * 2 + (h)) * HTB)
#define PG8_STAGE(bufoff, gbase, voff) do { _Pragma("unroll") for (int _i = 0; _i < 2; ++_i) \
        __builtin_amdgcn_global_load_lds((const unsigned*)((const char*)(gbase) + (voff)[_i]), (PG8_LAS unsigned*)(lds + (bufoff) + ldsw + _i * 8192), 16, 0, 0); } while (0)
#define PG8_LDA(dst, b, h) do { _Pragma("unroll") for (int m = 0; m < 4; ++m) _Pragma("unroll") for (int k = 0; k < 2; ++k) dst[m][k] = *(const PG8_LAS bf16x8*)(lds + PG8_SA(b, h) + aoff + m * 2048 + k * 1024); } while (0)
#define PG8_LDB(dst, b, h) do { _Pragma("unroll") for (int n = 0; n < 2; ++n) _Pragma("unroll") for (int k = 0; k < 2; ++k) dst[n][k] = *(const PG8_LAS bf16x8*)(lds + PG8_SB(b, h) + boff + n * 2048 + k * 1024); } while (0)
#define PG8_MMA(ai, bj, At, Bt) do { __builtin_amdgcn_s_setprio(1); _Pragma("unroll") for (int m = 0; m < 4; ++m) _Pragma("unroll") for (int n = 0; n < 2; ++n) _Pragma("unroll") for (int k = 0; k < 2; ++k) \
        acc[ai][bj][m][n] = __builtin_amdgcn_mfma_f32_16x16x32_bf16(Bt[n][k], At[m][k], acc[ai][bj][m][n], 0, 0, 0); __builtin_amdgcn_s_setprio(0); } while (0)
#define PG8_WAIT_V(n) asm volatile("s_waitcnt vmcnt(" #n ")" ::: "memory")
#define PG8_WAIT_L(n) asm volatile("s_waitcnt lgkmcnt(" #n ")" ::: "memory")
#define PG8_BAR __builtin_amdgcn_s_barrier()
#define PG8_SCHED __builtin_amdgcn_sched_barrier(0)
    Unit cur, nxt; int ui = 0;
    if (!S.next(0, cur)) return;
    f32x4 acc[2][2][4][2];
#pragma unroll
    for (int a = 0; a < 2; ++a)
#pragma unroll
        for (int b = 0; b < 2; ++b)
#pragma unroll
            for (int m = 0; m < 4; ++m)
#pragma unroll
                for (int n = 0; n < 2; ++n) acc[a][b][m][n] = (f32x4){0.f, 0.f, 0.f, 0.f};
    bf16x8 At[4][2], B0[2][2], B1[2][2];
    const char* cA = (const char*)g.A + (size_t)cur.pm * tstep; const char* cB = (const char*)g.Bt + (size_t)cur.pn * tstep;
    S.a_ready(cur);
    PG8_STAGE(PG8_SB(0, 0), cB, voffB); PG8_STAGE(PG8_SA(0, 0), cA, voffA); PG8_STAGE(PG8_SB(0, 1), cB + hstep, voffB); PG8_STAGE(PG8_SA(0, 1), cA + hstep, voffA);
    if (wr == 1) PG8_BAR;
    PG8_WAIT_V(4); PG8_BAR;
    PG8_STAGE(PG8_SB(1, 0), cB + kstep, voffB); PG8_STAGE(PG8_SA(1, 0), cA + kstep, voffA); PG8_STAGE(PG8_SB(1, 1), cB + hstep + kstep, voffB);
    PG8_WAIT_V(6); PG8_BAR;
    PG8_STAMP();
    for (;;) {
        const bool has_next = S.next(ui + 1, nxt);
        const char* nA = has_next ? (const char*)g.A + (size_t)nxt.pm * tstep : cA; const char* nB = has_next ? (const char*)g.Bt + (size_t)nxt.pn * tstep : cB;
        for (int t = 0; t < nt; t += 2) {
            const bool last = (t == nt - 2);
            const char* a1 = cA + (size_t)(t + 1) * kstep;
            const char* a2 = last ? nA : cA + (size_t)(t + 2) * kstep; const char* b2 = last ? nB : cB + (size_t)(t + 2) * kstep;
            const char* a3 = a2 + kstep; const char* b3 = b2 + kstep;
            if (last && has_next) S.a_ready(nxt);
            PG8_LDB(B0, 0, 0); PG8_SCHED; PG8_LDA(At, 0, 0); PG8_STAGE(PG8_SA(1, 1), a1 + hstep, voffA);
            PG8_WAIT_L(8); PG8_BAR; PG8_WAIT_L(0); PG8_MMA(0, 0, At, B0); PG8_BAR; PG8_SCHED;
            PG8_LDB(B1, 0, 1); PG8_STAGE(PG8_SB(0, 0), b2, voffB);
            PG8_BAR; PG8_WAIT_L(0); PG8_MMA(0, 1, At, B1); PG8_BAR;
            PG8_LDA(At, 0, 1); PG8_STAGE(PG8_SA(0, 0), a2, voffA);
            PG8_BAR; PG8_WAIT_L(0); PG8_MMA(1, 0, At, B0); PG8_BAR; PG8_SCHED;
            PG8_STAGE(PG8_SB(0, 1), b2 + hstep, voffB);
            PG8_WAIT_V(6); PG8_BAR; PG8_MMA(1, 1, At, B1); PG8_BAR;
            PG8_LDB(B0, 1, 0); PG8_SCHED; PG8_LDA(At, 1, 0); PG8_STAGE(PG8_SA(0, 1), a2 + hstep, voffA);
            PG8_WAIT_L(8); PG8_BAR; PG8_WAIT_L(0); PG8_MMA(0, 0, At, B0); PG8_BAR; PG8_SCHED;
            PG8_LDB(B1, 1, 1); PG8_STAGE(PG8_SB(1, 0), b3, voffB);
            PG8_BAR; PG8_WAIT_L(0); PG8_MMA(0, 1, At, B1); PG8_BAR;
            PG8_LDA(At, 1, 1); PG8_STAGE(PG8_SA(1, 0), a3, voffA);
            PG8_BAR; PG8_WAIT_L(0); PG8_MMA(1, 0, At, B0); PG8_BAR; PG8_SCHED;
            PG8_STAGE(PG8_SB(1, 1), b3 + hstep, voffB);
            PG8_WAIT_V(6); PG8_BAR; PG8_MMA(1, 1, At, B1); PG8_BAR;
        }
        PG8_STAMP();
        if constexpr (!Epi::AFTER_DRAIN) { E(acc, cur, wr, wc, fr, fq); S.done(cur); }
        PG8_STAMP();
        if (!has_next) break;
#pragma unroll
        for (int a = 0; a < 2; ++a)
#pragma unroll
            for (int b = 0; b < 2; ++b)
#pragma unroll
                for (int m = 0; m < 4; ++m)
#pragma unroll
                    for (int n = 0; n < 2; ++n) acc[a][b][m][n] = (f32x4){0.f, 0.f, 0.f, 0.f};
        cur = nxt; cA = nA; cB = nB; ++ui;
    }
    PG8_WAIT_V(0);
    if (wr == 0) PG8_BAR;
    PG8_BAR;
    if constexpr (Epi::AFTER_DRAIN) { E.fused(acc, cur, wr, wc, fr, fq, lds, wid, lane); S.done(cur); }
    PG8_STAMP();
    if (STAMP && wid == 0) { stamps[lane] = lane < nts ? (((unsigned long long)(unsigned)ts_hi << 32) | (unsigned)ts_lo) : 0ull;
        if (lane == 62) stamps[62] = rt_entry; if (lane == 63) stamps[63] = (unsigned long long)wall_clock64(); }
#undef PG8_STAMP
#undef PG8_SA
#undef PG8_SB
#undef PG8_STAGE
#undef PG8_LDA
#undef PG8_LDB
#undef PG8_MMA
#undef PG8_WAIT_V
#undef PG8_WAIT_L
#undef PG8_BAR
#undef PG8_SCHED
}
}
#define XB_TMO      128
#define XB_XCNT(j)  (256  + 64 * (j))
#define XB_XSUB(j)  (1280 + 64 * (j))
#define XB_XGEN(j)  (2304 + 64 * (j))
#define XB_TOP      3328
#define XB_TOPGEN   3392
#define XCD_BAR_WORDS 3456
#define XB_SPIN_CAP (1u << 18)
#define LAS __attribute__((address_space(3)))

__device__ __forceinline__ unsigned xb_ld(unsigned* p)              { return __hip_atomic_load(p, __ATOMIC_RELAXED, __HIP_MEMORY_SCOPE_AGENT); }
__device__ __forceinline__ unsigned xb_add(unsigned* p, unsigned v) { return __hip_atomic_fetch_add(p, v, __ATOMIC_RELAXED, __HIP_MEMORY_SCOPE_AGENT); }
__device__ __forceinline__ unsigned xb_xcc_id() { return (unsigned)__builtin_amdgcn_s_getreg((3 << 11) | 20) & 0xFu; }
#define XB_SPIN(cond, bar) do { unsigned _sp = 0; while (cond) { __builtin_amdgcn_s_sleep(1); \
    if ((++_sp & 255u) == 0u) { if (xb_ld(&(bar)[XB_TMO])) break; if (_sp > XB_SPIN_CAP) { atomicAdd(&(bar)[XB_TMO], 1u); break; } } } } while (0)

struct XcdBarrier {
    unsigned* bar; unsigned x;
    volatile LAS unsigned* st;
};

__device__ __forceinline__ XcdBarrier xcd_barrier_post(unsigned* bar, volatile LAS unsigned* st) {
    XcdBarrier b; b.bar = bar; b.x = xb_xcc_id(); b.st = st;
    if (threadIdx.x == 0) (void)xb_add(&bar[XB_XCNT(b.x)], 1u);
    return b;
}
__device__ __forceinline__ void xcd_barrier_complete(unsigned* bar, unsigned x, unsigned& nloc, unsigned& nx) {
    const unsigned G = gridDim.x * gridDim.y * gridDim.z;
    unsigned sum, cnt, mine, sp = 0u;
    for (;;) {
        sum = 0u; cnt = 0u; mine = 0u;
#pragma unroll
        for (unsigned j = 0; j < 16; ++j) { const unsigned c = xb_ld(&bar[XB_XCNT(j)]); sum += c; cnt += (c > 0u) ? 1u : 0u; mine = (j == x) ? c : mine; }
        if (sum == G) break;
        __builtin_amdgcn_s_sleep(1);
        if ((++sp & 255u) == 0u) { if (xb_ld(&bar[XB_TMO])) break; if (sp > XB_SPIN_CAP) { atomicAdd(&bar[XB_TMO], 1u); break; } }
    }
    nloc = mine > 0u ? mine : 1u; nx = cnt > 0u ? cnt : 1u;
}

__device__ __forceinline__ void xcd_barrier(const XcdBarrier& b) {
    asm volatile("s_waitcnt vmcnt(0)" ::: "memory");
    __syncthreads();
    if (threadIdx.x == 0) {
        unsigned* bar = b.bar;
        __builtin_amdgcn_s_waitcnt(0);
        unsigned nloc = b.st[0], nx = b.st[1];
        if (nloc == 0u) { xcd_barrier_complete(bar, b.x, nloc, nx); b.st[0] = nloc; b.st[1] = nx; }
        const unsigned old = xb_add(&bar[XB_XSUB(b.x)], 1u);
        const unsigned gen = old / nloc;
        if (old + 1u == (gen + 1u) * nloc) {
            __builtin_amdgcn_fence(__ATOMIC_RELEASE, "agent");
            asm volatile("s_waitcnt vmcnt(0)" ::: "memory");
            const unsigned og = xb_add(&bar[XB_TOP], 1u);
            const unsigned tg = og / nx;
            if (og + 1u == (tg + 1u) * nx) xb_add(&bar[XB_TOPGEN], 1u);
            else XB_SPIN(xb_ld(&bar[XB_TOPGEN]) == tg, bar);
            __builtin_amdgcn_fence(__ATOMIC_ACQUIRE, "agent");
            xb_add(&bar[XB_XGEN(b.x)], 1u);
            asm volatile("s_waitcnt vmcnt(0)" ::: "memory");
        } else {
            XB_SPIN(xb_ld(&bar[XB_XGEN(b.x)]) == gen, bar);
            __builtin_amdgcn_fence(__ATOMIC_ACQUIRE, "agent");
            asm volatile("s_waitcnt vmcnt(0)" ::: "memory");
        }
    }
    __syncthreads();
}


namespace mk {
using pg8::bf16_t; using pg8::bf16x8; using pg8::f32x4; using pg8::u32x4; using pg8::Unit; using pg8::cvt_pk_bf16;
typedef unsigned u32x2 __attribute__((ext_vector_type(2)));
typedef float cpx __attribute__((ext_vector_type(2)));
__host__ __device__ __forceinline__ cpx mkc(float a, float b) { cpx r; r.x = a; r.y = b; return r; }

constexpr int D = 2048, T_P = 32768, T_S = 8192, T = 40960, L_P = 16384, L_S = 2048, DFF = 5632;
constexpr int NTHR = 512;
constexpr int MODW = 53248;
constexpr int NPOS = 18432;
constexpr int QKVW = 9216;
constexpr float EPS = 1e-6f;
constexpr float QSCALE = 0.12751743082459868f;
constexpr int LDS_BYTES = 147456;
constexpr int LDS_MISC = 147456 - 256;

constexpr size_t al256(size_t x) { return (x + 255) & ~(size_t)255; }
constexpr size_t WS_CTL  = 0;
constexpr size_t CTL_BYTES = 65536;
constexpr size_t WS_PART = WS_CTL + CTL_BYTES;
constexpr size_t WS_MOD  = WS_PART + al256((size_t)8 * 6 * MODW * 4);
constexpr size_t WS_ROPE = WS_MOD + al256((size_t)6 * MODW * 4);
constexpr size_t WS_A2X  = WS_ROPE + (size_t)16384 * 16 * 8;
constexpr size_t WS_W3X  = WS_A2X + (size_t)2 * NPOS * 256 * 2;
constexpr size_t WS_WL   = WS_W3X + (size_t)2 * 8192 * 256 * 2;
constexpr size_t WL_FFN1 = 0;
constexpr size_t WL_FFN2 = WL_FFN1 + (size_t)11264 * 2048 * 2;
constexpr size_t WL_MIXIN = WL_FFN2 + (size_t)2048 * 5632 * 2;
constexpr size_t WL_MIXOUT = WL_MIXIN + (size_t)9216 * 2048 * 2;
constexpr size_t WL_BYTES = WL_MIXOUT + (size_t)2048 * 2048 * 2;
constexpr size_t WS_H    = WS_WL + WL_BYTES;
constexpr size_t H_BYTES = (size_t)T * 2048 * 2;
constexpr size_t WS_BIG  = WS_H + H_BYTES;
constexpr size_t BIG_ZINT = 0;
constexpr size_t BIG_TAPS = BIG_ZINT + (size_t)6144 * T * 2;
constexpr size_t BIG_HY_END = BIG_TAPS + (size_t)8192 * NPOS * 2;
constexpr size_t BIG_QKV = 0;
constexpr size_t BIG_OG  = BIG_QKV + (size_t)T * QKVW * 2;
constexpr size_t BIG_LSE = BIG_OG + (size_t)3 * T * 1024 * 2;
constexpr size_t BIG_AT_END = BIG_LSE + (size_t)3 * T * 8 * 4;
constexpr size_t BIG_MID = 0;
constexpr size_t BIG_BYTES = BIG_HY_END > BIG_AT_END ? BIG_HY_END : BIG_AT_END;
constexpr size_t WS_END  = WS_BIG + BIG_BYTES;
constexpr size_t FFT_SCR_PER_WG = 5 * 131072;
constexpr size_t FFT_EXT_PER_WG = 2 * 65536;
constexpr size_t WS_XB = WS_END + (size_t)256 * FFT_EXT_PER_WG;
constexpr size_t WS_TOTAL = WS_XB + (size_t)T * 2048 * 2;
static_assert(256 * FFT_SCR_PER_WG <= H_BYTES, "fft scratch must fit in H");

struct Params {
    const float *x_prompt, *x_sample, *c_prompt, *c_sample, *ada_w, *ada_b, *norm_mix, *norm_ffn;
    const float *hy_w_in, *hy_b_in, *hy_conv_w, *hy_conv_b, *hy_fw1, *hy_fb1, *hy_ffreq, *hy_fw2, *hy_fb2, *hy_fw3, *hy_decay, *hy_skip, *hy_w_out, *hy_b_out;
    const float *at_w_in, *at_w_out, *ffn_w_gate, *ffn_w_up, *ffn_w_down, *final_norm, *final_ada_w, *final_ada_b;
    float* out; unsigned char* ws; int ph_lo, ph_hi, probe, pad0;
};

#define LDSQ __attribute__((address_space(3)))

__device__ __forceinline__ float bf2f(bf16_t b) { return __uint_as_float(((unsigned)b) << 16); }
__device__ __forceinline__ bf16_t f2bf(float f) { unsigned u = __float_as_uint(f); u += 0x7FFFu + ((u >> 16) & 1u); return (bf16_t)(u >> 16); }
__device__ __forceinline__ int seq_of_row(int row) { return row < T_P ? (row >> 14) : 2 + ((row - T_P) >> 11); }
__device__ __forceinline__ int pos_of_row(int row) { return row < T_P ? (row & 16383) : (row & 2047); }
__device__ __forceinline__ float wave_sum(float v) {
#pragma unroll
    for (int o = 32; o >= 1; o >>= 1) v += __shfl_xor(v, o);
    return v;
}

struct EpiZinT {
    static constexpr bool PERM = true, AFTER_DRAIN = false;
    bf16_t* O; int ldc; const float* bias;
    __device__ __forceinline__ void operator()(const f32x4 (&acc)[2][2][4][2], const Unit& u, int wr, int wc, int fr, int fq) const {
        const int row0 = u.pm * 256 + wr * 64 + fr, col0 = u.pn * 256 + wc * 32 + 8 * fq;
        float bs[8];
#pragma unroll
        for (int r = 0; r < 8; ++r) bs[r] = bias[row0 + (r >> 2) * 128 + (r & 3) * 16];
#pragma unroll
        for (int ai = 0; ai < 2; ++ai)
#pragma unroll
            for (int m = 0; m < 4; ++m) { const int r = row0 + ai * 128 + m * 16; const float b = bs[ai * 4 + m]; bf16_t* rowp = O + (size_t)r * ldc + col0;
#pragma unroll
                for (int bj = 0; bj < 2; ++bj) { const f32x4 v0 = acc[ai][bj][m][0] + b, v1 = acc[ai][bj][m][1] + b;
                    u32x4 w; w.x = cvt_pk_bf16(v0[0], v0[1]); w.y = cvt_pk_bf16(v0[2], v0[3]); w.z = cvt_pk_bf16(v1[0], v1[1]); w.w = cvt_pk_bf16(v1[2], v1[3]);
                    *(u32x4*)(rowp + bj * 128) = w; } }
    }
};
struct EpiRes {
    static constexpr bool PERM = true, AFTER_DRAIN = false;
    bf16_t* X; const float* bias; const float* gate; int dry;
    __device__ __forceinline__ void operator()(const f32x4 (&acc)[2][2][4][2], const Unit& u, int wr, int wc, int fr, int fq) const {
        const int row0 = u.pm * 256 + wr * 64 + fr, col0 = u.pn * 256 + wc * 32 + 8 * fq;
        const float* gp = gate + (size_t)seq_of_row(u.pm * 256) * MODW + col0;
        bf16_t* xb = X + (size_t)row0 * 2048 + col0;
        u32x4 xv[2][4]; f32x4 gv[2][2], bv[2][2];
#pragma unroll
        for (int m4 = 0; m4 < 4; ++m4) xv[0][m4] = *(const u32x4*)(xb + (size_t)(m4 * 16) * 2048);
#pragma unroll
        for (int n = 0; n < 2; ++n) { gv[0][n] = *(const f32x4*)(gp + 4 * n); bv[0][n] = bias ? *(const f32x4*)(bias + col0 + 4 * n) : (f32x4){0.f, 0.f, 0.f, 0.f}; }
#pragma unroll
        for (int c = 0; c < 4; ++c) { const int bj = c >> 1, ai = c & 1;
            if (c < 3) { const int bj2 = (c + 1) >> 1, ai2 = (c + 1) & 1;
#pragma unroll
                for (int m4 = 0; m4 < 4; ++m4) xv[(c + 1) & 1][m4] = *(const u32x4*)(xb + (size_t)(ai2 * 128 + m4 * 16) * 2048 + bj2 * 128);
                if (c == 1) {
#pragma unroll
                    for (int n = 0; n < 2; ++n) { gv[1][n] = *(const f32x4*)(gp + 128 + 4 * n); bv[1][n] = bias ? *(const f32x4*)(bias + col0 + 128 + 4 * n) : (f32x4){0.f, 0.f, 0.f, 0.f}; } } }
#pragma unroll
            for (int m4 = 0; m4 < 4; ++m4) { const u32x4 xo = xv[c & 1][m4];
                const f32x4 xa = {__uint_as_float(xo.x << 16), __uint_as_float(xo.x & 0xffff0000u), __uint_as_float(xo.y << 16), __uint_as_float(xo.y & 0xffff0000u)};
                const f32x4 xc = {__uint_as_float(xo.z << 16), __uint_as_float(xo.z & 0xffff0000u), __uint_as_float(xo.w << 16), __uint_as_float(xo.w & 0xffff0000u)};
                const f32x4 ya = xa + gv[bj][0] * (acc[ai][bj][m4][0] + bv[bj][0]), yc = xc + gv[bj][1] * (acc[ai][bj][m4][1] + bv[bj][1]);
                u32x4 w; w.x = cvt_pk_bf16(ya[0], ya[1]); w.y = cvt_pk_bf16(ya[2], ya[3]); w.z = cvt_pk_bf16(yc[0], yc[1]); w.w = cvt_pk_bf16(yc[2], yc[3]);
                if (!dry) *(u32x4*)(xb + (size_t)(ai * 128 + m4 * 16) * 2048 + bj * 128) = w; } }
    }
};
struct EpiQKV {
    static constexpr bool PERM = true, AFTER_DRAIN = false;
    bf16_t* O; const cpx* rope;
    __device__ __forceinline__ void operator()(const f32x4 (&acc)[2][2][4][2], const Unit& u, int wr, int wc, int fr, int fq) const {
        const int row0 = u.pm * 256 + wr * 64 + fr, colt = u.pn * 256, col0 = colt + wc * 32 + 8 * fq;
        const int sidx = (colt % 3072) >> 10;
        const bool dorope = (sidx < 2) && (wc == 0);
        const float qs = (sidx == 0) ? QSCALE : 1.0f;
        f32x4 tt[2][4];
        if (dorope) { const cpx* rp = rope + (size_t)pos_of_row(row0) * 16 + 8 * (fq & 1);
            tt[0][0] = *(const f32x4*)(rp); tt[0][1] = *(const f32x4*)(rp + 2); tt[0][2] = *(const f32x4*)(rp + 4); tt[0][3] = *(const f32x4*)(rp + 6); }
#pragma unroll
        for (int g = 0; g < 8; ++g) { const int ai = g >> 2, m = g & 3; const int r = row0 + ai * 128 + m * 16; bf16_t* rowp = O + (size_t)r * QKVW + col0;
            f32x4 c0, c1, s0, s1;
            if (dorope) {
                if (g < 7) { const int r2 = row0 + ((g + 1) >> 2) * 128 + ((g + 1) & 3) * 16; const cpx* rp = rope + (size_t)pos_of_row(r2) * 16 + 8 * (fq & 1);
                    tt[(g + 1) & 1][0] = *(const f32x4*)(rp); tt[(g + 1) & 1][1] = *(const f32x4*)(rp + 2); tt[(g + 1) & 1][2] = *(const f32x4*)(rp + 4); tt[(g + 1) & 1][3] = *(const f32x4*)(rp + 6); }
                const f32x4 t0 = tt[g & 1][0], t1 = tt[g & 1][1], t2 = tt[g & 1][2], t3 = tt[g & 1][3];
                c0 = (f32x4){t0[0], t0[2], t1[0], t1[2]}; s0 = (f32x4){t0[1], t0[3], t1[1], t1[3]};
                c1 = (f32x4){t2[0], t2[2], t3[0], t3[2]}; s1 = (f32x4){t2[1], t2[3], t3[1], t3[3]}; }
#pragma unroll
            for (int bj = 0; bj < 2; ++bj) { f32x4 v0 = acc[ai][bj][m][0], v1 = acc[ai][bj][m][1];
                if (dorope) { f32x4 p0, p1;
#pragma unroll
                    for (int e = 0; e < 4; ++e) { p0[e] = __shfl_xor(v0[e], 32); p1[e] = __shfl_xor(v1[e], 32); }
                    if (fq < 2) { v0 = v0 * c0 - p0 * s0; v1 = v1 * c1 - p1 * s1; }
                    else        { v0 = v0 * c0 + p0 * s0; v1 = v1 * c1 + p1 * s1; } }
                v0 *= qs; v1 *= qs;
                u32x4 w; w.x = cvt_pk_bf16(v0[0], v0[1]); w.y = cvt_pk_bf16(v0[2], v0[3]); w.z = cvt_pk_bf16(v1[0], v1[1]); w.w = cvt_pk_bf16(v1[2], v1[3]);
                *(u32x4*)(rowp + bj * 128) = w; } }
    }
};
struct EpiFFN1 {
    static constexpr bool PERM = true, AFTER_DRAIN = false;
    bf16_t* O;
    __device__ __forceinline__ void operator()(const f32x4 (&acc)[2][2][4][2], const Unit& u, int wr, int wc, int fr, int fq) const {
        const int row0 = u.pm * 256 + wr * 64 + fr, col0 = u.pn * 128 + wc * 32 + 8 * fq;
#pragma unroll
        for (int ai = 0; ai < 2; ++ai)
#pragma unroll
            for (int m = 0; m < 4; ++m) { bf16_t* rowp = O + (size_t)(row0 + ai * 128 + m * 16) * DFF + col0; float o[8];
#pragma unroll
                for (int n = 0; n < 2; ++n)
#pragma unroll
                    for (int e = 0; e < 4; ++e) { const float g = acc[ai][0][m][n][e], up = acc[ai][1][m][n][e]; o[n * 4 + e] = g * __builtin_amdgcn_rcpf(1.0f + __expf(-g)) * up; }
                u32x4 w; w.x = cvt_pk_bf16(o[0], o[1]); w.y = cvt_pk_bf16(o[2], o[3]); w.z = cvt_pk_bf16(o[4], o[5]); w.w = cvt_pk_bf16(o[6], o[7]);
                *(u32x4*)rowp = w; }
    }
};
struct EpiTaps {
    static constexpr bool PERM = true, AFTER_DRAIN = false;
    _Float16* O;
    __device__ __forceinline__ void operator()(const f32x4 (&acc)[2][2][4][2], const Unit& u, int wr, int wc, int fr, int fq) const {
        typedef _Float16 h8 __attribute__((ext_vector_type(8)));
        const int row0 = u.pm * 256 + wr * 64 + fr, col0 = u.pn * 256 + wc * 32 + 8 * fq;
#pragma unroll
        for (int ai = 0; ai < 2; ++ai)
#pragma unroll
            for (int m = 0; m < 4; ++m) { _Float16* rowp = O + (size_t)(row0 + ai * 128 + m * 16) * NPOS + col0;
#pragma unroll
                for (int bj = 0; bj < 2; ++bj) { const f32x4 v0 = acc[ai][bj][m][0], v1 = acc[ai][bj][m][1]; h8 w;
                    w[0] = (_Float16)v0[0]; w[1] = (_Float16)v0[1]; w[2] = (_Float16)v0[2]; w[3] = (_Float16)v0[3]; w[4] = (_Float16)v1[0]; w[5] = (_Float16)v1[1]; w[6] = (_Float16)v1[2]; w[7] = (_Float16)v1[3];
                    *(h8*)(rowp + bj * 128) = w; } }
    }
};

__device__ __forceinline__ void ada_partials(const Params& p, LDSQ unsigned char* lds) {
    LDSQ float* cs = (LDSQ float*)lds;
    for (int i = pg8::otid(); i < 6 * 2048; i += NTHR) { const int b = i >> 11, k = i & 2047; const float c = b < 2 ? p.c_prompt[b * 2048 + k] : p.c_sample[(b - 2) * 2048 + k]; cs[i] = c / (1.0f + expf(-c)); }
    __syncthreads();
    float* part = (float*)(p.ws + WS_PART);
    for (int item = pg8::obid() * NTHR + pg8::otid(); item < 8 * 13312; item += pg8::ogrid() * NTHR) {
        const int chunk = item / 13312, c4 = item % 13312;
        const float* W; int ldw;
        if (c4 < 12288) { const int layer = c4 / 3072, col = (c4 % 3072) * 4; W = p.ada_w + (size_t)layer * 2048 * 12288 + col; ldw = 12288; }
        else { W = p.final_ada_w + (c4 - 12288) * 4; ldw = 4096; }
        f32x4 a0 = {0.f, 0.f, 0.f, 0.f}, a1 = a0, a2 = a0, a3 = a0, a4 = a0, a5 = a0;
        const int k0 = chunk * 256;
#pragma unroll 8
        for (int k = k0; k < k0 + 256; ++k) { const f32x4 w = *(const f32x4*)(W + (size_t)k * ldw);
            a0 += cs[k] * w; a1 += cs[2048 + k] * w; a2 += cs[4096 + k] * w; a3 += cs[6144 + k] * w; a4 += cs[8192 + k] * w; a5 += cs[10240 + k] * w; }
        float* o = part + (size_t)chunk * 6 * MODW + (size_t)c4 * 4;
        *(f32x4*)(o) = a0; *(f32x4*)(o + MODW) = a1; *(f32x4*)(o + 2 * MODW) = a2; *(f32x4*)(o + 3 * MODW) = a3; *(f32x4*)(o + 4 * MODW) = a4; *(f32x4*)(o + 5 * MODW) = a5;
    }
    __syncthreads();
}
__device__ __forceinline__ void ada_reduce(const Params& p) {
    const float* part = (const float*)(p.ws + WS_PART); float* mod = (float*)(p.ws + WS_MOD);
    for (int i = pg8::obid() * NTHR + pg8::otid(); i < 6 * MODW; i += pg8::ogrid() * NTHR) {
        const int c = i % MODW; float s = c < 49152 ? p.ada_b[c] : p.final_ada_b[c - 49152];
#pragma unroll
        for (int ch = 0; ch < 8; ++ch) s += part[(size_t)ch * 6 * MODW + i];
        mod[i] = s;
    }
}
__device__ __forceinline__ void rope_table(const Params& p) {
    cpx* rope = (cpx*)(p.ws + WS_ROPE);
    for (int i = pg8::obid() * NTHR + pg8::otid(); i < 16384 * 16; i += pg8::ogrid() * NTHR) {
        const int pos = i >> 4, f = i & 15; const float inv = powf(500000.0f, -(float)f / 16.0f); const float ang = (float)pos * inv;
        float s, c; sincosf(ang, &s, &c); rope[i] = mkc(c, s);
    }
}
__device__ __forceinline__ void filter_mlp(const Params& p) {
    const int lane = pg8::otid() & 63, gw = pg8::obid() * 8 + (pg8::otid() >> 6);
    bf16_t* a2x = (bf16_t*)(p.ws + WS_A2X);
    for (int q = gw; q < 2 * NPOS; q += pg8::ogrid() * 8) {
        const int j = q / NPOS, r = q % NPOS; const int L = r < 16384 ? 16384 : 2048, pos = r < 16384 ? r : r - 16384;
        const float fpos = (float)pos;
        float z = 0.f;
        if (lane == 0) z = fpos / (float)(L - 1);
        else if (lane <= 32) { const int bi = (lane - 1) & 15; const float band = 1e-4f + (float)bi * ((15.0f - 1e-4f) / 15.0f);
            const float ang = ((6.283185307179586f * fpos) * band) / (float)L; z = lane <= 16 ? cosf(ang) : -sinf(ang); }
        const float* w1 = p.hy_fw1 + j * 33 * 64; const float* w2 = p.hy_fw2 + j * 64 * 64;
        float acc = p.hy_fb1[j * 64 + lane];
#pragma unroll
        for (int m = 0; m < 33; ++m) acc += __shfl(z, m) * w1[m * 64 + lane];
        const float a1 = sinf(p.hy_ffreq[j * 128 + lane] * acc);
        acc = p.hy_fb2[j * 64 + lane];
#pragma unroll
        for (int m = 0; m < 64; ++m) acc += __shfl(a1, m) * w2[m * 64 + lane];
        const float a2 = sinf(p.hy_ffreq[j * 128 + 64 + lane] * acc);
        const bf16_t hi = f2bf(a2), lo = f2bf(a2 - bf2f(hi));
        bf16_t* o = a2x + ((size_t)j * NPOS + r) * 256;
        o[lane] = hi; o[64 + lane] = hi; o[128 + lane] = lo; o[192 + lane] = 0;
    }
    bf16_t* w3x = (bf16_t*)(p.ws + WS_W3X);
    for (int i = pg8::obid() * NTHR + pg8::otid(); i < 2 * 8192 * 64; i += pg8::ogrid() * NTHR) {
        const int k = i & 63, col = (i >> 6) & 8191, j = i >> 19;
        const float v = p.hy_fw3[(size_t)j * 64 * 8192 + (size_t)k * 8192 + col];
        const bf16_t hi = f2bf(v), lo = f2bf(v - bf2f(hi));
        bf16_t* o = w3x + ((size_t)j * 8192 + col) * 256;
        o[k] = hi; o[64 + k] = lo; o[128 + k] = hi; o[192 + k] = 0;
    }
}
__device__ __forceinline__ void convert_T(LDSQ unsigned char* lds, const float* src, int K, int N, bf16_t* dst, int ffs) {
    LDSQ float* tile = (LDSQ float*)lds;
    const int tid = pg8::otid(), ntn = N >> 8, ntiles = (K >> 6) * ntn, stride = pg8::ogrid();
    const int r = tid >> 6, c4 = tid & 63;
    f32x4 v[8];
    int ti = pg8::obid();
    if (ti < ntiles) { const int tk = ti / ntn, tn = ti % ntn;
#pragma unroll
        for (int it = 0; it < 8; ++it) v[it] = *(const f32x4*)(src + (size_t)(tk * 64 + r + 8 * it) * N + tn * 256 + 4 * c4); }
    for (; ti < ntiles; ti += stride) {
        const int tk = ti / ntn, tn = ti % ntn;
#pragma unroll
        for (int it = 0; it < 8; ++it) { LDSQ float* tp = tile + (r + 8 * it) * 257 + 4 * c4; tp[0] = v[it][0]; tp[1] = v[it][1]; tp[2] = v[it][2]; tp[3] = v[it][3]; }
        __syncthreads();
        if (ti + stride < ntiles) { const int t2 = ti + stride, tk2 = t2 / ntn, tn2 = t2 % ntn;
#pragma unroll
            for (int it = 0; it < 8; ++it) v[it] = *(const f32x4*)(src + (size_t)(tk2 * 64 + r + 8 * it) * N + tn2 * 256 + 4 * c4); }
        { const int n = tid >> 1, kh = tid & 1; const int nn = tn * 256 + n; const int row = ffs < 0 ? nn : (256 * (nn >> 7) + 128 * ffs + (nn & 127));
          bf16_t* dp = dst + (size_t)row * K + tk * 64 + kh * 32;
#pragma unroll
          for (int q = 0; q < 4; ++q) { float f[8];
#pragma unroll
              for (int e = 0; e < 8; ++e) f[e] = tile[(kh * 32 + q * 8 + e) * 257 + n];
              u32x4 w; w.x = cvt_pk_bf16(f[0], f[1]); w.y = cvt_pk_bf16(f[2], f[3]); w.z = cvt_pk_bf16(f[4], f[5]); w.w = cvt_pk_bf16(f[6], f[7]);
              *(u32x4*)(dp + q * 8) = w; } }
        __syncthreads();
    }
}
template <bool FINAL, bool SRC_F32> __device__ __forceinline__ void norm_rows(const float* xp, const float* xs, bf16_t* xb, const float* g, const float* modl, int sh_off, int sc_off, bf16_t* H, float* outf) {
    const int lane = pg8::otid() & 63, gw = pg8::obid() * 8 + (pg8::otid() >> 6), nw = pg8::ogrid() * 8;
    const int rpw = (T + nw - 1) / nw, r0 = gw * rpw, r1 = (r0 + rpw < T) ? r0 + rpw : T;
    if (r0 >= r1) return;
    f32x4 gs[8], sh[8]; int curseq = -1;
    struct RowBuf { f32x4 f[SRC_F32 ? 8 : 1]; u32x2 b[SRC_F32 ? 1 : 8]; };
    auto request = [&](RowBuf& B, int row) {
        if (SRC_F32) { const f32x4* src = (const f32x4*)(row < T_P ? xp + (size_t)row * 2048 : xs + (size_t)(row - T_P) * 2048);
#pragma unroll
            for (int i = 0; i < 8; ++i) B.f[i] = src[lane + 64 * i]; }
        else { const u32x2* src = (const u32x2*)(xb + (size_t)row * 2048);
#pragma unroll
            for (int i = 0; i < 8; ++i) B.b[i] = src[lane + 64 * i]; } };
    auto process = [&](RowBuf& B, int row, int next) {
        f32x4 v[8];
#pragma unroll
        for (int i = 0; i < 8; ++i) { if (SRC_F32) v[i] = B.f[i]; else v[i] = (f32x4){__uint_as_float(B.b[i].x << 16), __uint_as_float(B.b[i].x & 0xffff0000u), __uint_as_float(B.b[i].y << 16), __uint_as_float(B.b[i].y & 0xffff0000u)}; }
        if (next < r1) request(B, next);
        const int seq = seq_of_row(row);
        if (seq != curseq) { curseq = seq; const float* mod = modl + (size_t)seq * MODW;
#pragma unroll
            for (int i = 0; i < 8; ++i) { const int col = (lane + 64 * i) * 4; gs[i] = *(const f32x4*)(g + col); sh[i] = *(const f32x4*)(mod + sc_off + col); }
#pragma unroll
            for (int i = 0; i < 8; ++i) { const int col = (lane + 64 * i) * 4; const f32x4 sft = *(const f32x4*)(mod + sh_off + col); gs[i] = gs[i] * (1.0f + sh[i]); sh[i] = sft; } }
        float ss = 0.f;
#pragma unroll
        for (int i = 0; i < 8; ++i) ss += v[i][0] * v[i][0] + v[i][1] * v[i][1] + v[i][2] * v[i][2] + v[i][3] * v[i][3];
        ss = wave_sum(ss);
        const float rstd = 1.0f / sqrtf(ss * (1.0f / 2048.0f) + EPS);
#pragma unroll
        for (int i = 0; i < 8; ++i) { const int col = (lane + 64 * i) * 4;
            const f32x4 h = (v[i] * rstd) * gs[i] + sh[i];
            if (FINAL) *(f32x4*)(outf + (size_t)row * 2048 + col) = h;
            else { u32x2 w; w.x = cvt_pk_bf16(h[0], h[1]); w.y = cvt_pk_bf16(h[2], h[3]); *(u32x2*)(H + (size_t)row * 2048 + col) = w;
                if (SRC_F32) { u32x2 c; c.x = cvt_pk_bf16(v[i][0], v[i][1]); c.y = cvt_pk_bf16(v[i][2], v[i][3]); *(u32x2*)(xb + (size_t)row * 2048 + col) = c; } } } };
    if (SRC_F32) {
        RowBuf B0, B1;
        request(B0, r0); if (r0 + 1 < r1) request(B1, r0 + 1);
        for (int row = r0; row < r1; row += 2) { process(B0, row, row + 2); if (row + 1 < r1) process(B1, row + 1, row + 3); }
    } else {
        RowBuf B0, B1, B2;
        request(B0, r0); if (r0 + 1 < r1) request(B1, r0 + 1); if (r0 + 2 < r1) request(B2, r0 + 2);
        for (int row = r0; row < r1; row += 3) {
            process(B0, row, row + 3);
            if (row + 1 < r1) process(B1, row + 1, row + 4);
            if (row + 2 < r1) process(B2, row + 2, row + 5);
        }
    }
}
__device__ __forceinline__ void final_norm_phase(const Params& p) {
    norm_rows<true, false>(nullptr, nullptr, (bf16_t*)(p.ws + WS_XB), p.final_norm, (const float*)(p.ws + WS_MOD) + 49152, 0, 2048, nullptr, p.out);
}
__device__ __forceinline__ void transpose_phase(const Params& p, LDSQ unsigned char* lds) {
    LDSQ bf16_t* tile = (LDSQ bf16_t*)lds;
    const bf16_t* zin = (const bf16_t*)(p.ws + WS_BIG + BIG_ZINT); bf16_t* H = (bf16_t*)(p.ws + WS_H);
    const int tid = pg8::otid(), stride = pg8::ogrid();
    const int cr = tid >> 5, tq = tid & 31;
    u32x4 v[4];
    int ti = pg8::obid();
    if (ti < 32 * 160) { const int tc = ti / 160, tt = ti % 160;
#pragma unroll
        for (int it = 0; it < 4; ++it) v[it] = *(const u32x4*)(zin + (size_t)(tc * 64 + cr + 16 * it) * T + tt * 256 + tq * 8); }
    for (; ti < 32 * 160; ti += stride) {
        const int tc = ti / 160, tt = ti % 160;
#pragma unroll
        for (int it = 0; it < 4; ++it) *(LDSQ u32x4*)(tile + (cr + 16 * it) * 264 + tq * 8) = v[it];
        __syncthreads();
        if (ti + stride < 32 * 160) { const int t2 = ti + stride, tc2 = t2 / 160, tt2 = t2 % 160;
#pragma unroll
            for (int it = 0; it < 4; ++it) v[it] = *(const u32x4*)(zin + (size_t)(tc2 * 64 + cr + 16 * it) * T + tt2 * 256 + tq * 8); }
        { const int cq = tid & 7, tk = tid >> 3;
#pragma unroll
          for (int it = 0; it < 4; ++it) { const int tok = tk + 64 * it; unsigned w[4];
#pragma unroll
              for (int e = 0; e < 4; ++e) { const unsigned lo = tile[(cq * 8 + 2 * e) * 264 + tok], hi = tile[(cq * 8 + 2 * e + 1) * 264 + tok]; w[e] = lo | (hi << 16); }
              *(u32x4*)(H + (size_t)(tt * 256 + tok) * 2048 + tc * 64 + cq * 8) = (u32x4){w[0], w[1], w[2], w[3]}; } }
        __syncthreads();
    }
}

__host__ __device__ constexpr float cos64q(int k) {
    constexpr float t[17] = {1.0f, 0.99518472667219693f, 0.98078528040323043f, 0.95694033573220882f, 0.92387953251128674f, 0.88192126434835505f, 0.83146961230254524f,
        0.77301045336273699f, 0.70710678118654757f, 0.63439328416364549f, 0.55557023301960229f, 0.47139673682599781f, 0.38268343236508984f, 0.29028467725446233f,
        0.19509032201612833f, 0.09801714032956077f, 0.0f};
    return t[k];
}
__host__ __device__ constexpr float cos64(int k) { k &= 63; return k <= 16 ? cos64q(k) : k <= 32 ? -cos64q(32 - k) : k <= 48 ? -cos64q(k - 32) : cos64q(64 - k); }
__host__ __device__ constexpr float sin64(int k) { return cos64((k + 48) & 63); }
template <int R> __host__ __device__ constexpr int brev(int k) { int r = 0; for (int b = 1; b < R; b <<= 1) { r = (r << 1) | (k & 1); k >>= 1; } return r; }

typedef _Float16 hcpx __attribute__((ext_vector_type(2)));
typedef _Float16 hcpx2 __attribute__((ext_vector_type(4)));
__device__ __forceinline__ hcpx h_of(cpx a) { hcpx r; r.x = (_Float16)a.x; r.y = (_Float16)a.y; return r; }
__device__ __forceinline__ cpx c_of(hcpx a) { return mkc((float)a.x, (float)a.y); }
__device__ __forceinline__ hcpx2 h2_of(cpx a, cpx b) { hcpx2 r; r.x = (_Float16)a.x; r.y = (_Float16)a.y; r.z = (_Float16)b.x; r.w = (_Float16)b.y; return r; }
#define VA __device__ __forceinline__ float
VA f_mul(float a, float b) { float r; asm("v_mul_f32_e32 %0, %1, %2" : "=v"(r) : "v"(a), "v"(b)); return r; }
VA f_fma(float a, float b, float c) { float r; asm("v_fma_f32 %0, %1, %2, %3" : "=v"(r) : "v"(a), "v"(b), "v"(c)); return r; }
VA f_fms(float a, float b, float c) { float r; asm("v_fma_f32 %0, %1, %2, -%3" : "=v"(r) : "v"(a), "v"(b), "v"(c)); return r; }
#undef VA
__device__ __forceinline__ cpx cmul(cpx a, cpx b) { float rx, ry;
    asm("v_mul_f32_e32 %0, %3, %5\n\tv_mul_f32_e32 %1, %3, %4\n\tv_fma_f32 %0, %2, %4, -%0\n\tv_fma_f32 %1, %2, %5, %1" : "=&v"(rx), "=&v"(ry) : "v"(a.x), "v"(a.y), "v"(b.x), "v"(b.y)); return mkc(rx, ry); }
__device__ __forceinline__ cpx cmulc(cpx a, cpx b) { float rx, ry;
    asm("v_mul_f32_e32 %0, %3, %5\n\tv_mul_f32_e32 %1, %2, %5\n\tv_fma_f32 %0, %2, %4, %0\n\tv_fma_f32 %1, %3, %4, -%1" : "=&v"(rx), "=&v"(ry) : "v"(a.x), "v"(a.y), "v"(b.x), "v"(b.y)); return mkc(rx, ry); }

template <int R, bool INV, int H, int P> __device__ __forceinline__ void bfly(cpx (&v)[R]) {
    constexpr int b = (P / H) * 2 * H, i = P % H, e = i * (32 / H);
    float ux = v[b + i].x, uy = v[b + i].y, wx = v[b + i + H].x, wy = v[b + i + H].y;
    if constexpr (e == 0) { float dx, dy;
        asm("v_sub_f32_e32 %2, %0, %4\n\tv_sub_f32_e32 %3, %1, %5\n\tv_add_f32_e32 %0, %0, %4\n\tv_add_f32_e32 %1, %1, %5" : "+v"(ux), "+v"(uy), "=&v"(dx), "=&v"(dy) : "v"(wx), "v"(wy));
        wx = dx; wy = dy; }
    else if constexpr (e == 16) { float ox, oy;
        if constexpr (!INV) asm("v_sub_f32_e32 %2, %1, %5\n\tv_sub_f32_e32 %3, %4, %0\n\tv_add_f32_e32 %0, %0, %4\n\tv_add_f32_e32 %1, %1, %5" : "+v"(ux), "+v"(uy), "=&v"(ox), "=&v"(oy) : "v"(wx), "v"(wy));
        else                asm("v_sub_f32_e32 %2, %5, %1\n\tv_sub_f32_e32 %3, %0, %4\n\tv_add_f32_e32 %0, %0, %4\n\tv_add_f32_e32 %1, %1, %5" : "+v"(ux), "+v"(uy), "=&v"(ox), "=&v"(oy) : "v"(wx), "v"(wy));
        wx = ox; wy = oy; }
    else { constexpr float c = cos64(e), s = INV ? sin64(e) : -sin64(e);
        constexpr unsigned cb = __builtin_bit_cast(unsigned, c), sb = __builtin_bit_cast(unsigned, s), nsb = __builtin_bit_cast(unsigned, -s);
        float dx, dy;
        asm("v_sub_f32_e32 %4, %0, %2\n\tv_sub_f32_e32 %5, %1, %3\n\tv_add_f32_e32 %0, %0, %2\n\tv_add_f32_e32 %1, %1, %3\n\t"
            "v_mul_f32_e32 %2, %8, %5\n\tv_mul_f32_e32 %3, %6, %5\n\tv_fmamk_f32 %2, %4, %6, %2\n\tv_fmamk_f32 %3, %4, %7, %3"
            : "+v"(ux), "+v"(uy), "+v"(wx), "+v"(wy), "=&v"(dx), "=&v"(dy) : "i"(cb), "i"(sb), "i"(nsb)); }
    v[b + i] = mkc(ux, uy); v[b + i + H] = mkc(wx, wy);
}
template <int R, bool INV, int H, int... Ps> __device__ __forceinline__ void dft_stage(cpx (&v)[R], std::integer_sequence<int, Ps...>) { (bfly<R, INV, H, Ps>(v), ...); }
template <int R, bool INV, int H> __device__ __forceinline__ void dft_stages(cpx (&v)[R]) {
    dft_stage<R, INV, H>(v, std::make_integer_sequence<int, R / 2>{});
    if constexpr (H > 1) dft_stages<R, INV, H / 2>(v);
}
template <int R, bool INV> __device__ __forceinline__ void dft_r2(cpx (&v)[R]) { dft_stages<R, INV, R / 2>(v); }
template <int R, bool CONJ, bool BREV> __device__ __forceinline__ void apply_pows(cpx (&v)[R], cpx w) {
    constexpr int H = R > 16 ? 16 : R;
    cpx pw[H];
    pw[1] = w;
#pragma unroll
    for (int k = 2; k < H; ++k) pw[k] = (k & 1) ? cmul(pw[k - 1], w) : cmul(pw[k / 2], pw[k / 2]);
#pragma unroll
    for (int k = 1; k < H; ++k) { const int idx = BREV ? brev<R>(k) : k; v[idx] = CONJ ? cmulc(v[idx], pw[k]) : cmul(v[idx], pw[k]); }
    if (R > 16) {
        const cpx w16 = cmul(pw[8], pw[8]);
#pragma unroll
        for (int k = 0; k < R - 16; ++k) { const cpx q = k == 0 ? w16 : cmul(pw[k], w16); const int idx = BREV ? brev<R>(16 + k) : 16 + k; v[idx] = CONJ ? cmulc(v[idx], q) : cmul(v[idx], q); }
    }
}
__device__ __forceinline__ int phys(int i) { return i + (i >> 5); }
constexpr int TW_OFF = 135168 + 64;
template <int S> __host__ __device__ constexpr int poff(int j) { return S >= 32 ? j * (S + S / 32) : j * S + ((j * S) >> 5); }
typedef hcpx PreRegs[32];
template <int R, int S> __device__ __forceinline__ void fft_prefetch(int t, const hcpx* gio, PreRegs& pre) {
    constexpr int G = 32 / R;
#pragma unroll
    for (int gi = 0; gi < G; ++gi) { const int gam = gi * 512 + t, hi = gam / S, lo = gam % S, base = hi * (R * S) + lo;
#pragma unroll
        for (int j = 0; j < R; ++j) pre[gi * R + j] = __builtin_nontemporal_load(gio + base + j * S); }
}
template <int R, int S, bool INV, int IO> __device__ __forceinline__ void fft_pass(LDSQ cpx* A, int t, hcpx* gio, const PreRegs& pre) {
    constexpr int G = 32 / R;
    asm volatile("" : "+v"(t) :: "memory");
    const LDSQ cpx* TW = (const LDSQ cpx*)((LDSQ unsigned char*)A + TW_OFF);
    cpx v[G][R]; cpx tw[G];
#pragma unroll
    for (int gi = 0; gi < G; ++gi) {
        const int gam = gi * 512 + t, hi = gam / S, lo = gam % S, base = hi * (R * S) + lo; const LDSQ cpx* Ab = A + phys(base);
#pragma unroll
        for (int j = 0; j < R; ++j) v[gi][j] = (IO == 3) ? c_of(pre[gi * R + j]) : (IO == 1) ? c_of(__builtin_nontemporal_load(gio + base + j * S)) : Ab[poff<S>(j)];
        tw[gi] = TW[lo * (16384 / (R * S))];
    }
#pragma unroll
    for (int gi = 0; gi < G; ++gi) {
        const int gam = gi * 512 + t, hi = gam / S, lo = gam % S, base = hi * (R * S) + lo; LDSQ cpx* Ab = A + phys(base);
        if (!INV) {
            dft_r2<R, false>(v[gi]);
            apply_pows<R, false, true>(v[gi], tw[gi]);
#pragma unroll
            for (int k = 0; k < R; ++k) { if (IO == 2) gio[base + k * S] = h_of(v[gi][brev<R>(k)]); else Ab[poff<S>(k)] = v[gi][brev<R>(k)]; }
        } else {
            apply_pows<R, true, false>(v[gi], tw[gi]);
            dft_r2<R, true>(v[gi]);
#pragma unroll
            for (int j = 0; j < R; ++j) { if (IO == 2) gio[base + j * S] = h_of(v[gi][brev<R>(j)]); else Ab[poff<S>(j)] = v[gi][brev<R>(j)]; }
        }
    }
}
template <int R, int MODE> __device__ __forceinline__ void fft_mid(LDSQ cpx* A, int t, hcpx* spec, float scale) {
    constexpr int G = 32 / R;
    asm volatile("" : "+v"(t) :: "memory");
    hcpx2 sp[G][R / 2];
    if (MODE == 1) {
#pragma unroll
        for (int gi = 0; gi < G; ++gi)
#pragma unroll
            for (int k2 = 0; k2 < R / 2; ++k2) sp[gi][k2] = *(const hcpx2*)(spec + 2 * (size_t)(k2 * (16384 / R) + gi * 512 + t));
    }
#pragma unroll
    for (int gi = 0; gi < G; ++gi) {
        const int gam = gi * 512 + t, base = gam * R;
        cpx v[R];
        LDSQ cpx* Ab = A + phys(base);
#pragma unroll
        for (int j = 0; j < R; ++j) v[j] = Ab[j];
        dft_r2<R, false>(v);
        if (MODE == 0) {
#pragma unroll
            for (int k2 = 0; k2 < R / 2; ++k2) { const cpx x = v[brev<R>(2 * k2)], y = v[brev<R>(2 * k2 + 1)];
                *(hcpx2*)(spec + 2 * (size_t)(k2 * (16384 / R) + gam)) = h2_of(mkc(x.x * scale, x.y * scale), mkc(y.x * scale, y.y * scale)); }
        } else {
            cpx x[R];
#pragma unroll
            for (int k2 = 0; k2 < R / 2; ++k2) { const hcpx2 s = sp[gi][k2]; x[2 * k2] = cmul(v[brev<R>(2 * k2)], mkc((float)s.x * scale, (float)s.y * scale)); x[2 * k2 + 1] = cmul(v[brev<R>(2 * k2 + 1)], mkc((float)s.z * scale, (float)s.w * scale)); }
            dft_r2<R, true>(x);
#pragma unroll
            for (int j = 0; j < R; ++j) Ab[j] = x[brev<R>(j)];
        }
    }
}
#define GL_DRAIN() asm volatile("s_waitcnt vmcnt(0)" ::: "memory")
struct NoHook { __device__ __forceinline__ void operator()() const {} };
template <int LOG2L, bool INV, int GIO, class Hook = NoHook> __device__ __forceinline__ void fft_outer(LDSQ cpx* A, int t, hcpx* gio, const hcpx* pfsrc, PreRegs& pre, Hook hook = Hook()) {
    constexpr int R1 = LOG2L == 14 ? 32 : 16, S1 = LOG2L == 14 ? 512 : 128, S2 = LOG2L == 14 ? 16 : 8;
    if (!INV) { fft_pass<R1, S1, false, GIO == 3 ? 3 : 0>(A, t, nullptr, pre); __syncthreads(); fft_pass<R1, S2, false, 0>(A, t, nullptr, pre); GL_DRAIN(); __syncthreads(); }
    else      { fft_pass<R1, S2, true, 0>(A, t, nullptr, pre); __syncthreads();
                if (GIO == 2) fft_prefetch<R1, S1>(t, pfsrc, pre);
                hook();
                fft_pass<R1, S1, true, GIO == 2 ? 2 : 0>(A, t, gio, pre); if (GIO != 2) GL_DRAIN(); __syncthreads(); }
}
template <int LOG2L, int SRC, int DST, class Hook = NoHook> __device__ __forceinline__ void fft_conv(LDSQ cpx* A, int t, hcpx* spec, hcpx* gdst, const hcpx* pfsrc, PreRegs& pre, Hook hook = Hook()) {
    fft_outer<LOG2L, false, SRC>(A, t, nullptr, nullptr, pre);
    fft_mid<LOG2L == 14 ? 16 : 8, 1>(A, t, spec, 1.0f / (float)(1 << LOG2L));
    if (SRC == 3) GL_DRAIN();
    __syncthreads();
    fft_outer<LOG2L, true, DST>(A, t, gdst, pfsrc, pre, hook);
}

__device__ __forceinline__ void sconv4r(u32x2 q, unsigned zmr, unsigned zpr, float w0, float w1, float w2, float bb, float (&o)[4]) {
    const float zm = __uint_as_float(zmr << 16), zp = __uint_as_float(zpr << 16);
    const float z0 = __uint_as_float(q.x << 16), z1 = __uint_as_float(q.x & 0xffff0000u), z2 = __uint_as_float(q.y << 16), z3 = __uint_as_float(q.y & 0xffff0000u);
    o[0] = w0 * zm + w1 * z0 + w2 * z1 + bb; o[1] = w0 * z0 + w1 * z1 + w2 * z2 + bb; o[2] = w0 * z1 + w1 * z2 + w2 * z3 + bb; o[3] = w0 * z2 + w1 * z3 + w2 * zp + bb;
}
typedef _Float16 h4 __attribute__((ext_vector_type(4)));
__device__ __forceinline__ void tapquad(h4 a, h4 bq, unsigned b0bits, float wf, float wb, float rf1, float rf2, float rf3, float rb1, float rb2, float rb3, float (&fa)[4], float (&fb)[4]) {
    const float b0 = (float)__builtin_bit_cast(_Float16, (unsigned short)b0bits);
    fa[0] = (float)a.x * wf; fa[1] = (float)a.y * (wf * rf1); fa[2] = (float)a.z * (wf * rf2); fa[3] = (float)a.w * (wf * rf3);
    fb[0] = b0 * wb; fb[1] = (float)bq.w * (wb * rb1); fb[2] = (float)bq.z * (wb * rb2); fb[3] = (float)bq.y * (wb * rb3);
}
template <int LOG2L> struct SweepIdx {
    static constexpr int L = 1 << LOG2L, QS = L / 32;
    int t, seq, n00, a00; cpx wq0, w1, w2, w3;
    __device__ __forceinline__ SweepIdx(int t_, bool need_w) { t = t_; asm volatile("" : "+v"(t) :: "memory"); seq = (LOG2L == 14) ? 0 : (t >> 6); const int q0 = (LOG2L == 14) ? t : (t & 63); n00 = 4 * q0; a00 = seq * L + n00;
        if (need_w) { float sb, cb; sincospif(-(float)n00 / (float)L, &sb, &cb); wq0 = mkc(cb, sb);
            sincospif(-1.0f / (float)L, &sb, &cb); w1 = mkc(cb, sb); w2 = cmul(w1, w1); w3 = cmul(w2, w1); } }
};
#define WQS mkc(0.92387953251128674f, -0.38268343236508978f)
struct TapWin { float wf0, wfs, rf1, rf2, rf3, wb0, wbs, rb1, rb2, rb3; };
template <int LOG2L> __device__ __forceinline__ TapWin tap_windows(float df, float db, int n00) {
    constexpr int L = 1 << LOG2L, QS = L / 32; TapWin w;
    w.wf0 = expf(-df * (float)n00); w.wfs = expf(-df * (float)(4 * QS)); w.rf1 = expf(-df); w.rf2 = w.rf1 * w.rf1; w.rf3 = w.rf2 * w.rf1;
    w.wb0 = expf(-db * (float)(L - n00)); w.wbs = expf(db * (float)(4 * QS)); w.rb1 = expf(db); w.rb2 = w.rb1 * w.rb1; w.rb3 = w.rb2 * w.rb1; return w;
}
template <int LOG2L> __device__ __forceinline__ void sweep_taps2(LDSQ cpx* A, int t_, const _Float16* tf0, const _Float16* tb0, const _Float16* tf1, const _Float16* tb1, float df0, float db0, float df1, float db1, hcpx* hos, float& ss0, float& ss1) {
    constexpr int L = 1 << LOG2L, QS = L / 32; const SweepIdx<LOG2L> X(t_, true);
    const TapWin W0 = tap_windows<LOG2L>(df0, db0, X.n00), W1 = tap_windows<LOG2L>(df1, db1, X.n00);
    float s0 = 0.f, s1 = 0.f, wf0 = W0.wf0, wb0 = W0.wb0, wf1 = W1.wf0, wb1 = W1.wb0;
    cpx wn = X.wq0;
    h4 ra0[8], rb0[8], ra1[8], rb1[8]; unsigned rc0[8], rc1[8];
#pragma unroll
    for (int i = 0; i < 8; ++i) { const int n = 4 * (i * QS) + X.n00, nb = n > 0 ? L - n : L - 1;
        ra0[i] = *(const h4*)(tf0 + n); rb0[i] = *(const h4*)(tb0 + L - n - 4); rc0[i] = ((const unsigned short*)tb0)[nb];
        ra1[i] = *(const h4*)(tf1 + n); rb1[i] = *(const h4*)(tb1 + L - n - 4); rc1[i] = ((const unsigned short*)tb1)[nb]; }
#pragma unroll
    for (int i = 0; i < 8; ++i) { const int n = 4 * (i * QS) + X.n00; float fa0[4], fb0[4], fa1[4], fb1[4]; const unsigned hm = n > 0 ? 0xffffu : 0u;
        tapquad(ra0[i], rb0[i], rc0[i] & hm, wf0, wb0, W0.rf1, W0.rf2, W0.rf3, W0.rb1, W0.rb2, W0.rb3, fa0, fb0);
        tapquad(ra1[i], rb1[i], rc1[i] & hm, wf1, wb1, W1.rf1, W1.rf2, W1.rf3, W1.rb1, W1.rb2, W1.rb3, fa1, fb1);
        LDSQ cpx* ap = A + phys(X.a00 + 4 * i * QS); hcpx* hp = hos + X.a00 + 4 * i * QS;
#pragma unroll
        for (int e = 0; e < 4; ++e) { s0 += fa0[e] * fa0[e] + fb0[e] * fb0[e]; s1 += fa1[e] * fa1[e] + fb1[e] * fb1[e]; ap[e] = mkc(fa0[e] + fb0[e], fa1[e] + fb1[e]); }
        const cpx wa = cmul(wn, X.w1), wb2 = cmul(wn, X.w2), wc = cmul(wn, X.w3);
        const cpx y0 = cmul(mkc(fa0[0] - fb0[0], fa1[0] - fb1[0]), wn), y1 = cmul(mkc(fa0[1] - fb0[1], fa1[1] - fb1[1]), wa);
        const cpx y2 = cmul(mkc(fa0[2] - fb0[2], fa1[2] - fb1[2]), wb2), y3 = cmul(mkc(fa0[3] - fb0[3], fa1[3] - fb1[3]), wc);
        *(hcpx2*)hp = h2_of(y0, y1); *(hcpx2*)(hp + 2) = h2_of(y2, y3);
        wn = cmul(wn, WQS); wf0 *= W0.wfs; wb0 *= W0.wbs; wf1 *= W1.wfs; wb1 *= W1.wbs; }
    ss0 = s0; ss1 = s1;
}
template <int LOG2L, int PART> __device__ __forceinline__ void fft_mid_sep(LDSQ cpx* A, int t, hcpx* spec0, hcpx* spec1, const LDSQ float* red, const float* skp0, const float* skp1) {
    constexpr int R = LOG2L == 14 ? 16 : 8, G = 32 / R, NB = LOG2L == 14 ? 32 : 16, NG = NB * NB;
    asm volatile("" : "+v"(t) :: "memory");
#pragma unroll
    for (int gi = 0; gi < G; ++gi) {
        cpx v[R]; LDSQ cpx* Ab = A + phys((gi * 512 + t) * R);
#pragma unroll
        for (int j = 0; j < R; ++j) v[j] = Ab[j];
        dft_r2<R, false>(v);
#pragma unroll
        for (int k = 0; k < R; ++k) Ab[k] = v[brev<R>(k)];
    }
    __syncthreads();
#pragma unroll
    for (int gi = 0; gi < G; ++gi) {
        const int gam = gi * 512 + t, seq = gam / NG, g = gam % NG, k1 = g / NB, k2 = g % NB;
        const int gp = PART == 1 ? NG - 1 - g : (k1 ? (NB - k1) * NB + (NB - 1 - k2) : (k2 ? NB - k2 : 0));
        const bool wrap = PART == 0 && g == 0;
        const LDSQ cpx* Ab = A + phys(gam * R); const LDSQ cpx* Ap = A + phys((seq * NG + gp) * R);
        cpx z[R], q[R];
#pragma unroll
        for (int k = 0; k < R; ++k) { z[k] = Ab[k]; q[k] = Ap[k]; }
        float ss0, ss1;
        if (LOG2L == 14) { ss0 = red[0] + red[1] + red[2] + red[3] + red[4] + red[5] + red[6] + red[7]; ss1 = red[8] + red[9] + red[10] + red[11] + red[12] + red[13] + red[14] + red[15]; }
        else { ss0 = red[seq]; ss1 = red[8 + seq]; }
        const float n0 = 0.25f / sqrtf(ss0 + EPS), n1 = 0.25f / sqrtf(ss1 + EPS), h0 = 0.5f * skp0[seq], h1 = 0.5f * skp1[seq];
        hcpx* s0p = spec0 + 2 * (size_t)gam; hcpx* s1p = spec1 + 2 * (size_t)gam;
#pragma unroll
        for (int k2_ = 0; k2_ < R / 2; ++k2_) { cpx o0[2], o1[2];
#pragma unroll
            for (int e = 0; e < 2; ++e) { const int k = 2 * k2_ + e; cpx zp = q[R - 1 - k]; const cpx zw = q[(R - k) & (R - 1)];
                if (PART == 0) { zp.x = wrap ? zw.x : zp.x; zp.y = wrap ? zw.y : zp.y; }
                o0[e] = mkc((z[k].x + zp.x) * n0 + h0, (z[k].y - zp.y) * n0); o1[e] = mkc((z[k].y + zp.y) * n1 + h1, (zp.x - z[k].x) * n1); }
            *(hcpx2*)(s0p + 2 * (size_t)(k2_ * (16384 / R))) = h2_of(o0[0], o0[1]); *(hcpx2*)(s1p + 2 * (size_t)(k2_ * (16384 / R))) = h2_of(o1[0], o1[1]); }
    }
}
template <int LOG2L> __device__ __forceinline__ void sweep_load_v(LDSQ cpx* A, int t_, const bf16_t* zrow, size_t tb0, const float* cw, const float* cbias, int rc0, hcpx* xw) {
    constexpr int L = 1 << LOG2L, QS = L / 32; const SweepIdx<LOG2L> X(t_, true);
    const int rc = rc0 + X.seq; const float cw0 = cw[rc], cw1 = cw[6144 + rc], cw2 = cw[2 * 6144 + rc], bb = cbias[rc];
    const bf16_t* z0 = zrow + (size_t)rc * T + tb0; const bf16_t* z1 = z0 + L;
    cpx wn = X.wq0;
    u32x2 rq[8][2]; unsigned rm[8][2], rp[8][2];
#pragma unroll
    for (int i = 0; i < 8; ++i) { const int n = 4 * (i * QS) + X.n00, nm = n > 0 ? n - 1 : 0, np = n + 4 < L ? n + 4 : L - 1;
        rq[i][0] = *(const u32x2*)(z0 + n); rq[i][1] = *(const u32x2*)(z1 + n); rm[i][0] = z0[nm]; rm[i][1] = z1[nm]; rp[i][0] = z0[np]; rp[i][1] = z1[np]; }
#pragma unroll
    for (int i = 0; i < 8; ++i) { const int n = 4 * (i * QS) + X.n00; float xa[4], xb[4]; const unsigned hm = n > 0 ? 0xffffu : 0u, hp = n + 4 < L ? 0xffffu : 0u;
        sconv4r(rq[i][0], rm[i][0] & hm, rp[i][0] & hp, cw0, cw1, cw2, bb, xa); sconv4r(rq[i][1], rm[i][1] & hm, rp[i][1] & hp, cw0, cw1, cw2, bb, xb);
        LDSQ cpx* ap = A + phys(X.a00 + 4 * i * QS); hcpx* xp = xw + X.a00 + 4 * i * QS;
        ap[0] = mkc(xa[0], xb[0]); ap[1] = mkc(xa[1], xb[1]); ap[2] = mkc(xa[2], xb[2]); ap[3] = mkc(xa[3], xb[3]);
        const cpx y0 = cmul(mkc(xa[0], xb[0]), wn), y1 = cmul(mkc(xa[1], xb[1]), cmul(wn, X.w1)), y2 = cmul(mkc(xa[2], xb[2]), cmul(wn, X.w2)), y3 = cmul(mkc(xa[3], xb[3]), cmul(wn, X.w3));
        *(hcpx2*)xp = h2_of(y0, y1); *(hcpx2*)(xp + 2) = h2_of(y2, y3);
        wn = cmul(wn, WQS); }
}
constexpr int CPA = 2;
template <int N> struct CombPreN { u32x2 q[N][2]; unsigned zm[N][2], zp[N][2]; hcpx2 h01[N], h23[N]; };
typedef CombPreN<CPA> CombPre;
template <int LOG2L, int I0, int N> __device__ __forceinline__ void combine_prefetch(int t_, const hcpx* yes, const bf16_t* zrow, size_t tb0, int rg0, CombPreN<N>& P) {
    constexpr int L = 1 << LOG2L, QS = L / 32; const SweepIdx<LOG2L> X(t_, false);
    const int rg = rg0 + X.seq; const bf16_t* g0 = zrow + (size_t)rg * T + tb0; const bf16_t* g1 = g0 + L;
#pragma unroll
    for (int i = 0; i < N; ++i) { const int n = 4 * ((I0 + i) * QS) + X.n00; const hcpx* yp = yes + X.a00 + 4 * (I0 + i) * QS;
        P.q[i][0] = *(const u32x2*)(g0 + n); P.q[i][1] = *(const u32x2*)(g1 + n);
        const int nm = n > 0 ? n - 1 : 0, np = n + 4 < L ? n + 4 : L - 1;
        P.zm[i][0] = g0[nm]; P.zm[i][1] = g1[nm]; P.zp[i][0] = g0[np]; P.zp[i][1] = g1[np];
        P.h01[i] = __builtin_nontemporal_load((const hcpx2*)yp); P.h23[i] = __builtin_nontemporal_load((const hcpx2*)(yp + 2)); }
}
template <int LOG2L, int FINAL> __device__ __forceinline__ void sweep_combine(LDSQ cpx* A, int t_, const CombPre& P0, const hcpx* yes, hcpx* xw, bf16_t* zrow, size_t tb0, const float* cw, const float* cbias, int rg0, int ro0, int dry) {
    constexpr int L = 1 << LOG2L, QS = L / 32; const SweepIdx<LOG2L> X(t_, true);
    CombPreN<8 - CPA> P1; combine_prefetch<LOG2L, CPA>(X.t, yes, zrow, tb0, rg0, P1);
    const int rg = rg0 + X.seq; const float cw0 = cw[rg], cw1 = cw[6144 + rg], cw2 = cw[2 * 6144 + rg], bb = cbias[rg];
    bf16_t* o0 = zrow + (size_t)(ro0 + X.seq) * T + tb0; bf16_t* o1 = o0 + L;
    cpx wn = X.wq0;
#pragma unroll
    for (int i = 0; i < 8; ++i) { const int n = 4 * (i * QS) + X.n00; float ga[4], gb[4];
        const bool ah = i < CPA; const int ia = ah ? i : 0, ib = ah ? 0 : i - CPA;
        const unsigned hm = n > 0 ? 0xffffu : 0u, hp = n + 4 < L ? 0xffffu : 0u;
        sconv4r(ah ? P0.q[ia][0] : P1.q[ib][0], (ah ? P0.zm[ia][0] : P1.zm[ib][0]) & hm, (ah ? P0.zp[ia][0] : P1.zp[ib][0]) & hp, cw0, cw1, cw2, bb, ga);
        sconv4r(ah ? P0.q[ia][1] : P1.q[ib][1], (ah ? P0.zm[ia][1] : P1.zm[ib][1]) & hm, (ah ? P0.zp[ia][1] : P1.zp[ib][1]) & hp, cw0, cw1, cw2, bb, gb);
        const LDSQ cpx* ap = A + phys(X.a00 + 4 * i * QS);
        const hcpx2 h01 = ah ? P0.h01[ia] : P1.h01[ib], h23 = ah ? P0.h23[ia] : P1.h23[ib];
        const f32x4 e01 = {(float)h01.x, (float)h01.y, (float)h01.z, (float)h01.w}, e23 = {(float)h23.x, (float)h23.y, (float)h23.z, (float)h23.w};
        const cpx wa = cmul(wn, X.w1), wb2 = cmul(wn, X.w2), wc = cmul(wn, X.w3);
        const cpx r0 = cmulc(ap[0], wn), r1 = cmulc(ap[1], wa), r2 = cmulc(ap[2], wb2), r3 = cmulc(ap[3], wc);
        const cpx s0 = mkc(ga[0] * (e01[0] + r0.x), gb[0] * (e01[1] + r0.y)), s1 = mkc(ga[1] * (e01[2] + r1.x), gb[1] * (e01[3] + r1.y));
        const cpx s2 = mkc(ga[2] * (e23[0] + r2.x), gb[2] * (e23[1] + r2.y)), s3 = mkc(ga[3] * (e23[2] + r3.x), gb[3] * (e23[3] + r3.y));
        if (FINAL == 0) { LDSQ cpx* aw = A + phys(X.a00 + 4 * i * QS); hcpx* xp = xw + X.a00 + 4 * i * QS;
            aw[0] = s0; aw[1] = s1; aw[2] = s2; aw[3] = s3;
            const cpx y0 = cmul(s0, wn), y1 = cmul(s1, wa), y2 = cmul(s2, wb2), y3 = cmul(s3, wc);
            *(hcpx2*)xp = h2_of(y0, y1); *(hcpx2*)(xp + 2) = h2_of(y2, y3); }
        else if (!dry) { u32x2 wa2, wb3; wa2.x = cvt_pk_bf16(s0.x, s1.x); wa2.y = cvt_pk_bf16(s2.x, s3.x); wb3.x = cvt_pk_bf16(s0.y, s1.y); wb3.y = cvt_pk_bf16(s2.y, s3.y);
            *(u32x2*)(o0 + n) = wa2; *(u32x2*)(o1 + n) = wb3; }
        wn = cmul(wn, WQS); }
}
template <int LOG2L> __device__ __forceinline__ void hyena_item(const Params& p, LDSQ unsigned char* lds, int layer_j, int c0, int dry) {
    constexpr int L = 1 << LOG2L, NPAIR = (LOG2L == 14) ? 1 : 2;
    constexpr int TOK0 = (LOG2L == 14) ? 0 : T_P, PB = (LOG2L == 14) ? 0 : 16384;
    LDSQ cpx* A = (LDSQ cpx*)lds;
    LDSQ float* red = (LDSQ float*)(lds + 135168);
    const int t = pg8::otid(), ch = c0 + ((LOG2L == 14) ? 0 : (t >> 6));
    bf16_t* zin = (bf16_t*)(p.ws + WS_BIG + BIG_ZINT);
    const _Float16* taps = (const _Float16*)(p.ws + WS_BIG + BIG_TAPS);
    hcpx* scr = (hcpx*)(p.ws + WS_H + (size_t)pg8::obid() * FFT_SCR_PER_WG);
    hcpx* u1s = scr + (size_t)4 * 16384;
    hcpx* yes = (hcpx*)(p.ws + WS_END + (size_t)pg8::obid() * FFT_EXT_PER_WG);
    PreRegs pre;
    hcpx* xw = yes + 16384;
    {
        const _Float16* tf0 = taps + (size_t)(0 * 2048 + ch) * NPOS + PB; const _Float16* tb0 = taps + (size_t)(1 * 2048 + ch) * NPOS + PB;
        const _Float16* tf1 = taps + (size_t)(2 * 2048 + ch) * NPOS + PB; const _Float16* tb1 = taps + (size_t)(3 * 2048 + ch) * NPOS + PB;
        const float* dec = p.hy_decay + (size_t)layer_j * 8192 + ch;
        const float df0 = fabsf(dec[0]) * (1.0f / (float)(L - 1)), db0 = fabsf(dec[2048]) * (1.0f / (float)(L - 1));
        const float df1 = fabsf(dec[4096]) * (1.0f / (float)(L - 1)), db1 = fabsf(dec[6144]) * (1.0f / (float)(L - 1));
        float ss0, ss1;
        sweep_taps2<LOG2L>(A, t, tf0, tb0, tf1, tb1, df0, db0, df1, db1, xw, ss0, ss1);
        ss0 = wave_sum(ss0); ss1 = wave_sum(ss1);
        if ((t & 63) == 0) { red[t >> 6] = ss0; red[8 + (t >> 6)] = ss1; }
        __syncthreads();
        const float* skp0 = p.hy_skip + (size_t)layer_j * 2 * 2048 + c0; const float* skp1 = skp0 + 2048;
        fft_outer<LOG2L, false, 0>(A, t, nullptr, nullptr, pre);
        fft_prefetch<LOG2L == 14 ? 32 : 16, LOG2L == 14 ? 512 : 128>(t, xw, pre);
        fft_mid_sep<LOG2L, 0>(A, t, scr + (size_t)0 * 16384, scr + (size_t)2 * 16384, red, skp0, skp1); __syncthreads();
        fft_outer<LOG2L, false, 3>(A, t, nullptr, nullptr, pre);
        fft_mid_sep<LOG2L, 1>(A, t, scr + (size_t)1 * 16384, scr + (size_t)3 * 16384, red, skp0, skp1); __syncthreads();
    }
    const float* cw = p.hy_conv_w + (size_t)layer_j * 3 * 6144; const float* cbias = p.hy_conv_b + (size_t)layer_j * 6144;
#pragma unroll 1
    for (int pr = 0; pr < NPAIR; ++pr) {
        const size_t tb0 = (size_t)TOK0 + (size_t)(2 * pr) * L;
        sweep_load_v<LOG2L>(A, t, zin, tb0, cw, cbias, 2 * 2048 + c0, xw); __syncthreads();
        fft_conv<LOG2L, 0, 2>(A, t, scr + (size_t)0 * 16384, yes, xw, pre);
        CombPre cp;
        fft_conv<LOG2L, 3, 0>(A, t, scr + (size_t)1 * 16384, nullptr, nullptr, pre, [&]() { combine_prefetch<LOG2L, 0>(t, yes, zin, tb0, c0, cp); });
        sweep_combine<LOG2L, 0>(A, t, cp, yes, xw, zin, tb0, cw, cbias, c0, c0, dry); __syncthreads();
        fft_conv<LOG2L, 0, 2>(A, t, scr + (size_t)2 * 16384, yes, xw, pre);
        fft_conv<LOG2L, 3, 0>(A, t, scr + (size_t)3 * 16384, nullptr, nullptr, pre, [&]() { combine_prefetch<LOG2L, 0>(t, yes, zin, tb0, 2048 + c0, cp); });
        sweep_combine<LOG2L, 1>(A, t, cp, yes, xw, zin, tb0, cw, cbias, 2048 + c0, c0, dry); __syncthreads();
    }
}
__device__ __forceinline__ void hyena_conv_phase(const Params& p, LDSQ unsigned char* lds, int layer_j, int dry) {
    { LDSQ cpx* TW = (LDSQ cpx*)(lds + TW_OFF);
      for (int e = pg8::otid(); e < 1024; e += NTHR) { float sn, cs; sincospif(-2.0f * (float)e / 16384.0f, &sn, &cs); TW[e] = mkc(cs, sn); }
      __syncthreads(); }
    for (int it = pg8::obid(); it < 2048; it += pg8::ogrid()) hyena_item<14>(p, lds, layer_j, it, dry);
    for (int it = pg8::obid(); it < 256; it += pg8::ogrid()) hyena_item<11>(p, lds, layer_j, it * 8, dry);
}

__device__ __forceinline__ void attn_phase(const Params& p, LDSQ unsigned char* lds, int dry = 0) {
    constexpr int KROW = 272, VROW = 264;
    LDSQ unsigned char* Kl = lds; LDSQ bf16_t* VT = (LDSQ bf16_t*)(lds + 256 * KROW);
    const bf16_t* qkv = (const bf16_t*)(p.ws + WS_BIG + BIG_QKV);
    bf16_t* og = (bf16_t*)(p.ws + WS_BIG + BIG_OG); float* lse = (float*)(p.ws + WS_BIG + BIG_LSE);
    const int tid = pg8::otid(), lane = tid & 63, wid = __builtin_amdgcn_readfirstlane(tid >> 6), l15 = lane & 15, g4 = lane >> 4;
    const int blk = wid >> 2, qq = 16 * (wid & 3) + l15;
    for (int u = pg8::obid(); u < 1792 + 512; u += pg8::ogrid()) {
        const int it = u < 1792 ? 4 * u : 7168 + (u - 1792), len = u < 1792 ? 4 : 1;
        int g, b, hh, rho, pp0, L, tokbase;
        if (it < 6144) { g = it >> 11; const int rem = it & 2047; const int npp = 128 >> (2 * g); pp0 = rem % npp; rho = (rem / npp) & ((1 << (2 * g)) - 1); hh = (rem >> 7) & 7; b = rem >> 10; L = L_P; tokbase = 0; }
        else { const int i2 = it - 6144; g = i2 >> 9; const int rem = i2 & 511; const int npp = 16 >> (2 * g); pp0 = rem % npp; rho = (rem / npp) & ((1 << (2 * g)) - 1); hh = (rem >> 4) & 7; b = rem >> 7; L = L_S; tokbase = T_P; }
        const int rsh = 2 * g, n = L >> rsh;
        const size_t tok0 = (size_t)tokbase + (size_t)b * L + rho;
        const int qcol = g * 3072 + hh * 128, kcol = qcol + 1024, vcol = qcol + 2048;
        u32x4 kr[2][4], vr[2][4];
        auto request_half = [&](int ih, u32x4 (&kh)[4], u32x4 (&vh)[4]) {
#pragma unroll
            for (int s4 = 0; s4 < 4; ++s4) { const int ci = tid + 512 * s4;
                { const int slot = ci >> 4, chn = ci & 15, i = ih + slot, ic = i < 0 ? 0 : (i < n ? i : n - 1); kh[s4] = *(const u32x4*)(qkv + (tok0 + ((size_t)ic << rsh)) * QKVW + kcol + chn * 8); }
                { const int slot = (ci & 15) + 16 * ((ci >> 6) & 7), chn = ((ci >> 4) & 3) + 4 * (ci >> 9), i = ih + slot, ic = i < 0 ? 0 : (i < n ? i : n - 1); vh[s4] = *(const u32x4*)(qkv + (tok0 + ((size_t)ic << rsh)) * QKVW + vcol + chn * 8); } } };
        auto stage_half = [&](int ih, int ring0, const u32x4 (&kh)[4], const u32x4 (&vh)[4]) {
#pragma unroll
            for (int s4 = 0; s4 < 4; ++s4) { const int ci = tid + 512 * s4;
                { const int slot = ci >> 4, chn = ci & 15, i = ih + slot; const unsigned ok = (i >= 0 && i < n) ? 0xffffffffu : 0u;
                  u32x4 v = kh[s4]; v.x &= ok; v.y &= ok; v.z &= ok; v.w &= ok;
                  *(LDSQ u32x4*)(Kl + (ring0 + slot) * KROW + chn * 16) = v; }
                { const int slot = (ci & 15) + 16 * ((ci >> 6) & 7), chn = ((ci >> 4) & 3) + 4 * (ci >> 9), i = ih + slot; const unsigned ok = (i >= 0 && i < n) ? 0xffffffffu : 0u;
                  u32x4 v = vh[s4]; v.x &= ok; v.y &= ok; v.z &= ok; v.w &= ok;
                  LDSQ bf16_t* vp = VT + (32 * (chn >> 2) + 4 * (chn & 3)) * VROW + ring0 + slot;
                  vp[0] = (bf16_t)(v.x & 0xffffu); vp[VROW] = (bf16_t)(v.x >> 16); vp[2 * VROW] = (bf16_t)(v.y & 0xffffu); vp[3 * VROW] = (bf16_t)(v.y >> 16);
                  vp[16 * VROW] = (bf16_t)(v.z & 0xffffu); vp[17 * VROW] = (bf16_t)(v.z >> 16); vp[18 * VROW] = (bf16_t)(v.w & 0xffffu); vp[19 * VROW] = (bf16_t)(v.w >> 16); } } };
        request_half(128 * pp0 - 64, kr[0], vr[0]); request_half(128 * pp0 + 64, kr[1], vr[1]);
#pragma unroll 1
        for (int s = 0; s < len; ++s) {
            const int pp = pp0 + s, i0 = 128 * pp - 64, off = (128 * pp) & 255;
            const int qi = 128 * pp + 64 * blk + qq;
            const size_t tq = tok0 + ((size_t)qi << rsh);
            bf16x8 bq[4];
#pragma unroll
            for (int ks = 0; ks < 4; ++ks) bq[ks] = *(const bf16x8*)(qkv + tq * QKVW + qcol + 32 * ks + 8 * g4);
            if (s == 0) stage_half(i0, off, kr[0], vr[0]);
            stage_half(i0 + 128, (128 + off) & 255, kr[1], vr[1]);
            __syncthreads();
            const int ktb = wid & 3;
            f32x4 sc[10]; bf16x8 kf[2][4];
            __builtin_amdgcn_s_setprio(1);
            auto kload = [&](int j, bf16x8 (&f)[4]) { const int rb = (64 * blk + 16 * (ktb + j) + off) & 255;
#pragma unroll
                for (int ks = 0; ks < 4; ++ks) f[ks] = *(const LDSQ bf16x8*)(Kl + (rb + l15) * KROW + (32 * ks + 8 * g4) * 2); };
            kload(0, kf[0]);
#pragma unroll
            for (int j = 0; j < 9; ++j) {
                if (j + 1 < 9) kload(j + 1, kf[(j + 1) & 1]);
                __builtin_amdgcn_sched_barrier(0);
                f32x4 a = {0.f, 0.f, 0.f, 0.f};
#pragma unroll
                for (int ks = 0; ks < 4; ++ks) a = __builtin_amdgcn_mfma_f32_16x16x32_bf16(kf[j & 1][ks], bq[ks], a, 0, 0, 0);
                sc[j] = a;
                __builtin_amdgcn_sched_barrier(0); }
            __builtin_amdgcn_s_setprio(0);
            if (s + 1 < len) request_half(i0 + 256, kr[1], vr[1]);
            const int ibase = 128 * pp + 64 * blk - 64;
            const int klo = qq > -ibase ? qq : -ibase, khi = (qq + 128 < n - 1 - ibase) ? qq + 128 : n - 1 - ibase;
            const unsigned kspan = (unsigned)(khi - klo); const int kk0 = 4 * g4 - klo + 16 * ktb;
            float mx = -3.0e38f;
#pragma unroll
            for (int j = 0; j < 9; ++j)
#pragma unroll
                for (int r = 0; r < 4; ++r) { const bool ok = (unsigned)(kk0 + 16 * j + r) <= kspan;
                    sc[j][r] = ok ? sc[j][r] : -3.0e38f; mx = fmaxf(mx, sc[j][r]); }
            mx = fmaxf(mx, __shfl_xor(mx, 16)); mx = fmaxf(mx, __shfl_xor(mx, 32));
            float ls = 0.f;
#pragma unroll
            for (int j = 0; j < 9; ++j)
#pragma unroll
                for (int r = 0; r < 4; ++r) { const float e = __builtin_amdgcn_exp2f(sc[j][r] - mx); sc[j][r] = e; ls += e; }
            sc[9] = (f32x4){0.f, 0.f, 0.f, 0.f};
            ls += __shfl_xor(ls, 16); ls += __shfl_xor(ls, 32);
            f32x4 oa[8];
#pragma unroll
            for (int dt = 0; dt < 8; ++dt) oa[dt] = (f32x4){0.f, 0.f, 0.f, 0.f};
            u32x2 vf[2][4][2];
            auto vload = [&](int gidx, u32x2 (&f)[4][2]) { const int k2 = gidx >> 1, d0 = (gidx & 1) * 4;
                const int cb0 = (64 * blk + 16 * ktb + 32 * k2 + off) & 255, cb1 = (cb0 + 16) & 255;
#pragma unroll
                for (int d = 0; d < 4; ++d) { const LDSQ bf16_t* vq = VT + (16 * (d0 + d) + l15) * VROW + 4 * g4; f[d][0] = *(const LDSQ u32x2*)(vq + cb0); f[d][1] = *(const LDSQ u32x2*)(vq + cb1); } };
            __builtin_amdgcn_s_setprio(1);
            vload(0, vf[0]);
#pragma unroll
            for (int gidx = 0; gidx < 10; ++gidx) { const int k2 = gidx >> 1, d0 = (gidx & 1) * 4;
                if (gidx + 1 < 10) vload(gidx + 1, vf[(gidx + 1) & 1]);
                __builtin_amdgcn_sched_barrier(0);
                union { u32x4 u; bf16x8 h; } pb;
                pb.u.x = cvt_pk_bf16(sc[2 * k2][0], sc[2 * k2][1]); pb.u.y = cvt_pk_bf16(sc[2 * k2][2], sc[2 * k2][3]);
                pb.u.z = cvt_pk_bf16(sc[2 * k2 + 1][0], sc[2 * k2 + 1][1]); pb.u.w = cvt_pk_bf16(sc[2 * k2 + 1][2], sc[2 * k2 + 1][3]);
#pragma unroll
                for (int d = 0; d < 4; ++d) { union { u32x4 u; bf16x8 h; } va; const u32x2 lo = vf[gidx & 1][d][0], hi = vf[gidx & 1][d][1];
                    va.u.x = lo.x; va.u.y = lo.y; va.u.z = hi.x; va.u.w = hi.y;
                    oa[d0 + d] = __builtin_amdgcn_mfma_f32_16x16x32_bf16(va.h, pb.h, oa[d0 + d], 0, 0, 0); }
                __builtin_amdgcn_sched_barrier(0); }
            __builtin_amdgcn_s_setprio(0);
            const float inv = 1.0f / ls;
            const size_t gt = (size_t)g * T + tq;
#pragma unroll
            for (int q = 0; q < 4; ++q) { u32x4 w; w.x = cvt_pk_bf16(oa[2 * q][0] * inv, oa[2 * q][1] * inv); w.y = cvt_pk_bf16(oa[2 * q][2] * inv, oa[2 * q][3] * inv);
                w.z = cvt_pk_bf16(oa[2 * q + 1][0] * inv, oa[2 * q + 1][1] * inv); w.w = cvt_pk_bf16(oa[2 * q + 1][2] * inv, oa[2 * q + 1][3] * inv);
                if (!dry) *(u32x4*)(og + gt * 1024 + hh * 128 + 32 * q + 8 * g4) = w; }
            if (g4 == 0 && !dry) lse[gt * 8 + hh] = mx + log2f(ls);
            __syncthreads();
        }
    }
}
__device__ __forceinline__ void attn_merge_phase(const Params& p) {
    const bf16_t* og = (const bf16_t*)(p.ws + WS_BIG + BIG_OG); const float* lse = (const float*)(p.ws + WS_BIG + BIG_LSE); bf16_t* H = (bf16_t*)(p.ws + WS_H);
    const int stride = pg8::ogrid() * NTHR;
    for (int i0 = pg8::obid() * NTHR + pg8::otid(); i0 < T * 128; i0 += 4 * stride) {
        u32x4 v0[4], v1[4], v2[4]; float l0[4], l1[4], l2[4];
#pragma unroll
        for (int u = 0; u < 4; ++u) { const int i = i0 + u * stride; if (i < T * 128) { const int tok = i >> 7, c8 = i & 127, hh = c8 >> 4;
            l0[u] = lse[(size_t)tok * 8 + hh]; l1[u] = lse[((size_t)T + tok) * 8 + hh]; l2[u] = lse[((size_t)2 * T + tok) * 8 + hh];
            v0[u] = *(const u32x4*)(og + (size_t)tok * 1024 + c8 * 8); v1[u] = *(const u32x4*)(og + ((size_t)T + tok) * 1024 + c8 * 8); v2[u] = *(const u32x4*)(og + ((size_t)2 * T + tok) * 1024 + c8 * 8); } }
#pragma unroll
        for (int u = 0; u < 4; ++u) { const int i = i0 + u * stride; if (i < T * 128) { const int tok = i >> 7, c8 = i & 127;
            const float m = fmaxf(l0[u], fmaxf(l1[u], l2[u])); float a0 = exp2f(l0[u] - m), a1 = exp2f(l1[u] - m), a2 = exp2f(l2[u] - m); const float is = 1.0f / (a0 + a1 + a2); a0 *= is; a1 *= is; a2 *= is;
            u32x4 w;
#pragma unroll
            for (int e = 0; e < 4; ++e) { const float lo = a0 * __uint_as_float(v0[u][e] << 16) + a1 * __uint_as_float(v1[u][e] << 16) + a2 * __uint_as_float(v2[u][e] << 16);
                const float hi = a0 * __uint_as_float(v0[u][e] & 0xffff0000u) + a1 * __uint_as_float(v1[u][e] & 0xffff0000u) + a2 * __uint_as_float(v2[u][e] & 0xffff0000u);
                w[e] = cvt_pk_bf16(lo, hi); }
            *(u32x4*)(H + (size_t)tok * 1024 + c8 * 8) = w; } }
    }
}

constexpr int NPHASE = 35;
typedef const __attribute__((address_space(4))) unsigned char* KARG;
template <class Tp> __device__ __forceinline__ Tp karg(int byte_off) { return *(volatile const __attribute__((address_space(4))) Tp*)((KARG)__builtin_amdgcn_kernarg_segment_ptr() + byte_off); }
#define PA(q, member) q.member = karg<decltype(Params::member)>((int)__builtin_offsetof(Params, member))
__global__ void __launch_bounds__(512, 2) mega(Params parg) {
    extern __shared__ __attribute__((aligned(16))) unsigned char shm[];
    LDSQ unsigned char* lds = (LDSQ unsigned char*)shm;
    const int tid = pg8::otid();
    volatile LDSQ unsigned* misc = (volatile LDSQ unsigned*)(lds + LDS_MISC);
    if (tid < 8) misc[tid] = 0u;
    __syncthreads();
    const int ph_lo = parg.ph_lo, ph_hi = parg.ph_hi, probe = parg.probe;
#define REPS(bit, lay) (1 + (1 + ((probe >> 15) & 1)) * (((probe >> (bit)) & 1) & ((((probe >> 10) & 3) == 0) | ((probe >> (10 + ((lay) & 1))) & 1))))
    XcdBarrier bar; bar.bar = nullptr; bar.x = 0; bar.st = misc;
    if (ph_hi - ph_lo > 1) { Params q{}; PA(q, ws); bar = xcd_barrier_post((unsigned*)(q.ws + WS_CTL), misc); }
#define IN(k) (ph_lo <= (k) && (k) < ph_hi)
#define REPBAR() do { if (((probe >> 16) & 1) && rep + 1 < nrep) { Params qb{}; PA(qb, ws); bar.bar = (unsigned*)(qb.ws + WS_CTL); xcd_barrier(bar); } } while (0)
#define SEAM(k) do { if (IN(k) && IN((k) + 1)) { Params qb{}; PA(qb, ws); bar.bar = (unsigned*)(qb.ws + WS_CTL); xcd_barrier(bar); if ((probe >> 12) & 1) { xcd_barrier(bar); xcd_barrier(bar); } } } while (0)

    for (int rep = 0, nrep = REPS(0, 0); rep < nrep; ++rep)
    if (IN(0)) { Params q{}; PA(q, ws); PA(q, c_prompt); PA(q, c_sample); PA(q, ada_w); PA(q, final_ada_w); ada_partials(q, lds); rope_table(q);
                 PA(q, hy_fw1); PA(q, hy_fb1); PA(q, hy_ffreq); PA(q, hy_fw2); PA(q, hy_fb2); PA(q, hy_fw3); filter_mlp(q); }
    SEAM(0);
    for (int rep = 0, nrep = REPS(0, 0); rep < nrep; ++rep)
    if (IN(1)) { Params q{}; PA(q, ws); PA(q, ada_b); PA(q, final_ada_b); ada_reduce(q); }
    SEAM(1);
#pragma unroll 1
    for (int layer = 0; layer < 4; ++layer) {
        const int pb = 2 + 8 * layer, j = layer >> 1; const bool hy = (layer & 1) == 0;
        for (int rep = 0, nrep = REPS(1, layer); rep < nrep; ++rep)
        if (IN(pb + 0)) {
            Params q{}; PA(q, ws); unsigned char* wl = q.ws + WS_WL;
            PA(q, ffn_w_gate); convert_T(lds, q.ffn_w_gate + (size_t)layer * 2048 * DFF, 2048, DFF, (bf16_t*)(wl + WL_FFN1), 0);
            PA(q, ffn_w_up);   convert_T(lds, q.ffn_w_up + (size_t)layer * 2048 * DFF, 2048, DFF, (bf16_t*)(wl + WL_FFN1), 1);
            PA(q, ffn_w_down); convert_T(lds, q.ffn_w_down + (size_t)layer * DFF * 2048, DFF, 2048, (bf16_t*)(wl + WL_FFN2), -1);
            if (hy) { PA(q, hy_w_in);  convert_T(lds, q.hy_w_in + (size_t)j * 2048 * 6144, 2048, 6144, (bf16_t*)(wl + WL_MIXIN), -1);
                      PA(q, hy_w_out); convert_T(lds, q.hy_w_out + (size_t)j * 2048 * 2048, 2048, 2048, (bf16_t*)(wl + WL_MIXOUT), -1); }
            else    { PA(q, at_w_in);  convert_T(lds, q.at_w_in + (size_t)j * 2048 * QKVW, 2048, QKVW, (bf16_t*)(wl + WL_MIXIN), -1);
                      PA(q, at_w_out); convert_T(lds, q.at_w_out + (size_t)j * 1024 * 2048, 1024, 2048, (bf16_t*)(wl + WL_MIXOUT), -1); }
            PA(q, norm_mix);
            const float* modl = (const float*)(q.ws + WS_MOD) + layer * 12288;
            if (layer == 0) { PA(q, x_prompt); PA(q, x_sample); norm_rows<false, true>(q.x_prompt, q.x_sample, (bf16_t*)(q.ws + WS_XB), q.norm_mix + layer * 2048, modl, 0, 2048, (bf16_t*)(q.ws + WS_H), nullptr); }
            else            norm_rows<false, false>(nullptr, nullptr, (bf16_t*)(q.ws + WS_XB), q.norm_mix + layer * 2048, modl, 0, 2048, (bf16_t*)(q.ws + WS_H), nullptr);
            if (hy) { __syncthreads();
                pg8::Gemm g{(const bf16_t*)(q.ws + WS_W3X) + (size_t)j * 8192 * 256, (const bf16_t*)(q.ws + WS_A2X) + (size_t)j * NPOS * 256, 8192, NPOS, 256};
                pg8::StaticOrder S; S.init(8192, NPOS, pg8::ogrid(), pg8::obid());
                EpiTaps E{(_Float16*)(q.ws + WS_BIG + BIG_TAPS)};
                pg8::gemm_phase<EpiTaps, pg8::StaticOrder, false>(lds, g, S, E, nullptr); }
        }
        SEAM(pb + 0);
        for (int rep = 0, nrep = REPS(2, layer); rep < nrep; ++rep)
        if (IN(pb + 1)) {
            Params q{}; PA(q, ws);
            if (hy) { PA(q, hy_b_in); pg8::Gemm g{(const bf16_t*)(q.ws + WS_WL + WL_MIXIN), (const bf16_t*)(q.ws + WS_H), 6144, T, 2048}; pg8::StaticOrder S; S.init(6144, T, pg8::ogrid(), pg8::obid());
                EpiZinT E{(bf16_t*)(q.ws + WS_BIG + BIG_ZINT), T, q.hy_b_in + (size_t)j * 6144};
                pg8::gemm_phase<EpiZinT, pg8::StaticOrder, false>(lds, g, S, E, nullptr); }
            else { pg8::Gemm g{(const bf16_t*)(q.ws + WS_H), (const bf16_t*)(q.ws + WS_WL + WL_MIXIN), T, QKVW, 2048}; pg8::StaticOrder S; S.init(T, QKVW, pg8::ogrid(), pg8::obid());
                EpiQKV E{(bf16_t*)(q.ws + WS_BIG + BIG_QKV), (const cpx*)(q.ws + WS_ROPE)};
                pg8::gemm_phase<EpiQKV, pg8::StaticOrder, false>(lds, g, S, E, nullptr); }
            REPBAR();
        }
        SEAM(pb + 1);
        for (int rep = 0, nrep = REPS(3, layer); rep < nrep; ++rep)
        if (IN(pb + 2)) { Params q{}; PA(q, ws); if (hy) { PA(q, hy_skip); PA(q, hy_conv_w); PA(q, hy_conv_b); PA(q, hy_decay); hyena_conv_phase(q, lds, j, rep + 1 < nrep); } else attn_phase(q, lds, (rep + 1 < nrep) ? (1 | ((probe >> 12) & 2)) : 0); }
        SEAM(pb + 2);
        for (int rep = 0, nrep = REPS(4, layer); rep < nrep; ++rep)
        if (IN(pb + 3)) { Params q{}; PA(q, ws); if (hy) transpose_phase(q, lds); else attn_merge_phase(q); }
        SEAM(pb + 3);
        for (int rep = 0, nrep = REPS(5, layer); rep < nrep; ++rep)
        if (IN(pb + 4)) {
            Params q{}; PA(q, ws); PA(q, hy_b_out);
            pg8::Gemm g{(const bf16_t*)(q.ws + WS_H), (const bf16_t*)(q.ws + WS_WL + WL_MIXOUT), T, 2048, hy ? 2048 : 1024}; pg8::StaticOrder S; S.init(T, 2048, pg8::ogrid(), pg8::obid());
            EpiRes E{(bf16_t*)(q.ws + WS_XB), hy ? q.hy_b_out + (size_t)j * 2048 : nullptr, (const float*)(q.ws + WS_MOD) + layer * 12288 + 4096, rep + 1 < nrep};
            pg8::gemm_phase<EpiRes, pg8::StaticOrder, false>(lds, g, S, E, nullptr);
            REPBAR();
        }
        SEAM(pb + 4);
        for (int rep = 0, nrep = REPS(6, layer); rep < nrep; ++rep)
        if (IN(pb + 5)) { Params q{}; PA(q, ws); PA(q, norm_ffn);
            norm_rows<false, false>(nullptr, nullptr, (bf16_t*)(q.ws + WS_XB), q.norm_ffn + layer * 2048, (const float*)(q.ws + WS_MOD) + layer * 12288, 6144, 8192, (bf16_t*)(q.ws + WS_H), nullptr); }
        SEAM(pb + 5);
        for (int rep = 0, nrep = REPS(7, layer); rep < nrep; ++rep)
        if (IN(pb + 6)) {
            Params q{}; PA(q, ws);
            pg8::Gemm g{(const bf16_t*)(q.ws + WS_H), (const bf16_t*)(q.ws + WS_WL + WL_FFN1), T, 2 * DFF, 2048}; pg8::StaticOrder S; S.init(T, 2 * DFF, pg8::ogrid(), pg8::obid());
            EpiFFN1 E{(bf16_t*)(q.ws + WS_BIG + BIG_MID)};
            pg8::gemm_phase<EpiFFN1, pg8::StaticOrder, false>(lds, g, S, E, nullptr);
            REPBAR();
        }
        SEAM(pb + 6);
        for (int rep = 0, nrep = REPS(8, layer); rep < nrep; ++rep)
        if (IN(pb + 7)) {
            Params q{}; PA(q, ws);
            pg8::Gemm g{(const bf16_t*)(q.ws + WS_BIG + BIG_MID), (const bf16_t*)(q.ws + WS_WL + WL_FFN2), T, 2048, DFF}; pg8::StaticOrder S; S.init(T, 2048, pg8::ogrid(), pg8::obid());
            EpiRes E{(bf16_t*)(q.ws + WS_XB), nullptr, (const float*)(q.ws + WS_MOD) + layer * 12288 + 10240, rep + 1 < nrep};
            pg8::gemm_phase<EpiRes, pg8::StaticOrder, false>(lds, g, S, E, nullptr);
            REPBAR();
        }
        SEAM(pb + 7);
    }
    if (IN(34)) { Params q{}; PA(q, ws); PA(q, out); PA(q, final_norm); final_norm_phase(q); }
#undef REPS
#undef IN
#undef SEAM
}
}

extern "C" void kernel_launch(void* const* d_in, const int* in_sizes, int n_in, void* d_out, int out_size, void* d_ws, size_t ws_size, hipStream_t stream) {
    static int grid = 0;
    if (grid == 0) {
        if (n_in != 30 || out_size != mk::T * mk::D || ws_size < mk::WS_TOTAL) { fprintf(stderr, "kernel_launch: unexpected shapes (n_in %d out %d ws %zu need %zu); nothing launched\n", n_in, out_size, ws_size, (size_t)mk::WS_TOTAL); grid = -1; return; }
        int dev = 0, cus = 0;
        if (hipGetDevice(&dev) != hipSuccess || hipDeviceGetAttribute(&cus, hipDeviceAttributeMultiprocessorCount, dev) != hipSuccess) { grid = -1; return; }
        if (hipFuncSetAttribute((const void*)mk::mega, hipFuncAttributeMaxDynamicSharedMemorySize, mk::LDS_BYTES) != hipSuccess) { fprintf(stderr, "kernel_launch: hipFuncSetAttribute failed\n"); grid = -1; return; }
        int per_cu = 0; (void)hipOccupancyMaxActiveBlocksPerMultiprocessor(&per_cu, (const void*)mk::mega, 512, mk::LDS_BYTES); (void)hipGetLastError();
        if (per_cu < 1) fprintf(stderr, "kernel_launch: occupancy query reports %d blocks per CU\n", per_cu);
        grid = cus > 256 ? 256 : cus;
    }
    if (grid < 0) return;
    mk::Params p{};
    const float** f = (const float**)&p;
    for (int i = 0; i < 30; ++i) f[i] = (const float*)d_in[i];
    p.out = (float*)d_out; p.ws = (unsigned char*)d_ws; p.probe = MK_PROBE;
#if MK_PER_PHASE
    for (int k = 0; k < mk::NPHASE; ++k) { p.ph_lo = k; p.ph_hi = k + 1; hipLaunchKernelGGL(mk::mega, dim3(grid), dim3(512), mk::LDS_BYTES, stream, p); }
#else
    (void)hipMemsetAsync((char*)d_ws + mk::WS_CTL, 0, mk::CTL_BYTES, stream);
    p.ph_lo = 0; p.ph_hi = mk::NPHASE;
    hipLaunchKernelGGL(mk::mega, dim3(grid), dim3(512), mk::LDS_BYTES, stream, p);
#endif
}
```

```cpp
#include <hip/hip_runtime.h>
#include <cstdio>
#include <cstdint>
#include <utility>
#ifndef MK_PER_PHASE
#define MK_PER_PHASE 0
#endif
#ifndef MK_PROBE
#define MK_PROBE 0
#endif
namespace pg8 {
#define PG8_LAS __attribute__((address_space(3)))
__device__ __forceinline__ int otid() { int t = threadIdx.x; asm volatile("" : "+v"(t) :: "memory"); return t; }
__device__ __forceinline__ int obid() { int b = blockIdx.x; asm volatile("" : "+s"(b)); return b; }
__device__ __forceinline__ int ogrid() { int g = gridDim.x; asm volatile("" : "+s"(g)); return g; }
typedef unsigned short bf16_t;
typedef short bf16x8 __attribute__((ext_vector_type(8)));
typedef float f32x4 __attribute__((ext_vector_type(4)));
typedef unsigned u32x4 __attribute__((ext_vector_type(4)));
constexpr int BM = 256, BK = 64, HALF = 128, HTB = HALF * BK * 2  , STAGE_BYTES = 8 * HTB, NXCD = 8, WGM = 4;

__host__ __device__ __forceinline__ int lds_byte(int r, int c) { const int st = (r >> 4) * 2 + (c >> 5), rr = r & 15, cc = c & 31, ob = rr * 64 + cc * 2; return st * 1024 + (ob ^ (((ob >> 9) & 1) << 5)); }
__host__ __device__ __forceinline__ void stage_rc(int b, int& R, int& C) { const int st = b / 1024, sb = b % 1024, swz = sb ^ (((sb >> 9) & 1) << 5); R = (st >> 1) * 16 + swz / 64; C = (st & 1) * 32 + (swz % 64) / 2; }
__host__ __device__ __forceinline__ int perm32(int rho) { const int n = rho >> 4, i = rho & 15; return 8 * (i >> 2) + 4 * n + (i & 3); }

struct Unit { int pm, pn; };
struct Gemm { const bf16_t* A; const bf16_t* Bt; int M, N, K; };

struct StaticOrder {
    int nM, nN, nwg, G, c, wgm;
    __host__ __device__ void init(int M, int N, int G_, int c_, int wgm_ = WGM) { nM = M / BM; nN = N / BM; nwg = nM * nN; G = G_; c = c_; wgm = wgm_; }
    __host__ __device__ bool next(int i, Unit& u) const {
        const long L = (long)i * G + c; if (L >= nwg) return false;
        int wgid = (int)L; { const int q = nwg / NXCD, r = nwg % NXCD, xcd = wgid % NXCD, off = wgid / NXCD; wgid = (xcd < r ? xcd * (q + 1) : r * (q + 1) + (xcd - r) * q) + off; }
        const int nig = wgm * nN, gid = wgid / nig, fm = gid * wgm, gsz = (nM - fm) < wgm ? (nM - fm) : wgm;
        u.pm = fm + ((wgid % nig) % gsz); u.pn = (wgid % nig) / gsz; return true;
    }
    __device__ __forceinline__ void a_ready(const Unit&) const {}
    __device__ __forceinline__ void done(const Unit&) const {}
};
__device__ __forceinline__ unsigned cvt_pk_bf16(float lo, float hi) { unsigned r; asm volatile("v_cvt_pk_bf16_f32 %0, %1, %2" : "=v"(r) : "v"(lo), "v"(hi)); return r; }
template <class Epi, class Sched, bool STAMP = false>
__device__ __forceinline__ void gemm_phase(PG8_LAS unsigned char* lds, const Gemm g, const Sched& S, const Epi& E, unsigned long long* stamps) {
    const int tid = otid(), wid = __builtin_amdgcn_readfirstlane(tid >> 6), lane = tid & 63, wr = wid >> 2, wc = wid & 3, fr = lane & 15, fq = lane >> 4;
    const int K = g.K, nt = K / BK;
    int ts_lo = 0, ts_hi = 0, nts = 0; const unsigned long long rt_entry = STAMP ? (unsigned long long)wall_clock64() : 0ull;
#define PG8_STAMP() do { if (STAMP && wid == 0 && nts < 64) { const unsigned long long _c = (unsigned long long)clock64(); \
        ts_lo = (lane == nts) ? (int)(unsigned)_c : ts_lo; ts_hi = (lane == nts) ? (int)(unsigned)(_c >> 32) : ts_hi; ++nts; } } while (0)
    PG8_STAMP();
    unsigned voffA[2], voffB[2];
#pragma unroll
    for (int i = 0; i < 2; ++i) { int R, C; stage_rc(tid * 16 + i * 8192, R, C); const int Rb = Epi::PERM ? ((R & ~31) + perm32(R & 31)) : R;
        voffA[i] = (unsigned)(R * K + C) * 2u; voffB[i] = (unsigned)(Rb * K + C) * 2u; }
    const size_t kstep = (size_t)(BK * 2);
    const size_t hstep = (size_t)HALF * K * 2;
    const size_t tstep = 2 * hstep;
    const unsigned ldsw = (unsigned)wid * 1024u;
    const int aoff = lds_byte(wr * 64 + fr, fq * 8), boff = lds_byte(wc * 32 + fr, fq * 8);
#define PG8_SA(b, h) (((b) * 2 + (h)) * HTB)
#define PG8_SB(b, h) ((4 + (b) * 2 + (h)) * HTB)
#define PG8_STAGE(bufoff, gbase, voff) do { _Pragma("unroll") for (int _i = 0; _i < 2; ++_i) \
        __builtin_amdgcn_global_load_lds((const unsigned*)((const char*)(gbase) + (voff)[_i]), (PG8_LAS unsigned*)(lds + (bufoff) + ldsw + _i * 8192), 16, 0, 0); } while (0)
#define PG8_LDA(dst, b, h) do { _Pragma("unroll") for (int m = 0; m < 4; ++m) _Pragma("unroll") for (int k = 0; k < 2; ++k) dst[m][k] = *(const PG8_LAS bf16x8*)(lds + PG8_SA(b, h) + aoff + m * 2048 + k * 1024); } while (0)
#define PG8_LDB(dst, b, h) do { _Pragma("unroll") for (int n = 0; n < 2; ++n) _Pragma("unroll") for (int k = 0; k < 2; ++k) dst[n][k] = *(const PG8_LAS bf16x8*)(lds + PG8_SB(b, h) + boff + n * 2048 + k * 1024); } while (0)
#define PG8_MMA(ai, bj, At, Bt) do { __builtin_amdgcn_s_setprio(1); _Pragma("unroll") for (int m = 0; m < 4; ++m) _Pragma("unroll") for (int n = 0; n < 2; ++n) _Pragma("unroll") for (int k = 0; k < 2; ++k) \
        acc[ai][bj][m][n] = __builtin_amdgcn_mfma_f32_16x16x32_bf16(Bt[n][k], At[m][k], acc[ai][bj][m][n], 0, 0, 0); __builtin_amdgcn_s_setprio(0); } while (0)
#define PG8_WAIT_V(n) asm volatile("s_waitcnt vmcnt(" #n ")" ::: "memory")
#define PG8_WAIT_L(n) asm volatile("s_waitcnt lgkmcnt(" #n ")" ::: "memory")
#define PG8_BAR __builtin_amdgcn_s_barrier()
#define PG8_SCHED __builtin_amdgcn_sched_barrier(0)
    Unit cur, nxt; int ui = 0;
    if (!S.next(0, cur)) return;
    f32x4 acc[2][2][4][2];
#pragma unroll
    for (int a = 0; a < 2; ++a)
#pragma unroll
        for (int b = 0; b < 2; ++b)
#pragma unroll
            for (int m = 0; m < 4; ++m)
#pragma unroll
                for (int n = 0; n < 2; ++n) acc[a][b][m][n] = (f32x4){0.f, 0.f, 0.f, 0.f};
    bf16x8 At[4][2], B0[2][2], B1[2][2];
    const char* cA = (const char*)g.A + (size_t)cur.pm * tstep; const char* cB = (const char*)g.Bt + (size_t)cur.pn * tstep;
    S.a_ready(cur);
    PG8_STAGE(PG8_SB(0, 0), cB, voffB); PG8_STAGE(PG8_SA(0, 0), cA, voffA); PG8_STAGE(PG8_SB(0, 1), cB + hstep, voffB); PG8_STAGE(PG8_SA(0, 1), cA + hstep, voffA);
    if (wr == 1) PG8_BAR;
    PG8_WAIT_V(4); PG8_BAR;
    PG8_STAGE(PG8_SB(1, 0), cB + kstep, voffB); PG8_STAGE(PG8_SA(1, 0), cA + kstep, voffA); PG8_STAGE(PG8_SB(1, 1), cB + hstep + kstep, voffB);
    PG8_WAIT_V(6); PG8_BAR;
    PG8_STAMP();
    for (;;) {
        const bool has_next = S.next(ui + 1, nxt);
        const char* nA = has_next ? (const char*)g.A + (size_t)nxt.pm * tstep : cA; const char* nB = has_next ? (const char*)g.Bt + (size_t)nxt.pn * tstep : cB;
        for (int t = 0; t < nt; t += 2) {
            const bool last = (t == nt - 2);
            const char* a1 = cA + (size_t)(t + 1) * kstep;
            const char* a2 = last ? nA : cA + (size_t)(t + 2) * kstep; const char* b2 = last ? nB : cB + (size_t)(t + 2) * kstep;
            const char* a3 = a2 + kstep; const char* b3 = b2 + kstep;
            if (last && has_next) S.a_ready(nxt);
            PG8_LDB(B0, 0, 0); PG8_SCHED; PG8_LDA(At, 0, 0); PG8_STAGE(PG8_SA(1, 1), a1 + hstep, voffA);
            PG8_WAIT_L(8); PG8_BAR; PG8_WAIT_L(0); PG8_MMA(0, 0, At, B0); PG8_BAR; PG8_SCHED;
            PG8_LDB(B1, 0, 1); PG8_STAGE(PG8_SB(0, 0), b2, voffB);
            PG8_BAR; PG8_WAIT_L(0); PG8_MMA(0, 1, At, B1); PG8_BAR;
            PG8_LDA(At, 0, 1); PG8_STAGE(PG8_SA(0, 0), a2, voffA);
            PG8_BAR; PG8_WAIT_L(0); PG8_MMA(1, 0, At, B0); PG8_BAR; PG8_SCHED;
            PG8_STAGE(PG8_SB(0, 1), b2 + hstep, voffB);
            PG8_WAIT_V(6); PG8_BAR; PG8_MMA(1, 1, At, B1); PG8_BAR;
            PG8_LDB(B0, 1, 0); PG8_SCHED; PG8_LDA(At, 1, 0); PG8_STAGE(PG8_SA(0, 1), a2 + hstep, voffA);
            PG8_WAIT_L(8); PG8_BAR; PG8_WAIT_L(0); PG8_MMA(0, 0, At, B0); PG8_BAR; PG8_SCHED;
            PG8_LDB(B1, 1, 1); PG8_STAGE(PG8_SB(1, 0), b3, voffB);
            PG8_BAR; PG8_WAIT_L(0); PG8_MMA(0, 1, At, B1); PG8_BAR;
            PG8_LDA(At, 1, 1); PG8_STAGE(PG8_SA(1, 0), a3, voffA);
            PG8_BAR; PG8_WAIT_L(0); PG8_MMA(1, 0, At, B0); PG8_BAR; PG8_SCHED;
            PG8_STAGE(PG8_SB(1, 1), b3 + hstep, voffB);
            PG8_WAIT_V(6); PG8_BAR; PG8_MMA(1, 1, At, B1); PG8_BAR;
        }
        PG8_STAMP();
        if constexpr (!Epi::AFTER_DRAIN) { E(acc, cur, wr, wc, fr, fq); S.done(cur); }
        PG8_STAMP();
        if (!has_next) break;
#pragma unroll
        for (int a = 0; a < 2; ++a)
#pragma unroll
            for (int b = 0; b < 2; ++b)
#pragma unroll
                for (int m = 0; m < 4; ++m)
#pragma unroll
                    for (int n = 0; n < 2; ++n) acc[a][b][m][n] = (f32x4){0.f, 0.f, 0.f, 0.f};
        cur = nxt; cA = nA; cB = nB; ++ui;
    }
    PG8_WAIT_V(0);
    if (wr == 0) PG8_BAR;
    PG8_BAR;
    if constexpr (Epi::AFTER_DRAIN) { E.fused(acc, cur, wr, wc, fr, fq, lds, wid, lane); S.done(cur); }
    PG8_STAMP();
    if (STAMP && wid == 0) { stamps[lane] = lane < nts ? (((unsigned long long)(unsigned)ts_hi << 32) | (unsigned)ts_lo) : 0ull;
        if (lane == 62) stamps[62] = rt_entry; if (lane == 63) stamps[63] = (unsigned long long)wall_clock64(); }
#undef PG8_STAMP
#undef PG8_SA
#undef PG8_SB
#undef PG8_STAGE
#undef PG8_LDA
#undef PG8_LDB
#undef PG8_MMA
#undef PG8_WAIT_V
#undef PG8_WAIT_L
#undef PG8_BAR
#undef PG8_SCHED
}
}
#define XB_TMO      128
#define XB_XCNT(j)  (256  + 64 * (j))
#define XB_XSUB(j)  (1280 + 64 * (j))
#define XB_XGEN(j)  (2304 + 64 * (j))
#define XB_TOP      3328
#define XB_TOPGEN   3392
#define XCD_BAR_WORDS 3456
#define XB_SPIN_CAP (1u << 18)
#define LAS __attribute__((address_space(3)))

__device__ __forceinline__ unsigned xb_ld(unsigned* p)              { return __hip_atomic_load(p, __ATOMIC_RELAXED, __HIP_MEMORY_SCOPE_AGENT); }
__device__ __forceinline__ unsigned xb_add(unsigned* p, unsigned v) { return __hip_atomic_fetch_add(p, v, __ATOMIC_RELAXED, __HIP_MEMORY_SCOPE_AGENT); }
__device__ __forceinline__ unsigned xb_xcc_id() { return (unsigned)__builtin_amdgcn_s_getreg((3 << 11) | 20) & 0xFu; }
#define XB_SPIN(cond, bar) do { unsigned _sp = 0; while (cond) { __builtin_amdgcn_s_sleep(1); \
    if ((++_sp & 255u) == 0u) { if (xb_ld(&(bar)[XB_TMO])) break; if (_sp > XB_SPIN_CAP) { atomicAdd(&(bar)[XB_TMO], 1u); break; } } } } while (0)

struct XcdBarrier {
    unsigned* bar; unsigned x;
    volatile LAS unsigned* st;
};

__device__ __forceinline__ XcdBarrier xcd_barrier_post(unsigned* bar, volatile LAS unsigned* st) {
    XcdBarrier b; b.bar = bar; b.x = xb_xcc_id(); b.st = st;
    if (threadIdx.x == 0) (void)xb_add(&bar[XB_XCNT(b.x)], 1u);
    return b;
}
__device__ __forceinline__ void xcd_barrier_complete(unsigned* bar, unsigned x, unsigned& nloc, unsigned& nx) {
    const unsigned G = gridDim.x * gridDim.y * gridDim.z;
    unsigned sum, cnt, mine, sp = 0u;
    for (;;) {
        sum = 0u; cnt = 0u; mine = 0u;
#pragma unroll
        for (unsigned j = 0; j < 16; ++j) { const unsigned c = xb_ld(&bar[XB_XCNT(j)]); sum += c; cnt += (c > 0u) ? 1u : 0u; mine = (j == x) ? c : mine; }
        if (sum == G) break;
        __builtin_amdgcn_s_sleep(1);
        if ((++sp & 255u) == 0u) { if (xb_ld(&bar[XB_TMO])) break; if (sp > XB_SPIN_CAP) { atomicAdd(&bar[XB_TMO], 1u); break; } }
    }
    nloc = mine > 0u ? mine : 1u; nx = cnt > 0u ? cnt : 1u;
}

__device__ __forceinline__ void xcd_barrier(const XcdBarrier& b) {
    asm volatile("s_waitcnt vmcnt(0)" ::: "memory");
    __syncthreads();
    if (threadIdx.x == 0) {
        unsigned* bar = b.bar;
        __builtin_amdgcn_s_waitcnt(0);
        unsigned nloc = b.st[0], nx = b.st[1];
        if (nloc == 0u) { xcd_barrier_complete(bar, b.x, nloc, nx); b.st[0] = nloc; b.st[1] = nx; }
        const unsigned old = xb_add(&bar[XB_XSUB(b.x)], 1u);
        const unsigned gen = old / nloc;
        if (old + 1u == (gen + 1u) * nloc) {
            __builtin_amdgcn_fence(__ATOMIC_RELEASE, "agent");
            asm volatile("s_waitcnt vmcnt(0)" ::: "memory");
            const unsigned og = xb_add(&bar[XB_TOP], 1u);
            const unsigned tg = og / nx;
            if (og + 1u == (tg + 1u) * nx) xb_add(&bar[XB_TOPGEN], 1u);
            else XB_SPIN(xb_ld(&bar[XB_TOPGEN]) == tg, bar);
            __builtin_amdgcn_fence(__ATOMIC_ACQUIRE, "agent");
            xb_add(&bar[XB_XGEN(b.x)], 1u);
            asm volatile("s_waitcnt vmcnt(0)" ::: "memory");
        } else {
            XB_SPIN(xb_ld(&bar[XB_XGEN(b.x)]) == gen, bar);
            __builtin_amdgcn_fence(__ATOMIC_ACQUIRE, "agent");
            asm volatile("s_waitcnt vmcnt(0)" ::: "memory");
        }
    }
    __syncthreads();
}


namespace mk {
using pg8::bf16_t; using pg8::bf16x8; using pg8::f32x4; using pg8::u32x4; using pg8::Unit; using pg8::cvt_pk_bf16;
typedef unsigned u32x2 __attribute__((ext_vector_type(2)));
typedef float cpx __attribute__((ext_vector_type(2)));
__host__ __device__ __forceinline__ cpx mkc(float a, float b) { cpx r; r.x = a; r.y = b; return r; }

constexpr int D = 2048, T_P = 32768, T_S = 8192, T = 40960, L_P = 16384, L_S = 2048, DFF = 5632;
constexpr int NTHR = 512;
constexpr int MODW = 53248;
constexpr int NPOS = 18432;
constexpr int QKVW = 9216;
constexpr float EPS = 1e-6f;
constexpr float QSCALE = 0.12751743082459868f;
constexpr int LDS_BYTES = 147456;
constexpr int LDS_MISC = 147456 - 256;

constexpr size_t al256(size_t x) { return (x + 255) & ~(size_t)255; }
constexpr size_t WS_CTL  = 0;
constexpr size_t CTL_BYTES = 65536;
constexpr size_t WS_PART = WS_CTL + CTL_BYTES;
constexpr size_t WS_MOD  = WS_PART + al256((size_t)8 * 6 * MODW * 4);
constexpr size_t WS_ROPE = WS_MOD + al256((size_t)6 * MODW * 4);
constexpr size_t WS_A2X  = WS_ROPE + (size_t)16384 * 16 * 8;
constexpr size_t WS_W3X  = WS_A2X + (size_t)2 * NPOS * 256 * 2;
constexpr size_t WS_WL   = WS_W3X + (size_t)2 * 8192 * 256 * 2;
constexpr size_t WL_FFN1 = 0;
constexpr size_t WL_FFN2 = WL_FFN1 + (size_t)11264 * 2048 * 2;
constexpr size_t WL_MIXIN = WL_FFN2 + (size_t)2048 * 5632 * 2;
constexpr size_t WL_MIXOUT = WL_MIXIN + (size_t)9216 * 2048 * 2;
constexpr size_t WL_BYTES = WL_MIXOUT + (size_t)2048 * 2048 * 2;
constexpr size_t WS_H    = WS_WL + WL_BYTES;
constexpr size_t H_BYTES = (size_t)T * 2048 * 2;
constexpr size_t WS_BIG  = WS_H + H_BYTES;
constexpr size_t BIG_ZINT = 0;
constexpr size_t BIG_TAPS = BIG_ZINT + (size_t)6144 * T * 2;
constexpr size_t BIG_HY_END = BIG_TAPS + (size_t)8192 * NPOS * 2;
constexpr size_t BIG_QKV = 0;
constexpr size_t BIG_OG  = BIG_QKV + (size_t)T * QKVW * 2;
constexpr size_t BIG_LSE = BIG_OG + (size_t)3 * T * 1024 * 2;
constexpr size_t BIG_AT_END = BIG_LSE + (size_t)3 * T * 8 * 4;
constexpr size_t BIG_MID = 0;
constexpr size_t BIG_BYTES = BIG_HY_END > BIG_AT_END ? BIG_HY_END : BIG_AT_END;
constexpr size_t WS_END  = WS_BIG + BIG_BYTES;
constexpr size_t FFT_SCR_PER_WG = 5 * 131072;
constexpr size_t FFT_EXT_PER_WG = 2 * 65536;
constexpr size_t WS_XB = WS_END + (size_t)256 * FFT_EXT_PER_WG;
constexpr size_t WS_TOTAL = WS_XB + (size_t)T * 2048 * 2;
static_assert(256 * FFT_SCR_PER_WG <= H_BYTES, "fft scratch must fit in H");

struct Params {
    const float *x_prompt, *x_sample, *c_prompt, *c_sample, *ada_w, *ada_b, *norm_mix, *norm_ffn;
    const float *hy_w_in, *hy_b_in, *hy_conv_w, *hy_conv_b, *hy_fw1, *hy_fb1, *hy_ffreq, *hy_fw2, *hy_fb2, *hy_fw3, *hy_decay, *hy_skip, *hy_w_out, *hy_b_out;
    const float *at_w_in, *at_w_out, *ffn_w_gate, *ffn_w_up, *ffn_w_down, *final_norm, *final_ada_w, *final_ada_b;
    float* out; unsigned char* ws; int ph_lo, ph_hi, probe, pad0;
};

#define LDSQ __attribute__((address_space(3)))

__device__ __forceinline__ float bf2f(bf16_t b) { return __uint_as_float(((unsigned)b) << 16); }
__device__ __forceinline__ bf16_t f2bf(float f) { unsigned u = __float_as_uint(f); u += 0x7FFFu + ((u >> 16) & 1u); return (bf16_t)(u >> 16); }
__device__ __forceinline__ int seq_of_row(int row) { return row < T_P ? (row >> 14) : 2 + ((row - T_P) >> 11); }
__device__ __forceinline__ int pos_of_row(int row) { return row < T_P ? (row & 16383) : (row & 2047); }
__device__ __forceinline__ float wave_sum(float v) {
#pragma unroll
    for (int o = 32; o >= 1; o >>= 1) v += __shfl_xor(v, o);
    return v;
}

struct EpiZinT {
    static constexpr bool PERM = true, AFTER_DRAIN = false;
    bf16_t* O; int ldc; const float* bias;
    __device__ __forceinline__ void operator()(const f32x4 (&acc)[2][2][4][2], const Unit& u, int wr, int wc, int fr, int fq) const {
        const int row0 = u.pm * 256 + wr * 64 + fr, col0 = u.pn * 256 + wc * 32 + 8 * fq;
        float bs[8];
#pragma unroll
        for (int r = 0; r < 8; ++r) bs[r] = bias[row0 + (r >> 2) * 128 + (r & 3) * 16];
#pragma unroll
        for (int ai = 0; ai < 2; ++ai)
#pragma unroll
            for (int m = 0; m < 4; ++m) { const int r = row0 + ai * 128 + m * 16; const float b = bs[ai * 4 + m]; bf16_t* rowp = O + (size_t)r * ldc + col0;
#pragma unroll
                for (int bj = 0; bj < 2; ++bj) { const f32x4 v0 = acc[ai][bj][m][0] + b, v1 = acc[ai][bj][m][1] + b;
                    u32x4 w; w.x = cvt_pk_bf16(v0[0], v0[1]); w.y = cvt_pk_bf16(v0[2], v0[3]); w.z = cvt_pk_bf16(v1[0], v1[1]); w.w = cvt_pk_bf16(v1[2], v1[3]);
                    *(u32x4*)(rowp + bj * 128) = w; } }
    }
};
struct EpiRes {
    static constexpr bool PERM = true, AFTER_DRAIN = false;
    bf16_t* X; const float* bias; const float* gate; int dry;
    __device__ __forceinline__ void operator()(const f32x4 (&acc)[2][2][4][2], const Unit& u, int wr, int wc, int fr, int fq) const {
        const int row0 = u.pm * 256 + wr * 64 + fr, col0 = u.pn * 256 + wc * 32 + 8 * fq;
        const float* gp = gate + (size_t)seq_of_row(u.pm * 256) * MODW + col0;
        bf16_t* xb = X + (size_t)row0 * 2048 + col0;
        u32x4 xv[2][4]; f32x4 gv[2][2], bv[2][2];
#pragma unroll
        for (int m4 = 0; m4 < 4; ++m4) xv[0][m4] = *(const u32x4*)(xb + (size_t)(m4 * 16) * 2048);
#pragma unroll
        for (int n = 0; n < 2; ++n) { gv[0][n] = *(const f32x4*)(gp + 4 * n); bv[0][n] = bias ? *(const f32x4*)(bias + col0 + 4 * n) : (f32x4){0.f, 0.f, 0.f, 0.f}; }
#pragma unroll
        for (int c = 0; c < 4; ++c) { const int bj = c >> 1, ai = c & 1;
            if (c < 3) { const int bj2 = (c + 1) >> 1, ai2 = (c + 1) & 1;
#pragma unroll
                for (int m4 = 0; m4 < 4; ++m4) xv[(c + 1) & 1][m4] = *(const u32x4*)(xb + (size_t)(ai2 * 128 + m4 * 16) * 2048 + bj2 * 128);
                if (c == 1) {
#pragma unroll
                    for (int n = 0; n < 2; ++n) { gv[1][n] = *(const f32x4*)(gp + 128 + 4 * n); bv[1][n] = bias ? *(const f32x4*)(bias + col0 + 128 + 4 * n) : (f32x4){0.f, 0.f, 0.f, 0.f}; } } }
#pragma unroll
            for (int m4 = 0; m4 < 4; ++m4) { const u32x4 xo = xv[c & 1][m4];
                const f32x4 xa = {__uint_as_float(xo.x << 16), __uint_as_float(xo.x & 0xffff0000u), __uint_as_float(xo.y << 16), __uint_as_float(xo.y & 0xffff0000u)};
                const f32x4 xc = {__uint_as_float(xo.z << 16), __uint_as_float(xo.z & 0xffff0000u), __uint_as_float(xo.w << 16), __uint_as_float(xo.w & 0xffff0000u)};
                const f32x4 ya = xa + gv[bj][0] * (acc[ai][bj][m4][0] + bv[bj][0]), yc = xc + gv[bj][1] * (acc[ai][bj][m4][1] + bv[bj][1]);
                u32x4 w; w.x = cvt_pk_bf16(ya[0], ya[1]); w.y = cvt_pk_bf16(ya[2], ya[3]); w.z = cvt_pk_bf16(yc[0], yc[1]); w.w = cvt_pk_bf16(yc[2], yc[3]);
                if (!dry) *(u32x4*)(xb + (size_t)(ai * 128 + m4 * 16) * 2048 + bj * 128) = w; } }
    }
};
struct EpiQKV {
    static constexpr bool PERM = true, AFTER_DRAIN = false;
    bf16_t* O; const cpx* rope;
    __device__ __forceinline__ void operator()(const f32x4 (&acc)[2][2][4][2], const Unit& u, int wr, int wc, int fr, int fq) const {
        const int row0 = u.pm * 256 + wr * 64 + fr, colt = u.pn * 256, col0 = colt + wc * 32 + 8 * fq;
        const int sidx = (colt % 3072) >> 10;
        const bool dorope = (sidx < 2) && (wc == 0);
        const float qs = (sidx == 0) ? QSCALE : 1.0f;
        f32x4 tt[2][4];
        if (dorope) { const cpx* rp = rope + (size_t)pos_of_row(row0) * 16 + 8 * (fq & 1);
            tt[0][0] = *(const f32x4*)(rp); tt[0][1] = *(const f32x4*)(rp + 2); tt[0][2] = *(const f32x4*)(rp + 4); tt[0][3] = *(const f32x4*)(rp + 6); }
#pragma unroll
        for (int g = 0; g < 8; ++g) { const int ai = g >> 2, m = g & 3; const int r = row0 + ai * 128 + m * 16; bf16_t* rowp = O + (size_t)r * QKVW + col0;
            f32x4 c0, c1, s0, s1;
            if (dorope) {
                if (g < 7) { const int r2 = row0 + ((g + 1) >> 2) * 128 + ((g + 1) & 3) * 16; const cpx* rp = rope + (size_t)pos_of_row(r2) * 16 + 8 * (fq & 1);
                    tt[(g + 1) & 1][0] = *(const f32x4*)(rp); tt[(g + 1) & 1][1] = *(const f32x4*)(rp + 2); tt[(g + 1) & 1][2] = *(const f32x4*)(rp + 4); tt[(g + 1) & 1][3] = *(const f32x4*)(rp + 6); }
                const f32x4 t0 = tt[g & 1][0], t1 = tt[g & 1][1], t2 = tt[g & 1][2], t3 = tt[g & 1][3];
                c0 = (f32x4){t0[0], t0[2], t1[0], t1[2]}; s0 = (f32x4){t0[1], t0[3], t1[1], t1[3]};
                c1 = (f32x4){t2[0], t2[2], t3[0], t3[2]}; s1 = (f32x4){t2[1], t2[3], t3[1], t3[3]}; }
#pragma unroll
            for (int bj = 0; bj < 2; ++bj) { f32x4 v0 = acc[ai][bj][m][0], v1 = acc[ai][bj][m][1];
                if (dorope) { f32x4 p0, p1;
#pragma unroll
                    for (int e = 0; e < 4; ++e) { p0[e] = __shfl_xor(v0[e], 32); p1[e] = __shfl_xor(v1[e], 32); }
                    if (fq < 2) { v0 = v0 * c0 - p0 * s0; v1 = v1 * c1 - p1 * s1; }
                    else        { v0 = v0 * c0 + p0 * s0; v1 = v1 * c1 + p1 * s1; } }
                v0 *= qs; v1 *= qs;
                u32x4 w; w.x = cvt_pk_bf16(v0[0], v0[1]); w.y = cvt_pk_bf16(v0[2], v0[3]); w.z = cvt_pk_bf16(v1[0], v1[1]); w.w = cvt_pk_bf16(v1[2], v1[3]);
                *(u32x4*)(rowp + bj * 128) = w; } }
    }
};
struct EpiFFN1 {
    static constexpr bool PERM = true, AFTER_DRAIN = false;
    bf16_t* O;
    __device__ __forceinline__ void operator()(const f32x4 (&acc)[2][2][4][2], const Unit& u, int wr, int wc, int fr, int fq) const {
        const int row0 = u.pm * 256 + wr * 64 + fr, col0 = u.pn * 128 + wc * 32 + 8 * fq;
#pragma unroll
        for (int ai = 0; ai < 2; ++ai)
#pragma unroll
            for (int m = 0; m < 4; ++m) { bf16_t* rowp = O + (size_t)(row0 + ai * 128 + m * 16) * DFF + col0; float o[8];
#pragma unroll
                for (int n = 0; n < 2; ++n)
#pragma unroll
                    for (int e = 0; e < 4; ++e) { const float g = acc[ai][0][m][n][e], up = acc[ai][1][m][n][e]; o[n * 4 + e] = g * __builtin_amdgcn_rcpf(1.0f + __expf(-g)) * up; }
                u32x4 w; w.x = cvt_pk_bf16(o[0], o[1]); w.y = cvt_pk_bf16(o[2], o[3]); w.z = cvt_pk_bf16(o[4], o[5]); w.w = cvt_pk_bf16(o[6], o[7]);
                *(u32x4*)rowp = w; }
    }
};
struct EpiTaps {
    static constexpr bool PERM = true, AFTER_DRAIN = false;
    _Float16* O;
    __device__ __forceinline__ void operator()(const f32x4 (&acc)[2][2][4][2], const Unit& u, int wr, int wc, int fr, int fq) const {
        typedef _Float16 h8 __attribute__((ext_vector_type(8)));
        const int row0 = u.pm * 256 + wr * 64 + fr, col0 = u.pn * 256 + wc * 32 + 8 * fq;
#pragma unroll
        for (int ai = 0; ai < 2; ++ai)
#pragma unroll
            for (int m = 0; m < 4; ++m) { _Float16* rowp = O + (size_t)(row0 + ai * 128 + m * 16) * NPOS + col0;
#pragma unroll
                for (int bj = 0; bj < 2; ++bj) { const f32x4 v0 = acc[ai][bj][m][0], v1 = acc[ai][bj][m][1]; h8 w;
                    w[0] = (_Float16)v0[0]; w[1] = (_Float16)v0[1]; w[2] = (_Float16)v0[2]; w[3] = (_Float16)v0[3]; w[4] = (_Float16)v1[0]; w[5] = (_Float16)v1[1]; w[6] = (_Float16)v1[2]; w[7] = (_Float16)v1[3];
                    *(h8*)(rowp + bj * 128) = w; } }
    }
};

__device__ __forceinline__ void ada_partials(const Params& p, LDSQ unsigned char* lds) {
    LDSQ float* cs = (LDSQ float*)lds;
    for (int i = pg8::otid(); i < 6 * 2048; i += NTHR) { const int b = i >> 11, k = i & 2047; const float c = b < 2 ? p.c_prompt[b * 2048 + k] : p.c_sample[(b - 2) * 2048 + k]; cs[i] = c / (1.0f + expf(-c)); }
    __syncthreads();
    float* part = (float*)(p.ws + WS_PART);
    for (int item = pg8::obid() * NTHR + pg8::otid(); item < 8 * 13312; item += pg8::ogrid() * NTHR) {
        const int chunk = item / 13312, c4 = item % 13312;
        const float* W; int ldw;
        if (c4 < 12288) { const int layer = c4 / 3072, col = (c4 % 3072) * 4; W = p.ada_w + (size_t)layer * 2048 * 12288 + col; ldw = 12288; }
        else { W = p.final_ada_w + (c4 - 12288) * 4; ldw = 4096; }
        f32x4 a0 = {0.f, 0.f, 0.f, 0.f}, a1 = a0, a2 = a0, a3 = a0, a4 = a0, a5 = a0;
        const int k0 = chunk * 256;
#pragma unroll 8
        for (int k = k0; k < k0 + 256; ++k) { const f32x4 w = *(const f32x4*)(W + (size_t)k * ldw);
            a0 += cs[k] * w; a1 += cs[2048 + k] * w; a2 += cs[4096 + k] * w; a3 += cs[6144 + k] * w; a4 += cs[8192 + k] * w; a5 += cs[10240 + k] * w; }
        float* o = part + (size_t)chunk * 6 * MODW + (size_t)c4 * 4;
        *(f32x4*)(o) = a0; *(f32x4*)(o + MODW) = a1; *(f32x4*)(o + 2 * MODW) = a2; *(f32x4*)(o + 3 * MODW) = a3; *(f32x4*)(o + 4 * MODW) = a4; *(f32x4*)(o + 5 * MODW) = a5;
    }
    __syncthreads();
}
__device__ __forceinline__ void ada_reduce(const Params& p) {
    const float* part = (const float*)(p.ws + WS_PART); float* mod = (float*)(p.ws + WS_MOD);
    for (int i = pg8::obid() * NTHR + pg8::otid(); i < 6 * MODW; i += pg8::ogrid() * NTHR) {
        const int c = i % MODW; float s = c < 49152 ? p.ada_b[c] : p.final_ada_b[c - 49152];
#pragma unroll
        for (int ch = 0; ch < 8; ++ch) s += part[(size_t)ch * 6 * MODW + i];
        mod[i] = s;
    }
}
__device__ __forceinline__ void rope_table(const Params& p) {
    cpx* rope = (cpx*)(p.ws + WS_ROPE);
    for (int i = pg8::obid() * NTHR + pg8::otid(); i < 16384 * 16; i += pg8::ogrid() * NTHR) {
        const int pos = i >> 4, f = i & 15; const float inv = powf(500000.0f, -(float)f / 16.0f); const float ang = (float)pos * inv;
        float s, c; sincosf(ang, &s, &c); rope[i] = mkc(c, s);
    }
}
__device__ __forceinline__ void filter_mlp(const Params& p) {
    const int lane = pg8::otid() & 63, gw = pg8::obid() * 8 + (pg8::otid() >> 6);
    bf16_t* a2x = (bf16_t*)(p.ws + WS_A2X);
    for (int q = gw; q < 2 * NPOS; q += pg8::ogrid() * 8) {
        const int j = q / NPOS, r = q % NPOS; const int L = r < 16384 ? 16384 : 2048, pos = r < 16384 ? r : r - 16384;
        const float fpos = (float)pos;
        float z = 0.f;
        if (lane == 0) z = fpos / (float)(L - 1);
        else if (lane <= 32) { const int bi = (lane - 1) & 15; const float band = 1e-4f + (float)bi * ((15.0f - 1e-4f) / 15.0f);
            const float ang = ((6.283185307179586f * fpos) * band) / (float)L; z = lane <= 16 ? cosf(ang) : -sinf(ang); }
        const float* w1 = p.hy_fw1 + j * 33 * 64; const float* w2 = p.hy_fw2 + j * 64 * 64;
        float acc = p.hy_fb1[j * 64 + lane];
#pragma unroll
        for (int m = 0; m < 33; ++m) acc += __shfl(z, m) * w1[m * 64 + lane];
        const float a1 = sinf(p.hy_ffreq[j * 128 + lane] * acc);
        acc = p.hy_fb2[j * 64 + lane];
#pragma unroll
        for (int m = 0; m < 64; ++m) acc += __shfl(a1, m) * w2[m * 64 + lane];
        const float a2 = sinf(p.hy_ffreq[j * 128 + 64 + lane] * acc);
        const bf16_t hi = f2bf(a2), lo = f2bf(a2 - bf2f(hi));
        bf16_t* o = a2x + ((size_t)j * NPOS + r) * 256;
        o[lane] = hi; o[64 + lane] = hi; o[128 + lane] = lo; o[192 + lane] = 0;
    }
    bf16_t* w3x = (bf16_t*)(p.ws + WS_W3X);
    for (int i = pg8::obid() * NTHR + pg8::otid(); i < 2 * 8192 * 64; i += pg8::ogrid() * NTHR) {
        const int k = i & 63, col = (i >> 6) & 8191, j = i >> 19;
        const float v = p.hy_fw3[(size_t)j * 64 * 8192 + (size_t)k * 8192 + col];
        const bf16_t hi = f2bf(v), lo = f2bf(v - bf2f(hi));
        bf16_t* o = w3x + ((size_t)j * 8192 + col) * 256;
        o[k] = hi; o[64 + k] = lo; o[128 + k] = hi; o[192 + k] = 0;
    }
}
__device__ __forceinline__ void convert_T(LDSQ unsigned char* lds, const float* src, int K, int N, bf16_t* dst, int ffs) {
    LDSQ float* tile = (LDSQ float*)lds;
    const int tid = pg8::otid(), ntn = N >> 8, ntiles = (K >> 6) * ntn, stride = pg8::ogrid();
    const int r = tid >> 6, c4 = tid & 63;
    f32x4 v[8];
    int ti = pg8::obid();
    if (ti < ntiles) { const int tk = ti / ntn, tn = ti % ntn;
#pragma unroll
        for (int it = 0; it < 8; ++it) v[it] = *(const f32x4*)(src + (size_t)(tk * 64 + r + 8 * it) * N + tn * 256 + 4 * c4); }
    for (; ti < ntiles; ti += stride) {
        const int tk = ti / ntn, tn = ti % ntn;
#pragma unroll
        for (int it = 0; it < 8; ++it) { LDSQ float* tp = tile + (r + 8 * it) * 257 + 4 * c4; tp[0] = v[it][0]; tp[1] = v[it][1]; tp[2] = v[it][2]; tp[3] = v[it][3]; }
        __syncthreads();
        if (ti + stride < ntiles) { const int t2 = ti + stride, tk2 = t2 / ntn, tn2 = t2 % ntn;
#pragma unroll
            for (int it = 0; it < 8; ++it) v[it] = *(const f32x4*)(src + (size_t)(tk2 * 64 + r + 8 * it) * N + tn2 * 256 + 4 * c4); }
        { const int n = tid >> 1, kh = tid & 1; const int nn = tn * 256 + n; const int row = ffs < 0 ? nn : (256 * (nn >> 7) + 128 * ffs + (nn & 127));
          bf16_t* dp = dst + (size_t)row * K + tk * 64 + kh * 32;
#pragma unroll
          for (int q = 0; q < 4; ++q) { float f[8];
#pragma unroll
              for (int e = 0; e < 8; ++e) f[e] = tile[(kh * 32 + q * 8 + e) * 257 + n];
              u32x4 w; w.x = cvt_pk_bf16(f[0], f[1]); w.y = cvt_pk_bf16(f[2], f[3]); w.z = cvt_pk_bf16(f[4], f[5]); w.w = cvt_pk_bf16(f[6], f[7]);
              *(u32x4*)(dp + q * 8) = w; } }
        __syncthreads();
    }
}
template <bool FINAL, bool SRC_F32> __device__ __forceinline__ void norm_rows(const float* xp, const float* xs, bf16_t* xb, const float* g, const float* modl, int sh_off, int sc_off, bf16_t* H, float* outf) {
    const int lane = pg8::otid() & 63, gw = pg8::obid() * 8 + (pg8::otid() >> 6), nw = pg8::ogrid() * 8;
    const int rpw = (T + nw - 1) / nw, r0 = gw * rpw, r1 = (r0 + rpw < T) ? r0 + rpw : T;
    if (r0 >= r1) return;
    f32x4 gs[8], sh[8]; int curseq = -1;
    struct RowBuf { f32x4 f[SRC_F32 ? 8 : 1]; u32x2 b[SRC_F32 ? 1 : 8]; };
    auto request = [&](RowBuf& B, int row) {
        if (SRC_F32) { const f32x4* src = (const f32x4*)(row < T_P ? xp + (size_t)row * 2048 : xs + (size_t)(row - T_P) * 2048);
#pragma unroll
            for (int i = 0; i < 8; ++i) B.f[i] = src[lane + 64 * i]; }
        else { const u32x2* src = (const u32x2*)(xb + (size_t)row * 2048);
#pragma unroll
            for (int i = 0; i < 8; ++i) B.b[i] = src[lane + 64 * i]; } };
    auto process = [&](RowBuf& B, int row, int next) {
        f32x4 v[8];
#pragma unroll
        for (int i = 0; i < 8; ++i) { if (SRC_F32) v[i] = B.f[i]; else v[i] = (f32x4){__uint_as_float(B.b[i].x << 16), __uint_as_float(B.b[i].x & 0xffff0000u), __uint_as_float(B.b[i].y << 16), __uint_as_float(B.b[i].y & 0xffff0000u)}; }
        if (next < r1) request(B, next);
        const int seq = seq_of_row(row);
        if (seq != curseq) { curseq = seq; const float* mod = modl + (size_t)seq * MODW;
#pragma unroll
            for (int i = 0; i < 8; ++i) { const int col = (lane + 64 * i) * 4; gs[i] = *(const f32x4*)(g + col); sh[i] = *(const f32x4*)(mod + sc_off + col); }
#pragma unroll
            for (int i = 0; i < 8; ++i) { const int col = (lane + 64 * i) * 4; const f32x4 sft = *(const f32x4*)(mod + sh_off + col); gs[i] = gs[i] * (1.0f + sh[i]); sh[i] = sft; } }
        float ss = 0.f;
#pragma unroll
        for (int i = 0; i < 8; ++i) ss += v[i][0] * v[i][0] + v[i][1] * v[i][1] + v[i][2] * v[i][2] + v[i][3] * v[i][3];
        ss = wave_sum(ss);
        const float rstd = 1.0f / sqrtf(ss * (1.0f / 2048.0f) + EPS);
#pragma unroll
        for (int i = 0; i < 8; ++i) { const int col = (lane + 64 * i) * 4;
            const f32x4 h = (v[i] * rstd) * gs[i] + sh[i];
            if (FINAL) *(f32x4*)(outf + (size_t)row * 2048 + col) = h;
            else { u32x2 w; w.x = cvt_pk_bf16(h[0], h[1]); w.y = cvt_pk_bf16(h[2], h[3]); *(u32x2*)(H + (size_t)row * 2048 + col) = w;
                if (SRC_F32) { u32x2 c; c.x = cvt_pk_bf16(v[i][0], v[i][1]); c.y = cvt_pk_bf16(v[i][2], v[i][3]); *(u32x2*)(xb + (size_t)row * 2048 + col) = c; } } } };
    if (SRC_F32) {
        RowBuf B0, B1;
        request(B0, r0); if (r0 + 1 < r1) request(B1, r0 + 1);
        for (int row = r0; row < r1; row += 2) { process(B0, row, row + 2); if (row + 1 < r1) process(B1, row + 1, row + 3); }
    } else {
        RowBuf B0, B1, B2;
        request(B0, r0); if (r0 + 1 < r1) request(B1, r0 + 1); if (r0 + 2 < r1) request(B2, r0 + 2);
        for (int row = r0; row < r1; row += 3) {
            process(B0, row, row + 3);
            if (row + 1 < r1) process(B1, row + 1, row + 4);
            if (row + 2 < r1) process(B2, row + 2, row + 5);
        }
    }
}
__device__ __forceinline__ void final_norm_phase(const Params& p) {
    norm_rows<true, false>(nullptr, nullptr, (bf16_t*)(p.ws + WS_XB), p.final_norm, (const float*)(p.ws + WS_MOD) + 49152, 0, 2048, nullptr, p.out);
}
__device__ __forceinline__ void transpose_phase(const Params& p, LDSQ unsigned char* lds) {
    LDSQ bf16_t* tile = (LDSQ bf16_t*)lds;
    const bf16_t* zin = (const bf16_t*)(p.ws + WS_BIG + BIG_ZINT); bf16_t* H = (bf16_t*)(p.ws + WS_H);
    const int tid = pg8::otid(), stride = pg8::ogrid();
    const int cr = tid >> 5, tq = tid & 31;
    u32x4 v[4];
    int ti = pg8::obid();
    if (ti < 32 * 160) { const int tc = ti / 160, tt = ti % 160;
#pragma unroll
        for (int it = 0; it < 4; ++it) v[it] = *(const u32x4*)(zin + (size_t)(tc * 64 + cr + 16 * it) * T + tt * 256 + tq * 8); }
    for (; ti < 32 * 160; ti += stride) {
        const int tc = ti / 160, tt = ti % 160;
#pragma unroll
        for (int it = 0; it < 4; ++it) *(LDSQ u32x4*)(tile + (cr + 16 * it) * 264 + tq * 8) = v[it];
        __syncthreads();
        if (ti + stride < 32 * 160) { const int t2 = ti + stride, tc2 = t2 / 160, tt2 = t2 % 160;
#pragma unroll
            for (int it = 0; it < 4; ++it) v[it] = *(const u32x4*)(zin + (size_t)(tc2 * 64 + cr + 16 * it) * T + tt2 * 256 + tq * 8); }
        { const int cq = tid & 7, tk = tid >> 3;
#pragma unroll
          for (int it = 0; it < 4; ++it) { const int tok = tk + 64 * it; unsigned w[4];
#pragma unroll
              for (int e = 0; e < 4; ++e) { const unsigned lo = tile[(cq * 8 + 2 * e) * 264 + tok], hi = tile[(cq * 8 + 2 * e + 1) * 264 + tok]; w[e] = lo | (hi << 16); }
              *(u32x4*)(H + (size_t)(tt * 256 + tok) * 2048 + tc * 64 + cq * 8) = (u32x4){w[0], w[1], w[2], w[3]}; } }
        __syncthreads();
    }
}

__host__ __device__ constexpr float cos64q(int k) {
    constexpr float t[17] = {1.0f, 0.99518472667219693f, 0.98078528040323043f, 0.95694033573220882f, 0.92387953251128674f, 0.88192126434835505f, 0.83146961230254524f,
        0.77301045336273699f, 0.70710678118654757f, 0.63439328416364549f, 0.55557023301960229f, 0.47139673682599781f, 0.38268343236508984f, 0.29028467725446233f,
        0.19509032201612833f, 0.09801714032956077f, 0.0f};
    return t[k];
}
__host__ __device__ constexpr float cos64(int k) { k &= 63; return k <= 16 ? cos64q(k) : k <= 32 ? -cos64q(32 - k) : k <= 48 ? -cos64q(k - 32) : cos64q(64 - k); }
__host__ __device__ constexpr float sin64(int k) { return cos64((k + 48) & 63); }
template <int R> __host__ __device__ constexpr int brev(int k) { int r = 0; for (int b = 1; b < R; b <<= 1) { r = (r << 1) | (k & 1); k >>= 1; } return r; }

typedef _Float16 hcpx __attribute__((ext_vector_type(2)));
typedef _Float16 hcpx2 __attribute__((ext_vector_type(4)));
__device__ __forceinline__ hcpx h_of(cpx a) { hcpx r; r.x = (_Float16)a.x; r.y = (_Float16)a.y; return r; }
__device__ __forceinline__ cpx c_of(hcpx a) { return mkc((float)a.x, (float)a.y); }
__device__ __forceinline__ hcpx2 h2_of(cpx a, cpx b) { hcpx2 r; r.x = (_Float16)a.x; r.y = (_Float16)a.y; r.z = (_Float16)b.x; r.w = (_Float16)b.y; return r; }
#define VA __device__ __forceinline__ float
VA f_mul(float a, float b) { float r; asm("v_mul_f32_e32 %0, %1, %2" : "=v"(r) : "v"(a), "v"(b)); return r; }
VA f_fma(float a, float b, float c) { float r; asm("v_fma_f32 %0, %1, %2, %3" : "=v"(r) : "v"(a), "v"(b), "v"(c)); return r; }
VA f_fms(float a, float b, float c) { float r; asm("v_fma_f32 %0, %1, %2, -%3" : "=v"(r) : "v"(a), "v"(b), "v"(c)); return r; }
#undef VA
__device__ __forceinline__ cpx cmul(cpx a, cpx b) { float rx, ry;
    asm("v_mul_f32_e32 %0, %3, %5\n\tv_mul_f32_e32 %1, %3, %4\n\tv_fma_f32 %0, %2, %4, -%0\n\tv_fma_f32 %1, %2, %5, %1" : "=&v"(rx), "=&v"(ry) : "v"(a.x), "v"(a.y), "v"(b.x), "v"(b.y)); return mkc(rx, ry); }
__device__ __forceinline__ cpx cmulc(cpx a, cpx b) { float rx, ry;
    asm("v_mul_f32_e32 %0, %3, %5\n\tv_mul_f32_e32 %1, %2, %5\n\tv_fma_f32 %0, %2, %4, %0\n\tv_fma_f32 %1, %3, %4, -%1" : "=&v"(rx), "=&v"(ry) : "v"(a.x), "v"(a.y), "v"(b.x), "v"(b.y)); return mkc(rx, ry); }

template <int R, bool INV, int H, int P> __device__ __forceinline__ void bfly(cpx (&v)[R]) {
    constexpr int b = (P / H) * 2 * H, i = P % H, e = i * (32 / H);
    float ux = v[b + i].x, uy = v[b + i].y, wx = v[b + i + H].x, wy = v[b + i + H].y;
    if constexpr (e == 0) { float dx, dy;
        asm("v_sub_f32_e32 %2, %0, %4\n\tv_sub_f32_e32 %3, %1, %5\n\tv_add_f32_e32 %0, %0, %4\n\tv_add_f32_e32 %1, %1, %5" : "+v"(ux), "+v"(uy), "=&v"(dx), "=&v"(dy) : "v"(wx), "v"(wy));
        wx = dx; wy = dy; }
    else if constexpr (e == 16) { float ox, oy;
        if constexpr (!INV) asm("v_sub_f32_e32 %2, %1, %5\n\tv_sub_f32_e32 %3, %4, %0\n\tv_add_f32_e32 %0, %0, %4\n\tv_add_f32_e32 %1, %1, %5" : "+v"(ux), "+v"(uy), "=&v"(ox), "=&v"(oy) : "v"(wx), "v"(wy));
        else                asm("v_sub_f32_e32 %2, %5, %1\n\tv_sub_f32_e32 %3, %0, %4\n\tv_add_f32_e32 %0, %0, %4\n\tv_add_f32_e32 %1, %1, %5" : "+v"(ux), "+v"(uy), "=&v"(ox), "=&v"(oy) : "v"(wx), "v"(wy));
        wx = ox; wy = oy; }
    else {
        constexpr int e2 = e < 16 ? e : e - 32;
        constexpr float cph = cos64(e2 & 63), sph = (INV ? 1.0f : -1.0f) * sin64(e2 & 63);
        constexpr float tn = -(sph / (1.0f + cph));
        constexpr unsigned tb = __builtin_bit_cast(unsigned, tn), sb = __builtin_bit_cast(unsigned, sph);
        if constexpr (e < 16)
            asm("v_sub_f32_e32 %2, %0, %2\n\tv_fma_f32 %0, 2.0, %0, -%2\n\tv_sub_f32_e32 %3, %1, %3\n\tv_fma_f32 %1, 2.0, %1, -%3\n\t"
                "v_fmamk_f32 %2, %3, %4, %2\n\tv_fmamk_f32 %3, %2, %5, %3\n\tv_fmamk_f32 %2, %3, %4, %2"
                : "+v"(ux), "+v"(uy), "+v"(wx), "+v"(wy) : "i"(tb), "i"(sb));
        else
            asm("v_sub_f32_e32 %2, %2, %0\n\tv_fma_f32 %0, 2.0, %0, %2\n\tv_sub_f32_e32 %3, %3, %1\n\tv_fma_f32 %1, 2.0, %1, %3\n\t"
                "v_fmamk_f32 %2, %3, %4, %2\n\tv_fmamk_f32 %3, %2, %5, %3\n\tv_fmamk_f32 %2, %3, %4, %2"
                : "+v"(ux), "+v"(uy), "+v"(wx), "+v"(wy) : "i"(tb), "i"(sb)); }
    v[b + i] = mkc(ux, uy); v[b + i + H] = mkc(wx, wy);
}
template <int R, bool INV, int H, int... Ps> __device__ __forceinline__ void dft_stage(cpx (&v)[R], std::integer_sequence<int, Ps...>) { (bfly<R, INV, H, Ps>(v), ...); }
template <int R, bool INV, int H> __device__ __forceinline__ void dft_stages(cpx (&v)[R]) {
    dft_stage<R, INV, H>(v, std::make_integer_sequence<int, R / 2>{});
    if constexpr (H > 1) dft_stages<R, INV, H / 2>(v);
}
template <int R, bool INV> __device__ __forceinline__ void dft_r2(cpx (&v)[R]) { dft_stages<R, INV, R / 2>(v); }
template <int R, bool CONJ, bool BREV> __device__ __forceinline__ void apply_pows(cpx (&v)[R], cpx w) {
    constexpr int H = R > 16 ? 16 : R;
    cpx pw[H];
    pw[1] = w;
#pragma unroll
    for (int k = 2; k < H; ++k) pw[k] = (k & 1) ? cmul(pw[k - 1], w) : cmul(pw[k / 2], pw[k / 2]);
#pragma unroll
    for (int k = 1; k < H; ++k) { const int idx = BREV ? brev<R>(k) : k; v[idx] = CONJ ? cmulc(v[idx], pw[k]) : cmul(v[idx], pw[k]); }
    if (R > 16) {
        const cpx w16 = cmul(pw[8], pw[8]);
#pragma unroll
        for (int k = 0; k < R - 16; ++k) { const cpx q = k == 0 ? w16 : cmul(pw[k], w16); const int idx = BREV ? brev<R>(16 + k) : 16 + k; v[idx] = CONJ ? cmulc(v[idx], q) : cmul(v[idx], q); }
    }
}
__device__ __forceinline__ int phys(int i) { return i + (i >> 5); }
constexpr int TW_OFF = 135168 + 64;
template <int S> __host__ __device__ constexpr int poff(int j) { return S >= 32 ? j * (S + S / 32) : j * S + ((j * S) >> 5); }
typedef hcpx PreRegs[32];
template <int R, int S> __device__ __forceinline__ void fft_prefetch(int t, const hcpx* gio, PreRegs& pre) {
    constexpr int G = 32 / R;
#pragma unroll
    for (int gi = 0; gi < G; ++gi) { const int gam = gi * 512 + t, hi = gam / S, lo = gam % S, base = hi * (R * S) + lo;
#pragma unroll
        for (int j = 0; j < R; ++j) pre[gi * R + j] = __builtin_nontemporal_load(gio + base + j * S); }
}
template <int R, int S, bool INV, int IO> __device__ __forceinline__ void fft_pass(LDSQ cpx* A, int t, hcpx* gio, const PreRegs& pre) {
    constexpr int G = 32 / R;
    asm volatile("" : "+v"(t) :: "memory");
    const LDSQ cpx* TW = (const LDSQ cpx*)((LDSQ unsigned char*)A + TW_OFF);
    cpx v[G][R]; cpx tw[G];
#pragma unroll
    for (int gi = 0; gi < G; ++gi) {
        const int gam = gi * 512 + t, hi = gam / S, lo = gam % S, base = hi * (R * S) + lo; const LDSQ cpx* Ab = A + phys(base);
#pragma unroll
        for (int j = 0; j < R; ++j) v[gi][j] = (IO == 3) ? c_of(pre[gi * R + j]) : (IO == 1) ? c_of(__builtin_nontemporal_load(gio + base + j * S)) : Ab[poff<S>(j)];
        tw[gi] = TW[lo * (16384 / (R * S))];
    }
#pragma unroll
    for (int gi = 0; gi < G; ++gi) {
        const int gam = gi * 512 + t, hi = gam / S, lo = gam % S, base = hi * (R * S) + lo; LDSQ cpx* Ab = A + phys(base);
        if (!INV) {
            dft_r2<R, false>(v[gi]);
            apply_pows<R, false, true>(v[gi], tw[gi]);
#pragma unroll
            for (int k = 0; k < R; ++k) { if (IO == 2) gio[base + k * S] = h_of(v[gi][brev<R>(k)]); else Ab[poff<S>(k)] = v[gi][brev<R>(k)]; }
        } else {
            apply_pows<R, true, false>(v[gi], tw[gi]);
            dft_r2<R, true>(v[gi]);
#pragma unroll
            for (int j = 0; j < R; ++j) { if (IO == 2) gio[base + j * S] = h_of(v[gi][brev<R>(j)]); else Ab[poff<S>(j)] = v[gi][brev<R>(j)]; }
        }
    }
}
template <int R, int MODE> __device__ __forceinline__ void fft_mid(LDSQ cpx* A, int t, hcpx* spec, float scale) {
    constexpr int G = 32 / R;
    asm volatile("" : "+v"(t) :: "memory");
    hcpx2 sp[G][R / 2];
    if (MODE == 1) {
#pragma unroll
        for (int gi = 0; gi < G; ++gi)
#pragma unroll
            for (int k2 = 0; k2 < R / 2; ++k2) sp[gi][k2] = *(const hcpx2*)(spec + 2 * (size_t)(k2 * (16384 / R) + gi * 512 + t));
    }
#pragma unroll
    for (int gi = 0; gi < G; ++gi) {
        const int gam = gi * 512 + t, base = gam * R;
        cpx v[R];
        LDSQ cpx* Ab = A + phys(base);
#pragma unroll
        for (int j = 0; j < R; ++j) v[j] = Ab[j];
        dft_r2<R, false>(v);
        if (MODE == 0) {
#pragma unroll
            for (int k2 = 0; k2 < R / 2; ++k2) { const cpx x = v[brev<R>(2 * k2)], y = v[brev<R>(2 * k2 + 1)];
                *(hcpx2*)(spec + 2 * (size_t)(k2 * (16384 / R) + gam)) = h2_of(mkc(x.x * scale, x.y * scale), mkc(y.x * scale, y.y * scale)); }
        } else {
            cpx x[R];
#pragma unroll
            for (int k2 = 0; k2 < R / 2; ++k2) { const hcpx2 s = sp[gi][k2]; x[2 * k2] = cmul(v[brev<R>(2 * k2)], mkc((float)s.x * scale, (float)s.y * scale)); x[2 * k2 + 1] = cmul(v[brev<R>(2 * k2 + 1)], mkc((float)s.z * scale, (float)s.w * scale)); }
            dft_r2<R, true>(x);
#pragma unroll
            for (int j = 0; j < R; ++j) Ab[j] = x[brev<R>(j)];
        }
    }
}
#define GL_DRAIN() asm volatile("s_waitcnt vmcnt(0)" ::: "memory")
struct NoHook { __device__ __forceinline__ void operator()() const {} };
template <int LOG2L, bool INV, int GIO, class Hook = NoHook> __device__ __forceinline__ void fft_outer(LDSQ cpx* A, int t, hcpx* gio, const hcpx* pfsrc, PreRegs& pre, Hook hook = Hook()) {
    constexpr int R1 = LOG2L == 14 ? 32 : 16, S1 = LOG2L == 14 ? 512 : 128, S2 = LOG2L == 14 ? 16 : 8;
    if (!INV) { fft_pass<R1, S1, false, GIO == 3 ? 3 : 0>(A, t, nullptr, pre); __syncthreads(); fft_pass<R1, S2, false, 0>(A, t, nullptr, pre); GL_DRAIN(); __syncthreads(); }
    else      { fft_pass<R1, S2, true, 0>(A, t, nullptr, pre); __syncthreads();
                if (GIO == 2) fft_prefetch<R1, S1>(t, pfsrc, pre);
                hook();
                fft_pass<R1, S1, true, GIO == 2 ? 2 : 0>(A, t, gio, pre); if (GIO != 2) GL_DRAIN(); __syncthreads(); }
}
template <int LOG2L, int SRC, int DST, class Hook = NoHook> __device__ __forceinline__ void fft_conv(LDSQ cpx* A, int t, hcpx* spec, hcpx* gdst, const hcpx* pfsrc, PreRegs& pre, Hook hook = Hook()) {
    fft_outer<LOG2L, false, SRC>(A, t, nullptr, nullptr, pre);
    fft_mid<LOG2L == 14 ? 16 : 8, 1>(A, t, spec, 1.0f / (float)(1 << LOG2L));
    if (SRC == 3) GL_DRAIN();
    __syncthreads();
    fft_outer<LOG2L, true, DST>(A, t, gdst, pfsrc, pre, hook);
}

__device__ __forceinline__ void sconv4r(u32x2 q, unsigned zmr, unsigned zpr, float w0, float w1, float w2, float bb, float (&o)[4]) {
    const float zm = __uint_as_float(zmr << 16), zp = __uint_as_float(zpr << 16);
    const float z0 = __uint_as_float(q.x << 16), z1 = __uint_as_float(q.x & 0xffff0000u), z2 = __uint_as_float(q.y << 16), z3 = __uint_as_float(q.y & 0xffff0000u);
    o[0] = w0 * zm + w1 * z0 + w2 * z1 + bb; o[1] = w0 * z0 + w1 * z1 + w2 * z2 + bb; o[2] = w0 * z1 + w1 * z2 + w2 * z3 + bb; o[3] = w0 * z2 + w1 * z3 + w2 * zp + bb;
}
typedef _Float16 h4 __attribute__((ext_vector_type(4)));
__device__ __forceinline__ void tapquad(h4 a, h4 bq, unsigned b0bits, float wf, float wb, float rf1, float rf2, float rf3, float rb1, float rb2, float rb3, float (&fa)[4], float (&fb)[4]) {
    const float b0 = (float)__builtin_bit_cast(_Float16, (unsigned short)b0bits);
    fa[0] = (float)a.x * wf; fa[1] = (float)a.y * (wf * rf1); fa[2] = (float)a.z * (wf * rf2); fa[3] = (float)a.w * (wf * rf3);
    fb[0] = b0 * wb; fb[1] = (float)bq.w * (wb * rb1); fb[2] = (float)bq.z * (wb * rb2); fb[3] = (float)bq.y * (wb * rb3);
}
template <int LOG2L> struct SweepIdx {
    static constexpr int L = 1 << LOG2L, QS = L / 32;
    int t, seq, n00, a00; cpx wq0, w1, w2, w3;
    __device__ __forceinline__ SweepIdx(int t_, bool need_w) { t = t_; asm volatile("" : "+v"(t) :: "memory"); seq = (LOG2L == 14) ? 0 : (t >> 6); const int q0 = (LOG2L == 14) ? t : (t & 63); n00 = 4 * q0; a00 = seq * L + n00;
        if (need_w) { float sb, cb; sincospif(-(float)n00 / (float)L, &sb, &cb); wq0 = mkc(cb, sb);
            sincospif(-1.0f / (float)L, &sb, &cb); w1 = mkc(cb, sb); w2 = cmul(w1, w1); w3 = cmul(w2, w1); } }
};
#define WQS mkc(0.92387953251128674f, -0.38268343236508978f)
struct TapWin { float wf0, wfs, rf1, rf2, rf3, wb0, wbs, rb1, rb2, rb3; };
template <int LOG2L> __device__ __forceinline__ TapWin tap_windows(float df, float db, int n00) {
    constexpr int L = 1 << LOG2L, QS = L / 32; TapWin w;
    w.wf0 = expf(-df * (float)n00); w.wfs = expf(-df * (float)(4 * QS)); w.rf1 = expf(-df); w.rf2 = w.rf1 * w.rf1; w.rf3 = w.rf2 * w.rf1;
    w.wb0 = expf(-db * (float)(L - n00)); w.wbs = expf(db * (float)(4 * QS)); w.rb1 = expf(db); w.rb2 = w.rb1 * w.rb1; w.rb3 = w.rb2 * w.rb1; return w;
}
template <int LOG2L> __device__ __forceinline__ void sweep_taps2(LDSQ cpx* A, int t_, const _Float16* tf0, const _Float16* tb0, const _Float16* tf1, const _Float16* tb1, float df0, float db0, float df1, float db1, hcpx* hos, float& ss0, float& ss1) {
    constexpr int L = 1 << LOG2L, QS = L / 32; const SweepIdx<LOG2L> X(t_, true);
    const TapWin W0 = tap_windows<LOG2L>(df0, db0, X.n00), W1 = tap_windows<LOG2L>(df1, db1, X.n00);
    float s0 = 0.f, s1 = 0.f, wf0 = W0.wf0, wb0 = W0.wb0, wf1 = W1.wf0, wb1 = W1.wb0;
    cpx wn = X.wq0;
    h4 ra0[8], rb0[8], ra1[8], rb1[8]; unsigned rc0[8], rc1[8];
#pragma unroll
    for (int i = 0; i < 8; ++i) { const int n = 4 * (i * QS) + X.n00, nb = n > 0 ? L - n : L - 1;
        ra0[i] = *(const h4*)(tf0 + n); rb0[i] = *(const h4*)(tb0 + L - n - 4); rc0[i] = ((const unsigned short*)tb0)[nb];
        ra1[i] = *(const h4*)(tf1 + n); rb1[i] = *(const h4*)(tb1 + L - n - 4); rc1[i] = ((const unsigned short*)tb1)[nb]; }
#pragma unroll
    for (int i = 0; i < 8; ++i) { const int n = 4 * (i * QS) + X.n00; float fa0[4], fb0[4], fa1[4], fb1[4]; const unsigned hm = n > 0 ? 0xffffu : 0u;
        tapquad(ra0[i], rb0[i], rc0[i] & hm, wf0, wb0, W0.rf1, W0.rf2, W0.rf3, W0.rb1, W0.rb2, W0.rb3, fa0, fb0);
        tapquad(ra1[i], rb1[i], rc1[i] & hm, wf1, wb1, W1.rf1, W1.rf2, W1.rf3, W1.rb1, W1.rb2, W1.rb3, fa1, fb1);
        LDSQ cpx* ap = A + phys(X.a00 + 4 * i * QS); hcpx* hp = hos + X.a00 + 4 * i * QS;
#pragma unroll
        for (int e = 0; e < 4; ++e) { s0 += fa0[e] * fa0[e] + fb0[e] * fb0[e]; s1 += fa1[e] * fa1[e] + fb1[e] * fb1[e]; ap[e] = mkc(fa0[e] + fb0[e], fa1[e] + fb1[e]); }
        const cpx wa = cmul(wn, X.w1), wb2 = cmul(wn, X.w2), wc = cmul(wn, X.w3);
        const cpx y0 = cmul(mkc(fa0[0] - fb0[0], fa1[0] - fb1[0]), wn), y1 = cmul(mkc(fa0[1] - fb0[1], fa1[1] - fb1[1]), wa);
        const cpx y2 = cmul(mkc(fa0[2] - fb0[2], fa1[2] - fb1[2]), wb2), y3 = cmul(mkc(fa0[3] - fb0[3], fa1[3] - fb1[3]), wc);
        *(hcpx2*)hp = h2_of(y0, y1); *(hcpx2*)(hp + 2) = h2_of(y2, y3);
        wn = cmul(wn, WQS); wf0 *= W0.wfs; wb0 *= W0.wbs; wf1 *= W1.wfs; wb1 *= W1.wbs; }
    ss0 = s0; ss1 = s1;
}
template <int LOG2L, int PART> __device__ __forceinline__ void fft_mid_sep(LDSQ cpx* A, int t, hcpx* spec0, hcpx* spec1, const LDSQ float* red, const float* skp0, const float* skp1) {
    constexpr int R = LOG2L == 14 ? 16 : 8, G = 32 / R, NB = LOG2L == 14 ? 32 : 16, NG = NB * NB;
    asm volatile("" : "+v"(t) :: "memory");
#pragma unroll
    for (int gi = 0; gi < G; ++gi) {
        cpx v[R]; LDSQ cpx* Ab = A + phys((gi * 512 + t) * R);
#pragma unroll
        for (int j = 0; j < R; ++j) v[j] = Ab[j];
        dft_r2<R, false>(v);
#pragma unroll
        for (int k = 0; k < R; ++k) Ab[k] = v[brev<R>(k)];
    }
    __syncthreads();
#pragma unroll
    for (int gi = 0; gi < G; ++gi) {
        const int gam = gi * 512 + t, seq = gam / NG, g = gam % NG, k1 = g / NB, k2 = g % NB;
        const int gp = PART == 1 ? NG - 1 - g : (k1 ? (NB - k1) * NB + (NB - 1 - k2) : (k2 ? NB - k2 : 0));
        const bool wrap = PART == 0 && g == 0;
        const LDSQ cpx* Ab = A + phys(gam * R); const LDSQ cpx* Ap = A + phys((seq * NG + gp) * R);
        cpx z[R], q[R];
#pragma unroll
        for (int k = 0; k < R; ++k) { z[k] = Ab[k]; q[k] = Ap[k]; }
        float ss0, ss1;
        if (LOG2L == 14) { ss0 = red[0] + red[1] + red[2] + red[3] + red[4] + red[5] + red[6] + red[7]; ss1 = red[8] + red[9] + red[10] + red[11] + red[12] + red[13] + red[14] + red[15]; }
        else { ss0 = red[seq]; ss1 = red[8 + seq]; }
        const float n0 = 0.25f / sqrtf(ss0 + EPS), n1 = 0.25f / sqrtf(ss1 + EPS), h0 = 0.5f * skp0[seq], h1 = 0.5f * skp1[seq];
        hcpx* s0p = spec0 + 2 * (size_t)gam; hcpx* s1p = spec1 + 2 * (size_t)gam;
#pragma unroll
        for (int k2_ = 0; k2_ < R / 2; ++k2_) { cpx o0[2], o1[2];
#pragma unroll
            for (int e = 0; e < 2; ++e) { const int k = 2 * k2_ + e; cpx zp = q[R - 1 - k]; const cpx zw = q[(R - k) & (R - 1)];
                if (PART == 0) { zp.x = wrap ? zw.x : zp.x; zp.y = wrap ? zw.y : zp.y; }
                o0[e] = mkc((z[k].x + zp.x) * n0 + h0, (z[k].y - zp.y) * n0); o1[e] = mkc((z[k].y + zp.y) * n1 + h1, (zp.x - z[k].x) * n1); }
            *(hcpx2*)(s0p + 2 * (size_t)(k2_ * (16384 / R))) = h2_of(o0[0], o0[1]); *(hcpx2*)(s1p + 2 * (size_t)(k2_ * (16384 / R))) = h2_of(o1[0], o1[1]); }
    }
}
template <int LOG2L> __device__ __forceinline__ void sweep_load_v(LDSQ cpx* A, int t_, const bf16_t* zrow, size_t tb0, const float* cw, const float* cbias, int rc0, hcpx* xw) {
    constexpr int L = 1 << LOG2L, QS = L / 32; const SweepIdx<LOG2L> X(t_, true);
    const int rc = rc0 + X.seq; const float cw0 = cw[rc], cw1 = cw[6144 + rc], cw2 = cw[2 * 6144 + rc], bb = cbias[rc];
    const bf16_t* z0 = zrow + (size_t)rc * T + tb0; const bf16_t* z1 = z0 + L;
    cpx wn = X.wq0;
    u32x2 rq[8][2]; unsigned rm[8][2], rp[8][2];
#pragma unroll
    for (int i = 0; i < 8; ++i) { const int n = 4 * (i * QS) + X.n00, nm = n > 0 ? n - 1 : 0, np = n + 4 < L ? n + 4 : L - 1;
        rq[i][0] = *(const u32x2*)(z0 + n); rq[i][1] = *(const u32x2*)(z1 + n); rm[i][0] = z0[nm]; rm[i][1] = z1[nm]; rp[i][0] = z0[np]; rp[i][1] = z1[np]; }
#pragma unroll
    for (int i = 0; i < 8; ++i) { const int n = 4 * (i * QS) + X.n00; float xa[4], xb[4]; const unsigned hm = n > 0 ? 0xffffu : 0u, hp = n + 4 < L ? 0xffffu : 0u;
        sconv4r(rq[i][0], rm[i][0] & hm, rp[i][0] & hp, cw0, cw1, cw2, bb, xa); sconv4r(rq[i][1], rm[i][1] & hm, rp[i][1] & hp, cw0, cw1, cw2, bb, xb);
        LDSQ cpx* ap = A + phys(X.a00 + 4 * i * QS); hcpx* xp = xw + X.a00 + 4 * i * QS;
        ap[0] = mkc(xa[0], xb[0]); ap[1] = mkc(xa[1], xb[1]); ap[2] = mkc(xa[2], xb[2]); ap[3] = mkc(xa[3], xb[3]);
        const cpx y0 = cmul(mkc(xa[0], xb[0]), wn), y1 = cmul(mkc(xa[1], xb[1]), cmul(wn, X.w1)), y2 = cmul(mkc(xa[2], xb[2]), cmul(wn, X.w2)), y3 = cmul(mkc(xa[3], xb[3]), cmul(wn, X.w3));
        *(hcpx2*)xp = h2_of(y0, y1); *(hcpx2*)(xp + 2) = h2_of(y2, y3);
        wn = cmul(wn, WQS); }
}
constexpr int CPA = 2;
template <int N> struct CombPreN { u32x2 q[N][2]; unsigned zm[N][2], zp[N][2]; hcpx2 h01[N], h23[N]; };
typedef CombPreN<CPA> CombPre;
template <int LOG2L, int I0, int N> __device__ __forceinline__ void combine_prefetch(int t_, const hcpx* yes, const bf16_t* zrow, size_t tb0, int rg0, CombPreN<N>& P) {
    constexpr int L = 1 << LOG2L, QS = L / 32; const SweepIdx<LOG2L> X(t_, false);
    const int rg = rg0 + X.seq; const bf16_t* g0 = zrow + (size_t)rg * T + tb0; const bf16_t* g1 = g0 + L;
#pragma unroll
    for (int i = 0; i < N; ++i) { const int n = 4 * ((I0 + i) * QS) + X.n00; const hcpx* yp = yes + X.a00 + 4 * (I0 + i) * QS;
        P.q[i][0] = *(const u32x2*)(g0 + n); P.q[i][1] = *(const u32x2*)(g1 + n);
        const int nm = n > 0 ? n - 1 : 0, np = n + 4 < L ? n + 4 : L - 1;
        P.zm[i][0] = g0[nm]; P.zm[i][1] = g1[nm]; P.zp[i][0] = g0[np]; P.zp[i][1] = g1[np];
        P.h01[i] = __builtin_nontemporal_load((const hcpx2*)yp); P.h23[i] = __builtin_nontemporal_load((const hcpx2*)(yp + 2)); }
}
template <int LOG2L, int FINAL> __device__ __forceinline__ void sweep_combine(LDSQ cpx* A, int t_, const CombPre& P0, const hcpx* yes, hcpx* xw, bf16_t* zrow, size_t tb0, const float* cw, const float* cbias, int rg0, int ro0, int dry) {
    constexpr int L = 1 << LOG2L, QS = L / 32; const SweepIdx<LOG2L> X(t_, true);
    CombPreN<8 - CPA> P1; combine_prefetch<LOG2L, CPA>(X.t, yes, zrow, tb0, rg0, P1);
    const int rg = rg0 + X.seq; const float cw0 = cw[rg], cw1 = cw[6144 + rg], cw2 = cw[2 * 6144 + rg], bb = cbias[rg];
    bf16_t* o0 = zrow + (size_t)(ro0 + X.seq) * T + tb0; bf16_t* o1 = o0 + L;
    cpx wn = X.wq0;
#pragma unroll
    for (int i = 0; i < 8; ++i) { const int n = 4 * (i * QS) + X.n00; float ga[4], gb[4];
        const bool ah = i < CPA; const int ia = ah ? i : 0, ib = ah ? 0 : i - CPA;
        const unsigned hm = n > 0 ? 0xffffu : 0u, hp = n + 4 < L ? 0xffffu : 0u;
        sconv4r(ah ? P0.q[ia][0] : P1.q[ib][0], (ah ? P0.zm[ia][0] : P1.zm[ib][0]) & hm, (ah ? P0.zp[ia][0] : P1.zp[ib][0]) & hp, cw0, cw1, cw2, bb, ga);
        sconv4r(ah ? P0.q[ia][1] : P1.q[ib][1], (ah ? P0.zm[ia][1] : P1.zm[ib][1]) & hm, (ah ? P0.zp[ia][1] : P1.zp[ib][1]) & hp, cw0, cw1, cw2, bb, gb);
        const LDSQ cpx* ap = A + phys(X.a00 + 4 * i * QS);
        const hcpx2 h01 = ah ? P0.h01[ia] : P1.h01[ib], h23 = ah ? P0.h23[ia] : P1.h23[ib];
        const f32x4 e01 = {(float)h01.x, (float)h01.y, (float)h01.z, (float)h01.w}, e23 = {(float)h23.x, (float)h23.y, (float)h23.z, (float)h23.w};
        const cpx wa = cmul(wn, X.w1), wb2 = cmul(wn, X.w2), wc = cmul(wn, X.w3);
        const cpx r0 = cmulc(ap[0], wn), r1 = cmulc(ap[1], wa), r2 = cmulc(ap[2], wb2), r3 = cmulc(ap[3], wc);
        const cpx s0 = mkc(ga[0] * (e01[0] + r0.x), gb[0] * (e01[1] + r0.y)), s1 = mkc(ga[1] * (e01[2] + r1.x), gb[1] * (e01[3] + r1.y));
        const cpx s2 = mkc(ga[2] * (e23[0] + r2.x), gb[2] * (e23[1] + r2.y)), s3 = mkc(ga[3] * (e23[2] + r3.x), gb[3] * (e23[3] + r3.y));
        if (FINAL == 0) { LDSQ cpx* aw = A + phys(X.a00 + 4 * i * QS); hcpx* xp = xw + X.a00 + 4 * i * QS;
            aw[0] = s0; aw[1] = s1; aw[2] = s2; aw[3] = s3;
            const cpx y0 = cmul(s0, wn), y1 = cmul(s1, wa), y2 = cmul(s2, wb2), y3 = cmul(s3, wc);
            *(hcpx2*)xp = h2_of(y0, y1); *(hcpx2*)(xp + 2) = h2_of(y2, y3); }
        else if (!dry) { u32x2 wa2, wb3; wa2.x = cvt_pk_bf16(s0.x, s1.x); wa2.y = cvt_pk_bf16(s2.x, s3.x); wb3.x = cvt_pk_bf16(s0.y, s1.y); wb3.y = cvt_pk_bf16(s2.y, s3.y);
            *(u32x2*)(o0 + n) = wa2; *(u32x2*)(o1 + n) = wb3; }
        wn = cmul(wn, WQS); }
}
template <int LOG2L> __device__ __forceinline__ void hyena_item(const Params& p, LDSQ unsigned char* lds, int layer_j, int c0, int dry) {
    constexpr int L = 1 << LOG2L, NPAIR = (LOG2L == 14) ? 1 : 2;
    constexpr int TOK0 = (LOG2L == 14) ? 0 : T_P, PB = (LOG2L == 14) ? 0 : 16384;
    LDSQ cpx* A = (LDSQ cpx*)lds;
    LDSQ float* red = (LDSQ float*)(lds + 135168);
    const int t = pg8::otid(), ch = c0 + ((LOG2L == 14) ? 0 : (t >> 6));
    bf16_t* zin = (bf16_t*)(p.ws + WS_BIG + BIG_ZINT);
    const _Float16* taps = (const _Float16*)(p.ws + WS_BIG + BIG_TAPS);
    hcpx* scr = (hcpx*)(p.ws + WS_H + (size_t)pg8::obid() * FFT_SCR_PER_WG);
    hcpx* u1s = scr + (size_t)4 * 16384;
    hcpx* yes = (hcpx*)(p.ws + WS_END + (size_t)pg8::obid() * FFT_EXT_PER_WG);
    PreRegs pre;
    hcpx* xw = yes + 16384;
    {
        const _Float16* tf0 = taps + (size_t)(0 * 2048 + ch) * NPOS + PB; const _Float16* tb0 = taps + (size_t)(1 * 2048 + ch) * NPOS + PB;
        const _Float16* tf1 = taps + (size_t)(2 * 2048 + ch) * NPOS + PB; const _Float16* tb1 = taps + (size_t)(3 * 2048 + ch) * NPOS + PB;
        const float* dec = p.hy_decay + (size_t)layer_j * 8192 + ch;
        const float df0 = fabsf(dec[0]) * (1.0f / (float)(L - 1)), db0 = fabsf(dec[2048]) * (1.0f / (float)(L - 1));
        const float df1 = fabsf(dec[4096]) * (1.0f / (float)(L - 1)), db1 = fabsf(dec[6144]) * (1.0f / (float)(L - 1));
        float ss0, ss1;
        sweep_taps2<LOG2L>(A, t, tf0, tb0, tf1, tb1, df0, db0, df1, db1, xw, ss0, ss1);
        ss0 = wave_sum(ss0); ss1 = wave_sum(ss1);
        if ((t & 63) == 0) { red[t >> 6] = ss0; red[8 + (t >> 6)] = ss1; }
        __syncthreads();
        const float* skp0 = p.hy_skip + (size_t)layer_j * 2 * 2048 + c0; const float* skp1 = skp0 + 2048;
        fft_outer<LOG2L, false, 0>(A, t, nullptr, nullptr, pre);
        fft_prefetch<LOG2L == 14 ? 32 : 16, LOG2L == 14 ? 512 : 128>(t, xw, pre);
        fft_mid_sep<LOG2L, 0>(A, t, scr + (size_t)0 * 16384, scr + (size_t)2 * 16384, red, skp0, skp1); __syncthreads();
        fft_outer<LOG2L, false, 3>(A, t, nullptr, nullptr, pre);
        fft_mid_sep<LOG2L, 1>(A, t, scr + (size_t)1 * 16384, scr + (size_t)3 * 16384, red, skp0, skp1); __syncthreads();
    }
    const float* cw = p.hy_conv_w + (size_t)layer_j * 3 * 6144; const float* cbias = p.hy_conv_b + (size_t)layer_j * 6144;
#pragma unroll 1
    for (int pr = 0; pr < NPAIR; ++pr) {
        const size_t tb0 = (size_t)TOK0 + (size_t)(2 * pr) * L;
        sweep_load_v<LOG2L>(A, t, zin, tb0, cw, cbias, 2 * 2048 + c0, xw); __syncthreads();
        fft_conv<LOG2L, 0, 2>(A, t, scr + (size_t)0 * 16384, yes, xw, pre);
        CombPre cp;
        fft_conv<LOG2L, 3, 0>(A, t, scr + (size_t)1 * 16384, nullptr, nullptr, pre, [&]() { combine_prefetch<LOG2L, 0>(t, yes, zin, tb0, c0, cp); });
        sweep_combine<LOG2L, 0>(A, t, cp, yes, xw, zin, tb0, cw, cbias, c0, c0, dry); __syncthreads();
        fft_conv<LOG2L, 0, 2>(A, t, scr + (size_t)2 * 16384, yes, xw, pre);
        fft_conv<LOG2L, 3, 0>(A, t, scr + (size_t)3 * 16384, nullptr, nullptr, pre, [&]() { combine_prefetch<LOG2L, 0>(t, yes, zin, tb0, 2048 + c0, cp); });
        sweep_combine<LOG2L, 1>(A, t, cp, yes, xw, zin, tb0, cw, cbias, 2048 + c0, c0, dry); __syncthreads();
    }
}
__device__ __forceinline__ void hyena_conv_phase(const Params& p, LDSQ unsigned char* lds, int layer_j, int dry) {
    { LDSQ cpx* TW = (LDSQ cpx*)(lds + TW_OFF);
      for (int e = pg8::otid(); e < 1024; e += NTHR) { float sn, cs; sincospif(-2.0f * (float)e / 16384.0f, &sn, &cs); TW[e] = mkc(cs, sn); }
      __syncthreads(); }
    for (int it = pg8::obid(); it < 2048; it += pg8::ogrid()) hyena_item<14>(p, lds, layer_j, it, dry);
    for (int it = pg8::obid(); it < 256; it += pg8::ogrid()) hyena_item<11>(p, lds, layer_j, it * 8, dry);
}

__device__ __forceinline__ void attn_phase(const Params& p, LDSQ unsigned char* lds, int dry = 0) {
    constexpr int KROW = 272, VROW = 264;
    LDSQ unsigned char* Kl = lds; LDSQ bf16_t* VT = (LDSQ bf16_t*)(lds + 256 * KROW);
    const bf16_t* qkv = (const bf16_t*)(p.ws + WS_BIG + BIG_QKV);
    bf16_t* og = (bf16_t*)(p.ws + WS_BIG + BIG_OG); float* lse = (float*)(p.ws + WS_BIG + BIG_LSE);
    const int tid = pg8::otid(), lane = tid & 63, wid = __builtin_amdgcn_readfirstlane(tid >> 6), l15 = lane & 15, g4 = lane >> 4;
    const int blk = wid >> 2, qq = 16 * (wid & 3) + l15;
    for (int u = pg8::obid(); u < 1792 + 512; u += pg8::ogrid()) {
        const int it = u < 1792 ? 4 * u : 7168 + (u - 1792), len = u < 1792 ? 4 : 1;
        int g, b, hh, rho, pp0, L, tokbase;
        if (it < 6144) { g = it >> 11; const int rem = it & 2047; const int npp = 128 >> (2 * g); pp0 = rem % npp; rho = (rem / npp) & ((1 << (2 * g)) - 1); hh = (rem >> 7) & 7; b = rem >> 10; L = L_P; tokbase = 0; }
        else { const int i2 = it - 6144; g = i2 >> 9; const int rem = i2 & 511; const int npp = 16 >> (2 * g); pp0 = rem % npp; rho = (rem / npp) & ((1 << (2 * g)) - 1); hh = (rem >> 4) & 7; b = rem >> 7; L = L_S; tokbase = T_P; }
        const int rsh = 2 * g, n = L >> rsh;
        const size_t tok0 = (size_t)tokbase + (size_t)b * L + rho;
        const int qcol = g * 3072 + hh * 128, kcol = qcol + 1024, vcol = qcol + 2048;
        u32x4 kr[2][4], vr[2][4];
        auto request_half = [&](int ih, u32x4 (&kh)[4], u32x4 (&vh)[4]) {
#pragma unroll
            for (int s4 = 0; s4 < 4; ++s4) { const int ci = tid + 512 * s4;
                { const int slot = ci >> 4, chn = ci & 15, i = ih + slot, ic = i < 0 ? 0 : (i < n ? i : n - 1); kh[s4] = *(const u32x4*)(qkv + (tok0 + ((size_t)ic << rsh)) * QKVW + kcol + chn * 8); }
                { const int slot = (ci & 15) + 16 * ((ci >> 6) & 7), chn = ((ci >> 4) & 3) + 4 * (ci >> 9), i = ih + slot, ic = i < 0 ? 0 : (i < n ? i : n - 1); vh[s4] = *(const u32x4*)(qkv + (tok0 + ((size_t)ic << rsh)) * QKVW + vcol + chn * 8); } } };
        auto stage_half = [&](int ih, int ring0, const u32x4 (&kh)[4], const u32x4 (&vh)[4]) {
#pragma unroll
            for (int s4 = 0; s4 < 4; ++s4) { const int ci = tid + 512 * s4;
                { const int slot = ci >> 4, chn = ci & 15, i = ih + slot; const unsigned ok = (i >= 0 && i < n) ? 0xffffffffu : 0u;
                  u32x4 v = kh[s4]; v.x &= ok; v.y &= ok; v.z &= ok; v.w &= ok;
                  *(LDSQ u32x4*)(Kl + (ring0 + slot) * KROW + chn * 16) = v; }
                { const int slot = (ci & 15) + 16 * ((ci >> 6) & 7), chn = ((ci >> 4) & 3) + 4 * (ci >> 9), i = ih + slot; const unsigned ok = (i >= 0 && i < n) ? 0xffffffffu : 0u;
                  u32x4 v = vh[s4]; v.x &= ok; v.y &= ok; v.z &= ok; v.w &= ok;
                  LDSQ bf16_t* vp = VT + (32 * (chn >> 2) + 4 * (chn & 3)) * VROW + ring0 + slot;
                  vp[0] = (bf16_t)(v.x & 0xffffu); vp[VROW] = (bf16_t)(v.x >> 16); vp[2 * VROW] = (bf16_t)(v.y & 0xffffu); vp[3 * VROW] = (bf16_t)(v.y >> 16);
                  vp[16 * VROW] = (bf16_t)(v.z & 0xffffu); vp[17 * VROW] = (bf16_t)(v.z >> 16); vp[18 * VROW] = (bf16_t)(v.w & 0xffffu); vp[19 * VROW] = (bf16_t)(v.w >> 16); } } };
        request_half(128 * pp0 - 64, kr[0], vr[0]); request_half(128 * pp0 + 64, kr[1], vr[1]);
#pragma unroll 1
        for (int s = 0; s < len; ++s) {
            const int pp = pp0 + s, i0 = 128 * pp - 64, off = (128 * pp) & 255;
            const int qi = 128 * pp + 64 * blk + qq;
            const size_t tq = tok0 + ((size_t)qi << rsh);
            bf16x8 bq[4];
#pragma unroll
            for (int ks = 0; ks < 4; ++ks) bq[ks] = *(const bf16x8*)(qkv + tq * QKVW + qcol + 32 * ks + 8 * g4);
            if (s == 0) stage_half(i0, off, kr[0], vr[0]);
            stage_half(i0 + 128, (128 + off) & 255, kr[1], vr[1]);
            __syncthreads();
            const int ktb = wid & 3;
            f32x4 sc[10]; bf16x8 kf[2][4];
            __builtin_amdgcn_s_setprio(1);
            auto kload = [&](int j, bf16x8 (&f)[4]) { const int rb = (64 * blk + 16 * (ktb + j) + off) & 255;
#pragma unroll
                for (int ks = 0; ks < 4; ++ks) f[ks] = *(const LDSQ bf16x8*)(Kl + (rb + l15) * KROW + (32 * ks + 8 * g4) * 2); };
            kload(0, kf[0]);
#pragma unroll
            for (int j = 0; j < 9; ++j) {
                if (j + 1 < 9) kload(j + 1, kf[(j + 1) & 1]);
                __builtin_amdgcn_sched_barrier(0);
                f32x4 a = {0.f, 0.f, 0.f, 0.f};
#pragma unroll
                for (int ks = 0; ks < 4; ++ks) a = __builtin_amdgcn_mfma_f32_16x16x32_bf16(kf[j & 1][ks], bq[ks], a, 0, 0, 0);
                sc[j] = a;
                __builtin_amdgcn_sched_barrier(0); }
            __builtin_amdgcn_s_setprio(0);
            if (s + 1 < len) request_half(i0 + 256, kr[1], vr[1]);
            const int ibase = 128 * pp + 64 * blk - 64;
            const int klo = qq > -ibase ? qq : -ibase, khi = (qq + 128 < n - 1 - ibase) ? qq + 128 : n - 1 - ibase;
            const unsigned kspan = (unsigned)(khi - klo); const int kk0 = 4 * g4 - klo + 16 * ktb;
            float mx = -3.0e38f;
#pragma unroll
            for (int j = 0; j < 9; ++j)
#pragma unroll
                for (int r = 0; r < 4; ++r) { const bool ok = (unsigned)(kk0 + 16 * j + r) <= kspan;
                    sc[j][r] = ok ? sc[j][r] : -3.0e38f; mx = fmaxf(mx, sc[j][r]); }
            mx = fmaxf(mx, __shfl_xor(mx, 16)); mx = fmaxf(mx, __shfl_xor(mx, 32));
            float ls = 0.f;
#pragma unroll
            for (int j = 0; j < 9; ++j)
#pragma unroll
                for (int r = 0; r < 4; ++r) { const float e = __builtin_amdgcn_exp2f(sc[j][r] - mx); sc[j][r] = e; ls += e; }
            sc[9] = (f32x4){0.f, 0.f, 0.f, 0.f};
            ls += __shfl_xor(ls, 16); ls += __shfl_xor(ls, 32);
            f32x4 oa[8];
#pragma unroll
            for (int dt = 0; dt < 8; ++dt) oa[dt] = (f32x4){0.f, 0.f, 0.f, 0.f};
            u32x2 vf[2][4][2];
            auto vload = [&](int gidx, u32x2 (&f)[4][2]) { const int k2 = gidx >> 1, d0 = (gidx & 1) * 4;
                const int cb0 = (64 * blk + 16 * ktb + 32 * k2 + off) & 255, cb1 = (cb0 + 16) & 255;
#pragma unroll
                for (int d = 0; d < 4; ++d) { const LDSQ bf16_t* vq = VT + (16 * (d0 + d) + l15) * VROW + 4 * g4; f[d][0] = *(const LDSQ u32x2*)(vq + cb0); f[d][1] = *(const LDSQ u32x2*)(vq + cb1); } };
            __builtin_amdgcn_s_setprio(1);
            vload(0, vf[0]);
#pragma unroll
            for (int gidx = 0; gidx < 10; ++gidx) { const int k2 = gidx >> 1, d0 = (gidx & 1) * 4;
                if (gidx + 1 < 10) vload(gidx + 1, vf[(gidx + 1) & 1]);
                __builtin_amdgcn_sched_barrier(0);
                union { u32x4 u; bf16x8 h; } pb;
                pb.u.x = cvt_pk_bf16(sc[2 * k2][0], sc[2 * k2][1]); pb.u.y = cvt_pk_bf16(sc[2 * k2][2], sc[2 * k2][3]);
                pb.u.z = cvt_pk_bf16(sc[2 * k2 + 1][0], sc[2 * k2 + 1][1]); pb.u.w = cvt_pk_bf16(sc[2 * k2 + 1][2], sc[2 * k2 + 1][3]);
#pragma unroll
                for (int d = 0; d < 4; ++d) { union { u32x4 u; bf16x8 h; } va; const u32x2 lo = vf[gidx & 1][d][0], hi = vf[gidx & 1][d][1];
                    va.u.x = lo.x; va.u.y = lo.y; va.u.z = hi.x; va.u.w = hi.y;
                    oa[d0 + d] = __builtin_amdgcn_mfma_f32_16x16x32_bf16(va.h, pb.h, oa[d0 + d], 0, 0, 0); }
                __builtin_amdgcn_sched_barrier(0); }
            __builtin_amdgcn_s_setprio(0);
            const float inv = 1.0f / ls;
            const size_t gt = (size_t)g * T + tq;
#pragma unroll
            for (int q = 0; q < 4; ++q) { u32x4 w; w.x = cvt_pk_bf16(oa[2 * q][0] * inv, oa[2 * q][1] * inv); w.y = cvt_pk_bf16(oa[2 * q][2] * inv, oa[2 * q][3] * inv);
                w.z = cvt_pk_bf16(oa[2 * q + 1][0] * inv, oa[2 * q + 1][1] * inv); w.w = cvt_pk_bf16(oa[2 * q + 1][2] * inv, oa[2 * q + 1][3] * inv);
                if (!dry) *(u32x4*)(og + gt * 1024 + hh * 128 + 32 * q + 8 * g4) = w; }
            if (g4 == 0 && !dry) lse[gt * 8 + hh] = mx + log2f(ls);
            __syncthreads();
        }
    }
}
__device__ __forceinline__ void attn_merge_phase(const Params& p) {
    const bf16_t* og = (const bf16_t*)(p.ws + WS_BIG + BIG_OG); const float* lse = (const float*)(p.ws + WS_BIG + BIG_LSE); bf16_t* H = (bf16_t*)(p.ws + WS_H);
    const int stride = pg8::ogrid() * NTHR;
    for (int i0 = pg8::obid() * NTHR + pg8::otid(); i0 < T * 128; i0 += 4 * stride) {
        u32x4 v0[4], v1[4], v2[4]; float l0[4], l1[4], l2[4];
#pragma unroll
        for (int u = 0; u < 4; ++u) { const int i = i0 + u * stride; if (i < T * 128) { const int tok = i >> 7, c8 = i & 127, hh = c8 >> 4;
            l0[u] = lse[(size_t)tok * 8 + hh]; l1[u] = lse[((size_t)T + tok) * 8 + hh]; l2[u] = lse[((size_t)2 * T + tok) * 8 + hh];
            v0[u] = *(const u32x4*)(og + (size_t)tok * 1024 + c8 * 8); v1[u] = *(const u32x4*)(og + ((size_t)T + tok) * 1024 + c8 * 8); v2[u] = *(const u32x4*)(og + ((size_t)2 * T + tok) * 1024 + c8 * 8); } }
#pragma unroll
        for (int u = 0; u < 4; ++u) { const int i = i0 + u * stride; if (i < T * 128) { const int tok = i >> 7, c8 = i & 127;
            const float m = fmaxf(l0[u], fmaxf(l1[u], l2[u])); float a0 = exp2f(l0[u] - m), a1 = exp2f(l1[u] - m), a2 = exp2f(l2[u] - m); const float is = 1.0f / (a0 + a1 + a2); a0 *= is; a1 *= is; a2 *= is;
            u32x4 w;
#pragma unroll
            for (int e = 0; e < 4; ++e) { const float lo = a0 * __uint_as_float(v0[u][e] << 16) + a1 * __uint_as_float(v1[u][e] << 16) + a2 * __uint_as_float(v2[u][e] << 16);
                const float hi = a0 * __uint_as_float(v0[u][e] & 0xffff0000u) + a1 * __uint_as_float(v1[u][e] & 0xffff0000u) + a2 * __uint_as_float(v2[u][e] & 0xffff0000u);
                w[e] = cvt_pk_bf16(lo, hi); }
            *(u32x4*)(H + (size_t)tok * 1024 + c8 * 8) = w; } }
    }
}

constexpr int NPHASE = 35;
typedef const __attribute__((address_space(4))) unsigned char* KARG;
template <class Tp> __device__ __forceinline__ Tp karg(int byte_off) { return *(volatile const __attribute__((address_space(4))) Tp*)((KARG)__builtin_amdgcn_kernarg_segment_ptr() + byte_off); }
#define PA(q, member) q.member = karg<decltype(Params::member)>((int)__builtin_offsetof(Params, member))
__global__ void __launch_bounds__(512, 2) mega(Params parg) {
    extern __shared__ __attribute__((aligned(16))) unsigned char shm[];
    LDSQ unsigned char* lds = (LDSQ unsigned char*)shm;
    const int tid = pg8::otid();
    volatile LDSQ unsigned* misc = (volatile LDSQ unsigned*)(lds + LDS_MISC);
    if (tid < 8) misc[tid] = 0u;
    __syncthreads();
    const int ph_lo = parg.ph_lo, ph_hi = parg.ph_hi, probe = parg.probe;
#define REPS(bit, lay) (1 + (1 + ((probe >> 15) & 1)) * (((probe >> (bit)) & 1) & ((((probe >> 10) & 3) == 0) | ((probe >> (10 + ((lay) & 1))) & 1))))
    XcdBarrier bar; bar.bar = nullptr; bar.x = 0; bar.st = misc;
    if (ph_hi - ph_lo > 1) { Params q{}; PA(q, ws); bar = xcd_barrier_post((unsigned*)(q.ws + WS_CTL), misc); }
#define IN(k) (ph_lo <= (k) && (k) < ph_hi)
#define REPBAR() do { if (((probe >> 16) & 1) && rep + 1 < nrep) { Params qb{}; PA(qb, ws); bar.bar = (unsigned*)(qb.ws + WS_CTL); xcd_barrier(bar); } } while (0)
#define SEAM(k) do { if (IN(k) && IN((k) + 1)) { Params qb{}; PA(qb, ws); bar.bar = (unsigned*)(qb.ws + WS_CTL); xcd_barrier(bar); if ((probe >> 12) & 1) { xcd_barrier(bar); xcd_barrier(bar); } } } while (0)

    for (int rep = 0, nrep = REPS(0, 0); rep < nrep; ++rep)
    if (IN(0)) { Params q{}; PA(q, ws); PA(q, c_prompt); PA(q, c_sample); PA(q, ada_w); PA(q, final_ada_w); ada_partials(q, lds); rope_table(q);
                 PA(q, hy_fw1); PA(q, hy_fb1); PA(q, hy_ffreq); PA(q, hy_fw2); PA(q, hy_fb2); PA(q, hy_fw3); filter_mlp(q); }
    SEAM(0);
    for (int rep = 0, nrep = REPS(0, 0); rep < nrep; ++rep)
    if (IN(1)) { Params q{}; PA(q, ws); PA(q, ada_b); PA(q, final_ada_b); ada_reduce(q); }
    SEAM(1);
#pragma unroll 1
    for (int layer = 0; layer < 4; ++layer) {
        const int pb = 2 + 8 * layer, j = layer >> 1; const bool hy = (layer & 1) == 0;
        for (int rep = 0, nrep = REPS(1, layer); rep < nrep; ++rep)
        if (IN(pb + 0)) {
            Params q{}; PA(q, ws); unsigned char* wl = q.ws + WS_WL;
            PA(q, ffn_w_gate); convert_T(lds, q.ffn_w_gate + (size_t)layer * 2048 * DFF, 2048, DFF, (bf16_t*)(wl + WL_FFN1), 0);
            PA(q, ffn_w_up);   convert_T(lds, q.ffn_w_up + (size_t)layer * 2048 * DFF, 2048, DFF, (bf16_t*)(wl + WL_FFN1), 1);
            PA(q, ffn_w_down); convert_T(lds, q.ffn_w_down + (size_t)layer * DFF * 2048, DFF, 2048, (bf16_t*)(wl + WL_FFN2), -1);
            if (hy) { PA(q, hy_w_in);  convert_T(lds, q.hy_w_in + (size_t)j * 2048 * 6144, 2048, 6144, (bf16_t*)(wl + WL_MIXIN), -1);
                      PA(q, hy_w_out); convert_T(lds, q.hy_w_out + (size_t)j * 2048 * 2048, 2048, 2048, (bf16_t*)(wl + WL_MIXOUT), -1); }
            else    { PA(q, at_w_in);  convert_T(lds, q.at_w_in + (size_t)j * 2048 * QKVW, 2048, QKVW, (bf16_t*)(wl + WL_MIXIN), -1);
                      PA(q, at_w_out); convert_T(lds, q.at_w_out + (size_t)j * 1024 * 2048, 1024, 2048, (bf16_t*)(wl + WL_MIXOUT), -1); }
            PA(q, norm_mix);
            const float* modl = (const float*)(q.ws + WS_MOD) + layer * 12288;
            if (layer == 0) { PA(q, x_prompt); PA(q, x_sample); norm_rows<false, true>(q.x_prompt, q.x_sample, (bf16_t*)(q.ws + WS_XB), q.norm_mix + layer * 2048, modl, 0, 2048, (bf16_t*)(q.ws + WS_H), nullptr); }
            else            norm_rows<false, false>(nullptr, nullptr, (bf16_t*)(q.ws + WS_XB), q.norm_mix + layer * 2048, modl, 0, 2048, (bf16_t*)(q.ws + WS_H), nullptr);
            if (hy) { __syncthreads();
                pg8::Gemm g{(const bf16_t*)(q.ws + WS_W3X) + (size_t)j * 8192 * 256, (const bf16_t*)(q.ws + WS_A2X) + (size_t)j * NPOS * 256, 8192, NPOS, 256};
                pg8::StaticOrder S; S.init(8192, NPOS, pg8::ogrid(), pg8::obid());
                EpiTaps E{(_Float16*)(q.ws + WS_BIG + BIG_TAPS)};
                pg8::gemm_phase<EpiTaps, pg8::StaticOrder, false>(lds, g, S, E, nullptr); }
        }
        SEAM(pb + 0);
        for (int rep = 0, nrep = REPS(2, layer); rep < nrep; ++rep)
        if (IN(pb + 1)) {
            Params q{}; PA(q, ws);
            if (hy) { PA(q, hy_b_in); pg8::Gemm g{(const bf16_t*)(q.ws + WS_WL + WL_MIXIN), (const bf16_t*)(q.ws + WS_H), 6144, T, 2048}; pg8::StaticOrder S; S.init(6144, T, pg8::ogrid(), pg8::obid());
                EpiZinT E{(bf16_t*)(q.ws + WS_BIG + BIG_ZINT), T, q.hy_b_in + (size_t)j * 6144};
                pg8::gemm_phase<EpiZinT, pg8::StaticOrder, false>(lds, g, S, E, nullptr); }
            else { pg8::Gemm g{(const bf16_t*)(q.ws + WS_H), (const bf16_t*)(q.ws + WS_WL + WL_MIXIN), T, QKVW, 2048}; pg8::StaticOrder S; S.init(T, QKVW, pg8::ogrid(), pg8::obid());
                EpiQKV E{(bf16_t*)(q.ws + WS_BIG + BIG_QKV), (const cpx*)(q.ws + WS_ROPE)};
                pg8::gemm_phase<EpiQKV, pg8::StaticOrder, false>(lds, g, S, E, nullptr); }
            REPBAR();
        }
        SEAM(pb + 1);
        for (int rep = 0, nrep = REPS(3, layer); rep < nrep; ++rep)
        if (IN(pb + 2)) { Params q{}; PA(q, ws); if (hy) { PA(q, hy_skip); PA(q, hy_conv_w); PA(q, hy_conv_b); PA(q, hy_decay); hyena_conv_phase(q, lds, j, rep + 1 < nrep); } else attn_phase(q, lds, (rep + 1 < nrep) ? (1 | ((probe >> 12) & 2)) : 0); }
        SEAM(pb + 2);
        for (int rep = 0, nrep = REPS(4, layer); rep < nrep; ++rep)
        if (IN(pb + 3)) { Params q{}; PA(q, ws); if (hy) transpose_phase(q, lds); else attn_merge_phase(q); }
        SEAM(pb + 3);
        for (int rep = 0, nrep = REPS(5, layer); rep < nrep; ++rep)
        if (IN(pb + 4)) {
            Params q{}; PA(q, ws); PA(q, hy_b_out);
            pg8::Gemm g{(const bf16_t*)(q.ws + WS_H), (const bf16_t*)(q.ws + WS_WL + WL_MIXOUT), T, 2048, hy ? 2048 : 1024}; pg8::StaticOrder S; S.init(T, 2048, pg8::ogrid(), pg8::obid());
            EpiRes E{(bf16_t*)(q.ws + WS_XB), hy ? q.hy_b_out + (size_t)j * 2048 : nullptr, (const float*)(q.ws + WS_MOD) + layer * 12288 + 4096, rep + 1 < nrep};
            pg8::gemm_phase<EpiRes, pg8::StaticOrder, false>(lds, g, S, E, nullptr);
            REPBAR();
        }
        SEAM(pb + 4);
        for (int rep = 0, nrep = REPS(6, layer); rep < nrep; ++rep)
        if (IN(pb + 5)) { Params q{}; PA(q, ws); PA(q, norm_ffn);
            norm_rows<false, false>(nullptr, nullptr, (bf16_t*)(q.ws + WS_XB), q.norm_ffn + layer * 2048, (const float*)(q.ws + WS_MOD) + layer * 12288, 6144, 8192, (bf16_t*)(q.ws + WS_H), nullptr); }
        SEAM(pb + 5);
        for (int rep = 0, nrep = REPS(7, layer); rep < nrep; ++rep)
        if (IN(pb + 6)) {
            Params q{}; PA(q, ws);
            pg8::Gemm g{(const bf16_t*)(q.ws + WS_H), (const bf16_t*)(q.ws + WS_WL + WL_FFN1), T, 2 * DFF, 2048}; pg8::StaticOrder S; S.init(T, 2 * DFF, pg8::ogrid(), pg8::obid());
            EpiFFN1 E{(bf16_t*)(q.ws + WS_BIG + BIG_MID)};
            pg8::gemm_phase<EpiFFN1, pg8::StaticOrder, false>(lds, g, S, E, nullptr);
            REPBAR();
        }
        SEAM(pb + 6);
        for (int rep = 0, nrep = REPS(8, layer); rep < nrep; ++rep)
        if (IN(pb + 7)) {
            Params q{}; PA(q, ws);
            pg8::Gemm g{(const bf16_t*)(q.ws + WS_BIG + BIG_MID), (const bf16_t*)(q.ws + WS_WL + WL_FFN2), T, 2048, DFF}; pg8::StaticOrder S; S.init(T, 2048, pg8::ogrid(), pg8::obid());
            EpiRes E{(bf16_t*)(q.ws + WS_XB), nullptr, (const float*)(q.ws + WS_MOD) + layer * 12288 + 10240, rep + 1 < nrep};
            pg8::gemm_phase<EpiRes, pg8::StaticOrder, false>(lds, g, S, E, nullptr);
            REPBAR();
        }
        SEAM(pb + 7);
    }
    if (IN(34)) { Params q{}; PA(q, ws); PA(q, out); PA(q, final_norm); final_norm_phase(q); }
#undef REPS
#undef IN
#undef SEAM
}
}

extern "C" void kernel_launch(void* const* d_in, const int* in_sizes, int n_in, void* d_out, int out_size, void* d_ws, size_t ws_size, hipStream_t stream) {
    static int grid = 0;
    if (grid == 0) {
        if (n_in != 30 || out_size != mk::T * mk::D || ws_size < mk::WS_TOTAL) { fprintf(stderr, "kernel_launch: unexpected shapes (n_in %d out %d ws %zu need %zu); nothing launched\n", n_in, out_size, ws_size, (size_t)mk::WS_TOTAL); grid = -1; return; }
        int dev = 0, cus = 0;
        if (hipGetDevice(&dev) != hipSuccess || hipDeviceGetAttribute(&cus, hipDeviceAttributeMultiprocessorCount, dev) != hipSuccess) { grid = -1; return; }
        if (hipFuncSetAttribute((const void*)mk::mega, hipFuncAttributeMaxDynamicSharedMemorySize, mk::LDS_BYTES) != hipSuccess) { fprintf(stderr, "kernel_launch: hipFuncSetAttribute failed\n"); grid = -1; return; }
        int per_cu = 0; (void)hipOccupancyMaxActiveBlocksPerMultiprocessor(&per_cu, (const void*)mk::mega, 512, mk::LDS_BYTES); (void)hipGetLastError();
        if (per_cu < 1) fprintf(stderr, "kernel_launch: occupancy query reports %d blocks per CU\n", per_cu);
        grid = cus > 256 ? 256 : cus;
    }
    if (grid < 0) return;
    mk::Params p{};
    const float** f = (const float**)&p;
    for (int i = 0; i < 30; ++i) f[i] = (const float*)d_in[i];
    p.out = (float*)d_out; p.ws = (unsigned char*)d_ws; p.probe = MK_PROBE;
#if MK_PER_PHASE
    for (int k = 0; k < mk::NPHASE; ++k) { p.ph_lo = k; p.ph_hi = k + 1; hipLaunchKernelGGL(mk::mega, dim3(grid), dim3(512), mk::LDS_BYTES, stream, p); }
#else
    (void)hipMemsetAsync((char*)d_ws + mk::WS_CTL, 0, mk::CTL_BYTES, stream);
    p.ph_lo = 0; p.ph_hi = mk::NPHASE;
    hipLaunchKernelGGL(mk::mega, dim3(grid), dim3(512), mk::LDS_BYTES, stream, p);
#endif
}
```
